# Optimizing an MI355X kernel written in HIP

```python
import math
import jax
import jax.numpy as jnp
from jax import lax
import numpy as np

D_MODEL = 1024
BATCH = 8
SEQ = 2048
DEPTH = 2

N_MIXERS = 2
N_DIFF_LAYERS = (DEPTH + N_MIXERS - 1) // N_MIXERS
N_RET_LAYERS = DEPTH // N_MIXERS

DIFF_HEADS = 8
DIFF_HEAD_DIM = D_MODEL // DIFF_HEADS // 2
DIFF_V_DIM = 2 * DIFF_HEAD_DIM
Q_BLOCK = 128

NUM_BUCKETS = 32
MAX_EXACT = NUM_BUCKETS // 2
MAX_DISTANCE = 128

RET_HEADS = 4
RET_QK_DIM = D_MODEL
RET_HEAD_DK = RET_QK_DIM // RET_HEADS
RET_V_DIM = 2 * D_MODEL
RET_HEAD_DV = RET_V_DIM // RET_HEADS
RET_CHUNK = 128
RET_IN_DIM = 2 * RET_QK_DIM + 2 * RET_V_DIM

N_GROUPS = 4
EXPERTS_PER_GROUP = 8
N_EXPERTS = N_GROUPS * EXPERTS_PER_GROUP
TOP_K_INNER = 2
EXPERT_FF = D_MODEL // 2
ROW_BLOCK = 128

RMS_EPS = 1e-6
SUBLN_EPS = 1e-5

kernel_name = "hybrid_diffattn_retnet_hmoe"


def rms_norm(x, g, eps=RMS_EPS):
    xf = x.astype(jnp.float32)
    y = xf * lax.rsqrt(jnp.mean(xf * xf, axis=-1, keepdims=True) + eps)
    return (y * g.astype(jnp.float32)).astype(x.dtype)


def t5_bucket(rel):
    n = jnp.maximum(rel, 0)
    is_small = n < MAX_EXACT
    nf = jnp.maximum(n, MAX_EXACT).astype(jnp.float32)
    large = MAX_EXACT + (jnp.log(nf / MAX_EXACT) / math.log(MAX_DISTANCE / MAX_EXACT)
                         * (NUM_BUCKETS - MAX_EXACT)).astype(jnp.int32)
    large = jnp.minimum(large, NUM_BUCKETS - 1)
    return jnp.where(is_small, n, large)


def diff_lambda_init(layer_idx):
    return 0.8 - 0.6 * math.exp(-0.3 * layer_idx)


def differential_attention(h, w_in, lam_qk, subln_g, w_out, rel_table, lambda_init):
    B, S, D = h.shape
    proj = h @ w_in
    q, k, v = jnp.split(proj, [D, 2 * D], axis=-1)
    q = q.reshape(B, S, DIFF_HEADS, 2, DIFF_HEAD_DIM).transpose(3, 0, 2, 1, 4)
    k = k.reshape(B, S, DIFF_HEADS, 2, DIFF_HEAD_DIM).transpose(3, 0, 2, 1, 4)
    v = v.reshape(B, S, DIFF_HEADS, DIFF_V_DIM).transpose(0, 2, 1, 3)
    lq = lam_qk.astype(jnp.float32)
    lam = (jnp.exp(jnp.sum(lq[0] * lq[1])) - jnp.exp(jnp.sum(lq[2] * lq[3]))
           + lambda_init)
    scale = DIFF_HEAD_DIM ** -0.5
    nb = S // Q_BLOCK
    qb = q.reshape(2, B, DIFF_HEADS, nb, Q_BLOCK, DIFF_HEAD_DIM).transpose(3, 0, 1, 2, 4, 5)
    kpos = jnp.arange(S)

    def block(args):
        qblk, bi = args
        qpos = bi * Q_BLOCK + jnp.arange(Q_BLOCK)
        rel = qpos[:, None] - kpos[None, :]
        bias = rel_table[t5_bucket(rel)].transpose(2, 0, 1).astype(jnp.float32)
        s = jnp.einsum('ibhqd,ibhkd->ibhqk', qblk, k).astype(jnp.float32) * scale + bias
        s = jnp.where(rel >= 0, s, -jnp.inf)
        p = jax.nn.softmax(s, axis=-1)
        a = p[0] - lam * p[1]
        return jnp.einsum('bhqk,bhkd->bhqd', a.astype(v.dtype), v)

    o = lax.map(block, (qb, jnp.arange(nb)))
    o = o.transpose(1, 0, 3, 2, 4).reshape(B, S, DIFF_HEADS, DIFF_V_DIM)
    o = rms_norm(o, subln_g, SUBLN_EPS) * (1.0 - lambda_init)
    return o.reshape(B, S, D) @ w_out


def rotate_every_two(x):
    x1 = x[..., ::2]
    x2 = x[..., 1::2]
    return jnp.stack((-x2, x1), axis=-1).reshape(x.shape)


def retention_chunkwise(q, k, v):
    B, H, S, DK = q.shape
    DV = v.shape[-1]
    C = RET_CHUNK
    N = S // C
    log_gamma = jnp.log(1.0 - 2.0 ** (-5.0 - jnp.arange(H, dtype=jnp.float32)))
    pos = jnp.arange(C, dtype=jnp.float32)
    dist = pos[:, None] - pos[None, :]
    inner_decay = jnp.where(dist[None] >= 0,
                            jnp.exp(jnp.maximum(dist, 0.0)[None] * log_gamma[:, None, None]),
                            0.0)
    q_decay = jnp.exp((pos + 1.0)[None] * log_gamma[:, None])
    k_decay = jnp.exp((C - 1.0 - pos)[None] * log_gamma[:, None])
    chunk_decay = jnp.exp(C * log_gamma)
    qc = q.reshape(B, H, N, C, DK)
    kc = k.reshape(B, H, N, C, DK)
    vc = v.reshape(B, H, N, C, DV)
    scores = jnp.einsum('bhncd,bhnmd->bhncm', qc, kc) * inner_decay[None, :, None]
    inner = jnp.einsum('bhncm,bhnmv->bhncv', scores, vc)

    def step(state, xs):
        qn, kn, vn = xs
        cross = jnp.einsum('bhcd,bhdv->bhcv', qn * q_decay[None, :, :, None], state)
        state = (state * chunk_decay[None, :, None, None]
                 + jnp.einsum('bhcd,bhcv->bhdv', kn * k_decay[None, :, :, None], vn))
        return state, cross

    xs = (qc.transpose(2, 0, 1, 3, 4), kc.transpose(2, 0, 1, 3, 4), vc.transpose(2, 0, 1, 3, 4))
    _, cross = lax.scan(step, jnp.zeros((B, H, DK, DV), jnp.float32), xs)
    cross = cross.transpose(1, 2, 0, 3, 4)
    return (inner + cross).reshape(B, H, S, DV)


def retention(h, w_in, w_out):
    B, S, D = h.shape
    proj = h @ w_in
    q, k, v, g = jnp.split(proj, [RET_QK_DIM, 2 * RET_QK_DIM, 2 * RET_QK_DIM + RET_V_DIM], axis=-1)
    q = q.reshape(B, S, RET_HEADS, RET_HEAD_DK).transpose(0, 2, 1, 3).astype(jnp.float32)
    k = k.reshape(B, S, RET_HEADS, RET_HEAD_DK).transpose(0, 2, 1, 3).astype(jnp.float32)
    k = k * (RET_HEAD_DK ** -0.5)
    v = v.reshape(B, S, RET_HEADS, RET_HEAD_DV).transpose(0, 2, 1, 3).astype(jnp.float32)
    angle = 1.0 / (10000.0 ** jnp.linspace(0.0, 1.0, RET_HEAD_DK // 2, dtype=jnp.float32))
    angle = jnp.repeat(angle, 2)
    phase = jnp.arange(S, dtype=jnp.float32)[:, None] * angle[None, :]
    sin, cos = jnp.sin(phase), jnp.cos(phase)
    q = q * cos + rotate_every_two(q) * sin
    k = k * cos + rotate_every_two(k) * sin
    o = retention_chunkwise(q, k, v)
    o = o * lax.rsqrt(jnp.mean(o * o, axis=-1, keepdims=True) + RMS_EPS)
    o = o.transpose(0, 2, 1, 3).reshape(B, S, RET_V_DIM).astype(h.dtype)
    o = jax.nn.silu(g) * o
    return o @ w_out


def hierarchical_moe(h, w_group, b_group, w_expert, b_expert, w_gate, w_up, w_down):
    B, S, D = h.shape
    T = B * S
    ht = h.reshape(T, D)
    tok = jnp.arange(T)
    g_probs = jax.nn.softmax((ht @ w_group + b_group).astype(jnp.float32), axis=-1)
    g_idx = jnp.argmax(g_probs, axis=-1)
    g_p = jnp.max(g_probs, axis=-1)
    e_logits = (ht @ w_expert + b_expert).astype(jnp.float32).reshape(T, N_GROUPS, EXPERTS_PER_GROUP)
    e_sel = e_logits[tok, g_idx]
    top_v, top_i = lax.top_k(e_sel, TOP_K_INNER)
    top_w = jax.nn.softmax(top_v, axis=-1) * g_p[:, None]
    expert_id = (g_idx[:, None] * EXPERTS_PER_GROUP + top_i).reshape(-1)
    weight = top_w.reshape(-1)
    token = jnp.repeat(tok, TOP_K_INNER)
    order = jnp.argsort(expert_id)
    s_e, s_tok, s_w = expert_id[order], token[order], weight[order]
    counts = jnp.zeros((N_EXPERTS,), jnp.int32).at[expert_id].add(1)
    padded = ((counts + ROW_BLOCK - 1) // ROW_BLOCK) * ROW_BLOCK
    pad_end = jnp.cumsum(padded)
    pad_start = pad_end - padded
    start = jnp.cumsum(counts) - counts
    n_assign = T * TOP_K_INNER
    dest = pad_start[s_e] + (jnp.arange(n_assign) - start[s_e])
    n_blocks = (n_assign + ROW_BLOCK - 1) // ROW_BLOCK + N_EXPERTS
    n_rows = n_blocks * ROW_BLOCK
    row_tok = jnp.zeros((n_rows,), jnp.int32).at[dest].set(s_tok.astype(jnp.int32))
    row_w = jnp.zeros((n_rows,), jnp.float32).at[dest].set(s_w)
    block_e = jnp.clip(jnp.searchsorted(pad_end, jnp.arange(n_blocks) * ROW_BLOCK, side='right'),
                       0, N_EXPERTS - 1)
    xr = ht[row_tok].reshape(n_blocks, ROW_BLOCK, D)

    def expert_block(args):
        xb, e = args
        return (jax.nn.silu(xb @ w_gate[e]) * (xb @ w_up[e])) @ w_down[e]

    yr = lax.map(expert_block, (xr, block_e)).reshape(n_rows, D)
    y = jnp.zeros((T, D), h.dtype).at[row_tok].add(yr * row_w[:, None].astype(h.dtype))
    return y.reshape(B, S, D)


def setup_inputs(seed: int = 0) -> dict:
    key = jax.random.key(seed)
    ks = jax.random.split(key, 20)

    def nrm(k, shape, scale):
        return jax.random.normal(k, shape, jnp.float32) * scale

    return {
        "x": nrm(ks[0], (BATCH, SEQ, D_MODEL), 1.0),
        "rel_bias_table": nrm(ks[1], (NUM_BUCKETS, DIFF_HEADS), 0.2),
        "norm_mix": 1.0 + nrm(ks[2], (DEPTH, D_MODEL), 0.01),
        "norm_ffn": 1.0 + nrm(ks[3], (DEPTH, D_MODEL), 0.01),
        "norm_final": 1.0 + nrm(ks[4], (D_MODEL,), 0.01),
        "diff_w_in": nrm(ks[5], (N_DIFF_LAYERS, D_MODEL, 3 * D_MODEL), D_MODEL ** -0.5),
        "diff_lambda_qk": nrm(ks[6], (N_DIFF_LAYERS, 4, DIFF_HEAD_DIM), 0.1),
        "diff_subln": 1.0 + nrm(ks[7], (N_DIFF_LAYERS, DIFF_V_DIM), 0.01),
        "diff_w_out": nrm(ks[8], (N_DIFF_LAYERS, D_MODEL, D_MODEL), D_MODEL ** -0.5),
        "ret_w_in": nrm(ks[9], (N_RET_LAYERS, D_MODEL, RET_IN_DIM), D_MODEL ** -0.5),
        "ret_w_out": nrm(ks[10], (N_RET_LAYERS, RET_V_DIM, D_MODEL), RET_V_DIM ** -0.5),
        "moe_w_group": nrm(ks[11], (DEPTH, D_MODEL, N_GROUPS), D_MODEL ** -0.5),
        "moe_b_group": nrm(ks[12], (DEPTH, N_GROUPS), 0.01),
        "moe_w_expert": nrm(ks[13], (DEPTH, D_MODEL, N_EXPERTS), D_MODEL ** -0.5),
        "moe_b_expert": nrm(ks[14], (DEPTH, N_EXPERTS), 0.01),
        "moe_w_gate": nrm(ks[15], (DEPTH, N_EXPERTS, D_MODEL, EXPERT_FF), D_MODEL ** -0.5),
        "moe_w_up": nrm(ks[16], (DEPTH, N_EXPERTS, D_MODEL, EXPERT_FF), D_MODEL ** -0.5),
        "moe_w_down": nrm(ks[17], (DEPTH, N_EXPERTS, EXPERT_FF, D_MODEL), EXPERT_FF ** -0.5),
    }


def reference(x, rel_bias_table, norm_mix, norm_ffn, norm_final, diff_w_in, diff_lambda_qk,
              diff_subln, diff_w_out, ret_w_in, ret_w_out, moe_w_group, moe_b_group,
              moe_w_expert, moe_b_expert, moe_w_gate, moe_w_up, moe_w_down):
    for i in range(DEPTH):
        hn = rms_norm(x, norm_mix[i])
        j = i // N_MIXERS
        if i % N_MIXERS == 0:
            mix = differential_attention(hn, diff_w_in[j], diff_lambda_qk[j], diff_subln[j],
                                         diff_w_out[j], rel_bias_table, diff_lambda_init(i))
        else:
            mix = retention(hn, ret_w_in[j], ret_w_out[j])
        x = x + mix
        x = x + hierarchical_moe(rms_norm(x, norm_ffn[i]), moe_w_group[i], moe_b_group[i],
                                 moe_w_expert[i], moe_b_expert[i], moe_w_gate[i],
                                 moe_w_up[i], moe_w_down[i])
    return rms_norm(x, norm_final)
```

```cpp
#include <hip/hip_runtime.h>
#include <hip/hip_bf16.h>
#include <cstdio>
#include <cstdint>

#define LAS __attribute__((address_space(3)))
#define GAS __attribute__((address_space(1)))

namespace pg8 {
typedef unsigned short bf16_t;
typedef short bf16x8 __attribute__((ext_vector_type(8)));
typedef float f32x4 __attribute__((ext_vector_type(4)));
typedef float f32x2 __attribute__((ext_vector_type(2)));
typedef unsigned u32x4 __attribute__((ext_vector_type(4)));
typedef unsigned u32x2 __attribute__((ext_vector_type(2)));
constexpr int BM = 256, BK = 64, HALF = 128, HTB = HALF * BK * 2, STAGE_BYTES = 8 * HTB, NXCD = 8, WGM = 8;

__host__ __device__ __forceinline__ int lds_byte(int r, int c) { const int st = (r >> 4) * 2 + (c >> 5), rr = r & 15, cc = c & 31, ob = rr * 64 + cc * 2; return st * 1024 + (ob ^ (((ob >> 9) & 1) << 5)); }
__host__ __device__ __forceinline__ void stage_rc(int b, int& R, int& C) { const int st = b / 1024, sb = b % 1024, swz = sb ^ (((sb >> 9) & 1) << 5); R = (st >> 1) * 16 + swz / 64; C = (st & 1) * 32 + (swz % 64) / 2; }
__host__ __device__ __forceinline__ int perm32(int rho) { const int n = rho >> 4, i = rho & 15; return 8 * (i >> 2) + 4 * n + (i & 3); }

struct Unit { int pm, pn, aux; long aoff, boff; };
struct Gemm { const bf16_t* A; const bf16_t* Bt; int lda, ldb, K; };

struct StaticOrder {
    int nM, nN, nwg, G, c, lda, ldb;
    __device__ void init(int M, int N, int G_, int c_, int lda_, int ldb_) { nM = M / BM; nN = N / BM; nwg = nM * nN; G = G_; c = c_; lda = lda_; ldb = ldb_; }
    __device__ bool next(int i, Unit& u) const {
        const long L = (long)i * G + c; if (L >= nwg) return false;
        int wgid = (int)L; { const int q = nwg / NXCD, r = nwg % NXCD, xcd = wgid % NXCD, off = wgid / NXCD; wgid = (xcd < r ? xcd * (q + 1) : r * (q + 1) + (xcd - r) * q) + off; }
        const int nig = WGM * nN, gid = wgid / nig, fm = gid * WGM, gsz = (nM - fm) < WGM ? (nM - fm) : WGM;
        u.pm = fm + ((wgid % nig) % gsz); u.pn = (wgid % nig) / gsz; u.aux = 0;
        u.aoff = (long)u.pm * BM * lda; u.boff = (long)u.pn * BM * ldb; return true;
    }
};

__device__ __forceinline__ unsigned cvt_pk_bf16(float lo, float hi) { unsigned r; asm volatile("v_cvt_pk_bf16_f32 %0, %1, %2" : "=v"(r) : "v"(lo), "v"(hi)); return r; }
__device__ __forceinline__ u32x4 pack8(const f32x4 v0, const f32x4 v1) { u32x4 w; w.x = cvt_pk_bf16(v0[0], v0[1]); w.y = cvt_pk_bf16(v0[2], v0[3]); w.z = cvt_pk_bf16(v1[0], v1[1]); w.w = cvt_pk_bf16(v1[2], v1[3]); return w; }

template <class Epi, class Sched, bool ALIGN_EPI, bool GATHER>
__device__ __forceinline__ void gemm_phase(LAS unsigned char* lds, const Gemm g, const Sched& S, const Epi& E, const LAS int* rowtab) {
    int tid_ = threadIdx.x; asm volatile("" : "+v"(tid_));
    const int tid = tid_, wid = __builtin_amdgcn_readfirstlane(tid >> 6), lane = tid & 63, wr = wid >> 2, wc = wid & 3, fr = lane & 15, fq = lane >> 4;
    const int K = g.K, nt = K / BK;
    int sR[2], sC[2]; unsigned voffB[2];
#pragma unroll
    for (int i = 0; i < 2; ++i) { int R, C; stage_rc(tid * 16 + i * 8192, R, C); sR[i] = R; sC[i] = C; const int Rb = Epi::PERM ? ((R & ~31) + perm32(R & 31)) : R; voffB[i] = (unsigned)(Rb * g.ldb + C) * 2u; }
    unsigned avo[2][2], navo[2][2];
#define PG8_SETOFF(o, ui_) do { _Pragma("unroll") for (int h_ = 0; h_ < 2; ++h_) _Pragma("unroll") for (int i_ = 0; i_ < 2; ++i_) { const int row_ = h_ * HALF + sR[i_]; \
        const int grow_ = GATHER ? rowtab[(ui_) * BM + row_] : row_; o[h_][i_] = (unsigned)(grow_ * g.lda + sC[i_]) * 2u; } } while (0)
    const size_t kstep = (size_t)(BK * 2);
    const size_t hstepB = (size_t)HALF * g.ldb * 2;
    const unsigned ldsw = (unsigned)wid * 1024u;
    const int aoff = lds_byte(wr * 64 + fr, fq * 8), boff = lds_byte(wc * 32 + fr, fq * 8);
#define PG8_SA(b, h) (((b) * 2 + (h)) * HTB)
#define PG8_SB(b, h) ((4 + (b) * 2 + (h)) * HTB)
#define PG8_STAGE(bufoff, gbase, voff) do { _Pragma("unroll") for (int _i = 0; _i < 2; ++_i) \
        __builtin_amdgcn_global_load_lds((const unsigned*)((const char*)(gbase) + (voff)[_i]), (LAS unsigned*)(lds + (bufoff) + ldsw + _i * 8192), 16, 0, 0); } while (0)
#define PG8_LDA(dst, b, h) do { _Pragma("unroll") for (int m = 0; m < 4; ++m) _Pragma("unroll") for (int k = 0; k < 2; ++k) dst[m][k] = *(const LAS bf16x8*)(lds + PG8_SA(b, h) + aoff + m * 2048 + k * 1024); } while (0)
#define PG8_LDB(dst, b, h) do { _Pragma("unroll") for (int n = 0; n < 2; ++n) _Pragma("unroll") for (int k = 0; k < 2; ++k) dst[n][k] = *(const LAS bf16x8*)(lds + PG8_SB(b, h) + boff + n * 2048 + k * 1024); } while (0)
#define PG8_MMA(ai, bj, At, Bt) do { __builtin_amdgcn_s_setprio(1); _Pragma("unroll") for (int m = 0; m < 4; ++m) _Pragma("unroll") for (int n = 0; n < 2; ++n) _Pragma("unroll") for (int k = 0; k < 2; ++k) \
        acc[ai][bj][m][n] = __builtin_amdgcn_mfma_f32_16x16x32_bf16(Bt[n][k], At[m][k], acc[ai][bj][m][n], 0, 0, 0); __builtin_amdgcn_s_setprio(0); } while (0)
#define PG8_WAIT_V(n) asm volatile("s_waitcnt vmcnt(" #n ")" ::: "memory")
#define PG8_WAIT_L(n) asm volatile("s_waitcnt lgkmcnt(" #n ")" ::: "memory")
#define PG8_BAR __builtin_amdgcn_s_barrier()
#define PG8_SCHED __builtin_amdgcn_sched_barrier(0)
    Unit cur, nxt; int ui = 0;
    if (!S.next(0, cur)) return;
    f32x4 acc[2][2][4][2];
#pragma unroll
    for (int a = 0; a < 2; ++a)
#pragma unroll
        for (int b = 0; b < 2; ++b)
#pragma unroll
            for (int m = 0; m < 4; ++m)
#pragma unroll
                for (int n = 0; n < 2; ++n) acc[a][b][m][n] = (f32x4){0.f, 0.f, 0.f, 0.f};
    bf16x8 At[4][2], B0[2][2], B1[2][2];
    const char* cA = (const char*)g.A + cur.aoff * 2; const char* cB = (const char*)g.Bt + cur.boff * 2;
    PG8_SETOFF(avo, 0);
    PG8_STAGE(PG8_SB(0, 0), cB, voffB); PG8_STAGE(PG8_SB(0, 1), cB + hstepB, voffB); PG8_STAGE(PG8_SA(0, 0), cA, avo[0]); PG8_STAGE(PG8_SA(0, 1), cA, avo[1]);
    if (wr == 1) PG8_BAR;
    PG8_WAIT_V(2); PG8_BAR;
    PG8_STAGE(PG8_SB(1, 0), cB + kstep, voffB); PG8_STAGE(PG8_SA(1, 0), cA + kstep, avo[0]); PG8_STAGE(PG8_SB(1, 1), cB + hstepB + kstep, voffB);
    PG8_WAIT_V(6); PG8_BAR;
    for (;;) {
        const bool has_next = S.next(ui + 1, nxt);
        const char* nA = has_next ? (const char*)g.A + nxt.aoff * 2 : cA; const char* nB = has_next ? (const char*)g.Bt + nxt.boff * 2 : cB;
        if (GATHER && has_next) { PG8_SETOFF(navo, ui + 1); }
        else {
#pragma unroll
            for (int h_ = 0; h_ < 2; ++h_)
#pragma unroll
                for (int i_ = 0; i_ < 2; ++i_) navo[h_][i_] = avo[h_][i_]; }
#pragma nounroll
        for (int t = 0; t < nt; t += 2) {
            const bool last = (t == nt - 2);
            const char* a1 = cA + (size_t)(t + 1) * kstep;
            const char* a2 = last ? nA : cA + (size_t)(t + 2) * kstep; const char* b2 = last ? nB : cB + (size_t)(t + 2) * kstep;
            const char* a3 = a2 + kstep; const char* b3 = b2 + kstep;
            unsigned o2[2][2];
#pragma unroll
            for (int h_ = 0; h_ < 2; ++h_)
#pragma unroll
                for (int i_ = 0; i_ < 2; ++i_) o2[h_][i_] = (GATHER && last) ? navo[h_][i_] : avo[h_][i_];
            PG8_LDB(B0, 0, 0); PG8_LDB(B1, 0, 1); PG8_SCHED; PG8_LDA(At, 0, 0); PG8_STAGE(PG8_SA(1, 1), a1, avo[1]);
            PG8_WAIT_V(8); PG8_WAIT_L(0); PG8_BAR; PG8_MMA(0, 0, At, B0); PG8_MMA(0, 1, At, B1); PG8_BAR; PG8_SCHED;
            PG8_LDA(At, 0, 1); PG8_STAGE(PG8_SB(0, 0), b2, voffB); PG8_STAGE(PG8_SB(0, 1), b2 + hstepB, voffB); PG8_STAGE(PG8_SA(0, 0), a2, o2[0]);
            PG8_WAIT_V(8); PG8_WAIT_L(0); PG8_BAR; PG8_MMA(1, 0, At, B0); PG8_MMA(1, 1, At, B1); PG8_BAR; PG8_SCHED;
            PG8_LDB(B0, 1, 0); PG8_LDB(B1, 1, 1); PG8_SCHED; PG8_LDA(At, 1, 0); PG8_STAGE(PG8_SA(0, 1), a2, o2[1]);
            PG8_WAIT_V(8); PG8_WAIT_L(0); PG8_BAR; PG8_MMA(0, 0, At, B0); PG8_MMA(0, 1, At, B1); PG8_BAR; PG8_SCHED;
            PG8_LDA(At, 1, 1); PG8_STAGE(PG8_SB(1, 0), b3, voffB); PG8_STAGE(PG8_SB(1, 1), b3 + hstepB, voffB); PG8_STAGE(PG8_SA(1, 0), a3, o2[0]);
            PG8_WAIT_V(8); PG8_WAIT_L(0); PG8_BAR; PG8_MMA(1, 0, At, B0); PG8_MMA(1, 1, At, B1); PG8_BAR; PG8_SCHED;
        }
        if constexpr (ALIGN_EPI) { if (wr == 0) PG8_BAR; }
        { int efr = fr, efq = fq; asm volatile("" : "+v"(efr), "+v"(efq)); E(acc, cur, wr, wc, efr, efq); }
        if (!has_next) break;
#pragma unroll
        for (int a = 0; a < 2; ++a)
#pragma unroll
            for (int b = 0; b < 2; ++b)
#pragma unroll
                for (int m = 0; m < 4; ++m)
#pragma unroll
                    for (int n = 0; n < 2; ++n) acc[a][b][m][n] = (f32x4){0.f, 0.f, 0.f, 0.f};
        cur = nxt; cA = nA; cB = nB; ++ui;
#pragma unroll
        for (int h_ = 0; h_ < 2; ++h_)
#pragma unroll
            for (int i_ = 0; i_ < 2; ++i_) avo[h_][i_] = navo[h_][i_];
        if constexpr (ALIGN_EPI) { if (wr == 1) PG8_BAR; }
    }
    PG8_WAIT_V(0);
    if constexpr (!ALIGN_EPI) { if (wr == 0) PG8_BAR; }
    PG8_BAR;
#undef PG8_SETOFF
#undef PG8_SA
#undef PG8_SB
#undef PG8_STAGE
#undef PG8_LDA
#undef PG8_LDB
#undef PG8_MMA
#undef PG8_WAIT_V
#undef PG8_WAIT_L
#undef PG8_BAR
#undef PG8_SCHED
}
}
constexpr int NB = 8, SEQ = 2048, DM = 1024, TOK = NB * SEQ;
constexpr int AH = 8;
constexpr int RH = 4, RDK = 256, RDV = 512, RC = 256, RNC = SEQ / RC;
constexpr int NEXP = 32, EFF = 512, NPAIR = 2 * TOK, LISTCAP = TOK;
constexpr int MAXRT = NPAIR / 256 + NEXP;
constexpr float RMS_EPS = 1e-6f, SUBLN_EPS = 1e-5f, LOG2E = 1.4426950408889634f;
constexpr float ATT_C2 = 0.125f * LOG2E;

constexpr size_t MiB = 1u << 20;
constexpr size_t WS_CTL = 0, CTL_ZERO_BYTES = 1 * MiB;
constexpr size_t WS_LIST = 1 * MiB;
constexpr size_t WS_PAIRW = 3 * MiB;
constexpr size_t WS_WRF = 3 * MiB + 512 * 1024;
constexpr size_t WS_SINCOS = 4 * MiB;
constexpr size_t WS_SINCOST = 6 * MiB;
constexpr size_t WS_WINT0 = 8 * MiB;
constexpr size_t WS_WOUTT0 = 14 * MiB;
constexpr size_t WS_WRINA = 16 * MiB;
constexpr size_t WS_WRINB = 24 * MiB;
constexpr size_t WS_WROUTT = 30 * MiB;
constexpr size_t WS_W1CAT = 34 * MiB;
constexpr size_t WS_W2T = 98 * MiB;
constexpr size_t WS_DS = 34 * MiB;
constexpr size_t WS_ORET = 34 * MiB;
constexpr size_t WS_HB = 130 * MiB;
constexpr size_t WS_ACTBASE = 162 * MiB;
constexpr size_t WS_QKV0 = WS_ACTBASE;
constexpr size_t WS_OP = WS_ACTBASE + 96 * MiB;
constexpr size_t WS_AO = WS_ACTBASE + 160 * MiB;
constexpr size_t WS_MACT = WS_ACTBASE;
constexpr size_t WS_Y = WS_ACTBASE + 40 * MiB;
constexpr size_t WS_ACAT = WS_ACTBASE;
constexpr size_t WS_BTCAT = WS_ACTBASE + 64 * MiB;
constexpr size_t WS_KI = WS_ACTBASE + 192 * MiB;
constexpr size_t WS_KIT = WS_ACTBASE + 224 * MiB;
constexpr size_t WS_SG = WS_ACTBASE + 256 * MiB;
constexpr size_t WS_END = WS_ACTBASE + 320 * MiB;
constexpr int CW_TMO = 0, CW_BAR = 4096, CW_CNT = 16384;

constexpr int RING_OFF = 0, RING_BYTES = 131072;
constexpr int LX_OFF = RING_BYTES;
constexpr int LX_MISC = LX_OFF + 320;
constexpr int LX_ROWTAB = LX_OFF + 1024;
constexpr int LX_TSTART = LX_OFF + 5120;
constexpr int LX_TEXP = LX_OFF + 5376;
constexpr int LX_LUT = LX_OFF + 6144;
constexpr int LX_CNT = LX_OFF + 7168;
constexpr int LDS_BYTES = 147456;

namespace pg8 {
struct EpiQKV {
    static constexpr bool PERM = true;
    bf16_t* O; float qscale;
    __device__ __forceinline__ void operator()(const f32x4 (&acc)[2][2][4][2], const Unit& u, int wr, int wc, int fr, int fq) const {
        const int row0 = u.pm * BM + wr * 64 + fr, col0 = u.pn * BM + wc * 32 + 8 * fq; const float sc = (u.pn < 4) ? qscale : 1.f;
#pragma unroll
        for (int ai = 0; ai < 2; ++ai)
#pragma unroll
            for (int m = 0; m < 4; ++m) { bf16_t* rowp = O + (size_t)(row0 + ai * HALF + m * 16) * 3072 + col0;
#pragma unroll
                for (int bj = 0; bj < 2; ++bj) *(u32x4*)(rowp + bj * HALF) = pack8(acc[ai][bj][m][0] * sc, acc[ai][bj][m][1] * sc); }
    }
};
struct EpiRes {
    static constexpr bool PERM = false;
    const float* res; float* out;
    __device__ __forceinline__ void operator()(const f32x4 (&acc)[2][2][4][2], const Unit& u, int wr, int wc, int fr, int fq) const {
        const int row0 = u.pm * BM + wr * 64 + fr, col0 = u.pn * BM + wc * 32 + 4 * fq;
#pragma unroll
        for (int ai = 0; ai < 2; ++ai)
#pragma unroll
            for (int m = 0; m < 4; ++m) { const size_t off = (size_t)(row0 + ai * HALF + m * 16) * 1024 + col0;
#pragma unroll
                for (int bj = 0; bj < 2; ++bj)
#pragma unroll
                    for (int n = 0; n < 2; ++n) { const f32x4 r = *(const f32x4*)(res + off + bj * HALF + n * 16); *(f32x4*)(out + off + bj * HALF + n * 16) = r + acc[ai][bj][m][n]; }
                asm volatile("" ::: "memory"); }
    }
};
__device__ __forceinline__ float silu_f(float x) { return x * __builtin_amdgcn_rcpf(1.0f + __builtin_amdgcn_exp2f(-x * LOG2E)); }
struct EpiMoe1 {
    static constexpr bool PERM = true;
    bf16_t* ACT;
    __device__ __forceinline__ void operator()(const f32x4 (&acc)[2][2][4][2], const Unit& u, int wr, int wc, int fr, int fq) const {
        const int row0 = u.pm * BM + wr * 64 + fr, col0 = (u.pn & 3) * 128 + wc * 32 + 8 * fq;
#pragma unroll
        for (int ai = 0; ai < 2; ++ai)
#pragma unroll
            for (int m = 0; m < 4; ++m) { f32x4 a0, a1;
#pragma unroll
                for (int j = 0; j < 4; ++j) { a0[j] = silu_f(acc[ai][0][m][0][j]) * acc[ai][1][m][0][j]; a1[j] = silu_f(acc[ai][0][m][1][j]) * acc[ai][1][m][1][j]; }
                *(u32x4*)(ACT + (size_t)(row0 + ai * HALF + m * 16) * 512 + col0) = pack8(a0, a1); }
    }
};
struct EpiMoe2 {
    static constexpr bool PERM = true;
    bf16_t* Y; const int* list; const float* pairw; const LAS int* lcnt;
    __device__ __forceinline__ void operator()(const f32x4 (&acc)[2][2][4][2], const Unit& u, int wr, int wc, int fr, int fq) const {
        const int e = u.pn >> 2, col0 = (u.pn & 3) * BM + wc * 32 + 8 * fq, pos0 = u.aux * BM + wr * 64 + fr, cn = lcnt[e];
#pragma unroll
        for (int ai = 0; ai < 2; ++ai)
#pragma unroll
            for (int m = 0; m < 4; ++m) { const int pos = pos0 + ai * HALF + m * 16;
                if (pos < cn) { const int pair = list[e * LISTCAP + pos]; const float w = pairw[pair]; bf16_t* rowp = Y + (size_t)pair * 1024 + col0;
#pragma unroll
                    for (int bj = 0; bj < 2; ++bj) *(u32x4*)(rowp + bj * HALF) = pack8(acc[ai][bj][m][0] * w, acc[ai][bj][m][1] * w); } }
    }
};
__device__ __forceinline__ float log2_gamma(int h) { return __builtin_log2f(1.0f - __builtin_amdgcn_exp2f(-5.0f - (float)h)); }
struct EpiRetA {
    static constexpr bool PERM = true;
    bf16_t* ACAT; bf16_t* KI; bf16_t* SG; const float* sincos;
    __device__ __forceinline__ void operator()(const f32x4 (&acc)[2][2][4][2], const Unit& u, int wr, int wc, int fr, int fq) const {
        const int r0 = wr * 64 + fr, c0 = wc * 32 + 8 * fq;
        if (u.pn >= 8) {
#pragma unroll
            for (int ai = 0; ai < 2; ++ai)
#pragma unroll
                for (int m = 0; m < 4; ++m) { bf16_t* rowp = SG + (size_t)(u.pm * BM + r0 + ai * HALF + m * 16) * 2048 + (u.pn - 8) * BM + c0;
#pragma unroll
                    for (int bj = 0; bj < 2; ++bj) { f32x4 a0, a1;
#pragma unroll
                        for (int j = 0; j < 4; ++j) { a0[j] = silu_f(acc[ai][bj][m][0][j]); a1[j] = silu_f(acc[ai][bj][m][1][j]); }
                        *(u32x4*)(rowp + bj * HALF) = pack8(a0, a1); } }
            return;
        }
        const bool isq = u.pn < 4; const int h = u.pn & 3; const float l2g = log2_gamma(h);
        const int b = u.pm >> 3, n = u.pm & 7;
#pragma unroll
        for (int ai = 0; ai < 2; ++ai)
#pragma unroll
            for (int m = 0; m < 4; ++m) { const int r = r0 + ai * HALF + m * 16, pos = n * RC + r;
                const float fac = isq ? __builtin_amdgcn_exp2f((float)(r + 1) * l2g) : 0.0625f * __builtin_amdgcn_exp2f(-(float)(r + 1) * l2g);
                bf16_t* rowp = isq ? ACAT + ((size_t)((b * RH + h) * RNC + n) * RC + r) * 512 + 256 + c0 : KI + (size_t)(u.pm * BM + r) * 1024 + h * RDK + c0;
#pragma unroll
                for (int bj = 0; bj < 2; ++bj) { const f32x4* cs = (const f32x4*)(sincos + ((size_t)pos * 128 + (bj * HALF + c0) / 2) * 2);
                    const f32x4 t0 = cs[0], t1 = cs[1]; const f32x4 x0 = acc[ai][bj][m][0], x1 = acc[ai][bj][m][1]; f32x4 y0, y1;
                    y0[0] = (x0[0] * t0[0] - x0[1] * t0[1]) * fac; y0[1] = (x0[1] * t0[0] + x0[0] * t0[1]) * fac; y0[2] = (x0[2] * t0[2] - x0[3] * t0[3]) * fac; y0[3] = (x0[3] * t0[2] + x0[2] * t0[3]) * fac;
                    y1[0] = (x1[0] * t1[0] - x1[1] * t1[1]) * fac; y1[1] = (x1[1] * t1[0] + x1[0] * t1[1]) * fac; y1[2] = (x1[2] * t1[2] - x1[3] * t1[3]) * fac; y1[3] = (x1[3] * t1[2] + x1[2] * t1[3]) * fac;
                    *(u32x4*)(rowp + bj * HALF) = pack8(y0, y1); } }
    }
};
struct EpiRetB {
    static constexpr bool PERM = true;
    bf16_t* KIT; bf16_t* BTCAT; const float* sincosT;
    __device__ __forceinline__ void operator()(const f32x4 (&acc)[2][2][4][2], const Unit& u, int wr, int wc, int fr, int fq) const {
        const int r0 = wr * 64 + fr, c0 = wc * 32 + 8 * fq; const int b = u.pn >> 3, n = u.pn & 7;
        if (u.pm >= 4) { const int h = (u.pm - 4) >> 1, dv0 = ((u.pm - 4) & 1) * BM;
#pragma unroll
            for (int ai = 0; ai < 2; ++ai)
#pragma unroll
                for (int m = 0; m < 4; ++m) { bf16_t* rowp = BTCAT + ((size_t)((b * RH + h) * RNC + n) * RDV + dv0 + r0 + ai * HALF + m * 16) * 512 + c0;
#pragma unroll
                    for (int bj = 0; bj < 2; ++bj) *(u32x4*)(rowp + bj * HALF) = pack8(acc[ai][bj][m][0], acc[ai][bj][m][1]); }
            return;
        }
        const int h = u.pm; const float l2g = log2_gamma(h);
        float fc[2][8];
#pragma unroll
        for (int bj = 0; bj < 2; ++bj)
#pragma unroll
            for (int j = 0; j < 8; ++j) fc[bj][j] = 0.0625f * __builtin_amdgcn_exp2f(-(float)(bj * HALF + c0 + j + 1) * l2g);
        const bool odd = (fr & 1) != 0;
#pragma unroll
        for (int ai = 0; ai < 2; ++ai)
#pragma unroll
            for (int m = 0; m < 4; ++m) { const int r = r0 + ai * HALF + m * 16;
                bf16_t* rowp = KIT + ((size_t)((b * RH + h) * RDK + r)) * SEQ + n * RC + c0;
#pragma unroll
                for (int bj = 0; bj < 2; ++bj) { const f32x4* cs = (const f32x4*)(sincosT + ((size_t)(r >> 1) * SEQ + n * RC + bj * HALF + c0) * 2);
                    f32x4 y[2];
#pragma unroll
                    for (int nn = 0; nn < 2; ++nn) { const f32x4 ta = cs[nn * 2], tb = cs[nn * 2 + 1]; const f32x4 x = acc[ai][bj][m][nn]; f32x4 xp;
#pragma unroll
                        for (int j = 0; j < 4; ++j) xp[j] = __shfl_xor(x[j], 1);
                        const float cc[4] = {ta[0], ta[2], tb[0], tb[2]}, ss[4] = {ta[1], ta[3], tb[1], tb[3]};
#pragma unroll
                        for (int j = 0; j < 4; ++j) y[nn][j] = (x[j] * cc[j] + (odd ? xp[j] : -xp[j]) * ss[j]) * fc[bj][nn * 4 + j]; }
                    *(u32x4*)(rowp + bj * HALF) = pack8(y[0], y[1]); } }
    }
};
struct EpiScores {
    static constexpr bool PERM = true;
    bf16_t* ACAT;
    __device__ __forceinline__ void operator()(const f32x4 (&acc)[2][2][4][2], const Unit& u, int wr, int wc, int fr, int fq) const {
        const int r0 = wr * 64 + fr, c0 = wc * 32 + 8 * fq;
#pragma unroll
        for (int ai = 0; ai < 2; ++ai)
#pragma unroll
            for (int m = 0; m < 4; ++m) { const int r = r0 + ai * HALF + m * 16; bf16_t* rowp = ACAT + ((size_t)u.pm * RC + r) * 512 + c0;
#pragma unroll
                for (int bj = 0; bj < 2; ++bj) { f32x4 y0 = acc[ai][bj][m][0], y1 = acc[ai][bj][m][1]; const int cb = bj * HALF + c0;
#pragma unroll
                    for (int j = 0; j < 4; ++j) { if (cb + j > r) y0[j] = 0.f; if (cb + 4 + j > r) y1[j] = 0.f; }
                    *(u32x4*)(rowp + bj * HALF) = pack8(y0, y1); } }
    }
};
struct EpiDS {
    static constexpr bool PERM = true;
    bf16_t* DS;
    __device__ __forceinline__ void operator()(const f32x4 (&acc)[2][2][4][2], const Unit& u, int wr, int wc, int fr, int fq) const {
        const int r0 = wr * 64 + fr, c0 = wc * 32 + 8 * fq;
#pragma unroll
        for (int ai = 0; ai < 2; ++ai)
#pragma unroll
            for (int m = 0; m < 4; ++m) { bf16_t* rowp = DS + ((size_t)u.pm * RDV + u.pn * BM + r0 + ai * HALF + m * 16) * RDK + c0;
#pragma unroll
                for (int bj = 0; bj < 2; ++bj) *(u32x4*)(rowp + bj * HALF) = pack8(acc[ai][bj][m][0], acc[ai][bj][m][1]); }
    }
};
struct EpiRetO {
    static constexpr bool PERM = true;
    bf16_t* ORET;
    __device__ __forceinline__ void operator()(const f32x4 (&acc)[2][2][4][2], const Unit& u, int wr, int wc, int fr, int fq) const {
        const int r0 = wr * 64 + fr, c0 = wc * 32 + 8 * fq; const int n = u.pm & 7, h = (u.pm >> 3) & 3, b = u.pm >> 5;
#pragma unroll
        for (int ai = 0; ai < 2; ++ai)
#pragma unroll
            for (int m = 0; m < 4; ++m) { bf16_t* rowp = ORET + ((size_t)(b * SEQ + n * RC + r0 + ai * HALF + m * 16)) * 2048 + h * RDV + u.pn * BM + c0;
#pragma unroll
                for (int bj = 0; bj < 2; ++bj) *(u32x4*)(rowp + bj * HALF) = pack8(acc[ai][bj][m][0], acc[ai][bj][m][1]); }
    }
};
struct ScoresOrder {
    int G, c;
    __device__ bool next(int i, Unit& u) const { const int L = i * G + c; if (L >= NB * RH * RNC) return false; const int n = L & 7, h = (L >> 3) & 3, b = L >> 5;
        u.pm = L; u.pn = 0; u.aux = 0; u.aoff = (long)L * RC * 512 + 256; u.boff = (long)(b * SEQ + n * RC) * 1024 + h * RDK; return true; }
};
struct DsOrder {
    int G, c;
    __device__ bool next(int i, Unit& u) const { const int L = i * G + c; if (L >= NB * RH * 7 * 2) return false; const int dvt = L & 1, q = L >> 1, n = q % 7, bh = q / 7, p = bh * RNC + n;
        u.pm = p; u.pn = dvt; u.aux = 0; u.aoff = ((long)p * RDV + dvt * BM) * 512; u.boff = (long)bh * RDK * SEQ + n * RC; return true; }
};
struct RetOOrder {
    int G, c;
    __device__ bool next(int i, Unit& u) const { const int L = i * G + c; if (L >= NB * RH * RNC * 2) return false; const int dvt = L & 1, p = L >> 1;
        u.pm = p; u.pn = dvt; u.aux = 0; u.aoff = (long)p * RC * 512; u.boff = ((long)p * RDV + dvt * BM) * 512; return true; }
};
struct MoeOrder {
    int G, c, ldb; long a_tile; const LAS int* tstart; const LAS int* texp;
    __device__ bool next(int i, Unit& u) const { const int L = i * G + c; const int ntiles = tstart[33]; if (L >= ntiles * 4) return false; const int rt = L >> 2, pnl = L & 3, e = texp[rt];
        u.pm = rt; u.pn = e * 4 + pnl; u.aux = rt - tstart[e]; u.aoff = (long)rt * a_tile; u.boff = ((long)e * 1024 + pnl * BM) * ldb; return true; }
};
}
namespace attn_body {
using bf16=__hip_bfloat16;
using bf16x8=__attribute__((ext_vector_type(8)))short;
using s16x4=__attribute__((ext_vector_type(4)))short;
using f32x16=__attribute__((ext_vector_type(16)))float;
using u32x4=__attribute__((ext_vector_type(4)))unsigned;
constexpr int D=64,PQ=3072,PO=1024;
constexpr int NW=8,QBLK=32,QB=QBLK*NW,KVBLK=64,NQB=SEQ/QB;
__device__ __forceinline__ int crow(int r,int hi){return (r&3)+8*(r>>2)+4*hi;}
#define SBAR() __builtin_amdgcn_sched_barrier(0)
__device__ __forceinline__ void biasmask(f32x16&p0,f32x16&p1,int jb6,int qrel,int hi,const LAS float*lut){
  const float NEG=-INFINITY; const int base=128+qrel-64*jb6-4*hi;
  #pragma unroll
  for(int g=0;g<4;++g){
    #pragma unroll
    for(int q=0;q<4;++q){const int r=4*g+q; const int rel=base-(q+8*g); const int rel1=rel-32;
      const float b0=lut[rel<0?0:(rel>128?128:rel)], b1=lut[rel1<0?0:(rel1>128?128:rel1)];
      p0[r]=(rel<0)?NEG:p0[r]+b0; p1[r]=(rel1<0)?NEG:p1[r]+b1;}
    asm volatile("":"+v"(p0),"+v"(p1)); __builtin_amdgcn_sched_barrier(0);}
}
constexpr int NSLOT=3, SLOTB=8192;
constexpr int LDS_K=0, LDS_V=NSLOT*SLOTB, LDS_WS=2*NSLOT*SLOTB, LDS_OST=LDS_WS+NW*64*4, LDS_BYTES=LDS_OST+NW*4096;
__device__ __forceinline__ void glds16(const void*gsrc,unsigned lds_dst){unsigned keep;
  asm volatile("s_mov_b32 %0, m0\n\ts_mov_b32 m0, %2\n\ts_nop 0\n\tglobal_load_lds_dwordx4 %1, off\n\ts_mov_b32 m0, %0":"=&s"(keep):"v"(gsrc),"s"(lds_dst):"memory");}
__device__ __forceinline__ float max3f(float a,float b,float c){float r;asm("v_max3_f32 %0, %1, %2, %3":"=v"(r):"v"(a),"v"(b),"v"(c));return r;}
__device__ __forceinline__ float max2f(float a,float b){float r;asm("v_max_f32_e32 %0, %1, %2":"=v"(r):"v"(a),"v"(b));return r;}
__device__ __forceinline__ float fadd_s(float a,float b){float r;asm("v_add_f32_e32 %0, %1, %2":"=v"(r):"v"(a),"v"(b));return r;}
__device__ __forceinline__ float fsub_s(float a,float b){float r;asm("v_sub_f32_e32 %0, %1, %2":"=v"(r):"v"(a),"v"(b));return r;}
typedef float f32x2_t __attribute__((ext_vector_type(2))); typedef __bf16 bf16x2_t __attribute__((ext_vector_type(2)));
__device__ __forceinline__ unsigned cvtpk_s(float lo,float hi){f32x2_t v={lo,hi};bf16x2_t b=__builtin_convertvector(v,bf16x2_t);return __builtin_bit_cast(unsigned,b);}
#define WAIT_BAR(N) asm volatile("s_waitcnt vmcnt(" #N ") lgkmcnt(0)\n\ts_barrier":::"memory")

__device__ __forceinline__ void qkt(f32x16&p0,f32x16&p1,const char*Kslot,const bf16x8*qr,const f32x16&negm,int r32,int hi){
  const char*kb=Kslot+hi*1024+r32*16;
  #pragma unroll
  for(int d0=0;d0<4;++d0){
    const bf16x8 b0=*reinterpret_cast<const bf16x8*>(kb+d0*2048);
    const bf16x8 b1=*reinterpret_cast<const bf16x8*>(kb+d0*2048+512);
    if(d0==0){p0=__builtin_amdgcn_mfma_f32_32x32x16_bf16(b0,qr[0],negm,0,0,0);p1=__builtin_amdgcn_mfma_f32_32x32x16_bf16(b1,qr[0],negm,0,0,0);}
    else{p0=__builtin_amdgcn_mfma_f32_32x32x16_bf16(b0,qr[d0],p0,0,0,0);p1=__builtin_amdgcn_mfma_f32_32x32x16_bf16(b1,qr[d0],p1,0,0,0);}}
}
typedef LAS const char* lds_cptr;
typedef short v4i16_t __attribute__((ext_vector_type(4)));
__device__ __forceinline__ void kload8(bf16x8*kf,lds_cptr kp){
  kf[0]=*(const LAS bf16x8*)(kp);      kf[1]=*(const LAS bf16x8*)(kp+512);
  kf[2]=*(const LAS bf16x8*)(kp+2048); kf[3]=*(const LAS bf16x8*)(kp+2560);
  kf[4]=*(const LAS bf16x8*)(kp+4096); kf[5]=*(const LAS bf16x8*)(kp+4608);
  kf[6]=*(const LAS bf16x8*)(kp+6144); kf[7]=*(const LAS bf16x8*)(kp+6656);
}
__device__ __forceinline__ void kload2(bf16x8*kf,lds_cptr kp,int j){ kf[2*j]=*(const LAS bf16x8*)(kp+j*2048); kf[2*j+1]=*(const LAS bf16x8*)(kp+j*2048+512); }
__device__ __forceinline__ s16x4 vtr(lds_cptr p){ return __builtin_bit_cast(s16x4,__builtin_amdgcn_ds_read_tr16_b64_v4i16((LAS v4i16_t*)p)); }
__device__ __forceinline__ float rowmax(const f32x16&p0,const f32x16&p1){
  float a=max3f(p0[0],p0[1],p1[0]),b=max3f(p0[2],p0[3],p1[1]);a=max3f(a,p1[2],p1[3]);
  #pragma unroll
  for(int r=4;r<16;r+=4){a=max3f(a,p0[r],p0[r+1]);b=max3f(b,p0[r+2],p0[r+3]);a=max3f(a,p1[r],p1[r+1]);b=max3f(b,p1[r+2],p1[r+3]);}
  const float m=max2f(a,b);
  auto rr=__builtin_amdgcn_permlane32_swap(__float_as_uint(m),__float_as_uint(m),false,false);
  return max2f(__uint_as_float(rr[0]),__uint_as_float(rr[1]));
}
__device__ __forceinline__ void pv(f32x16*o,int vb,bf16x8 pa0,bf16x8 pa1,bf16x8 pa2,bf16x8 pa3){
  #pragma unroll
  for(int d0=0;d0<2;++d0){s16x4 lo[4],hi[4];
    #pragma unroll
    for(int ks=0;ks<4;++ks){
      asm volatile("ds_read_b64_tr_b16 %0,%1 offset:%c2":"=&v"(lo[ks]):"v"(vb),"i"(d0*4096+ks*1024):"memory");
      asm volatile("ds_read_b64_tr_b16 %0,%1 offset:%c2":"=&v"(hi[ks]):"v"(vb),"i"(d0*4096+ks*1024+512):"memory");}
    asm volatile("s_waitcnt lgkmcnt(0)":::"memory");SBAR();
    #define PK(k) (bf16x8){lo[k][0],lo[k][1],lo[k][2],lo[k][3],hi[k][0],hi[k][1],hi[k][2],hi[k][3]}
    o[d0]=__builtin_amdgcn_mfma_f32_32x32x16_bf16(pa0,PK(0),o[d0],0,0,0);
    o[d0]=__builtin_amdgcn_mfma_f32_32x32x16_bf16(pa1,PK(1),o[d0],0,0,0);
    o[d0]=__builtin_amdgcn_mfma_f32_32x32x16_bf16(pa2,PK(2),o[d0],0,0,0);
    o[d0]=__builtin_amdgcn_mfma_f32_32x32x16_bf16(pa3,PK(3),o[d0],0,0,0);
    #undef PK
  }
}
template<int THRL> __device__ __forceinline__ void attn_unit(int b,int qb,const bf16*QKV,int Qc,int Kc,int Vc,bf16*O,const LAS float*lut,char*shm){
  int tid_=threadIdx.x; asm volatile("":"+v"(tid_)); const int tid=tid_,lane=tid&63,r32=lane&31,hi=lane>>5; const int wid=__builtin_amdgcn_readfirstlane(tid>>6);
  const long rowbase=(long)b*SEQ; const int q0=qb*QB;
  const bf16*Qw=QKV+(rowbase+q0+wid*QBLK)*PQ+Qc;
  const bf16*Kh=QKV+rowbase*PQ+Kc,*Vh=QKV+rowbase*PQ+Vc;
  const unsigned lds0=(unsigned)(uintptr_t)shm;
  float*wsf=(float*)(shm+LDS_WS)+wid*64;
  const bf16*ksrc=Kh+(long)lane*PQ+wid*8;
  const bf16*vsrc=Vh+(long)(16*(wid&3)+(lane>>2))*PQ+(wid>>2)*32+(lane&3)*8;
  const unsigned kdst=lds0+LDS_K+wid*1024, vdst=lds0+LDS_V+wid*1024;
  #define DMA_K(t,slot) glds16(ksrc+(long)(t)*KVBLK*PQ,(unsigned)__builtin_amdgcn_readfirstlane(kdst+(slot)))
  #define DMA_V(t,slot) glds16(vsrc+(long)(t)*KVBLK*PQ,(unsigned)__builtin_amdgcn_readfirstlane(vdst+(slot)))
  const int vb0=(int)(lds0+LDS_V)+((lane>>4)&1)*32+(lane&3)*8+(4*hi+((lane&15)>>2))*64;
  const char*Kbase=shm+LDS_K; bf16x8 kf[8];
  const lds_cptr shm3=(lds_cptr)shm; const lds_cptr kp0=shm3+LDS_K+hi*1024+r32*16; const lds_cptr vp0=shm3+LDS_V+((lane>>4)&1)*32+(lane&3)*8+(4*hi+((lane&15)>>2))*64;
  const int NT=(q0+QB)/KVBLK;
  DMA_K(0,0);DMA_V(0,0);DMA_K(1,SLOTB);
  bf16x8 qr[4];
  #pragma unroll
  for(int d0=0;d0<4;++d0)qr[d0]=*reinterpret_cast<const bf16x8*>(&Qw[(long)r32*PQ+d0*16+hi*8]);
  float mhat=0.f,l_reg=0.f;f32x16 o[2];f32x16 negm; { float zz; asm volatile("v_mov_b32 %0, 0":"=v"(zz)); _Pragma("unroll") for(int r=0;r<16;++r){o[0][r]=zz;o[1][r]=zz;negm[r]=zz;} } asm volatile("":"+v"(negm));
  const int qrel=wid*QBLK+r32;
  #define CMASK(P0,P1,t) do{int jb_=(t)-(NT-6); if(jb_>=0)biasmask(P0,P1,jb_,qrel,hi,lut);}while(0)
  bool resc=false;
  #define START(P0,P1) do{ const float rm=rowmax(P0,P1); resc=false; \
    { const float dl=rm; mhat=fadd_s(mhat,dl); \
      _Pragma("unroll") for(int r=0;r<16;++r){P0[r]=fsub_s(P0[r],dl);P1[r]=fsub_s(P1[r],dl);} \
      _Pragma("unroll") for(int r=0;r<16;++r)negm[r]=-mhat; asm volatile("":"+v"(negm)); } \
    _Pragma("unroll") for(int r=0;r<16;++r)P0[r]=__builtin_amdgcn_exp2f(P0[r]); }while(0)
  #define RESC() do{ if(resc){ asm volatile("s_waitcnt lgkmcnt(0)":::"memory"); \
      _Pragma("unroll") for(int d_=0;d_<2;++d_) _Pragma("unroll") for(int r=0;r<16;++r)o[d_][r]*=wsf[crow(r,hi)]; } }while(0)
  f32x16 pA0,pA1,pB0,pB1;
  int sl_prev=0,sl_cur=0,sl_next=SLOTB;
  #define ROT() do{sl_prev=sl_cur;sl_cur=sl_next;sl_next=(sl_next==(NSLOT-1)*SLOTB)?0:sl_next+SLOTB;}while(0)
  DMA_K(2,2*SLOTB);
  WAIT_BAR(3);
  qkt(pA0,pA1,Kbase,qr,negm,r32,hi);asm volatile("s_nop 15\n\ts_nop 7":"+v"(pA0),"+v"(pA1));CMASK(pA0,pA1,0);
  START(pA0,pA1);
  _Pragma("unroll") for(int r=0;r<16;++r)pA1[r]=__builtin_amdgcn_exp2f(pA1[r]);
  WAIT_BAR(0);
  DMA_K(3,0);DMA_V(1,SLOTB);
  ROT();
  kload8(kf,kp0+sl_cur);
  WAIT_BAR(2);
  s16x4 vlo[8],vhi[8]; u32x4 pw0,pw1,pw2,pw3;
  #define PKW(P,B) cvtpk_s(P[B],P[B+1])
  #define PAF(k) __builtin_bit_cast(bf16x8,pw##k)
  #define VFR(i) (bf16x8){vlo[i][0],vlo[i][1],vlo[i][2],vlo[i][3],vhi[i][0],vhi[i][1],vhi[i][2],vhi[i][3]}
  #define PIN(x) asm volatile("":"+v"(x))
  #define MX3(a,b,c) __builtin_fmaxf(__builtin_fmaxf((a),(b)),(c))
  #define GAPA(MF,A0,A1,A2,A3,W0,W1,PW) do{ MF; sacc+=A0; sacc+=A1; sacc+=A2; sacc+=A3; PIN(sacc); W0; W1; PIN(PW); SBAR(); }while(0)
  #define EX(v) __builtin_amdgcn_exp2f(v)
  #define GAPB(MF,X,B) do{ MF; X[B]=EX(X[B]); X[B+1]=EX(X[B+1]); X[B+2]=EX(X[B+2]); X[B+3]=EX(X[B+3]); PIN(X); SBAR(); }while(0)
  #define VRD(i) do{ vlo[i]=vtr(vp_+(((i)>>2)*4096+((i)&3)*1024)); vhi[i]=vtr(vp_+(((i)>>2)*4096+((i)&3)*1024+512)); }while(0)
  #define KRD(G,j) do{ if(G){ kload2(kf,kp0+sl_next,j); SBAR(); } }while(0)
  #define STEP(C0,C1,P0,P1,t,GK,GV,GL) do{ SBAR(); \
    const lds_cptr vp_=vp0+sl_prev; \
    VRD(0); SBAR(); float sacc=(P0[0]+P0[1]); \
    GAPA(C0=__builtin_amdgcn_mfma_f32_32x32x16_bf16(kf[0],qr[0],negm,0,0,0), P0[2],P0[3],P0[4],P0[5],     pw0[0]=PKW(P0,0), pw0[1]=PKW(P0,2), pw0); \
    VRD(4); SBAR(); GAPA(C1=__builtin_amdgcn_mfma_f32_32x32x16_bf16(kf[1],qr[0],negm,0,0,0), P0[6],P0[7],P0[8],P0[9],     pw0[2]=PKW(P0,4), pw0[3]=PKW(P0,6), pw0); \
    VRD(1); SBAR(); GAPA(C0=__builtin_amdgcn_mfma_f32_32x32x16_bf16(kf[2],qr[1],C0,0,0,0),   P0[10],P0[11],P0[12],P0[13], pw1[0]=PKW(P0,8), pw1[1]=PKW(P0,10), pw1); \
    VRD(5); SBAR(); GAPA(C1=__builtin_amdgcn_mfma_f32_32x32x16_bf16(kf[3],qr[1],C1,0,0,0),   P0[14],P0[15],P1[0],P1[1],   pw1[2]=PKW(P0,12),pw1[3]=PKW(P0,14), pw1); \
    VRD(2); SBAR(); GAPA(C0=__builtin_amdgcn_mfma_f32_32x32x16_bf16(kf[4],qr[2],C0,0,0,0),   P1[2],P1[3],P1[4],P1[5],     pw2[0]=PKW(P1,0), pw2[1]=PKW(P1,2), pw2); \
    VRD(6); SBAR(); GAPA(C1=__builtin_amdgcn_mfma_f32_32x32x16_bf16(kf[5],qr[2],C1,0,0,0),   P1[6],P1[7],P1[8],P1[9],     pw2[2]=PKW(P1,4), pw2[3]=PKW(P1,6), pw2); \
    VRD(3); SBAR(); GAPA(C0=__builtin_amdgcn_mfma_f32_32x32x16_bf16(kf[6],qr[3],C0,0,0,0),   P1[10],P1[11],P1[12],P1[13], pw3[0]=PKW(P1,8), pw3[1]=PKW(P1,10), pw3); \
    VRD(7); SBAR(); GAPA(C1=__builtin_amdgcn_mfma_f32_32x32x16_bf16(kf[7],qr[3],C1,0,0,0),   P1[14],P1[15],0.f,0.f,       pw3[2]=PKW(P1,12),pw3[3]=PKW(P1,14), pw3); \
    l_reg+=sacc; \
    if(GK){DMA_K((t)+3,sl_cur);} if(GV){DMA_V((t)+1,sl_next);} \
    CMASK(C0,C1,t); \
    { float a=MX3(C0[0],C0[1],C1[0]),b=MX3(C0[2],C0[3],C1[1]); a=MX3(a,C1[2],C1[3]); \
      _Pragma("unroll") for(int r=4;r<16;r+=4){a=MX3(a,C0[r],C0[r+1]);b=MX3(b,C0[r+2],C0[r+3]);a=MX3(a,C1[r],C1[r+1]);b=MX3(b,C1[r+2],C1[r+3]);} \
      float rm=__builtin_fmaxf(a,b); { auto rr=__builtin_amdgcn_permlane32_swap(__float_as_uint(rm),__float_as_uint(rm),false,false); rm=__builtin_fmaxf(__uint_as_float(rr[0]),__uint_as_float(rr[1])); } \
      resc=false; \
      if(__builtin_expect(__any(rm>(float)THRL),0)){ const float dl=__builtin_fmaxf(rm,0.f); mhat+=dl; \
        _Pragma("unroll") for(int r=0;r<16;++r){C0[r]-=dl;C1[r]-=dl;} \
        _Pragma("unroll") for(int r=0;r<16;++r)negm[r]=-mhat; asm volatile("":"+v"(negm)); \
        const float f=__builtin_amdgcn_exp2f(-dl); l_reg*=f; if(hi==0)wsf[r32]=f; resc=true; } } \
    SBAR(); \
    GAPB(o[0]=__builtin_amdgcn_mfma_f32_32x32x16_bf16(PAF(0),VFR(0),o[0],0,0,0), C0,0); \
    GAPB(o[1]=__builtin_amdgcn_mfma_f32_32x32x16_bf16(PAF(0),VFR(4),o[1],0,0,0), C0,4); \
    KRD(GL,0); GAPB(o[0]=__builtin_amdgcn_mfma_f32_32x32x16_bf16(PAF(1),VFR(1),o[0],0,0,0), C0,8); \
    KRD(GL,1); GAPB(o[1]=__builtin_amdgcn_mfma_f32_32x32x16_bf16(PAF(1),VFR(5),o[1],0,0,0), C0,12); \
    KRD(GL,2); GAPB(o[0]=__builtin_amdgcn_mfma_f32_32x32x16_bf16(PAF(2),VFR(2),o[0],0,0,0), C1,0); \
    KRD(GL,3); GAPB(o[1]=__builtin_amdgcn_mfma_f32_32x32x16_bf16(PAF(2),VFR(6),o[1],0,0,0), C1,4); \
    GAPB(o[0]=__builtin_amdgcn_mfma_f32_32x32x16_bf16(PAF(3),VFR(3),o[0],0,0,0), C1,8); \
    GAPB(o[1]=__builtin_amdgcn_mfma_f32_32x32x16_bf16(PAF(3),VFR(7),o[1],0,0,0), C1,12); \
    }while(0)
  int t=1;
  #undef CMASK
  #define CMASK(P0,P1,t) do{}while(0)
  for(;t+7<NT;t+=2){
    STEP(pB0,pB1,pA0,pA1,t,true,true,true);     WAIT_BAR(2); RESC(); ROT();
    STEP(pA0,pA1,pB0,pB1,t+1,true,true,true);   WAIT_BAR(2); RESC(); ROT();
  }
  #undef CMASK
  #define CMASK(P0,P1,t) do{int jb_=(t)-(NT-6); if(jb_>=0)biasmask(P0,P1,jb_,qrel,hi,lut);}while(0)
  #define ENDW(tt) do{ if((tt)+3<NT){WAIT_BAR(2);} else if((tt)+2<NT){WAIT_BAR(1);} else {WAIT_BAR(0);} }while(0)
  for(;t+1<NT;t+=2){
    STEP(pB0,pB1,pA0,pA1,t,(t+3<NT),(t+1<NT),(t+1<NT));       ENDW(t);   RESC(); ROT();
    STEP(pA0,pA1,pB0,pB1,t+1,(t+4<NT),(t+2<NT),(t+2<NT));     ENDW(t+1); RESC(); ROT();
  }
  STEP(pB0,pB1,pA0,pA1,NT-1,false,false,false); RESC();
  { float sacc=pB0[0]+pB0[1]; _Pragma("unroll") for(int r=2;r<16;++r)sacc+=pB0[r]; _Pragma("unroll") for(int r=0;r<16;++r)sacc+=pB1[r]; l_reg+=sacc;
    pw0=(u32x4){PKW(pB0,0),PKW(pB0,2),PKW(pB0,4),PKW(pB0,6)};pw1=(u32x4){PKW(pB0,8),PKW(pB0,10),PKW(pB0,12),PKW(pB0,14)};pw2=(u32x4){PKW(pB1,0),PKW(pB1,2),PKW(pB1,4),PKW(pB1,6)};pw3=(u32x4){PKW(pB1,8),PKW(pB1,10),PKW(pB1,12),PKW(pB1,14)};
    SBAR(); pv(o,vb0+sl_cur,PAF(0),PAF(1),PAF(2),PAF(3)); }
  #undef PKW
  #undef PAF
  #undef VFR
  #undef PIN
  #undef MX3
  #undef GAPA
  #undef GAPB
  #undef EX
  #undef VRD
  #undef KRD
  #undef STEP
  #undef ENDW
  {auto rr=__builtin_amdgcn_permlane32_swap(__float_as_uint(l_reg),__float_as_uint(l_reg),false,false);l_reg=__uint_as_float(rr[0])+__uint_as_float(rr[1]);}
  if(hi==0)wsf[32+r32]=l_reg;asm volatile("s_waitcnt lgkmcnt(0)":::"memory");
  float rli[16];
  #pragma unroll
  for(int r=0;r<16;++r)rli[r]=__builtin_amdgcn_rcpf(wsf[32+crow(r,hi)]);
  bf16*Ow=O+(rowbase+q0+wid*QBLK)*PO;
  { bf16*stg=(bf16*)(shm+LDS_OST)+wid*2048;
    #pragma unroll
    for(int r=0;r<16;++r){const int orow=crow(r,hi);
      #pragma unroll
      for(int d0=0;d0<2;++d0)stg[orow*64+d0*32+r32]=__float2bfloat16(o[d0][r]*rli[r]);}
    asm volatile("s_waitcnt lgkmcnt(0)":::"memory");
    #pragma unroll
    for(int i=0;i<4;++i){const int row=i*8+(lane>>3),ch=lane&7; const u32x4 v=*(const u32x4*)(stg+row*64+ch*8); *(u32x4*)(Ow+(long)row*PO+ch*8)=v;} }
  asm volatile("s_waitcnt lgkmcnt(0)\n\ts_barrier":::"memory");
  #undef DMA_K
  #undef DMA_V
  #undef CMASK
  #undef START
  #undef RESC
  #undef ROT
}
constexpr int ATTN_LDS_BYTES=LDS_BYTES;
#undef SBAR
#undef WAIT_BAR
}
constexpr int NWAVES = 8;
typedef unsigned short bf16;
typedef unsigned v4u __attribute__((ext_vector_type(4)));
typedef unsigned v2u __attribute__((ext_vector_type(2)));
typedef float f32x4 __attribute__((ext_vector_type(4)));
typedef float f32x2 __attribute__((ext_vector_type(2)));
typedef short bf16x8 __attribute__((ext_vector_type(8)));
typedef GAS unsigned gu32;
#define RLX_AGENT __ATOMIC_RELAXED, __HIP_MEMORY_SCOPE_AGENT
#define LDS_WAIT() asm volatile("s_waitcnt lgkmcnt(0)" ::: "memory")
#define VM_WAIT() asm volatile("s_waitcnt vmcnt(0)" ::: "memory")
__device__ __forceinline__ unsigned f2bf(float f) { unsigned u = __builtin_bit_cast(unsigned, f); return (u + 0x7fffu + ((u >> 16) & 1u)) >> 16; }
__device__ __forceinline__ unsigned pk2(float lo, float hi) { return f2bf(lo) | (f2bf(hi) << 16); }
__device__ __forceinline__ float bf2f(unsigned short b) { return __builtin_bit_cast(float, (unsigned)b << 16); }
__device__ __forceinline__ float bflo(unsigned w) { return __builtin_bit_cast(float, w << 16); }
__device__ __forceinline__ float bfhi(unsigned w) { return __builtin_bit_cast(float, w & 0xffff0000u); }

#define XB_TMO      128
#define XB_XCNT(j)  (256  + 64 * (j))
#define XB_XSUB(j)  (1280 + 64 * (j))
#define XB_XGEN(j)  (2304 + 64 * (j))
#define XB_TOP      3328
#define XB_TOPGEN   3392
#define XCD_BAR_WORDS 3456
#define XB_SPIN_CAP (1u << 18)
__device__ __forceinline__ unsigned xb_ld(unsigned* p)              { return __hip_atomic_load(p, __ATOMIC_RELAXED, __HIP_MEMORY_SCOPE_AGENT); }
__device__ __forceinline__ unsigned xb_add(unsigned* p, unsigned v) { return __hip_atomic_fetch_add(p, v, __ATOMIC_RELAXED, __HIP_MEMORY_SCOPE_AGENT); }
__device__ __forceinline__ unsigned xb_xcc_id() { return (unsigned)__builtin_amdgcn_s_getreg((3 << 11) | 20) & 0xFu; }
#define XB_SPIN(cond, bar) do { unsigned _sp = 0; while (cond) { __builtin_amdgcn_s_sleep(1); \
    if ((++_sp & 255u) == 0u) { if (xb_ld(&(bar)[XB_TMO])) break; if (_sp > XB_SPIN_CAP) { atomicAdd(&(bar)[XB_TMO], 1u); break; } } } } while (0)
struct XcdBarrier { unsigned* bar; unsigned x; volatile LAS unsigned* st; };
__device__ __forceinline__ XcdBarrier xcd_barrier_post(unsigned* bar, volatile LAS unsigned* st) {
    XcdBarrier b; b.bar = bar; b.x = xb_xcc_id(); b.st = st;
    if (threadIdx.x == 0) (void)xb_add(&bar[XB_XCNT(b.x)], 1u);
    return b;
}
__device__ __forceinline__ void xcd_barrier_complete(unsigned* bar, unsigned x, unsigned& nloc, unsigned& nx) {
    const unsigned G = gridDim.x * gridDim.y * gridDim.z;
    unsigned sum, cnt, mine, sp = 0u;
    for (;;) {
        sum = 0u; cnt = 0u; mine = 0u;
#pragma unroll
        for (unsigned j = 0; j < 16; ++j) { const unsigned c = xb_ld(&bar[XB_XCNT(j)]); sum += c; cnt += (c > 0u) ? 1u : 0u; mine = (j == x) ? c : mine; }
        if (sum == G) break;
        __builtin_amdgcn_s_sleep(1);
        if ((++sp & 255u) == 0u) { if (xb_ld(&bar[XB_TMO])) break; if (sp > XB_SPIN_CAP) { atomicAdd(&bar[XB_TMO], 1u); break; } }
    }
    nloc = mine > 0u ? mine : 1u; nx = cnt > 0u ? cnt : 1u;
}
__device__ __forceinline__ void xcd_barrier(const XcdBarrier& b) {
    asm volatile("s_waitcnt vmcnt(0)" ::: "memory");
    __syncthreads();
    if (threadIdx.x == 0) {
        unsigned* bar = b.bar;
        __builtin_amdgcn_s_waitcnt(0);
        unsigned nloc = b.st[0], nx = b.st[1];
        if (nloc == 0u) { xcd_barrier_complete(bar, b.x, nloc, nx); b.st[0] = nloc; b.st[1] = nx; }
        const unsigned old = xb_add(&bar[XB_XSUB(b.x)], 1u);
        const unsigned gen = old / nloc;
        if (old + 1u == (gen + 1u) * nloc) {
            __builtin_amdgcn_fence(__ATOMIC_RELEASE, "agent");
            asm volatile("s_waitcnt vmcnt(0)" ::: "memory");
            const unsigned og = xb_add(&bar[XB_TOP], 1u);
            const unsigned tg = og / nx;
            if (og + 1u == (tg + 1u) * nx) xb_add(&bar[XB_TOPGEN], 1u);
            else XB_SPIN(xb_ld(&bar[XB_TOPGEN]) == tg, bar);
            __builtin_amdgcn_fence(__ATOMIC_ACQUIRE, "agent");
            xb_add(&bar[XB_XGEN(b.x)], 1u);
            asm volatile("s_waitcnt vmcnt(0)" ::: "memory");
        } else {
            XB_SPIN(xb_ld(&bar[XB_XGEN(b.x)]) == gen, bar);
            __builtin_amdgcn_fence(__ATOMIC_ACQUIRE, "agent");
            asm volatile("s_waitcnt vmcnt(0)" ::: "memory");
        }
    }
    __syncthreads();
}

struct Args { const float* in[18]; float* out; unsigned char* ws; int ph_lo, ph_hi, li, pad; };
struct Frame {
    LAS unsigned char* lds;
    gu32* ctl;
    unsigned char* ws;
    int tid, lane, wave;
    int vcu, G;
};

__device__ __forceinline__ float wave_sum(float v) {
#pragma unroll
    for (int o = 1; o < 64; o <<= 1) v += __shfl_xor(v, o);
    return v;
}
__device__ __forceinline__ void transpose_block(const float* src, int ld_src, bf16* dst, int ld_dst, LAS float* scr, int lane, bf16* dst2) {
#pragma unroll 8
    for (int i = 0; i < 32; ++i) { const int kk = 2 * i + (lane >> 5); scr[kk * 33 + (lane & 31)] = src[(size_t)kk * ld_src + (lane & 31)]; }
    LDS_WAIT(); asm volatile("" ::: "memory");
    const int c = lane & 7;
#pragma unroll
    for (int j = 0; j < 4; ++j) { const int n = (lane >> 3) + 8 * j; const LAS float* s = scr + (8 * c) * 33 + n;
        v4u o; o.x = pk2(s[0 * 33], s[1 * 33]); o.y = pk2(s[2 * 33], s[3 * 33]); o.z = pk2(s[4 * 33], s[5 * 33]); o.w = pk2(s[6 * 33], s[7 * 33]);
        *(GAS v4u*)(dst + (size_t)n * ld_dst + 8 * c) = o;
        if (dst2) *(GAS v4u*)(dst2 + (size_t)n * ld_dst + 8 * c) = o; }
    LDS_WAIT(); asm volatile("" ::: "memory");
}
__device__ __forceinline__ void rms_row_to_bf16(int lane, const float* xrow, const float* g, bf16* orow) {
    const GAS f32x4* xr = (const GAS f32x4*)xrow + lane; const GAS f32x4* gr = (const GAS f32x4*)g + lane;
    f32x4 v[4]; float s = 0.f;
#pragma unroll
    for (int j = 0; j < 4; ++j) { v[j] = xr[64 * j]; s += (v[j].x * v[j].x + v[j].y * v[j].y) + (v[j].z * v[j].z + v[j].w * v[j].w); }
    const float rstd = 1.0f / sqrtf(wave_sum(s) * (1.f / 1024.f) + RMS_EPS);
    GAS v2u* o8 = (GAS v2u*)orow + lane;
#pragma unroll
    for (int j = 0; j < 4; ++j) { const f32x4 gg = gr[64 * j]; v2u o; o.x = pk2(v[j].x * rstd * gg.x, v[j].y * rstd * gg.y); o.y = pk2(v[j].z * rstd * gg.z, v[j].w * rstd * gg.w); o8[64 * j] = o; }
}

constexpr int IT_WIN0 = (1024 / 64) * (3072 / 32);
constexpr int IT_WOUT0 = (1024 / 64) * (1024 / 32);
constexpr int IT_RIN = (1024 / 64) * (6144 / 32);
constexpr int IT_ROUT = (2048 / 64) * (1024 / 32);
constexpr int IT_SHARED = IT_WIN0 + IT_WOUT0 + IT_RIN + IT_ROUT;
constexpr int IT_EXP = 3 * 256;
constexpr int IT_MOE = NEXP * IT_EXP;
__device__ __forceinline__ void conv_shared_item(Frame& F, const Args& a, int it, LAS float* scr) {
    unsigned char* ws = F.ws;
    if (it < IT_WIN0) { const int nblk = 96, kb = it / nblk, nb = it % nblk;
        transpose_block(a.in[5] + (size_t)(64 * kb) * 3072 + 32 * nb, 3072, (bf16*)(ws + WS_WINT0) + (size_t)(32 * nb) * 1024 + 64 * kb, 1024, scr, F.lane, nullptr); return; }
    it -= IT_WIN0;
    if (it < IT_WOUT0) { const int nblk = 32, kb = it / nblk, nb = it % nblk;
        transpose_block(a.in[8] + (size_t)(64 * kb) * 1024 + 32 * nb, 1024, (bf16*)(ws + WS_WOUTT0) + (size_t)(32 * nb) * 1024 + 64 * kb, 1024, scr, F.lane, nullptr); return; }
    it -= IT_WOUT0;
    if (it < IT_RIN) { const int nblk = 192, kb = it / nblk, nb = it % nblk, n0 = 32 * nb;
        bf16* A = (bf16*)(ws + WS_WRINA); bf16* B = (bf16*)(ws + WS_WRINB); bf16 *d1, *d2 = nullptr;
        if (n0 < 1024) d1 = A + (size_t)n0 * 1024;
        else if (n0 < 2048) { d1 = A + (size_t)n0 * 1024; d2 = B + (size_t)(n0 - 1024) * 1024; }
        else if (n0 < 4096) d1 = B + (size_t)(n0 - 1024) * 1024;
        else d1 = A + (size_t)(n0 - 2048) * 1024;
        transpose_block(a.in[9] + (size_t)(64 * kb) * 6144 + n0, 6144, d1 + 64 * kb, 1024, scr, F.lane, d2 ? d2 + 64 * kb : nullptr); return; }
    it -= IT_RIN;
    { const int nblk = 32, kb = it / nblk, nb = it % nblk;
        transpose_block(a.in[10] + (size_t)(64 * kb) * 1024 + 32 * nb, 1024, (bf16*)(ws + WS_WROUTT) + (size_t)(32 * nb) * 2048 + 64 * kb, 2048, scr, F.lane, nullptr); }
}
__device__ __forceinline__ void conv_moe_item(Frame& F, const Args& a, int layer, int it, LAS float* scr) {
    unsigned char* ws = F.ws;
    const int e = it / IT_EXP; int r = it % IT_EXP; const size_t le = (size_t)layer * NEXP + e;
    if (r < 512) { const int up = r >> 8; r &= 255; const int kb = r / 16, nb = r % 16, n0 = 32 * nb;
        const float* src = a.in[up ? 16 : 15] + le * (1024 * 512) + (size_t)(64 * kb) * 512 + n0;
        const int drow = 256 * (n0 >> 7) + 128 * up + (n0 & 127);
        transpose_block(src, 512, (bf16*)(ws + WS_W1CAT) + ((size_t)e * 1024 + drow) * 1024 + 64 * kb, 1024, scr, F.lane, nullptr); return; }
    r -= 512; { const int kb = r / 32, nb = r % 32;
        const float* src = a.in[17] + le * (512 * 1024) + (size_t)(64 * kb) * 1024 + 32 * nb;
        transpose_block(src, 1024, (bf16*)(ws + WS_W2T) + ((size_t)e * 1024 + 32 * nb) * 512 + 64 * kb, 512, scr, F.lane, nullptr); }
}
__device__ __forceinline__ void build_router_frags(Frame& F, const Args& a, int gtid, int gthreads) {
    bf16* wrf = (bf16*)(F.ws + WS_WRF);
    for (int idx = gtid; idx < 2 * 32 * 3 * 64 * 8; idx += gthreads) {
        const int j = idx & 7, lane = (idx >> 3) & 63, nt = (idx >> 9) % 3, s = ((idx >> 9) / 3) & 31, L = (idx >> 9) / 96;
        const int k = 32 * s + 8 * (lane >> 4) + j, o = 16 * nt + (lane & 15);
        float w = 0.f;
        if (o < 4) w = a.in[11][((size_t)L * 1024 + k) * 4 + o]; else if (o < 36) w = a.in[13][((size_t)L * 1024 + k) * 32 + (o - 4)];
        w *= a.in[3][L * 1024 + k];
        const unsigned hi = f2bf(w); const float lo = w - __builtin_bit_cast(float, hi << 16);
        const size_t base = ((((size_t)L * 32 + s) * 3 + nt) * 2) * 512 + (size_t)lane * 8 + j;
        wrf[base] = (bf16)hi; wrf[base + 512] = (bf16)f2bf(lo);
    }
}
__device__ __forceinline__ void build_sincos(Frame& F, int gtid, int gthreads) {
    float* t1 = (float*)(F.ws + WS_SINCOS); float* t2 = (float*)(F.ws + WS_SINCOST);
    for (int idx = gtid; idx < SEQ * 128; idx += gthreads) {
        const int pos = idx >> 7, i = idx & 127;
        double ang = 1.0, bs = 0.9300449458481391;
        for (int bit = 0; bit < 7; ++bit) { if ((i >> bit) & 1) ang *= bs; bs *= bs; }
        const double ph = (double)pos * ang;
        const double kq = __builtin_rint(ph * 0.63661977236758134308);
        double r = __builtin_fma(-kq, 1.57079632679489655800, ph); r = __builtin_fma(-kq, 6.12323399573676603587e-17, r);
        const double r2 = r * r;
        double sn = r * (1.0 + r2 * (-1.0 / 6 + r2 * (1.0 / 120 + r2 * (-1.0 / 5040 + r2 * (1.0 / 362880 + r2 * (-1.0 / 39916800 + r2 * (1.0 / 6227020800.0)))))));
        double cs = 1.0 + r2 * (-0.5 + r2 * (1.0 / 24 + r2 * (-1.0 / 720 + r2 * (1.0 / 40320 + r2 * (-1.0 / 3628800 + r2 * (1.0 / 479001600.0 + r2 * (-1.0 / 87178291200.0)))))));
        const int q = ((int)kq) & 3;
        double s_ = (q == 0) ? sn : (q == 1) ? cs : (q == 2) ? -sn : -cs;
        double c_ = (q == 0) ? cs : (q == 1) ? -sn : (q == 2) ? -cs : sn;
        t1[(size_t)idx * 2] = (float)c_; t1[(size_t)idx * 2 + 1] = (float)s_;
        const size_t j = ((size_t)i * SEQ + pos) * 2; t2[j] = (float)c_; t2[j + 1] = (float)s_;
    }
}
__device__ __forceinline__ void p_prologue(Frame& F, const Args& a) {
    LAS float* scr = (LAS float*)(F.lds + RING_OFF + F.wave * 16384);
    const int gw = F.vcu * NWAVES + F.wave, NGW = F.G * NWAVES;
    for (int it = gw; it < IT_SHARED + IT_MOE; it += NGW) { if (it < IT_SHARED) conv_shared_item(F, a, it, scr); else conv_moe_item(F, a, 0, it - IT_SHARED, scr); }
    build_router_frags(F, a, F.vcu * 512 + F.tid, F.G * 512);
    build_sincos(F, F.vcu * 512 + F.tid, F.G * 512);
    for (int m = gw; m < TOK; m += NGW) rms_row_to_bf16(F.lane, a.in[0] + (size_t)m * DM, a.in[2], (bf16*)(F.ws + WS_HB) + (size_t)m * DM);
}
__device__ __forceinline__ void p_attention(Frame& F, const Args& a) {
    LAS float* lut = (LAS float*)(F.lds + LX_LUT);
    const attn_body::bf16* QKV = (const attn_body::bf16*)(F.ws + WS_QKV0);
    for (int v = F.vcu; v < 256; v += F.G) {
        const int bh = v >> 2, s = v & 3, b = bh >> 3, h = bh & 7;
        __syncthreads();
        if (F.tid < 132) { const int n = F.tid; int bk = n;
            if (n >= 16) { bk = 16; const int thr[15] = {19, 21, 24, 27, 31, 35, 40, 46, 52, 59, 67, 77, 87, 99, 113};
#pragma unroll
                for (int q = 0; q < 15; ++q) bk += (n >= thr[q]) ? 1 : 0; }
            lut[n] = (a.in[1][bk * 8 + h] - a.in[1][31 * 8 + h]) * LOG2E; }
        __syncthreads();
        for (int i = 0; i < 8; ++i) {
            const int qb = (i < 4) ? 7 - s : s, m = (i >> 1) & 1, vh = i & 1;
            attn_body::bf16* O = (attn_body::bf16*)(F.ws + WS_OP) + (size_t)m * TOK * 1024 + h * 128 + vh * 64;
            attn_body::attn_unit<8>(b, qb, QKV, h * 128 + m * 64, 1024 + h * 128 + m * 64, 2048 + h * 128 + vh * 64, O, lut, (char*)F.lds + RING_OFF);
        }
    }
}
__device__ __forceinline__ void p_diffcombine(Frame& F, const Args& a) {
    const int gw = F.vcu * NWAVES + F.wave, NGW = F.G * NWAVES, lane = F.lane;
    const float* lq = a.in[6];
    const float lam = __expf(wave_sum(lq[lane] * lq[64 + lane])) - __expf(wave_sum(lq[128 + lane] * lq[192 + lane])) + 0.2f;
    const int d0 = (lane & 7) * 16; float g[16];
#pragma unroll
    for (int j = 0; j < 16; ++j) g[j] = a.in[7][d0 + j] * 0.8f;
    const bf16* O0 = (const bf16*)(F.ws + WS_OP); const bf16* O1 = O0 + (size_t)TOK * 1024; bf16* AO = (bf16*)(F.ws + WS_AO);
    for (int m = gw; m < TOK; m += NGW) {
        const GAS v4u* p0 = (const GAS v4u*)(O0 + (size_t)m * 1024 + lane * 16); const GAS v4u* p1 = (const GAS v4u*)(O1 + (size_t)m * 1024 + lane * 16);
        const v4u a0 = p0[0], a1 = p0[1], b0 = p1[0], b1 = p1[1];
        const unsigned wa[8] = {a0.x, a0.y, a0.z, a0.w, a1.x, a1.y, a1.z, a1.w}, wb[8] = {b0.x, b0.y, b0.z, b0.w, b1.x, b1.y, b1.z, b1.w};
        float o[16]; float ss = 0.f;
#pragma unroll
        for (int j = 0; j < 8; ++j) { o[2 * j] = bflo(wa[j]) - lam * bflo(wb[j]); o[2 * j + 1] = bfhi(wa[j]) - lam * bfhi(wb[j]); ss += o[2 * j] * o[2 * j] + o[2 * j + 1] * o[2 * j + 1]; }
        ss += __shfl_xor(ss, 1); ss += __shfl_xor(ss, 2); ss += __shfl_xor(ss, 4);
        const float rstd = 1.0f / sqrtf(ss * (1.f / 128.f) + SUBLN_EPS);
        v4u w0, w1;
        w0.x = pk2(o[0] * rstd * g[0], o[1] * rstd * g[1]); w0.y = pk2(o[2] * rstd * g[2], o[3] * rstd * g[3]); w0.z = pk2(o[4] * rstd * g[4], o[5] * rstd * g[5]); w0.w = pk2(o[6] * rstd * g[6], o[7] * rstd * g[7]);
        w1.x = pk2(o[8] * rstd * g[8], o[9] * rstd * g[9]); w1.y = pk2(o[10] * rstd * g[10], o[11] * rstd * g[11]); w1.z = pk2(o[12] * rstd * g[12], o[13] * rstd * g[13]); w1.w = pk2(o[14] * rstd * g[14], o[15] * rstd * g[15]);
        GAS v4u* po = (GAS v4u*)(AO + (size_t)m * 1024 + lane * 16); po[0] = w0; po[1] = w1;
    }
}
template <int LAYER> __device__ __forceinline__ void p_router(Frame& F, const Args& a, const float* xres) {
    typedef float f32x4v __attribute__((ext_vector_type(4)));
    LAS float* part = (LAS float*)(F.lds + RING_OFF);
    LAS float* ssqp = (LAS float*)(F.lds + RING_OFF + 98304);
    LAS float* logit = (LAS float*)(F.lds + RING_OFF + 100352);
    LAS float* rstd_s = (LAS float*)(F.lds + RING_OFF + 109568);
    LAS int* lcnt = (LAS int*)(F.lds + RING_OFF + 109824);
    LAS int* lbase = (LAS int*)(F.lds + RING_OFF + 109952);
    const int lane = F.lane, w = F.wave, row = lane & 15, kg = lane >> 4;
    const bf16x8* wrf = (const bf16x8*)(F.ws + WS_WRF) + (size_t)LAYER * (32 * 3 * 2 * 64);
    bf16x8 Bh[4][3], Bl[4][3];
#pragma unroll
    for (int s = 0; s < 4; ++s)
#pragma unroll
        for (int nt = 0; nt < 3; ++nt) { Bh[s][nt] = wrf[(((4 * w + s) * 3 + nt) * 2 + 0) * 64 + lane]; Bl[s][nt] = wrf[(((4 * w + s) * 3 + nt) * 2 + 1) * 64 + lane]; }
    const float* gffn = a.in[3] + LAYER * 1024; const float* bg = a.in[12] + LAYER * 4; const float* be = a.in[14] + LAYER * 32;
    int* list = (int*)(F.ws + WS_LIST); float* pairw = (float*)(F.ws + WS_PAIRW); bf16* HB = (bf16*)(F.ws + WS_HB);
    for (int tb = F.vcu; tb < TOK / 64; tb += F.G) {
        __syncthreads();
        if (F.tid < 32) lcnt[F.tid] = 0;
        f32x4v acc[4][3];
#pragma unroll
        for (int mt = 0; mt < 4; ++mt)
#pragma unroll
            for (int nt = 0; nt < 3; ++nt) acc[mt][nt] = (f32x4v){0.f, 0.f, 0.f, 0.f};
#pragma unroll
        for (int mt = 0; mt < 4; ++mt) { const float* xr = xres + (size_t)(tb * 64 + mt * 16 + row) * DM + 128 * w + 8 * kg; float ss = 0.f;
#pragma unroll
            for (int s = 0; s < 4; ++s) { const f32x4 x0 = *(const GAS f32x4*)(xr + 32 * s), x1 = *(const GAS f32x4*)(xr + 32 * s + 4);
                const float xv[8] = {x0.x, x0.y, x0.z, x0.w, x1.x, x1.y, x1.z, x1.w}; bf16x8 ah, al;
#pragma unroll
                for (int j = 0; j < 8; ++j) { ss += xv[j] * xv[j]; const unsigned hi = f2bf(xv[j]); ah[j] = (short)hi; al[j] = (short)f2bf(xv[j] - __builtin_bit_cast(float, hi << 16)); }
#pragma unroll
                for (int nt = 0; nt < 3; ++nt) { acc[mt][nt] = __builtin_amdgcn_mfma_f32_16x16x32_bf16(ah, Bh[s][nt], acc[mt][nt], 0, 0, 0);
                    acc[mt][nt] = __builtin_amdgcn_mfma_f32_16x16x32_bf16(ah, Bl[s][nt], acc[mt][nt], 0, 0, 0); acc[mt][nt] = __builtin_amdgcn_mfma_f32_16x16x32_bf16(al, Bh[s][nt], acc[mt][nt], 0, 0, 0); } }
            ss += __shfl_xor(ss, 16); ss += __shfl_xor(ss, 32);
            if (kg == 0) ssqp[w * 64 + mt * 16 + row] = ss;
#pragma unroll
            for (int nt = 0; nt < 3; ++nt)
#pragma unroll
                for (int r = 0; r < 4; ++r) part[(w * 64 + mt * 16 + 4 * kg + r) * 48 + nt * 16 + row] = acc[mt][nt][r]; }
        __syncthreads();
        if (F.tid < 64) { float s = 0.f;
#pragma unroll
            for (int q = 0; q < 8; ++q) s += ssqp[q * 64 + F.tid];
            rstd_s[F.tid] = 1.0f / sqrtf(s * (1.f / 1024.f) + RMS_EPS); }
        __syncthreads();
        for (int idx = F.tid; idx < 64 * 36; idx += 512) { const int tk = idx / 36, o = idx % 36; float s = 0.f;
#pragma unroll
            for (int q = 0; q < 8; ++q) s += part[(q * 64 + tk) * 48 + o];
            logit[tk * 36 + o] = s * rstd_s[tk] + (o < 4 ? bg[o] : be[o - 4]); }
        __syncthreads();
        if (w == 0) {
            const LAS float* lg = logit + lane * 36;
            int gi = 0; float gm = lg[0];
#pragma unroll
            for (int j = 1; j < 4; ++j) { const float v = lg[j]; if (v > gm) { gm = v; gi = j; } }
            float gs = 0.f;
#pragma unroll
            for (int j = 0; j < 4; ++j) gs += __expf(lg[j] - gm);
            const float gp = 1.0f / gs;
            const LAS float* le = lg + 4 + gi * 8;
            int i1 = 0; float v1 = le[0];
#pragma unroll
            for (int j = 1; j < 8; ++j) { const float v = le[j]; if (v > v1) { v1 = v; i1 = j; } }
            int i2 = -1; float v2 = -INFINITY;
#pragma unroll
            for (int j = 0; j < 8; ++j) { const float v = le[j]; if (j != i1 && v > v2) { v2 = v; i2 = j; } }
            const float e2 = __expf(v2 - v1), w1 = gp / (1.0f + e2), w2 = gp * e2 / (1.0f + e2);
            const int e_1 = gi * 8 + i1, e_2 = gi * 8 + i2;
            const int r1 = __hip_atomic_fetch_add(lcnt + e_1, 1, __ATOMIC_RELAXED, __HIP_MEMORY_SCOPE_WORKGROUP);
            const int r2 = __hip_atomic_fetch_add(lcnt + e_2, 1, __ATOMIC_RELAXED, __HIP_MEMORY_SCOPE_WORKGROUP);
            LDS_WAIT();
            if (lane < 32) { const int c = lcnt[lane]; int bs = 0; if (c > 0) bs = (int)__hip_atomic_fetch_add((unsigned*)(F.ctl + CW_CNT + (LAYER * 32 + lane) * 64), (unsigned)c, RLX_AGENT); lbase[lane] = bs; }
            LDS_WAIT();
            const int tg = tb * 64 + lane; const int p1 = lbase[e_1] + r1, p2 = lbase[e_2] + r2;
            list[e_1 * LISTCAP + p1] = 2 * tg; list[e_2 * LISTCAP + p2] = 2 * tg + 1; pairw[2 * tg] = w1; pairw[2 * tg + 1] = w2;
        }
        for (int i = 0; i < 8; ++i) { const int tk = w * 8 + i, tg = tb * 64 + tk; const float rs = rstd_s[tk];
            const GAS f32x4* xr = (const GAS f32x4*)(xres + (size_t)tg * DM) + lane; const GAS f32x4* gr = (const GAS f32x4*)gffn + lane; GAS v2u* o8 = (GAS v2u*)(HB + (size_t)tg * DM) + lane;
#pragma unroll
            for (int j = 0; j < 4; ++j) { const f32x4 v = xr[64 * j], gg = gr[64 * j]; v2u o; o.x = pk2(v.x * rs * gg.x, v.y * rs * gg.y); o.y = pk2(v.z * rs * gg.z, v.w * rs * gg.w); o8[64 * j] = o; } }
    }
}
template <int LAYER> __device__ __forceinline__ void moe_setup(Frame& F) {
    LAS int* tstart = (LAS int*)(F.lds + LX_TSTART); LAS int* texp = (LAS int*)(F.lds + LX_TEXP); LAS int* lc = (LAS int*)(F.lds + LX_CNT);
    __syncthreads();
    if (F.tid < 32) { int c = (int)__hip_atomic_load((unsigned*)(F.ctl + CW_CNT + (LAYER * 32 + F.tid) * 64), RLX_AGENT); c = c < 0 ? 0 : (c > LISTCAP ? LISTCAP : c); lc[F.tid] = c; }
    __syncthreads();
    if (F.tid == 0) { int acc = 0; for (int e = 0; e < 32; ++e) { tstart[e] = acc; acc += (lc[e] + 255) >> 8; } if (acc > MAXRT) acc = MAXRT; tstart[32] = acc; tstart[33] = acc; }
    __syncthreads();
    if (F.tid < MAXRT) { int e = 0;
#pragma unroll 1
        for (int q = 1; q < 32; ++q) if (tstart[q] <= F.tid) e = q;
        texp[F.tid] = e; }
    __syncthreads();
}
template <int LAYER> __device__ __forceinline__ void p_moe1(Frame& F) {
    moe_setup<LAYER>(F);
    const LAS int* tstart = (const LAS int*)(F.lds + LX_TSTART); const LAS int* texp = (const LAS int*)(F.lds + LX_TEXP); const LAS int* lc = (const LAS int*)(F.lds + LX_CNT);
    LAS int* rowtab = (LAS int*)(F.lds + LX_ROWTAB);
    pg8::MoeOrder S{F.G, F.vcu, 1024, 0, tstart, texp};
    const int* list = (const int*)(F.ws + WS_LIST);
    pg8::Unit u;
    for (int i = 0; i < 4 && S.next(i, u); ++i) { if (F.tid < 256) { const int e = u.pn >> 2, pos = u.aux * 256 + F.tid; rowtab[i * 256 + F.tid] = (pos < lc[e]) ? (list[e * LISTCAP + pos] >> 1) : 0; } }
    VM_WAIT(); __syncthreads();
    pg8::Gemm g{(const bf16*)(F.ws + WS_HB), (const bf16*)(F.ws + WS_W1CAT), 1024, 1024, 1024};
    pg8::EpiMoe1 E{(bf16*)(F.ws + WS_MACT)};
    pg8::gemm_phase<pg8::EpiMoe1, pg8::MoeOrder, true, true>(F.lds + RING_OFF, g, S, E, rowtab);
}
template <int LAYER> __device__ __forceinline__ void p_moe2(Frame& F) {
    moe_setup<LAYER>(F);
    const LAS int* tstart = (const LAS int*)(F.lds + LX_TSTART); const LAS int* texp = (const LAS int*)(F.lds + LX_TEXP); const LAS int* lc = (const LAS int*)(F.lds + LX_CNT);
    pg8::MoeOrder S{F.G, F.vcu, 512, 256 * 512, tstart, texp};
    pg8::Gemm g{(const bf16*)(F.ws + WS_MACT), (const bf16*)(F.ws + WS_W2T), 512, 512, 512};
    pg8::EpiMoe2 E{(bf16*)(F.ws + WS_Y), (const int*)(F.ws + WS_LIST), (const float*)(F.ws + WS_PAIRW), lc};
    pg8::gemm_phase<pg8::EpiMoe2, pg8::MoeOrder, true, false>(F.lds + RING_OFF, g, S, E, nullptr);
}
template <bool FINAL> __device__ __forceinline__ void p_combine(Frame& F, float* xres, const float* g) {
    const int gw = F.vcu * NWAVES + F.wave, NGW = F.G * NWAVES, lane = F.lane;
    const bf16* Y = (const bf16*)(F.ws + WS_Y); bf16* HB = (bf16*)(F.ws + WS_HB);
    for (int m = gw; m < TOK; m += NGW) {
        GAS f32x4* xr = (GAS f32x4*)(xres + (size_t)m * DM) + lane; const GAS v2u* y0 = (const GAS v2u*)(Y + (size_t)(2 * m) * DM) + lane; const GAS v2u* y1 = (const GAS v2u*)(Y + (size_t)(2 * m + 1) * DM) + lane;
        const GAS f32x4* gr = (const GAS f32x4*)g + lane;
        f32x4 v[4]; float s = 0.f;
#pragma unroll
        for (int j = 0; j < 4; ++j) { const f32x4 x = xr[64 * j]; const v2u p = y0[64 * j], q = y1[64 * j];
            v[j].x = x.x + bflo(p.x) + bflo(q.x); v[j].y = x.y + bfhi(p.x) + bfhi(q.x); v[j].z = x.z + bflo(p.y) + bflo(q.y); v[j].w = x.w + bfhi(p.y) + bfhi(q.y);
            s += (v[j].x * v[j].x + v[j].y * v[j].y) + (v[j].z * v[j].z + v[j].w * v[j].w); }
        const float rstd = 1.0f / sqrtf(wave_sum(s) * (1.f / 1024.f) + RMS_EPS);
        if (FINAL) {
#pragma unroll
            for (int j = 0; j < 4; ++j) { const f32x4 gg = gr[64 * j]; f32x4 o; o.x = v[j].x * rstd * gg.x; o.y = v[j].y * rstd * gg.y; o.z = v[j].z * rstd * gg.z; o.w = v[j].w * rstd * gg.w; xr[64 * j] = o; }
        } else {
            GAS v2u* o8 = (GAS v2u*)(HB + (size_t)m * DM) + lane;
#pragma unroll
            for (int j = 0; j < 4; ++j) { xr[64 * j] = v[j]; const f32x4 gg = gr[64 * j]; v2u o; o.x = pk2(v[j].x * rstd * gg.x, v[j].y * rstd * gg.y); o.y = pk2(v[j].z * rstd * gg.z, v[j].w * rstd * gg.w); o8[64 * j] = o; }
        }
    }
}
__device__ __forceinline__ void p_scan(Frame& F) {
    const bf16* DS = (const bf16*)(F.ws + WS_DS); bf16* BT = (bf16*)(F.ws + WS_BTCAT);
    for (int gidx = F.vcu * 512 + F.tid; gidx < NB * RH * 16384; gidx += F.G * 512) {
        const int bh = gidx >> 14, e8 = gidx & 16383, dv = e8 >> 5, dk0 = (e8 & 31) * 8, h = bh & 3;
        const float cd = __builtin_amdgcn_exp2f(256.0f * pg8::log2_gamma(h));
        v4u d[7];
#pragma unroll
        for (int n = 0; n < 7; ++n) d[n] = *(const GAS v4u*)(DS + ((size_t)(bh * RNC + n) * RDV + dv) * RDK + dk0);
        float s[8];
#pragma unroll
        for (int j = 0; j < 8; ++j) s[j] = 0.f;
#pragma unroll
        for (int n = 0; n < 8; ++n) {
            v4u o; o.x = pk2(s[0], s[1]); o.y = pk2(s[2], s[3]); o.z = pk2(s[4], s[5]); o.w = pk2(s[6], s[7]);
            *(GAS v4u*)(BT + ((size_t)(bh * RNC + n) * RDV + dv) * 512 + 256 + dk0) = o;
            if (n < 7) { const unsigned wv[4] = {d[n].x, d[n].y, d[n].z, d[n].w};
#pragma unroll
                for (int j = 0; j < 4; ++j) { s[2 * j] = cd * (s[2 * j] + bflo(wv[j])); s[2 * j + 1] = cd * (s[2 * j + 1] + bfhi(wv[j])); } }
        }
    }
}
__device__ __forceinline__ void p_normgate(Frame& F) {
    const int gw = F.vcu * NWAVES + F.wave, NGW = F.G * NWAVES, lane = F.lane;
    const bf16* OR = (const bf16*)(F.ws + WS_ORET); bf16* SG = (bf16*)(F.ws + WS_SG);
    for (int m = gw; m < TOK; m += NGW) {
        const GAS v4u* po = (const GAS v4u*)(OR + (size_t)m * 2048 + lane * 32); GAS v4u* pg = (GAS v4u*)(SG + (size_t)m * 2048 + lane * 32);
        v4u ov[4], gv[4]; float ss = 0.f;
#pragma unroll
        for (int q = 0; q < 4; ++q) { ov[q] = po[q]; gv[q] = pg[q]; }
#pragma unroll
        for (int q = 0; q < 4; ++q) { const unsigned wv[4] = {ov[q].x, ov[q].y, ov[q].z, ov[q].w};
#pragma unroll
            for (int j = 0; j < 4; ++j) { const float x0 = bflo(wv[j]), x1 = bfhi(wv[j]); ss += x0 * x0 + x1 * x1; } }
        ss += __shfl_xor(ss, 1); ss += __shfl_xor(ss, 2); ss += __shfl_xor(ss, 4); ss += __shfl_xor(ss, 8);
        const float rstd = 1.0f / sqrtf(ss * (1.f / 512.f) + RMS_EPS);
#pragma unroll
        for (int q = 0; q < 4; ++q) { const unsigned wv[4] = {ov[q].x, ov[q].y, ov[q].z, ov[q].w}, wg[4] = {gv[q].x, gv[q].y, gv[q].z, gv[q].w}; unsigned r[4];
#pragma unroll
            for (int j = 0; j < 4; ++j) r[j] = pk2(bflo(wv[j]) * rstd * bflo(wg[j]), bfhi(wv[j]) * rstd * bfhi(wg[j]));
            v4u o; o.x = r[0]; o.y = r[1]; o.z = r[2]; o.w = r[3]; pg[q] = o; }
    }
}
__device__ __forceinline__ void p_conv_moe1(Frame& F, const Args& a) {
    LAS float* scr = (LAS float*)(F.lds + RING_OFF + F.wave * 16384);
    const int gw = F.vcu * NWAVES + F.wave, NGW = F.G * NWAVES;
    for (int it = gw; it < IT_MOE; it += NGW) conv_moe_item(F, a, 1, it, scr);
}

constexpr int N_PHASES = 19;
#ifndef MK_PER_PHASE
#define MK_PER_PHASE 0
#endif
__global__ void __launch_bounds__(NWAVES * 64, 2) hybrid_fwd(Args args) {
    extern __shared__ __attribute__((aligned(16))) unsigned char lds[];
    Frame F;
    F.lds = (LAS unsigned char*)lds;
    F.tid = threadIdx.x; F.lane = F.tid & 63; F.wave = __builtin_amdgcn_readfirstlane(F.tid >> 6);
    F.G = gridDim.x; { const int bx = blockIdx.x; F.vcu = (F.G % 8 == 0) ? (bx % 8) * (F.G / 8) + bx / 8 : bx; }
    F.ws = args.ws; F.ctl = (gu32*)(args.ws + WS_CTL);
    for (int u = F.tid; u < (LDS_BYTES - LX_OFF) / 4; u += NWAVES * 64) ((LAS unsigned*)(F.lds + LX_OFF))[u] = 0u;
    __syncthreads();
    XcdBarrier bar; bar.bar = (unsigned*)(F.ctl + CW_BAR); bar.x = 0; bar.st = nullptr;
    if (!MK_PER_PHASE) bar = xcd_barrier_post((unsigned*)(F.ctl + CW_BAR), (volatile LAS unsigned*)(F.lds + LX_MISC) + 8);
    const int lo = args.ph_lo, hi = args.ph_hi;
#ifndef PH_MASK
#define PH_MASK 0x7ffff
#endif
#define IN(k) (((PH_MASK >> (k)) & 1) && lo <= (k) && (k) < hi)
#define SEAM(k) do { if (IN(k) && IN((k) + 1)) xcd_barrier(bar); } while (0)
#define REFRESH() do { int t_ = threadIdx.x; asm volatile("" : "+v"(t_)); F.tid = t_; F.lane = t_ & 63; } while (0)
    float* xres = args.out;
    unsigned char* ws = args.ws;
    const int bx = (int)blockIdx.x;

    if (IN(0)) { REFRESH(); p_prologue(F, args); } SEAM(0);
    if (IN(1)) { REFRESH();
        pg8::Gemm g{(const bf16*)(ws + WS_HB), (const bf16*)(ws + WS_WINT0), 1024, 1024, 1024}; pg8::StaticOrder S; S.init(TOK, 3072, F.G, bx, 1024, 1024);
        pg8::EpiQKV E{(bf16*)(ws + WS_QKV0), ATT_C2};
        pg8::gemm_phase<pg8::EpiQKV, pg8::StaticOrder, true, false>(F.lds + RING_OFF, g, S, E, nullptr);
    } SEAM(1);
    if (IN(2)) { REFRESH(); p_attention(F, args); } SEAM(2);
    if (IN(3)) { REFRESH(); p_diffcombine(F, args); } SEAM(3);
    if (IN(4)) { REFRESH();
        pg8::Gemm g{(const bf16*)(ws + WS_AO), (const bf16*)(ws + WS_WOUTT0), 1024, 1024, 1024}; pg8::StaticOrder S; S.init(TOK, 1024, F.G, bx, 1024, 1024);
        pg8::EpiRes E{args.in[0], xres};
        pg8::gemm_phase<pg8::EpiRes, pg8::StaticOrder, true, false>(F.lds + RING_OFF, g, S, E, nullptr);
    } SEAM(4);
    if (IN(5)) { REFRESH(); p_router<0>(F, args, xres); } SEAM(5);
    if (IN(6)) { REFRESH(); p_moe1<0>(F); } SEAM(6);
    if (IN(7)) { REFRESH(); p_moe2<0>(F); } SEAM(7);
    if (IN(8)) { REFRESH(); p_combine<false>(F, xres, args.in[2] + 1024); } SEAM(8);
    if (IN(9)) { REFRESH();
        { pg8::Gemm g{(const bf16*)(ws + WS_HB), (const bf16*)(ws + WS_WRINA), 1024, 1024, 1024}; pg8::StaticOrder S; S.init(TOK, 4096, F.G, bx, 1024, 1024);
          pg8::EpiRetA E{(bf16*)(ws + WS_ACAT), (bf16*)(ws + WS_KI), (bf16*)(ws + WS_SG), (const float*)(ws + WS_SINCOS)};
          pg8::gemm_phase<pg8::EpiRetA, pg8::StaticOrder, true, false>(F.lds + RING_OFF, g, S, E, nullptr); }
        { pg8::Gemm g{(const bf16*)(ws + WS_WRINB), (const bf16*)(ws + WS_HB), 1024, 1024, 1024}; pg8::StaticOrder S; S.init(3072, TOK, F.G, bx, 1024, 1024);
          pg8::EpiRetB E{(bf16*)(ws + WS_KIT), (bf16*)(ws + WS_BTCAT), (const float*)(ws + WS_SINCOST)};
          pg8::gemm_phase<pg8::EpiRetB, pg8::StaticOrder, true, false>(F.lds + RING_OFF, g, S, E, nullptr); }
    } SEAM(9);
    if (IN(10)) { REFRESH();
        { pg8::Gemm g{(const bf16*)(ws + WS_ACAT), (const bf16*)(ws + WS_KI), 512, 1024, 256}; pg8::ScoresOrder S{F.G, F.vcu};
          pg8::EpiScores E{(bf16*)(ws + WS_ACAT)};
          pg8::gemm_phase<pg8::EpiScores, pg8::ScoresOrder, true, false>(F.lds + RING_OFF, g, S, E, nullptr); }
        { pg8::Gemm g{(const bf16*)(ws + WS_BTCAT), (const bf16*)(ws + WS_KIT), 512, 2048, 256}; pg8::DsOrder S{F.G, F.vcu};
          pg8::EpiDS E{(bf16*)(ws + WS_DS)};
          pg8::gemm_phase<pg8::EpiDS, pg8::DsOrder, true, false>(F.lds + RING_OFF, g, S, E, nullptr); }
    } SEAM(10);
    if (IN(11)) { REFRESH(); p_scan(F); } SEAM(11);
    if (IN(12)) { REFRESH();
        pg8::Gemm g{(const bf16*)(ws + WS_ACAT), (const bf16*)(ws + WS_BTCAT), 512, 512, 512}; pg8::RetOOrder S{F.G, F.vcu};
        pg8::EpiRetO E{(bf16*)(ws + WS_ORET)};
        pg8::gemm_phase<pg8::EpiRetO, pg8::RetOOrder, true, false>(F.lds + RING_OFF, g, S, E, nullptr);
    } SEAM(12);
    if (IN(13)) { REFRESH(); p_normgate(F); } SEAM(13);
    if (IN(14)) { REFRESH();
        pg8::Gemm g{(const bf16*)(ws + WS_SG), (const bf16*)(ws + WS_WROUTT), 2048, 2048, 2048}; pg8::StaticOrder S; S.init(TOK, 1024, F.G, bx, 2048, 2048);
        pg8::EpiRes E{xres, xres};
        pg8::gemm_phase<pg8::EpiRes, pg8::StaticOrder, true, false>(F.lds + RING_OFF, g, S, E, nullptr);
    } SEAM(14);
    if (IN(15)) { REFRESH(); p_router<1>(F, args, xres); __syncthreads(); p_conv_moe1(F, args); } SEAM(15);
    if (IN(16)) { REFRESH(); p_moe1<1>(F); } SEAM(16);
    if (IN(17)) { REFRESH(); p_moe2<1>(F); } SEAM(17);
    if (IN(18)) { REFRESH(); p_combine<true>(F, xres, args.in[4]); }
#undef IN
#undef SEAM
}

extern "C" void kernel_launch(void* const* d_in, const int* in_sizes, int n_in, void* d_out, int out_size, void* d_ws, size_t ws_size, hipStream_t stream) {
    static int grid = 0;
    if (grid == 0) {
        if (n_in != 18 || in_sizes[0] != TOK * DM || out_size != TOK * DM || ws_size < WS_END) { fprintf(stderr, "kernel_launch: unexpected shapes / workspace (n_in %d, in0 %d, out %d, ws %zu < %zu); nothing launched\n", n_in, n_in > 0 ? in_sizes[0] : -1, out_size, ws_size, (size_t)WS_END); grid = -1; return; }
        int dev = 0, cus = 0, per_cu = 0;
        if (hipGetDevice(&dev) != hipSuccess || hipDeviceGetAttribute(&cus, hipDeviceAttributeMultiprocessorCount, dev) != hipSuccess) { grid = -1; return; }
        if (hipFuncSetAttribute((const void*)hybrid_fwd, hipFuncAttributeMaxDynamicSharedMemorySize, LDS_BYTES) != hipSuccess) { fprintf(stderr, "kernel_launch: hipFuncSetAttribute failed\n"); grid = -1; return; }
        if (hipOccupancyMaxActiveBlocksPerMultiprocessor(&per_cu, (const void*)hybrid_fwd, NWAVES * 64, LDS_BYTES) != hipSuccess || per_cu < 1) { fprintf(stderr, "kernel_launch: occupancy query says %d\n", per_cu); }
        (void)hipGetLastError();
        grid = cus > 256 ? 256 : cus;
    }
    if (grid < 0) return;
    if (hipMemsetAsync((char*)d_ws + WS_CTL, 0, CTL_ZERO_BYTES, stream) != hipSuccess) return;
    Args a{};
    for (int i = 0; i < 18; ++i) a.in[i] = (const float*)d_in[i];
    a.out = (float*)d_out; a.ws = (unsigned char*)d_ws; a.pad = 0;
#if MK_PER_PHASE
    for (int p = 0; p < N_PHASES; ++p) { a.ph_lo = p; a.ph_hi = p + 1; a.li = p; hipLaunchKernelGGL(hybrid_fwd, dim3(grid), dim3(NWAVES * 64), LDS_BYTES, stream, a); }
#else
    a.ph_lo = 0; a.ph_hi = N_PHASES; a.li = 0;
    hipLaunchKernelGGL(hybrid_fwd, dim3(grid), dim3(NWAVES * 64), LDS_BYTES, stream, a);
#endif
}
```

```cpp
#include <hip/hip_runtime.h>
#include <hip/hip_bf16.h>
#include <cstdio>
#include <cstdint>

#define LAS __attribute__((address_space(3)))
#define GAS __attribute__((address_space(1)))

namespace pg8 {
typedef unsigned short bf16_t;
typedef short bf16x8 __attribute__((ext_vector_type(8)));
typedef float f32x4 __attribute__((ext_vector_type(4)));
typedef float f32x2 __attribute__((ext_vector_type(2)));
typedef unsigned u32x4 __attribute__((ext_vector_type(4)));
typedef unsigned u32x2 __attribute__((ext_vector_type(2)));
constexpr int BM = 256, BK = 64, HALF = 128, HTB = HALF * BK * 2, STAGE_BYTES = 8 * HTB, NXCD = 8, WGM = 8;

__host__ __device__ __forceinline__ int lds_byte(int r, int c) { const int st = (r >> 4) * 2 + (c >> 5), rr = r & 15, cc = c & 31, ob = rr * 64 + cc * 2; return st * 1024 + (ob ^ (((ob >> 9) & 1) << 5)); }
__host__ __device__ __forceinline__ void stage_rc(int b, int& R, int& C) { const int st = b / 1024, sb = b % 1024, swz = sb ^ (((sb >> 9) & 1) << 5); R = (st >> 1) * 16 + swz / 64; C = (st & 1) * 32 + (swz % 64) / 2; }
__host__ __device__ __forceinline__ int perm32(int rho) { const int n = rho >> 4, i = rho & 15; return 8 * (i >> 2) + 4 * n + (i & 3); }

struct Unit { int pm, pn, aux; long aoff, boff; };
struct Gemm { const bf16_t* A; const bf16_t* Bt; int lda, ldb, K; };

struct StaticOrder {
    int nM, nN, nwg, G, c, lda, ldb;
    __device__ void init(int M, int N, int G_, int c_, int lda_, int ldb_) { nM = M / BM; nN = N / BM; nwg = nM * nN; G = G_; c = c_; lda = lda_; ldb = ldb_; }
    __device__ bool next(int i, Unit& u) const {
        const long L = (long)i * G + c; if (L >= nwg) return false;
        int wgid = (int)L; { const int q = nwg / NXCD, r = nwg % NXCD, xcd = wgid % NXCD, off = wgid / NXCD; wgid = (xcd < r ? xcd * (q + 1) : r * (q + 1) + (xcd - r) * q) + off; }
        const int nig = WGM * nN, gid = wgid / nig, fm = gid * WGM, gsz = (nM - fm) < WGM ? (nM - fm) : WGM;
        u.pm = fm + ((wgid % nig) % gsz); u.pn = (wgid % nig) / gsz; u.aux = 0;
        u.aoff = (long)u.pm * BM * lda; u.boff = (long)u.pn * BM * ldb; return true;
    }
};

__device__ __forceinline__ unsigned cvt_pk_bf16(float lo, float hi) { unsigned r; asm volatile("v_cvt_pk_bf16_f32 %0, %1, %2" : "=v"(r) : "v"(lo), "v"(hi)); return r; }
__device__ __forceinline__ u32x4 pack8(const f32x4 v0, const f32x4 v1) { u32x4 w; w.x = cvt_pk_bf16(v0[0], v0[1]); w.y = cvt_pk_bf16(v0[2], v0[3]); w.z = cvt_pk_bf16(v1[0], v1[1]); w.w = cvt_pk_bf16(v1[2], v1[3]); return w; }

typedef int v4i_t __attribute__((ext_vector_type(4)));
typedef int v8i_t __attribute__((ext_vector_type(8)));
__device__ __forceinline__ v8i_t cat8(const bf16x8 a, const bf16x8 b) { const v4i_t x = __builtin_bit_cast(v4i_t, a), y = __builtin_bit_cast(v4i_t, b); return __builtin_shufflevector(x, y, 0, 1, 2, 3, 4, 5, 6, 7); }
template <class Epi, class Sched, bool ALIGN_EPI, bool GATHER, bool FP8 = false>
__device__ __forceinline__ void gemm_phase(LAS unsigned char* lds, const Gemm g, const Sched& S, const Epi& E, const LAS int* rowtab) {
    int tid_ = threadIdx.x; asm volatile("" : "+v"(tid_));
    const int tid = tid_, wid = __builtin_amdgcn_readfirstlane(tid >> 6), lane = tid & 63, wr = wid >> 2, wc = wid & 3, fr = lane & 15, fq = lane >> 4;
    const int K = g.K, nt = K / BK;
    int sR[2], sC[2]; unsigned voffB[2];
#pragma unroll
    for (int i = 0; i < 2; ++i) { int R, C; stage_rc(tid * 16 + i * 8192, R, C); sR[i] = R; sC[i] = C; const int Rb = Epi::PERM ? ((R & ~31) + perm32(R & 31)) : R; voffB[i] = (unsigned)(Rb * g.ldb + C) * 2u; }
    unsigned avo[2][2], navo[2][2];
#define PG8_SETOFF(o, ui_) do { _Pragma("unroll") for (int h_ = 0; h_ < 2; ++h_) _Pragma("unroll") for (int i_ = 0; i_ < 2; ++i_) { const int row_ = h_ * HALF + sR[i_]; \
        const int grow_ = GATHER ? rowtab[(ui_) * BM + row_] : row_; o[h_][i_] = (unsigned)(grow_ * g.lda + sC[i_]) * 2u; } } while (0)
    const size_t kstep = (size_t)(BK * 2);
    const size_t hstepB = (size_t)HALF * g.ldb * 2;
    const unsigned ldsw = (unsigned)wid * 1024u;
    const int aoff = lds_byte(wr * 64 + fr, fq * 8), boff = lds_byte(wc * 32 + fr, fq * 8);
#define PG8_SA(b, h) (((b) * 2 + (h)) * HTB)
#define PG8_SB(b, h) ((4 + (b) * 2 + (h)) * HTB)
#define PG8_STAGE(bufoff, gbase, voff) do { _Pragma("unroll") for (int _i = 0; _i < 2; ++_i) \
        __builtin_amdgcn_global_load_lds((const unsigned*)((const char*)(gbase) + (voff)[_i]), (LAS unsigned*)(lds + (bufoff) + ldsw + _i * 8192), 16, 0, 0); } while (0)
#define PG8_LD8(dst8, addr_) do { const v4i_t lo_ = *(const LAS v4i_t*)(addr_), hi_ = *(const LAS v4i_t*)((addr_) + 1024); dst8 = __builtin_shufflevector(lo_, hi_, 0, 1, 2, 3, 4, 5, 6, 7); } while (0)
#define PG8_LDA(dst, b, h) do { _Pragma("unroll") for (int m = 0; m < 4; ++m) { if constexpr (FP8) { PG8_LD8(dst##8[m], lds + PG8_SA(b, h) + aoff + m * 2048); } else { _Pragma("unroll") for (int k = 0; k < 2; ++k) dst[m][k] = *(const LAS bf16x8*)(lds + PG8_SA(b, h) + aoff + m * 2048 + k * 1024); } } } while (0)
#define PG8_LDB(dst, b, h) do { _Pragma("unroll") for (int n = 0; n < 2; ++n) { if constexpr (FP8) { PG8_LD8(dst##8[n], lds + PG8_SB(b, h) + boff + n * 2048); } else { _Pragma("unroll") for (int k = 0; k < 2; ++k) dst[n][k] = *(const LAS bf16x8*)(lds + PG8_SB(b, h) + boff + n * 2048 + k * 1024); } } } while (0)
#define PG8_MMA(ai, bj, At, Bt) do { __builtin_amdgcn_s_setprio(1); _Pragma("unroll") for (int m = 0; m < 4; ++m) _Pragma("unroll") for (int n = 0; n < 2; ++n) { \
        if constexpr (FP8) asm volatile("v_mfma_scale_f32_16x16x128_f8f6f4 %0, %1, %2, %0, %3, %3 op_sel_hi:[0,0,0]" : "+v"(acc[ai][bj][m][n]) : "v"(Bt##8[n]), "v"(At##8[m]), "v"(sc1)); \
        else { _Pragma("unroll") for (int k = 0; k < 2; ++k) acc[ai][bj][m][n] = __builtin_amdgcn_mfma_f32_16x16x32_bf16(Bt[n][k], At[m][k], acc[ai][bj][m][n], 0, 0, 0); } } \
        __builtin_amdgcn_s_setprio(0); } while (0)
#define PG8_WAIT_V(n) asm volatile("s_waitcnt vmcnt(" #n ")" ::: "memory")
#define PG8_WAIT_L(n) asm volatile("s_waitcnt lgkmcnt(" #n ")" ::: "memory")
#define PG8_BAR __builtin_amdgcn_s_barrier()
#define PG8_SCHED __builtin_amdgcn_sched_barrier(0)
    unsigned sc1 = 0; if constexpr (FP8) asm volatile("v_mov_b32 %0, 0x7f7f7f7f\n\ts_nop 4" : "=v"(sc1));
    Unit cur, nxt; int ui = 0;
    if (!S.next(0, cur)) return;
    f32x4 acc[2][2][4][2];
#pragma unroll
    for (int a = 0; a < 2; ++a)
#pragma unroll
        for (int b = 0; b < 2; ++b)
#pragma unroll
            for (int m = 0; m < 4; ++m)
#pragma unroll
                for (int n = 0; n < 2; ++n) acc[a][b][m][n] = (f32x4){0.f, 0.f, 0.f, 0.f};
    bf16x8 At[4][2], B0[2][2], B1[2][2]; v8i_t At8[4], B08[2], B18[2];
    const char* cA = (const char*)g.A + cur.aoff * 2; const char* cB = (const char*)g.Bt + cur.boff * 2;
    PG8_SETOFF(avo, 0);
    PG8_STAGE(PG8_SB(0, 0), cB, voffB); PG8_STAGE(PG8_SB(0, 1), cB + hstepB, voffB); PG8_STAGE(PG8_SA(0, 0), cA, avo[0]); PG8_STAGE(PG8_SA(0, 1), cA, avo[1]);
    if (wr == 1) PG8_BAR;
    PG8_WAIT_V(2); PG8_BAR;
    PG8_STAGE(PG8_SB(1, 0), cB + kstep, voffB); PG8_STAGE(PG8_SA(1, 0), cA + kstep, avo[0]); PG8_STAGE(PG8_SB(1, 1), cB + hstepB + kstep, voffB);
    PG8_WAIT_V(6); PG8_BAR;
    for (;;) {
        const bool has_next = S.next(ui + 1, nxt);
        const char* nA = has_next ? (const char*)g.A + nxt.aoff * 2 : cA; const char* nB = has_next ? (const char*)g.Bt + nxt.boff * 2 : cB;
        if (GATHER && has_next) { PG8_SETOFF(navo, ui + 1); }
        else {
#pragma unroll
            for (int h_ = 0; h_ < 2; ++h_)
#pragma unroll
                for (int i_ = 0; i_ < 2; ++i_) navo[h_][i_] = avo[h_][i_]; }
#pragma nounroll
        for (int t = 0; t < nt; t += 2) {
            const bool last = (t == nt - 2);
            const char* a1 = cA + (size_t)(t + 1) * kstep;
            const char* a2 = last ? nA : cA + (size_t)(t + 2) * kstep; const char* b2 = last ? nB : cB + (size_t)(t + 2) * kstep;
            const char* a3 = a2 + kstep; const char* b3 = b2 + kstep;
            unsigned o2[2][2];
#pragma unroll
            for (int h_ = 0; h_ < 2; ++h_)
#pragma unroll
                for (int i_ = 0; i_ < 2; ++i_) o2[h_][i_] = (GATHER && last) ? navo[h_][i_] : avo[h_][i_];
            PG8_LDB(B0, 0, 0); PG8_LDB(B1, 0, 1); PG8_SCHED; PG8_LDA(At, 0, 0); PG8_STAGE(PG8_SA(1, 1), a1, avo[1]);
            PG8_WAIT_V(8); PG8_WAIT_L(0); PG8_BAR; PG8_MMA(0, 0, At, B0); PG8_MMA(0, 1, At, B1); PG8_BAR; PG8_SCHED;
            PG8_LDA(At, 0, 1); PG8_STAGE(PG8_SB(0, 0), b2, voffB); PG8_STAGE(PG8_SB(0, 1), b2 + hstepB, voffB); PG8_STAGE(PG8_SA(0, 0), a2, o2[0]);
            PG8_WAIT_V(8); PG8_WAIT_L(0); PG8_BAR; PG8_MMA(1, 0, At, B0); PG8_MMA(1, 1, At, B1); PG8_BAR; PG8_SCHED;
            PG8_LDB(B0, 1, 0); PG8_LDB(B1, 1, 1); PG8_SCHED; PG8_LDA(At, 1, 0); PG8_STAGE(PG8_SA(0, 1), a2, o2[1]);
            PG8_WAIT_V(8); PG8_WAIT_L(0); PG8_BAR; PG8_MMA(0, 0, At, B0); PG8_MMA(0, 1, At, B1); PG8_BAR; PG8_SCHED;
            PG8_LDA(At, 1, 1); PG8_STAGE(PG8_SB(1, 0), b3, voffB); PG8_STAGE(PG8_SB(1, 1), b3 + hstepB, voffB); PG8_STAGE(PG8_SA(1, 0), a3, o2[0]);
            PG8_WAIT_V(8); PG8_WAIT_L(0); PG8_BAR; PG8_MMA(1, 0, At, B0); PG8_MMA(1, 1, At, B1); PG8_BAR; PG8_SCHED;
        }
        if constexpr (ALIGN_EPI) { if (wr == 0) PG8_BAR; }
        if constexpr (FP8) asm volatile("s_nop 15\n\ts_nop 3" ::: "memory");
        { int efr = fr, efq = fq; asm volatile("" : "+v"(efr), "+v"(efq)); E(acc, cur, wr, wc, efr, efq); }
        if (!has_next) break;
#pragma unroll
        for (int a = 0; a < 2; ++a)
#pragma unroll
            for (int b = 0; b < 2; ++b)
#pragma unroll
                for (int m = 0; m < 4; ++m)
#pragma unroll
                    for (int n = 0; n < 2; ++n) acc[a][b][m][n] = (f32x4){0.f, 0.f, 0.f, 0.f};
        cur = nxt; cA = nA; cB = nB; ++ui;
#pragma unroll
        for (int h_ = 0; h_ < 2; ++h_)
#pragma unroll
            for (int i_ = 0; i_ < 2; ++i_) avo[h_][i_] = navo[h_][i_];
        if constexpr (ALIGN_EPI) { if (wr == 1) PG8_BAR; }
    }
    PG8_WAIT_V(0);
    if constexpr (!ALIGN_EPI) { if (wr == 0) PG8_BAR; }
    PG8_BAR;
#undef PG8_SETOFF
#undef PG8_SA
#undef PG8_SB
#undef PG8_STAGE
#undef PG8_LDA
#undef PG8_LDB
#undef PG8_MMA
#undef PG8_WAIT_V
#undef PG8_WAIT_L
#undef PG8_BAR
#undef PG8_SCHED
}
}
constexpr int NB = 8, SEQ = 2048, DM = 1024, TOK = NB * SEQ;
constexpr int AH = 8;
constexpr int RH = 4, RDK = 256, RDV = 512, RC = 256, RNC = SEQ / RC;
constexpr int NEXP = 32, EFF = 512, NPAIR = 2 * TOK, LISTCAP = TOK;
constexpr int MAXRT = NPAIR / 256 + NEXP;
constexpr float RMS_EPS = 1e-6f, SUBLN_EPS = 1e-5f, LOG2E = 1.4426950408889634f;
constexpr float H8_SCALE = 16.f, W1_SCALE = 64.f, ACT_SCALE = 8.f, W2_SCALE = 32.f;
constexpr float ATT_C2 = 0.125f * LOG2E;

constexpr size_t MiB = 1u << 20;
constexpr size_t WS_CTL = 0, CTL_ZERO_BYTES = 1 * MiB;
constexpr size_t WS_LIST = 1 * MiB;
constexpr size_t WS_PAIRW = 3 * MiB;
constexpr size_t WS_WRF = 3 * MiB + 512 * 1024;
constexpr size_t WS_SINCOS = 4 * MiB;
constexpr size_t WS_SINCOST = 6 * MiB;
constexpr size_t WS_WINT0 = 8 * MiB;
constexpr size_t WS_WOUTT0 = 14 * MiB;
constexpr size_t WS_WRINA = 16 * MiB;
constexpr size_t WS_WRINB = 24 * MiB;
constexpr size_t WS_WROUTT = 30 * MiB;
constexpr size_t WS_W1CAT = 34 * MiB;
constexpr size_t WS_W2T = 98 * MiB;
constexpr size_t WS_DS = 34 * MiB;
constexpr size_t WS_ORET = 34 * MiB;
constexpr size_t WS_HB = 130 * MiB;
constexpr size_t WS_ACTBASE = 162 * MiB;
constexpr size_t WS_QKV0 = WS_ACTBASE;
constexpr size_t WS_OP = WS_ACTBASE + 96 * MiB;
constexpr size_t WS_AO = WS_ACTBASE + 160 * MiB;
constexpr size_t WS_MACT = WS_ACTBASE;
constexpr size_t WS_Y = WS_ACTBASE + 40 * MiB;
constexpr size_t WS_ACAT = WS_ACTBASE;
constexpr size_t WS_BTCAT = WS_ACTBASE + 64 * MiB;
constexpr size_t WS_KI = WS_ACTBASE + 192 * MiB;
constexpr size_t WS_KIT = WS_ACTBASE + 224 * MiB;
constexpr size_t WS_SG = WS_ACTBASE + 256 * MiB;
constexpr size_t WS_END = WS_ACTBASE + 320 * MiB;
constexpr int CW_TMO = 0, CW_BAR = 4096, CW_CNT = 16384;

constexpr int RING_OFF = 0, RING_BYTES = 131072;
constexpr int LX_OFF = RING_BYTES;
constexpr int LX_MISC = LX_OFF + 320;
constexpr int LX_ROWTAB = LX_OFF + 1024;
constexpr int LX_TSTART = LX_OFF + 5120;
constexpr int LX_TEXP = LX_OFF + 5376;
constexpr int LX_LUT = LX_OFF + 6144;
constexpr int LX_CNT = LX_OFF + 7168;
constexpr int LDS_BYTES = 147456;

namespace pg8 {
struct EpiQKV {
    static constexpr bool PERM = true;
    bf16_t* O; float qscale;
    __device__ __forceinline__ void operator()(const f32x4 (&acc)[2][2][4][2], const Unit& u, int wr, int wc, int fr, int fq) const {
        const int row0 = u.pm * BM + wr * 64 + fr, col0 = u.pn * BM + wc * 32 + 8 * fq; const float sc = (u.pn < 4) ? qscale : 1.f;
#pragma unroll
        for (int ai = 0; ai < 2; ++ai)
#pragma unroll
            for (int m = 0; m < 4; ++m) { bf16_t* rowp = O + (size_t)(row0 + ai * HALF + m * 16) * 3072 + col0;
#pragma unroll
                for (int bj = 0; bj < 2; ++bj) *(u32x4*)(rowp + bj * HALF) = pack8(acc[ai][bj][m][0] * sc, acc[ai][bj][m][1] * sc); }
    }
};
struct EpiRes {
    static constexpr bool PERM = false;
    const float* res; float* out;
    __device__ __forceinline__ void operator()(const f32x4 (&acc)[2][2][4][2], const Unit& u, int wr, int wc, int fr, int fq) const {
        const int row0 = u.pm * BM + wr * 64 + fr, col0 = u.pn * BM + wc * 32 + 4 * fq;
#pragma unroll
        for (int ai = 0; ai < 2; ++ai)
#pragma unroll
            for (int m = 0; m < 4; ++m) { const size_t off = (size_t)(row0 + ai * HALF + m * 16) * 1024 + col0;
#pragma unroll
                for (int bj = 0; bj < 2; ++bj)
#pragma unroll
                    for (int n = 0; n < 2; ++n) { const f32x4 r = *(const f32x4*)(res + off + bj * HALF + n * 16); *(f32x4*)(out + off + bj * HALF + n * 16) = r + acc[ai][bj][m][n]; }
                asm volatile("" ::: "memory"); }
    }
};
__device__ __forceinline__ float silu_f(float x) { return x * __builtin_amdgcn_rcpf(1.0f + __builtin_amdgcn_exp2f(-x * LOG2E)); }
__device__ __forceinline__ unsigned pk4_fp8(float a, float b, float c, float d) { int w = 0; w = __builtin_amdgcn_cvt_pk_fp8_f32(a, b, w, false); w = __builtin_amdgcn_cvt_pk_fp8_f32(c, d, w, true); return (unsigned)w; }
struct EpiMoe1 {
    static constexpr bool PERM = true;
    unsigned char* ACT;
    __device__ __forceinline__ void operator()(const f32x4 (&acc)[2][2][4][2], const Unit& u, int wr, int wc, int fr, int fq) const {
        const int row0 = u.pm * BM + wr * 64 + fr, col0 = (u.pn & 3) * 128 + wc * 32 + 8 * fq; constexpr float si = 1.0f / (H8_SCALE * W1_SCALE);
#pragma unroll
        for (int ai = 0; ai < 2; ++ai)
#pragma unroll
            for (int m = 0; m < 4; ++m) { f32x4 a0, a1;
#pragma unroll
                for (int j = 0; j < 4; ++j) { a0[j] = silu_f(acc[ai][0][m][0][j] * si) * acc[ai][1][m][0][j] * (si * ACT_SCALE); a1[j] = silu_f(acc[ai][0][m][1][j] * si) * acc[ai][1][m][1][j] * (si * ACT_SCALE); }
                u32x2 w; w.x = pk4_fp8(a0[0], a0[1], a0[2], a0[3]); w.y = pk4_fp8(a1[0], a1[1], a1[2], a1[3]);
                *(u32x2*)(ACT + (size_t)(row0 + ai * HALF + m * 16) * 512 + col0) = w; }
    }
};
struct EpiMoe2 {
    static constexpr bool PERM = true;
    bf16_t* Y; const int* list; const float* pairw; const LAS int* lcnt;
    __device__ __forceinline__ void operator()(const f32x4 (&acc)[2][2][4][2], const Unit& u, int wr, int wc, int fr, int fq) const {
        const int e = u.pn >> 2, col0 = (u.pn & 3) * BM + wc * 32 + 8 * fq, pos0 = u.aux * BM + wr * 64 + fr, cn = lcnt[e];
#pragma unroll
        for (int ai = 0; ai < 2; ++ai)
#pragma unroll
            for (int m = 0; m < 4; ++m) { const int pos = pos0 + ai * HALF + m * 16;
                if (pos < cn) { const int pair = list[e * LISTCAP + pos]; const float w = pairw[pair] * (1.0f / (ACT_SCALE * W2_SCALE)); bf16_t* rowp = Y + (size_t)pair * 1024 + col0;
#pragma unroll
                    for (int bj = 0; bj < 2; ++bj) *(u32x4*)(rowp + bj * HALF) = pack8(acc[ai][bj][m][0] * w, acc[ai][bj][m][1] * w); } }
    }
};
__device__ __forceinline__ float log2_gamma(int h) { return __builtin_log2f(1.0f - __builtin_amdgcn_exp2f(-5.0f - (float)h)); }
struct EpiRetA {
    static constexpr bool PERM = true;
    bf16_t* ACAT; bf16_t* KI; bf16_t* SG; const float* sincos;
    __device__ __forceinline__ void operator()(const f32x4 (&acc)[2][2][4][2], const Unit& u, int wr, int wc, int fr, int fq) const {
        const int r0 = wr * 64 + fr, c0 = wc * 32 + 8 * fq;
        if (u.pn >= 8) {
#pragma unroll
            for (int ai = 0; ai < 2; ++ai)
#pragma unroll
                for (int m = 0; m < 4; ++m) { bf16_t* rowp = SG + (size_t)(u.pm * BM + r0 + ai * HALF + m * 16) * 2048 + (u.pn - 8) * BM + c0;
#pragma unroll
                    for (int bj = 0; bj < 2; ++bj) { f32x4 a0, a1;
#pragma unroll
                        for (int j = 0; j < 4; ++j) { a0[j] = silu_f(acc[ai][bj][m][0][j]); a1[j] = silu_f(acc[ai][bj][m][1][j]); }
                        *(u32x4*)(rowp + bj * HALF) = pack8(a0, a1); } }
            return;
        }
        const bool isq = u.pn < 4; const int h = u.pn & 3; const float l2g = log2_gamma(h);
        const int b = u.pm >> 3, n = u.pm & 7;
#pragma unroll
        for (int ai = 0; ai < 2; ++ai)
#pragma unroll
            for (int m = 0; m < 4; ++m) { const int r = r0 + ai * HALF + m * 16, pos = n * RC + r;
                const float fac = isq ? __builtin_amdgcn_exp2f((float)(r + 1) * l2g) : 0.0625f * __builtin_amdgcn_exp2f(-(float)(r + 1) * l2g);
                bf16_t* rowp = isq ? ACAT + ((size_t)((b * RH + h) * RNC + n) * RC + r) * 512 + 256 + c0 : KI + (size_t)(u.pm * BM + r) * 1024 + h * RDK + c0;
#pragma unroll
                for (int bj = 0; bj < 2; ++bj) { const f32x4* cs = (const f32x4*)(sincos + ((size_t)pos * 128 + (bj * HALF + c0) / 2) * 2);
                    const f32x4 t0 = cs[0], t1 = cs[1]; const f32x4 x0 = acc[ai][bj][m][0], x1 = acc[ai][bj][m][1]; f32x4 y0, y1;
                    y0[0] = (x0[0] * t0[0] - x0[1] * t0[1]) * fac; y0[1] = (x0[1] * t0[0] + x0[0] * t0[1]) * fac; y0[2] = (x0[2] * t0[2] - x0[3] * t0[3]) * fac; y0[3] = (x0[3] * t0[2] + x0[2] * t0[3]) * fac;
                    y1[0] = (x1[0] * t1[0] - x1[1] * t1[1]) * fac; y1[1] = (x1[1] * t1[0] + x1[0] * t1[1]) * fac; y1[2] = (x1[2] * t1[2] - x1[3] * t1[3]) * fac; y1[3] = (x1[3] * t1[2] + x1[2] * t1[3]) * fac;
                    *(u32x4*)(rowp + bj * HALF) = pack8(y0, y1); } }
    }
};
struct EpiRetB {
    static constexpr bool PERM = true;
    bf16_t* KIT; bf16_t* BTCAT; const float* sincosT;
    __device__ __forceinline__ void operator()(const f32x4 (&acc)[2][2][4][2], const Unit& u, int wr, int wc, int fr, int fq) const {
        const int r0 = wr * 64 + fr, c0 = wc * 32 + 8 * fq; const int b = u.pn >> 3, n = u.pn & 7;
        if (u.pm >= 4) { const int h = (u.pm - 4) >> 1, dv0 = ((u.pm - 4) & 1) * BM;
#pragma unroll
            for (int ai = 0; ai < 2; ++ai)
#pragma unroll
                for (int m = 0; m < 4; ++m) { bf16_t* rowp = BTCAT + ((size_t)((b * RH + h) * RNC + n) * RDV + dv0 + r0 + ai * HALF + m * 16) * 512 + c0;
#pragma unroll
                    for (int bj = 0; bj < 2; ++bj) *(u32x4*)(rowp + bj * HALF) = pack8(acc[ai][bj][m][0], acc[ai][bj][m][1]); }
            return;
        }
        const int h = u.pm; const float l2g = log2_gamma(h);
        float fc[2][8];
#pragma unroll
        for (int bj = 0; bj < 2; ++bj)
#pragma unroll
            for (int j = 0; j < 8; ++j) fc[bj][j] = 0.0625f * __builtin_amdgcn_exp2f(-(float)(bj * HALF + c0 + j + 1) * l2g);
        const bool odd = (fr & 1) != 0;
#pragma unroll
        for (int ai = 0; ai < 2; ++ai)
#pragma unroll
            for (int m = 0; m < 4; ++m) { const int r = r0 + ai * HALF + m * 16;
                bf16_t* rowp = KIT + ((size_t)((b * RH + h) * RDK + r)) * SEQ + n * RC + c0;
#pragma unroll
                for (int bj = 0; bj < 2; ++bj) { const f32x4* cs = (const f32x4*)(sincosT + ((size_t)(r >> 1) * SEQ + n * RC + bj * HALF + c0) * 2);
                    f32x4 y[2];
#pragma unroll
                    for (int nn = 0; nn < 2; ++nn) { const f32x4 ta = cs[nn * 2], tb = cs[nn * 2 + 1]; const f32x4 x = acc[ai][bj][m][nn]; f32x4 xp;
#pragma unroll
                        for (int j = 0; j < 4; ++j) xp[j] = __shfl_xor(x[j], 1);
                        const float cc[4] = {ta[0], ta[2], tb[0], tb[2]}, ss[4] = {ta[1], ta[3], tb[1], tb[3]};
#pragma unroll
                        for (int j = 0; j < 4; ++j) y[nn][j] = (x[j] * cc[j] + (odd ? xp[j] : -xp[j]) * ss[j]) * fc[bj][nn * 4 + j]; }
                    *(u32x4*)(rowp + bj * HALF) = pack8(y[0], y[1]); } }
    }
};
struct EpiScores {
    static constexpr bool PERM = true;
    bf16_t* ACAT;
    __device__ __forceinline__ void operator()(const f32x4 (&acc)[2][2][4][2], const Unit& u, int wr, int wc, int fr, int fq) const {
        const int r0 = wr * 64 + fr, c0 = wc * 32 + 8 * fq;
#pragma unroll
        for (int ai = 0; ai < 2; ++ai)
#pragma unroll
            for (int m = 0; m < 4; ++m) { const int r = r0 + ai * HALF + m * 16; bf16_t* rowp = ACAT + ((size_t)u.pm * RC + r) * 512 + c0;
#pragma unroll
                for (int bj = 0; bj < 2; ++bj) { f32x4 y0 = acc[ai][bj][m][0], y1 = acc[ai][bj][m][1]; const int cb = bj * HALF + c0;
#pragma unroll
                    for (int j = 0; j < 4; ++j) { if (cb + j > r) y0[j] = 0.f; if (cb + 4 + j > r) y1[j] = 0.f; }
                    *(u32x4*)(rowp + bj * HALF) = pack8(y0, y1); } }
    }
};
struct EpiDS {
    static constexpr bool PERM = true;
    bf16_t* DS;
    __device__ __forceinline__ void operator()(const f32x4 (&acc)[2][2][4][2], const Unit& u, int wr, int wc, int fr, int fq) const {
        const int r0 = wr * 64 + fr, c0 = wc * 32 + 8 * fq;
#pragma unroll
        for (int ai = 0; ai < 2; ++ai)
#pragma unroll
            for (int m = 0; m < 4; ++m) { bf16_t* rowp = DS + ((size_t)u.pm * RDV + u.pn * BM + r0 + ai * HALF + m * 16) * RDK + c0;
#pragma unroll
                for (int bj = 0; bj < 2; ++bj) *(u32x4*)(rowp + bj * HALF) = pack8(acc[ai][bj][m][0], acc[ai][bj][m][1]); }
    }
};
struct EpiRetO {
    static constexpr bool PERM = true;
    bf16_t* ORET;
    __device__ __forceinline__ void operator()(const f32x4 (&acc)[2][2][4][2], const Unit& u, int wr, int wc, int fr, int fq) const {
        const int r0 = wr * 64 + fr, c0 = wc * 32 + 8 * fq; const int n = u.pm & 7, h = (u.pm >> 3) & 3, b = u.pm >> 5;
#pragma unroll
        for (int ai = 0; ai < 2; ++ai)
#pragma unroll
            for (int m = 0; m < 4; ++m) { bf16_t* rowp = ORET + ((size_t)(b * SEQ + n * RC + r0 + ai * HALF + m * 16)) * 2048 + h * RDV + u.pn * BM + c0;
#pragma unroll
                for (int bj = 0; bj < 2; ++bj) *(u32x4*)(rowp + bj * HALF) = pack8(acc[ai][bj][m][0], acc[ai][bj][m][1]); }
    }
};
struct ScoresOrder {
    int G, c;
    __device__ bool next(int i, Unit& u) const { const int L = i * G + c; if (L >= NB * RH * RNC) return false; const int n = L & 7, h = (L >> 3) & 3, b = L >> 5;
        u.pm = L; u.pn = 0; u.aux = 0; u.aoff = (long)L * RC * 512 + 256; u.boff = (long)(b * SEQ + n * RC) * 1024 + h * RDK; return true; }
};
struct DsOrder {
    int G, c;
    __device__ bool next(int i, Unit& u) const { const int L = i * G + c; if (L >= NB * RH * 7 * 2) return false; const int dvt = L & 1, q = L >> 1, n = q % 7, bh = q / 7, p = bh * RNC + n;
        u.pm = p; u.pn = dvt; u.aux = 0; u.aoff = ((long)p * RDV + dvt * BM) * 512; u.boff = (long)bh * RDK * SEQ + n * RC; return true; }
};
struct RetOOrder {
    int G, c;
    __device__ bool next(int i, Unit& u) const { const int L = i * G + c; if (L >= NB * RH * RNC * 2) return false; const int dvt = L & 1, p = L >> 1;
        u.pm = p; u.pn = dvt; u.aux = 0; u.aoff = (long)p * RC * 512; u.boff = ((long)p * RDV + dvt * BM) * 512; return true; }
};
struct MoeOrder {
    int G, c, ldb; long a_tile; const LAS int* tstart; const LAS int* texp;
    __device__ bool next(int i, Unit& u) const { const int L = i * G + c; const int ntiles = tstart[33]; if (L >= ntiles * 4) return false; const int rt = L >> 2, pnl = L & 3, e = texp[rt];
        u.pm = rt; u.pn = e * 4 + pnl; u.aux = rt - tstart[e]; u.aoff = (long)rt * a_tile; u.boff = ((long)e * 1024 + pnl * BM) * ldb; return true; }
};
}
namespace attn_body {
using bf16=__hip_bfloat16;
using bf16x8=__attribute__((ext_vector_type(8)))short;
using s16x4=__attribute__((ext_vector_type(4)))short;
using f32x16=__attribute__((ext_vector_type(16)))float;
using u32x4=__attribute__((ext_vector_type(4)))unsigned;
constexpr int D=64,PQ=3072,PO=1024;
constexpr int NW=8,QBLK=32,QB=QBLK*NW,KVBLK=64,NQB=SEQ/QB;
__device__ __forceinline__ int crow(int r,int hi){return (r&3)+8*(r>>2)+4*hi;}
#define SBAR() __builtin_amdgcn_sched_barrier(0)
__device__ __forceinline__ void biasmask(f32x16&p0,f32x16&p1,int jb6,int qrel,int hi,const LAS float*lut){
  const float NEG=-INFINITY; const int base=128+qrel-64*jb6-4*hi;
  #pragma unroll
  for(int g=0;g<4;++g){
    #pragma unroll
    for(int q=0;q<4;++q){const int r=4*g+q; const int rel=base-(q+8*g); const int rel1=rel-32;
      const float b0=lut[rel<0?0:(rel>128?128:rel)], b1=lut[rel1<0?0:(rel1>128?128:rel1)];
      p0[r]=(rel<0)?NEG:p0[r]+b0; p1[r]=(rel1<0)?NEG:p1[r]+b1;}
    asm volatile("":"+v"(p0),"+v"(p1)); __builtin_amdgcn_sched_barrier(0);}
}
constexpr int NSLOT=3, SLOTB=8192;
constexpr int LDS_K=0, LDS_V=NSLOT*SLOTB, LDS_WS=2*NSLOT*SLOTB, LDS_OST=LDS_WS+NW*64*4, LDS_BYTES=LDS_OST+NW*4096;
__device__ __forceinline__ void glds16(const void*gsrc,unsigned lds_dst){unsigned keep;
  asm volatile("s_mov_b32 %0, m0\n\ts_mov_b32 m0, %2\n\ts_nop 0\n\tglobal_load_lds_dwordx4 %1, off\n\ts_mov_b32 m0, %0":"=&s"(keep):"v"(gsrc),"s"(lds_dst):"memory");}
__device__ __forceinline__ float max3f(float a,float b,float c){float r;asm("v_max3_f32 %0, %1, %2, %3":"=v"(r):"v"(a),"v"(b),"v"(c));return r;}
__device__ __forceinline__ float max2f(float a,float b){float r;asm("v_max_f32_e32 %0, %1, %2":"=v"(r):"v"(a),"v"(b));return r;}
__device__ __forceinline__ float fadd_s(float a,float b){float r;asm("v_add_f32_e32 %0, %1, %2":"=v"(r):"v"(a),"v"(b));return r;}
__device__ __forceinline__ float fsub_s(float a,float b){float r;asm("v_sub_f32_e32 %0, %1, %2":"=v"(r):"v"(a),"v"(b));return r;}
typedef float f32x2_t __attribute__((ext_vector_type(2))); typedef __bf16 bf16x2_t __attribute__((ext_vector_type(2)));
__device__ __forceinline__ unsigned cvtpk_s(float lo,float hi){f32x2_t v={lo,hi};bf16x2_t b=__builtin_convertvector(v,bf16x2_t);return __builtin_bit_cast(unsigned,b);}
#define WAIT_BAR(N) asm volatile("s_waitcnt vmcnt(" #N ") lgkmcnt(0)\n\ts_barrier":::"memory")

__device__ __forceinline__ void qkt(f32x16&p0,f32x16&p1,const char*Kslot,const bf16x8*qr,const f32x16&negm,int r32,int hi){
  const char*kb=Kslot+hi*1024+r32*16;
  #pragma unroll
  for(int d0=0;d0<4;++d0){
    const bf16x8 b0=*reinterpret_cast<const bf16x8*>(kb+d0*2048);
    const bf16x8 b1=*reinterpret_cast<const bf16x8*>(kb+d0*2048+512);
    if(d0==0){p0=__builtin_amdgcn_mfma_f32_32x32x16_bf16(b0,qr[0],negm,0,0,0);p1=__builtin_amdgcn_mfma_f32_32x32x16_bf16(b1,qr[0],negm,0,0,0);}
    else{p0=__builtin_amdgcn_mfma_f32_32x32x16_bf16(b0,qr[d0],p0,0,0,0);p1=__builtin_amdgcn_mfma_f32_32x32x16_bf16(b1,qr[d0],p1,0,0,0);}}
}
typedef LAS const char* lds_cptr;
typedef short v4i16_t __attribute__((ext_vector_type(4)));
__device__ __forceinline__ void kload8(bf16x8*kf,lds_cptr kp){
  kf[0]=*(const LAS bf16x8*)(kp);      kf[1]=*(const LAS bf16x8*)(kp+512);
  kf[2]=*(const LAS bf16x8*)(kp+2048); kf[3]=*(const LAS bf16x8*)(kp+2560);
  kf[4]=*(const LAS bf16x8*)(kp+4096); kf[5]=*(const LAS bf16x8*)(kp+4608);
  kf[6]=*(const LAS bf16x8*)(kp+6144); kf[7]=*(const LAS bf16x8*)(kp+6656);
}
__device__ __forceinline__ void kload2(bf16x8*kf,lds_cptr kp,int j){ kf[2*j]=*(const LAS bf16x8*)(kp+j*2048); kf[2*j+1]=*(const LAS bf16x8*)(kp+j*2048+512); }
__device__ __forceinline__ s16x4 vtr(lds_cptr p){ return __builtin_bit_cast(s16x4,__builtin_amdgcn_ds_read_tr16_b64_v4i16((LAS v4i16_t*)p)); }
__device__ __forceinline__ float rowmax(const f32x16&p0,const f32x16&p1){
  float a=max3f(p0[0],p0[1],p1[0]),b=max3f(p0[2],p0[3],p1[1]);a=max3f(a,p1[2],p1[3]);
  #pragma unroll
  for(int r=4;r<16;r+=4){a=max3f(a,p0[r],p0[r+1]);b=max3f(b,p0[r+2],p0[r+3]);a=max3f(a,p1[r],p1[r+1]);b=max3f(b,p1[r+2],p1[r+3]);}
  const float m=max2f(a,b);
  auto rr=__builtin_amdgcn_permlane32_swap(__float_as_uint(m),__float_as_uint(m),false,false);
  return max2f(__uint_as_float(rr[0]),__uint_as_float(rr[1]));
}
__device__ __forceinline__ void pv(f32x16*o,int vb,bf16x8 pa0,bf16x8 pa1,bf16x8 pa2,bf16x8 pa3){
  #pragma unroll
  for(int d0=0;d0<2;++d0){s16x4 lo[4],hi[4];
    #pragma unroll
    for(int ks=0;ks<4;++ks){
      asm volatile("ds_read_b64_tr_b16 %0,%1 offset:%c2":"=&v"(lo[ks]):"v"(vb),"i"(d0*4096+ks*1024):"memory");
      asm volatile("ds_read_b64_tr_b16 %0,%1 offset:%c2":"=&v"(hi[ks]):"v"(vb),"i"(d0*4096+ks*1024+512):"memory");}
    asm volatile("s_waitcnt lgkmcnt(0)":::"memory");SBAR();
    #define PK(k) (bf16x8){lo[k][0],lo[k][1],lo[k][2],lo[k][3],hi[k][0],hi[k][1],hi[k][2],hi[k][3]}
    o[d0]=__builtin_amdgcn_mfma_f32_32x32x16_bf16(pa0,PK(0),o[d0],0,0,0);
    o[d0]=__builtin_amdgcn_mfma_f32_32x32x16_bf16(pa1,PK(1),o[d0],0,0,0);
    o[d0]=__builtin_amdgcn_mfma_f32_32x32x16_bf16(pa2,PK(2),o[d0],0,0,0);
    o[d0]=__builtin_amdgcn_mfma_f32_32x32x16_bf16(pa3,PK(3),o[d0],0,0,0);
    #undef PK
  }
}
template<int THRL> __device__ __forceinline__ void attn_unit(int b,int qb,const bf16*QKV,int Qc,int Kc,int Vc,bf16*O,const LAS float*lut,char*shm){
  int tid_=threadIdx.x; asm volatile("":"+v"(tid_)); const int tid=tid_,lane=tid&63,r32=lane&31,hi=lane>>5; const int wid=__builtin_amdgcn_readfirstlane(tid>>6);
  const long rowbase=(long)b*SEQ; const int q0=qb*QB;
  const bf16*Qw=QKV+(rowbase+q0+wid*QBLK)*PQ+Qc;
  const bf16*Kh=QKV+rowbase*PQ+Kc,*Vh=QKV+rowbase*PQ+Vc;
  const unsigned lds0=(unsigned)(uintptr_t)shm;
  float*wsf=(float*)(shm+LDS_WS)+wid*64;
  const bf16*ksrc=Kh+(long)lane*PQ+wid*8;
  const bf16*vsrc=Vh+(long)(16*(wid&3)+(lane>>2))*PQ+(wid>>2)*32+(lane&3)*8;
  const unsigned kdst=lds0+LDS_K+wid*1024, vdst=lds0+LDS_V+wid*1024;
  #define DMA_K(t,slot) glds16(ksrc+(long)(t)*KVBLK*PQ,(unsigned)__builtin_amdgcn_readfirstlane(kdst+(slot)))
  #define DMA_V(t,slot) glds16(vsrc+(long)(t)*KVBLK*PQ,(unsigned)__builtin_amdgcn_readfirstlane(vdst+(slot)))
  const int vb0=(int)(lds0+LDS_V)+((lane>>4)&1)*32+(lane&3)*8+(4*hi+((lane&15)>>2))*64;
  const char*Kbase=shm+LDS_K; bf16x8 kf[8];
  const lds_cptr shm3=(lds_cptr)shm; const lds_cptr kp0=shm3+LDS_K+hi*1024+r32*16; const lds_cptr vp0=shm3+LDS_V+((lane>>4)&1)*32+(lane&3)*8+(4*hi+((lane&15)>>2))*64;
  const int NT=(q0+QB)/KVBLK;
  DMA_K(0,0);DMA_V(0,0);DMA_K(1,SLOTB);
  bf16x8 qr[4];
  #pragma unroll
  for(int d0=0;d0<4;++d0)qr[d0]=*reinterpret_cast<const bf16x8*>(&Qw[(long)r32*PQ+d0*16+hi*8]);
  float mhat=0.f,l_reg=0.f;f32x16 o[2];f32x16 negm; { float zz; asm volatile("v_mov_b32 %0, 0":"=v"(zz)); _Pragma("unroll") for(int r=0;r<16;++r){o[0][r]=zz;o[1][r]=zz;negm[r]=zz;} } asm volatile("":"+v"(negm));
  const int qrel=wid*QBLK+r32;
  #define CMASK(P0,P1,t) do{int jb_=(t)-(NT-6); if(jb_>=0)biasmask(P0,P1,jb_,qrel,hi,lut);}while(0)
  bool resc=false;
  #define START(P0,P1) do{ const float rm=rowmax(P0,P1); resc=false; \
    { const float dl=rm; mhat=fadd_s(mhat,dl); \
      _Pragma("unroll") for(int r=0;r<16;++r){P0[r]=fsub_s(P0[r],dl);P1[r]=fsub_s(P1[r],dl);} \
      _Pragma("unroll") for(int r=0;r<16;++r)negm[r]=-mhat; asm volatile("":"+v"(negm)); } \
    _Pragma("unroll") for(int r=0;r<16;++r)P0[r]=__builtin_amdgcn_exp2f(P0[r]); }while(0)
  #define RESC() do{ if(resc){ asm volatile("s_waitcnt lgkmcnt(0)":::"memory"); \
      _Pragma("unroll") for(int d_=0;d_<2;++d_) _Pragma("unroll") for(int r=0;r<16;++r)o[d_][r]*=wsf[crow(r,hi)]; } }while(0)
  f32x16 pA0,pA1,pB0,pB1;
  int sl_prev=0,sl_cur=0,sl_next=SLOTB;
  #define ROT() do{sl_prev=sl_cur;sl_cur=sl_next;sl_next=(sl_next==(NSLOT-1)*SLOTB)?0:sl_next+SLOTB;}while(0)
  DMA_K(2,2*SLOTB);
  WAIT_BAR(3);
  qkt(pA0,pA1,Kbase,qr,negm,r32,hi);asm volatile("s_nop 15\n\ts_nop 7":"+v"(pA0),"+v"(pA1));CMASK(pA0,pA1,0);
  START(pA0,pA1);
  _Pragma("unroll") for(int r=0;r<16;++r)pA1[r]=__builtin_amdgcn_exp2f(pA1[r]);
  WAIT_BAR(0);
  DMA_K(3,0);DMA_V(1,SLOTB);
  ROT();
  kload8(kf,kp0+sl_cur);
  WAIT_BAR(2);
  s16x4 vlo[8],vhi[8]; u32x4 pw0,pw1,pw2,pw3;
  #define PKW(P,B) cvtpk_s(P[B],P[B+1])
  #define PAF(k) __builtin_bit_cast(bf16x8,pw##k)
  #define VFR(i) (bf16x8){vlo[i][0],vlo[i][1],vlo[i][2],vlo[i][3],vhi[i][0],vhi[i][1],vhi[i][2],vhi[i][3]}
  #define PIN(x) asm volatile("":"+v"(x))
  #define MX3(a,b,c) __builtin_fmaxf(__builtin_fmaxf((a),(b)),(c))
  #define GAPA(MF,A0,A1,A2,A3,W0,W1,PW) do{ MF; sacc+=A0; sacc+=A1; sacc+=A2; sacc+=A3; PIN(sacc); W0; W1; PIN(PW); SBAR(); }while(0)
  #define EX(v) __builtin_amdgcn_exp2f(v)
  #define GAPB(MF,X,B) do{ MF; X[B]=EX(X[B]); X[B+1]=EX(X[B+1]); X[B+2]=EX(X[B+2]); X[B+3]=EX(X[B+3]); PIN(X); SBAR(); }while(0)
  #define VRD(i) do{ vlo[i]=vtr(vp_+(((i)>>2)*4096+((i)&3)*1024)); vhi[i]=vtr(vp_+(((i)>>2)*4096+((i)&3)*1024+512)); }while(0)
  #define KRD(G,j) do{ if(G){ kload2(kf,kp0+sl_next,j); SBAR(); } }while(0)
  #define STEP(C0,C1,P0,P1,t,GK,GV,GL) do{ SBAR(); \
    const lds_cptr vp_=vp0+sl_prev; \
    VRD(0); SBAR(); float sacc=(P0[0]+P0[1]); \
    GAPA(C0=__builtin_amdgcn_mfma_f32_32x32x16_bf16(kf[0],qr[0],negm,0,0,0), P0[2],P0[3],P0[4],P0[5],     pw0[0]=PKW(P0,0), pw0[1]=PKW(P0,2), pw0); \
    VRD(4); SBAR(); GAPA(C1=__builtin_amdgcn_mfma_f32_32x32x16_bf16(kf[1],qr[0],negm,0,0,0), P0[6],P0[7],P0[8],P0[9],     pw0[2]=PKW(P0,4), pw0[3]=PKW(P0,6), pw0); \
    VRD(1); SBAR(); GAPA(C0=__builtin_amdgcn_mfma_f32_32x32x16_bf16(kf[2],qr[1],C0,0,0,0),   P0[10],P0[11],P0[12],P0[13], pw1[0]=PKW(P0,8), pw1[1]=PKW(P0,10), pw1); \
    VRD(5); SBAR(); GAPA(C1=__builtin_amdgcn_mfma_f32_32x32x16_bf16(kf[3],qr[1],C1,0,0,0),   P0[14],P0[15],P1[0],P1[1],   pw1[2]=PKW(P0,12),pw1[3]=PKW(P0,14), pw1); \
    VRD(2); SBAR(); GAPA(C0=__builtin_amdgcn_mfma_f32_32x32x16_bf16(kf[4],qr[2],C0,0,0,0),   P1[2],P1[3],P1[4],P1[5],     pw2[0]=PKW(P1,0), pw2[1]=PKW(P1,2), pw2); \
    VRD(6); SBAR(); GAPA(C1=__builtin_amdgcn_mfma_f32_32x32x16_bf16(kf[5],qr[2],C1,0,0,0),   P1[6],P1[7],P1[8],P1[9],     pw2[2]=PKW(P1,4), pw2[3]=PKW(P1,6), pw2); \
    VRD(3); SBAR(); GAPA(C0=__builtin_amdgcn_mfma_f32_32x32x16_bf16(kf[6],qr[3],C0,0,0,0),   P1[10],P1[11],P1[12],P1[13], pw3[0]=PKW(P1,8), pw3[1]=PKW(P1,10), pw3); \
    VRD(7); SBAR(); GAPA(C1=__builtin_amdgcn_mfma_f32_32x32x16_bf16(kf[7],qr[3],C1,0,0,0),   P1[14],P1[15],0.f,0.f,       pw3[2]=PKW(P1,12),pw3[3]=PKW(P1,14), pw3); \
    l_reg+=sacc; \
    if(GK){DMA_K((t)+3,sl_cur);} if(GV){DMA_V((t)+1,sl_next);} \
    CMASK(C0,C1,t); \
    { float a=MX3(C0[0],C0[1],C1[0]),b=MX3(C0[2],C0[3],C1[1]); a=MX3(a,C1[2],C1[3]); \
      _Pragma("unroll") for(int r=4;r<16;r+=4){a=MX3(a,C0[r],C0[r+1]);b=MX3(b,C0[r+2],C0[r+3]);a=MX3(a,C1[r],C1[r+1]);b=MX3(b,C1[r+2],C1[r+3]);} \
      float rm=__builtin_fmaxf(a,b); { auto rr=__builtin_amdgcn_permlane32_swap(__float_as_uint(rm),__float_as_uint(rm),false,false); rm=__builtin_fmaxf(__uint_as_float(rr[0]),__uint_as_float(rr[1])); } \
      resc=false; \
      if(__builtin_expect(__any(rm>(float)THRL),0)){ const float dl=__builtin_fmaxf(rm,0.f); mhat+=dl; \
        _Pragma("unroll") for(int r=0;r<16;++r){C0[r]-=dl;C1[r]-=dl;} \
        _Pragma("unroll") for(int r=0;r<16;++r)negm[r]=-mhat; asm volatile("":"+v"(negm)); \
        const float f=__builtin_amdgcn_exp2f(-dl); l_reg*=f; if(hi==0)wsf[r32]=f; resc=true; } } \
    SBAR(); \
    GAPB(o[0]=__builtin_amdgcn_mfma_f32_32x32x16_bf16(PAF(0),VFR(0),o[0],0,0,0), C0,0); \
    GAPB(o[1]=__builtin_amdgcn_mfma_f32_32x32x16_bf16(PAF(0),VFR(4),o[1],0,0,0), C0,4); \
    KRD(GL,0); GAPB(o[0]=__builtin_amdgcn_mfma_f32_32x32x16_bf16(PAF(1),VFR(1),o[0],0,0,0), C0,8); \
    KRD(GL,1); GAPB(o[1]=__builtin_amdgcn_mfma_f32_32x32x16_bf16(PAF(1),VFR(5),o[1],0,0,0), C0,12); \
    KRD(GL,2); GAPB(o[0]=__builtin_amdgcn_mfma_f32_32x32x16_bf16(PAF(2),VFR(2),o[0],0,0,0), C1,0); \
    KRD(GL,3); GAPB(o[1]=__builtin_amdgcn_mfma_f32_32x32x16_bf16(PAF(2),VFR(6),o[1],0,0,0), C1,4); \
    GAPB(o[0]=__builtin_amdgcn_mfma_f32_32x32x16_bf16(PAF(3),VFR(3),o[0],0,0,0), C1,8); \
    GAPB(o[1]=__builtin_amdgcn_mfma_f32_32x32x16_bf16(PAF(3),VFR(7),o[1],0,0,0), C1,12); \
    }while(0)
  int t=1;
  #undef CMASK
  #define CMASK(P0,P1,t) do{}while(0)
  for(;t+7<NT;t+=2){
    STEP(pB0,pB1,pA0,pA1,t,true,true,true);     WAIT_BAR(2); RESC(); ROT();
    STEP(pA0,pA1,pB0,pB1,t+1,true,true,true);   WAIT_BAR(2); RESC(); ROT();
  }
  #undef CMASK
  #define CMASK(P0,P1,t) do{int jb_=(t)-(NT-6); if(jb_>=0)biasmask(P0,P1,jb_,qrel,hi,lut);}while(0)
  #define ENDW(tt) do{ if((tt)+3<NT){WAIT_BAR(2);} else if((tt)+2<NT){WAIT_BAR(1);} else {WAIT_BAR(0);} }while(0)
  for(;t+1<NT;t+=2){
    STEP(pB0,pB1,pA0,pA1,t,(t+3<NT),(t+1<NT),(t+1<NT));       ENDW(t);   RESC(); ROT();
    STEP(pA0,pA1,pB0,pB1,t+1,(t+4<NT),(t+2<NT),(t+2<NT));     ENDW(t+1); RESC(); ROT();
  }
  STEP(pB0,pB1,pA0,pA1,NT-1,false,false,false); RESC();
  { float sacc=pB0[0]+pB0[1]; _Pragma("unroll") for(int r=2;r<16;++r)sacc+=pB0[r]; _Pragma("unroll") for(int r=0;r<16;++r)sacc+=pB1[r]; l_reg+=sacc;
    pw0=(u32x4){PKW(pB0,0),PKW(pB0,2),PKW(pB0,4),PKW(pB0,6)};pw1=(u32x4){PKW(pB0,8),PKW(pB0,10),PKW(pB0,12),PKW(pB0,14)};pw2=(u32x4){PKW(pB1,0),PKW(pB1,2),PKW(pB1,4),PKW(pB1,6)};pw3=(u32x4){PKW(pB1,8),PKW(pB1,10),PKW(pB1,12),PKW(pB1,14)};
    SBAR(); pv(o,vb0+sl_cur,PAF(0),PAF(1),PAF(2),PAF(3)); }
  #undef PKW
  #undef PAF
  #undef VFR
  #undef PIN
  #undef MX3
  #undef GAPA
  #undef GAPB
  #undef EX
  #undef VRD
  #undef KRD
  #undef STEP
  #undef ENDW
  {auto rr=__builtin_amdgcn_permlane32_swap(__float_as_uint(l_reg),__float_as_uint(l_reg),false,false);l_reg=__uint_as_float(rr[0])+__uint_as_float(rr[1]);}
  if(hi==0)wsf[32+r32]=l_reg;asm volatile("s_waitcnt lgkmcnt(0)":::"memory");
  float rli[16];
  #pragma unroll
  for(int r=0;r<16;++r)rli[r]=__builtin_amdgcn_rcpf(wsf[32+crow(r,hi)]);
  bf16*Ow=O+(rowbase+q0+wid*QBLK)*PO;
  { bf16*stg=(bf16*)(shm+LDS_OST)+wid*2048;
    #pragma unroll
    for(int r=0;r<16;++r){const int orow=crow(r,hi);
      #pragma unroll
      for(int d0=0;d0<2;++d0)stg[orow*64+d0*32+r32]=__float2bfloat16(o[d0][r]*rli[r]);}
    asm volatile("s_waitcnt lgkmcnt(0)":::"memory");
    #pragma unroll
    for(int i=0;i<4;++i){const int row=i*8+(lane>>3),ch=lane&7; const u32x4 v=*(const u32x4*)(stg+row*64+ch*8); *(u32x4*)(Ow+(long)row*PO+ch*8)=v;} }
  asm volatile("s_waitcnt lgkmcnt(0)\n\ts_barrier":::"memory");
  #undef DMA_K
  #undef DMA_V
  #undef CMASK
  #undef START
  #undef RESC
  #undef ROT
}
constexpr int ATTN_LDS_BYTES=LDS_BYTES;
#undef SBAR
#undef WAIT_BAR
}
constexpr int NWAVES = 8;
typedef unsigned short bf16;
typedef unsigned v4u __attribute__((ext_vector_type(4)));
typedef unsigned v2u __attribute__((ext_vector_type(2)));
typedef float f32x4 __attribute__((ext_vector_type(4)));
typedef float f32x2 __attribute__((ext_vector_type(2)));
typedef short bf16x8 __attribute__((ext_vector_type(8)));
typedef GAS unsigned gu32;
#define RLX_AGENT __ATOMIC_RELAXED, __HIP_MEMORY_SCOPE_AGENT
#define LDS_WAIT() asm volatile("s_waitcnt lgkmcnt(0)" ::: "memory")
#define VM_WAIT() asm volatile("s_waitcnt vmcnt(0)" ::: "memory")
__device__ __forceinline__ unsigned f2bf(float f) { unsigned u = __builtin_bit_cast(unsigned, f); return (u + 0x7fffu + ((u >> 16) & 1u)) >> 16; }
__device__ __forceinline__ unsigned pk2(float lo, float hi) { return f2bf(lo) | (f2bf(hi) << 16); }
__device__ __forceinline__ float bf2f(unsigned short b) { return __builtin_bit_cast(float, (unsigned)b << 16); }
__device__ __forceinline__ float bflo(unsigned w) { return __builtin_bit_cast(float, w << 16); }
__device__ __forceinline__ float bfhi(unsigned w) { return __builtin_bit_cast(float, w & 0xffff0000u); }

#define XB_TMO      128
#define XB_XCNT(j)  (256  + 64 * (j))
#define XB_XSUB(j)  (1280 + 64 * (j))
#define XB_XGEN(j)  (2304 + 64 * (j))
#define XB_TOP      3328
#define XB_TOPGEN   3392
#define XCD_BAR_WORDS 3456
#define XB_SPIN_CAP (1u << 18)
__device__ __forceinline__ unsigned xb_ld(unsigned* p)              { return __hip_atomic_load(p, __ATOMIC_RELAXED, __HIP_MEMORY_SCOPE_AGENT); }
__device__ __forceinline__ unsigned xb_add(unsigned* p, unsigned v) { return __hip_atomic_fetch_add(p, v, __ATOMIC_RELAXED, __HIP_MEMORY_SCOPE_AGENT); }
__device__ __forceinline__ unsigned xb_xcc_id() { return (unsigned)__builtin_amdgcn_s_getreg((3 << 11) | 20) & 0xFu; }
#define XB_SPIN(cond, bar) do { unsigned _sp = 0; while (cond) { __builtin_amdgcn_s_sleep(1); \
    if ((++_sp & 255u) == 0u) { if (xb_ld(&(bar)[XB_TMO])) break; if (_sp > XB_SPIN_CAP) { atomicAdd(&(bar)[XB_TMO], 1u); break; } } } } while (0)
struct XcdBarrier { unsigned* bar; unsigned x; volatile LAS unsigned* st; };
__device__ __forceinline__ XcdBarrier xcd_barrier_post(unsigned* bar, volatile LAS unsigned* st) {
    XcdBarrier b; b.bar = bar; b.x = xb_xcc_id(); b.st = st;
    if (threadIdx.x == 0) (void)xb_add(&bar[XB_XCNT(b.x)], 1u);
    return b;
}
__device__ __forceinline__ void xcd_barrier_complete(unsigned* bar, unsigned x, unsigned& nloc, unsigned& nx) {
    const unsigned G = gridDim.x * gridDim.y * gridDim.z;
    unsigned sum, cnt, mine, sp = 0u;
    for (;;) {
        sum = 0u; cnt = 0u; mine = 0u;
#pragma unroll
        for (unsigned j = 0; j < 16; ++j) { const unsigned c = xb_ld(&bar[XB_XCNT(j)]); sum += c; cnt += (c > 0u) ? 1u : 0u; mine = (j == x) ? c : mine; }
        if (sum == G) break;
        __builtin_amdgcn_s_sleep(1);
        if ((++sp & 255u) == 0u) { if (xb_ld(&bar[XB_TMO])) break; if (sp > XB_SPIN_CAP) { atomicAdd(&bar[XB_TMO], 1u); break; } }
    }
    nloc = mine > 0u ? mine : 1u; nx = cnt > 0u ? cnt : 1u;
}
__device__ __forceinline__ void xcd_barrier(const XcdBarrier& b) {
    asm volatile("s_waitcnt vmcnt(0)" ::: "memory");
    __syncthreads();
    if (threadIdx.x == 0) {
        unsigned* bar = b.bar;
        __builtin_amdgcn_s_waitcnt(0);
        unsigned nloc = b.st[0], nx = b.st[1];
        if (nloc == 0u) { xcd_barrier_complete(bar, b.x, nloc, nx); b.st[0] = nloc; b.st[1] = nx; }
        const unsigned old = xb_add(&bar[XB_XSUB(b.x)], 1u);
        const unsigned gen = old / nloc;
        if (old + 1u == (gen + 1u) * nloc) {
            __builtin_amdgcn_fence(__ATOMIC_RELEASE, "agent");
            asm volatile("s_waitcnt vmcnt(0)" ::: "memory");
            const unsigned og = xb_add(&bar[XB_TOP], 1u);
            const unsigned tg = og / nx;
            if (og + 1u == (tg + 1u) * nx) xb_add(&bar[XB_TOPGEN], 1u);
            else XB_SPIN(xb_ld(&bar[XB_TOPGEN]) == tg, bar);
            __builtin_amdgcn_fence(__ATOMIC_ACQUIRE, "agent");
            xb_add(&bar[XB_XGEN(b.x)], 1u);
            asm volatile("s_waitcnt vmcnt(0)" ::: "memory");
        } else {
            XB_SPIN(xb_ld(&bar[XB_XGEN(b.x)]) == gen, bar);
            __builtin_amdgcn_fence(__ATOMIC_ACQUIRE, "agent");
            asm volatile("s_waitcnt vmcnt(0)" ::: "memory");
        }
    }
    __syncthreads();
}

struct Args { const float* in[18]; float* out; unsigned char* ws; int ph_lo, ph_hi, li, pad; };
struct Frame {
    LAS unsigned char* lds;
    gu32* ctl;
    unsigned char* ws;
    int tid, lane, wave;
    int vcu, G;
};

__device__ __forceinline__ float wave_sum(float v) {
#pragma unroll
    for (int o = 1; o < 64; o <<= 1) v += __shfl_xor(v, o);
    return v;
}
__device__ __forceinline__ void transpose_block(const float* src, int ld_src, bf16* dst, int ld_dst, LAS float* scr, int lane, bf16* dst2) {
#pragma unroll 8
    for (int i = 0; i < 32; ++i) { const int kk = 2 * i + (lane >> 5); scr[kk * 33 + (lane & 31)] = src[(size_t)kk * ld_src + (lane & 31)]; }
    LDS_WAIT(); asm volatile("" ::: "memory");
    const int c = lane & 7;
#pragma unroll
    for (int j = 0; j < 4; ++j) { const int n = (lane >> 3) + 8 * j; const LAS float* s = scr + (8 * c) * 33 + n;
        v4u o; o.x = pk2(s[0 * 33], s[1 * 33]); o.y = pk2(s[2 * 33], s[3 * 33]); o.z = pk2(s[4 * 33], s[5 * 33]); o.w = pk2(s[6 * 33], s[7 * 33]);
        *(GAS v4u*)(dst + (size_t)n * ld_dst + 8 * c) = o;
        if (dst2) *(GAS v4u*)(dst2 + (size_t)n * ld_dst + 8 * c) = o; }
    LDS_WAIT(); asm volatile("" ::: "memory");
}
__device__ __forceinline__ unsigned pk4_fp8f(float a, float b, float c, float d) { int w = 0; w = __builtin_amdgcn_cvt_pk_fp8_f32(a, b, w, false); w = __builtin_amdgcn_cvt_pk_fp8_f32(c, d, w, true); return (unsigned)w; }
__device__ __forceinline__ void transpose_block8(const float* src, int ld_src, unsigned char* dst, int ld_dst, float sc, LAS float* scr, int lane) {
#pragma unroll 8
    for (int i = 0; i < 32; ++i) { const int kk = 2 * i + (lane >> 5); scr[kk * 33 + (lane & 31)] = src[(size_t)kk * ld_src + (lane & 31)]; }
    LDS_WAIT(); asm volatile("" ::: "memory");
    const int c = lane & 7;
#pragma unroll
    for (int j = 0; j < 4; ++j) { const int n = (lane >> 3) + 8 * j; const LAS float* s = scr + (8 * c) * 33 + n;
        v2u o; o.x = pk4_fp8f(s[0 * 33] * sc, s[1 * 33] * sc, s[2 * 33] * sc, s[3 * 33] * sc); o.y = pk4_fp8f(s[4 * 33] * sc, s[5 * 33] * sc, s[6 * 33] * sc, s[7 * 33] * sc);
        *(GAS v2u*)(dst + (size_t)n * ld_dst + 8 * c) = o; }
    LDS_WAIT(); asm volatile("" ::: "memory");
}
__device__ __forceinline__ void rms_row_to_bf16(int lane, const float* xrow, const float* g, bf16* orow) {
    const GAS f32x4* xr = (const GAS f32x4*)xrow + lane; const GAS f32x4* gr = (const GAS f32x4*)g + lane;
    f32x4 v[4]; float s = 0.f;
#pragma unroll
    for (int j = 0; j < 4; ++j) { v[j] = xr[64 * j]; s += (v[j].x * v[j].x + v[j].y * v[j].y) + (v[j].z * v[j].z + v[j].w * v[j].w); }
    const float rstd = 1.0f / sqrtf(wave_sum(s) * (1.f / 1024.f) + RMS_EPS);
    GAS v2u* o8 = (GAS v2u*)orow + lane;
#pragma unroll
    for (int j = 0; j < 4; ++j) { const f32x4 gg = gr[64 * j]; v2u o; o.x = pk2(v[j].x * rstd * gg.x, v[j].y * rstd * gg.y); o.y = pk2(v[j].z * rstd * gg.z, v[j].w * rstd * gg.w); o8[64 * j] = o; }
}

constexpr int IT_WIN0 = (1024 / 64) * (3072 / 32);
constexpr int IT_WOUT0 = (1024 / 64) * (1024 / 32);
constexpr int IT_RIN = (1024 / 64) * (6144 / 32);
constexpr int IT_ROUT = (2048 / 64) * (1024 / 32);
constexpr int IT_SHARED = IT_WIN0 + IT_WOUT0 + IT_RIN + IT_ROUT;
constexpr int IT_EXP = 3 * 256;
constexpr int IT_MOE = NEXP * IT_EXP;
__device__ __forceinline__ void conv_shared_item(Frame& F, const Args& a, int it, LAS float* scr) {
    unsigned char* ws = F.ws;
    if (it < IT_WIN0) { const int nblk = 96, kb = it / nblk, nb = it % nblk;
        transpose_block(a.in[5] + (size_t)(64 * kb) * 3072 + 32 * nb, 3072, (bf16*)(ws + WS_WINT0) + (size_t)(32 * nb) * 1024 + 64 * kb, 1024, scr, F.lane, nullptr); return; }
    it -= IT_WIN0;
    if (it < IT_WOUT0) { const int nblk = 32, kb = it / nblk, nb = it % nblk;
        transpose_block(a.in[8] + (size_t)(64 * kb) * 1024 + 32 * nb, 1024, (bf16*)(ws + WS_WOUTT0) + (size_t)(32 * nb) * 1024 + 64 * kb, 1024, scr, F.lane, nullptr); return; }
    it -= IT_WOUT0;
    if (it < IT_RIN) { const int nblk = 192, kb = it / nblk, nb = it % nblk, n0 = 32 * nb;
        bf16* A = (bf16*)(ws + WS_WRINA); bf16* B = (bf16*)(ws + WS_WRINB); bf16 *d1, *d2 = nullptr;
        if (n0 < 1024) d1 = A + (size_t)n0 * 1024;
        else if (n0 < 2048) { d1 = A + (size_t)n0 * 1024; d2 = B + (size_t)(n0 - 1024) * 1024; }
        else if (n0 < 4096) d1 = B + (size_t)(n0 - 1024) * 1024;
        else d1 = A + (size_t)(n0 - 2048) * 1024;
        transpose_block(a.in[9] + (size_t)(64 * kb) * 6144 + n0, 6144, d1 + 64 * kb, 1024, scr, F.lane, d2 ? d2 + 64 * kb : nullptr); return; }
    it -= IT_RIN;
    { const int nblk = 32, kb = it / nblk, nb = it % nblk;
        transpose_block(a.in[10] + (size_t)(64 * kb) * 1024 + 32 * nb, 1024, (bf16*)(ws + WS_WROUTT) + (size_t)(32 * nb) * 2048 + 64 * kb, 2048, scr, F.lane, nullptr); }
}
__device__ __forceinline__ void conv_moe_item(Frame& F, const Args& a, int layer, int it, LAS float* scr) {
    unsigned char* ws = F.ws;
    const int e = it / IT_EXP; int r = it % IT_EXP; const size_t le = (size_t)layer * NEXP + e;
    if (r < 512) { const int up = r >> 8; r &= 255; const int kb = r / 16, nb = r % 16, n0 = 32 * nb;
        const float* src = a.in[up ? 16 : 15] + le * (1024 * 512) + (size_t)(64 * kb) * 512 + n0;
        const int drow = 256 * (n0 >> 7) + 128 * up + (n0 & 127);
        transpose_block8(src, 512, ws + WS_W1CAT + ((size_t)e * 1024 + drow) * 1024 + 64 * kb, 1024, W1_SCALE, scr, F.lane); return; }
    r -= 512; { const int kb = r / 32, nb = r % 32;
        const float* src = a.in[17] + le * (512 * 1024) + (size_t)(64 * kb) * 1024 + 32 * nb;
        transpose_block8(src, 1024, ws + WS_W2T + ((size_t)e * 1024 + 32 * nb) * 512 + 64 * kb, 512, W2_SCALE, scr, F.lane); }
}
__device__ __forceinline__ void build_router_frags(Frame& F, const Args& a, int gtid, int gthreads) {
    bf16* wrf = (bf16*)(F.ws + WS_WRF);
    for (int idx = gtid; idx < 2 * 32 * 3 * 64 * 8; idx += gthreads) {
        const int j = idx & 7, lane = (idx >> 3) & 63, nt = (idx >> 9) % 3, s = ((idx >> 9) / 3) & 31, L = (idx >> 9) / 96;
        const int k = 32 * s + 8 * (lane >> 4) + j, o = 16 * nt + (lane & 15);
        float w = 0.f;
        if (o < 4) w = a.in[11][((size_t)L * 1024 + k) * 4 + o]; else if (o < 36) w = a.in[13][((size_t)L * 1024 + k) * 32 + (o - 4)];
        w *= a.in[3][L * 1024 + k];
        const unsigned hi = f2bf(w); const float lo = w - __builtin_bit_cast(float, hi << 16);
        const size_t base = ((((size_t)L * 32 + s) * 3 + nt) * 2) * 512 + (size_t)lane * 8 + j;
        wrf[base] = (bf16)hi; wrf[base + 512] = (bf16)f2bf(lo);
    }
}
__device__ __forceinline__ void build_sincos(Frame& F, int gtid, int gthreads) {
    float* t1 = (float*)(F.ws + WS_SINCOS); float* t2 = (float*)(F.ws + WS_SINCOST);
    for (int idx = gtid; idx < SEQ * 128; idx += gthreads) {
        const int pos = idx >> 7, i = idx & 127;
        double ang = 1.0, bs = 0.9300449458481391;
        for (int bit = 0; bit < 7; ++bit) { if ((i >> bit) & 1) ang *= bs; bs *= bs; }
        const double ph = (double)pos * ang;
        const double kq = __builtin_rint(ph * 0.63661977236758134308);
        double r = __builtin_fma(-kq, 1.57079632679489655800, ph); r = __builtin_fma(-kq, 6.12323399573676603587e-17, r);
        const double r2 = r * r;
        double sn = r * (1.0 + r2 * (-1.0 / 6 + r2 * (1.0 / 120 + r2 * (-1.0 / 5040 + r2 * (1.0 / 362880 + r2 * (-1.0 / 39916800 + r2 * (1.0 / 6227020800.0)))))));
        double cs = 1.0 + r2 * (-0.5 + r2 * (1.0 / 24 + r2 * (-1.0 / 720 + r2 * (1.0 / 40320 + r2 * (-1.0 / 3628800 + r2 * (1.0 / 479001600.0 + r2 * (-1.0 / 87178291200.0)))))));
        const int q = ((int)kq) & 3;
        double s_ = (q == 0) ? sn : (q == 1) ? cs : (q == 2) ? -sn : -cs;
        double c_ = (q == 0) ? cs : (q == 1) ? -sn : (q == 2) ? -cs : sn;
        t1[(size_t)idx * 2] = (float)c_; t1[(size_t)idx * 2 + 1] = (float)s_;
        const size_t j = ((size_t)i * SEQ + pos) * 2; t2[j] = (float)c_; t2[j + 1] = (float)s_;
    }
}
__device__ __forceinline__ void p_prologue(Frame& F, const Args& a) {
    LAS float* scr = (LAS float*)(F.lds + RING_OFF + F.wave * 16384);
    const int gw = F.vcu * NWAVES + F.wave, NGW = F.G * NWAVES;
    for (int it = gw; it < IT_SHARED + IT_MOE; it += NGW) { if (it < IT_SHARED) conv_shared_item(F, a, it, scr); else conv_moe_item(F, a, 0, it - IT_SHARED, scr); }
    build_router_frags(F, a, F.vcu * 512 + F.tid, F.G * 512);
    build_sincos(F, F.vcu * 512 + F.tid, F.G * 512);
    for (int m = gw; m < TOK; m += NGW) rms_row_to_bf16(F.lane, a.in[0] + (size_t)m * DM, a.in[2], (bf16*)(F.ws + WS_HB) + (size_t)m * DM);
}
__device__ __forceinline__ void p_attention(Frame& F, const Args& a) {
    LAS float* lut = (LAS float*)(F.lds + LX_LUT);
    const attn_body::bf16* QKV = (const attn_body::bf16*)(F.ws + WS_QKV0);
    for (int v = F.vcu; v < 256; v += F.G) {
        const int bh = v >> 2, s = v & 3, b = bh >> 3, h = bh & 7;
        __syncthreads();
        if (F.tid < 132) { const int n = F.tid; int bk = n;
            if (n >= 16) { bk = 16; const int thr[15] = {19, 21, 24, 27, 31, 35, 40, 46, 52, 59, 67, 77, 87, 99, 113};
#pragma unroll
                for (int q = 0; q < 15; ++q) bk += (n >= thr[q]) ? 1 : 0; }
            lut[n] = (a.in[1][bk * 8 + h] - a.in[1][31 * 8 + h]) * LOG2E; }
        __syncthreads();
        for (int i = 0; i < 8; ++i) {
            const int qb = (i < 4) ? 7 - s : s, m = (i >> 1) & 1, vh = i & 1;
            attn_body::bf16* O = (attn_body::bf16*)(F.ws + WS_OP) + (size_t)m * TOK * 1024 + h * 128 + vh * 64;
            attn_body::attn_unit<8>(b, qb, QKV, h * 128 + m * 64, 1024 + h * 128 + m * 64, 2048 + h * 128 + vh * 64, O, lut, (char*)F.lds + RING_OFF);
        }
    }
}
__device__ __forceinline__ void p_diffcombine(Frame& F, const Args& a) {
    const int gw = F.vcu * NWAVES + F.wave, NGW = F.G * NWAVES, lane = F.lane;
    const float* lq = a.in[6];
    const float lam = __expf(wave_sum(lq[lane] * lq[64 + lane])) - __expf(wave_sum(lq[128 + lane] * lq[192 + lane])) + 0.2f;
    const int d0 = (lane & 7) * 16; float g[16];
#pragma unroll
    for (int j = 0; j < 16; ++j) g[j] = a.in[7][d0 + j] * 0.8f;
    const bf16* O0 = (const bf16*)(F.ws + WS_OP); const bf16* O1 = O0 + (size_t)TOK * 1024; bf16* AO = (bf16*)(F.ws + WS_AO);
    for (int m = gw; m < TOK; m += NGW) {
        const GAS v4u* p0 = (const GAS v4u*)(O0 + (size_t)m * 1024 + lane * 16); const GAS v4u* p1 = (const GAS v4u*)(O1 + (size_t)m * 1024 + lane * 16);
        const v4u a0 = p0[0], a1 = p0[1], b0 = p1[0], b1 = p1[1];
        const unsigned wa[8] = {a0.x, a0.y, a0.z, a0.w, a1.x, a1.y, a1.z, a1.w}, wb[8] = {b0.x, b0.y, b0.z, b0.w, b1.x, b1.y, b1.z, b1.w};
        float o[16]; float ss = 0.f;
#pragma unroll
        for (int j = 0; j < 8; ++j) { o[2 * j] = bflo(wa[j]) - lam * bflo(wb[j]); o[2 * j + 1] = bfhi(wa[j]) - lam * bfhi(wb[j]); ss += o[2 * j] * o[2 * j] + o[2 * j + 1] * o[2 * j + 1]; }
        ss += __shfl_xor(ss, 1); ss += __shfl_xor(ss, 2); ss += __shfl_xor(ss, 4);
        const float rstd = 1.0f / sqrtf(ss * (1.f / 128.f) + SUBLN_EPS);
        v4u w0, w1;
        w0.x = pk2(o[0] * rstd * g[0], o[1] * rstd * g[1]); w0.y = pk2(o[2] * rstd * g[2], o[3] * rstd * g[3]); w0.z = pk2(o[4] * rstd * g[4], o[5] * rstd * g[5]); w0.w = pk2(o[6] * rstd * g[6], o[7] * rstd * g[7]);
        w1.x = pk2(o[8] * rstd * g[8], o[9] * rstd * g[9]); w1.y = pk2(o[10] * rstd * g[10], o[11] * rstd * g[11]); w1.z = pk2(o[12] * rstd * g[12], o[13] * rstd * g[13]); w1.w = pk2(o[14] * rstd * g[14], o[15] * rstd * g[15]);
        GAS v4u* po = (GAS v4u*)(AO + (size_t)m * 1024 + lane * 16); po[0] = w0; po[1] = w1;
    }
}
template <int LAYER> __device__ __forceinline__ void p_router(Frame& F, const Args& a, const float* xres) {
    typedef float f32x4v __attribute__((ext_vector_type(4)));
    LAS float* part = (LAS float*)(F.lds + RING_OFF);
    LAS float* ssqp = (LAS float*)(F.lds + RING_OFF + 98304);
    LAS float* logit = (LAS float*)(F.lds + RING_OFF + 100352);
    LAS float* rstd_s = (LAS float*)(F.lds + RING_OFF + 109568);
    LAS int* lcnt = (LAS int*)(F.lds + RING_OFF + 109824);
    LAS int* lbase = (LAS int*)(F.lds + RING_OFF + 109952);
    const int lane = F.lane, w = F.wave, row = lane & 15, kg = lane >> 4;
    const bf16x8* wrf = (const bf16x8*)(F.ws + WS_WRF) + (size_t)LAYER * (32 * 3 * 2 * 64);
    bf16x8 Bh[4][3], Bl[4][3];
#pragma unroll
    for (int s = 0; s < 4; ++s)
#pragma unroll
        for (int nt = 0; nt < 3; ++nt) { Bh[s][nt] = wrf[(((4 * w + s) * 3 + nt) * 2 + 0) * 64 + lane]; Bl[s][nt] = wrf[(((4 * w + s) * 3 + nt) * 2 + 1) * 64 + lane]; }
    const float* gffn = a.in[3] + LAYER * 1024; const float* bg = a.in[12] + LAYER * 4; const float* be = a.in[14] + LAYER * 32;
    int* list = (int*)(F.ws + WS_LIST); float* pairw = (float*)(F.ws + WS_PAIRW); bf16* HB = (bf16*)(F.ws + WS_HB);
    for (int tb = F.vcu; tb < TOK / 64; tb += F.G) {
        __syncthreads();
        if (F.tid < 32) lcnt[F.tid] = 0;
        f32x4v acc[4][3];
#pragma unroll
        for (int mt = 0; mt < 4; ++mt)
#pragma unroll
            for (int nt = 0; nt < 3; ++nt) acc[mt][nt] = (f32x4v){0.f, 0.f, 0.f, 0.f};
#pragma unroll
        for (int mt = 0; mt < 4; ++mt) { const float* xr = xres + (size_t)(tb * 64 + mt * 16 + row) * DM + 128 * w + 8 * kg; float ss = 0.f;
#pragma unroll
            for (int s = 0; s < 4; ++s) { const f32x4 x0 = *(const GAS f32x4*)(xr + 32 * s), x1 = *(const GAS f32x4*)(xr + 32 * s + 4);
                const float xv[8] = {x0.x, x0.y, x0.z, x0.w, x1.x, x1.y, x1.z, x1.w}; bf16x8 ah, al;
#pragma unroll
                for (int j = 0; j < 8; ++j) { ss += xv[j] * xv[j]; const unsigned hi = f2bf(xv[j]); ah[j] = (short)hi; al[j] = (short)f2bf(xv[j] - __builtin_bit_cast(float, hi << 16)); }
#pragma unroll
                for (int nt = 0; nt < 3; ++nt) { acc[mt][nt] = __builtin_amdgcn_mfma_f32_16x16x32_bf16(ah, Bh[s][nt], acc[mt][nt], 0, 0, 0);
                    acc[mt][nt] = __builtin_amdgcn_mfma_f32_16x16x32_bf16(ah, Bl[s][nt], acc[mt][nt], 0, 0, 0); acc[mt][nt] = __builtin_amdgcn_mfma_f32_16x16x32_bf16(al, Bh[s][nt], acc[mt][nt], 0, 0, 0); } }
            ss += __shfl_xor(ss, 16); ss += __shfl_xor(ss, 32);
            if (kg == 0) ssqp[w * 64 + mt * 16 + row] = ss;
#pragma unroll
            for (int nt = 0; nt < 3; ++nt)
#pragma unroll
                for (int r = 0; r < 4; ++r) part[(w * 64 + mt * 16 + 4 * kg + r) * 48 + nt * 16 + row] = acc[mt][nt][r]; }
        __syncthreads();
        if (F.tid < 64) { float s = 0.f;
#pragma unroll
            for (int q = 0; q < 8; ++q) s += ssqp[q * 64 + F.tid];
            rstd_s[F.tid] = 1.0f / sqrtf(s * (1.f / 1024.f) + RMS_EPS); }
        __syncthreads();
        for (int idx = F.tid; idx < 64 * 36; idx += 512) { const int tk = idx / 36, o = idx % 36; float s = 0.f;
#pragma unroll
            for (int q = 0; q < 8; ++q) s += part[(q * 64 + tk) * 48 + o];
            logit[tk * 36 + o] = s * rstd_s[tk] + (o < 4 ? bg[o] : be[o - 4]); }
        __syncthreads();
        if (w == 0) {
            const LAS float* lg = logit + lane * 36;
            int gi = 0; float gm = lg[0];
#pragma unroll
            for (int j = 1; j < 4; ++j) { const float v = lg[j]; if (v > gm) { gm = v; gi = j; } }
            float gs = 0.f;
#pragma unroll
            for (int j = 0; j < 4; ++j) gs += __expf(lg[j] - gm);
            const float gp = 1.0f / gs;
            const LAS float* le = lg + 4 + gi * 8;
            int i1 = 0; float v1 = le[0];
#pragma unroll
            for (int j = 1; j < 8; ++j) { const float v = le[j]; if (v > v1) { v1 = v; i1 = j; } }
            int i2 = -1; float v2 = -INFINITY;
#pragma unroll
            for (int j = 0; j < 8; ++j) { const float v = le[j]; if (j != i1 && v > v2) { v2 = v; i2 = j; } }
            const float e2 = __expf(v2 - v1), w1 = gp / (1.0f + e2), w2 = gp * e2 / (1.0f + e2);
            const int e_1 = gi * 8 + i1, e_2 = gi * 8 + i2;
            const int r1 = __hip_atomic_fetch_add(lcnt + e_1, 1, __ATOMIC_RELAXED, __HIP_MEMORY_SCOPE_WORKGROUP);
            const int r2 = __hip_atomic_fetch_add(lcnt + e_2, 1, __ATOMIC_RELAXED, __HIP_MEMORY_SCOPE_WORKGROUP);
            LDS_WAIT();
            if (lane < 32) { const int c = lcnt[lane]; int bs = 0; if (c > 0) bs = (int)__hip_atomic_fetch_add((unsigned*)(F.ctl + CW_CNT + (LAYER * 32 + lane) * 64), (unsigned)c, RLX_AGENT); lbase[lane] = bs; }
            LDS_WAIT();
            const int tg = tb * 64 + lane; const int p1 = lbase[e_1] + r1, p2 = lbase[e_2] + r2;
            list[e_1 * LISTCAP + p1] = 2 * tg; list[e_2 * LISTCAP + p2] = 2 * tg + 1; pairw[2 * tg] = w1; pairw[2 * tg + 1] = w2;
        }
        for (int i = 0; i < 8; ++i) { const int tk = w * 8 + i, tg = tb * 64 + tk; const float rs = rstd_s[tk];
            const GAS f32x4* xr = (const GAS f32x4*)(xres + (size_t)tg * DM) + lane; const GAS f32x4* gr = (const GAS f32x4*)gffn + lane; GAS unsigned* o4 = (GAS unsigned*)((unsigned char*)HB + (size_t)tg * DM) + lane;
#pragma unroll
            for (int j = 0; j < 4; ++j) { const f32x4 v = xr[64 * j], gg = gr[64 * j]; const float rs8 = rs * H8_SCALE; o4[64 * j] = pk4_fp8f(v.x * rs8 * gg.x, v.y * rs8 * gg.y, v.z * rs8 * gg.z, v.w * rs8 * gg.w); } }
    }
}
template <int LAYER> __device__ __forceinline__ void moe_setup(Frame& F) {
    LAS int* tstart = (LAS int*)(F.lds + LX_TSTART); LAS int* texp = (LAS int*)(F.lds + LX_TEXP); LAS int* lc = (LAS int*)(F.lds + LX_CNT);
    __syncthreads();
    if (F.tid < 32) { int c = (int)__hip_atomic_load((unsigned*)(F.ctl + CW_CNT + (LAYER * 32 + F.tid) * 64), RLX_AGENT); c = c < 0 ? 0 : (c > LISTCAP ? LISTCAP : c); lc[F.tid] = c; }
    __syncthreads();
    if (F.tid == 0) { int acc = 0; for (int e = 0; e < 32; ++e) { tstart[e] = acc; acc += (lc[e] + 255) >> 8; } if (acc > MAXRT) acc = MAXRT; tstart[32] = acc; tstart[33] = acc; }
    __syncthreads();
    if (F.tid < MAXRT) { int e = 0;
#pragma unroll 1
        for (int q = 1; q < 32; ++q) if (tstart[q] <= F.tid) e = q;
        texp[F.tid] = e; }
    __syncthreads();
}
template <int LAYER> __device__ __forceinline__ void p_moe1(Frame& F) {
    moe_setup<LAYER>(F);
    const LAS int* tstart = (const LAS int*)(F.lds + LX_TSTART); const LAS int* texp = (const LAS int*)(F.lds + LX_TEXP); const LAS int* lc = (const LAS int*)(F.lds + LX_CNT);
    LAS int* rowtab = (LAS int*)(F.lds + LX_ROWTAB);
    pg8::MoeOrder S{F.G, F.vcu, 512, 0, tstart, texp};
    const int* list = (const int*)(F.ws + WS_LIST);
    pg8::Unit u;
    for (int i = 0; i < 4 && S.next(i, u); ++i) { if (F.tid < 256) { const int e = u.pn >> 2, pos = u.aux * 256 + F.tid; rowtab[i * 256 + F.tid] = (pos < lc[e]) ? (list[e * LISTCAP + pos] >> 1) : 0; } }
    VM_WAIT(); __syncthreads();
    pg8::Gemm g{(const bf16*)(F.ws + WS_HB), (const bf16*)(F.ws + WS_W1CAT), 512, 512, 512};
    pg8::EpiMoe1 E{(unsigned char*)(F.ws + WS_MACT)};
    pg8::gemm_phase<pg8::EpiMoe1, pg8::MoeOrder, true, true, true>(F.lds + RING_OFF, g, S, E, rowtab);
}
template <int LAYER> __device__ __forceinline__ void p_moe2(Frame& F) {
    moe_setup<LAYER>(F);
    const LAS int* tstart = (const LAS int*)(F.lds + LX_TSTART); const LAS int* texp = (const LAS int*)(F.lds + LX_TEXP); const LAS int* lc = (const LAS int*)(F.lds + LX_CNT);
    pg8::MoeOrder S{F.G, F.vcu, 256, 256 * 256, tstart, texp};
    pg8::Gemm g{(const bf16*)(F.ws + WS_MACT), (const bf16*)(F.ws + WS_W2T), 256, 256, 256};
    pg8::EpiMoe2 E{(bf16*)(F.ws + WS_Y), (const int*)(F.ws + WS_LIST), (const float*)(F.ws + WS_PAIRW), lc};
    pg8::gemm_phase<pg8::EpiMoe2, pg8::MoeOrder, true, false, true>(F.lds + RING_OFF, g, S, E, nullptr);
}
template <bool FINAL> __device__ __forceinline__ void p_combine(Frame& F, float* xres, const float* g) {
    const int gw = F.vcu * NWAVES + F.wave, NGW = F.G * NWAVES, lane = F.lane;
    const bf16* Y = (const bf16*)(F.ws + WS_Y); bf16* HB = (bf16*)(F.ws + WS_HB);
    for (int m = gw; m < TOK; m += NGW) {
        GAS f32x4* xr = (GAS f32x4*)(xres + (size_t)m * DM) + lane; const GAS v2u* y0 = (const GAS v2u*)(Y + (size_t)(2 * m) * DM) + lane; const GAS v2u* y1 = (const GAS v2u*)(Y + (size_t)(2 * m + 1) * DM) + lane;
        const GAS f32x4* gr = (const GAS f32x4*)g + lane;
        f32x4 v[4]; float s = 0.f;
#pragma unroll
        for (int j = 0; j < 4; ++j) { const f32x4 x = xr[64 * j]; const v2u p = y0[64 * j], q = y1[64 * j];
            v[j].x = x.x + bflo(p.x) + bflo(q.x); v[j].y = x.y + bfhi(p.x) + bfhi(q.x); v[j].z = x.z + bflo(p.y) + bflo(q.y); v[j].w = x.w + bfhi(p.y) + bfhi(q.y);
            s += (v[j].x * v[j].x + v[j].y * v[j].y) + (v[j].z * v[j].z + v[j].w * v[j].w); }
        const float rstd = 1.0f / sqrtf(wave_sum(s) * (1.f / 1024.f) + RMS_EPS);
        if (FINAL) {
#pragma unroll
            for (int j = 0; j < 4; ++j) { const f32x4 gg = gr[64 * j]; f32x4 o; o.x = v[j].x * rstd * gg.x; o.y = v[j].y * rstd * gg.y; o.z = v[j].z * rstd * gg.z; o.w = v[j].w * rstd * gg.w; xr[64 * j] = o; }
        } else {
            GAS v2u* o8 = (GAS v2u*)(HB + (size_t)m * DM) + lane;
#pragma unroll
            for (int j = 0; j < 4; ++j) { xr[64 * j] = v[j]; const f32x4 gg = gr[64 * j]; v2u o; o.x = pk2(v[j].x * rstd * gg.x, v[j].y * rstd * gg.y); o.y = pk2(v[j].z * rstd * gg.z, v[j].w * rstd * gg.w); o8[64 * j] = o; }
        }
    }
}
__device__ __forceinline__ void p_scan(Frame& F) {
    const bf16* DS = (const bf16*)(F.ws + WS_DS); bf16* BT = (bf16*)(F.ws + WS_BTCAT);
    for (int gidx = F.vcu * 512 + F.tid; gidx < NB * RH * 16384; gidx += F.G * 512) {
        const int bh = gidx >> 14, e8 = gidx & 16383, dv = e8 >> 5, dk0 = (e8 & 31) * 8, h = bh & 3;
        const float cd = __builtin_amdgcn_exp2f(256.0f * pg8::log2_gamma(h));
        v4u d[7];
#pragma unroll
        for (int n = 0; n < 7; ++n) d[n] = *(const GAS v4u*)(DS + ((size_t)(bh * RNC + n) * RDV + dv) * RDK + dk0);
        float s[8];
#pragma unroll
        for (int j = 0; j < 8; ++j) s[j] = 0.f;
#pragma unroll
        for (int n = 0; n < 8; ++n) {
            v4u o; o.x = pk2(s[0], s[1]); o.y = pk2(s[2], s[3]); o.z = pk2(s[4], s[5]); o.w = pk2(s[6], s[7]);
            *(GAS v4u*)(BT + ((size_t)(bh * RNC + n) * RDV + dv) * 512 + 256 + dk0) = o;
            if (n < 7) { const unsigned wv[4] = {d[n].x, d[n].y, d[n].z, d[n].w};
#pragma unroll
                for (int j = 0; j < 4; ++j) { s[2 * j] = cd * (s[2 * j] + bflo(wv[j])); s[2 * j + 1] = cd * (s[2 * j + 1] + bfhi(wv[j])); } }
        }
    }
}
__device__ __forceinline__ void p_normgate(Frame& F) {
    const int gw = F.vcu * NWAVES + F.wave, NGW = F.G * NWAVES, lane = F.lane;
    const bf16* OR = (const bf16*)(F.ws + WS_ORET); bf16* SG = (bf16*)(F.ws + WS_SG);
    for (int m = gw; m < TOK; m += NGW) {
        const GAS v4u* po = (const GAS v4u*)(OR + (size_t)m * 2048 + lane * 32); GAS v4u* pg = (GAS v4u*)(SG + (size_t)m * 2048 + lane * 32);
        v4u ov[4], gv[4]; float ss = 0.f;
#pragma unroll
        for (int q = 0; q < 4; ++q) { ov[q] = po[q]; gv[q] = pg[q]; }
#pragma unroll
        for (int q = 0; q < 4; ++q) { const unsigned wv[4] = {ov[q].x, ov[q].y, ov[q].z, ov[q].w};
#pragma unroll
            for (int j = 0; j < 4; ++j) { const float x0 = bflo(wv[j]), x1 = bfhi(wv[j]); ss += x0 * x0 + x1 * x1; } }
        ss += __shfl_xor(ss, 1); ss += __shfl_xor(ss, 2); ss += __shfl_xor(ss, 4); ss += __shfl_xor(ss, 8);
        const float rstd = 1.0f / sqrtf(ss * (1.f / 512.f) + RMS_EPS);
#pragma unroll
        for (int q = 0; q < 4; ++q) { const unsigned wv[4] = {ov[q].x, ov[q].y, ov[q].z, ov[q].w}, wg[4] = {gv[q].x, gv[q].y, gv[q].z, gv[q].w}; unsigned r[4];
#pragma unroll
            for (int j = 0; j < 4; ++j) r[j] = pk2(bflo(wv[j]) * rstd * bflo(wg[j]), bfhi(wv[j]) * rstd * bfhi(wg[j]));
            v4u o; o.x = r[0]; o.y = r[1]; o.z = r[2]; o.w = r[3]; pg[q] = o; }
    }
}
__device__ __forceinline__ void p_conv_moe1(Frame& F, const Args& a) {
    LAS float* scr = (LAS float*)(F.lds + RING_OFF + F.wave * 16384);
    const int gw = F.vcu * NWAVES + F.wave, NGW = F.G * NWAVES;
    for (int it = gw; it < IT_MOE; it += NGW) conv_moe_item(F, a, 1, it, scr);
}

constexpr int N_PHASES = 19;
#ifndef MK_PER_PHASE
#define MK_PER_PHASE 0
#endif
__global__ void __launch_bounds__(NWAVES * 64, 2) hybrid_fwd(Args args) {
    extern __shared__ __attribute__((aligned(16))) unsigned char lds[];
    Frame F;
    F.lds = (LAS unsigned char*)lds;
    F.tid = threadIdx.x; F.lane = F.tid & 63; F.wave = __builtin_amdgcn_readfirstlane(F.tid >> 6);
    F.G = gridDim.x; { const int bx = blockIdx.x; F.vcu = (F.G % 8 == 0) ? (bx % 8) * (F.G / 8) + bx / 8 : bx; }
    F.ws = args.ws; F.ctl = (gu32*)(args.ws + WS_CTL);
    for (int u = F.tid; u < (LDS_BYTES - LX_OFF) / 4; u += NWAVES * 64) ((LAS unsigned*)(F.lds + LX_OFF))[u] = 0u;
    __syncthreads();
    XcdBarrier bar; bar.bar = (unsigned*)(F.ctl + CW_BAR); bar.x = 0; bar.st = nullptr;
    if (!MK_PER_PHASE) bar = xcd_barrier_post((unsigned*)(F.ctl + CW_BAR), (volatile LAS unsigned*)(F.lds + LX_MISC) + 8);
    const int lo = args.ph_lo, hi = args.ph_hi;
#ifndef PH_MASK
#define PH_MASK 0x7ffff
#endif
#define IN(k) (((PH_MASK >> (k)) & 1) && lo <= (k) && (k) < hi)
#define SEAM(k) do { if (IN(k) && IN((k) + 1)) xcd_barrier(bar); } while (0)
#define REFRESH() do { int t_ = threadIdx.x; asm volatile("" : "+v"(t_)); F.tid = t_; F.lane = t_ & 63; } while (0)
#ifndef DUP_MASK
#define DUP_MASK 0
#endif
#ifndef XBAR_N
#define XBAR_N 0
#endif
#define DUP(k) (((DUP_MASK >> (k)) & 1) != 0)
    float* xres = args.out;
    unsigned char* ws = args.ws;
    const int bx = (int)blockIdx.x;

    if (IN(0)) { REFRESH(); p_prologue(F, args); if (DUP(0)) { xcd_barrier(bar); p_prologue(F, args); } for (int q = 0; q < XBAR_N; ++q) xcd_barrier(bar); } SEAM(0);
    if (IN(1)) { REFRESH(); for (int rep_ = 0; rep_ < (DUP(1) ? 2 : 1); ++rep_) { if (rep_) xcd_barrier(bar);
        pg8::Gemm g{(const bf16*)(ws + WS_HB), (const bf16*)(ws + WS_WINT0), 1024, 1024, 1024}; pg8::StaticOrder S; S.init(TOK, 3072, F.G, bx, 1024, 1024);
        pg8::EpiQKV E{(bf16*)(ws + WS_QKV0), ATT_C2};
        pg8::gemm_phase<pg8::EpiQKV, pg8::StaticOrder, true, false>(F.lds + RING_OFF, g, S, E, nullptr);
    }
    } SEAM(1);
    if (IN(2)) { REFRESH(); p_attention(F, args); if (DUP(2)) { xcd_barrier(bar); p_attention(F, args); } } SEAM(2);
    if (IN(3)) { REFRESH(); p_diffcombine(F, args); if (DUP(3)) { xcd_barrier(bar); p_diffcombine(F, args); } } SEAM(3);
    if (IN(4)) { REFRESH();
        pg8::Gemm g{(const bf16*)(ws + WS_AO), (const bf16*)(ws + WS_WOUTT0), 1024, 1024, 1024}; pg8::StaticOrder S; S.init(TOK, 1024, F.G, bx, 1024, 1024);
        pg8::EpiRes E{args.in[0], xres};
        pg8::gemm_phase<pg8::EpiRes, pg8::StaticOrder, true, false>(F.lds + RING_OFF, g, S, E, nullptr);
    } SEAM(4);
    if (IN(5)) { REFRESH(); p_router<0>(F, args, xres); } SEAM(5);
    if (IN(6)) { REFRESH(); p_moe1<0>(F); if (DUP(6)) { xcd_barrier(bar); p_moe1<0>(F); } } SEAM(6);
    if (IN(7)) { REFRESH(); p_moe2<0>(F); if (DUP(7)) { xcd_barrier(bar); p_moe2<0>(F); } } SEAM(7);
    if (IN(8)) { REFRESH(); p_combine<false>(F, xres, args.in[2] + 1024); } SEAM(8);
    if (IN(9)) { REFRESH(); for (int rep_ = 0; rep_ < (DUP(9) ? 2 : 1); ++rep_) { if (rep_) xcd_barrier(bar);
        { pg8::Gemm g{(const bf16*)(ws + WS_HB), (const bf16*)(ws + WS_WRINA), 1024, 1024, 1024}; pg8::StaticOrder S; S.init(TOK, 4096, F.G, bx, 1024, 1024);
          pg8::EpiRetA E{(bf16*)(ws + WS_ACAT), (bf16*)(ws + WS_KI), (bf16*)(ws + WS_SG), (const float*)(ws + WS_SINCOS)};
          pg8::gemm_phase<pg8::EpiRetA, pg8::StaticOrder, true, false>(F.lds + RING_OFF, g, S, E, nullptr); }
        { pg8::Gemm g{(const bf16*)(ws + WS_WRINB), (const bf16*)(ws + WS_HB), 1024, 1024, 1024}; pg8::StaticOrder S; S.init(3072, TOK, F.G, bx, 1024, 1024);
          pg8::EpiRetB E{(bf16*)(ws + WS_KIT), (bf16*)(ws + WS_BTCAT), (const float*)(ws + WS_SINCOST)};
          pg8::gemm_phase<pg8::EpiRetB, pg8::StaticOrder, true, false>(F.lds + RING_OFF, g, S, E, nullptr); }
    }
    } SEAM(9);
    if (IN(10)) { REFRESH(); for (int rep_ = 0; rep_ < (DUP(10) ? 2 : 1); ++rep_) { if (rep_) xcd_barrier(bar);
        { pg8::Gemm g{(const bf16*)(ws + WS_ACAT), (const bf16*)(ws + WS_KI), 512, 1024, 256}; pg8::ScoresOrder S{F.G, F.vcu};
          pg8::EpiScores E{(bf16*)(ws + WS_ACAT)};
          pg8::gemm_phase<pg8::EpiScores, pg8::ScoresOrder, true, false>(F.lds + RING_OFF, g, S, E, nullptr); }
        { pg8::Gemm g{(const bf16*)(ws + WS_BTCAT), (const bf16*)(ws + WS_KIT), 512, 2048, 256}; pg8::DsOrder S{F.G, F.vcu};
          pg8::EpiDS E{(bf16*)(ws + WS_DS)};
          pg8::gemm_phase<pg8::EpiDS, pg8::DsOrder, true, false>(F.lds + RING_OFF, g, S, E, nullptr); }
    }
    } SEAM(10);
    if (IN(11)) { REFRESH(); p_scan(F); if (DUP(11)) { xcd_barrier(bar); p_scan(F); } } SEAM(11);
    if (IN(12)) { REFRESH(); for (int rep_ = 0; rep_ < (DUP(12) ? 2 : 1); ++rep_) { if (rep_) xcd_barrier(bar);
        pg8::Gemm g{(const bf16*)(ws + WS_ACAT), (const bf16*)(ws + WS_BTCAT), 512, 512, 512}; pg8::RetOOrder S{F.G, F.vcu};
        pg8::EpiRetO E{(bf16*)(ws + WS_ORET)};
        pg8::gemm_phase<pg8::EpiRetO, pg8::RetOOrder, true, false>(F.lds + RING_OFF, g, S, E, nullptr);
    }
    } SEAM(12);
    if (IN(13)) { REFRESH(); p_normgate(F); } SEAM(13);
    if (IN(14)) { REFRESH();
        pg8::Gemm g{(const bf16*)(ws + WS_SG), (const bf16*)(ws + WS_WROUTT), 2048, 2048, 2048}; pg8::StaticOrder S; S.init(TOK, 1024, F.G, bx, 2048, 2048);
        pg8::EpiRes E{xres, xres};
        pg8::gemm_phase<pg8::EpiRes, pg8::StaticOrder, true, false>(F.lds + RING_OFF, g, S, E, nullptr);
    } SEAM(14);
    if (IN(15)) { REFRESH(); p_router<1>(F, args, xres); __syncthreads(); p_conv_moe1(F, args); } SEAM(15);
    if (IN(16)) { REFRESH(); p_moe1<1>(F); } SEAM(16);
    if (IN(17)) { REFRESH(); p_moe2<1>(F); } SEAM(17);
    if (IN(18)) { REFRESH(); p_combine<true>(F, xres, args.in[4]); }
#undef IN
#undef SEAM
}

extern "C" void kernel_launch(void* const* d_in, const int* in_sizes, int n_in, void* d_out, int out_size, void* d_ws, size_t ws_size, hipStream_t stream) {
    static int grid = 0;
    if (grid == 0) {
        if (n_in != 18 || in_sizes[0] != TOK * DM || out_size != TOK * DM || ws_size < WS_END) { fprintf(stderr, "kernel_launch: unexpected shapes / workspace (n_in %d, in0 %d, out %d, ws %zu < %zu); nothing launched\n", n_in, n_in > 0 ? in_sizes[0] : -1, out_size, ws_size, (size_t)WS_END); grid = -1; return; }
        int dev = 0, cus = 0, per_cu = 0;
        if (hipGetDevice(&dev) != hipSuccess || hipDeviceGetAttribute(&cus, hipDeviceAttributeMultiprocessorCount, dev) != hipSuccess) { grid = -1; return; }
        if (hipFuncSetAttribute((const void*)hybrid_fwd, hipFuncAttributeMaxDynamicSharedMemorySize, LDS_BYTES) != hipSuccess) { fprintf(stderr, "kernel_launch: hipFuncSetAttribute failed\n"); grid = -1; return; }
        if (hipOccupancyMaxActiveBlocksPerMultiprocessor(&per_cu, (const void*)hybrid_fwd, NWAVES * 64, LDS_BYTES) != hipSuccess || per_cu < 1) { fprintf(stderr, "kernel_launch: occupancy query says %d\n", per_cu); }
        (void)hipGetLastError();
        grid = cus > 256 ? 256 : cus;
    }
    if (grid < 0) return;
    if (hipMemsetAsync((char*)d_ws + WS_CTL, 0, CTL_ZERO_BYTES, stream) != hipSuccess) return;
    Args a{};
    for (int i = 0; i < 18; ++i) a.in[i] = (const float*)d_in[i];
    a.out = (float*)d_out; a.ws = (unsigned char*)d_ws; a.pad = 0;
#if MK_PER_PHASE
    for (int p = 0; p < N_PHASES; ++p) { a.ph_lo = p; a.ph_hi = p + 1; a.li = p; hipLaunchKernelGGL(hybrid_fwd, dim3(grid), dim3(NWAVES * 64), LDS_BYTES, stream, a); }
#else
    a.ph_lo = 0; a.ph_hi = N_PHASES; a.li = 0;
    hipLaunchKernelGGL(hybrid_fwd, dim3(grid), dim3(NWAVES * 64), LDS_BYTES, stream, a);
#endif
}
```

```cpp
#include <hip/hip_runtime.h>
#include <hip/hip_bf16.h>
#include <cstdio>
#include <cstdint>

#define LAS __attribute__((address_space(3)))
#define GAS __attribute__((address_space(1)))

namespace pg8 {
typedef unsigned short bf16_t;
typedef short bf16x8 __attribute__((ext_vector_type(8)));
typedef float f32x4 __attribute__((ext_vector_type(4)));
typedef float f32x2 __attribute__((ext_vector_type(2)));
typedef unsigned u32x4 __attribute__((ext_vector_type(4)));
typedef unsigned u32x2 __attribute__((ext_vector_type(2)));
constexpr int BM = 256, BK = 64, HALF = 128, HTB = HALF * BK * 2, STAGE_BYTES = 8 * HTB, NXCD = 8, WGM = 8;

__host__ __device__ __forceinline__ int lds_byte(int r, int c) { const int st = (r >> 4) * 2 + (c >> 5), rr = r & 15, cc = c & 31, ob = rr * 64 + cc * 2; return st * 1024 + (ob ^ (((ob >> 9) & 1) << 5)); }
__host__ __device__ __forceinline__ void stage_rc(int b, int& R, int& C) { const int st = b / 1024, sb = b % 1024, swz = sb ^ (((sb >> 9) & 1) << 5); R = (st >> 1) * 16 + swz / 64; C = (st & 1) * 32 + (swz % 64) / 2; }
__host__ __device__ __forceinline__ int perm32(int rho) { const int n = rho >> 4, i = rho & 15; return 8 * (i >> 2) + 4 * n + (i & 3); }

struct Unit { int pm, pn, aux; long aoff, boff; };
struct Gemm { const bf16_t* A; const bf16_t* Bt; int lda, ldb, K; };

struct StaticOrder {
    int nM, nN, nwg, G, c, lda, ldb;
    __device__ void init(int M, int N, int G_, int c_, int lda_, int ldb_) { nM = M / BM; nN = N / BM; nwg = nM * nN; G = G_; c = c_; lda = lda_; ldb = ldb_; }
    __device__ bool next(int i, Unit& u) const {
        const long L = (long)i * G + c; if (L >= nwg) return false;
        int wgid = (int)L; { const int q = nwg / NXCD, r = nwg % NXCD, xcd = wgid % NXCD, off = wgid / NXCD; wgid = (xcd < r ? xcd * (q + 1) : r * (q + 1) + (xcd - r) * q) + off; }
        const int nig = WGM * nN, gid = wgid / nig, fm = gid * WGM, gsz = (nM - fm) < WGM ? (nM - fm) : WGM;
        u.pm = fm + ((wgid % nig) % gsz); u.pn = (wgid % nig) / gsz; u.aux = 0;
        u.aoff = (long)u.pm * BM * lda; u.boff = (long)u.pn * BM * ldb; return true;
    }
};

__device__ __forceinline__ unsigned cvt_pk_bf16(float lo, float hi) { unsigned r; asm volatile("v_cvt_pk_bf16_f32 %0, %1, %2" : "=v"(r) : "v"(lo), "v"(hi)); return r; }
__device__ __forceinline__ u32x4 pack8(const f32x4 v0, const f32x4 v1) { u32x4 w; w.x = cvt_pk_bf16(v0[0], v0[1]); w.y = cvt_pk_bf16(v0[2], v0[3]); w.z = cvt_pk_bf16(v1[0], v1[1]); w.w = cvt_pk_bf16(v1[2], v1[3]); return w; }

typedef int v4i_t __attribute__((ext_vector_type(4)));
typedef int v8i_t __attribute__((ext_vector_type(8)));
__device__ __forceinline__ v8i_t cat8(const bf16x8 a, const bf16x8 b) { const v4i_t x = __builtin_bit_cast(v4i_t, a), y = __builtin_bit_cast(v4i_t, b); return __builtin_shufflevector(x, y, 0, 1, 2, 3, 4, 5, 6, 7); }
template <class Epi, class Sched, bool ALIGN_EPI, bool GATHER, bool FP8 = false>
__device__ __forceinline__ void gemm_phase(LAS unsigned char* lds, const Gemm g, const Sched& S, const Epi& E, const LAS int* rowtab) {
    int tid_ = threadIdx.x; asm volatile("" : "+v"(tid_));
    const int tid = tid_, wid = __builtin_amdgcn_readfirstlane(tid >> 6), lane = tid & 63, wr = wid >> 2, wc = wid & 3, fr = lane & 15, fq = lane >> 4;
    const int K = g.K, nt = K / BK;
    int sR[2], sC[2]; unsigned voffB[2];
#pragma unroll
    for (int i = 0; i < 2; ++i) { int R, C; stage_rc(tid * 16 + i * 8192, R, C); sR[i] = R; sC[i] = C; const int Rb = Epi::PERM ? ((R & ~31) + perm32(R & 31)) : R; voffB[i] = (unsigned)(Rb * g.ldb + C) * 2u; }
    unsigned avo[2][2], navo[2][2];
#define PG8_SETOFF(o, ui_) do { _Pragma("unroll") for (int h_ = 0; h_ < 2; ++h_) _Pragma("unroll") for (int i_ = 0; i_ < 2; ++i_) { const int row_ = h_ * HALF + sR[i_]; \
        const int grow_ = GATHER ? rowtab[(ui_) * BM + row_] : row_; o[h_][i_] = (unsigned)(grow_ * g.lda + sC[i_]) * 2u; } } while (0)
    const size_t kstep = (size_t)(BK * 2);
    const size_t hstepB = (size_t)HALF * g.ldb * 2;
    const unsigned ldsw = (unsigned)wid * 1024u;
    const int aoff = lds_byte(wr * 64 + fr, fq * 8), boff = lds_byte(wc * 32 + fr, fq * 8);
#define PG8_SA(b, h) (((b) * 2 + (h)) * HTB)
#define PG8_SB(b, h) ((4 + (b) * 2 + (h)) * HTB)
#define PG8_STAGE(bufoff, gbase, voff) do { _Pragma("unroll") for (int _i = 0; _i < 2; ++_i) \
        __builtin_amdgcn_global_load_lds((const unsigned*)((const char*)(gbase) + (voff)[_i]), (LAS unsigned*)(lds + (bufoff) + ldsw + _i * 8192), 16, 0, 0); } while (0)
#define PG8_LD8(dst8, addr_) do { const v4i_t lo_ = *(const LAS v4i_t*)(addr_), hi_ = *(const LAS v4i_t*)((addr_) + 1024); dst8 = __builtin_shufflevector(lo_, hi_, 0, 1, 2, 3, 4, 5, 6, 7); } while (0)
#define PG8_LDA(dst, b, h) do { _Pragma("unroll") for (int m = 0; m < 4; ++m) { if constexpr (FP8) { PG8_LD8(dst##8[m], lds + PG8_SA(b, h) + aoff + m * 2048); } else { _Pragma("unroll") for (int k = 0; k < 2; ++k) dst[m][k] = *(const LAS bf16x8*)(lds + PG8_SA(b, h) + aoff + m * 2048 + k * 1024); } } } while (0)
#define PG8_LDB(dst, b, h) do { _Pragma("unroll") for (int n = 0; n < 2; ++n) { if constexpr (FP8) { PG8_LD8(dst##8[n], lds + PG8_SB(b, h) + boff + n * 2048); } else { _Pragma("unroll") for (int k = 0; k < 2; ++k) dst[n][k] = *(const LAS bf16x8*)(lds + PG8_SB(b, h) + boff + n * 2048 + k * 1024); } } } while (0)
#define PG8_MMA(ai, bj, At, Bt) do { __builtin_amdgcn_s_setprio(1); _Pragma("unroll") for (int m = 0; m < 4; ++m) _Pragma("unroll") for (int n = 0; n < 2; ++n) { \
        if constexpr (FP8) asm volatile("v_mfma_scale_f32_16x16x128_f8f6f4 %0, %1, %2, %0, %3, %3 op_sel_hi:[0,0,0]" : "+v"(acc[ai][bj][m][n]) : "v"(Bt##8[n]), "v"(At##8[m]), "v"(sc1)); \
        else { _Pragma("unroll") for (int k = 0; k < 2; ++k) acc[ai][bj][m][n] = __builtin_amdgcn_mfma_f32_16x16x32_bf16(Bt[n][k], At[m][k], acc[ai][bj][m][n], 0, 0, 0); } } \
        __builtin_amdgcn_s_setprio(0); } while (0)
#define PG8_WAIT_V(n) asm volatile("s_waitcnt vmcnt(" #n ")" ::: "memory")
#define PG8_WAIT_L(n) asm volatile("s_waitcnt lgkmcnt(" #n ")" ::: "memory")
#define PG8_BAR __builtin_amdgcn_s_barrier()
#define PG8_SCHED __builtin_amdgcn_sched_barrier(0)
    unsigned sc1 = 0; if constexpr (FP8) asm volatile("v_mov_b32 %0, 0x7f7f7f7f\n\ts_nop 4" : "=v"(sc1));
    Unit cur, nxt; int ui = 0;
    if (!S.next(0, cur)) return;
    f32x4 acc[2][2][4][2];
#pragma unroll
    for (int a = 0; a < 2; ++a)
#pragma unroll
        for (int b = 0; b < 2; ++b)
#pragma unroll
            for (int m = 0; m < 4; ++m)
#pragma unroll
                for (int n = 0; n < 2; ++n) acc[a][b][m][n] = (f32x4){0.f, 0.f, 0.f, 0.f};
    bf16x8 At[4][2], B0[2][2], B1[2][2]; v8i_t At8[4], B08[2], B18[2];
    const char* cA = (const char*)g.A + cur.aoff * 2; const char* cB = (const char*)g.Bt + cur.boff * 2;
    PG8_SETOFF(avo, 0);
    PG8_STAGE(PG8_SB(0, 0), cB, voffB); PG8_STAGE(PG8_SB(0, 1), cB + hstepB, voffB); PG8_STAGE(PG8_SA(0, 0), cA, avo[0]); PG8_STAGE(PG8_SA(0, 1), cA, avo[1]);
    if (wr == 1) PG8_BAR;
    PG8_WAIT_V(2); PG8_BAR;
    PG8_STAGE(PG8_SB(1, 0), cB + kstep, voffB); PG8_STAGE(PG8_SA(1, 0), cA + kstep, avo[0]); PG8_STAGE(PG8_SB(1, 1), cB + hstepB + kstep, voffB);
    PG8_WAIT_V(6); PG8_BAR;
    for (;;) {
        const bool has_next = S.next(ui + 1, nxt);
        const char* nA = has_next ? (const char*)g.A + nxt.aoff * 2 : cA; const char* nB = has_next ? (const char*)g.Bt + nxt.boff * 2 : cB;
        if (GATHER && has_next) { PG8_SETOFF(navo, ui + 1); }
        else {
#pragma unroll
            for (int h_ = 0; h_ < 2; ++h_)
#pragma unroll
                for (int i_ = 0; i_ < 2; ++i_) navo[h_][i_] = avo[h_][i_]; }
#pragma nounroll
        for (int t = 0; t < nt; t += 2) {
            const bool last = (t == nt - 2);
            const char* a1 = cA + (size_t)(t + 1) * kstep;
            const char* a2 = last ? nA : cA + (size_t)(t + 2) * kstep; const char* b2 = last ? nB : cB + (size_t)(t + 2) * kstep;
            const char* a3 = a2 + kstep; const char* b3 = b2 + kstep;
            unsigned o2[2][2];
#pragma unroll
            for (int h_ = 0; h_ < 2; ++h_)
#pragma unroll
                for (int i_ = 0; i_ < 2; ++i_) o2[h_][i_] = (GATHER && last) ? navo[h_][i_] : avo[h_][i_];
            PG8_LDB(B0, 0, 0); PG8_LDB(B1, 0, 1); PG8_SCHED; PG8_LDA(At, 0, 0); PG8_STAGE(PG8_SA(1, 1), a1, avo[1]);
            PG8_WAIT_V(8); PG8_WAIT_L(0); PG8_BAR; PG8_MMA(0, 0, At, B0); PG8_MMA(0, 1, At, B1); PG8_BAR; PG8_SCHED;
            PG8_LDA(At, 0, 1); PG8_STAGE(PG8_SB(0, 0), b2, voffB); PG8_STAGE(PG8_SB(0, 1), b2 + hstepB, voffB); PG8_STAGE(PG8_SA(0, 0), a2, o2[0]);
            PG8_WAIT_V(8); PG8_WAIT_L(0); PG8_BAR; PG8_MMA(1, 0, At, B0); PG8_MMA(1, 1, At, B1); PG8_BAR; PG8_SCHED;
            PG8_LDB(B0, 1, 0); PG8_LDB(B1, 1, 1); PG8_SCHED; PG8_LDA(At, 1, 0); PG8_STAGE(PG8_SA(0, 1), a2, o2[1]);
            PG8_WAIT_V(8); PG8_WAIT_L(0); PG8_BAR; PG8_MMA(0, 0, At, B0); PG8_MMA(0, 1, At, B1); PG8_BAR; PG8_SCHED;
            PG8_LDA(At, 1, 1); PG8_STAGE(PG8_SB(1, 0), b3, voffB); PG8_STAGE(PG8_SB(1, 1), b3 + hstepB, voffB); PG8_STAGE(PG8_SA(1, 0), a3, o2[0]);
            PG8_WAIT_V(8); PG8_WAIT_L(0); PG8_BAR; PG8_MMA(1, 0, At, B0); PG8_MMA(1, 1, At, B1); PG8_BAR; PG8_SCHED;
        }
        if constexpr (ALIGN_EPI) { if (wr == 0) PG8_BAR; }
        if constexpr (FP8) asm volatile("s_nop 15\n\ts_nop 3" ::: "memory");
        { int efr = fr, efq = fq; asm volatile("" : "+v"(efr), "+v"(efq)); E(acc, cur, wr, wc, efr, efq); }
        if (!has_next) break;
#pragma unroll
        for (int a = 0; a < 2; ++a)
#pragma unroll
            for (int b = 0; b < 2; ++b)
#pragma unroll
                for (int m = 0; m < 4; ++m)
#pragma unroll
                    for (int n = 0; n < 2; ++n) acc[a][b][m][n] = (f32x4){0.f, 0.f, 0.f, 0.f};
        cur = nxt; cA = nA; cB = nB; ++ui;
#pragma unroll
        for (int h_ = 0; h_ < 2; ++h_)
#pragma unroll
            for (int i_ = 0; i_ < 2; ++i_) avo[h_][i_] = navo[h_][i_];
        if constexpr (ALIGN_EPI) { if (wr == 1) PG8_BAR; }
    }
    PG8_WAIT_V(0);
    if constexpr (!ALIGN_EPI) { if (wr == 0) PG8_BAR; }
    PG8_BAR;
#undef PG8_SETOFF
#undef PG8_SA
#undef PG8_SB
#undef PG8_STAGE
#undef PG8_LDA
#undef PG8_LDB
#undef PG8_MMA
#undef PG8_WAIT_V
#undef PG8_WAIT_L
#undef PG8_BAR
#undef PG8_SCHED
}
}
constexpr int NB = 8, SEQ = 2048, DM = 1024, TOK = NB * SEQ;
constexpr int AH = 8;
constexpr int RH = 4, RDK = 256, RDV = 512, RC = 256, RNC = SEQ / RC;
constexpr int NEXP = 32, EFF = 512, NPAIR = 2 * TOK, LISTCAP = TOK;
constexpr int MAXRT = NPAIR / 256 + NEXP;
constexpr float RMS_EPS = 1e-6f, SUBLN_EPS = 1e-5f, LOG2E = 1.4426950408889634f;
#ifndef QKV_FP8
#define QKV_FP8 0
#endif
#ifndef RIN_FP8
#define RIN_FP8 1
#endif
constexpr float WIN_SCALE = 64.f, IN_DESCALE = 1.0f / (16.f * 64.f);
constexpr float H8_SCALE = 16.f, W1_SCALE = 64.f, ACT_SCALE = 8.f, W2_SCALE = 32.f;
constexpr float ATT_C2 = 0.125f * LOG2E;

constexpr size_t MiB = 1u << 20;
constexpr size_t WS_CTL = 0, CTL_ZERO_BYTES = 1 * MiB;
constexpr size_t WS_LIST = 1 * MiB;
constexpr size_t WS_PAIRW = 3 * MiB;
constexpr size_t WS_WRF = 3 * MiB + 512 * 1024;
constexpr size_t WS_SINCOS = 4 * MiB;
constexpr size_t WS_SINCOST = 6 * MiB;
constexpr size_t WS_WINT0 = 8 * MiB;
constexpr size_t WS_WOUTT0 = 14 * MiB;
constexpr size_t WS_WRINA = 16 * MiB;
constexpr size_t WS_WRINB = 24 * MiB;
constexpr size_t WS_WROUTT = 30 * MiB;
constexpr size_t WS_W1CAT = 34 * MiB;
constexpr size_t WS_W2T = 98 * MiB;
constexpr size_t WS_DS = 34 * MiB;
constexpr size_t WS_ORET = 34 * MiB;
constexpr size_t WS_HB = 130 * MiB;
constexpr size_t WS_ACTBASE = 162 * MiB;
constexpr size_t WS_QKV0 = WS_ACTBASE;
constexpr size_t WS_OP = WS_ACTBASE + 96 * MiB;
constexpr size_t WS_AO = WS_ACTBASE + 160 * MiB;
constexpr size_t WS_MACT = WS_ACTBASE;
constexpr size_t WS_Y = WS_ACTBASE + 40 * MiB;
constexpr size_t WS_ACAT = WS_ACTBASE;
constexpr size_t WS_BTCAT = WS_ACTBASE + 64 * MiB;
constexpr size_t WS_KI = WS_ACTBASE + 192 * MiB;
constexpr size_t WS_KIT = WS_ACTBASE + 224 * MiB;
constexpr size_t WS_SG = WS_ACTBASE + 256 * MiB;
constexpr size_t WS_END = WS_ACTBASE + 320 * MiB;
constexpr int CW_TMO = 0, CW_BAR = 4096, CW_CNT = 16384;

constexpr int RING_OFF = 0, RING_BYTES = 131072;
constexpr int LX_OFF = RING_BYTES;
constexpr int LX_MISC = LX_OFF + 320;
constexpr int LX_ROWTAB = LX_OFF + 1024;
constexpr int LX_TSTART = LX_OFF + 5120;
constexpr int LX_TEXP = LX_OFF + 5376;
constexpr int LX_LUT = LX_OFF + 6144;
constexpr int LX_CNT = LX_OFF + 7168;
constexpr int LDS_BYTES = 147456;

namespace pg8 {
struct EpiQKV {
    static constexpr bool PERM = true;
    bf16_t* O; float qscale;
    __device__ __forceinline__ void operator()(const f32x4 (&acc)[2][2][4][2], const Unit& u, int wr, int wc, int fr, int fq) const {
        const int row0 = u.pm * BM + wr * 64 + fr, col0 = u.pn * BM + wc * 32 + 8 * fq; const float sc = ((u.pn < 4) ? qscale : 1.f) * (QKV_FP8 ? IN_DESCALE : 1.f);
#pragma unroll
        for (int ai = 0; ai < 2; ++ai)
#pragma unroll
            for (int m = 0; m < 4; ++m) { bf16_t* rowp = O + (size_t)(row0 + ai * HALF + m * 16) * 3072 + col0;
#pragma unroll
                for (int bj = 0; bj < 2; ++bj) *(u32x4*)(rowp + bj * HALF) = pack8(acc[ai][bj][m][0] * sc, acc[ai][bj][m][1] * sc); }
    }
};
struct EpiRes {
    static constexpr bool PERM = false;
    const float* res; float* out;
    __device__ __forceinline__ void operator()(const f32x4 (&acc)[2][2][4][2], const Unit& u, int wr, int wc, int fr, int fq) const {
        const int row0 = u.pm * BM + wr * 64 + fr, col0 = u.pn * BM + wc * 32 + 4 * fq;
#pragma unroll
        for (int ai = 0; ai < 2; ++ai)
#pragma unroll
            for (int m = 0; m < 4; ++m) { const size_t off = (size_t)(row0 + ai * HALF + m * 16) * 1024 + col0;
#pragma unroll
                for (int bj = 0; bj < 2; ++bj)
#pragma unroll
                    for (int n = 0; n < 2; ++n) { const f32x4 r = *(const f32x4*)(res + off + bj * HALF + n * 16); *(f32x4*)(out + off + bj * HALF + n * 16) = r + acc[ai][bj][m][n]; }
                asm volatile("" ::: "memory"); }
    }
};
__device__ __forceinline__ float silu_f(float x) { return x * __builtin_amdgcn_rcpf(1.0f + __builtin_amdgcn_exp2f(-x * LOG2E)); }
__device__ __forceinline__ unsigned pk4_fp8(float a, float b, float c, float d) { int w = 0; w = __builtin_amdgcn_cvt_pk_fp8_f32(a, b, w, false); w = __builtin_amdgcn_cvt_pk_fp8_f32(c, d, w, true); return (unsigned)w; }
struct EpiMoe1 {
    static constexpr bool PERM = true;
    unsigned char* ACT;
    __device__ __forceinline__ void operator()(const f32x4 (&acc)[2][2][4][2], const Unit& u, int wr, int wc, int fr, int fq) const {
        const int row0 = u.pm * BM + wr * 64 + fr, col0 = (u.pn & 3) * 128 + wc * 32 + 8 * fq; constexpr float si = 1.0f / (H8_SCALE * W1_SCALE);
#pragma unroll
        for (int ai = 0; ai < 2; ++ai)
#pragma unroll
            for (int m = 0; m < 4; ++m) { f32x4 a0, a1;
#pragma unroll
                for (int j = 0; j < 4; ++j) { a0[j] = silu_f(acc[ai][0][m][0][j] * si) * acc[ai][1][m][0][j] * (si * ACT_SCALE); a1[j] = silu_f(acc[ai][0][m][1][j] * si) * acc[ai][1][m][1][j] * (si * ACT_SCALE); }
                u32x2 w; w.x = pk4_fp8(a0[0], a0[1], a0[2], a0[3]); w.y = pk4_fp8(a1[0], a1[1], a1[2], a1[3]);
                *(u32x2*)(ACT + (size_t)(row0 + ai * HALF + m * 16) * 512 + col0) = w; }
    }
};
struct EpiMoe2 {
    static constexpr bool PERM = true;
    bf16_t* Y; const int* list; const float* pairw; const LAS int* lcnt;
    __device__ __forceinline__ void operator()(const f32x4 (&acc)[2][2][4][2], const Unit& u, int wr, int wc, int fr, int fq) const {
        const int e = u.pn >> 2, col0 = (u.pn & 3) * BM + wc * 32 + 8 * fq, pos0 = u.aux * BM + wr * 64 + fr, cn = lcnt[e];
#pragma unroll
        for (int ai = 0; ai < 2; ++ai)
#pragma unroll
            for (int m = 0; m < 4; ++m) { const int pos = pos0 + ai * HALF + m * 16;
                if (pos < cn) { const int pair = list[e * LISTCAP + pos]; const float w = pairw[pair] * (1.0f / (ACT_SCALE * W2_SCALE)); bf16_t* rowp = Y + (size_t)pair * 1024 + col0;
#pragma unroll
                    for (int bj = 0; bj < 2; ++bj) *(u32x4*)(rowp + bj * HALF) = pack8(acc[ai][bj][m][0] * w, acc[ai][bj][m][1] * w); } }
    }
};
__device__ __forceinline__ float log2_gamma(int h) { return __builtin_log2f(1.0f - __builtin_amdgcn_exp2f(-5.0f - (float)h)); }
struct EpiRetA {
    static constexpr bool PERM = true;
    bf16_t* ACAT; bf16_t* KI; bf16_t* SG; const float* sincos;
    __device__ __forceinline__ void operator()(const f32x4 (&acc)[2][2][4][2], const Unit& u, int wr, int wc, int fr, int fq) const {
        const int r0 = wr * 64 + fr, c0 = wc * 32 + 8 * fq;
        if (u.pn >= 8) {
#pragma unroll
            for (int ai = 0; ai < 2; ++ai)
#pragma unroll
                for (int m = 0; m < 4; ++m) { bf16_t* rowp = SG + (size_t)(u.pm * BM + r0 + ai * HALF + m * 16) * 2048 + (u.pn - 8) * BM + c0;
#pragma unroll
                    for (int bj = 0; bj < 2; ++bj) { f32x4 a0, a1;
#pragma unroll
                        for (int j = 0; j < 4; ++j) { a0[j] = silu_f(acc[ai][bj][m][0][j] * IN_DESCALE); a1[j] = silu_f(acc[ai][bj][m][1][j] * IN_DESCALE); }
                        *(u32x4*)(rowp + bj * HALF) = pack8(a0, a1); } }
            return;
        }
        const bool isq = u.pn < 4; const int h = u.pn & 3; const float l2g = log2_gamma(h);
        const int b = u.pm >> 3, n = u.pm & 7;
#pragma unroll
        for (int ai = 0; ai < 2; ++ai)
#pragma unroll
            for (int m = 0; m < 4; ++m) { const int r = r0 + ai * HALF + m * 16, pos = n * RC + r;
                const float fac = IN_DESCALE * (isq ? __builtin_amdgcn_exp2f((float)(r + 1) * l2g) : 0.0625f * __builtin_amdgcn_exp2f(-(float)(r + 1) * l2g));
                bf16_t* rowp = isq ? ACAT + ((size_t)((b * RH + h) * RNC + n) * RC + r) * 512 + 256 + c0 : KI + (size_t)(u.pm * BM + r) * 1024 + h * RDK + c0;
#pragma unroll
                for (int bj = 0; bj < 2; ++bj) { const f32x4* cs = (const f32x4*)(sincos + ((size_t)pos * 128 + (bj * HALF + c0) / 2) * 2);
                    const f32x4 t0 = cs[0], t1 = cs[1]; const f32x4 x0 = acc[ai][bj][m][0], x1 = acc[ai][bj][m][1]; f32x4 y0, y1;
                    y0[0] = (x0[0] * t0[0] - x0[1] * t0[1]) * fac; y0[1] = (x0[1] * t0[0] + x0[0] * t0[1]) * fac; y0[2] = (x0[2] * t0[2] - x0[3] * t0[3]) * fac; y0[3] = (x0[3] * t0[2] + x0[2] * t0[3]) * fac;
                    y1[0] = (x1[0] * t1[0] - x1[1] * t1[1]) * fac; y1[1] = (x1[1] * t1[0] + x1[0] * t1[1]) * fac; y1[2] = (x1[2] * t1[2] - x1[3] * t1[3]) * fac; y1[3] = (x1[3] * t1[2] + x1[2] * t1[3]) * fac;
                    *(u32x4*)(rowp + bj * HALF) = pack8(y0, y1); } }
    }
};
struct EpiRetB {
    static constexpr bool PERM = true;
    bf16_t* KIT; bf16_t* BTCAT; const float* sincosT;
    __device__ __forceinline__ void operator()(const f32x4 (&acc)[2][2][4][2], const Unit& u, int wr, int wc, int fr, int fq) const {
        const int r0 = wr * 64 + fr, c0 = wc * 32 + 8 * fq; const int b = u.pn >> 3, n = u.pn & 7;
        if (u.pm >= 4) { const int h = (u.pm - 4) >> 1, dv0 = ((u.pm - 4) & 1) * BM;
#pragma unroll
            for (int ai = 0; ai < 2; ++ai)
#pragma unroll
                for (int m = 0; m < 4; ++m) { bf16_t* rowp = BTCAT + ((size_t)((b * RH + h) * RNC + n) * RDV + dv0 + r0 + ai * HALF + m * 16) * 512 + c0;
#pragma unroll
                    for (int bj = 0; bj < 2; ++bj) *(u32x4*)(rowp + bj * HALF) = pack8(acc[ai][bj][m][0] * IN_DESCALE, acc[ai][bj][m][1] * IN_DESCALE); }
            return;
        }
        const int h = u.pm; const float l2g = log2_gamma(h);
        float fc[2][8];
#pragma unroll
        for (int bj = 0; bj < 2; ++bj)
#pragma unroll
            for (int j = 0; j < 8; ++j) fc[bj][j] = (0.0625f * IN_DESCALE) * __builtin_amdgcn_exp2f(-(float)(bj * HALF + c0 + j + 1) * l2g);
        const bool odd = (fr & 1) != 0;
#pragma unroll
        for (int ai = 0; ai < 2; ++ai)
#pragma unroll
            for (int m = 0; m < 4; ++m) { const int r = r0 + ai * HALF + m * 16;
                bf16_t* rowp = KIT + ((size_t)((b * RH + h) * RDK + r)) * SEQ + n * RC + c0;
#pragma unroll
                for (int bj = 0; bj < 2; ++bj) { const f32x4* cs = (const f32x4*)(sincosT + ((size_t)(r >> 1) * SEQ + n * RC + bj * HALF + c0) * 2);
                    f32x4 y[2];
#pragma unroll
                    for (int nn = 0; nn < 2; ++nn) { const f32x4 ta = cs[nn * 2], tb = cs[nn * 2 + 1]; const f32x4 x = acc[ai][bj][m][nn]; f32x4 xp;
#pragma unroll
                        for (int j = 0; j < 4; ++j) xp[j] = __shfl_xor(x[j], 1);
                        const float cc[4] = {ta[0], ta[2], tb[0], tb[2]}, ss[4] = {ta[1], ta[3], tb[1], tb[3]};
#pragma unroll
                        for (int j = 0; j < 4; ++j) y[nn][j] = (x[j] * cc[j] + (odd ? xp[j] : -xp[j]) * ss[j]) * fc[bj][nn * 4 + j]; }
                    *(u32x4*)(rowp + bj * HALF) = pack8(y[0], y[1]); } }
    }
};
struct EpiScores {
    static constexpr bool PERM = true;
    bf16_t* ACAT;
    __device__ __forceinline__ void operator()(const f32x4 (&acc)[2][2][4][2], const Unit& u, int wr, int wc, int fr, int fq) const {
        const int r0 = wr * 64 + fr, c0 = wc * 32 + 8 * fq;
#pragma unroll
        for (int ai = 0; ai < 2; ++ai)
#pragma unroll
            for (int m = 0; m < 4; ++m) { const int r = r0 + ai * HALF + m * 16; bf16_t* rowp = ACAT + ((size_t)u.pm * RC + r) * 512 + c0;
#pragma unroll
                for (int bj = 0; bj < 2; ++bj) { f32x4 y0 = acc[ai][bj][m][0], y1 = acc[ai][bj][m][1]; const int cb = bj * HALF + c0;
#pragma unroll
                    for (int j = 0; j < 4; ++j) { if (cb + j > r) y0[j] = 0.f; if (cb + 4 + j > r) y1[j] = 0.f; }
                    *(u32x4*)(rowp + bj * HALF) = pack8(y0, y1); } }
    }
};
struct EpiDS {
    static constexpr bool PERM = true;
    bf16_t* DS;
    __device__ __forceinline__ void operator()(const f32x4 (&acc)[2][2][4][2], const Unit& u, int wr, int wc, int fr, int fq) const {
        const int r0 = wr * 64 + fr, c0 = wc * 32 + 8 * fq;
#pragma unroll
        for (int ai = 0; ai < 2; ++ai)
#pragma unroll
            for (int m = 0; m < 4; ++m) { bf16_t* rowp = DS + ((size_t)u.pm * RDV + u.pn * BM + r0 + ai * HALF + m * 16) * RDK + c0;
#pragma unroll
                for (int bj = 0; bj < 2; ++bj) *(u32x4*)(rowp + bj * HALF) = pack8(acc[ai][bj][m][0], acc[ai][bj][m][1]); }
    }
};
struct EpiRetO {
    static constexpr bool PERM = true;
    bf16_t* ORET;
    __device__ __forceinline__ void operator()(const f32x4 (&acc)[2][2][4][2], const Unit& u, int wr, int wc, int fr, int fq) const {
        const int r0 = wr * 64 + fr, c0 = wc * 32 + 8 * fq; const int n = u.pm & 7, h = (u.pm >> 3) & 3, b = u.pm >> 5;
#pragma unroll
        for (int ai = 0; ai < 2; ++ai)
#pragma unroll
            for (int m = 0; m < 4; ++m) { bf16_t* rowp = ORET + ((size_t)(b * SEQ + n * RC + r0 + ai * HALF + m * 16)) * 2048 + h * RDV + u.pn * BM + c0;
#pragma unroll
                for (int bj = 0; bj < 2; ++bj) *(u32x4*)(rowp + bj * HALF) = pack8(acc[ai][bj][m][0], acc[ai][bj][m][1]); }
    }
};
struct ScoresOrder {
    int G, c;
    __device__ bool next(int i, Unit& u) const { const int L = i * G + c; if (L >= NB * RH * RNC) return false; const int n = L & 7, h = (L >> 3) & 3, b = L >> 5;
        u.pm = L; u.pn = 0; u.aux = 0; u.aoff = (long)L * RC * 512 + 256; u.boff = (long)(b * SEQ + n * RC) * 1024 + h * RDK; return true; }
};
struct DsOrder {
    int G, c;
    __device__ bool next(int i, Unit& u) const { const int L = i * G + c; if (L >= NB * RH * 7 * 2) return false; const int dvt = L & 1, q = L >> 1, n = q % 7, bh = q / 7, p = bh * RNC + n;
        u.pm = p; u.pn = dvt; u.aux = 0; u.aoff = ((long)p * RDV + dvt * BM) * 512; u.boff = (long)bh * RDK * SEQ + n * RC; return true; }
};
struct RetOOrder {
    int G, c;
    __device__ bool next(int i, Unit& u) const { const int L = i * G + c; if (L >= NB * RH * RNC * 2) return false; const int dvt = L & 1, p = L >> 1;
        u.pm = p; u.pn = dvt; u.aux = 0; u.aoff = (long)p * RC * 512; u.boff = ((long)p * RDV + dvt * BM) * 512; return true; }
};
struct MoeOrder {
    int G, c, ldb; long a_tile; const LAS int* tstart; const LAS int* texp;
    __device__ bool next(int i, Unit& u) const { const int L = i * G + c; const int ntiles = tstart[33]; if (L >= ntiles * 4) return false; const int rt = L >> 2, pnl = L & 3, e = texp[rt];
        u.pm = rt; u.pn = e * 4 + pnl; u.aux = rt - tstart[e]; u.aoff = (long)rt * a_tile; u.boff = ((long)e * 1024 + pnl * BM) * ldb; return true; }
};
}
namespace attn_body {
using bf16=__hip_bfloat16;
using bf16x8=__attribute__((ext_vector_type(8)))short;
using s16x4=__attribute__((ext_vector_type(4)))short;
using f32x16=__attribute__((ext_vector_type(16)))float;
using u32x4=__attribute__((ext_vector_type(4)))unsigned;
constexpr int D=64,PQ=3072,PO=1024;
constexpr int NW=8,QBLK=32,QB=QBLK*NW,KVBLK=64,NQB=SEQ/QB;
__device__ __forceinline__ int crow(int r,int hi){return (r&3)+8*(r>>2)+4*hi;}
#define SBAR() __builtin_amdgcn_sched_barrier(0)
__device__ __forceinline__ void biasmask(f32x16&p0,f32x16&p1,int jb6,int qrel,int hi,const LAS float*lut){
  const float NEG=-INFINITY; const int base=128+qrel-64*jb6-4*hi;
  #pragma unroll
  for(int g=0;g<4;++g){
    #pragma unroll
    for(int q=0;q<4;++q){const int r=4*g+q; const int rel=base-(q+8*g); const int rel1=rel-32;
      const float b0=lut[rel<0?0:(rel>128?128:rel)], b1=lut[rel1<0?0:(rel1>128?128:rel1)];
      p0[r]=(rel<0)?NEG:p0[r]+b0; p1[r]=(rel1<0)?NEG:p1[r]+b1;}
    asm volatile("":"+v"(p0),"+v"(p1)); __builtin_amdgcn_sched_barrier(0);}
}
constexpr int NSLOT=3, SLOTB=8192;
constexpr int LDS_K=0, LDS_V=NSLOT*SLOTB, LDS_WS=2*NSLOT*SLOTB, LDS_OST=LDS_WS+NW*64*4, LDS_BYTES=LDS_OST+NW*4096;
__device__ __forceinline__ void glds16(const void*gsrc,unsigned lds_dst){unsigned keep;
  asm volatile("s_mov_b32 %0, m0\n\ts_mov_b32 m0, %2\n\ts_nop 0\n\tglobal_load_lds_dwordx4 %1, off\n\ts_mov_b32 m0, %0":"=&s"(keep):"v"(gsrc),"s"(lds_dst):"memory");}
__device__ __forceinline__ float max3f(float a,float b,float c){float r;asm("v_max3_f32 %0, %1, %2, %3":"=v"(r):"v"(a),"v"(b),"v"(c));return r;}
__device__ __forceinline__ float max2f(float a,float b){float r;asm("v_max_f32_e32 %0, %1, %2":"=v"(r):"v"(a),"v"(b));return r;}
__device__ __forceinline__ float fadd_s(float a,float b){float r;asm("v_add_f32_e32 %0, %1, %2":"=v"(r):"v"(a),"v"(b));return r;}
__device__ __forceinline__ float fsub_s(float a,float b){float r;asm("v_sub_f32_e32 %0, %1, %2":"=v"(r):"v"(a),"v"(b));return r;}
typedef float f32x2_t __attribute__((ext_vector_type(2))); typedef __bf16 bf16x2_t __attribute__((ext_vector_type(2)));
__device__ __forceinline__ unsigned cvtpk_s(float lo,float hi){f32x2_t v={lo,hi};bf16x2_t b=__builtin_convertvector(v,bf16x2_t);return __builtin_bit_cast(unsigned,b);}
#define WAIT_BAR(N) asm volatile("s_waitcnt vmcnt(" #N ") lgkmcnt(0)\n\ts_barrier":::"memory")

__device__ __forceinline__ void qkt(f32x16&p0,f32x16&p1,const char*Kslot,const bf16x8*qr,const f32x16&negm,int r32,int hi){
  const char*kb=Kslot+hi*1024+r32*16;
  #pragma unroll
  for(int d0=0;d0<4;++d0){
    const bf16x8 b0=*reinterpret_cast<const bf16x8*>(kb+d0*2048);
    const bf16x8 b1=*reinterpret_cast<const bf16x8*>(kb+d0*2048+512);
    if(d0==0){p0=__builtin_amdgcn_mfma_f32_32x32x16_bf16(b0,qr[0],negm,0,0,0);p1=__builtin_amdgcn_mfma_f32_32x32x16_bf16(b1,qr[0],negm,0,0,0);}
    else{p0=__builtin_amdgcn_mfma_f32_32x32x16_bf16(b0,qr[d0],p0,0,0,0);p1=__builtin_amdgcn_mfma_f32_32x32x16_bf16(b1,qr[d0],p1,0,0,0);}}
}
typedef LAS const char* lds_cptr;
typedef short v4i16_t __attribute__((ext_vector_type(4)));
__device__ __forceinline__ void kload8(bf16x8*kf,lds_cptr kp){
  kf[0]=*(const LAS bf16x8*)(kp);      kf[1]=*(const LAS bf16x8*)(kp+512);
  kf[2]=*(const LAS bf16x8*)(kp+2048); kf[3]=*(const LAS bf16x8*)(kp+2560);
  kf[4]=*(const LAS bf16x8*)(kp+4096); kf[5]=*(const LAS bf16x8*)(kp+4608);
  kf[6]=*(const LAS bf16x8*)(kp+6144); kf[7]=*(const LAS bf16x8*)(kp+6656);
}
__device__ __forceinline__ void kload2(bf16x8*kf,lds_cptr kp,int j){ kf[2*j]=*(const LAS bf16x8*)(kp+j*2048); kf[2*j+1]=*(const LAS bf16x8*)(kp+j*2048+512); }
__device__ __forceinline__ s16x4 vtr(lds_cptr p){ return __builtin_bit_cast(s16x4,__builtin_amdgcn_ds_read_tr16_b64_v4i16((LAS v4i16_t*)p)); }
__device__ __forceinline__ float rowmax(const f32x16&p0,const f32x16&p1){
  float a=max3f(p0[0],p0[1],p1[0]),b=max3f(p0[2],p0[3],p1[1]);a=max3f(a,p1[2],p1[3]);
  #pragma unroll
  for(int r=4;r<16;r+=4){a=max3f(a,p0[r],p0[r+1]);b=max3f(b,p0[r+2],p0[r+3]);a=max3f(a,p1[r],p1[r+1]);b=max3f(b,p1[r+2],p1[r+3]);}
  const float m=max2f(a,b);
  auto rr=__builtin_amdgcn_permlane32_swap(__float_as_uint(m),__float_as_uint(m),false,false);
  return max2f(__uint_as_float(rr[0]),__uint_as_float(rr[1]));
}
__device__ __forceinline__ void pv(f32x16*o,int vb,bf16x8 pa0,bf16x8 pa1,bf16x8 pa2,bf16x8 pa3){
  #pragma unroll
  for(int d0=0;d0<2;++d0){s16x4 lo[4],hi[4];
    #pragma unroll
    for(int ks=0;ks<4;++ks){
      asm volatile("ds_read_b64_tr_b16 %0,%1 offset:%c2":"=&v"(lo[ks]):"v"(vb),"i"(d0*4096+ks*1024):"memory");
      asm volatile("ds_read_b64_tr_b16 %0,%1 offset:%c2":"=&v"(hi[ks]):"v"(vb),"i"(d0*4096+ks*1024+512):"memory");}
    asm volatile("s_waitcnt lgkmcnt(0)":::"memory");SBAR();
    #define PK(k) (bf16x8){lo[k][0],lo[k][1],lo[k][2],lo[k][3],hi[k][0],hi[k][1],hi[k][2],hi[k][3]}
    o[d0]=__builtin_amdgcn_mfma_f32_32x32x16_bf16(pa0,PK(0),o[d0],0,0,0);
    o[d0]=__builtin_amdgcn_mfma_f32_32x32x16_bf16(pa1,PK(1),o[d0],0,0,0);
    o[d0]=__builtin_amdgcn_mfma_f32_32x32x16_bf16(pa2,PK(2),o[d0],0,0,0);
    o[d0]=__builtin_amdgcn_mfma_f32_32x32x16_bf16(pa3,PK(3),o[d0],0,0,0);
    #undef PK
  }
}
template<int THRL> __device__ __forceinline__ void attn_unit(int b,int qb,const bf16*QKV,int Qc,int Kc,int Vc,bf16*O,const LAS float*lut,char*shm){
  int tid_=threadIdx.x; asm volatile("":"+v"(tid_)); const int tid=tid_,lane=tid&63,r32=lane&31,hi=lane>>5; const int wid=__builtin_amdgcn_readfirstlane(tid>>6);
  const long rowbase=(long)b*SEQ; const int q0=qb*QB;
  const bf16*Qw=QKV+(rowbase+q0+wid*QBLK)*PQ+Qc;
  const bf16*Kh=QKV+rowbase*PQ+Kc,*Vh=QKV+rowbase*PQ+Vc;
  const unsigned lds0=(unsigned)(uintptr_t)shm;
  float*wsf=(float*)(shm+LDS_WS)+wid*64;
  const bf16*ksrc=Kh+(long)lane*PQ+wid*8;
  const bf16*vsrc=Vh+(long)(16*(wid&3)+(lane>>2))*PQ+(wid>>2)*32+(lane&3)*8;
  const unsigned kdst=lds0+LDS_K+wid*1024, vdst=lds0+LDS_V+wid*1024;
  #define DMA_K(t,slot) glds16(ksrc+(long)(t)*KVBLK*PQ,(unsigned)__builtin_amdgcn_readfirstlane(kdst+(slot)))
  #define DMA_V(t,slot) glds16(vsrc+(long)(t)*KVBLK*PQ,(unsigned)__builtin_amdgcn_readfirstlane(vdst+(slot)))
  const int vb0=(int)(lds0+LDS_V)+((lane>>4)&1)*32+(lane&3)*8+(4*hi+((lane&15)>>2))*64;
  const char*Kbase=shm+LDS_K; bf16x8 kf[8];
  const lds_cptr shm3=(lds_cptr)shm; const lds_cptr kp0=shm3+LDS_K+hi*1024+r32*16; const lds_cptr vp0=shm3+LDS_V+((lane>>4)&1)*32+(lane&3)*8+(4*hi+((lane&15)>>2))*64;
  const int NT=(q0+QB)/KVBLK;
  DMA_K(0,0);DMA_V(0,0);DMA_K(1,SLOTB);
  bf16x8 qr[4];
  #pragma unroll
  for(int d0=0;d0<4;++d0)qr[d0]=*reinterpret_cast<const bf16x8*>(&Qw[(long)r32*PQ+d0*16+hi*8]);
  float mhat=0.f,l_reg=0.f;f32x16 o[2];f32x16 negm; { float zz; asm volatile("v_mov_b32 %0, 0":"=v"(zz)); _Pragma("unroll") for(int r=0;r<16;++r){o[0][r]=zz;o[1][r]=zz;negm[r]=zz;} } asm volatile("":"+v"(negm));
  const int qrel=wid*QBLK+r32;
  #define CMASK(P0,P1,t) do{int jb_=(t)-(NT-6); if(jb_>=0)biasmask(P0,P1,jb_,qrel,hi,lut);}while(0)
  bool resc=false;
  #define START(P0,P1) do{ const float rm=rowmax(P0,P1); resc=false; \
    { const float dl=rm; mhat=fadd_s(mhat,dl); \
      _Pragma("unroll") for(int r=0;r<16;++r){P0[r]=fsub_s(P0[r],dl);P1[r]=fsub_s(P1[r],dl);} \
      _Pragma("unroll") for(int r=0;r<16;++r)negm[r]=-mhat; asm volatile("":"+v"(negm)); } \
    _Pragma("unroll") for(int r=0;r<16;++r)P0[r]=__builtin_amdgcn_exp2f(P0[r]); }while(0)
  #define RESC() do{ if(resc){ asm volatile("s_waitcnt lgkmcnt(0)":::"memory"); \
      _Pragma("unroll") for(int d_=0;d_<2;++d_) _Pragma("unroll") for(int r=0;r<16;++r)o[d_][r]*=wsf[crow(r,hi)]; } }while(0)
  f32x16 pA0,pA1,pB0,pB1;
  int sl_prev=0,sl_cur=0,sl_next=SLOTB;
  #define ROT() do{sl_prev=sl_cur;sl_cur=sl_next;sl_next=(sl_next==(NSLOT-1)*SLOTB)?0:sl_next+SLOTB;}while(0)
  DMA_K(2,2*SLOTB);
  WAIT_BAR(3);
  qkt(pA0,pA1,Kbase,qr,negm,r32,hi);asm volatile("s_nop 15\n\ts_nop 7":"+v"(pA0),"+v"(pA1));CMASK(pA0,pA1,0);
  START(pA0,pA1);
  _Pragma("unroll") for(int r=0;r<16;++r)pA1[r]=__builtin_amdgcn_exp2f(pA1[r]);
  WAIT_BAR(0);
  DMA_K(3,0);DMA_V(1,SLOTB);
  ROT();
  kload8(kf,kp0+sl_cur);
  WAIT_BAR(2);
  s16x4 vlo[8],vhi[8]; u32x4 pw0,pw1,pw2,pw3;
  #define PKW(P,B) cvtpk_s(P[B],P[B+1])
  #define PAF(k) __builtin_bit_cast(bf16x8,pw##k)
  #define VFR(i) (bf16x8){vlo[i][0],vlo[i][1],vlo[i][2],vlo[i][3],vhi[i][0],vhi[i][1],vhi[i][2],vhi[i][3]}
  #define PIN(x) asm volatile("":"+v"(x))
  #define MX3(a,b,c) __builtin_fmaxf(__builtin_fmaxf((a),(b)),(c))
  #define GAPA(MF,A0,A1,A2,A3,W0,W1,PW) do{ MF; sacc+=A0; sacc+=A1; sacc+=A2; sacc+=A3; PIN(sacc); W0; W1; PIN(PW); SBAR(); }while(0)
  #define EX(v) __builtin_amdgcn_exp2f(v)
  #define GAPB(MF,X,B) do{ MF; X[B]=EX(X[B]); X[B+1]=EX(X[B+1]); X[B+2]=EX(X[B+2]); X[B+3]=EX(X[B+3]); PIN(X); SBAR(); }while(0)
  #define VRD(i) do{ vlo[i]=vtr(vp_+(((i)>>2)*4096+((i)&3)*1024)); vhi[i]=vtr(vp_+(((i)>>2)*4096+((i)&3)*1024+512)); }while(0)
  #define KRD(G,j) do{ if(G){ kload2(kf,kp0+sl_next,j); SBAR(); } }while(0)
  #define STEP(C0,C1,P0,P1,t,GK,GV,GL) do{ SBAR(); \
    const lds_cptr vp_=vp0+sl_prev; \
    VRD(0); SBAR(); float sacc=(P0[0]+P0[1]); \
    GAPA(C0=__builtin_amdgcn_mfma_f32_32x32x16_bf16(kf[0],qr[0],negm,0,0,0), P0[2],P0[3],P0[4],P0[5],     pw0[0]=PKW(P0,0), pw0[1]=PKW(P0,2), pw0); \
    VRD(4); SBAR(); GAPA(C1=__builtin_amdgcn_mfma_f32_32x32x16_bf16(kf[1],qr[0],negm,0,0,0), P0[6],P0[7],P0[8],P0[9],     pw0[2]=PKW(P0,4), pw0[3]=PKW(P0,6), pw0); \
    VRD(1); SBAR(); GAPA(C0=__builtin_amdgcn_mfma_f32_32x32x16_bf16(kf[2],qr[1],C0,0,0,0),   P0[10],P0[11],P0[12],P0[13], pw1[0]=PKW(P0,8), pw1[1]=PKW(P0,10), pw1); \
    VRD(5); SBAR(); GAPA(C1=__builtin_amdgcn_mfma_f32_32x32x16_bf16(kf[3],qr[1],C1,0,0,0),   P0[14],P0[15],P1[0],P1[1],   pw1[2]=PKW(P0,12),pw1[3]=PKW(P0,14), pw1); \
    VRD(2); SBAR(); GAPA(C0=__builtin_amdgcn_mfma_f32_32x32x16_bf16(kf[4],qr[2],C0,0,0,0),   P1[2],P1[3],P1[4],P1[5],     pw2[0]=PKW(P1,0), pw2[1]=PKW(P1,2), pw2); \
    VRD(6); SBAR(); GAPA(C1=__builtin_amdgcn_mfma_f32_32x32x16_bf16(kf[5],qr[2],C1,0,0,0),   P1[6],P1[7],P1[8],P1[9],     pw2[2]=PKW(P1,4), pw2[3]=PKW(P1,6), pw2); \
    VRD(3); SBAR(); GAPA(C0=__builtin_amdgcn_mfma_f32_32x32x16_bf16(kf[6],qr[3],C0,0,0,0),   P1[10],P1[11],P1[12],P1[13], pw3[0]=PKW(P1,8), pw3[1]=PKW(P1,10), pw3); \
    VRD(7); SBAR(); GAPA(C1=__builtin_amdgcn_mfma_f32_32x32x16_bf16(kf[7],qr[3],C1,0,0,0),   P1[14],P1[15],0.f,0.f,       pw3[2]=PKW(P1,12),pw3[3]=PKW(P1,14), pw3); \
    l_reg+=sacc; \
    if(GK){DMA_K((t)+3,sl_cur);} if(GV){DMA_V((t)+1,sl_next);} \
    CMASK(C0,C1,t); \
    { float a=MX3(C0[0],C0[1],C1[0]),b=MX3(C0[2],C0[3],C1[1]); a=MX3(a,C1[2],C1[3]); \
      _Pragma("unroll") for(int r=4;r<16;r+=4){a=MX3(a,C0[r],C0[r+1]);b=MX3(b,C0[r+2],C0[r+3]);a=MX3(a,C1[r],C1[r+1]);b=MX3(b,C1[r+2],C1[r+3]);} \
      float rm=__builtin_fmaxf(a,b); { auto rr=__builtin_amdgcn_permlane32_swap(__float_as_uint(rm),__float_as_uint(rm),false,false); rm=__builtin_fmaxf(__uint_as_float(rr[0]),__uint_as_float(rr[1])); } \
      resc=false; \
      if(__builtin_expect(__any(rm>(float)THRL),0)){ const float dl=__builtin_fmaxf(rm,0.f); mhat+=dl; \
        _Pragma("unroll") for(int r=0;r<16;++r){C0[r]-=dl;C1[r]-=dl;} \
        _Pragma("unroll") for(int r=0;r<16;++r)negm[r]=-mhat; asm volatile("":"+v"(negm)); \
        const float f=__builtin_amdgcn_exp2f(-dl); l_reg*=f; if(hi==0)wsf[r32]=f; resc=true; } } \
    SBAR(); \
    GAPB(o[0]=__builtin_amdgcn_mfma_f32_32x32x16_bf16(PAF(0),VFR(0),o[0],0,0,0), C0,0); \
    GAPB(o[1]=__builtin_amdgcn_mfma_f32_32x32x16_bf16(PAF(0),VFR(4),o[1],0,0,0), C0,4); \
    KRD(GL,0); GAPB(o[0]=__builtin_amdgcn_mfma_f32_32x32x16_bf16(PAF(1),VFR(1),o[0],0,0,0), C0,8); \
    KRD(GL,1); GAPB(o[1]=__builtin_amdgcn_mfma_f32_32x32x16_bf16(PAF(1),VFR(5),o[1],0,0,0), C0,12); \
    KRD(GL,2); GAPB(o[0]=__builtin_amdgcn_mfma_f32_32x32x16_bf16(PAF(2),VFR(2),o[0],0,0,0), C1,0); \
    KRD(GL,3); GAPB(o[1]=__builtin_amdgcn_mfma_f32_32x32x16_bf16(PAF(2),VFR(6),o[1],0,0,0), C1,4); \
    GAPB(o[0]=__builtin_amdgcn_mfma_f32_32x32x16_bf16(PAF(3),VFR(3),o[0],0,0,0), C1,8); \
    GAPB(o[1]=__builtin_amdgcn_mfma_f32_32x32x16_bf16(PAF(3),VFR(7),o[1],0,0,0), C1,12); \
    }while(0)
  int t=1;
  #undef CMASK
  #define CMASK(P0,P1,t) do{}while(0)
  for(;t+7<NT;t+=2){
    STEP(pB0,pB1,pA0,pA1,t,true,true,true);     WAIT_BAR(2); RESC(); ROT();
    STEP(pA0,pA1,pB0,pB1,t+1,true,true,true);   WAIT_BAR(2); RESC(); ROT();
  }
  #undef CMASK
  #define CMASK(P0,P1,t) do{int jb_=(t)-(NT-6); if(jb_>=0)biasmask(P0,P1,jb_,qrel,hi,lut);}while(0)
  #define ENDW(tt) do{ if((tt)+3<NT){WAIT_BAR(2);} else if((tt)+2<NT){WAIT_BAR(1);} else {WAIT_BAR(0);} }while(0)
  for(;t+1<NT;t+=2){
    STEP(pB0,pB1,pA0,pA1,t,(t+3<NT),(t+1<NT),(t+1<NT));       ENDW(t);   RESC(); ROT();
    STEP(pA0,pA1,pB0,pB1,t+1,(t+4<NT),(t+2<NT),(t+2<NT));     ENDW(t+1); RESC(); ROT();
  }
  STEP(pB0,pB1,pA0,pA1,NT-1,false,false,false); RESC();
  { float sacc=pB0[0]+pB0[1]; _Pragma("unroll") for(int r=2;r<16;++r)sacc+=pB0[r]; _Pragma("unroll") for(int r=0;r<16;++r)sacc+=pB1[r]; l_reg+=sacc;
    pw0=(u32x4){PKW(pB0,0),PKW(pB0,2),PKW(pB0,4),PKW(pB0,6)};pw1=(u32x4){PKW(pB0,8),PKW(pB0,10),PKW(pB0,12),PKW(pB0,14)};pw2=(u32x4){PKW(pB1,0),PKW(pB1,2),PKW(pB1,4),PKW(pB1,6)};pw3=(u32x4){PKW(pB1,8),PKW(pB1,10),PKW(pB1,12),PKW(pB1,14)};
    SBAR(); pv(o,vb0+sl_cur,PAF(0),PAF(1),PAF(2),PAF(3)); }
  #undef PKW
  #undef PAF
  #undef VFR
  #undef PIN
  #undef MX3
  #undef GAPA
  #undef GAPB
  #undef EX
  #undef VRD
  #undef KRD
  #undef STEP
  #undef ENDW
  {auto rr=__builtin_amdgcn_permlane32_swap(__float_as_uint(l_reg),__float_as_uint(l_reg),false,false);l_reg=__uint_as_float(rr[0])+__uint_as_float(rr[1]);}
  if(hi==0)wsf[32+r32]=l_reg;asm volatile("s_waitcnt lgkmcnt(0)":::"memory");
  float rli[16];
  #pragma unroll
  for(int r=0;r<16;++r)rli[r]=__builtin_amdgcn_rcpf(wsf[32+crow(r,hi)]);
  bf16*Ow=O+(rowbase+q0+wid*QBLK)*PO;
  { bf16*stg=(bf16*)(shm+LDS_OST)+wid*2048;
    #pragma unroll
    for(int r=0;r<16;++r){const int orow=crow(r,hi);
      #pragma unroll
      for(int d0=0;d0<2;++d0)stg[orow*64+d0*32+r32]=__float2bfloat16(o[d0][r]*rli[r]);}
    asm volatile("s_waitcnt lgkmcnt(0)":::"memory");
    #pragma unroll
    for(int i=0;i<4;++i){const int row=i*8+(lane>>3),ch=lane&7; const u32x4 v=*(const u32x4*)(stg+row*64+ch*8); *(u32x4*)(Ow+(long)row*PO+ch*8)=v;} }
  asm volatile("s_waitcnt lgkmcnt(0)\n\ts_barrier":::"memory");
  #undef DMA_K
  #undef DMA_V
  #undef CMASK
  #undef START
  #undef RESC
  #undef ROT
}
constexpr int ATTN_LDS_BYTES=LDS_BYTES;
#undef SBAR
#undef WAIT_BAR
}
constexpr int NWAVES = 8;
typedef unsigned short bf16;
typedef unsigned v4u __attribute__((ext_vector_type(4)));
typedef unsigned v2u __attribute__((ext_vector_type(2)));
typedef float f32x4 __attribute__((ext_vector_type(4)));
typedef float f32x2 __attribute__((ext_vector_type(2)));
typedef short bf16x8 __attribute__((ext_vector_type(8)));
typedef GAS unsigned gu32;
#define RLX_AGENT __ATOMIC_RELAXED, __HIP_MEMORY_SCOPE_AGENT
#define LDS_WAIT() asm volatile("s_waitcnt lgkmcnt(0)" ::: "memory")
#define VM_WAIT() asm volatile("s_waitcnt vmcnt(0)" ::: "memory")
__device__ __forceinline__ unsigned f2bf(float f) { unsigned u = __builtin_bit_cast(unsigned, f); return (u + 0x7fffu + ((u >> 16) & 1u)) >> 16; }
__device__ __forceinline__ unsigned pk2(float lo, float hi) { return f2bf(lo) | (f2bf(hi) << 16); }
__device__ __forceinline__ float bf2f(unsigned short b) { return __builtin_bit_cast(float, (unsigned)b << 16); }
__device__ __forceinline__ float bflo(unsigned w) { return __builtin_bit_cast(float, w << 16); }
__device__ __forceinline__ float bfhi(unsigned w) { return __builtin_bit_cast(float, w & 0xffff0000u); }

#define XB_TMO      128
#define XB_XCNT(j)  (256  + 64 * (j))
#define XB_XSUB(j)  (1280 + 64 * (j))
#define XB_XGEN(j)  (2304 + 64 * (j))
#define XB_TOP      3328
#define XB_TOPGEN   3392
#define XCD_BAR_WORDS 3456
#define XB_SPIN_CAP (1u << 18)
__device__ __forceinline__ unsigned xb_ld(unsigned* p)              { return __hip_atomic_load(p, __ATOMIC_RELAXED, __HIP_MEMORY_SCOPE_AGENT); }
__device__ __forceinline__ unsigned xb_add(unsigned* p, unsigned v) { return __hip_atomic_fetch_add(p, v, __ATOMIC_RELAXED, __HIP_MEMORY_SCOPE_AGENT); }
__device__ __forceinline__ unsigned xb_xcc_id() { return (unsigned)__builtin_amdgcn_s_getreg((3 << 11) | 20) & 0xFu; }
#define XB_SPIN(cond, bar) do { unsigned _sp = 0; while (cond) { __builtin_amdgcn_s_sleep(1); \
    if ((++_sp & 255u) == 0u) { if (xb_ld(&(bar)[XB_TMO])) break; if (_sp > XB_SPIN_CAP) { atomicAdd(&(bar)[XB_TMO], 1u); break; } } } } while (0)
struct XcdBarrier { unsigned* bar; unsigned x; volatile LAS unsigned* st; };
__device__ __forceinline__ XcdBarrier xcd_barrier_post(unsigned* bar, volatile LAS unsigned* st) {
    XcdBarrier b; b.bar = bar; b.x = xb_xcc_id(); b.st = st;
    if (threadIdx.x == 0) (void)xb_add(&bar[XB_XCNT(b.x)], 1u);
    return b;
}
__device__ __forceinline__ void xcd_barrier_complete(unsigned* bar, unsigned x, unsigned& nloc, unsigned& nx) {
    const unsigned G = gridDim.x * gridDim.y * gridDim.z;
    unsigned sum, cnt, mine, sp = 0u;
    for (;;) {
        sum = 0u; cnt = 0u; mine = 0u;
#pragma unroll
        for (unsigned j = 0; j < 16; ++j) { const unsigned c = xb_ld(&bar[XB_XCNT(j)]); sum += c; cnt += (c > 0u) ? 1u : 0u; mine = (j == x) ? c : mine; }
        if (sum == G) break;
        __builtin_amdgcn_s_sleep(1);
        if ((++sp & 255u) == 0u) { if (xb_ld(&bar[XB_TMO])) break; if (sp > XB_SPIN_CAP) { atomicAdd(&bar[XB_TMO], 1u); break; } }
    }
    nloc = mine > 0u ? mine : 1u; nx = cnt > 0u ? cnt : 1u;
}
__device__ __forceinline__ void xcd_barrier(const XcdBarrier& b) {
    asm volatile("s_waitcnt vmcnt(0)" ::: "memory");
    __syncthreads();
    if (threadIdx.x == 0) {
        unsigned* bar = b.bar;
        __builtin_amdgcn_s_waitcnt(0);
        unsigned nloc = b.st[0], nx = b.st[1];
        if (nloc == 0u) { xcd_barrier_complete(bar, b.x, nloc, nx); b.st[0] = nloc; b.st[1] = nx; }
        const unsigned old = xb_add(&bar[XB_XSUB(b.x)], 1u);
        const unsigned gen = old / nloc;
        if (old + 1u == (gen + 1u) * nloc) {
            __builtin_amdgcn_fence(__ATOMIC_RELEASE, "agent");
            asm volatile("s_waitcnt vmcnt(0)" ::: "memory");
            const unsigned og = xb_add(&bar[XB_TOP], 1u);
            const unsigned tg = og / nx;
            if (og + 1u == (tg + 1u) * nx) xb_add(&bar[XB_TOPGEN], 1u);
            else XB_SPIN(xb_ld(&bar[XB_TOPGEN]) == tg, bar);
            __builtin_amdgcn_fence(__ATOMIC_ACQUIRE, "agent");
            xb_add(&bar[XB_XGEN(b.x)], 1u);
            asm volatile("s_waitcnt vmcnt(0)" ::: "memory");
        } else {
            XB_SPIN(xb_ld(&bar[XB_XGEN(b.x)]) == gen, bar);
            __builtin_amdgcn_fence(__ATOMIC_ACQUIRE, "agent");
            asm volatile("s_waitcnt vmcnt(0)" ::: "memory");
        }
    }
    __syncthreads();
}

struct Args { const float* in[18]; float* out; unsigned char* ws; int ph_lo, ph_hi, li, pad; };
struct Frame {
    LAS unsigned char* lds;
    gu32* ctl;
    unsigned char* ws;
    int tid, lane, wave;
    int vcu, G;
};

__device__ __forceinline__ float wave_sum(float v) {
#pragma unroll
    for (int o = 1; o < 64; o <<= 1) v += __shfl_xor(v, o);
    return v;
}
__device__ __forceinline__ void transpose_block(const float* src, int ld_src, bf16* dst, int ld_dst, LAS float* scr, int lane, bf16* dst2) {
#pragma unroll 8
    for (int i = 0; i < 32; ++i) { const int kk = 2 * i + (lane >> 5); scr[kk * 33 + (lane & 31)] = src[(size_t)kk * ld_src + (lane & 31)]; }
    LDS_WAIT(); asm volatile("" ::: "memory");
    const int c = lane & 7;
#pragma unroll
    for (int j = 0; j < 4; ++j) { const int n = (lane >> 3) + 8 * j; const LAS float* s = scr + (8 * c) * 33 + n;
        v4u o; o.x = pk2(s[0 * 33], s[1 * 33]); o.y = pk2(s[2 * 33], s[3 * 33]); o.z = pk2(s[4 * 33], s[5 * 33]); o.w = pk2(s[6 * 33], s[7 * 33]);
        *(GAS v4u*)(dst + (size_t)n * ld_dst + 8 * c) = o;
        if (dst2) *(GAS v4u*)(dst2 + (size_t)n * ld_dst + 8 * c) = o; }
    LDS_WAIT(); asm volatile("" ::: "memory");
}
__device__ __forceinline__ unsigned pk4_fp8f(float a, float b, float c, float d) { int w = 0; w = __builtin_amdgcn_cvt_pk_fp8_f32(a, b, w, false); w = __builtin_amdgcn_cvt_pk_fp8_f32(c, d, w, true); return (unsigned)w; }
__device__ __forceinline__ void transpose_block8(const float* src, int ld_src, unsigned char* dst, int ld_dst, float sc, LAS float* scr, int lane, unsigned char* dst2 = nullptr) {
#pragma unroll 8
    for (int i = 0; i < 32; ++i) { const int kk = 2 * i + (lane >> 5); scr[kk * 33 + (lane & 31)] = src[(size_t)kk * ld_src + (lane & 31)]; }
    LDS_WAIT(); asm volatile("" ::: "memory");
    const int c = lane & 7;
#pragma unroll
    for (int j = 0; j < 4; ++j) { const int n = (lane >> 3) + 8 * j; const LAS float* s = scr + (8 * c) * 33 + n;
        v2u o; o.x = pk4_fp8f(s[0 * 33] * sc, s[1 * 33] * sc, s[2 * 33] * sc, s[3 * 33] * sc); o.y = pk4_fp8f(s[4 * 33] * sc, s[5 * 33] * sc, s[6 * 33] * sc, s[7 * 33] * sc);
        *(GAS v2u*)(dst + (size_t)n * ld_dst + 8 * c) = o;
        if (dst2) *(GAS v2u*)(dst2 + (size_t)n * ld_dst + 8 * c) = o; }
    LDS_WAIT(); asm volatile("" ::: "memory");
}
__device__ __forceinline__ void rms_row_to_bf16(int lane, const float* xrow, const float* g, bf16* orow) {
    const GAS f32x4* xr = (const GAS f32x4*)xrow + lane; const GAS f32x4* gr = (const GAS f32x4*)g + lane;
    f32x4 v[4]; float s = 0.f;
#pragma unroll
    for (int j = 0; j < 4; ++j) { v[j] = xr[64 * j]; s += (v[j].x * v[j].x + v[j].y * v[j].y) + (v[j].z * v[j].z + v[j].w * v[j].w); }
    const float rstd = 1.0f / sqrtf(wave_sum(s) * (1.f / 1024.f) + RMS_EPS);
    GAS v2u* o8 = (GAS v2u*)orow + lane;
#pragma unroll
    for (int j = 0; j < 4; ++j) { const f32x4 gg = gr[64 * j]; v2u o; o.x = pk2(v[j].x * rstd * gg.x, v[j].y * rstd * gg.y); o.y = pk2(v[j].z * rstd * gg.z, v[j].w * rstd * gg.w); o8[64 * j] = o; }
}

__device__ __forceinline__ void rms_row_to_fp8(int lane, const float* xrow, const float* g, unsigned char* orow) {
    const GAS f32x4* xr = (const GAS f32x4*)xrow + lane; const GAS f32x4* gr = (const GAS f32x4*)g + lane;
    f32x4 v[4]; float s = 0.f;
#pragma unroll
    for (int j = 0; j < 4; ++j) { v[j] = xr[64 * j]; s += (v[j].x * v[j].x + v[j].y * v[j].y) + (v[j].z * v[j].z + v[j].w * v[j].w); }
    const float rstd = H8_SCALE / sqrtf(wave_sum(s) * (1.f / 1024.f) + RMS_EPS);
    GAS unsigned* o4 = (GAS unsigned*)orow + lane;
#pragma unroll
    for (int j = 0; j < 4; ++j) { const f32x4 gg = gr[64 * j]; o4[64 * j] = pk4_fp8f(v[j].x * rstd * gg.x, v[j].y * rstd * gg.y, v[j].z * rstd * gg.z, v[j].w * rstd * gg.w); }
}
constexpr int IT_WIN0 = (1024 / 64) * (3072 / 32);
constexpr int IT_WOUT0 = (1024 / 64) * (1024 / 32);
constexpr int IT_RIN = (1024 / 64) * (6144 / 32);
constexpr int IT_ROUT = (2048 / 64) * (1024 / 32);
constexpr int IT_SHARED = IT_WIN0 + IT_WOUT0 + IT_RIN + IT_ROUT;
constexpr int IT_EXP = 3 * 256;
constexpr int IT_MOE = NEXP * IT_EXP;
__device__ __forceinline__ void conv_shared_item(Frame& F, const Args& a, int it, LAS float* scr) {
    unsigned char* ws = F.ws;
    if (it < IT_WIN0) { const int nblk = 96, kb = it / nblk, nb = it % nblk;
        if (QKV_FP8) transpose_block8(a.in[5] + (size_t)(64 * kb) * 3072 + 32 * nb, 3072, ws + WS_WINT0 + (size_t)(32 * nb) * 1024 + 64 * kb, 1024, WIN_SCALE, scr, F.lane);
        else transpose_block(a.in[5] + (size_t)(64 * kb) * 3072 + 32 * nb, 3072, (bf16*)(ws + WS_WINT0) + (size_t)(32 * nb) * 1024 + 64 * kb, 1024, scr, F.lane, nullptr);
        return; }
    it -= IT_WIN0;
    if (it < IT_WOUT0) { const int nblk = 32, kb = it / nblk, nb = it % nblk;
        transpose_block(a.in[8] + (size_t)(64 * kb) * 1024 + 32 * nb, 1024, (bf16*)(ws + WS_WOUTT0) + (size_t)(32 * nb) * 1024 + 64 * kb, 1024, scr, F.lane, nullptr); return; }
    it -= IT_WOUT0;
    if (it < IT_RIN) { const int nblk = 192, kb = it / nblk, nb = it % nblk, n0 = 32 * nb;
        unsigned char* A = ws + WS_WRINA; unsigned char* B = ws + WS_WRINB; unsigned char *d1, *d2 = nullptr;
        if (n0 < 1024) d1 = A + (size_t)n0 * 1024;
        else if (n0 < 2048) { d1 = A + (size_t)n0 * 1024; d2 = B + (size_t)(n0 - 1024) * 1024; }
        else if (n0 < 4096) d1 = B + (size_t)(n0 - 1024) * 1024;
        else d1 = A + (size_t)(n0 - 2048) * 1024;
        transpose_block8(a.in[9] + (size_t)(64 * kb) * 6144 + n0, 6144, d1 + 64 * kb, 1024, WIN_SCALE, scr, F.lane, d2 ? d2 + 64 * kb : nullptr); return; }
    it -= IT_RIN;
    { const int nblk = 32, kb = it / nblk, nb = it % nblk;
        transpose_block(a.in[10] + (size_t)(64 * kb) * 1024 + 32 * nb, 1024, (bf16*)(ws + WS_WROUTT) + (size_t)(32 * nb) * 2048 + 64 * kb, 2048, scr, F.lane, nullptr); }
}
__device__ __forceinline__ void conv_moe_item(Frame& F, const Args& a, int layer, int it, LAS float* scr) {
    unsigned char* ws = F.ws;
    const int e = it / IT_EXP; int r = it % IT_EXP; const size_t le = (size_t)layer * NEXP + e;
    if (r < 512) { const int up = r >> 8; r &= 255; const int kb = r / 16, nb = r % 16, n0 = 32 * nb;
        const float* src = a.in[up ? 16 : 15] + le * (1024 * 512) + (size_t)(64 * kb) * 512 + n0;
        const int drow = 256 * (n0 >> 7) + 128 * up + (n0 & 127);
        transpose_block8(src, 512, ws + WS_W1CAT + ((size_t)e * 1024 + drow) * 1024 + 64 * kb, 1024, W1_SCALE, scr, F.lane); return; }
    r -= 512; { const int kb = r / 32, nb = r % 32;
        const float* src = a.in[17] + le * (512 * 1024) + (size_t)(64 * kb) * 1024 + 32 * nb;
        transpose_block8(src, 1024, ws + WS_W2T + ((size_t)e * 1024 + 32 * nb) * 512 + 64 * kb, 512, W2_SCALE, scr, F.lane); }
}
__device__ __forceinline__ void build_router_frags(Frame& F, const Args& a, int gtid, int gthreads) {
    bf16* wrf = (bf16*)(F.ws + WS_WRF);
    for (int idx = gtid; idx < 2 * 32 * 3 * 64 * 8; idx += gthreads) {
        const int j = idx & 7, lane = (idx >> 3) & 63, nt = (idx >> 9) % 3, s = ((idx >> 9) / 3) & 31, L = (idx >> 9) / 96;
        const int k = 32 * s + 8 * (lane >> 4) + j, o = 16 * nt + (lane & 15);
        float w = 0.f;
        if (o < 4) w = a.in[11][((size_t)L * 1024 + k) * 4 + o]; else if (o < 36) w = a.in[13][((size_t)L * 1024 + k) * 32 + (o - 4)];
        w *= a.in[3][L * 1024 + k];
        const unsigned hi = f2bf(w); const float lo = w - __builtin_bit_cast(float, hi << 16);
        const size_t base = ((((size_t)L * 32 + s) * 3 + nt) * 2) * 512 + (size_t)lane * 8 + j;
        wrf[base] = (bf16)hi; wrf[base + 512] = (bf16)f2bf(lo);
    }
}
__device__ __forceinline__ void build_sincos(Frame& F, int gtid, int gthreads) {
    float* t1 = (float*)(F.ws + WS_SINCOS); float* t2 = (float*)(F.ws + WS_SINCOST);
    for (int idx = gtid; idx < SEQ * 128; idx += gthreads) {
        const int pos = idx >> 7, i = idx & 127;
        double ang = 1.0, bs = 0.9300449458481391;
        for (int bit = 0; bit < 7; ++bit) { if ((i >> bit) & 1) ang *= bs; bs *= bs; }
        const double ph = (double)pos * ang;
        const double kq = __builtin_rint(ph * 0.63661977236758134308);
        double r = __builtin_fma(-kq, 1.57079632679489655800, ph); r = __builtin_fma(-kq, 6.12323399573676603587e-17, r);
        const double r2 = r * r;
        double sn = r * (1.0 + r2 * (-1.0 / 6 + r2 * (1.0 / 120 + r2 * (-1.0 / 5040 + r2 * (1.0 / 362880 + r2 * (-1.0 / 39916800 + r2 * (1.0 / 6227020800.0)))))));
        double cs = 1.0 + r2 * (-0.5 + r2 * (1.0 / 24 + r2 * (-1.0 / 720 + r2 * (1.0 / 40320 + r2 * (-1.0 / 3628800 + r2 * (1.0 / 479001600.0 + r2 * (-1.0 / 87178291200.0)))))));
        const int q = ((int)kq) & 3;
        double s_ = (q == 0) ? sn : (q == 1) ? cs : (q == 2) ? -sn : -cs;
        double c_ = (q == 0) ? cs : (q == 1) ? -sn : (q == 2) ? -cs : sn;
        t1[(size_t)idx * 2] = (float)c_; t1[(size_t)idx * 2 + 1] = (float)s_;
        const size_t j = ((size_t)i * SEQ + pos) * 2; t2[j] = (float)c_; t2[j + 1] = (float)s_;
    }
}
__device__ __forceinline__ void p_prologue(Frame& F, const Args& a) {
    LAS float* scr = (LAS float*)(F.lds + RING_OFF + F.wave * 16384);
    const int gw = F.vcu * NWAVES + F.wave, NGW = F.G * NWAVES;
    for (int it = gw; it < IT_SHARED + IT_MOE; it += NGW) { if (it < IT_SHARED) conv_shared_item(F, a, it, scr); else conv_moe_item(F, a, 0, it - IT_SHARED, scr); }
    build_router_frags(F, a, F.vcu * 512 + F.tid, F.G * 512);
    build_sincos(F, F.vcu * 512 + F.tid, F.G * 512);
    for (int m = gw; m < TOK; m += NGW) { if (QKV_FP8) rms_row_to_fp8(F.lane, a.in[0] + (size_t)m * DM, a.in[2], F.ws + WS_HB + (size_t)m * DM); else rms_row_to_bf16(F.lane, a.in[0] + (size_t)m * DM, a.in[2], (bf16*)(F.ws + WS_HB) + (size_t)m * DM); }
}
__device__ __forceinline__ void p_attention(Frame& F, const Args& a) {
    LAS float* lut = (LAS float*)(F.lds + LX_LUT);
    const attn_body::bf16* QKV = (const attn_body::bf16*)(F.ws + WS_QKV0);
    for (int v = F.vcu; v < 256; v += F.G) {
        const int bh = v >> 2, s = v & 3, b = bh >> 3, h = bh & 7;
        __syncthreads();
        if (F.tid < 132) { const int n = F.tid; int bk = n;
            if (n >= 16) { bk = 16; const int thr[15] = {19, 21, 24, 27, 31, 35, 40, 46, 52, 59, 67, 77, 87, 99, 113};
#pragma unroll
                for (int q = 0; q < 15; ++q) bk += (n >= thr[q]) ? 1 : 0; }
            lut[n] = (a.in[1][bk * 8 + h] - a.in[1][31 * 8 + h]) * LOG2E; }
        __syncthreads();
        for (int i = 0; i < 8; ++i) {
            const int qb = (i < 4) ? 7 - s : s, m = (i >> 1) & 1, vh = i & 1;
            attn_body::bf16* O = (attn_body::bf16*)(F.ws + WS_OP) + (size_t)m * TOK * 1024 + h * 128 + vh * 64;
            attn_body::attn_unit<8>(b, qb, QKV, h * 128 + m * 64, 1024 + h * 128 + m * 64, 2048 + h * 128 + vh * 64, O, lut, (char*)F.lds + RING_OFF);
        }
    }
}
__device__ __forceinline__ void p_diffcombine(Frame& F, const Args& a) {
    const int gw = F.vcu * NWAVES + F.wave, NGW = F.G * NWAVES, lane = F.lane;
    const float* lq = a.in[6];
    const float lam = __expf(wave_sum(lq[lane] * lq[64 + lane])) - __expf(wave_sum(lq[128 + lane] * lq[192 + lane])) + 0.2f;
    const int d0 = (lane & 7) * 16; float g[16];
#pragma unroll
    for (int j = 0; j < 16; ++j) g[j] = a.in[7][d0 + j] * 0.8f;
    const bf16* O0 = (const bf16*)(F.ws + WS_OP); const bf16* O1 = O0 + (size_t)TOK * 1024; bf16* AO = (bf16*)(F.ws + WS_AO);
    for (int m = gw; m < TOK; m += NGW) {
        const GAS v4u* p0 = (const GAS v4u*)(O0 + (size_t)m * 1024 + lane * 16); const GAS v4u* p1 = (const GAS v4u*)(O1 + (size_t)m * 1024 + lane * 16);
        const v4u a0 = p0[0], a1 = p0[1], b0 = p1[0], b1 = p1[1];
        const unsigned wa[8] = {a0.x, a0.y, a0.z, a0.w, a1.x, a1.y, a1.z, a1.w}, wb[8] = {b0.x, b0.y, b0.z, b0.w, b1.x, b1.y, b1.z, b1.w};
        float o[16]; float ss = 0.f;
#pragma unroll
        for (int j = 0; j < 8; ++j) { o[2 * j] = bflo(wa[j]) - lam * bflo(wb[j]); o[2 * j + 1] = bfhi(wa[j]) - lam * bfhi(wb[j]); ss += o[2 * j] * o[2 * j] + o[2 * j + 1] * o[2 * j + 1]; }
        ss += __shfl_xor(ss, 1); ss += __shfl_xor(ss, 2); ss += __shfl_xor(ss, 4);
        const float rstd = 1.0f / sqrtf(ss * (1.f / 128.f) + SUBLN_EPS);
        v4u w0, w1;
        w0.x = pk2(o[0] * rstd * g[0], o[1] * rstd * g[1]); w0.y = pk2(o[2] * rstd * g[2], o[3] * rstd * g[3]); w0.z = pk2(o[4] * rstd * g[4], o[5] * rstd * g[5]); w0.w = pk2(o[6] * rstd * g[6], o[7] * rstd * g[7]);
        w1.x = pk2(o[8] * rstd * g[8], o[9] * rstd * g[9]); w1.y = pk2(o[10] * rstd * g[10], o[11] * rstd * g[11]); w1.z = pk2(o[12] * rstd * g[12], o[13] * rstd * g[13]); w1.w = pk2(o[14] * rstd * g[14], o[15] * rstd * g[15]);
        GAS v4u* po = (GAS v4u*)(AO + (size_t)m * 1024 + lane * 16); po[0] = w0; po[1] = w1;
    }
}
template <int LAYER> __device__ __forceinline__ void p_router(Frame& F, const Args& a, const float* xres, int bank = LAYER) {
    typedef float f32x4v __attribute__((ext_vector_type(4)));
    LAS float* part = (LAS float*)(F.lds + RING_OFF);
    LAS float* ssqp = (LAS float*)(F.lds + RING_OFF + 98304);
    LAS float* logit = (LAS float*)(F.lds + RING_OFF + 100352);
    LAS float* rstd_s = (LAS float*)(F.lds + RING_OFF + 109568);
    LAS int* lcnt = (LAS int*)(F.lds + RING_OFF + 109824);
    LAS int* lbase = (LAS int*)(F.lds + RING_OFF + 109952);
    const int lane = F.lane, w = F.wave, row = lane & 15, kg = lane >> 4;
    const bf16x8* wrf = (const bf16x8*)(F.ws + WS_WRF) + (size_t)LAYER * (32 * 3 * 2 * 64);
    bf16x8 Bh[4][3], Bl[4][3];
#pragma unroll
    for (int s = 0; s < 4; ++s)
#pragma unroll
        for (int nt = 0; nt < 3; ++nt) { Bh[s][nt] = wrf[(((4 * w + s) * 3 + nt) * 2 + 0) * 64 + lane]; Bl[s][nt] = wrf[(((4 * w + s) * 3 + nt) * 2 + 1) * 64 + lane]; }
    const float* gffn = a.in[3] + LAYER * 1024; const float* bg = a.in[12] + LAYER * 4; const float* be = a.in[14] + LAYER * 32;
    int* list = (int*)(F.ws + WS_LIST); float* pairw = (float*)(F.ws + WS_PAIRW); bf16* HB = (bf16*)(F.ws + WS_HB);
    for (int tb = F.vcu; tb < TOK / 64; tb += F.G) {
        __syncthreads();
        if (F.tid < 32) lcnt[F.tid] = 0;
        f32x4v acc[4][3];
#pragma unroll
        for (int mt = 0; mt < 4; ++mt)
#pragma unroll
            for (int nt = 0; nt < 3; ++nt) acc[mt][nt] = (f32x4v){0.f, 0.f, 0.f, 0.f};
#pragma unroll
        for (int mt = 0; mt < 4; ++mt) { const float* xr = xres + (size_t)(tb * 64 + mt * 16 + row) * DM + 128 * w + 8 * kg; float ss = 0.f;
#pragma unroll
            for (int s = 0; s < 4; ++s) { const f32x4 x0 = *(const GAS f32x4*)(xr + 32 * s), x1 = *(const GAS f32x4*)(xr + 32 * s + 4);
                const float xv[8] = {x0.x, x0.y, x0.z, x0.w, x1.x, x1.y, x1.z, x1.w}; bf16x8 ah, al;
#pragma unroll
                for (int j = 0; j < 8; ++j) { ss += xv[j] * xv[j]; const unsigned hi = f2bf(xv[j]); ah[j] = (short)hi; al[j] = (short)f2bf(xv[j] - __builtin_bit_cast(float, hi << 16)); }
#pragma unroll
                for (int nt = 0; nt < 3; ++nt) { acc[mt][nt] = __builtin_amdgcn_mfma_f32_16x16x32_bf16(ah, Bh[s][nt], acc[mt][nt], 0, 0, 0);
                    acc[mt][nt] = __builtin_amdgcn_mfma_f32_16x16x32_bf16(ah, Bl[s][nt], acc[mt][nt], 0, 0, 0); acc[mt][nt] = __builtin_amdgcn_mfma_f32_16x16x32_bf16(al, Bh[s][nt], acc[mt][nt], 0, 0, 0); } }
            ss += __shfl_xor(ss, 16); ss += __shfl_xor(ss, 32);
            if (kg == 0) ssqp[w * 64 + mt * 16 + row] = ss;
#pragma unroll
            for (int nt = 0; nt < 3; ++nt)
#pragma unroll
                for (int r = 0; r < 4; ++r) part[(w * 64 + mt * 16 + 4 * kg + r) * 48 + nt * 16 + row] = acc[mt][nt][r]; }
        __syncthreads();
        if (F.tid < 64) { float s = 0.f;
#pragma unroll
            for (int q = 0; q < 8; ++q) s += ssqp[q * 64 + F.tid];
            rstd_s[F.tid] = 1.0f / sqrtf(s * (1.f / 1024.f) + RMS_EPS); }
        __syncthreads();
        for (int idx = F.tid; idx < 64 * 36; idx += 512) { const int tk = idx / 36, o = idx % 36; float s = 0.f;
#pragma unroll
            for (int q = 0; q < 8; ++q) s += part[(q * 64 + tk) * 48 + o];
            logit[tk * 36 + o] = s * rstd_s[tk] + (o < 4 ? bg[o] : be[o - 4]); }
        __syncthreads();
        if (w == 0) {
            const LAS float* lg = logit + lane * 36;
            int gi = 0; float gm = lg[0];
#pragma unroll
            for (int j = 1; j < 4; ++j) { const float v = lg[j]; if (v > gm) { gm = v; gi = j; } }
            float gs = 0.f;
#pragma unroll
            for (int j = 0; j < 4; ++j) gs += __expf(lg[j] - gm);
            const float gp = 1.0f / gs;
            const LAS float* le = lg + 4 + gi * 8;
            int i1 = 0; float v1 = le[0];
#pragma unroll
            for (int j = 1; j < 8; ++j) { const float v = le[j]; if (v > v1) { v1 = v; i1 = j; } }
            int i2 = -1; float v2 = -INFINITY;
#pragma unroll
            for (int j = 0; j < 8; ++j) { const float v = le[j]; if (j != i1 && v > v2) { v2 = v; i2 = j; } }
            const float e2 = __expf(v2 - v1), w1 = gp / (1.0f + e2), w2 = gp * e2 / (1.0f + e2);
            const int e_1 = gi * 8 + i1, e_2 = gi * 8 + i2;
            const int r1 = __hip_atomic_fetch_add(lcnt + e_1, 1, __ATOMIC_RELAXED, __HIP_MEMORY_SCOPE_WORKGROUP);
            const int r2 = __hip_atomic_fetch_add(lcnt + e_2, 1, __ATOMIC_RELAXED, __HIP_MEMORY_SCOPE_WORKGROUP);
            LDS_WAIT();
            if (lane < 32) { const int c = lcnt[lane]; int bs = 0; if (c > 0) bs = (int)__hip_atomic_fetch_add((unsigned*)(F.ctl + CW_CNT + (bank * 32 + lane) * 64), (unsigned)c, RLX_AGENT); lbase[lane] = bs; }
            LDS_WAIT();
            const int tg = tb * 64 + lane; const int p1 = lbase[e_1] + r1, p2 = lbase[e_2] + r2;
            list[e_1 * LISTCAP + p1] = 2 * tg; list[e_2 * LISTCAP + p2] = 2 * tg + 1; pairw[2 * tg] = w1; pairw[2 * tg + 1] = w2;
        }
        for (int i = 0; i < 8; ++i) { const int tk = w * 8 + i, tg = tb * 64 + tk; const float rs = rstd_s[tk];
            const GAS f32x4* xr = (const GAS f32x4*)(xres + (size_t)tg * DM) + lane; const GAS f32x4* gr = (const GAS f32x4*)gffn + lane; GAS unsigned* o4 = (GAS unsigned*)((unsigned char*)HB + (size_t)tg * DM) + lane;
#pragma unroll
            for (int j = 0; j < 4; ++j) { const f32x4 v = xr[64 * j], gg = gr[64 * j]; const float rs8 = rs * H8_SCALE; o4[64 * j] = pk4_fp8f(v.x * rs8 * gg.x, v.y * rs8 * gg.y, v.z * rs8 * gg.z, v.w * rs8 * gg.w); } }
    }
}
template <int LAYER> __device__ __forceinline__ void moe_setup(Frame& F) {
    LAS int* tstart = (LAS int*)(F.lds + LX_TSTART); LAS int* texp = (LAS int*)(F.lds + LX_TEXP); LAS int* lc = (LAS int*)(F.lds + LX_CNT);
    __syncthreads();
    if (F.tid < 32) { int c = (int)__hip_atomic_load((unsigned*)(F.ctl + CW_CNT + (LAYER * 32 + F.tid) * 64), RLX_AGENT); c = c < 0 ? 0 : (c > LISTCAP ? LISTCAP : c); lc[F.tid] = c; }
    __syncthreads();
    if (F.tid == 0) { int acc = 0; for (int e = 0; e < 32; ++e) { tstart[e] = acc; acc += (lc[e] + 255) >> 8; } if (acc > MAXRT) acc = MAXRT; tstart[32] = acc; tstart[33] = acc; }
    __syncthreads();
    if (F.tid < MAXRT) { int e = 0;
#pragma unroll 1
        for (int q = 1; q < 32; ++q) if (tstart[q] <= F.tid) e = q;
        texp[F.tid] = e; }
    __syncthreads();
}
template <int LAYER> __device__ __forceinline__ void p_moe1(Frame& F) {
    moe_setup<LAYER>(F);
    const LAS int* tstart = (const LAS int*)(F.lds + LX_TSTART); const LAS int* texp = (const LAS int*)(F.lds + LX_TEXP); const LAS int* lc = (const LAS int*)(F.lds + LX_CNT);
    LAS int* rowtab = (LAS int*)(F.lds + LX_ROWTAB);
    pg8::MoeOrder S{F.G, F.vcu, 512, 0, tstart, texp};
    const int* list = (const int*)(F.ws + WS_LIST);
    pg8::Unit u;
    for (int i = 0; i < 4 && S.next(i, u); ++i) { if (F.tid < 256) { const int e = u.pn >> 2, pos = u.aux * 256 + F.tid; rowtab[i * 256 + F.tid] = (pos < lc[e]) ? (list[e * LISTCAP + pos] >> 1) : 0; } }
    VM_WAIT(); __syncthreads();
    pg8::Gemm g{(const bf16*)(F.ws + WS_HB), (const bf16*)(F.ws + WS_W1CAT), 512, 512, 512};
    pg8::EpiMoe1 E{(unsigned char*)(F.ws + WS_MACT)};
    pg8::gemm_phase<pg8::EpiMoe1, pg8::MoeOrder, true, true, true>(F.lds + RING_OFF, g, S, E, rowtab);
}
template <int LAYER> __device__ __forceinline__ void p_moe2(Frame& F) {
    moe_setup<LAYER>(F);
    const LAS int* tstart = (const LAS int*)(F.lds + LX_TSTART); const LAS int* texp = (const LAS int*)(F.lds + LX_TEXP); const LAS int* lc = (const LAS int*)(F.lds + LX_CNT);
    pg8::MoeOrder S{F.G, F.vcu, 256, 256 * 256, tstart, texp};
    pg8::Gemm g{(const bf16*)(F.ws + WS_MACT), (const bf16*)(F.ws + WS_W2T), 256, 256, 256};
    pg8::EpiMoe2 E{(bf16*)(F.ws + WS_Y), (const int*)(F.ws + WS_LIST), (const float*)(F.ws + WS_PAIRW), lc};
    pg8::gemm_phase<pg8::EpiMoe2, pg8::MoeOrder, true, false, true>(F.lds + RING_OFF, g, S, E, nullptr);
}
template <bool FINAL> __device__ __forceinline__ void p_combine(Frame& F, float* xres, const float* g, float* dry = nullptr) {
    const int gw = F.vcu * NWAVES + F.wave, NGW = F.G * NWAVES, lane = F.lane;
    const bf16* Y = (const bf16*)(F.ws + WS_Y); bf16* HB = (bf16*)(F.ws + WS_HB);
    for (int m = gw; m < TOK; m += NGW) {
        GAS f32x4* xr = (GAS f32x4*)(xres + (size_t)m * DM) + lane; GAS f32x4* xw = dry ? (GAS f32x4*)(dry + (size_t)m * DM) + lane : xr; const GAS v2u* y0 = (const GAS v2u*)(Y + (size_t)(2 * m) * DM) + lane; const GAS v2u* y1 = (const GAS v2u*)(Y + (size_t)(2 * m + 1) * DM) + lane;
        const GAS f32x4* gr = (const GAS f32x4*)g + lane;
        f32x4 v[4]; float s = 0.f;
#pragma unroll
        for (int j = 0; j < 4; ++j) { const f32x4 x = xr[64 * j]; const v2u p = y0[64 * j], q = y1[64 * j];
            v[j].x = x.x + bflo(p.x) + bflo(q.x); v[j].y = x.y + bfhi(p.x) + bfhi(q.x); v[j].z = x.z + bflo(p.y) + bflo(q.y); v[j].w = x.w + bfhi(p.y) + bfhi(q.y);
            s += (v[j].x * v[j].x + v[j].y * v[j].y) + (v[j].z * v[j].z + v[j].w * v[j].w); }
        const float rstd = 1.0f / sqrtf(wave_sum(s) * (1.f / 1024.f) + RMS_EPS);
        if (FINAL) {
#pragma unroll
            for (int j = 0; j < 4; ++j) { const f32x4 gg = gr[64 * j]; f32x4 o; o.x = v[j].x * rstd * gg.x; o.y = v[j].y * rstd * gg.y; o.z = v[j].z * rstd * gg.z; o.w = v[j].w * rstd * gg.w; xw[64 * j] = o; }
        } else {
            GAS unsigned* o4 = (GAS unsigned*)((dry ? (unsigned char*)(dry + (size_t)TOK * DM) : (unsigned char*)HB) + (size_t)m * DM) + lane; const float r8 = rstd * H8_SCALE;
#pragma unroll
            for (int j = 0; j < 4; ++j) { xw[64 * j] = v[j]; const f32x4 gg = gr[64 * j]; o4[64 * j] = pk4_fp8f(v[j].x * r8 * gg.x, v[j].y * r8 * gg.y, v[j].z * r8 * gg.z, v[j].w * r8 * gg.w); }
        }
    }
}
__device__ __forceinline__ void p_scan(Frame& F) {
    const bf16* DS = (const bf16*)(F.ws + WS_DS); bf16* BT = (bf16*)(F.ws + WS_BTCAT);
    for (int gidx = F.vcu * 512 + F.tid; gidx < NB * RH * 16384; gidx += F.G * 512) {
        const int bh = gidx >> 14, e8 = gidx & 16383, dv = e8 >> 5, dk0 = (e8 & 31) * 8, h = bh & 3;
        const float cd = __builtin_amdgcn_exp2f(256.0f * pg8::log2_gamma(h));
        v4u d[7];
#pragma unroll
        for (int n = 0; n < 7; ++n) d[n] = *(const GAS v4u*)(DS + ((size_t)(bh * RNC + n) * RDV + dv) * RDK + dk0);
        float s[8];
#pragma unroll
        for (int j = 0; j < 8; ++j) s[j] = 0.f;
#pragma unroll
        for (int n = 0; n < 8; ++n) {
            v4u o; o.x = pk2(s[0], s[1]); o.y = pk2(s[2], s[3]); o.z = pk2(s[4], s[5]); o.w = pk2(s[6], s[7]);
            *(GAS v4u*)(BT + ((size_t)(bh * RNC + n) * RDV + dv) * 512 + 256 + dk0) = o;
            if (n < 7) { const unsigned wv[4] = {d[n].x, d[n].y, d[n].z, d[n].w};
#pragma unroll
                for (int j = 0; j < 4; ++j) { s[2 * j] = cd * (s[2 * j] + bflo(wv[j])); s[2 * j + 1] = cd * (s[2 * j + 1] + bfhi(wv[j])); } }
        }
    }
}
__device__ __forceinline__ void p_normgate(Frame& F, bf16* dry = nullptr) {
    const int gw = F.vcu * NWAVES + F.wave, NGW = F.G * NWAVES, lane = F.lane;
    const bf16* OR = (const bf16*)(F.ws + WS_ORET); bf16* SG = (bf16*)(F.ws + WS_SG);
    for (int m = gw; m < TOK; m += NGW) {
        const GAS v4u* po = (const GAS v4u*)(OR + (size_t)m * 2048 + lane * 32); GAS v4u* pg = (GAS v4u*)(SG + (size_t)m * 2048 + lane * 32); GAS v4u* pw = dry ? (GAS v4u*)(dry + (size_t)m * 2048 + lane * 32) : pg;
        v4u ov[4], gv[4]; float ss = 0.f;
#pragma unroll
        for (int q = 0; q < 4; ++q) { ov[q] = po[q]; gv[q] = pg[q]; }
#pragma unroll
        for (int q = 0; q < 4; ++q) { const unsigned wv[4] = {ov[q].x, ov[q].y, ov[q].z, ov[q].w};
#pragma unroll
            for (int j = 0; j < 4; ++j) { const float x0 = bflo(wv[j]), x1 = bfhi(wv[j]); ss += x0 * x0 + x1 * x1; } }
        ss += __shfl_xor(ss, 1); ss += __shfl_xor(ss, 2); ss += __shfl_xor(ss, 4); ss += __shfl_xor(ss, 8);
        const float rstd = 1.0f / sqrtf(ss * (1.f / 512.f) + RMS_EPS);
#pragma unroll
        for (int q = 0; q < 4; ++q) { const unsigned wv[4] = {ov[q].x, ov[q].y, ov[q].z, ov[q].w}, wg[4] = {gv[q].x, gv[q].y, gv[q].z, gv[q].w}; unsigned r[4];
#pragma unroll
            for (int j = 0; j < 4; ++j) r[j] = pk2(bflo(wv[j]) * rstd * bflo(wg[j]), bfhi(wv[j]) * rstd * bfhi(wg[j]));
            v4u o; o.x = r[0]; o.y = r[1]; o.z = r[2]; o.w = r[3]; pw[q] = o; }
    }
}
__device__ __forceinline__ void p_conv_moe1(Frame& F, const Args& a) {
    LAS float* scr = (LAS float*)(F.lds + RING_OFF + F.wave * 16384);
    const int gw = F.vcu * NWAVES + F.wave, NGW = F.G * NWAVES;
    for (int it = gw; it < IT_MOE; it += NGW) conv_moe_item(F, a, 1, it, scr);
}

constexpr int N_PHASES = 19;
#ifndef MK_PER_PHASE
#define MK_PER_PHASE 0
#endif
__global__ void __launch_bounds__(NWAVES * 64, 2) hybrid_fwd(Args args) {
    extern __shared__ __attribute__((aligned(16))) unsigned char lds[];
    Frame F;
    F.lds = (LAS unsigned char*)lds;
    F.tid = threadIdx.x; F.lane = F.tid & 63; F.wave = __builtin_amdgcn_readfirstlane(F.tid >> 6);
    F.G = gridDim.x; { const int bx = blockIdx.x; F.vcu = (F.G % 8 == 0) ? (bx % 8) * (F.G / 8) + bx / 8 : bx; }
    F.ws = args.ws; F.ctl = (gu32*)(args.ws + WS_CTL);
    for (int u = F.tid; u < (LDS_BYTES - LX_OFF) / 4; u += NWAVES * 64) ((LAS unsigned*)(F.lds + LX_OFF))[u] = 0u;
    __syncthreads();
    XcdBarrier bar; bar.bar = (unsigned*)(F.ctl + CW_BAR); bar.x = 0; bar.st = nullptr;
    if (!MK_PER_PHASE) bar = xcd_barrier_post((unsigned*)(F.ctl + CW_BAR), (volatile LAS unsigned*)(F.lds + LX_MISC) + 8);
    const int lo = args.ph_lo, hi = args.ph_hi;
#ifndef PH_MASK
#define PH_MASK 0x7ffff
#endif
#define IN(k) (((PH_MASK >> (k)) & 1) && lo <= (k) && (k) < hi)
#define SEAM(k) do { if (IN(k) && IN((k) + 1)) xcd_barrier(bar); } while (0)
#define REFRESH() do { int t_ = threadIdx.x; asm volatile("" : "+v"(t_)); F.tid = t_; F.lane = t_ & 63; } while (0)
#ifndef DUP_MASK
#define DUP_MASK 0
#endif
#ifndef XBAR_N
#define XBAR_N 0
#endif
#define DUP(k) (((DUP_MASK >> (k)) & 1) != 0)
    float* xres = args.out;
    unsigned char* ws = args.ws;
    const int bx = (int)blockIdx.x;

    if (IN(0)) { REFRESH(); p_prologue(F, args); if (DUP(0)) { xcd_barrier(bar); p_prologue(F, args); } for (int q = 0; q < XBAR_N; ++q) xcd_barrier(bar); } SEAM(0);
    if (IN(1)) { REFRESH(); for (int rep_ = 0; rep_ < (DUP(1) ? 2 : 1); ++rep_) { if (rep_) xcd_barrier(bar);
        constexpr int KQ = QKV_FP8 ? 512 : 1024; pg8::Gemm g{(const bf16*)(ws + WS_HB), (const bf16*)(ws + WS_WINT0), KQ, KQ, KQ}; pg8::StaticOrder S; S.init(TOK, 3072, F.G, bx, KQ, KQ);
        pg8::EpiQKV E{(bf16*)(ws + WS_QKV0), ATT_C2};
        pg8::gemm_phase<pg8::EpiQKV, pg8::StaticOrder, true, false, (QKV_FP8 != 0)>(F.lds + RING_OFF, g, S, E, nullptr);
    }
    } SEAM(1);
    if (IN(2)) { REFRESH(); p_attention(F, args); if (DUP(2)) { xcd_barrier(bar); p_attention(F, args); } } SEAM(2);
    if (IN(3)) { REFRESH(); p_diffcombine(F, args); if (DUP(3)) { xcd_barrier(bar); p_diffcombine(F, args); } } SEAM(3);
    if (IN(4)) { REFRESH(); for (int rep_ = 0; rep_ < (DUP(4) ? 2 : 1); ++rep_) { if (rep_) xcd_barrier(bar);
        pg8::Gemm g{(const bf16*)(ws + WS_AO), (const bf16*)(ws + WS_WOUTT0), 1024, 1024, 1024}; pg8::StaticOrder S; S.init(TOK, 1024, F.G, bx, 1024, 1024);
        pg8::EpiRes E{args.in[0], xres};
        pg8::gemm_phase<pg8::EpiRes, pg8::StaticOrder, true, false>(F.lds + RING_OFF, g, S, E, nullptr);
    }
    } SEAM(4);
    if (IN(5)) { REFRESH(); p_router<0>(F, args, xres); if (DUP(5)) { xcd_barrier(bar); p_router<0>(F, args, xres, 2); } } SEAM(5);
    if (IN(6)) { REFRESH(); p_moe1<0>(F); if (DUP(6)) { xcd_barrier(bar); p_moe1<0>(F); } } SEAM(6);
    if (IN(7)) { REFRESH(); p_moe2<0>(F); if (DUP(7)) { xcd_barrier(bar); p_moe2<0>(F); } } SEAM(7);
    if (IN(8)) { REFRESH(); if (DUP(8)) { p_combine<false>(F, xres, args.in[2] + 1024, (float*)(ws + WS_KI)); xcd_barrier(bar); } p_combine<false>(F, xres, args.in[2] + 1024); } SEAM(8);
    if (IN(9)) { REFRESH(); for (int rep_ = 0; rep_ < (DUP(9) ? 2 : 1); ++rep_) { if (rep_) xcd_barrier(bar);
        { pg8::Gemm g{(const bf16*)(ws + WS_HB), (const bf16*)(ws + WS_WRINA), 512, 512, 512}; pg8::StaticOrder S; S.init(TOK, 4096, F.G, bx, 512, 512);
          pg8::EpiRetA E{(bf16*)(ws + WS_ACAT), (bf16*)(ws + WS_KI), (bf16*)(ws + WS_SG), (const float*)(ws + WS_SINCOS)};
          pg8::gemm_phase<pg8::EpiRetA, pg8::StaticOrder, true, false, true>(F.lds + RING_OFF, g, S, E, nullptr); }
        { pg8::Gemm g{(const bf16*)(ws + WS_WRINB), (const bf16*)(ws + WS_HB), 512, 512, 512}; pg8::StaticOrder S; S.init(3072, TOK, F.G, bx, 512, 512);
          pg8::EpiRetB E{(bf16*)(ws + WS_KIT), (bf16*)(ws + WS_BTCAT), (const float*)(ws + WS_SINCOST)};
          pg8::gemm_phase<pg8::EpiRetB, pg8::StaticOrder, true, false, true>(F.lds + RING_OFF, g, S, E, nullptr); }
    }
    } SEAM(9);
    if (IN(10)) { REFRESH(); for (int rep_ = 0; rep_ < (DUP(10) ? 2 : 1); ++rep_) { if (rep_) xcd_barrier(bar);
        { pg8::Gemm g{(const bf16*)(ws + WS_ACAT), (const bf16*)(ws + WS_KI), 512, 1024, 256}; pg8::ScoresOrder S{F.G, F.vcu};
          pg8::EpiScores E{(bf16*)(ws + WS_ACAT)};
          pg8::gemm_phase<pg8::EpiScores, pg8::ScoresOrder, true, false>(F.lds + RING_OFF, g, S, E, nullptr); }
        { pg8::Gemm g{(const bf16*)(ws + WS_BTCAT), (const bf16*)(ws + WS_KIT), 512, 2048, 256}; pg8::DsOrder S{F.G, F.vcu};
          pg8::EpiDS E{(bf16*)(ws + WS_DS)};
          pg8::gemm_phase<pg8::EpiDS, pg8::DsOrder, true, false>(F.lds + RING_OFF, g, S, E, nullptr); }
    }
    } SEAM(10);
    if (IN(11)) { REFRESH(); p_scan(F); if (DUP(11)) { xcd_barrier(bar); p_scan(F); } } SEAM(11);
    if (IN(12)) { REFRESH(); for (int rep_ = 0; rep_ < (DUP(12) ? 2 : 1); ++rep_) { if (rep_) xcd_barrier(bar);
        pg8::Gemm g{(const bf16*)(ws + WS_ACAT), (const bf16*)(ws + WS_BTCAT), 512, 512, 512}; pg8::RetOOrder S{F.G, F.vcu};
        pg8::EpiRetO E{(bf16*)(ws + WS_ORET)};
        pg8::gemm_phase<pg8::EpiRetO, pg8::RetOOrder, true, false>(F.lds + RING_OFF, g, S, E, nullptr);
    }
    } SEAM(12);
    if (IN(13)) { REFRESH(); if (DUP(13)) { p_normgate(F, (bf16*)(ws + WS_ACAT)); xcd_barrier(bar); } p_normgate(F); } SEAM(13);
    if (IN(14)) { REFRESH(); for (int rep_ = (DUP(14) ? 0 : 1); rep_ < 2; ++rep_) { if (rep_ && DUP(14)) xcd_barrier(bar);
        pg8::Gemm g{(const bf16*)(ws + WS_SG), (const bf16*)(ws + WS_WROUTT), 2048, 2048, 2048}; pg8::StaticOrder S; S.init(TOK, 1024, F.G, bx, 2048, 2048);
        pg8::EpiRes E{xres, rep_ ? xres : (float*)(ws + WS_ACAT)};
        pg8::gemm_phase<pg8::EpiRes, pg8::StaticOrder, true, false>(F.lds + RING_OFF, g, S, E, nullptr);
    }
    } SEAM(14);
    if (IN(15)) { REFRESH(); p_router<1>(F, args, xres); __syncthreads(); p_conv_moe1(F, args); if (DUP(15)) { xcd_barrier(bar); p_router<1>(F, args, xres, 3); __syncthreads(); p_conv_moe1(F, args); } } SEAM(15);
    if (IN(16)) { REFRESH(); p_moe1<1>(F); } SEAM(16);
    if (IN(17)) { REFRESH(); p_moe2<1>(F); } SEAM(17);
    if (IN(18)) { REFRESH(); if (DUP(18)) { p_combine<true>(F, xres, args.in[4], (float*)(ws + WS_KI)); xcd_barrier(bar); } p_combine<true>(F, xres, args.in[4]); }
#undef IN
#undef SEAM
}

extern "C" void kernel_launch(void* const* d_in, const int* in_sizes, int n_in, void* d_out, int out_size, void* d_ws, size_t ws_size, hipStream_t stream) {
    static int grid = 0;
    if (grid == 0) {
        if (n_in != 18 || in_sizes[0] != TOK * DM || out_size != TOK * DM || ws_size < WS_END) { fprintf(stderr, "kernel_launch: unexpected shapes / workspace (n_in %d, in0 %d, out %d, ws %zu < %zu); nothing launched\n", n_in, n_in > 0 ? in_sizes[0] : -1, out_size, ws_size, (size_t)WS_END); grid = -1; return; }
        int dev = 0, cus = 0, per_cu = 0;
        if (hipGetDevice(&dev) != hipSuccess || hipDeviceGetAttribute(&cus, hipDeviceAttributeMultiprocessorCount, dev) != hipSuccess) { grid = -1; return; }
        if (hipFuncSetAttribute((const void*)hybrid_fwd, hipFuncAttributeMaxDynamicSharedMemorySize, LDS_BYTES) != hipSuccess) { fprintf(stderr, "kernel_launch: hipFuncSetAttribute failed\n"); grid = -1; return; }
        if (hipOccupancyMaxActiveBlocksPerMultiprocessor(&per_cu, (const void*)hybrid_fwd, NWAVES * 64, LDS_BYTES) != hipSuccess || per_cu < 1) { fprintf(stderr, "kernel_launch: occupancy query says %d\n", per_cu); }
        (void)hipGetLastError();
        grid = cus > 256 ? 256 : cus;
    }
    if (grid < 0) return;
    if (hipMemsetAsync((char*)d_ws + WS_CTL, 0, CTL_ZERO_BYTES, stream) != hipSuccess) return;
    Args a{};
    for (int i = 0; i < 18; ++i) a.in[i] = (const float*)d_in[i];
    a.out = (float*)d_out; a.ws = (unsigned char*)d_ws; a.pad = 0;
#if MK_PER_PHASE
    for (int p = 0; p < N_PHASES; ++p) { a.ph_lo = p; a.ph_hi = p + 1; a.li = p; hipLaunchKernelGGL(hybrid_fwd, dim3(grid), dim3(NWAVES * 64), LDS_BYTES, stream, a); }
#else
    a.ph_lo = 0; a.ph_hi = N_PHASES; a.li = 0;
    hipLaunchKernelGGL(hybrid_fwd, dim3(grid), dim3(NWAVES * 64), LDS_BYTES, stream, a);
#endif
}
```

```cpp
#include <hip/hip_runtime.h>
#include <hip/hip_bf16.h>
#include <cstdio>
#include <cstdint>

#define LAS __attribute__((address_space(3)))
#define GAS __attribute__((address_space(1)))

namespace pg8 {
typedef unsigned short bf16_t;
typedef short bf16x8 __attribute__((ext_vector_type(8)));
typedef float f32x4 __attribute__((ext_vector_type(4)));
typedef float f32x2 __attribute__((ext_vector_type(2)));
typedef unsigned u32x4 __attribute__((ext_vector_type(4)));
typedef unsigned u32x2 __attribute__((ext_vector_type(2)));
constexpr int BM = 256, BK = 64, HALF = 128, HTB = HALF * BK * 2, STAGE_BYTES = 8 * HTB, NXCD = 8, WGM = 8;

__host__ __device__ __forceinline__ int lds_byte(int r, int c) { const int st = (r >> 4) * 2 + (c >> 5), rr = r & 15, cc = c & 31, ob = rr * 64 + cc * 2; return st * 1024 + (ob ^ (((ob >> 9) & 1) << 5)); }
__host__ __device__ __forceinline__ void stage_rc(int b, int& R, int& C) { const int st = b / 1024, sb = b % 1024, swz = sb ^ (((sb >> 9) & 1) << 5); R = (st >> 1) * 16 + swz / 64; C = (st & 1) * 32 + (swz % 64) / 2; }
__host__ __device__ __forceinline__ int perm32(int rho) { const int n = rho >> 4, i = rho & 15; return 8 * (i >> 2) + 4 * n + (i & 3); }

struct Unit { int pm, pn, aux; long aoff, boff; };
struct Gemm { const bf16_t* A; const bf16_t* Bt; int lda, ldb, K; };

struct StaticOrder {
    int nM, nN, nwg, G, c, lda, ldb;
    __device__ void init(int M, int N, int G_, int c_, int lda_, int ldb_) { nM = M / BM; nN = N / BM; nwg = nM * nN; G = G_; c = c_; lda = lda_; ldb = ldb_; }
    __device__ bool next(int i, Unit& u) const {
        const long L = (long)i * G + c; if (L >= nwg) return false;
        int wgid = (int)L; { const int q = nwg / NXCD, r = nwg % NXCD, xcd = wgid % NXCD, off = wgid / NXCD; wgid = (xcd < r ? xcd * (q + 1) : r * (q + 1) + (xcd - r) * q) + off; }
        const int nig = WGM * nN, gid = wgid / nig, fm = gid * WGM, gsz = (nM - fm) < WGM ? (nM - fm) : WGM;
        u.pm = fm + ((wgid % nig) % gsz); u.pn = (wgid % nig) / gsz; u.aux = 0;
        u.aoff = (long)u.pm * BM * lda; u.boff = (long)u.pn * BM * ldb; return true;
    }
};

__device__ __forceinline__ unsigned cvt_pk_bf16(float lo, float hi) { unsigned r; asm volatile("v_cvt_pk_bf16_f32 %0, %1, %2" : "=v"(r) : "v"(lo), "v"(hi)); return r; }
__device__ __forceinline__ u32x4 pack8(const f32x4 v0, const f32x4 v1) { u32x4 w; w.x = cvt_pk_bf16(v0[0], v0[1]); w.y = cvt_pk_bf16(v0[2], v0[3]); w.z = cvt_pk_bf16(v1[0], v1[1]); w.w = cvt_pk_bf16(v1[2], v1[3]); return w; }

typedef int v4i_t __attribute__((ext_vector_type(4)));
typedef int v8i_t __attribute__((ext_vector_type(8)));
__device__ __forceinline__ v8i_t cat8(const bf16x8 a, const bf16x8 b) { const v4i_t x = __builtin_bit_cast(v4i_t, a), y = __builtin_bit_cast(v4i_t, b); return __builtin_shufflevector(x, y, 0, 1, 2, 3, 4, 5, 6, 7); }
template <class Epi, class Sched, bool ALIGN_EPI, bool GATHER, bool FP8 = false>
__device__ __forceinline__ void gemm_phase(LAS unsigned char* lds, const Gemm g, const Sched& S, const Epi& E, const LAS int* rowtab) {
    int tid_ = threadIdx.x; asm volatile("" : "+v"(tid_));
    const int tid = tid_, wid = __builtin_amdgcn_readfirstlane(tid >> 6), lane = tid & 63, wr = wid >> 2, wc = wid & 3, fr = lane & 15, fq = lane >> 4;
    const int K = g.K, nt = K / BK;
    int sR[2], sC[2]; unsigned voffB[2];
#pragma unroll
    for (int i = 0; i < 2; ++i) { int R, C; stage_rc(tid * 16 + i * 8192, R, C); sR[i] = R; sC[i] = C; const int Rb = Epi::PERM ? ((R & ~31) + perm32(R & 31)) : R; voffB[i] = (unsigned)(Rb * g.ldb + C) * 2u; }
    unsigned avo[2][2], navo[2][2];
#define PG8_SETOFF(o, ui_) do { _Pragma("unroll") for (int h_ = 0; h_ < 2; ++h_) _Pragma("unroll") for (int i_ = 0; i_ < 2; ++i_) { const int row_ = h_ * HALF + sR[i_]; \
        const int grow_ = GATHER ? rowtab[(ui_) * BM + row_] : row_; o[h_][i_] = (unsigned)(grow_ * g.lda + sC[i_]) * 2u; } } while (0)
    const size_t kstep = (size_t)(BK * 2);
    const size_t hstepB = (size_t)HALF * g.ldb * 2;
    const unsigned ldsw = (unsigned)wid * 1024u;
    const int aoff = lds_byte(wr * 64 + fr, fq * 8), boff = lds_byte(wc * 32 + fr, fq * 8);
#define PG8_SA(b, h) (((b) * 2 + (h)) * HTB)
#define PG8_SB(b, h) ((4 + (b) * 2 + (h)) * HTB)
#define PG8_STAGE(bufoff, gbase, voff) do { _Pragma("unroll") for (int _i = 0; _i < 2; ++_i) \
        __builtin_amdgcn_global_load_lds((const unsigned*)((const char*)(gbase) + (voff)[_i]), (LAS unsigned*)(lds + (bufoff) + ldsw + _i * 8192), 16, 0, 0); } while (0)
#define PG8_LD8(dst8, addr_) do { const v4i_t lo_ = *(const LAS v4i_t*)(addr_), hi_ = *(const LAS v4i_t*)((addr_) + 1024); dst8 = __builtin_shufflevector(lo_, hi_, 0, 1, 2, 3, 4, 5, 6, 7); } while (0)
#define PG8_LDA(dst, b, h) do { _Pragma("unroll") for (int m = 0; m < 4; ++m) { if constexpr (FP8) { PG8_LD8(dst##8[m], lds + PG8_SA(b, h) + aoff + m * 2048); } else { _Pragma("unroll") for (int k = 0; k < 2; ++k) dst[m][k] = *(const LAS bf16x8*)(lds + PG8_SA(b, h) + aoff + m * 2048 + k * 1024); } } } while (0)
#define PG8_LDB(dst, b, h) do { _Pragma("unroll") for (int n = 0; n < 2; ++n) { if constexpr (FP8) { PG8_LD8(dst##8[n], lds + PG8_SB(b, h) + boff + n * 2048); } else { _Pragma("unroll") for (int k = 0; k < 2; ++k) dst[n][k] = *(const LAS bf16x8*)(lds + PG8_SB(b, h) + boff + n * 2048 + k * 1024); } } } while (0)
#define PG8_MMA(ai, bj, At, Bt) do { __builtin_amdgcn_s_setprio(1); _Pragma("unroll") for (int m = 0; m < 4; ++m) _Pragma("unroll") for (int n = 0; n < 2; ++n) { \
        if constexpr (FP8) asm volatile("v_mfma_scale_f32_16x16x128_f8f6f4 %0, %1, %2, %0, %3, %3 op_sel_hi:[0,0,0]" : "+v"(acc[ai][bj][m][n]) : "v"(Bt##8[n]), "v"(At##8[m]), "v"(sc1)); \
        else { _Pragma("unroll") for (int k = 0; k < 2; ++k) acc[ai][bj][m][n] = __builtin_amdgcn_mfma_f32_16x16x32_bf16(Bt[n][k], At[m][k], acc[ai][bj][m][n], 0, 0, 0); } } \
        __builtin_amdgcn_s_setprio(0); } while (0)
#define PG8_WAIT_V(n) asm volatile("s_waitcnt vmcnt(" #n ")" ::: "memory")
#define PG8_WAIT_L(n) asm volatile("s_waitcnt lgkmcnt(" #n ")" ::: "memory")
#define PG8_BAR __builtin_amdgcn_s_barrier()
#define PG8_SCHED __builtin_amdgcn_sched_barrier(0)
    unsigned sc1 = 0; if constexpr (FP8) asm volatile("v_mov_b32 %0, 0x7f7f7f7f\n\ts_nop 4" : "=v"(sc1));
    Unit cur, nxt; int ui = 0;
    if (!S.next(0, cur)) return;
    f32x4 acc[2][2][4][2];
#pragma unroll
    for (int a = 0; a < 2; ++a)
#pragma unroll
        for (int b = 0; b < 2; ++b)
#pragma unroll
            for (int m = 0; m < 4; ++m)
#pragma unroll
                for (int n = 0; n < 2; ++n) acc[a][b][m][n] = (f32x4){0.f, 0.f, 0.f, 0.f};
    bf16x8 At[4][2], B0[2][2], B1[2][2]; v8i_t At8[4], B08[2], B18[2];
    const char* cA = (const char*)g.A + cur.aoff * 2; const char* cB = (const char*)g.Bt + cur.boff * 2;
    PG8_SETOFF(avo, 0);
    PG8_STAGE(PG8_SB(0, 0), cB, voffB); PG8_STAGE(PG8_SB(0, 1), cB + hstepB, voffB); PG8_STAGE(PG8_SA(0, 0), cA, avo[0]); PG8_STAGE(PG8_SA(0, 1), cA, avo[1]);
    if (wr == 1) PG8_BAR;
    PG8_WAIT_V(2); PG8_BAR;
    PG8_STAGE(PG8_SB(1, 0), cB + kstep, voffB); PG8_STAGE(PG8_SA(1, 0), cA + kstep, avo[0]); PG8_STAGE(PG8_SB(1, 1), cB + hstepB + kstep, voffB);
    PG8_WAIT_V(6); PG8_BAR;
    for (;;) {
        const bool has_next = S.next(ui + 1, nxt);
        const char* nA = has_next ? (const char*)g.A + nxt.aoff * 2 : cA; const char* nB = has_next ? (const char*)g.Bt + nxt.boff * 2 : cB;
        if (GATHER && has_next) { PG8_SETOFF(navo, ui + 1); }
        else {
#pragma unroll
            for (int h_ = 0; h_ < 2; ++h_)
#pragma unroll
                for (int i_ = 0; i_ < 2; ++i_) navo[h_][i_] = avo[h_][i_]; }
#pragma nounroll
        for (int t = 0; t < nt; t += 2) {
            const bool last = (t == nt - 2);
            const char* a1 = cA + (size_t)(t + 1) * kstep;
            const char* a2 = last ? nA : cA + (size_t)(t + 2) * kstep; const char* b2 = last ? nB : cB + (size_t)(t + 2) * kstep;
            const char* a3 = a2 + kstep; const char* b3 = b2 + kstep;
            unsigned o2[2][2];
#pragma unroll
            for (int h_ = 0; h_ < 2; ++h_)
#pragma unroll
                for (int i_ = 0; i_ < 2; ++i_) o2[h_][i_] = (GATHER && last) ? navo[h_][i_] : avo[h_][i_];
            PG8_LDB(B0, 0, 0); PG8_LDB(B1, 0, 1); PG8_SCHED; PG8_LDA(At, 0, 0); PG8_STAGE(PG8_SA(1, 1), a1, avo[1]);
            PG8_WAIT_V(8); PG8_WAIT_L(0); PG8_BAR; PG8_MMA(0, 0, At, B0); PG8_MMA(0, 1, At, B1); PG8_BAR; PG8_SCHED;
            PG8_LDA(At, 0, 1); PG8_STAGE(PG8_SB(0, 0), b2, voffB); PG8_STAGE(PG8_SB(0, 1), b2 + hstepB, voffB); PG8_STAGE(PG8_SA(0, 0), a2, o2[0]);
            PG8_WAIT_V(8); PG8_WAIT_L(0); PG8_BAR; PG8_MMA(1, 0, At, B0); PG8_MMA(1, 1, At, B1); PG8_BAR; PG8_SCHED;
            PG8_LDB(B0, 1, 0); PG8_LDB(B1, 1, 1); PG8_SCHED; PG8_LDA(At, 1, 0); PG8_STAGE(PG8_SA(0, 1), a2, o2[1]);
            PG8_WAIT_V(8); PG8_WAIT_L(0); PG8_BAR; PG8_MMA(0, 0, At, B0); PG8_MMA(0, 1, At, B1); PG8_BAR; PG8_SCHED;
            PG8_LDA(At, 1, 1); PG8_STAGE(PG8_SB(1, 0), b3, voffB); PG8_STAGE(PG8_SB(1, 1), b3 + hstepB, voffB); PG8_STAGE(PG8_SA(1, 0), a3, o2[0]);
            PG8_WAIT_V(8); PG8_WAIT_L(0); PG8_BAR; PG8_MMA(1, 0, At, B0); PG8_MMA(1, 1, At, B1); PG8_BAR; PG8_SCHED;
        }
        if constexpr (ALIGN_EPI) { if (wr == 0) PG8_BAR; }
        if constexpr (FP8) asm volatile("s_nop 15\n\ts_nop 3" ::: "memory");
        { int efr = fr, efq = fq; asm volatile("" : "+v"(efr), "+v"(efq)); E(acc, cur, wr, wc, efr, efq); }
        if (!has_next) break;
#pragma unroll
        for (int a = 0; a < 2; ++a)
#pragma unroll
            for (int b = 0; b < 2; ++b)
#pragma unroll
                for (int m = 0; m < 4; ++m)
#pragma unroll
                    for (int n = 0; n < 2; ++n) acc[a][b][m][n] = (f32x4){0.f, 0.f, 0.f, 0.f};
        cur = nxt; cA = nA; cB = nB; ++ui;
#pragma unroll
        for (int h_ = 0; h_ < 2; ++h_)
#pragma unroll
            for (int i_ = 0; i_ < 2; ++i_) avo[h_][i_] = navo[h_][i_];
        if constexpr (ALIGN_EPI) { if (wr == 1) PG8_BAR; }
    }
    PG8_WAIT_V(0);
    if constexpr (!ALIGN_EPI) { if (wr == 0) PG8_BAR; }
    PG8_BAR;
#undef PG8_SETOFF
#undef PG8_SA
#undef PG8_SB
#undef PG8_STAGE
#undef PG8_LDA
#undef PG8_LDB
#undef PG8_MMA
#undef PG8_WAIT_V
#undef PG8_WAIT_L
#undef PG8_BAR
#undef PG8_SCHED
}
}
constexpr int NB = 8, SEQ = 2048, DM = 1024, TOK = NB * SEQ;
constexpr int AH = 8;
constexpr int RH = 4, RDK = 256, RDV = 512, RC = 256, RNC = SEQ / RC;
constexpr int NEXP = 32, EFF = 512, NPAIR = 2 * TOK, LISTCAP = TOK;
constexpr int MAXRT = NPAIR / 256 + NEXP;
constexpr float RMS_EPS = 1e-6f, SUBLN_EPS = 1e-5f, LOG2E = 1.4426950408889634f;
#ifndef QKV_FP8
#define QKV_FP8 0
#endif
#ifndef RIN_FP8
#define RIN_FP8 1
#endif
constexpr float WIN_SCALE = 64.f, IN_DESCALE = 1.0f / (16.f * 64.f);
constexpr float H8_SCALE = 16.f, W1_SCALE = 64.f, ACT_SCALE = 8.f, W2_SCALE = 32.f;
constexpr float ATT_C2 = 0.125f * LOG2E;

constexpr size_t MiB = 1u << 20;
constexpr size_t WS_CTL = 0, CTL_ZERO_BYTES = 1 * MiB;
constexpr size_t WS_LIST = 1 * MiB;
constexpr size_t WS_PAIRW = 3 * MiB;
constexpr size_t WS_WRF = 3 * MiB + 512 * 1024;
constexpr size_t WS_SINCOS = 4 * MiB;
constexpr size_t WS_SINCOST = 6 * MiB;
constexpr size_t WS_WINT0 = 8 * MiB;
constexpr size_t WS_WOUTT0 = 14 * MiB;
constexpr size_t WS_WRINA = 16 * MiB;
constexpr size_t WS_WRINB = 24 * MiB;
constexpr size_t WS_WROUTT = 30 * MiB;
constexpr size_t WS_W1CAT = 34 * MiB;
constexpr size_t WS_W2T = 98 * MiB;
constexpr size_t WS_DS = 34 * MiB;
constexpr size_t WS_ORET = 34 * MiB;
constexpr size_t WS_HB = 130 * MiB;
constexpr size_t WS_ACTBASE = 162 * MiB;
constexpr size_t WS_QKV0 = WS_ACTBASE;
constexpr size_t WS_OP = WS_ACTBASE + 96 * MiB;
constexpr size_t WS_AO = WS_ACTBASE + 160 * MiB;
constexpr size_t WS_MACT = WS_ACTBASE;
constexpr size_t WS_Y = WS_ACTBASE + 40 * MiB;
constexpr size_t WS_ACAT = WS_ACTBASE;
constexpr size_t WS_BTCAT = WS_ACTBASE + 64 * MiB;
constexpr size_t WS_KI = WS_ACTBASE + 192 * MiB;
constexpr size_t WS_KIT = WS_ACTBASE + 224 * MiB;
constexpr size_t WS_SG = WS_ACTBASE + 256 * MiB;
constexpr size_t WS_END = WS_ACTBASE + 320 * MiB;
constexpr int CW_TMO = 0, CW_BAR = 4096, CW_CNT = 16384;

constexpr int RING_OFF = 0, RING_BYTES = 131072;
constexpr int LX_OFF = RING_BYTES;
constexpr int LX_MISC = LX_OFF + 320;
constexpr int LX_ROWTAB = LX_OFF + 1024;
constexpr int LX_TSTART = LX_OFF + 5120;
constexpr int LX_TEXP = LX_OFF + 5376;
constexpr int LX_LUT = LX_OFF + 6144;
constexpr int LX_CNT = LX_OFF + 7168;
constexpr int LX_SSQ = LX_OFF + 8192;
constexpr int LDS_BYTES = 147456;

namespace pg8 {
struct EpiQKV {
    static constexpr bool PERM = true;
    bf16_t* O; float qscale;
    __device__ __forceinline__ void operator()(const f32x4 (&acc)[2][2][4][2], const Unit& u, int wr, int wc, int fr, int fq) const {
        const int row0 = u.pm * BM + wr * 64 + fr, col0 = u.pn * BM + wc * 32 + 8 * fq; const float sc = ((u.pn < 4) ? qscale : 1.f) * (QKV_FP8 ? IN_DESCALE : 1.f);
#pragma unroll
        for (int ai = 0; ai < 2; ++ai)
#pragma unroll
            for (int m = 0; m < 4; ++m) { bf16_t* rowp = O + (size_t)(row0 + ai * HALF + m * 16) * 3072 + col0;
#pragma unroll
                for (int bj = 0; bj < 2; ++bj) *(u32x4*)(rowp + bj * HALF) = pack8(acc[ai][bj][m][0] * sc, acc[ai][bj][m][1] * sc); }
    }
};
struct EpiRes {
    static constexpr bool PERM = false;
    const float* res; float* out;
    __device__ __forceinline__ void operator()(const f32x4 (&acc)[2][2][4][2], const Unit& u, int wr, int wc, int fr, int fq) const {
        const int row0 = u.pm * BM + wr * 64 + fr, col0 = u.pn * BM + wc * 32 + 4 * fq;
#pragma unroll
        for (int ai = 0; ai < 2; ++ai)
#pragma unroll
            for (int m = 0; m < 4; ++m) { const size_t off = (size_t)(row0 + ai * HALF + m * 16) * 1024 + col0;
#pragma unroll
                for (int bj = 0; bj < 2; ++bj)
#pragma unroll
                    for (int n = 0; n < 2; ++n) { const f32x4 r = *(const f32x4*)(res + off + bj * HALF + n * 16); *(f32x4*)(out + off + bj * HALF + n * 16) = r + acc[ai][bj][m][n]; }
                asm volatile("" ::: "memory"); }
    }
};
__device__ __forceinline__ float silu_f(float x) { return x * __builtin_amdgcn_rcpf(1.0f + __builtin_amdgcn_exp2f(-x * LOG2E)); }
__device__ __forceinline__ unsigned pk4_fp8(float a, float b, float c, float d) { int w = 0; w = __builtin_amdgcn_cvt_pk_fp8_f32(a, b, w, false); w = __builtin_amdgcn_cvt_pk_fp8_f32(c, d, w, true); return (unsigned)w; }
struct EpiMoe1 {
    static constexpr bool PERM = true;
    unsigned char* ACT;
    __device__ __forceinline__ void operator()(const f32x4 (&acc)[2][2][4][2], const Unit& u, int wr, int wc, int fr, int fq) const {
        const int row0 = u.pm * BM + wr * 64 + fr, col0 = (u.pn & 3) * 128 + wc * 32 + 8 * fq; constexpr float si = 1.0f / (H8_SCALE * W1_SCALE);
#pragma unroll
        for (int ai = 0; ai < 2; ++ai)
#pragma unroll
            for (int m = 0; m < 4; ++m) { f32x4 a0, a1;
#pragma unroll
                for (int j = 0; j < 4; ++j) { a0[j] = silu_f(acc[ai][0][m][0][j] * si) * acc[ai][1][m][0][j] * (si * ACT_SCALE); a1[j] = silu_f(acc[ai][0][m][1][j] * si) * acc[ai][1][m][1][j] * (si * ACT_SCALE); }
                u32x2 w; w.x = pk4_fp8(a0[0], a0[1], a0[2], a0[3]); w.y = pk4_fp8(a1[0], a1[1], a1[2], a1[3]);
                *(u32x2*)(ACT + (size_t)(row0 + ai * HALF + m * 16) * 512 + col0) = w; }
    }
};
struct EpiMoe2 {
    static constexpr bool PERM = true;
    bf16_t* Y; const int* list; const float* pairw; const LAS int* lcnt;
    __device__ __forceinline__ void operator()(const f32x4 (&acc)[2][2][4][2], const Unit& u, int wr, int wc, int fr, int fq) const {
        const int e = u.pn >> 2, col0 = (u.pn & 3) * BM + wc * 32 + 8 * fq, pos0 = u.aux * BM + wr * 64 + fr, cn = lcnt[e];
#pragma unroll
        for (int ai = 0; ai < 2; ++ai)
#pragma unroll
            for (int m = 0; m < 4; ++m) { const int pos = pos0 + ai * HALF + m * 16;
                if (pos < cn) { const int pair = list[e * LISTCAP + pos]; const float w = pairw[pair] * (1.0f / (ACT_SCALE * W2_SCALE)); bf16_t* rowp = Y + (size_t)pair * 1024 + col0;
#pragma unroll
                    for (int bj = 0; bj < 2; ++bj) *(u32x4*)(rowp + bj * HALF) = pack8(acc[ai][bj][m][0] * w, acc[ai][bj][m][1] * w); } }
    }
};
__device__ __forceinline__ float log2_gamma(int h) { return __builtin_log2f(1.0f - __builtin_amdgcn_exp2f(-5.0f - (float)h)); }
struct EpiRetA {
    static constexpr bool PERM = true;
    bf16_t* ACAT; bf16_t* KI; bf16_t* SG; const float* sincos;
    __device__ __forceinline__ void operator()(const f32x4 (&acc)[2][2][4][2], const Unit& u, int wr, int wc, int fr, int fq) const {
        const int r0 = wr * 64 + fr, c0 = wc * 32 + 8 * fq;
        if (u.pn >= 8) {
#pragma unroll
            for (int ai = 0; ai < 2; ++ai)
#pragma unroll
                for (int m = 0; m < 4; ++m) { bf16_t* rowp = SG + (size_t)(u.pm * BM + r0 + ai * HALF + m * 16) * 2048 + (u.pn - 8) * BM + c0;
#pragma unroll
                    for (int bj = 0; bj < 2; ++bj) { f32x4 a0, a1;
#pragma unroll
                        for (int j = 0; j < 4; ++j) { a0[j] = silu_f(acc[ai][bj][m][0][j] * IN_DESCALE); a1[j] = silu_f(acc[ai][bj][m][1][j] * IN_DESCALE); }
                        *(u32x4*)(rowp + bj * HALF) = pack8(a0, a1); } }
            return;
        }
        const bool isq = u.pn < 4; const int h = u.pn & 3; const float l2g = log2_gamma(h);
        const int b = u.pm >> 3, n = u.pm & 7;
#pragma unroll
        for (int ai = 0; ai < 2; ++ai)
#pragma unroll
            for (int m = 0; m < 4; ++m) { const int r = r0 + ai * HALF + m * 16, pos = n * RC + r;
                const float fac = IN_DESCALE * (isq ? __builtin_amdgcn_exp2f((float)(r + 1) * l2g) : 0.0625f * __builtin_amdgcn_exp2f(-(float)(r + 1) * l2g));
                bf16_t* rowp = isq ? ACAT + ((size_t)((b * RH + h) * RNC + n) * RC + r) * 512 + 256 + c0 : KI + (size_t)(u.pm * BM + r) * 1024 + h * RDK + c0;
#pragma unroll
                for (int bj = 0; bj < 2; ++bj) { const f32x4* cs = (const f32x4*)(sincos + ((size_t)pos * 128 + (bj * HALF + c0) / 2) * 2);
                    const f32x4 t0 = cs[0], t1 = cs[1]; const f32x4 x0 = acc[ai][bj][m][0], x1 = acc[ai][bj][m][1]; f32x4 y0, y1;
                    y0[0] = (x0[0] * t0[0] - x0[1] * t0[1]) * fac; y0[1] = (x0[1] * t0[0] + x0[0] * t0[1]) * fac; y0[2] = (x0[2] * t0[2] - x0[3] * t0[3]) * fac; y0[3] = (x0[3] * t0[2] + x0[2] * t0[3]) * fac;
                    y1[0] = (x1[0] * t1[0] - x1[1] * t1[1]) * fac; y1[1] = (x1[1] * t1[0] + x1[0] * t1[1]) * fac; y1[2] = (x1[2] * t1[2] - x1[3] * t1[3]) * fac; y1[3] = (x1[3] * t1[2] + x1[2] * t1[3]) * fac;
                    *(u32x4*)(rowp + bj * HALF) = pack8(y0, y1); } }
    }
};
struct EpiRetB {
    static constexpr bool PERM = true;
    bf16_t* KIT; bf16_t* BTCAT; const float* sincosT;
    __device__ __forceinline__ void operator()(const f32x4 (&acc)[2][2][4][2], const Unit& u, int wr, int wc, int fr, int fq) const {
        const int r0 = wr * 64 + fr, c0 = wc * 32 + 8 * fq; const int b = u.pn >> 3, n = u.pn & 7;
        if (u.pm >= 4) { const int h = (u.pm - 4) >> 1, dv0 = ((u.pm - 4) & 1) * BM;
#pragma unroll
            for (int ai = 0; ai < 2; ++ai)
#pragma unroll
                for (int m = 0; m < 4; ++m) { bf16_t* rowp = BTCAT + ((size_t)((b * RH + h) * RNC + n) * RDV + dv0 + r0 + ai * HALF + m * 16) * 512 + c0;
#pragma unroll
                    for (int bj = 0; bj < 2; ++bj) *(u32x4*)(rowp + bj * HALF) = pack8(acc[ai][bj][m][0] * IN_DESCALE, acc[ai][bj][m][1] * IN_DESCALE); }
            return;
        }
        const int h = u.pm; const float l2g = log2_gamma(h);
        float fc[2][8];
#pragma unroll
        for (int bj = 0; bj < 2; ++bj)
#pragma unroll
            for (int j = 0; j < 8; ++j) fc[bj][j] = (0.0625f * IN_DESCALE) * __builtin_amdgcn_exp2f(-(float)(bj * HALF + c0 + j + 1) * l2g);
        const bool odd = (fr & 1) != 0;
#pragma unroll
        for (int ai = 0; ai < 2; ++ai)
#pragma unroll
            for (int m = 0; m < 4; ++m) { const int r = r0 + ai * HALF + m * 16;
                bf16_t* rowp = KIT + ((size_t)((b * RH + h) * RDK + r)) * SEQ + n * RC + c0;
#pragma unroll
                for (int bj = 0; bj < 2; ++bj) { const f32x4* cs = (const f32x4*)(sincosT + ((size_t)(r >> 1) * SEQ + n * RC + bj * HALF + c0) * 2);
                    f32x4 y[2];
#pragma unroll
                    for (int nn = 0; nn < 2; ++nn) { const f32x4 ta = cs[nn * 2], tb = cs[nn * 2 + 1]; const f32x4 x = acc[ai][bj][m][nn]; f32x4 xp;
#pragma unroll
                        for (int j = 0; j < 4; ++j) xp[j] = __shfl_xor(x[j], 1);
                        const float cc[4] = {ta[0], ta[2], tb[0], tb[2]}, ss[4] = {ta[1], ta[3], tb[1], tb[3]};
#pragma unroll
                        for (int j = 0; j < 4; ++j) y[nn][j] = (x[j] * cc[j] + (odd ? xp[j] : -xp[j]) * ss[j]) * fc[bj][nn * 4 + j]; }
                    *(u32x4*)(rowp + bj * HALF) = pack8(y[0], y[1]); } }
    }
};
struct EpiScores {
    static constexpr bool PERM = true;
    bf16_t* ACAT;
    __device__ __forceinline__ void operator()(const f32x4 (&acc)[2][2][4][2], const Unit& u, int wr, int wc, int fr, int fq) const {
        const int r0 = wr * 64 + fr, c0 = wc * 32 + 8 * fq;
#pragma unroll
        for (int ai = 0; ai < 2; ++ai)
#pragma unroll
            for (int m = 0; m < 4; ++m) { const int r = r0 + ai * HALF + m * 16; bf16_t* rowp = ACAT + ((size_t)u.pm * RC + r) * 512 + c0;
#pragma unroll
                for (int bj = 0; bj < 2; ++bj) { f32x4 y0 = acc[ai][bj][m][0], y1 = acc[ai][bj][m][1]; const int cb = bj * HALF + c0;
#pragma unroll
                    for (int j = 0; j < 4; ++j) { if (cb + j > r) y0[j] = 0.f; if (cb + 4 + j > r) y1[j] = 0.f; }
                    *(u32x4*)(rowp + bj * HALF) = pack8(y0, y1); } }
    }
};
struct EpiDS {
    static constexpr bool PERM = true;
    bf16_t* DS;
    __device__ __forceinline__ void operator()(const f32x4 (&acc)[2][2][4][2], const Unit& u, int wr, int wc, int fr, int fq) const {
        const int r0 = wr * 64 + fr, c0 = wc * 32 + 8 * fq;
#pragma unroll
        for (int ai = 0; ai < 2; ++ai)
#pragma unroll
            for (int m = 0; m < 4; ++m) { bf16_t* rowp = DS + ((size_t)u.pm * RDV + u.pn * BM + r0 + ai * HALF + m * 16) * RDK + c0;
#pragma unroll
                for (int bj = 0; bj < 2; ++bj) *(u32x4*)(rowp + bj * HALF) = pack8(acc[ai][bj][m][0], acc[ai][bj][m][1]); }
    }
};
struct EpiRetO {
    static constexpr bool PERM = true;
    bf16_t* ORET; bf16_t* SG; LAS float* ssq;
    __device__ __forceinline__ void operator()(const f32x4 (&acc)[2][2][4][2], const Unit& u, int wr, int wc, int fr, int fq) const {
        const int r0 = wr * 64 + fr, c0 = wc * 32 + 8 * fq; const int n = u.pm & 7, h = (u.pm >> 3) & 3, b = u.pm >> 5;
        LAS float* sq = ssq + (u.aux & 1) * 256;
        if (u.pn == 0) { const int t_ = threadIdx.x; if (t_ < 256) ssq[((u.aux & 1) ^ 1) * 256 + t_] = 0.f; }
#pragma unroll
        for (int ai = 0; ai < 2; ++ai)
#pragma unroll
            for (int m = 0; m < 4; ++m) { float s = 0.f;
#pragma unroll
                for (int bj = 0; bj < 2; ++bj)
#pragma unroll
                    for (int nn = 0; nn < 2; ++nn) { const f32x4 x = acc[ai][bj][m][nn]; s += (x[0] * x[0] + x[1] * x[1]) + (x[2] * x[2] + x[3] * x[3]); }
                s += __shfl_xor(s, 16); s += __shfl_xor(s, 32);
                if (fq == 0) (void)__hip_atomic_fetch_add(sq + r0 + ai * HALF + m * 16, s, __ATOMIC_RELAXED, __HIP_MEMORY_SCOPE_WORKGROUP); }
        const size_t rowbase = (size_t)(b * SEQ + n * RC) * 2048 + h * RDV;
        if (u.pn == 0) {
#pragma unroll
            for (int ai = 0; ai < 2; ++ai)
#pragma unroll
                for (int m = 0; m < 4; ++m) { bf16_t* rowp = ORET + rowbase + (size_t)(r0 + ai * HALF + m * 16) * 2048 + c0;
#pragma unroll
                    for (int bj = 0; bj < 2; ++bj) *(u32x4*)(rowp + bj * HALF) = pack8(acc[ai][bj][m][0], acc[ai][bj][m][1]); }
            return;
        }
        asm volatile("s_waitcnt lgkmcnt(0)" ::: "memory"); __builtin_amdgcn_s_barrier(); asm volatile("" ::: "memory");
#pragma unroll
        for (int ai = 0; ai < 2; ++ai)
#pragma unroll
            for (int m = 0; m < 4; ++m) { const int r = r0 + ai * HALF + m * 16; const float rstd = __builtin_amdgcn_rsqf(sq[r] * (1.0f / 512.0f) + RMS_EPS);
                const size_t ro = rowbase + (size_t)r * 2048 + c0;
#pragma unroll
                for (int bj = 0; bj < 2; ++bj) {
                    { bf16_t* gp = SG + ro + BM + bj * HALF; const u32x4 g = *(const u32x4*)gp; f32x4 y0 = acc[ai][bj][m][0] * rstd, y1 = acc[ai][bj][m][1] * rstd;
                      y0[0] *= __uint_as_float(g.x << 16); y0[1] *= __uint_as_float(g.x & 0xffff0000u); y0[2] *= __uint_as_float(g.y << 16); y0[3] *= __uint_as_float(g.y & 0xffff0000u);
                      y1[0] *= __uint_as_float(g.z << 16); y1[1] *= __uint_as_float(g.z & 0xffff0000u); y1[2] *= __uint_as_float(g.w << 16); y1[3] *= __uint_as_float(g.w & 0xffff0000u);
                      *(u32x4*)gp = pack8(y0, y1); }
                    { bf16_t* gp = SG + ro + bj * HALF; const u32x4 g = *(const u32x4*)gp; const u32x4 o = *(const u32x4*)(ORET + ro + bj * HALF); f32x4 y0, y1;
                      y0[0] = __uint_as_float(o.x << 16) * rstd * __uint_as_float(g.x << 16); y0[1] = __uint_as_float(o.x & 0xffff0000u) * rstd * __uint_as_float(g.x & 0xffff0000u);
                      y0[2] = __uint_as_float(o.y << 16) * rstd * __uint_as_float(g.y << 16); y0[3] = __uint_as_float(o.y & 0xffff0000u) * rstd * __uint_as_float(g.y & 0xffff0000u);
                      y1[0] = __uint_as_float(o.z << 16) * rstd * __uint_as_float(g.z << 16); y1[1] = __uint_as_float(o.z & 0xffff0000u) * rstd * __uint_as_float(g.z & 0xffff0000u);
                      y1[2] = __uint_as_float(o.w << 16) * rstd * __uint_as_float(g.w << 16); y1[3] = __uint_as_float(o.w & 0xffff0000u) * rstd * __uint_as_float(g.w & 0xffff0000u);
                      *(u32x4*)gp = pack8(y0, y1); } } }
    }
};
struct ScoresOrder {
    int G, c;
    __device__ bool next(int i, Unit& u) const { const int L = i * G + c; if (L >= NB * RH * RNC) return false; const int n = L & 7, h = (L >> 3) & 3, b = L >> 5;
        u.pm = L; u.pn = 0; u.aux = 0; u.aoff = (long)L * RC * 512 + 256; u.boff = (long)(b * SEQ + n * RC) * 1024 + h * RDK; return true; }
};
struct DsOrder {
    int G, c;
    __device__ bool next(int i, Unit& u) const { const int L = i * G + c; if (L >= NB * RH * 7 * 2) return false; const int dvt = L & 1, q = L >> 1, n = q % 7, bh = q / 7, p = bh * RNC + n;
        u.pm = p; u.pn = dvt; u.aux = 0; u.aoff = ((long)p * RDV + dvt * BM) * 512; u.boff = (long)bh * RDK * SEQ + n * RC; return true; }
};
struct RetOOrder {
    int G, c;
    __device__ bool next(int i, Unit& u) const { const int k = i >> 1, dvt = i & 1, p = k * G + c; if (p >= NB * RH * RNC) return false;
        u.pm = p; u.pn = dvt; u.aux = k; u.aoff = (long)p * RC * 512; u.boff = ((long)p * RDV + dvt * BM) * 512; return true; }
};
struct MoeOrder {
    int G, c, ldb; long a_tile; const LAS int* tstart; const LAS int* texp;
    __device__ bool next(int i, Unit& u) const { const int L = i * G + c; const int ntiles = tstart[33]; if (L >= ntiles * 4) return false; const int rt = L >> 2, pnl = L & 3, e = texp[rt];
        u.pm = rt; u.pn = e * 4 + pnl; u.aux = rt - tstart[e]; u.aoff = (long)rt * a_tile; u.boff = ((long)e * 1024 + pnl * BM) * ldb; return true; }
};
}
namespace attn_body {
using bf16=__hip_bfloat16;
using bf16x8=__attribute__((ext_vector_type(8)))short;
using s16x4=__attribute__((ext_vector_type(4)))short;
using f32x16=__attribute__((ext_vector_type(16)))float;
using u32x4=__attribute__((ext_vector_type(4)))unsigned;
constexpr int D=64,PQ=3072,PO=1024;
constexpr int NW=8,QBLK=32,QB=QBLK*NW,KVBLK=64,NQB=SEQ/QB;
__device__ __forceinline__ int crow(int r,int hi){return (r&3)+8*(r>>2)+4*hi;}
#define SBAR() __builtin_amdgcn_sched_barrier(0)
__device__ __forceinline__ void biasmask(f32x16&p0,f32x16&p1,int jb6,int qrel,int hi,const LAS float*lut){
  const float NEG=-INFINITY; const int base=128+qrel-64*jb6-4*hi;
  #pragma unroll
  for(int g=0;g<4;++g){
    #pragma unroll
    for(int q=0;q<4;++q){const int r=4*g+q; const int rel=base-(q+8*g); const int rel1=rel-32;
      const float b0=lut[rel<0?0:(rel>128?128:rel)], b1=lut[rel1<0?0:(rel1>128?128:rel1)];
      p0[r]=(rel<0)?NEG:p0[r]+b0; p1[r]=(rel1<0)?NEG:p1[r]+b1;}
    asm volatile("":"+v"(p0),"+v"(p1)); __builtin_amdgcn_sched_barrier(0);}
}
constexpr int NSLOT=3, SLOTB=8192;
constexpr int LDS_K=0, LDS_V=NSLOT*SLOTB, LDS_WS=2*NSLOT*SLOTB, LDS_OST=LDS_WS+NW*64*4, LDS_BYTES=LDS_OST+NW*4096;
__device__ __forceinline__ void glds16(const void*gsrc,unsigned lds_dst){unsigned keep;
  asm volatile("s_mov_b32 %0, m0\n\ts_mov_b32 m0, %2\n\ts_nop 0\n\tglobal_load_lds_dwordx4 %1, off\n\ts_mov_b32 m0, %0":"=&s"(keep):"v"(gsrc),"s"(lds_dst):"memory");}
__device__ __forceinline__ float max3f(float a,float b,float c){float r;asm("v_max3_f32 %0, %1, %2, %3":"=v"(r):"v"(a),"v"(b),"v"(c));return r;}
__device__ __forceinline__ float max2f(float a,float b){float r;asm("v_max_f32_e32 %0, %1, %2":"=v"(r):"v"(a),"v"(b));return r;}
__device__ __forceinline__ float fadd_s(float a,float b){float r;asm("v_add_f32_e32 %0, %1, %2":"=v"(r):"v"(a),"v"(b));return r;}
__device__ __forceinline__ float fsub_s(float a,float b){float r;asm("v_sub_f32_e32 %0, %1, %2":"=v"(r):"v"(a),"v"(b));return r;}
typedef float f32x2_t __attribute__((ext_vector_type(2))); typedef __bf16 bf16x2_t __attribute__((ext_vector_type(2)));
__device__ __forceinline__ unsigned cvtpk_s(float lo,float hi){f32x2_t v={lo,hi};bf16x2_t b=__builtin_convertvector(v,bf16x2_t);return __builtin_bit_cast(unsigned,b);}
#define WAIT_BAR(N) asm volatile("s_waitcnt vmcnt(" #N ") lgkmcnt(0)\n\ts_barrier":::"memory")

__device__ __forceinline__ void qkt(f32x16&p0,f32x16&p1,const char*Kslot,const bf16x8*qr,const f32x16&negm,int r32,int hi){
  const char*kb=Kslot+hi*1024+r32*16;
  #pragma unroll
  for(int d0=0;d0<4;++d0){
    const bf16x8 b0=*reinterpret_cast<const bf16x8*>(kb+d0*2048);
    const bf16x8 b1=*reinterpret_cast<const bf16x8*>(kb+d0*2048+512);
    if(d0==0){p0=__builtin_amdgcn_mfma_f32_32x32x16_bf16(b0,qr[0],negm,0,0,0);p1=__builtin_amdgcn_mfma_f32_32x32x16_bf16(b1,qr[0],negm,0,0,0);}
    else{p0=__builtin_amdgcn_mfma_f32_32x32x16_bf16(b0,qr[d0],p0,0,0,0);p1=__builtin_amdgcn_mfma_f32_32x32x16_bf16(b1,qr[d0],p1,0,0,0);}}
}
typedef LAS const char* lds_cptr;
typedef short v4i16_t __attribute__((ext_vector_type(4)));
__device__ __forceinline__ void kload8(bf16x8*kf,lds_cptr kp){
  kf[0]=*(const LAS bf16x8*)(kp);      kf[1]=*(const LAS bf16x8*)(kp+512);
  kf[2]=*(const LAS bf16x8*)(kp+2048); kf[3]=*(const LAS bf16x8*)(kp+2560);
  kf[4]=*(const LAS bf16x8*)(kp+4096); kf[5]=*(const LAS bf16x8*)(kp+4608);
  kf[6]=*(const LAS bf16x8*)(kp+6144); kf[7]=*(const LAS bf16x8*)(kp+6656);
}
__device__ __forceinline__ void kload2(bf16x8*kf,lds_cptr kp,int j){ kf[2*j]=*(const LAS bf16x8*)(kp+j*2048); kf[2*j+1]=*(const LAS bf16x8*)(kp+j*2048+512); }
__device__ __forceinline__ s16x4 vtr(lds_cptr p){ return __builtin_bit_cast(s16x4,__builtin_amdgcn_ds_read_tr16_b64_v4i16((LAS v4i16_t*)p)); }
__device__ __forceinline__ float rowmax(const f32x16&p0,const f32x16&p1){
  float a=max3f(p0[0],p0[1],p1[0]),b=max3f(p0[2],p0[3],p1[1]);a=max3f(a,p1[2],p1[3]);
  #pragma unroll
  for(int r=4;r<16;r+=4){a=max3f(a,p0[r],p0[r+1]);b=max3f(b,p0[r+2],p0[r+3]);a=max3f(a,p1[r],p1[r+1]);b=max3f(b,p1[r+2],p1[r+3]);}
  const float m=max2f(a,b);
  auto rr=__builtin_amdgcn_permlane32_swap(__float_as_uint(m),__float_as_uint(m),false,false);
  return max2f(__uint_as_float(rr[0]),__uint_as_float(rr[1]));
}
__device__ __forceinline__ void pv(f32x16*o,int vb,bf16x8 pa0,bf16x8 pa1,bf16x8 pa2,bf16x8 pa3){
  #pragma unroll
  for(int d0=0;d0<2;++d0){s16x4 lo[4],hi[4];
    #pragma unroll
    for(int ks=0;ks<4;++ks){
      asm volatile("ds_read_b64_tr_b16 %0,%1 offset:%c2":"=&v"(lo[ks]):"v"(vb),"i"(d0*4096+ks*1024):"memory");
      asm volatile("ds_read_b64_tr_b16 %0,%1 offset:%c2":"=&v"(hi[ks]):"v"(vb),"i"(d0*4096+ks*1024+512):"memory");}
    asm volatile("s_waitcnt lgkmcnt(0)":::"memory");SBAR();
    #define PK(k) (bf16x8){lo[k][0],lo[k][1],lo[k][2],lo[k][3],hi[k][0],hi[k][1],hi[k][2],hi[k][3]}
    o[d0]=__builtin_amdgcn_mfma_f32_32x32x16_bf16(pa0,PK(0),o[d0],0,0,0);
    o[d0]=__builtin_amdgcn_mfma_f32_32x32x16_bf16(pa1,PK(1),o[d0],0,0,0);
    o[d0]=__builtin_amdgcn_mfma_f32_32x32x16_bf16(pa2,PK(2),o[d0],0,0,0);
    o[d0]=__builtin_amdgcn_mfma_f32_32x32x16_bf16(pa3,PK(3),o[d0],0,0,0);
    #undef PK
  }
}
template<int THRL> __device__ __forceinline__ void attn_unit(int b,int qb,const bf16*QKV,int Qc,int Kc,int Vc,bf16*O,const LAS float*lut,char*shm){
  int tid_=threadIdx.x; asm volatile("":"+v"(tid_)); const int tid=tid_,lane=tid&63,r32=lane&31,hi=lane>>5; const int wid=__builtin_amdgcn_readfirstlane(tid>>6);
  const long rowbase=(long)b*SEQ; const int q0=qb*QB;
  const bf16*Qw=QKV+(rowbase+q0+wid*QBLK)*PQ+Qc;
  const bf16*Kh=QKV+rowbase*PQ+Kc,*Vh=QKV+rowbase*PQ+Vc;
  const unsigned lds0=(unsigned)(uintptr_t)shm;
  float*wsf=(float*)(shm+LDS_WS)+wid*64;
  const bf16*ksrc=Kh+(long)lane*PQ+wid*8;
  const bf16*vsrc=Vh+(long)(16*(wid&3)+(lane>>2))*PQ+(wid>>2)*32+(lane&3)*8;
  const unsigned kdst=lds0+LDS_K+wid*1024, vdst=lds0+LDS_V+wid*1024;
  #define DMA_K(t,slot) glds16(ksrc+(long)(t)*KVBLK*PQ,(unsigned)__builtin_amdgcn_readfirstlane(kdst+(slot)))
  #define DMA_V(t,slot) glds16(vsrc+(long)(t)*KVBLK*PQ,(unsigned)__builtin_amdgcn_readfirstlane(vdst+(slot)))
  const int vb0=(int)(lds0+LDS_V)+((lane>>4)&1)*32+(lane&3)*8+(4*hi+((lane&15)>>2))*64;
  const char*Kbase=shm+LDS_K; bf16x8 kf[8];
  const lds_cptr shm3=(lds_cptr)shm; const lds_cptr kp0=shm3+LDS_K+hi*1024+r32*16; const lds_cptr vp0=shm3+LDS_V+((lane>>4)&1)*32+(lane&3)*8+(4*hi+((lane&15)>>2))*64;
  const int NT=(q0+QB)/KVBLK;
  DMA_K(0,0);DMA_V(0,0);DMA_K(1,SLOTB);
  bf16x8 qr[4];
  #pragma unroll
  for(int d0=0;d0<4;++d0)qr[d0]=*reinterpret_cast<const bf16x8*>(&Qw[(long)r32*PQ+d0*16+hi*8]);
  float mhat=0.f,l_reg=0.f;f32x16 o[2];f32x16 negm; { float zz; asm volatile("v_mov_b32 %0, 0":"=v"(zz)); _Pragma("unroll") for(int r=0;r<16;++r){o[0][r]=zz;o[1][r]=zz;negm[r]=zz;} } asm volatile("":"+v"(negm));
  const int qrel=wid*QBLK+r32;
  #define CMASK(P0,P1,t) do{int jb_=(t)-(NT-6); if(jb_>=0)biasmask(P0,P1,jb_,qrel,hi,lut);}while(0)
  bool resc=false;
  #define START(P0,P1) do{ const float rm=rowmax(P0,P1); resc=false; \
    { const float dl=rm; mhat=fadd_s(mhat,dl); \
      _Pragma("unroll") for(int r=0;r<16;++r){P0[r]=fsub_s(P0[r],dl);P1[r]=fsub_s(P1[r],dl);} \
      _Pragma("unroll") for(int r=0;r<16;++r)negm[r]=-mhat; asm volatile("":"+v"(negm)); } \
    _Pragma("unroll") for(int r=0;r<16;++r)P0[r]=__builtin_amdgcn_exp2f(P0[r]); }while(0)
  #define RESC() do{ if(resc){ asm volatile("s_waitcnt lgkmcnt(0)":::"memory"); \
      _Pragma("unroll") for(int d_=0;d_<2;++d_) _Pragma("unroll") for(int r=0;r<16;++r)o[d_][r]*=wsf[crow(r,hi)]; } }while(0)
  f32x16 pA0,pA1,pB0,pB1;
  int sl_prev=0,sl_cur=0,sl_next=SLOTB;
  #define ROT() do{sl_prev=sl_cur;sl_cur=sl_next;sl_next=(sl_next==(NSLOT-1)*SLOTB)?0:sl_next+SLOTB;}while(0)
  DMA_K(2,2*SLOTB);
  WAIT_BAR(3);
  qkt(pA0,pA1,Kbase,qr,negm,r32,hi);asm volatile("s_nop 15\n\ts_nop 7":"+v"(pA0),"+v"(pA1));CMASK(pA0,pA1,0);
  START(pA0,pA1);
  _Pragma("unroll") for(int r=0;r<16;++r)pA1[r]=__builtin_amdgcn_exp2f(pA1[r]);
  WAIT_BAR(0);
  DMA_K(3,0);DMA_V(1,SLOTB);
  ROT();
  kload8(kf,kp0+sl_cur);
  WAIT_BAR(2);
  s16x4 vlo[8],vhi[8]; u32x4 pw0,pw1,pw2,pw3;
  #define PKW(P,B) cvtpk_s(P[B],P[B+1])
  #define PAF(k) __builtin_bit_cast(bf16x8,pw##k)
  #define VFR(i) (bf16x8){vlo[i][0],vlo[i][1],vlo[i][2],vlo[i][3],vhi[i][0],vhi[i][1],vhi[i][2],vhi[i][3]}
  #define PIN(x) asm volatile("":"+v"(x))
  #define MX3(a,b,c) __builtin_fmaxf(__builtin_fmaxf((a),(b)),(c))
  #define GAPA(MF,A0,A1,A2,A3,W0,W1,PW) do{ MF; sacc+=A0; sacc+=A1; sacc+=A2; sacc+=A3; PIN(sacc); W0; W1; PIN(PW); SBAR(); }while(0)
  #define EX(v) __builtin_amdgcn_exp2f(v)
  #define GAPB(MF,X,B) do{ MF; X[B]=EX(X[B]); X[B+1]=EX(X[B+1]); X[B+2]=EX(X[B+2]); X[B+3]=EX(X[B+3]); PIN(X); SBAR(); }while(0)
  #define VRD(i) do{ vlo[i]=vtr(vp_+(((i)>>2)*4096+((i)&3)*1024)); vhi[i]=vtr(vp_+(((i)>>2)*4096+((i)&3)*1024+512)); }while(0)
  #define KRD(G,j) do{ if(G){ kload2(kf,kp0+sl_next,j); SBAR(); } }while(0)
  #define STEP(C0,C1,P0,P1,t,GK,GV,GL) do{ SBAR(); \
    const lds_cptr vp_=vp0+sl_prev; \
    VRD(0); SBAR(); float sacc=(P0[0]+P0[1]); \
    GAPA(C0=__builtin_amdgcn_mfma_f32_32x32x16_bf16(kf[0],qr[0],negm,0,0,0), P0[2],P0[3],P0[4],P0[5],     pw0[0]=PKW(P0,0), pw0[1]=PKW(P0,2), pw0); \
    VRD(4); SBAR(); GAPA(C1=__builtin_amdgcn_mfma_f32_32x32x16_bf16(kf[1],qr[0],negm,0,0,0), P0[6],P0[7],P0[8],P0[9],     pw0[2]=PKW(P0,4), pw0[3]=PKW(P0,6), pw0); \
    VRD(1); SBAR(); GAPA(C0=__builtin_amdgcn_mfma_f32_32x32x16_bf16(kf[2],qr[1],C0,0,0,0),   P0[10],P0[11],P0[12],P0[13], pw1[0]=PKW(P0,8), pw1[1]=PKW(P0,10), pw1); \
    VRD(5); SBAR(); GAPA(C1=__builtin_amdgcn_mfma_f32_32x32x16_bf16(kf[3],qr[1],C1,0,0,0),   P0[14],P0[15],P1[0],P1[1],   pw1[2]=PKW(P0,12),pw1[3]=PKW(P0,14), pw1); \
    VRD(2); SBAR(); GAPA(C0=__builtin_amdgcn_mfma_f32_32x32x16_bf16(kf[4],qr[2],C0,0,0,0),   P1[2],P1[3],P1[4],P1[5],     pw2[0]=PKW(P1,0), pw2[1]=PKW(P1,2), pw2); \
    VRD(6); SBAR(); GAPA(C1=__builtin_amdgcn_mfma_f32_32x32x16_bf16(kf[5],qr[2],C1,0,0,0),   P1[6],P1[7],P1[8],P1[9],     pw2[2]=PKW(P1,4), pw2[3]=PKW(P1,6), pw2); \
    VRD(3); SBAR(); GAPA(C0=__builtin_amdgcn_mfma_f32_32x32x16_bf16(kf[6],qr[3],C0,0,0,0),   P1[10],P1[11],P1[12],P1[13], pw3[0]=PKW(P1,8), pw3[1]=PKW(P1,10), pw3); \
    VRD(7); SBAR(); GAPA(C1=__builtin_amdgcn_mfma_f32_32x32x16_bf16(kf[7],qr[3],C1,0,0,0),   P1[14],P1[15],0.f,0.f,       pw3[2]=PKW(P1,12),pw3[3]=PKW(P1,14), pw3); \
    l_reg+=sacc; \
    if(GK){DMA_K((t)+3,sl_cur);} if(GV){DMA_V((t)+1,sl_next);} \
    CMASK(C0,C1,t); \
    { float a=MX3(C0[0],C0[1],C1[0]),b=MX3(C0[2],C0[3],C1[1]); a=MX3(a,C1[2],C1[3]); \
      _Pragma("unroll") for(int r=4;r<16;r+=4){a=MX3(a,C0[r],C0[r+1]);b=MX3(b,C0[r+2],C0[r+3]);a=MX3(a,C1[r],C1[r+1]);b=MX3(b,C1[r+2],C1[r+3]);} \
      float rm=__builtin_fmaxf(a,b); { auto rr=__builtin_amdgcn_permlane32_swap(__float_as_uint(rm),__float_as_uint(rm),false,false); rm=__builtin_fmaxf(__uint_as_float(rr[0]),__uint_as_float(rr[1])); } \
      resc=false; \
      if(__builtin_expect(__any(rm>(float)THRL),0)){ const float dl=__builtin_fmaxf(rm,0.f); mhat+=dl; \
        _Pragma("unroll") for(int r=0;r<16;++r){C0[r]-=dl;C1[r]-=dl;} \
        _Pragma("unroll") for(int r=0;r<16;++r)negm[r]=-mhat; asm volatile("":"+v"(negm)); \
        const float f=__builtin_amdgcn_exp2f(-dl); l_reg*=f; if(hi==0)wsf[r32]=f; resc=true; } } \
    SBAR(); \
    GAPB(o[0]=__builtin_amdgcn_mfma_f32_32x32x16_bf16(PAF(0),VFR(0),o[0],0,0,0), C0,0); \
    GAPB(o[1]=__builtin_amdgcn_mfma_f32_32x32x16_bf16(PAF(0),VFR(4),o[1],0,0,0), C0,4); \
    KRD(GL,0); GAPB(o[0]=__builtin_amdgcn_mfma_f32_32x32x16_bf16(PAF(1),VFR(1),o[0],0,0,0), C0,8); \
    KRD(GL,1); GAPB(o[1]=__builtin_amdgcn_mfma_f32_32x32x16_bf16(PAF(1),VFR(5),o[1],0,0,0), C0,12); \
    KRD(GL,2); GAPB(o[0]=__builtin_amdgcn_mfma_f32_32x32x16_bf16(PAF(2),VFR(2),o[0],0,0,0), C1,0); \
    KRD(GL,3); GAPB(o[1]=__builtin_amdgcn_mfma_f32_32x32x16_bf16(PAF(2),VFR(6),o[1],0,0,0), C1,4); \
    GAPB(o[0]=__builtin_amdgcn_mfma_f32_32x32x16_bf16(PAF(3),VFR(3),o[0],0,0,0), C1,8); \
    GAPB(o[1]=__builtin_amdgcn_mfma_f32_32x32x16_bf16(PAF(3),VFR(7),o[1],0,0,0), C1,12); \
    }while(0)
  int t=1;
  #undef CMASK
  #define CMASK(P0,P1,t) do{}while(0)
  for(;t+7<NT;t+=2){
    STEP(pB0,pB1,pA0,pA1,t,true,true,true);     WAIT_BAR(2); RESC(); ROT();
    STEP(pA0,pA1,pB0,pB1,t+1,true,true,true);   WAIT_BAR(2); RESC(); ROT();
  }
  #undef CMASK
  #define CMASK(P0,P1,t) do{int jb_=(t)-(NT-6); if(jb_>=0)biasmask(P0,P1,jb_,qrel,hi,lut);}while(0)
  #define ENDW(tt) do{ if((tt)+3<NT){WAIT_BAR(2);} else if((tt)+2<NT){WAIT_BAR(1);} else {WAIT_BAR(0);} }while(0)
  for(;t+1<NT;t+=2){
    STEP(pB0,pB1,pA0,pA1,t,(t+3<NT),(t+1<NT),(t+1<NT));       ENDW(t);   RESC(); ROT();
    STEP(pA0,pA1,pB0,pB1,t+1,(t+4<NT),(t+2<NT),(t+2<NT));     ENDW(t+1); RESC(); ROT();
  }
  STEP(pB0,pB1,pA0,pA1,NT-1,false,false,false); RESC();
  { float sacc=pB0[0]+pB0[1]; _Pragma("unroll") for(int r=2;r<16;++r)sacc+=pB0[r]; _Pragma("unroll") for(int r=0;r<16;++r)sacc+=pB1[r]; l_reg+=sacc;
    pw0=(u32x4){PKW(pB0,0),PKW(pB0,2),PKW(pB0,4),PKW(pB0,6)};pw1=(u32x4){PKW(pB0,8),PKW(pB0,10),PKW(pB0,12),PKW(pB0,14)};pw2=(u32x4){PKW(pB1,0),PKW(pB1,2),PKW(pB1,4),PKW(pB1,6)};pw3=(u32x4){PKW(pB1,8),PKW(pB1,10),PKW(pB1,12),PKW(pB1,14)};
    SBAR(); pv(o,vb0+sl_cur,PAF(0),PAF(1),PAF(2),PAF(3)); }
  #undef PKW
  #undef PAF
  #undef VFR
  #undef PIN
  #undef MX3
  #undef GAPA
  #undef GAPB
  #undef EX
  #undef VRD
  #undef KRD
  #undef STEP
  #undef ENDW
  {auto rr=__builtin_amdgcn_permlane32_swap(__float_as_uint(l_reg),__float_as_uint(l_reg),false,false);l_reg=__uint_as_float(rr[0])+__uint_as_float(rr[1]);}
  if(hi==0)wsf[32+r32]=l_reg;asm volatile("s_waitcnt lgkmcnt(0)":::"memory");
  float rli[16];
  #pragma unroll
  for(int r=0;r<16;++r)rli[r]=__builtin_amdgcn_rcpf(wsf[32+crow(r,hi)]);
  bf16*Ow=O+(rowbase+q0+wid*QBLK)*PO;
  { bf16*stg=(bf16*)(shm+LDS_OST)+wid*2048;
    #pragma unroll
    for(int r=0;r<16;++r){const int orow=crow(r,hi);
      #pragma unroll
      for(int d0=0;d0<2;++d0)stg[orow*64+d0*32+r32]=__float2bfloat16(o[d0][r]*rli[r]);}
    asm volatile("s_waitcnt lgkmcnt(0)":::"memory");
    #pragma unroll
    for(int i=0;i<4;++i){const int row=i*8+(lane>>3),ch=lane&7; const u32x4 v=*(const u32x4*)(stg+row*64+ch*8); *(u32x4*)(Ow+(long)row*PO+ch*8)=v;} }
  asm volatile("s_waitcnt lgkmcnt(0)\n\ts_barrier":::"memory");
  #undef DMA_K
  #undef DMA_V
  #undef CMASK
  #undef START
  #undef RESC
  #undef ROT
}
constexpr int ATTN_LDS_BYTES=LDS_BYTES;
#undef SBAR
#undef WAIT_BAR
}
constexpr int NWAVES = 8;
typedef unsigned short bf16;
typedef unsigned v4u __attribute__((ext_vector_type(4)));
typedef unsigned v2u __attribute__((ext_vector_type(2)));
typedef float f32x4 __attribute__((ext_vector_type(4)));
typedef float f32x2 __attribute__((ext_vector_type(2)));
typedef short bf16x8 __attribute__((ext_vector_type(8)));
typedef GAS unsigned gu32;
#define RLX_AGENT __ATOMIC_RELAXED, __HIP_MEMORY_SCOPE_AGENT
#define LDS_WAIT() asm volatile("s_waitcnt lgkmcnt(0)" ::: "memory")
#define VM_WAIT() asm volatile("s_waitcnt vmcnt(0)" ::: "memory")
__device__ __forceinline__ unsigned f2bf(float f) { unsigned u = __builtin_bit_cast(unsigned, f); return (u + 0x7fffu + ((u >> 16) & 1u)) >> 16; }
__device__ __forceinline__ unsigned pk2(float lo, float hi) { return f2bf(lo) | (f2bf(hi) << 16); }
__device__ __forceinline__ float bf2f(unsigned short b) { return __builtin_bit_cast(float, (unsigned)b << 16); }
__device__ __forceinline__ float bflo(unsigned w) { return __builtin_bit_cast(float, w << 16); }
__device__ __forceinline__ float bfhi(unsigned w) { return __builtin_bit_cast(float, w & 0xffff0000u); }

#define XB_TMO      128
#define XB_XCNT(j)  (256  + 64 * (j))
#define XB_XSUB(j)  (1280 + 64 * (j))
#define XB_XGEN(j)  (2304 + 64 * (j))
#define XB_TOP      3328
#define XB_TOPGEN   3392
#define XCD_BAR_WORDS 3456
#define XB_SPIN_CAP (1u << 18)
__device__ __forceinline__ unsigned xb_ld(unsigned* p)              { return __hip_atomic_load(p, __ATOMIC_RELAXED, __HIP_MEMORY_SCOPE_AGENT); }
__device__ __forceinline__ unsigned xb_add(unsigned* p, unsigned v) { return __hip_atomic_fetch_add(p, v, __ATOMIC_RELAXED, __HIP_MEMORY_SCOPE_AGENT); }
__device__ __forceinline__ unsigned xb_xcc_id() { return (unsigned)__builtin_amdgcn_s_getreg((3 << 11) | 20) & 0xFu; }
#define XB_SPIN(cond, bar) do { unsigned _sp = 0; while (cond) { __builtin_amdgcn_s_sleep(1); \
    if ((++_sp & 255u) == 0u) { if (xb_ld(&(bar)[XB_TMO])) break; if (_sp > XB_SPIN_CAP) { atomicAdd(&(bar)[XB_TMO], 1u); break; } } } } while (0)
struct XcdBarrier { unsigned* bar; unsigned x; volatile LAS unsigned* st; };
__device__ __forceinline__ XcdBarrier xcd_barrier_post(unsigned* bar, volatile LAS unsigned* st) {
    XcdBarrier b; b.bar = bar; b.x = xb_xcc_id(); b.st = st;
    if (threadIdx.x == 0) (void)xb_add(&bar[XB_XCNT(b.x)], 1u);
    return b;
}
__device__ __forceinline__ void xcd_barrier_complete(unsigned* bar, unsigned x, unsigned& nloc, unsigned& nx) {
    const unsigned G = gridDim.x * gridDim.y * gridDim.z;
    unsigned sum, cnt, mine, sp = 0u;
    for (;;) {
        sum = 0u; cnt = 0u; mine = 0u;
#pragma unroll
        for (unsigned j = 0; j < 16; ++j) { const unsigned c = xb_ld(&bar[XB_XCNT(j)]); sum += c; cnt += (c > 0u) ? 1u : 0u; mine = (j == x) ? c : mine; }
        if (sum == G) break;
        __builtin_amdgcn_s_sleep(1);
        if ((++sp & 255u) == 0u) { if (xb_ld(&bar[XB_TMO])) break; if (sp > XB_SPIN_CAP) { atomicAdd(&bar[XB_TMO], 1u); break; } }
    }
    nloc = mine > 0u ? mine : 1u; nx = cnt > 0u ? cnt : 1u;
}
__device__ __forceinline__ void xcd_barrier(const XcdBarrier& b) {
    asm volatile("s_waitcnt vmcnt(0)" ::: "memory");
    __syncthreads();
    if (threadIdx.x == 0) {
        unsigned* bar = b.bar;
        __builtin_amdgcn_s_waitcnt(0);
        unsigned nloc = b.st[0], nx = b.st[1];
        if (nloc == 0u) { xcd_barrier_complete(bar, b.x, nloc, nx); b.st[0] = nloc; b.st[1] = nx; }
        const unsigned old = xb_add(&bar[XB_XSUB(b.x)], 1u);
        const unsigned gen = old / nloc;
        if (old + 1u == (gen + 1u) * nloc) {
            __builtin_amdgcn_fence(__ATOMIC_RELEASE, "agent");
            asm volatile("s_waitcnt vmcnt(0)" ::: "memory");
            const unsigned og = xb_add(&bar[XB_TOP], 1u);
            const unsigned tg = og / nx;
            if (og + 1u == (tg + 1u) * nx) xb_add(&bar[XB_TOPGEN], 1u);
            else XB_SPIN(xb_ld(&bar[XB_TOPGEN]) == tg, bar);
            __builtin_amdgcn_fence(__ATOMIC_ACQUIRE, "agent");
            xb_add(&bar[XB_XGEN(b.x)], 1u);
            asm volatile("s_waitcnt vmcnt(0)" ::: "memory");
        } else {
            XB_SPIN(xb_ld(&bar[XB_XGEN(b.x)]) == gen, bar);
            __builtin_amdgcn_fence(__ATOMIC_ACQUIRE, "agent");
            asm volatile("s_waitcnt vmcnt(0)" ::: "memory");
        }
    }
    __syncthreads();
}

struct Args { const float* in[18]; float* out; unsigned char* ws; int ph_lo, ph_hi, li, pad; };
struct Frame {
    LAS unsigned char* lds;
    gu32* ctl;
    unsigned char* ws;
    int tid, lane, wave;
    int vcu, G;
};

__device__ __forceinline__ float wave_sum(float v) {
#pragma unroll
    for (int o = 1; o < 64; o <<= 1) v += __shfl_xor(v, o);
    return v;
}
__device__ __forceinline__ void transpose_block(const float* src, int ld_src, bf16* dst, int ld_dst, LAS float* scr, int lane, bf16* dst2) {
#pragma unroll 8
    for (int i = 0; i < 32; ++i) { const int kk = 2 * i + (lane >> 5); scr[kk * 33 + (lane & 31)] = src[(size_t)kk * ld_src + (lane & 31)]; }
    LDS_WAIT(); asm volatile("" ::: "memory");
    const int c = lane & 7;
#pragma unroll
    for (int j = 0; j < 4; ++j) { const int n = (lane >> 3) + 8 * j; const LAS float* s = scr + (8 * c) * 33 + n;
        v4u o; o.x = pk2(s[0 * 33], s[1 * 33]); o.y = pk2(s[2 * 33], s[3 * 33]); o.z = pk2(s[4 * 33], s[5 * 33]); o.w = pk2(s[6 * 33], s[7 * 33]);
        *(GAS v4u*)(dst + (size_t)n * ld_dst + 8 * c) = o;
        if (dst2) *(GAS v4u*)(dst2 + (size_t)n * ld_dst + 8 * c) = o; }
    LDS_WAIT(); asm volatile("" ::: "memory");
}
__device__ __forceinline__ unsigned pk4_fp8f(float a, float b, float c, float d) { int w = 0; w = __builtin_amdgcn_cvt_pk_fp8_f32(a, b, w, false); w = __builtin_amdgcn_cvt_pk_fp8_f32(c, d, w, true); return (unsigned)w; }
__device__ __forceinline__ void transpose_block8(const float* src, int ld_src, unsigned char* dst, int ld_dst, float sc, LAS float* scr, int lane, unsigned char* dst2 = nullptr) {
#pragma unroll 8
    for (int i = 0; i < 32; ++i) { const int kk = 2 * i + (lane >> 5); scr[kk * 33 + (lane & 31)] = src[(size_t)kk * ld_src + (lane & 31)]; }
    LDS_WAIT(); asm volatile("" ::: "memory");
    const int c = lane & 7;
#pragma unroll
    for (int j = 0; j < 4; ++j) { const int n = (lane >> 3) + 8 * j; const LAS float* s = scr + (8 * c) * 33 + n;
        v2u o; o.x = pk4_fp8f(s[0 * 33] * sc, s[1 * 33] * sc, s[2 * 33] * sc, s[3 * 33] * sc); o.y = pk4_fp8f(s[4 * 33] * sc, s[5 * 33] * sc, s[6 * 33] * sc, s[7 * 33] * sc);
        *(GAS v2u*)(dst + (size_t)n * ld_dst + 8 * c) = o;
        if (dst2) *(GAS v2u*)(dst2 + (size_t)n * ld_dst + 8 * c) = o; }
    LDS_WAIT(); asm volatile("" ::: "memory");
}
__device__ __forceinline__ void rms_row_to_bf16(int lane, const float* xrow, const float* g, bf16* orow) {
    const GAS f32x4* xr = (const GAS f32x4*)xrow + lane; const GAS f32x4* gr = (const GAS f32x4*)g + lane;
    f32x4 v[4]; float s = 0.f;
#pragma unroll
    for (int j = 0; j < 4; ++j) { v[j] = xr[64 * j]; s += (v[j].x * v[j].x + v[j].y * v[j].y) + (v[j].z * v[j].z + v[j].w * v[j].w); }
    const float rstd = 1.0f / sqrtf(wave_sum(s) * (1.f / 1024.f) + RMS_EPS);
    GAS v2u* o8 = (GAS v2u*)orow + lane;
#pragma unroll
    for (int j = 0; j < 4; ++j) { const f32x4 gg = gr[64 * j]; v2u o; o.x = pk2(v[j].x * rstd * gg.x, v[j].y * rstd * gg.y); o.y = pk2(v[j].z * rstd * gg.z, v[j].w * rstd * gg.w); o8[64 * j] = o; }
}

__device__ __forceinline__ void rms_row_to_fp8(int lane, const float* xrow, const float* g, unsigned char* orow) {
    const GAS f32x4* xr = (const GAS f32x4*)xrow + lane; const GAS f32x4* gr = (const GAS f32x4*)g + lane;
    f32x4 v[4]; float s = 0.f;
#pragma unroll
    for (int j = 0; j < 4; ++j) { v[j] = xr[64 * j]; s += (v[j].x * v[j].x + v[j].y * v[j].y) + (v[j].z * v[j].z + v[j].w * v[j].w); }
    const float rstd = H8_SCALE / sqrtf(wave_sum(s) * (1.f / 1024.f) + RMS_EPS);
    GAS unsigned* o4 = (GAS unsigned*)orow + lane;
#pragma unroll
    for (int j = 0; j < 4; ++j) { const f32x4 gg = gr[64 * j]; o4[64 * j] = pk4_fp8f(v[j].x * rstd * gg.x, v[j].y * rstd * gg.y, v[j].z * rstd * gg.z, v[j].w * rstd * gg.w); }
}
constexpr int IT_WIN0 = (1024 / 64) * (3072 / 32);
constexpr int IT_WOUT0 = (1024 / 64) * (1024 / 32);
constexpr int IT_RIN = (1024 / 64) * (6144 / 32);
constexpr int IT_ROUT = (2048 / 64) * (1024 / 32);
constexpr int IT_SHARED = IT_WIN0 + IT_WOUT0 + IT_RIN + IT_ROUT;
constexpr int IT_EXP = 3 * 256;
constexpr int IT_MOE = NEXP * IT_EXP;
__device__ __forceinline__ void conv_shared_item(Frame& F, const Args& a, int it, LAS float* scr) {
    unsigned char* ws = F.ws;
    if (it < IT_WIN0) { const int nblk = 96, kb = it / nblk, nb = it % nblk;
        if (QKV_FP8) transpose_block8(a.in[5] + (size_t)(64 * kb) * 3072 + 32 * nb, 3072, ws + WS_WINT0 + (size_t)(32 * nb) * 1024 + 64 * kb, 1024, WIN_SCALE, scr, F.lane);
        else transpose_block(a.in[5] + (size_t)(64 * kb) * 3072 + 32 * nb, 3072, (bf16*)(ws + WS_WINT0) + (size_t)(32 * nb) * 1024 + 64 * kb, 1024, scr, F.lane, nullptr);
        return; }
    it -= IT_WIN0;
    if (it < IT_WOUT0) { const int nblk = 32, kb = it / nblk, nb = it % nblk;
        transpose_block(a.in[8] + (size_t)(64 * kb) * 1024 + 32 * nb, 1024, (bf16*)(ws + WS_WOUTT0) + (size_t)(32 * nb) * 1024 + 64 * kb, 1024, scr, F.lane, nullptr); return; }
    it -= IT_WOUT0;
    if (it < IT_RIN) { const int nblk = 192, kb = it / nblk, nb = it % nblk, n0 = 32 * nb;
        unsigned char* A = ws + WS_WRINA; unsigned char* B = ws + WS_WRINB; unsigned char *d1, *d2 = nullptr;
        if (n0 < 1024) d1 = A + (size_t)n0 * 1024;
        else if (n0 < 2048) { d1 = A + (size_t)n0 * 1024; d2 = B + (size_t)(n0 - 1024) * 1024; }
        else if (n0 < 4096) d1 = B + (size_t)(n0 - 1024) * 1024;
        else d1 = A + (size_t)(n0 - 2048) * 1024;
        transpose_block8(a.in[9] + (size_t)(64 * kb) * 6144 + n0, 6144, d1 + 64 * kb, 1024, WIN_SCALE, scr, F.lane, d2 ? d2 + 64 * kb : nullptr); return; }
    it -= IT_RIN;
    { const int nblk = 32, kb = it / nblk, nb = it % nblk;
        transpose_block(a.in[10] + (size_t)(64 * kb) * 1024 + 32 * nb, 1024, (bf16*)(ws + WS_WROUTT) + (size_t)(32 * nb) * 2048 + 64 * kb, 2048, scr, F.lane, nullptr); }
}
__device__ __forceinline__ void conv_moe_item(Frame& F, const Args& a, int layer, int it, LAS float* scr) {
    unsigned char* ws = F.ws;
    const int e = it / IT_EXP; int r = it % IT_EXP; const size_t le = (size_t)layer * NEXP + e;
    if (r < 512) { const int up = r >> 8; r &= 255; const int kb = r / 16, nb = r % 16, n0 = 32 * nb;
        const float* src = a.in[up ? 16 : 15] + le * (1024 * 512) + (size_t)(64 * kb) * 512 + n0;
        const int drow = 256 * (n0 >> 7) + 128 * up + (n0 & 127);
        transpose_block8(src, 512, ws + WS_W1CAT + ((size_t)e * 1024 + drow) * 1024 + 64 * kb, 1024, W1_SCALE, scr, F.lane); return; }
    r -= 512; { const int kb = r / 32, nb = r % 32;
        const float* src = a.in[17] + le * (512 * 1024) + (size_t)(64 * kb) * 1024 + 32 * nb;
        transpose_block8(src, 1024, ws + WS_W2T + ((size_t)e * 1024 + 32 * nb) * 512 + 64 * kb, 512, W2_SCALE, scr, F.lane); }
}
__device__ __forceinline__ void build_router_frags(Frame& F, const Args& a, int gtid, int gthreads) {
    bf16* wrf = (bf16*)(F.ws + WS_WRF);
    for (int idx = gtid; idx < 2 * 32 * 3 * 64 * 8; idx += gthreads) {
        const int j = idx & 7, lane = (idx >> 3) & 63, nt = (idx >> 9) % 3, s = ((idx >> 9) / 3) & 31, L = (idx >> 9) / 96;
        const int k = 32 * s + 8 * (lane >> 4) + j, o = 16 * nt + (lane & 15);
        float w = 0.f;
        if (o < 4) w = a.in[11][((size_t)L * 1024 + k) * 4 + o]; else if (o < 36) w = a.in[13][((size_t)L * 1024 + k) * 32 + (o - 4)];
        w *= a.in[3][L * 1024 + k];
        const unsigned hi = f2bf(w); const float lo = w - __builtin_bit_cast(float, hi << 16);
        const size_t base = ((((size_t)L * 32 + s) * 3 + nt) * 2) * 512 + (size_t)lane * 8 + j;
        wrf[base] = (bf16)hi; wrf[base + 512] = (bf16)f2bf(lo);
    }
}
__device__ __forceinline__ void build_sincos(Frame& F, int gtid, int gthreads) {
    float* t1 = (float*)(F.ws + WS_SINCOS); float* t2 = (float*)(F.ws + WS_SINCOST);
    for (int idx = gtid; idx < SEQ * 128; idx += gthreads) {
        const int pos = idx >> 7, i = idx & 127;
        double ang = 1.0, bs = 0.9300449458481391;
        for (int bit = 0; bit < 7; ++bit) { if ((i >> bit) & 1) ang *= bs; bs *= bs; }
        const double ph = (double)pos * ang;
        const double kq = __builtin_rint(ph * 0.63661977236758134308);
        double r = __builtin_fma(-kq, 1.57079632679489655800, ph); r = __builtin_fma(-kq, 6.12323399573676603587e-17, r);
        const double r2 = r * r;
        double sn = r * (1.0 + r2 * (-1.0 / 6 + r2 * (1.0 / 120 + r2 * (-1.0 / 5040 + r2 * (1.0 / 362880 + r2 * (-1.0 / 39916800 + r2 * (1.0 / 6227020800.0)))))));
        double cs = 1.0 + r2 * (-0.5 + r2 * (1.0 / 24 + r2 * (-1.0 / 720 + r2 * (1.0 / 40320 + r2 * (-1.0 / 3628800 + r2 * (1.0 / 479001600.0 + r2 * (-1.0 / 87178291200.0)))))));
        const int q = ((int)kq) & 3;
        double s_ = (q == 0) ? sn : (q == 1) ? cs : (q == 2) ? -sn : -cs;
        double c_ = (q == 0) ? cs : (q == 1) ? -sn : (q == 2) ? -cs : sn;
        t1[(size_t)idx * 2] = (float)c_; t1[(size_t)idx * 2 + 1] = (float)s_;
        const size_t j = ((size_t)i * SEQ + pos) * 2; t2[j] = (float)c_; t2[j + 1] = (float)s_;
    }
}
__device__ __forceinline__ void p_prologue(Frame& F, const Args& a) {
    LAS float* scr = (LAS float*)(F.lds + RING_OFF + F.wave * 16384);
    const int gw = F.vcu * NWAVES + F.wave, NGW = F.G * NWAVES;
    for (int it = gw; it < IT_SHARED + IT_MOE; it += NGW) { if (it < IT_SHARED) conv_shared_item(F, a, it, scr); else conv_moe_item(F, a, 0, it - IT_SHARED, scr); }
    build_router_frags(F, a, F.vcu * 512 + F.tid, F.G * 512);
    build_sincos(F, F.vcu * 512 + F.tid, F.G * 512);
    for (int m = gw; m < TOK; m += NGW) { if (QKV_FP8) rms_row_to_fp8(F.lane, a.in[0] + (size_t)m * DM, a.in[2], F.ws + WS_HB + (size_t)m * DM); else rms_row_to_bf16(F.lane, a.in[0] + (size_t)m * DM, a.in[2], (bf16*)(F.ws + WS_HB) + (size_t)m * DM); }
}
__device__ __forceinline__ void p_attention(Frame& F, const Args& a) {
    LAS float* lut = (LAS float*)(F.lds + LX_LUT);
    const attn_body::bf16* QKV = (const attn_body::bf16*)(F.ws + WS_QKV0);
    const float* lq = a.in[6];
    const float lam = __expf(wave_sum(lq[F.lane] * lq[64 + F.lane])) - __expf(wave_sum(lq[128 + F.lane] * lq[192 + F.lane])) + 0.2f;
    for (int v = F.vcu; v < 256; v += F.G) {
        const int bh = v >> 2, s = v & 3, b = bh >> 3, h = bh & 7;
        __syncthreads();
        if (F.tid < 132) { const int n = F.tid; int bk = n;
            if (n >= 16) { bk = 16; const int thr[15] = {19, 21, 24, 27, 31, 35, 40, 46, 52, 59, 67, 77, 87, 99, 113};
#pragma unroll
                for (int q = 0; q < 15; ++q) bk += (n >= thr[q]) ? 1 : 0; }
            lut[n] = (a.in[1][bk * 8 + h] - a.in[1][31 * 8 + h]) * LOG2E; }
        __syncthreads();
#pragma nounroll
        for (int i = 0; i < 8; ++i) {
            const int qb = (i < 4) ? 7 - s : s, m = (i >> 1) & 1, vh = i & 1;
            attn_body::bf16* O = (attn_body::bf16*)(F.ws + WS_OP) + (size_t)m * TOK * 1024 + h * 128 + vh * 64;
            attn_body::attn_unit<8>(b, qb, QKV, h * 128 + m * 64, 1024 + h * 128 + m * 64, 2048 + h * 128 + vh * 64, O, lut, (char*)F.lds + RING_OFF);
            if ((i & 3) == 3) {
                VM_WAIT(); __syncthreads();
                int t_ = threadIdx.x; asm volatile("" : "+v"(t_));
                const int row = b * SEQ + qb * 256 + (t_ >> 1), c0 = h * 128 + (t_ & 1) * 64;
                const bf16* O0 = (const bf16*)(F.ws + WS_OP) + (size_t)row * 1024 + c0; const bf16* O1 = O0 + (size_t)TOK * 1024; bf16* AO = (bf16*)(F.ws + WS_AO) + (size_t)row * 1024 + c0;
                const float* sg = a.in[7] + (t_ & 1) * 64;
                float ss = 0.f; v4u wa[8], wb[8];
#pragma unroll
                for (int q = 0; q < 8; ++q) { wa[q] = ((const GAS v4u*)O0)[q]; wb[q] = ((const GAS v4u*)O1)[q]; }
#pragma unroll
                for (int q = 0; q < 8; ++q) { const unsigned xa[4] = {wa[q].x, wa[q].y, wa[q].z, wa[q].w}, xb[4] = {wb[q].x, wb[q].y, wb[q].z, wb[q].w};
#pragma unroll
                    for (int j = 0; j < 4; ++j) { const float o0 = bflo(xa[j]) - lam * bflo(xb[j]), o1 = bfhi(xa[j]) - lam * bfhi(xb[j]); ss += o0 * o0 + o1 * o1; } }
                ss += __shfl_xor(ss, 1);
                const float rstd = 0.8f / sqrtf(ss * (1.f / 128.f) + SUBLN_EPS);
#pragma unroll
                for (int q = 0; q < 8; ++q) { const unsigned xa[4] = {wa[q].x, wa[q].y, wa[q].z, wa[q].w}, xb[4] = {wb[q].x, wb[q].y, wb[q].z, wb[q].w}; unsigned r[4];
                    const f32x4 g0 = *(const GAS f32x4*)(sg + q * 8), g1 = *(const GAS f32x4*)(sg + q * 8 + 4); const float gg[8] = {g0.x, g0.y, g0.z, g0.w, g1.x, g1.y, g1.z, g1.w};
#pragma unroll
                    for (int j = 0; j < 4; ++j) r[j] = pk2((bflo(xa[j]) - lam * bflo(xb[j])) * rstd * gg[2 * j], (bfhi(xa[j]) - lam * bfhi(xb[j])) * rstd * gg[2 * j + 1]);
                    v4u o; o.x = r[0]; o.y = r[1]; o.z = r[2]; o.w = r[3]; ((GAS v4u*)AO)[q] = o; }
            }
        }
    }
}
__device__ __forceinline__ void p_diffcombine(Frame& F, const Args& a) {
    const int gw = F.vcu * NWAVES + F.wave, NGW = F.G * NWAVES, lane = F.lane;
    const float* lq = a.in[6];
    const float lam = __expf(wave_sum(lq[lane] * lq[64 + lane])) - __expf(wave_sum(lq[128 + lane] * lq[192 + lane])) + 0.2f;
    const int d0 = (lane & 7) * 16; float g[16];
#pragma unroll
    for (int j = 0; j < 16; ++j) g[j] = a.in[7][d0 + j] * 0.8f;
    const bf16* O0 = (const bf16*)(F.ws + WS_OP); const bf16* O1 = O0 + (size_t)TOK * 1024; bf16* AO = (bf16*)(F.ws + WS_AO);
    for (int m = gw; m < TOK; m += NGW) {
        const GAS v4u* p0 = (const GAS v4u*)(O0 + (size_t)m * 1024 + lane * 16); const GAS v4u* p1 = (const GAS v4u*)(O1 + (size_t)m * 1024 + lane * 16);
        const v4u a0 = p0[0], a1 = p0[1], b0 = p1[0], b1 = p1[1];
        const unsigned wa[8] = {a0.x, a0.y, a0.z, a0.w, a1.x, a1.y, a1.z, a1.w}, wb[8] = {b0.x, b0.y, b0.z, b0.w, b1.x, b1.y, b1.z, b1.w};
        float o[16]; float ss = 0.f;
#pragma unroll
        for (int j = 0; j < 8; ++j) { o[2 * j] = bflo(wa[j]) - lam * bflo(wb[j]); o[2 * j + 1] = bfhi(wa[j]) - lam * bfhi(wb[j]); ss += o[2 * j] * o[2 * j] + o[2 * j + 1] * o[2 * j + 1]; }
        ss += __shfl_xor(ss, 1); ss += __shfl_xor(ss, 2); ss += __shfl_xor(ss, 4);
        const float rstd = 1.0f / sqrtf(ss * (1.f / 128.f) + SUBLN_EPS);
        v4u w0, w1;
        w0.x = pk2(o[0] * rstd * g[0], o[1] * rstd * g[1]); w0.y = pk2(o[2] * rstd * g[2], o[3] * rstd * g[3]); w0.z = pk2(o[4] * rstd * g[4], o[5] * rstd * g[5]); w0.w = pk2(o[6] * rstd * g[6], o[7] * rstd * g[7]);
        w1.x = pk2(o[8] * rstd * g[8], o[9] * rstd * g[9]); w1.y = pk2(o[10] * rstd * g[10], o[11] * rstd * g[11]); w1.z = pk2(o[12] * rstd * g[12], o[13] * rstd * g[13]); w1.w = pk2(o[14] * rstd * g[14], o[15] * rstd * g[15]);
        GAS v4u* po = (GAS v4u*)(AO + (size_t)m * 1024 + lane * 16); po[0] = w0; po[1] = w1;
    }
}
template <int LAYER> __device__ __forceinline__ void p_router(Frame& F, const Args& a, const float* xres, int bank = LAYER) {
    typedef float f32x4v __attribute__((ext_vector_type(4)));
    LAS float* part = (LAS float*)(F.lds + RING_OFF);
    LAS float* ssqp = (LAS float*)(F.lds + RING_OFF + 98304);
    LAS float* logit = (LAS float*)(F.lds + RING_OFF + 100352);
    LAS float* rstd_s = (LAS float*)(F.lds + RING_OFF + 109568);
    LAS int* lcnt = (LAS int*)(F.lds + RING_OFF + 109824);
    LAS int* lbase = (LAS int*)(F.lds + RING_OFF + 109952);
    const int lane = F.lane, w = F.wave, row = lane & 15, kg = lane >> 4;
    const bf16x8* wrf = (const bf16x8*)(F.ws + WS_WRF) + (size_t)LAYER * (32 * 3 * 2 * 64);
    bf16x8 Bh[4][3], Bl[4][3];
#pragma unroll
    for (int s = 0; s < 4; ++s)
#pragma unroll
        for (int nt = 0; nt < 3; ++nt) { Bh[s][nt] = wrf[(((4 * w + s) * 3 + nt) * 2 + 0) * 64 + lane]; Bl[s][nt] = wrf[(((4 * w + s) * 3 + nt) * 2 + 1) * 64 + lane]; }
    const float* gffn = a.in[3] + LAYER * 1024; const float* bg = a.in[12] + LAYER * 4; const float* be = a.in[14] + LAYER * 32;
    int* list = (int*)(F.ws + WS_LIST); float* pairw = (float*)(F.ws + WS_PAIRW); bf16* HB = (bf16*)(F.ws + WS_HB);
    for (int tb = F.vcu; tb < TOK / 64; tb += F.G) {
        __syncthreads();
        if (F.tid < 32) lcnt[F.tid] = 0;
        f32x4v acc[4][3];
#pragma unroll
        for (int mt = 0; mt < 4; ++mt)
#pragma unroll
            for (int nt = 0; nt < 3; ++nt) acc[mt][nt] = (f32x4v){0.f, 0.f, 0.f, 0.f};
#pragma unroll
        for (int mt = 0; mt < 4; ++mt) { const float* xr = xres + (size_t)(tb * 64 + mt * 16 + row) * DM + 128 * w + 8 * kg; float ss = 0.f;
#pragma unroll
            for (int s = 0; s < 4; ++s) { const f32x4 x0 = *(const GAS f32x4*)(xr + 32 * s), x1 = *(const GAS f32x4*)(xr + 32 * s + 4);
                const float xv[8] = {x0.x, x0.y, x0.z, x0.w, x1.x, x1.y, x1.z, x1.w}; bf16x8 ah, al;
#pragma unroll
                for (int j = 0; j < 8; ++j) { ss += xv[j] * xv[j]; const unsigned hi = f2bf(xv[j]); ah[j] = (short)hi; al[j] = (short)f2bf(xv[j] - __builtin_bit_cast(float, hi << 16)); }
#pragma unroll
                for (int nt = 0; nt < 3; ++nt) { acc[mt][nt] = __builtin_amdgcn_mfma_f32_16x16x32_bf16(ah, Bh[s][nt], acc[mt][nt], 0, 0, 0);
                    acc[mt][nt] = __builtin_amdgcn_mfma_f32_16x16x32_bf16(ah, Bl[s][nt], acc[mt][nt], 0, 0, 0); acc[mt][nt] = __builtin_amdgcn_mfma_f32_16x16x32_bf16(al, Bh[s][nt], acc[mt][nt], 0, 0, 0); } }
            ss += __shfl_xor(ss, 16); ss += __shfl_xor(ss, 32);
            if (kg == 0) ssqp[w * 64 + mt * 16 + row] = ss;
#pragma unroll
            for (int nt = 0; nt < 3; ++nt)
#pragma unroll
                for (int r = 0; r < 4; ++r) part[(w * 64 + mt * 16 + 4 * kg + r) * 48 + nt * 16 + row] = acc[mt][nt][r]; }
        __syncthreads();
        if (F.tid < 64) { float s = 0.f;
#pragma unroll
            for (int q = 0; q < 8; ++q) s += ssqp[q * 64 + F.tid];
            rstd_s[F.tid] = 1.0f / sqrtf(s * (1.f / 1024.f) + RMS_EPS); }
        __syncthreads();
        for (int idx = F.tid; idx < 64 * 36; idx += 512) { const int tk = idx / 36, o = idx % 36; float s = 0.f;
#pragma unroll
            for (int q = 0; q < 8; ++q) s += part[(q * 64 + tk) * 48 + o];
            logit[tk * 36 + o] = s * rstd_s[tk] + (o < 4 ? bg[o] : be[o - 4]); }
        __syncthreads();
        if (w == 0) {
            const LAS float* lg = logit + lane * 36;
            int gi = 0; float gm = lg[0];
#pragma unroll
            for (int j = 1; j < 4; ++j) { const float v = lg[j]; if (v > gm) { gm = v; gi = j; } }
            float gs = 0.f;
#pragma unroll
            for (int j = 0; j < 4; ++j) gs += __expf(lg[j] - gm);
            const float gp = 1.0f / gs;
            const LAS float* le = lg + 4 + gi * 8;
            int i1 = 0; float v1 = le[0];
#pragma unroll
            for (int j = 1; j < 8; ++j) { const float v = le[j]; if (v > v1) { v1 = v; i1 = j; } }
            int i2 = -1; float v2 = -INFINITY;
#pragma unroll
            for (int j = 0; j < 8; ++j) { const float v = le[j]; if (j != i1 && v > v2) { v2 = v; i2 = j; } }
            const float e2 = __expf(v2 - v1), w1 = gp / (1.0f + e2), w2 = gp * e2 / (1.0f + e2);
            const int e_1 = gi * 8 + i1, e_2 = gi * 8 + i2;
            const int r1 = __hip_atomic_fetch_add(lcnt + e_1, 1, __ATOMIC_RELAXED, __HIP_MEMORY_SCOPE_WORKGROUP);
            const int r2 = __hip_atomic_fetch_add(lcnt + e_2, 1, __ATOMIC_RELAXED, __HIP_MEMORY_SCOPE_WORKGROUP);
            LDS_WAIT();
            if (lane < 32) { const int c = lcnt[lane]; int bs = 0; if (c > 0) bs = (int)__hip_atomic_fetch_add((unsigned*)(F.ctl + CW_CNT + (bank * 32 + lane) * 64), (unsigned)c, RLX_AGENT); lbase[lane] = bs; }
            LDS_WAIT();
            const int tg = tb * 64 + lane; const int p1 = lbase[e_1] + r1, p2 = lbase[e_2] + r2;
            list[e_1 * LISTCAP + p1] = 2 * tg; list[e_2 * LISTCAP + p2] = 2 * tg + 1; pairw[2 * tg] = w1; pairw[2 * tg + 1] = w2;
        }
        for (int i = 0; i < 8; ++i) { const int tk = w * 8 + i, tg = tb * 64 + tk; const float rs = rstd_s[tk];
            const GAS f32x4* xr = (const GAS f32x4*)(xres + (size_t)tg * DM) + lane; const GAS f32x4* gr = (const GAS f32x4*)gffn + lane; GAS unsigned* o4 = (GAS unsigned*)((unsigned char*)HB + (size_t)tg * DM) + lane;
#pragma unroll
            for (int j = 0; j < 4; ++j) { const f32x4 v = xr[64 * j], gg = gr[64 * j]; const float rs8 = rs * H8_SCALE; o4[64 * j] = pk4_fp8f(v.x * rs8 * gg.x, v.y * rs8 * gg.y, v.z * rs8 * gg.z, v.w * rs8 * gg.w); } }
    }
}
template <int LAYER> __device__ __forceinline__ void moe_setup(Frame& F) {
    LAS int* tstart = (LAS int*)(F.lds + LX_TSTART); LAS int* texp = (LAS int*)(F.lds + LX_TEXP); LAS int* lc = (LAS int*)(F.lds + LX_CNT);
    __syncthreads();
    if (F.tid < 32) { int c = (int)__hip_atomic_load((unsigned*)(F.ctl + CW_CNT + (LAYER * 32 + F.tid) * 64), RLX_AGENT); c = c < 0 ? 0 : (c > LISTCAP ? LISTCAP : c); lc[F.tid] = c; }
    __syncthreads();
    if (F.tid == 0) { int acc = 0; for (int e = 0; e < 32; ++e) { tstart[e] = acc; acc += (lc[e] + 255) >> 8; } if (acc > MAXRT) acc = MAXRT; tstart[32] = acc; tstart[33] = acc; }
    __syncthreads();
    if (F.tid < MAXRT) { int e = 0;
#pragma unroll 1
        for (int q = 1; q < 32; ++q) if (tstart[q] <= F.tid) e = q;
        texp[F.tid] = e; }
    __syncthreads();
}
template <int LAYER> __device__ __forceinline__ void p_moe1(Frame& F) {
    moe_setup<LAYER>(F);
    const LAS int* tstart = (const LAS int*)(F.lds + LX_TSTART); const LAS int* texp = (const LAS int*)(F.lds + LX_TEXP); const LAS int* lc = (const LAS int*)(F.lds + LX_CNT);
    LAS int* rowtab = (LAS int*)(F.lds + LX_ROWTAB);
    pg8::MoeOrder S{F.G, F.vcu, 512, 0, tstart, texp};
    const int* list = (const int*)(F.ws + WS_LIST);
    pg8::Unit u;
    for (int i = 0; i < 4 && S.next(i, u); ++i) { if (F.tid < 256) { const int e = u.pn >> 2, pos = u.aux * 256 + F.tid; rowtab[i * 256 + F.tid] = (pos < lc[e]) ? (list[e * LISTCAP + pos] >> 1) : 0; } }
    VM_WAIT(); __syncthreads();
    pg8::Gemm g{(const bf16*)(F.ws + WS_HB), (const bf16*)(F.ws + WS_W1CAT), 512, 512, 512};
    pg8::EpiMoe1 E{(unsigned char*)(F.ws + WS_MACT)};
    pg8::gemm_phase<pg8::EpiMoe1, pg8::MoeOrder, true, true, true>(F.lds + RING_OFF, g, S, E, rowtab);
}
template <int LAYER> __device__ __forceinline__ void p_moe2(Frame& F) {
    moe_setup<LAYER>(F);
    const LAS int* tstart = (const LAS int*)(F.lds + LX_TSTART); const LAS int* texp = (const LAS int*)(F.lds + LX_TEXP); const LAS int* lc = (const LAS int*)(F.lds + LX_CNT);
    pg8::MoeOrder S{F.G, F.vcu, 256, 256 * 256, tstart, texp};
    pg8::Gemm g{(const bf16*)(F.ws + WS_MACT), (const bf16*)(F.ws + WS_W2T), 256, 256, 256};
    pg8::EpiMoe2 E{(bf16*)(F.ws + WS_Y), (const int*)(F.ws + WS_LIST), (const float*)(F.ws + WS_PAIRW), lc};
    pg8::gemm_phase<pg8::EpiMoe2, pg8::MoeOrder, true, false, true>(F.lds + RING_OFF, g, S, E, nullptr);
}
template <bool FINAL> __device__ __forceinline__ void p_combine(Frame& F, float* xres, const float* g, float* dry = nullptr) {
    const int gw = F.vcu * NWAVES + F.wave, NGW = F.G * NWAVES, lane = F.lane;
    const bf16* Y = (const bf16*)(F.ws + WS_Y); bf16* HB = (bf16*)(F.ws + WS_HB);
    for (int m = gw; m < TOK; m += NGW) {
        GAS f32x4* xr = (GAS f32x4*)(xres + (size_t)m * DM) + lane; GAS f32x4* xw = dry ? (GAS f32x4*)(dry + (size_t)m * DM) + lane : xr; const GAS v2u* y0 = (const GAS v2u*)(Y + (size_t)(2 * m) * DM) + lane; const GAS v2u* y1 = (const GAS v2u*)(Y + (size_t)(2 * m + 1) * DM) + lane;
        const GAS f32x4* gr = (const GAS f32x4*)g + lane;
        f32x4 v[4]; float s = 0.f;
#pragma unroll
        for (int j = 0; j < 4; ++j) { const f32x4 x = xr[64 * j]; const v2u p = y0[64 * j], q = y1[64 * j];
            v[j].x = x.x + bflo(p.x) + bflo(q.x); v[j].y = x.y + bfhi(p.x) + bfhi(q.x); v[j].z = x.z + bflo(p.y) + bflo(q.y); v[j].w = x.w + bfhi(p.y) + bfhi(q.y);
            s += (v[j].x * v[j].x + v[j].y * v[j].y) + (v[j].z * v[j].z + v[j].w * v[j].w); }
        const float rstd = 1.0f / sqrtf(wave_sum(s) * (1.f / 1024.f) + RMS_EPS);
        if (FINAL) {
#pragma unroll
            for (int j = 0; j < 4; ++j) { const f32x4 gg = gr[64 * j]; f32x4 o; o.x = v[j].x * rstd * gg.x; o.y = v[j].y * rstd * gg.y; o.z = v[j].z * rstd * gg.z; o.w = v[j].w * rstd * gg.w; xw[64 * j] = o; }
        } else {
            GAS unsigned* o4 = (GAS unsigned*)((dry ? (unsigned char*)(dry + (size_t)TOK * DM) : (unsigned char*)HB) + (size_t)m * DM) + lane; const float r8 = rstd * H8_SCALE;
#pragma unroll
            for (int j = 0; j < 4; ++j) { xw[64 * j] = v[j]; const f32x4 gg = gr[64 * j]; o4[64 * j] = pk4_fp8f(v[j].x * r8 * gg.x, v[j].y * r8 * gg.y, v[j].z * r8 * gg.z, v[j].w * r8 * gg.w); }
        }
    }
}
__device__ __forceinline__ void p_scan(Frame& F) {
    const bf16* DS = (const bf16*)(F.ws + WS_DS); bf16* BT = (bf16*)(F.ws + WS_BTCAT);
    for (int gidx = F.vcu * 512 + F.tid; gidx < NB * RH * 16384; gidx += F.G * 512) {
        const int bh = gidx >> 14, e8 = gidx & 16383, dv = e8 >> 5, dk0 = (e8 & 31) * 8, h = bh & 3;
        const float cd = __builtin_amdgcn_exp2f(256.0f * pg8::log2_gamma(h));
        v4u d[7];
#pragma unroll
        for (int n = 0; n < 7; ++n) d[n] = *(const GAS v4u*)(DS + ((size_t)(bh * RNC + n) * RDV + dv) * RDK + dk0);
        float s[8];
#pragma unroll
        for (int j = 0; j < 8; ++j) s[j] = 0.f;
#pragma unroll
        for (int n = 0; n < 8; ++n) {
            v4u o; o.x = pk2(s[0], s[1]); o.y = pk2(s[2], s[3]); o.z = pk2(s[4], s[5]); o.w = pk2(s[6], s[7]);
            *(GAS v4u*)(BT + ((size_t)(bh * RNC + n) * RDV + dv) * 512 + 256 + dk0) = o;
            if (n < 7) { const unsigned wv[4] = {d[n].x, d[n].y, d[n].z, d[n].w};
#pragma unroll
                for (int j = 0; j < 4; ++j) { s[2 * j] = cd * (s[2 * j] + bflo(wv[j])); s[2 * j + 1] = cd * (s[2 * j + 1] + bfhi(wv[j])); } }
        }
    }
}
__device__ __forceinline__ void p_normgate(Frame& F, bf16* dry = nullptr) {
    const int gw = F.vcu * NWAVES + F.wave, NGW = F.G * NWAVES, lane = F.lane;
    const bf16* OR = (const bf16*)(F.ws + WS_ORET); bf16* SG = (bf16*)(F.ws + WS_SG);
    for (int m = gw; m < TOK; m += NGW) {
        const GAS v4u* po = (const GAS v4u*)(OR + (size_t)m * 2048 + lane * 32); GAS v4u* pg = (GAS v4u*)(SG + (size_t)m * 2048 + lane * 32); GAS v4u* pw = dry ? (GAS v4u*)(dry + (size_t)m * 2048 + lane * 32) : pg;
        v4u ov[4], gv[4]; float ss = 0.f;
#pragma unroll
        for (int q = 0; q < 4; ++q) { ov[q] = po[q]; gv[q] = pg[q]; }
#pragma unroll
        for (int q = 0; q < 4; ++q) { const unsigned wv[4] = {ov[q].x, ov[q].y, ov[q].z, ov[q].w};
#pragma unroll
            for (int j = 0; j < 4; ++j) { const float x0 = bflo(wv[j]), x1 = bfhi(wv[j]); ss += x0 * x0 + x1 * x1; } }
        ss += __shfl_xor(ss, 1); ss += __shfl_xor(ss, 2); ss += __shfl_xor(ss, 4); ss += __shfl_xor(ss, 8);
        const float rstd = 1.0f / sqrtf(ss * (1.f / 512.f) + RMS_EPS);
#pragma unroll
        for (int q = 0; q < 4; ++q) { const unsigned wv[4] = {ov[q].x, ov[q].y, ov[q].z, ov[q].w}, wg[4] = {gv[q].x, gv[q].y, gv[q].z, gv[q].w}; unsigned r[4];
#pragma unroll
            for (int j = 0; j < 4; ++j) r[j] = pk2(bflo(wv[j]) * rstd * bflo(wg[j]), bfhi(wv[j]) * rstd * bfhi(wg[j]));
            v4u o; o.x = r[0]; o.y = r[1]; o.z = r[2]; o.w = r[3]; pw[q] = o; }
    }
}
__device__ __forceinline__ void p_conv_moe1(Frame& F, const Args& a) {
    LAS float* scr = (LAS float*)(F.lds + RING_OFF + F.wave * 16384);
    const int gw = F.vcu * NWAVES + F.wave, NGW = F.G * NWAVES;
    for (int it = gw; it < IT_MOE; it += NGW) conv_moe_item(F, a, 1, it, scr);
}

constexpr int N_PHASES = 19;
#ifndef MK_PER_PHASE
#define MK_PER_PHASE 0
#endif
__global__ void __launch_bounds__(NWAVES * 64, 2) hybrid_fwd(Args args) {
    extern __shared__ __attribute__((aligned(16))) unsigned char lds[];
    Frame F;
    F.lds = (LAS unsigned char*)lds;
    F.tid = threadIdx.x; F.lane = F.tid & 63; F.wave = __builtin_amdgcn_readfirstlane(F.tid >> 6);
    F.G = gridDim.x; { const int bx = blockIdx.x; F.vcu = (F.G % 8 == 0) ? (bx % 8) * (F.G / 8) + bx / 8 : bx; }
    F.ws = args.ws; F.ctl = (gu32*)(args.ws + WS_CTL);
    for (int u = F.tid; u < (LDS_BYTES - LX_OFF) / 4; u += NWAVES * 64) ((LAS unsigned*)(F.lds + LX_OFF))[u] = 0u;
    __syncthreads();
    XcdBarrier bar; bar.bar = (unsigned*)(F.ctl + CW_BAR); bar.x = 0; bar.st = nullptr;
    if (!MK_PER_PHASE) bar = xcd_barrier_post((unsigned*)(F.ctl + CW_BAR), (volatile LAS unsigned*)(F.lds + LX_MISC) + 8);
    const int lo = args.ph_lo, hi = args.ph_hi;
#ifndef PH_MASK
#define PH_MASK 0x7ffff
#endif
#define IN(k) (((PH_MASK >> (k)) & 1) && lo <= (k) && (k) < hi)
#define SEAM(k) do { if (IN(k) && IN((k) + 1)) xcd_barrier(bar); } while (0)
#define REFRESH() do { int t_ = threadIdx.x; asm volatile("" : "+v"(t_)); F.tid = t_; F.lane = t_ & 63; } while (0)
#ifndef DUP_MASK
#define DUP_MASK 0
#endif
#ifndef XBAR_N
#define XBAR_N 0
#endif
#define DUP(k) (((DUP_MASK >> (k)) & 1) != 0)
    float* xres = args.out;
    unsigned char* ws = args.ws;
    const int bx = (int)blockIdx.x;

    if (IN(0)) { REFRESH(); p_prologue(F, args); if (DUP(0)) { xcd_barrier(bar); p_prologue(F, args); } for (int q = 0; q < XBAR_N; ++q) xcd_barrier(bar); } SEAM(0);
    if (IN(1)) { REFRESH(); for (int rep_ = 0; rep_ < (DUP(1) ? 2 : 1); ++rep_) { if (rep_) xcd_barrier(bar);
        constexpr int KQ = QKV_FP8 ? 512 : 1024; pg8::Gemm g{(const bf16*)(ws + WS_HB), (const bf16*)(ws + WS_WINT0), KQ, KQ, KQ}; pg8::StaticOrder S; S.init(TOK, 3072, F.G, bx, KQ, KQ);
        pg8::EpiQKV E{(bf16*)(ws + WS_QKV0), ATT_C2};
        pg8::gemm_phase<pg8::EpiQKV, pg8::StaticOrder, true, false, (QKV_FP8 != 0)>(F.lds + RING_OFF, g, S, E, nullptr);
    }
    } SEAM(1);
    if (IN(2)) { REFRESH(); p_attention(F, args); if (DUP(2)) { xcd_barrier(bar); p_attention(F, args); } } if (IN(2) && IN(4)) xcd_barrier(bar);
    if (IN(4)) { REFRESH(); for (int rep_ = 0; rep_ < (DUP(4) ? 2 : 1); ++rep_) { if (rep_) xcd_barrier(bar);
        pg8::Gemm g{(const bf16*)(ws + WS_AO), (const bf16*)(ws + WS_WOUTT0), 1024, 1024, 1024}; pg8::StaticOrder S; S.init(TOK, 1024, F.G, bx, 1024, 1024);
        pg8::EpiRes E{args.in[0], xres};
        pg8::gemm_phase<pg8::EpiRes, pg8::StaticOrder, true, false>(F.lds + RING_OFF, g, S, E, nullptr);
    }
    } SEAM(4);
    if (IN(5)) { REFRESH(); p_router<0>(F, args, xres); if (DUP(5)) { xcd_barrier(bar); p_router<0>(F, args, xres, 2); } } SEAM(5);
    if (IN(6)) { REFRESH(); p_moe1<0>(F); if (DUP(6)) { xcd_barrier(bar); p_moe1<0>(F); } } SEAM(6);
    if (IN(7)) { REFRESH(); p_moe2<0>(F); if (DUP(7)) { xcd_barrier(bar); p_moe2<0>(F); } } SEAM(7);
    if (IN(8)) { REFRESH(); if (DUP(8)) { p_combine<false>(F, xres, args.in[2] + 1024, (float*)(ws + WS_KI)); xcd_barrier(bar); } p_combine<false>(F, xres, args.in[2] + 1024); } SEAM(8);
    if (IN(9)) { REFRESH(); for (int rep_ = 0; rep_ < (DUP(9) ? 2 : 1); ++rep_) { if (rep_) xcd_barrier(bar);
        { pg8::Gemm g{(const bf16*)(ws + WS_HB), (const bf16*)(ws + WS_WRINA), 512, 512, 512}; pg8::StaticOrder S; S.init(TOK, 4096, F.G, bx, 512, 512);
          pg8::EpiRetA E{(bf16*)(ws + WS_ACAT), (bf16*)(ws + WS_KI), (bf16*)(ws + WS_SG), (const float*)(ws + WS_SINCOS)};
          pg8::gemm_phase<pg8::EpiRetA, pg8::StaticOrder, true, false, true>(F.lds + RING_OFF, g, S, E, nullptr); }
        { pg8::Gemm g{(const bf16*)(ws + WS_WRINB), (const bf16*)(ws + WS_HB), 512, 512, 512}; pg8::StaticOrder S; S.init(3072, TOK, F.G, bx, 512, 512);
          pg8::EpiRetB E{(bf16*)(ws + WS_KIT), (bf16*)(ws + WS_BTCAT), (const float*)(ws + WS_SINCOST)};
          pg8::gemm_phase<pg8::EpiRetB, pg8::StaticOrder, true, false, true>(F.lds + RING_OFF, g, S, E, nullptr); }
    }
    } SEAM(9);
    if (IN(10)) { REFRESH(); for (int rep_ = 0; rep_ < (DUP(10) ? 2 : 1); ++rep_) { if (rep_) xcd_barrier(bar);
        { pg8::Gemm g{(const bf16*)(ws + WS_ACAT), (const bf16*)(ws + WS_KI), 512, 1024, 256}; pg8::ScoresOrder S{F.G, F.vcu};
          pg8::EpiScores E{(bf16*)(ws + WS_ACAT)};
          pg8::gemm_phase<pg8::EpiScores, pg8::ScoresOrder, true, false>(F.lds + RING_OFF, g, S, E, nullptr); }
        { pg8::Gemm g{(const bf16*)(ws + WS_BTCAT), (const bf16*)(ws + WS_KIT), 512, 2048, 256}; pg8::DsOrder S{F.G, F.vcu};
          pg8::EpiDS E{(bf16*)(ws + WS_DS)};
          pg8::gemm_phase<pg8::EpiDS, pg8::DsOrder, true, false>(F.lds + RING_OFF, g, S, E, nullptr); }
    }
    } SEAM(10);
    if (IN(11)) { REFRESH(); p_scan(F); if (DUP(11)) { xcd_barrier(bar); p_scan(F); } } SEAM(11);
    if (IN(12)) { REFRESH(); for (int rep_ = 0; rep_ < (DUP(12) ? 2 : 1); ++rep_) { if (rep_) xcd_barrier(bar);
        pg8::Gemm g{(const bf16*)(ws + WS_ACAT), (const bf16*)(ws + WS_BTCAT), 512, 512, 512}; pg8::RetOOrder S{F.G, F.vcu};
        pg8::EpiRetO E{(bf16*)(ws + WS_ORET), (bf16*)(ws + WS_SG), (LAS float*)(F.lds + LX_SSQ)};
        pg8::gemm_phase<pg8::EpiRetO, pg8::RetOOrder, true, false>(F.lds + RING_OFF, g, S, E, nullptr);
    }
    } if (IN(12) && IN(14)) xcd_barrier(bar);
    if (IN(14)) { REFRESH(); for (int rep_ = (DUP(14) ? 0 : 1); rep_ < 2; ++rep_) { if (rep_ && DUP(14)) xcd_barrier(bar);
        pg8::Gemm g{(const bf16*)(ws + WS_SG), (const bf16*)(ws + WS_WROUTT), 2048, 2048, 2048}; pg8::StaticOrder S; S.init(TOK, 1024, F.G, bx, 2048, 2048);
        pg8::EpiRes E{xres, rep_ ? xres : (float*)(ws + WS_ACAT)};
        pg8::gemm_phase<pg8::EpiRes, pg8::StaticOrder, true, false>(F.lds + RING_OFF, g, S, E, nullptr);
    }
    } SEAM(14);
    if (IN(15)) { REFRESH(); p_router<1>(F, args, xres); __syncthreads(); p_conv_moe1(F, args); if (DUP(15)) { xcd_barrier(bar); p_router<1>(F, args, xres, 3); __syncthreads(); p_conv_moe1(F, args); } } SEAM(15);
    if (IN(16)) { REFRESH(); p_moe1<1>(F); } SEAM(16);
    if (IN(17)) { REFRESH(); p_moe2<1>(F); } SEAM(17);
    if (IN(18)) { REFRESH(); if (DUP(18)) { p_combine<true>(F, xres, args.in[4], (float*)(ws + WS_KI)); xcd_barrier(bar); } p_combine<true>(F, xres, args.in[4]); }
#undef IN
#undef SEAM
}

extern "C" void kernel_launch(void* const* d_in, const int* in_sizes, int n_in, void* d_out, int out_size, void* d_ws, size_t ws_size, hipStream_t stream) {
    static int grid = 0;
    if (grid == 0) {
        if (n_in != 18 || in_sizes[0] != TOK * DM || out_size != TOK * DM || ws_size < WS_END) { fprintf(stderr, "kernel_launch: unexpected shapes / workspace (n_in %d, in0 %d, out %d, ws %zu < %zu); nothing launched\n", n_in, n_in > 0 ? in_sizes[0] : -1, out_size, ws_size, (size_t)WS_END); grid = -1; return; }
        int dev = 0, cus = 0, per_cu = 0;
        if (hipGetDevice(&dev) != hipSuccess || hipDeviceGetAttribute(&cus, hipDeviceAttributeMultiprocessorCount, dev) != hipSuccess) { grid = -1; return; }
        if (hipFuncSetAttribute((const void*)hybrid_fwd, hipFuncAttributeMaxDynamicSharedMemorySize, LDS_BYTES) != hipSuccess) { fprintf(stderr, "kernel_launch: hipFuncSetAttribute failed\n"); grid = -1; return; }
        if (hipOccupancyMaxActiveBlocksPerMultiprocessor(&per_cu, (const void*)hybrid_fwd, NWAVES * 64, LDS_BYTES) != hipSuccess || per_cu < 1) { fprintf(stderr, "kernel_launch: occupancy query says %d\n", per_cu); }
        (void)hipGetLastError();
        grid = cus > 256 ? 256 : cus;
    }
    if (grid < 0) return;
    if (hipMemsetAsync((char*)d_ws + WS_CTL, 0, CTL_ZERO_BYTES, stream) != hipSuccess) return;
    Args a{};
    for (int i = 0; i < 18; ++i) a.in[i] = (const float*)d_in[i];
    a.out = (float*)d_out; a.ws = (unsigned char*)d_ws; a.pad = 0;
#if MK_PER_PHASE
    for (int p = 0; p < N_PHASES; ++p) { a.ph_lo = p; a.ph_hi = p + 1; a.li = p; hipLaunchKernelGGL(hybrid_fwd, dim3(grid), dim3(NWAVES * 64), LDS_BYTES, stream, a); }
#else
    a.ph_lo = 0; a.ph_hi = N_PHASES; a.li = 0;
    hipLaunchKernelGGL(hybrid_fwd, dim3(grid), dim3(NWAVES * 64), LDS_BYTES, stream, a);
#endif
}
```

```cpp
#include <hip/hip_runtime.h>
#include <hip/hip_bf16.h>
#include <cstdio>
#include <cstdint>

#define LAS __attribute__((address_space(3)))
#define GAS __attribute__((address_space(1)))

namespace pg8 {
typedef unsigned short bf16_t;
typedef short bf16x8 __attribute__((ext_vector_type(8)));
typedef float f32x4 __attribute__((ext_vector_type(4)));
typedef float f32x2 __attribute__((ext_vector_type(2)));
typedef unsigned u32x4 __attribute__((ext_vector_type(4)));
typedef unsigned u32x2 __attribute__((ext_vector_type(2)));
constexpr int BM = 256, BK = 64, HALF = 128, HTB = HALF * BK * 2, STAGE_BYTES = 8 * HTB, NXCD = 8, WGM = 8;

__host__ __device__ __forceinline__ int lds_byte(int r, int c) { const int st = (r >> 4) * 2 + (c >> 5), rr = r & 15, cc = c & 31, ob = rr * 64 + cc * 2; return st * 1024 + (ob ^ (((ob >> 9) & 1) << 5)); }
__host__ __device__ __forceinline__ void stage_rc(int b, int& R, int& C) { const int st = b / 1024, sb = b % 1024, swz = sb ^ (((sb >> 9) & 1) << 5); R = (st >> 1) * 16 + swz / 64; C = (st & 1) * 32 + (swz % 64) / 2; }
__host__ __device__ __forceinline__ int perm32(int rho) { const int n = rho >> 4, i = rho & 15; return 8 * (i >> 2) + 4 * n + (i & 3); }

struct Unit { int pm, pn, aux; long aoff, boff; };
struct Gemm { const bf16_t* A; const bf16_t* Bt; int lda, ldb, K; };

struct StaticOrder {
    int nM, nN, nwg, G, c, lda, ldb;
    __device__ void init(int M, int N, int G_, int c_, int lda_, int ldb_) { nM = M / BM; nN = N / BM; nwg = nM * nN; G = G_; c = c_; lda = lda_; ldb = ldb_; }
    __device__ bool next(int i, Unit& u) const {
        const long L = (long)i * G + c; if (L >= nwg) return false;
        int wgid = (int)L; { const int q = nwg / NXCD, r = nwg % NXCD, xcd = wgid % NXCD, off = wgid / NXCD; wgid = (xcd < r ? xcd * (q + 1) : r * (q + 1) + (xcd - r) * q) + off; }
        const int nig = WGM * nN, gid = wgid / nig, fm = gid * WGM, gsz = (nM - fm) < WGM ? (nM - fm) : WGM;
        u.pm = fm + ((wgid % nig) % gsz); u.pn = (wgid % nig) / gsz; u.aux = 0;
        u.aoff = (long)u.pm * BM * lda; u.boff = (long)u.pn * BM * ldb; return true;
    }
};

__device__ __forceinline__ unsigned cvt_pk_bf16(float lo, float hi) { unsigned r; asm volatile("v_cvt_pk_bf16_f32 %0, %1, %2" : "=v"(r) : "v"(lo), "v"(hi)); return r; }
__device__ __forceinline__ u32x4 pack8(const f32x4 v0, const f32x4 v1) { u32x4 w; w.x = cvt_pk_bf16(v0[0], v0[1]); w.y = cvt_pk_bf16(v0[2], v0[3]); w.z = cvt_pk_bf16(v1[0], v1[1]); w.w = cvt_pk_bf16(v1[2], v1[3]); return w; }

typedef int v4i_t __attribute__((ext_vector_type(4)));
typedef int v8i_t __attribute__((ext_vector_type(8)));
__device__ __forceinline__ v8i_t cat8(const bf16x8 a, const bf16x8 b) { const v4i_t x = __builtin_bit_cast(v4i_t, a), y = __builtin_bit_cast(v4i_t, b); return __builtin_shufflevector(x, y, 0, 1, 2, 3, 4, 5, 6, 7); }
template <class Epi, class Sched, bool ALIGN_EPI, bool GATHER, bool FP8 = false>
__device__ __forceinline__ void gemm_phase(LAS unsigned char* lds, const Gemm g, const Sched& S, const Epi& E, const LAS int* rowtab) {
    int tid_ = threadIdx.x; asm volatile("" : "+v"(tid_));
    const int tid = tid_, wid = __builtin_amdgcn_readfirstlane(tid >> 6), lane = tid & 63, wr = wid >> 2, wc = wid & 3, fr = lane & 15, fq = lane >> 4;
    const int K = g.K, nt = K / BK;
    int sR[2], sC[2]; unsigned voffB[2];
#pragma unroll
    for (int i = 0; i < 2; ++i) { int R, C; stage_rc(tid * 16 + i * 8192, R, C); sR[i] = R; sC[i] = C; const int Rb = Epi::PERM ? ((R & ~31) + perm32(R & 31)) : R; voffB[i] = (unsigned)(Rb * g.ldb + C) * 2u; }
    unsigned avo[2][2], navo[2][2];
#define PG8_SETOFF(o, ui_) do { _Pragma("unroll") for (int h_ = 0; h_ < 2; ++h_) _Pragma("unroll") for (int i_ = 0; i_ < 2; ++i_) { const int row_ = h_ * HALF + sR[i_]; \
        const int grow_ = GATHER ? rowtab[(ui_) * BM + row_] : row_; o[h_][i_] = (unsigned)(grow_ * g.lda + sC[i_]) * 2u; } } while (0)
    const size_t kstep = (size_t)(BK * 2);
    const size_t hstepB = (size_t)HALF * g.ldb * 2;
    const unsigned ldsw = (unsigned)wid * 1024u;
    const int aoff = lds_byte(wr * 64 + fr, fq * 8), boff = lds_byte(wc * 32 + fr, fq * 8);
#define PG8_SA(b, h) (((b) * 2 + (h)) * HTB)
#define PG8_SB(b, h) ((4 + (b) * 2 + (h)) * HTB)
#define PG8_STAGE(bufoff, gbase, voff) do { _Pragma("unroll") for (int _i = 0; _i < 2; ++_i) \
        __builtin_amdgcn_global_load_lds((const unsigned*)((const char*)(gbase) + (voff)[_i]), (LAS unsigned*)(lds + (bufoff) + ldsw + _i * 8192), 16, 0, 0); } while (0)
#define PG8_LD8(dst8, addr_) do { const v4i_t lo_ = *(const LAS v4i_t*)(addr_), hi_ = *(const LAS v4i_t*)((addr_) + 1024); dst8 = __builtin_shufflevector(lo_, hi_, 0, 1, 2, 3, 4, 5, 6, 7); } while (0)
#define PG8_LDA(dst, b, h) do { _Pragma("unroll") for (int m = 0; m < 4; ++m) { if constexpr (FP8) { PG8_LD8(dst##8[m], lds + PG8_SA(b, h) + aoff + m * 2048); } else { _Pragma("unroll") for (int k = 0; k < 2; ++k) dst[m][k] = *(const LAS bf16x8*)(lds + PG8_SA(b, h) + aoff + m * 2048 + k * 1024); } } } while (0)
#define PG8_LDB(dst, b, h) do { _Pragma("unroll") for (int n = 0; n < 2; ++n) { if constexpr (FP8) { PG8_LD8(dst##8[n], lds + PG8_SB(b, h) + boff + n * 2048); } else { _Pragma("unroll") for (int k = 0; k < 2; ++k) dst[n][k] = *(const LAS bf16x8*)(lds + PG8_SB(b, h) + boff + n * 2048 + k * 1024); } } } while (0)
#define PG8_MMA(ai, bj, At, Bt) do { __builtin_amdgcn_s_setprio(1); _Pragma("unroll") for (int m = 0; m < 4; ++m) _Pragma("unroll") for (int n = 0; n < 2; ++n) { \
        if constexpr (FP8) asm volatile("v_mfma_scale_f32_16x16x128_f8f6f4 %0, %1, %2, %0, %3, %3 op_sel_hi:[0,0,0]" : "+v"(acc[ai][bj][m][n]) : "v"(Bt##8[n]), "v"(At##8[m]), "v"(sc1)); \
        else { _Pragma("unroll") for (int k = 0; k < 2; ++k) acc[ai][bj][m][n] = __builtin_amdgcn_mfma_f32_16x16x32_bf16(Bt[n][k], At[m][k], acc[ai][bj][m][n], 0, 0, 0); } } \
        __builtin_amdgcn_s_setprio(0); } while (0)
#define PG8_WAIT_V(n) asm volatile("s_waitcnt vmcnt(" #n ")" ::: "memory")
#define PG8_WAIT_L(n) asm volatile("s_waitcnt lgkmcnt(" #n ")" ::: "memory")
#define PG8_BAR __builtin_amdgcn_s_barrier()
#define PG8_SCHED __builtin_amdgcn_sched_barrier(0)
    unsigned sc1 = 0; if constexpr (FP8) asm volatile("v_mov_b32 %0, 0x7f7f7f7f\n\ts_nop 4" : "=v"(sc1));
    Unit cur, nxt; int ui = 0;
    if (!S.next(0, cur)) return;
    f32x4 acc[2][2][4][2];
#pragma unroll
    for (int a = 0; a < 2; ++a)
#pragma unroll
        for (int b = 0; b < 2; ++b)
#pragma unroll
            for (int m = 0; m < 4; ++m)
#pragma unroll
                for (int n = 0; n < 2; ++n) acc[a][b][m][n] = (f32x4){0.f, 0.f, 0.f, 0.f};
    bf16x8 At[4][2], B0[2][2], B1[2][2]; v8i_t At8[4], B08[2], B18[2];
    const char* cA = (const char*)g.A + cur.aoff * 2; const char* cB = (const char*)g.Bt + cur.boff * 2;
    PG8_SETOFF(avo, 0);
    PG8_STAGE(PG8_SB(0, 0), cB, voffB); PG8_STAGE(PG8_SB(0, 1), cB + hstepB, voffB); PG8_STAGE(PG8_SA(0, 0), cA, avo[0]); PG8_STAGE(PG8_SA(0, 1), cA, avo[1]);
    if (wr == 1) PG8_BAR;
    PG8_WAIT_V(2); PG8_BAR;
    PG8_STAGE(PG8_SB(1, 0), cB + kstep, voffB); PG8_STAGE(PG8_SA(1, 0), cA + kstep, avo[0]); PG8_STAGE(PG8_SB(1, 1), cB + hstepB + kstep, voffB);
    PG8_WAIT_V(6); PG8_BAR;
    for (;;) {
        const bool has_next = S.next(ui + 1, nxt);
        const char* nA = has_next ? (const char*)g.A + nxt.aoff * 2 : cA; const char* nB = has_next ? (const char*)g.Bt + nxt.boff * 2 : cB;
        if (GATHER && has_next) { PG8_SETOFF(navo, ui + 1); }
        else {
#pragma unroll
            for (int h_ = 0; h_ < 2; ++h_)
#pragma unroll
                for (int i_ = 0; i_ < 2; ++i_) navo[h_][i_] = avo[h_][i_]; }
#pragma nounroll
        for (int t = 0; t < nt; t += 2) {
            const bool last = (t == nt - 2);
            const char* a1 = cA + (size_t)(t + 1) * kstep;
            const char* a2 = last ? nA : cA + (size_t)(t + 2) * kstep; const char* b2 = last ? nB : cB + (size_t)(t + 2) * kstep;
            const char* a3 = a2 + kstep; const char* b3 = b2 + kstep;
            unsigned o2[2][2];
#pragma unroll
            for (int h_ = 0; h_ < 2; ++h_)
#pragma unroll
                for (int i_ = 0; i_ < 2; ++i_) o2[h_][i_] = (GATHER && last) ? navo[h_][i_] : avo[h_][i_];
            PG8_LDB(B0, 0, 0); PG8_LDB(B1, 0, 1); PG8_SCHED; PG8_LDA(At, 0, 0); PG8_STAGE(PG8_SA(1, 1), a1, avo[1]);
            PG8_WAIT_V(8); PG8_WAIT_L(0); PG8_BAR; PG8_MMA(0, 0, At, B0); PG8_MMA(0, 1, At, B1); PG8_BAR; PG8_SCHED;
            PG8_LDA(At, 0, 1); PG8_STAGE(PG8_SB(0, 0), b2, voffB); PG8_STAGE(PG8_SB(0, 1), b2 + hstepB, voffB); PG8_STAGE(PG8_SA(0, 0), a2, o2[0]);
            PG8_WAIT_V(8); PG8_WAIT_L(0); PG8_BAR; PG8_MMA(1, 0, At, B0); PG8_MMA(1, 1, At, B1); PG8_BAR; PG8_SCHED;
            PG8_LDB(B0, 1, 0); PG8_LDB(B1, 1, 1); PG8_SCHED; PG8_LDA(At, 1, 0); PG8_STAGE(PG8_SA(0, 1), a2, o2[1]);
            PG8_WAIT_V(8); PG8_WAIT_L(0); PG8_BAR; PG8_MMA(0, 0, At, B0); PG8_MMA(0, 1, At, B1); PG8_BAR; PG8_SCHED;
            PG8_LDA(At, 1, 1); PG8_STAGE(PG8_SB(1, 0), b3, voffB); PG8_STAGE(PG8_SB(1, 1), b3 + hstepB, voffB); PG8_STAGE(PG8_SA(1, 0), a3, o2[0]);
            PG8_WAIT_V(8); PG8_WAIT_L(0); PG8_BAR; PG8_MMA(1, 0, At, B0); PG8_MMA(1, 1, At, B1); PG8_BAR; PG8_SCHED;
        }
        if constexpr (ALIGN_EPI) { if (wr == 0) PG8_BAR; }
        if constexpr (FP8) asm volatile("s_nop 15\n\ts_nop 3" ::: "memory");
        { int efr = fr, efq = fq; asm volatile("" : "+v"(efr), "+v"(efq)); E(acc, cur, wr, wc, efr, efq); }
        if (!has_next) break;
#pragma unroll
        for (int a = 0; a < 2; ++a)
#pragma unroll
            for (int b = 0; b < 2; ++b)
#pragma unroll
                for (int m = 0; m < 4; ++m)
#pragma unroll
                    for (int n = 0; n < 2; ++n) acc[a][b][m][n] = (f32x4){0.f, 0.f, 0.f, 0.f};
        cur = nxt; cA = nA; cB = nB; ++ui;
#pragma unroll
        for (int h_ = 0; h_ < 2; ++h_)
#pragma unroll
            for (int i_ = 0; i_ < 2; ++i_) avo[h_][i_] = navo[h_][i_];
        if constexpr (ALIGN_EPI) { if (wr == 1) PG8_BAR; }
    }
    PG8_WAIT_V(0);
    if constexpr (!ALIGN_EPI) { if (wr == 0) PG8_BAR; }
    PG8_BAR;
#undef PG8_SETOFF
#undef PG8_SA
#undef PG8_SB
#undef PG8_STAGE
#undef PG8_LDA
#undef PG8_LDB
#undef PG8_MMA
#undef PG8_WAIT_V
#undef PG8_WAIT_L
#undef PG8_BAR
#undef PG8_SCHED
}
}
constexpr int NB = 8, SEQ = 2048, DM = 1024, TOK = NB * SEQ;
constexpr int AH = 8;
constexpr int RH = 4, RDK = 256, RDV = 512, RC = 256, RNC = SEQ / RC;
constexpr int NEXP = 32, EFF = 512, NPAIR = 2 * TOK, LISTCAP = TOK;
constexpr int MAXRT = NPAIR / 256 + NEXP;
constexpr float RMS_EPS = 1e-6f, SUBLN_EPS = 1e-5f, LOG2E = 1.4426950408889634f;
#ifndef QKV_FP8
#define QKV_FP8 0
#endif
#ifndef RIN_FP8
#define RIN_FP8 1
#endif
constexpr float WIN_SCALE = 64.f, IN_DESCALE = 1.0f / (16.f * 64.f);
constexpr float H8_SCALE = 16.f, W1_SCALE = 64.f, ACT_SCALE = 8.f, W2_SCALE = 32.f;
constexpr float ATT_C2 = 0.125f * LOG2E;

constexpr size_t MiB = 1u << 20;
constexpr size_t WS_CTL = 0, CTL_ZERO_BYTES = 1 * MiB;
constexpr size_t WS_LIST = 1 * MiB;
constexpr size_t WS_PAIRW = 3 * MiB;
constexpr size_t WS_WRF = 3 * MiB + 512 * 1024;
constexpr size_t WS_SINCOS = 4 * MiB;
constexpr size_t WS_SINCOST = 6 * MiB;
constexpr size_t WS_WINT0 = 8 * MiB;
constexpr size_t WS_WOUTT0 = 14 * MiB;
constexpr size_t WS_WRINA = 16 * MiB;
constexpr size_t WS_WRINB = 24 * MiB;
constexpr size_t WS_WROUTT = 30 * MiB;
constexpr size_t WS_W1CAT = 34 * MiB;
constexpr size_t WS_W2T = 98 * MiB;
constexpr size_t WS_DS = 34 * MiB;
constexpr size_t WS_ORET = 34 * MiB;
constexpr size_t WS_HB = 130 * MiB;
constexpr size_t WS_ACTBASE = 162 * MiB;
constexpr size_t WS_QKV0 = WS_ACTBASE;
constexpr size_t WS_OP = WS_ACTBASE + 96 * MiB;
constexpr size_t WS_AO = WS_ACTBASE + 160 * MiB;
constexpr size_t WS_MACT = WS_ACTBASE;
constexpr size_t WS_Y = WS_ACTBASE + 40 * MiB;
constexpr size_t WS_ACAT = WS_ACTBASE;
constexpr size_t WS_BTCAT = WS_ACTBASE + 64 * MiB;
constexpr size_t WS_KI = WS_ACTBASE + 192 * MiB;
constexpr size_t WS_KIT = WS_ACTBASE + 224 * MiB;
constexpr size_t WS_SG = WS_ACTBASE + 256 * MiB;
constexpr size_t WS_END = WS_ACTBASE + 320 * MiB;
constexpr int CW_TMO = 0, CW_BAR = 4096, CW_CNT = 16384;

constexpr int RING_OFF = 0, RING_BYTES = 131072;
constexpr int LX_OFF = RING_BYTES;
constexpr int LX_MISC = LX_OFF + 320;
constexpr int LX_ROWTAB = LX_OFF + 1024;
constexpr int LX_TSTART = LX_OFF + 5120;
constexpr int LX_TEXP = LX_OFF + 5376;
constexpr int LX_LUT = LX_OFF + 10240;
constexpr int LX_CNT = LX_OFF + 7168;
constexpr int LX_SSQ = LX_OFF + 8192;
constexpr int LDS_BYTES = 147456;

namespace pg8 {
struct EpiQKV {
    static constexpr bool PERM = true;
    bf16_t* O; float qscale;
    __device__ __forceinline__ void operator()(const f32x4 (&acc)[2][2][4][2], const Unit& u, int wr, int wc, int fr, int fq) const {
        const int row0 = u.pm * BM + wr * 64 + fr, col0 = u.pn * BM + wc * 32 + 8 * fq; const float sc = ((u.pn < 4) ? qscale : 1.f) * (QKV_FP8 ? IN_DESCALE : 1.f);
#pragma unroll
        for (int ai = 0; ai < 2; ++ai)
#pragma unroll
            for (int m = 0; m < 4; ++m) { bf16_t* rowp = O + (size_t)(row0 + ai * HALF + m * 16) * 3072 + col0;
#pragma unroll
                for (int bj = 0; bj < 2; ++bj) *(u32x4*)(rowp + bj * HALF) = pack8(acc[ai][bj][m][0] * sc, acc[ai][bj][m][1] * sc); }
    }
};
struct EpiRes {
    static constexpr bool PERM = false;
    const float* res; float* out;
    __device__ __forceinline__ void operator()(const f32x4 (&acc)[2][2][4][2], const Unit& u, int wr, int wc, int fr, int fq) const {
        const int row0 = u.pm * BM + wr * 64 + fr, col0 = u.pn * BM + wc * 32 + 4 * fq;
#pragma unroll
        for (int ai = 0; ai < 2; ++ai)
#pragma unroll
            for (int m = 0; m < 4; ++m) { const size_t off = (size_t)(row0 + ai * HALF + m * 16) * 1024 + col0;
#pragma unroll
                for (int bj = 0; bj < 2; ++bj)
#pragma unroll
                    for (int n = 0; n < 2; ++n) { const f32x4 r = *(const f32x4*)(res + off + bj * HALF + n * 16); *(f32x4*)(out + off + bj * HALF + n * 16) = r + acc[ai][bj][m][n]; }
                asm volatile("" ::: "memory"); }
    }
};
__device__ __forceinline__ float silu_f(float x) { return x * __builtin_amdgcn_rcpf(1.0f + __builtin_amdgcn_exp2f(-x * LOG2E)); }
__device__ __forceinline__ unsigned pk4_fp8(float a, float b, float c, float d) { int w = 0; w = __builtin_amdgcn_cvt_pk_fp8_f32(a, b, w, false); w = __builtin_amdgcn_cvt_pk_fp8_f32(c, d, w, true); return (unsigned)w; }
struct EpiMoe1 {
    static constexpr bool PERM = true;
    unsigned char* ACT;
    __device__ __forceinline__ void operator()(const f32x4 (&acc)[2][2][4][2], const Unit& u, int wr, int wc, int fr, int fq) const {
        const int row0 = u.pm * BM + wr * 64 + fr, col0 = (u.pn & 3) * 128 + wc * 32 + 8 * fq; constexpr float si = 1.0f / (H8_SCALE * W1_SCALE);
#pragma unroll
        for (int ai = 0; ai < 2; ++ai)
#pragma unroll
            for (int m = 0; m < 4; ++m) { f32x4 a0, a1;
#pragma unroll
                for (int j = 0; j < 4; ++j) { a0[j] = silu_f(acc[ai][0][m][0][j] * si) * acc[ai][1][m][0][j] * (si * ACT_SCALE); a1[j] = silu_f(acc[ai][0][m][1][j] * si) * acc[ai][1][m][1][j] * (si * ACT_SCALE); }
                u32x2 w; w.x = pk4_fp8(a0[0], a0[1], a0[2], a0[3]); w.y = pk4_fp8(a1[0], a1[1], a1[2], a1[3]);
                *(u32x2*)(ACT + (size_t)(row0 + ai * HALF + m * 16) * 512 + col0) = w; }
    }
};
struct EpiMoe2 {
    static constexpr bool PERM = true;
    bf16_t* Y; const int* list; const float* pairw; const LAS int* lcnt;
    __device__ __forceinline__ void operator()(const f32x4 (&acc)[2][2][4][2], const Unit& u, int wr, int wc, int fr, int fq) const {
        const int e = u.pn >> 2, col0 = (u.pn & 3) * BM + wc * 32 + 8 * fq, pos0 = u.aux * BM + wr * 64 + fr, cn = lcnt[e];
#pragma unroll
        for (int ai = 0; ai < 2; ++ai)
#pragma unroll
            for (int m = 0; m < 4; ++m) { const int pos = pos0 + ai * HALF + m * 16;
                if (pos < cn) { const int pair = list[e * LISTCAP + pos]; const float w = pairw[pair] * (1.0f / (ACT_SCALE * W2_SCALE)); bf16_t* rowp = Y + (size_t)pair * 1024 + col0;
#pragma unroll
                    for (int bj = 0; bj < 2; ++bj) *(u32x4*)(rowp + bj * HALF) = pack8(acc[ai][bj][m][0] * w, acc[ai][bj][m][1] * w); } }
    }
};
__device__ __forceinline__ float log2_gamma(int h) { return __builtin_log2f(1.0f - __builtin_amdgcn_exp2f(-5.0f - (float)h)); }
struct EpiRetA {
    static constexpr bool PERM = true;
    bf16_t* ACAT; bf16_t* KI; bf16_t* SG; const float* sincos;
    __device__ __forceinline__ void operator()(const f32x4 (&acc)[2][2][4][2], const Unit& u, int wr, int wc, int fr, int fq) const {
        const int r0 = wr * 64 + fr, c0 = wc * 32 + 8 * fq;
        if (u.pn >= 8) {
#pragma unroll
            for (int ai = 0; ai < 2; ++ai)
#pragma unroll
                for (int m = 0; m < 4; ++m) { bf16_t* rowp = SG + (size_t)(u.pm * BM + r0 + ai * HALF + m * 16) * 2048 + (u.pn - 8) * BM + c0;
#pragma unroll
                    for (int bj = 0; bj < 2; ++bj) { f32x4 a0, a1;
#pragma unroll
                        for (int j = 0; j < 4; ++j) { a0[j] = silu_f(acc[ai][bj][m][0][j] * IN_DESCALE); a1[j] = silu_f(acc[ai][bj][m][1][j] * IN_DESCALE); }
                        *(u32x4*)(rowp + bj * HALF) = pack8(a0, a1); } }
            return;
        }
        const bool isq = u.pn < 4; const int h = u.pn & 3; const float l2g = log2_gamma(h);
        const int b = u.pm >> 3, n = u.pm & 7;
#pragma unroll
        for (int ai = 0; ai < 2; ++ai)
#pragma unroll
            for (int m = 0; m < 4; ++m) { const int r = r0 + ai * HALF + m * 16, pos = n * RC + r;
                const float fac = IN_DESCALE * (isq ? __builtin_amdgcn_exp2f((float)(r + 1) * l2g) : 0.0625f * __builtin_amdgcn_exp2f(-(float)(r + 1) * l2g));
                bf16_t* rowp = isq ? ACAT + ((size_t)((b * RH + h) * RNC + n) * RC + r) * 512 + 256 + c0 : KI + (size_t)(u.pm * BM + r) * 1024 + h * RDK + c0;
#pragma unroll
                for (int bj = 0; bj < 2; ++bj) { const f32x4* cs = (const f32x4*)(sincos + ((size_t)pos * 128 + (bj * HALF + c0) / 2) * 2);
                    const f32x4 t0 = cs[0], t1 = cs[1]; const f32x4 x0 = acc[ai][bj][m][0], x1 = acc[ai][bj][m][1]; f32x4 y0, y1;
                    y0[0] = (x0[0] * t0[0] - x0[1] * t0[1]) * fac; y0[1] = (x0[1] * t0[0] + x0[0] * t0[1]) * fac; y0[2] = (x0[2] * t0[2] - x0[3] * t0[3]) * fac; y0[3] = (x0[3] * t0[2] + x0[2] * t0[3]) * fac;
                    y1[0] = (x1[0] * t1[0] - x1[1] * t1[1]) * fac; y1[1] = (x1[1] * t1[0] + x1[0] * t1[1]) * fac; y1[2] = (x1[2] * t1[2] - x1[3] * t1[3]) * fac; y1[3] = (x1[3] * t1[2] + x1[2] * t1[3]) * fac;
                    *(u32x4*)(rowp + bj * HALF) = pack8(y0, y1); } }
    }
};
struct EpiRetB {
    static constexpr bool PERM = true;
    bf16_t* KIT; bf16_t* BTCAT; const float* sincosT;
    __device__ __forceinline__ void operator()(const f32x4 (&acc)[2][2][4][2], const Unit& u, int wr, int wc, int fr, int fq) const {
        const int r0 = wr * 64 + fr, c0 = wc * 32 + 8 * fq; const int b = u.pn >> 3, n = u.pn & 7;
        if (u.pm >= 4) { const int h = (u.pm - 4) >> 1, dv0 = ((u.pm - 4) & 1) * BM;
#pragma unroll
            for (int ai = 0; ai < 2; ++ai)
#pragma unroll
                for (int m = 0; m < 4; ++m) { bf16_t* rowp = BTCAT + ((size_t)((b * RH + h) * RNC + n) * RDV + dv0 + r0 + ai * HALF + m * 16) * 512 + c0;
#pragma unroll
                    for (int bj = 0; bj < 2; ++bj) *(u32x4*)(rowp + bj * HALF) = pack8(acc[ai][bj][m][0] * IN_DESCALE, acc[ai][bj][m][1] * IN_DESCALE); }
            return;
        }
        const int h = u.pm; const float l2g = log2_gamma(h);
        float fc[2][8];
#pragma unroll
        for (int bj = 0; bj < 2; ++bj)
#pragma unroll
            for (int j = 0; j < 8; ++j) fc[bj][j] = (0.0625f * IN_DESCALE) * __builtin_amdgcn_exp2f(-(float)(bj * HALF + c0 + j + 1) * l2g);
        const bool odd = (fr & 1) != 0;
#pragma unroll
        for (int ai = 0; ai < 2; ++ai)
#pragma unroll
            for (int m = 0; m < 4; ++m) { const int r = r0 + ai * HALF + m * 16;
                bf16_t* rowp = KIT + ((size_t)((b * RH + h) * RDK + r)) * SEQ + n * RC + c0;
#pragma unroll
                for (int bj = 0; bj < 2; ++bj) { const f32x4* cs = (const f32x4*)(sincosT + ((size_t)(r >> 1) * SEQ + n * RC + bj * HALF + c0) * 2);
                    f32x4 y[2];
#pragma unroll
                    for (int nn = 0; nn < 2; ++nn) { const f32x4 ta = cs[nn * 2], tb = cs[nn * 2 + 1]; const f32x4 x = acc[ai][bj][m][nn]; f32x4 xp;
#pragma unroll
                        for (int j = 0; j < 4; ++j) xp[j] = __shfl_xor(x[j], 1);
                        const float cc[4] = {ta[0], ta[2], tb[0], tb[2]}, ss[4] = {ta[1], ta[3], tb[1], tb[3]};
#pragma unroll
                        for (int j = 0; j < 4; ++j) y[nn][j] = (x[j] * cc[j] + (odd ? xp[j] : -xp[j]) * ss[j]) * fc[bj][nn * 4 + j]; }
                    *(u32x4*)(rowp + bj * HALF) = pack8(y[0], y[1]); } }
    }
};
struct EpiScores {
    static constexpr bool PERM = true;
    bf16_t* ACAT;
    __device__ __forceinline__ void operator()(const f32x4 (&acc)[2][2][4][2], const Unit& u, int wr, int wc, int fr, int fq) const {
        const int r0 = wr * 64 + fr, c0 = wc * 32 + 8 * fq;
#pragma unroll
        for (int ai = 0; ai < 2; ++ai)
#pragma unroll
            for (int m = 0; m < 4; ++m) { const int r = r0 + ai * HALF + m * 16; bf16_t* rowp = ACAT + ((size_t)u.pm * RC + r) * 512 + c0;
#pragma unroll
                for (int bj = 0; bj < 2; ++bj) { f32x4 y0 = acc[ai][bj][m][0], y1 = acc[ai][bj][m][1]; const int cb = bj * HALF + c0;
#pragma unroll
                    for (int j = 0; j < 4; ++j) { if (cb + j > r) y0[j] = 0.f; if (cb + 4 + j > r) y1[j] = 0.f; }
                    *(u32x4*)(rowp + bj * HALF) = pack8(y0, y1); } }
    }
};
struct EpiDS {
    static constexpr bool PERM = true;
    bf16_t* DS;
    __device__ __forceinline__ void operator()(const f32x4 (&acc)[2][2][4][2], const Unit& u, int wr, int wc, int fr, int fq) const {
        const int r0 = wr * 64 + fr, c0 = wc * 32 + 8 * fq;
#pragma unroll
        for (int ai = 0; ai < 2; ++ai)
#pragma unroll
            for (int m = 0; m < 4; ++m) { bf16_t* rowp = DS + ((size_t)u.pm * RDV + u.pn * BM + r0 + ai * HALF + m * 16) * RDK + c0;
#pragma unroll
                for (int bj = 0; bj < 2; ++bj) *(u32x4*)(rowp + bj * HALF) = pack8(acc[ai][bj][m][0], acc[ai][bj][m][1]); }
    }
};
struct EpiRetO {
    static constexpr bool PERM = true;
    bf16_t* ORET; bf16_t* SG; LAS float* ssq;
    __device__ __forceinline__ void operator()(const f32x4 (&acc)[2][2][4][2], const Unit& u, int wr, int wc, int fr, int fq) const {
        const int r0 = wr * 64 + fr, c0 = wc * 32 + 8 * fq; const int n = u.pm & 7, h = (u.pm >> 3) & 3, b = u.pm >> 5;
        LAS float* sq = ssq + (u.aux & 1) * 256;
        if (u.pn == 0) { const int t_ = threadIdx.x; if (t_ < 256) ssq[((u.aux & 1) ^ 1) * 256 + t_] = 0.f; }
#pragma unroll
        for (int ai = 0; ai < 2; ++ai)
#pragma unroll
            for (int m = 0; m < 4; ++m) { float s = 0.f;
#pragma unroll
                for (int bj = 0; bj < 2; ++bj)
#pragma unroll
                    for (int nn = 0; nn < 2; ++nn) { const f32x4 x = acc[ai][bj][m][nn]; s += (x[0] * x[0] + x[1] * x[1]) + (x[2] * x[2] + x[3] * x[3]); }
                s += __shfl_xor(s, 16); s += __shfl_xor(s, 32);
                if (fq == 0) (void)__hip_atomic_fetch_add(sq + r0 + ai * HALF + m * 16, s, __ATOMIC_RELAXED, __HIP_MEMORY_SCOPE_WORKGROUP); }
        const size_t rowbase = (size_t)(b * SEQ + n * RC) * 2048 + h * RDV;
        if (u.pn == 0) {
#pragma unroll
            for (int ai = 0; ai < 2; ++ai)
#pragma unroll
                for (int m = 0; m < 4; ++m) { bf16_t* rowp = ORET + rowbase + (size_t)(r0 + ai * HALF + m * 16) * 2048 + c0;
#pragma unroll
                    for (int bj = 0; bj < 2; ++bj) *(u32x4*)(rowp + bj * HALF) = pack8(acc[ai][bj][m][0], acc[ai][bj][m][1]); }
            return;
        }
        asm volatile("s_waitcnt lgkmcnt(0)" ::: "memory"); __builtin_amdgcn_s_barrier(); asm volatile("" ::: "memory");
#pragma unroll
        for (int ai = 0; ai < 2; ++ai)
#pragma unroll
            for (int m = 0; m < 4; ++m) { const int r = r0 + ai * HALF + m * 16; const float rstd = __builtin_amdgcn_rsqf(sq[r] * (1.0f / 512.0f) + RMS_EPS);
                const size_t ro = rowbase + (size_t)r * 2048 + c0;
#pragma unroll
                for (int bj = 0; bj < 2; ++bj) {
                    { bf16_t* gp = SG + ro + BM + bj * HALF; const u32x4 g = *(const u32x4*)gp; f32x4 y0 = acc[ai][bj][m][0] * rstd, y1 = acc[ai][bj][m][1] * rstd;
                      y0[0] *= __uint_as_float(g.x << 16); y0[1] *= __uint_as_float(g.x & 0xffff0000u); y0[2] *= __uint_as_float(g.y << 16); y0[3] *= __uint_as_float(g.y & 0xffff0000u);
                      y1[0] *= __uint_as_float(g.z << 16); y1[1] *= __uint_as_float(g.z & 0xffff0000u); y1[2] *= __uint_as_float(g.w << 16); y1[3] *= __uint_as_float(g.w & 0xffff0000u);
                      *(u32x4*)gp = pack8(y0, y1); }
                    { bf16_t* gp = SG + ro + bj * HALF; const u32x4 g = *(const u32x4*)gp; const u32x4 o = *(const u32x4*)(ORET + ro + bj * HALF); f32x4 y0, y1;
                      y0[0] = __uint_as_float(o.x << 16) * rstd * __uint_as_float(g.x << 16); y0[1] = __uint_as_float(o.x & 0xffff0000u) * rstd * __uint_as_float(g.x & 0xffff0000u);
                      y0[2] = __uint_as_float(o.y << 16) * rstd * __uint_as_float(g.y << 16); y0[3] = __uint_as_float(o.y & 0xffff0000u) * rstd * __uint_as_float(g.y & 0xffff0000u);
                      y1[0] = __uint_as_float(o.z << 16) * rstd * __uint_as_float(g.z << 16); y1[1] = __uint_as_float(o.z & 0xffff0000u) * rstd * __uint_as_float(g.z & 0xffff0000u);
                      y1[2] = __uint_as_float(o.w << 16) * rstd * __uint_as_float(g.w << 16); y1[3] = __uint_as_float(o.w & 0xffff0000u) * rstd * __uint_as_float(g.w & 0xffff0000u);
                      *(u32x4*)gp = pack8(y0, y1); } } }
    }
};
struct ScoresOrder {
    int G, c;
    __device__ bool next(int i, Unit& u) const { const int L = i * G + c; if (L >= NB * RH * RNC) return false; const int n = L & 7, h = (L >> 3) & 3, b = L >> 5;
        u.pm = L; u.pn = 0; u.aux = 0; u.aoff = (long)L * RC * 512 + 256; u.boff = (long)(b * SEQ + n * RC) * 1024 + h * RDK; return true; }
};
struct DsOrder {
    int G, c;
    __device__ bool next(int i, Unit& u) const { const int L = i * G + c; if (L >= NB * RH * 7 * 2) return false; const int dvt = L & 1, q = L >> 1, n = q % 7, bh = q / 7, p = bh * RNC + n;
        u.pm = p; u.pn = dvt; u.aux = 0; u.aoff = ((long)p * RDV + dvt * BM) * 512; u.boff = (long)bh * RDK * SEQ + n * RC; return true; }
};
struct RetOOrder {
    int G, c;
    __device__ bool next(int i, Unit& u) const { const int k = i >> 1, dvt = i & 1, p = k * G + c; if (p >= NB * RH * RNC) return false;
        u.pm = p; u.pn = dvt; u.aux = k; u.aoff = (long)p * RC * 512; u.boff = ((long)p * RDV + dvt * BM) * 512; return true; }
};
struct MoeOrder {
    int G, c, ldb; long a_tile; const LAS int* tstart; const LAS int* texp;
    __device__ bool next(int i, Unit& u) const { const int L = i * G + c; const int ntiles = tstart[33]; if (L >= ntiles * 4) return false; const int rt = L >> 2, pnl = L & 3, e = texp[rt];
        u.pm = rt; u.pn = e * 4 + pnl; u.aux = rt - tstart[e]; u.aoff = (long)rt * a_tile; u.boff = ((long)e * 1024 + pnl * BM) * ldb; return true; }
};
}
namespace attn_body {
using bf16=__hip_bfloat16;
using bf16x8=__attribute__((ext_vector_type(8)))short;
using s16x4=__attribute__((ext_vector_type(4)))short;
using f32x16=__attribute__((ext_vector_type(16)))float;
using u32x4=__attribute__((ext_vector_type(4)))unsigned;
constexpr int D=64,PQ=3072,PO=1024;
constexpr int NW=8,QBLK=32,QB=QBLK*NW,KVBLK=64,NQB=SEQ/QB;
__device__ __forceinline__ int crow(int r,int hi){return (r&3)+8*(r>>2)+4*hi;}
#define SBAR() __builtin_amdgcn_sched_barrier(0)
__device__ __forceinline__ void biasmask(f32x16&p0,f32x16&p1,int jb6,int qrel,int hi,const LAS float*lut2){
  const LAS float*pb=lut2+(128+qrel-64*jb6-4*hi+288-91);
  #pragma unroll
  for(int g=0;g<4;++g){
    #pragma unroll
    for(int q=0;q<4;++q){const int r=4*g+q, c=q+8*g; const int rel=128+qrel-64*jb6-4*hi-c; const float b0=pb[91-c], b1=pb[91-c-32]; p0[r]=(rel<0)?-INFINITY:p0[r]+b0; p1[r]=(rel<32)?-INFINITY:p1[r]+b1;}
    asm volatile("":"+v"(p0),"+v"(p1)); __builtin_amdgcn_sched_barrier(0);}
}
constexpr int NSLOT=3, SLOTB=8192;
constexpr int LDS_K=0, LDS_V=NSLOT*SLOTB, LDS_WS=2*NSLOT*SLOTB, LDS_OST=LDS_WS+NW*64*4, LDS_BYTES=LDS_OST+NW*4096;
__device__ __forceinline__ void glds16(const void*gsrc,unsigned lds_dst){unsigned keep;
  asm volatile("s_mov_b32 %0, m0\n\ts_mov_b32 m0, %2\n\ts_nop 0\n\tglobal_load_lds_dwordx4 %1, off\n\ts_mov_b32 m0, %0":"=&s"(keep):"v"(gsrc),"s"(lds_dst):"memory");}
__device__ __forceinline__ float max3f(float a,float b,float c){float r;asm("v_max3_f32 %0, %1, %2, %3":"=v"(r):"v"(a),"v"(b),"v"(c));return r;}
__device__ __forceinline__ float max2f(float a,float b){float r;asm("v_max_f32_e32 %0, %1, %2":"=v"(r):"v"(a),"v"(b));return r;}
__device__ __forceinline__ float fadd_s(float a,float b){float r;asm("v_add_f32_e32 %0, %1, %2":"=v"(r):"v"(a),"v"(b));return r;}
__device__ __forceinline__ float fsub_s(float a,float b){float r;asm("v_sub_f32_e32 %0, %1, %2":"=v"(r):"v"(a),"v"(b));return r;}
typedef float f32x2_t __attribute__((ext_vector_type(2))); typedef __bf16 bf16x2_t __attribute__((ext_vector_type(2)));
__device__ __forceinline__ unsigned cvtpk_s(float lo,float hi){f32x2_t v={lo,hi};bf16x2_t b=__builtin_convertvector(v,bf16x2_t);return __builtin_bit_cast(unsigned,b);}
#define WAIT_BAR(N) asm volatile("s_waitcnt vmcnt(" #N ") lgkmcnt(0)\n\ts_barrier":::"memory")

__device__ __forceinline__ void qkt(f32x16&p0,f32x16&p1,const char*Kslot,const bf16x8*qr,const f32x16&negm,int r32,int hi){
  const char*kb=Kslot+hi*1024+r32*16;
  #pragma unroll
  for(int d0=0;d0<4;++d0){
    const bf16x8 b0=*reinterpret_cast<const bf16x8*>(kb+d0*2048);
    const bf16x8 b1=*reinterpret_cast<const bf16x8*>(kb+d0*2048+512);
    if(d0==0){p0=__builtin_amdgcn_mfma_f32_32x32x16_bf16(b0,qr[0],negm,0,0,0);p1=__builtin_amdgcn_mfma_f32_32x32x16_bf16(b1,qr[0],negm,0,0,0);}
    else{p0=__builtin_amdgcn_mfma_f32_32x32x16_bf16(b0,qr[d0],p0,0,0,0);p1=__builtin_amdgcn_mfma_f32_32x32x16_bf16(b1,qr[d0],p1,0,0,0);}}
}
typedef LAS const char* lds_cptr;
typedef short v4i16_t __attribute__((ext_vector_type(4)));
__device__ __forceinline__ void kload8(bf16x8*kf,lds_cptr kp){
  kf[0]=*(const LAS bf16x8*)(kp);      kf[1]=*(const LAS bf16x8*)(kp+512);
  kf[2]=*(const LAS bf16x8*)(kp+2048); kf[3]=*(const LAS bf16x8*)(kp+2560);
  kf[4]=*(const LAS bf16x8*)(kp+4096); kf[5]=*(const LAS bf16x8*)(kp+4608);
  kf[6]=*(const LAS bf16x8*)(kp+6144); kf[7]=*(const LAS bf16x8*)(kp+6656);
}
__device__ __forceinline__ void kload2(bf16x8*kf,lds_cptr kp,int j){ kf[2*j]=*(const LAS bf16x8*)(kp+j*2048); kf[2*j+1]=*(const LAS bf16x8*)(kp+j*2048+512); }
__device__ __forceinline__ s16x4 vtr(lds_cptr p){ return __builtin_bit_cast(s16x4,__builtin_amdgcn_ds_read_tr16_b64_v4i16((LAS v4i16_t*)p)); }
__device__ __forceinline__ float rowmax(const f32x16&p0,const f32x16&p1){
  float a=max3f(p0[0],p0[1],p1[0]),b=max3f(p0[2],p0[3],p1[1]);a=max3f(a,p1[2],p1[3]);
  #pragma unroll
  for(int r=4;r<16;r+=4){a=max3f(a,p0[r],p0[r+1]);b=max3f(b,p0[r+2],p0[r+3]);a=max3f(a,p1[r],p1[r+1]);b=max3f(b,p1[r+2],p1[r+3]);}
  const float m=max2f(a,b);
  auto rr=__builtin_amdgcn_permlane32_swap(__float_as_uint(m),__float_as_uint(m),false,false);
  return max2f(__uint_as_float(rr[0]),__uint_as_float(rr[1]));
}
__device__ __forceinline__ void pv(f32x16*o,int vb,bf16x8 pa0,bf16x8 pa1,bf16x8 pa2,bf16x8 pa3){
  #pragma unroll
  for(int d0=0;d0<2;++d0){s16x4 lo[4],hi[4];
    #pragma unroll
    for(int ks=0;ks<4;++ks){
      asm volatile("ds_read_b64_tr_b16 %0,%1 offset:%c2":"=&v"(lo[ks]):"v"(vb),"i"(d0*4096+ks*1024):"memory");
      asm volatile("ds_read_b64_tr_b16 %0,%1 offset:%c2":"=&v"(hi[ks]):"v"(vb),"i"(d0*4096+ks*1024+512):"memory");}
    asm volatile("s_waitcnt lgkmcnt(0)":::"memory");SBAR();
    #define PK(k) (bf16x8){lo[k][0],lo[k][1],lo[k][2],lo[k][3],hi[k][0],hi[k][1],hi[k][2],hi[k][3]}
    o[d0]=__builtin_amdgcn_mfma_f32_32x32x16_bf16(pa0,PK(0),o[d0],0,0,0);
    o[d0]=__builtin_amdgcn_mfma_f32_32x32x16_bf16(pa1,PK(1),o[d0],0,0,0);
    o[d0]=__builtin_amdgcn_mfma_f32_32x32x16_bf16(pa2,PK(2),o[d0],0,0,0);
    o[d0]=__builtin_amdgcn_mfma_f32_32x32x16_bf16(pa3,PK(3),o[d0],0,0,0);
    #undef PK
  }
}
template<int THRL> __device__ __forceinline__ void attn_unit(int b,int qb,const bf16*QKV,int Qc,int Kc,int Vc,bf16*O,const LAS float*lut,char*shm){
  int tid_=threadIdx.x; asm volatile("":"+v"(tid_)); const int tid=tid_,lane=tid&63,r32=lane&31,hi=lane>>5; const int wid=__builtin_amdgcn_readfirstlane(tid>>6);
  const long rowbase=(long)b*SEQ; const int q0=qb*QB;
  const bf16*Qw=QKV+(rowbase+q0+wid*QBLK)*PQ+Qc;
  const bf16*Kh=QKV+rowbase*PQ+Kc,*Vh=QKV+rowbase*PQ+Vc;
  const unsigned lds0=(unsigned)(uintptr_t)shm;
  float*wsf=(float*)(shm+LDS_WS)+wid*64;
  const bf16*ksrc=Kh+(long)lane*PQ+wid*8;
  const bf16*vsrc=Vh+(long)(16*(wid&3)+(lane>>2))*PQ+(wid>>2)*32+(lane&3)*8;
  const unsigned kdst=lds0+LDS_K+wid*1024, vdst=lds0+LDS_V+wid*1024;
  #define DMA_K(t,slot) glds16(ksrc+(long)(t)*KVBLK*PQ,(unsigned)__builtin_amdgcn_readfirstlane(kdst+(slot)))
  #define DMA_V(t,slot) glds16(vsrc+(long)(t)*KVBLK*PQ,(unsigned)__builtin_amdgcn_readfirstlane(vdst+(slot)))
  const int vb0=(int)(lds0+LDS_V)+((lane>>4)&1)*32+(lane&3)*8+(4*hi+((lane&15)>>2))*64;
  const char*Kbase=shm+LDS_K; bf16x8 kf[8];
  const lds_cptr shm3=(lds_cptr)shm; const lds_cptr kp0=shm3+LDS_K+hi*1024+r32*16; const lds_cptr vp0=shm3+LDS_V+((lane>>4)&1)*32+(lane&3)*8+(4*hi+((lane&15)>>2))*64;
  const int NT=(q0+QB)/KVBLK;
  DMA_K(0,0);DMA_V(0,0);DMA_K(1,SLOTB);
  bf16x8 qr[4];
  #pragma unroll
  for(int d0=0;d0<4;++d0)qr[d0]=*reinterpret_cast<const bf16x8*>(&Qw[(long)r32*PQ+d0*16+hi*8]);
  float mhat=0.f,l_reg=0.f;f32x16 o[2];f32x16 negm; { float zz; asm volatile("v_mov_b32 %0, 0":"=v"(zz)); _Pragma("unroll") for(int r=0;r<16;++r){o[0][r]=zz;o[1][r]=zz;negm[r]=zz;} } asm volatile("":"+v"(negm));
  const int qrel=wid*QBLK+r32;
  #define CMASK(P0,P1,t) do{int jb_=(t)-(NT-6); if(jb_>=0)biasmask(P0,P1,jb_,qrel,hi,lut);}while(0)
  bool resc=false;
  #define START(P0,P1) do{ const float rm=rowmax(P0,P1); resc=false; \
    { const float dl=rm; mhat=fadd_s(mhat,dl); \
      _Pragma("unroll") for(int r=0;r<16;++r){P0[r]=fsub_s(P0[r],dl);P1[r]=fsub_s(P1[r],dl);} \
      _Pragma("unroll") for(int r=0;r<16;++r)negm[r]=-mhat; asm volatile("":"+v"(negm)); } \
    _Pragma("unroll") for(int r=0;r<16;++r)P0[r]=__builtin_amdgcn_exp2f(P0[r]); }while(0)
  #define RESC() do{ if(resc){ asm volatile("s_waitcnt lgkmcnt(0)":::"memory"); \
      _Pragma("unroll") for(int d_=0;d_<2;++d_) _Pragma("unroll") for(int r=0;r<16;++r)o[d_][r]*=wsf[crow(r,hi)]; } }while(0)
  f32x16 pA0,pA1,pB0,pB1;
  int sl_prev=0,sl_cur=0,sl_next=SLOTB;
  #define ROT() do{sl_prev=sl_cur;sl_cur=sl_next;sl_next=(sl_next==(NSLOT-1)*SLOTB)?0:sl_next+SLOTB;}while(0)
  DMA_K(2,2*SLOTB);
  WAIT_BAR(3);
  qkt(pA0,pA1,Kbase,qr,negm,r32,hi);asm volatile("s_nop 15\n\ts_nop 7":"+v"(pA0),"+v"(pA1));CMASK(pA0,pA1,0);
  START(pA0,pA1);
  _Pragma("unroll") for(int r=0;r<16;++r)pA1[r]=__builtin_amdgcn_exp2f(pA1[r]);
  WAIT_BAR(0);
  DMA_K(3,0);DMA_V(1,SLOTB);
  ROT();
  kload8(kf,kp0+sl_cur);
  WAIT_BAR(2);
  s16x4 vlo[8],vhi[8]; u32x4 pw0,pw1,pw2,pw3;
  #define PKW(P,B) cvtpk_s(P[B],P[B+1])
  #define PAF(k) __builtin_bit_cast(bf16x8,pw##k)
  #define VFR(i) (bf16x8){vlo[i][0],vlo[i][1],vlo[i][2],vlo[i][3],vhi[i][0],vhi[i][1],vhi[i][2],vhi[i][3]}
  #define PIN(x) asm volatile("":"+v"(x))
  #define MX3(a,b,c) __builtin_fmaxf(__builtin_fmaxf((a),(b)),(c))
  #define GAPA(MF,A0,A1,A2,A3,W0,W1,PW) do{ MF; sacc+=A0; sacc+=A1; sacc+=A2; sacc+=A3; PIN(sacc); W0; W1; PIN(PW); SBAR(); }while(0)
  #define EX(v) __builtin_amdgcn_exp2f(v)
  #define GAPB(MF,X,B) do{ MF; X[B]=EX(X[B]); X[B+1]=EX(X[B+1]); X[B+2]=EX(X[B+2]); X[B+3]=EX(X[B+3]); PIN(X); SBAR(); }while(0)
  #define VRD(i) do{ vlo[i]=vtr(vp_+(((i)>>2)*4096+((i)&3)*1024)); vhi[i]=vtr(vp_+(((i)>>2)*4096+((i)&3)*1024+512)); }while(0)
  #define KRD(G,j) do{ if(G){ kload2(kf,kp0+sl_next,j); SBAR(); } }while(0)
  #define STEP(C0,C1,P0,P1,t,GK,GV,GL) do{ SBAR(); \
    const lds_cptr vp_=vp0+sl_prev; \
    VRD(0); SBAR(); float sacc=(P0[0]+P0[1]); \
    GAPA(C0=__builtin_amdgcn_mfma_f32_32x32x16_bf16(kf[0],qr[0],negm,0,0,0), P0[2],P0[3],P0[4],P0[5],     pw0[0]=PKW(P0,0), pw0[1]=PKW(P0,2), pw0); \
    VRD(4); SBAR(); GAPA(C1=__builtin_amdgcn_mfma_f32_32x32x16_bf16(kf[1],qr[0],negm,0,0,0), P0[6],P0[7],P0[8],P0[9],     pw0[2]=PKW(P0,4), pw0[3]=PKW(P0,6), pw0); \
    VRD(1); SBAR(); GAPA(C0=__builtin_amdgcn_mfma_f32_32x32x16_bf16(kf[2],qr[1],C0,0,0,0),   P0[10],P0[11],P0[12],P0[13], pw1[0]=PKW(P0,8), pw1[1]=PKW(P0,10), pw1); \
    VRD(5); SBAR(); GAPA(C1=__builtin_amdgcn_mfma_f32_32x32x16_bf16(kf[3],qr[1],C1,0,0,0),   P0[14],P0[15],P1[0],P1[1],   pw1[2]=PKW(P0,12),pw1[3]=PKW(P0,14), pw1); \
    VRD(2); SBAR(); GAPA(C0=__builtin_amdgcn_mfma_f32_32x32x16_bf16(kf[4],qr[2],C0,0,0,0),   P1[2],P1[3],P1[4],P1[5],     pw2[0]=PKW(P1,0), pw2[1]=PKW(P1,2), pw2); \
    VRD(6); SBAR(); GAPA(C1=__builtin_amdgcn_mfma_f32_32x32x16_bf16(kf[5],qr[2],C1,0,0,0),   P1[6],P1[7],P1[8],P1[9],     pw2[2]=PKW(P1,4), pw2[3]=PKW(P1,6), pw2); \
    VRD(3); SBAR(); GAPA(C0=__builtin_amdgcn_mfma_f32_32x32x16_bf16(kf[6],qr[3],C0,0,0,0),   P1[10],P1[11],P1[12],P1[13], pw3[0]=PKW(P1,8), pw3[1]=PKW(P1,10), pw3); \
    VRD(7); SBAR(); GAPA(C1=__builtin_amdgcn_mfma_f32_32x32x16_bf16(kf[7],qr[3],C1,0,0,0),   P1[14],P1[15],0.f,0.f,       pw3[2]=PKW(P1,12),pw3[3]=PKW(P1,14), pw3); \
    l_reg+=sacc; \
    if(GK){DMA_K((t)+3,sl_cur);} if(GV){DMA_V((t)+1,sl_next);} \
    CMASK(C0,C1,t); \
    { float a=MX3(C0[0],C0[1],C1[0]),b=MX3(C0[2],C0[3],C1[1]); a=MX3(a,C1[2],C1[3]); \
      _Pragma("unroll") for(int r=4;r<16;r+=4){a=MX3(a,C0[r],C0[r+1]);b=MX3(b,C0[r+2],C0[r+3]);a=MX3(a,C1[r],C1[r+1]);b=MX3(b,C1[r+2],C1[r+3]);} \
      float rm=__builtin_fmaxf(a,b); { auto rr=__builtin_amdgcn_permlane32_swap(__float_as_uint(rm),__float_as_uint(rm),false,false); rm=__builtin_fmaxf(__uint_as_float(rr[0]),__uint_as_float(rr[1])); } \
      resc=false; \
      if(__builtin_expect(__any(rm>(float)THRL),0)){ const float dl=__builtin_fmaxf(rm,0.f); mhat+=dl; \
        _Pragma("unroll") for(int r=0;r<16;++r){C0[r]-=dl;C1[r]-=dl;} \
        _Pragma("unroll") for(int r=0;r<16;++r)negm[r]=-mhat; asm volatile("":"+v"(negm)); \
        const float f=__builtin_amdgcn_exp2f(-dl); l_reg*=f; if(hi==0)wsf[r32]=f; resc=true; } } \
    SBAR(); \
    GAPB(o[0]=__builtin_amdgcn_mfma_f32_32x32x16_bf16(PAF(0),VFR(0),o[0],0,0,0), C0,0); \
    GAPB(o[1]=__builtin_amdgcn_mfma_f32_32x32x16_bf16(PAF(0),VFR(4),o[1],0,0,0), C0,4); \
    KRD(GL,0); GAPB(o[0]=__builtin_amdgcn_mfma_f32_32x32x16_bf16(PAF(1),VFR(1),o[0],0,0,0), C0,8); \
    KRD(GL,1); GAPB(o[1]=__builtin_amdgcn_mfma_f32_32x32x16_bf16(PAF(1),VFR(5),o[1],0,0,0), C0,12); \
    KRD(GL,2); GAPB(o[0]=__builtin_amdgcn_mfma_f32_32x32x16_bf16(PAF(2),VFR(2),o[0],0,0,0), C1,0); \
    KRD(GL,3); GAPB(o[1]=__builtin_amdgcn_mfma_f32_32x32x16_bf16(PAF(2),VFR(6),o[1],0,0,0), C1,4); \
    GAPB(o[0]=__builtin_amdgcn_mfma_f32_32x32x16_bf16(PAF(3),VFR(3),o[0],0,0,0), C1,8); \
    GAPB(o[1]=__builtin_amdgcn_mfma_f32_32x32x16_bf16(PAF(3),VFR(7),o[1],0,0,0), C1,12); \
    }while(0)
  int t=1;
  #undef CMASK
  #define CMASK(P0,P1,t) do{}while(0)
  for(;t+7<NT;t+=2){
    STEP(pB0,pB1,pA0,pA1,t,true,true,true);     WAIT_BAR(2); RESC(); ROT();
    STEP(pA0,pA1,pB0,pB1,t+1,true,true,true);   WAIT_BAR(2); RESC(); ROT();
  }
  #undef CMASK
  #define CMASK(P0,P1,t) do{int jb_=(t)-(NT-6); if(jb_>=0)biasmask(P0,P1,jb_,qrel,hi,lut);}while(0)
  #define ENDW(tt) do{ if((tt)+3<NT){WAIT_BAR(2);} else if((tt)+2<NT){WAIT_BAR(1);} else {WAIT_BAR(0);} }while(0)
  for(;t+1<NT;t+=2){
    STEP(pB0,pB1,pA0,pA1,t,(t+3<NT),(t+1<NT),(t+1<NT));       ENDW(t);   RESC(); ROT();
    STEP(pA0,pA1,pB0,pB1,t+1,(t+4<NT),(t+2<NT),(t+2<NT));     ENDW(t+1); RESC(); ROT();
  }
  STEP(pB0,pB1,pA0,pA1,NT-1,false,false,false); RESC();
  { float sacc=pB0[0]+pB0[1]; _Pragma("unroll") for(int r=2;r<16;++r)sacc+=pB0[r]; _Pragma("unroll") for(int r=0;r<16;++r)sacc+=pB1[r]; l_reg+=sacc;
    pw0=(u32x4){PKW(pB0,0),PKW(pB0,2),PKW(pB0,4),PKW(pB0,6)};pw1=(u32x4){PKW(pB0,8),PKW(pB0,10),PKW(pB0,12),PKW(pB0,14)};pw2=(u32x4){PKW(pB1,0),PKW(pB1,2),PKW(pB1,4),PKW(pB1,6)};pw3=(u32x4){PKW(pB1,8),PKW(pB1,10),PKW(pB1,12),PKW(pB1,14)};
    SBAR(); pv(o,vb0+sl_cur,PAF(0),PAF(1),PAF(2),PAF(3)); }
  #undef PKW
  #undef PAF
  #undef VFR
  #undef PIN
  #undef MX3
  #undef GAPA
  #undef GAPB
  #undef EX
  #undef VRD
  #undef KRD
  #undef STEP
  #undef ENDW
  {auto rr=__builtin_amdgcn_permlane32_swap(__float_as_uint(l_reg),__float_as_uint(l_reg),false,false);l_reg=__uint_as_float(rr[0])+__uint_as_float(rr[1]);}
  if(hi==0)wsf[32+r32]=l_reg;asm volatile("s_waitcnt lgkmcnt(0)":::"memory");
  float rli[16];
  #pragma unroll
  for(int r=0;r<16;++r)rli[r]=__builtin_amdgcn_rcpf(wsf[32+crow(r,hi)]);
  bf16*Ow=O+(rowbase+q0+wid*QBLK)*PO;
  { bf16*stg=(bf16*)(shm+LDS_OST)+wid*2048;
    #pragma unroll
    for(int r=0;r<16;++r){const int orow=crow(r,hi);
      #pragma unroll
      for(int d0=0;d0<2;++d0)stg[orow*64+d0*32+r32]=__float2bfloat16(o[d0][r]*rli[r]);}
    asm volatile("s_waitcnt lgkmcnt(0)":::"memory");
    #pragma unroll
    for(int i=0;i<4;++i){const int row=i*8+(lane>>3),ch=lane&7; const u32x4 v=*(const u32x4*)(stg+row*64+ch*8); *(u32x4*)(Ow+(long)row*PO+ch*8)=v;} }
  asm volatile("s_waitcnt lgkmcnt(0)\n\ts_barrier":::"memory");
  #undef DMA_K
  #undef DMA_V
  #undef CMASK
  #undef START
  #undef RESC
  #undef ROT
}
constexpr int ATTN_LDS_BYTES=LDS_BYTES;
#undef SBAR
#undef WAIT_BAR
}
constexpr int NWAVES = 8;
typedef unsigned short bf16;
typedef unsigned v4u __attribute__((ext_vector_type(4)));
typedef unsigned v2u __attribute__((ext_vector_type(2)));
typedef float f32x4 __attribute__((ext_vector_type(4)));
typedef float f32x2 __attribute__((ext_vector_type(2)));
typedef short bf16x8 __attribute__((ext_vector_type(8)));
typedef GAS unsigned gu32;
#define RLX_AGENT __ATOMIC_RELAXED, __HIP_MEMORY_SCOPE_AGENT
#define LDS_WAIT() asm volatile("s_waitcnt lgkmcnt(0)" ::: "memory")
#define VM_WAIT() asm volatile("s_waitcnt vmcnt(0)" ::: "memory")
__device__ __forceinline__ unsigned f2bf(float f) { unsigned u = __builtin_bit_cast(unsigned, f); return (u + 0x7fffu + ((u >> 16) & 1u)) >> 16; }
__device__ __forceinline__ unsigned pk2(float lo, float hi) { return f2bf(lo) | (f2bf(hi) << 16); }
__device__ __forceinline__ float bf2f(unsigned short b) { return __builtin_bit_cast(float, (unsigned)b << 16); }
__device__ __forceinline__ float bflo(unsigned w) { return __builtin_bit_cast(float, w << 16); }
__device__ __forceinline__ float bfhi(unsigned w) { return __builtin_bit_cast(float, w & 0xffff0000u); }

#define XB_TMO      128
#define XB_XCNT(j)  (256  + 64 * (j))
#define XB_XSUB(j)  (1280 + 64 * (j))
#define XB_XGEN(j)  (2304 + 64 * (j))
#define XB_TOP      3328
#define XB_TOPGEN   3392
#define XCD_BAR_WORDS 3456
#define XB_SPIN_CAP (1u << 18)
__device__ __forceinline__ unsigned xb_ld(unsigned* p)              { return __hip_atomic_load(p, __ATOMIC_RELAXED, __HIP_MEMORY_SCOPE_AGENT); }
__device__ __forceinline__ unsigned xb_add(unsigned* p, unsigned v) { return __hip_atomic_fetch_add(p, v, __ATOMIC_RELAXED, __HIP_MEMORY_SCOPE_AGENT); }
__device__ __forceinline__ unsigned xb_xcc_id() { return (unsigned)__builtin_amdgcn_s_getreg((3 << 11) | 20) & 0xFu; }
#define XB_SPIN(cond, bar) do { unsigned _sp = 0; while (cond) { __builtin_amdgcn_s_sleep(1); \
    if ((++_sp & 255u) == 0u) { if (xb_ld(&(bar)[XB_TMO])) break; if (_sp > XB_SPIN_CAP) { atomicAdd(&(bar)[XB_TMO], 1u); break; } } } } while (0)
struct XcdBarrier { unsigned* bar; unsigned x; volatile LAS unsigned* st; };
__device__ __forceinline__ XcdBarrier xcd_barrier_post(unsigned* bar, volatile LAS unsigned* st) {
    XcdBarrier b; b.bar = bar; b.x = xb_xcc_id(); b.st = st;
    if (threadIdx.x == 0) (void)xb_add(&bar[XB_XCNT(b.x)], 1u);
    return b;
}
__device__ __forceinline__ void xcd_barrier_complete(unsigned* bar, unsigned x, unsigned& nloc, unsigned& nx) {
    const unsigned G = gridDim.x * gridDim.y * gridDim.z;
    unsigned sum, cnt, mine, sp = 0u;
    for (;;) {
        sum = 0u; cnt = 0u; mine = 0u;
#pragma unroll
        for (unsigned j = 0; j < 16; ++j) { const unsigned c = xb_ld(&bar[XB_XCNT(j)]); sum += c; cnt += (c > 0u) ? 1u : 0u; mine = (j == x) ? c : mine; }
        if (sum == G) break;
        __builtin_amdgcn_s_sleep(1);
        if ((++sp & 255u) == 0u) { if (xb_ld(&bar[XB_TMO])) break; if (sp > XB_SPIN_CAP) { atomicAdd(&bar[XB_TMO], 1u); break; } }
    }
    nloc = mine > 0u ? mine : 1u; nx = cnt > 0u ? cnt : 1u;
}
__device__ __forceinline__ void xcd_barrier(const XcdBarrier& b) {
    asm volatile("s_waitcnt vmcnt(0)" ::: "memory");
    __syncthreads();
    if (threadIdx.x == 0) {
        unsigned* bar = b.bar;
        __builtin_amdgcn_s_waitcnt(0);
        unsigned nloc = b.st[0], nx = b.st[1];
        if (nloc == 0u) { xcd_barrier_complete(bar, b.x, nloc, nx); b.st[0] = nloc; b.st[1] = nx; }
        const unsigned old = xb_add(&bar[XB_XSUB(b.x)], 1u);
        const unsigned gen = old / nloc;
        if (old + 1u == (gen + 1u) * nloc) {
            __builtin_amdgcn_fence(__ATOMIC_RELEASE, "agent");
            asm volatile("s_waitcnt vmcnt(0)" ::: "memory");
            const unsigned og = xb_add(&bar[XB_TOP], 1u);
            const unsigned tg = og / nx;
            if (og + 1u == (tg + 1u) * nx) xb_add(&bar[XB_TOPGEN], 1u);
            else XB_SPIN(xb_ld(&bar[XB_TOPGEN]) == tg, bar);
            __builtin_amdgcn_fence(__ATOMIC_ACQUIRE, "agent");
            xb_add(&bar[XB_XGEN(b.x)], 1u);
            asm volatile("s_waitcnt vmcnt(0)" ::: "memory");
        } else {
            XB_SPIN(xb_ld(&bar[XB_XGEN(b.x)]) == gen, bar);
            __builtin_amdgcn_fence(__ATOMIC_ACQUIRE, "agent");
            asm volatile("s_waitcnt vmcnt(0)" ::: "memory");
        }
    }
    __syncthreads();
}

struct Args { const float* in[18]; float* out; unsigned char* ws; int ph_lo, ph_hi, li, pad; };
struct Frame {
    LAS unsigned char* lds;
    gu32* ctl;
    unsigned char* ws;
    int tid, lane, wave;
    int vcu, G;
};

__device__ __forceinline__ float wave_sum(float v) {
#pragma unroll
    for (int o = 1; o < 64; o <<= 1) v += __shfl_xor(v, o);
    return v;
}
__device__ __forceinline__ void transpose_block(const float* src, int ld_src, bf16* dst, int ld_dst, LAS float* scr, int lane, bf16* dst2) {
#pragma unroll 8
    for (int i = 0; i < 32; ++i) { const int kk = 2 * i + (lane >> 5); scr[kk * 33 + (lane & 31)] = src[(size_t)kk * ld_src + (lane & 31)]; }
    LDS_WAIT(); asm volatile("" ::: "memory");
    const int c = lane & 7;
#pragma unroll
    for (int j = 0; j < 4; ++j) { const int n = (lane >> 3) + 8 * j; const LAS float* s = scr + (8 * c) * 33 + n;
        v4u o; o.x = pk2(s[0 * 33], s[1 * 33]); o.y = pk2(s[2 * 33], s[3 * 33]); o.z = pk2(s[4 * 33], s[5 * 33]); o.w = pk2(s[6 * 33], s[7 * 33]);
        *(GAS v4u*)(dst + (size_t)n * ld_dst + 8 * c) = o;
        if (dst2) *(GAS v4u*)(dst2 + (size_t)n * ld_dst + 8 * c) = o; }
    LDS_WAIT(); asm volatile("" ::: "memory");
}
__device__ __forceinline__ unsigned pk4_fp8f(float a, float b, float c, float d) { int w = 0; w = __builtin_amdgcn_cvt_pk_fp8_f32(a, b, w, false); w = __builtin_amdgcn_cvt_pk_fp8_f32(c, d, w, true); return (unsigned)w; }
__device__ __forceinline__ void transpose_block8(const float* src, int ld_src, unsigned char* dst, int ld_dst, float sc, LAS float* scr, int lane, unsigned char* dst2 = nullptr) {
#pragma unroll 8
    for (int i = 0; i < 32; ++i) { const int kk = 2 * i + (lane >> 5); scr[kk * 33 + (lane & 31)] = src[(size_t)kk * ld_src + (lane & 31)]; }
    LDS_WAIT(); asm volatile("" ::: "memory");
    const int c = lane & 7;
#pragma unroll
    for (int j = 0; j < 4; ++j) { const int n = (lane >> 3) + 8 * j; const LAS float* s = scr + (8 * c) * 33 + n;
        v2u o; o.x = pk4_fp8f(s[0 * 33] * sc, s[1 * 33] * sc, s[2 * 33] * sc, s[3 * 33] * sc); o.y = pk4_fp8f(s[4 * 33] * sc, s[5 * 33] * sc, s[6 * 33] * sc, s[7 * 33] * sc);
        *(GAS v2u*)(dst + (size_t)n * ld_dst + 8 * c) = o;
        if (dst2) *(GAS v2u*)(dst2 + (size_t)n * ld_dst + 8 * c) = o; }
    LDS_WAIT(); asm volatile("" ::: "memory");
}
__device__ __forceinline__ void rms_row_to_bf16(int lane, const float* xrow, const float* g, bf16* orow) {
    const GAS f32x4* xr = (const GAS f32x4*)xrow + lane; const GAS f32x4* gr = (const GAS f32x4*)g + lane;
    f32x4 v[4]; float s = 0.f;
#pragma unroll
    for (int j = 0; j < 4; ++j) { v[j] = xr[64 * j]; s += (v[j].x * v[j].x + v[j].y * v[j].y) + (v[j].z * v[j].z + v[j].w * v[j].w); }
    const float rstd = 1.0f / sqrtf(wave_sum(s) * (1.f / 1024.f) + RMS_EPS);
    GAS v2u* o8 = (GAS v2u*)orow + lane;
#pragma unroll
    for (int j = 0; j < 4; ++j) { const f32x4 gg = gr[64 * j]; v2u o; o.x = pk2(v[j].x * rstd * gg.x, v[j].y * rstd * gg.y); o.y = pk2(v[j].z * rstd * gg.z, v[j].w * rstd * gg.w); o8[64 * j] = o; }
}

__device__ __forceinline__ void rms_row_to_fp8(int lane, const float* xrow, const float* g, unsigned char* orow) {
    const GAS f32x4* xr = (const GAS f32x4*)xrow + lane; const GAS f32x4* gr = (const GAS f32x4*)g + lane;
    f32x4 v[4]; float s = 0.f;
#pragma unroll
    for (int j = 0; j < 4; ++j) { v[j] = xr[64 * j]; s += (v[j].x * v[j].x + v[j].y * v[j].y) + (v[j].z * v[j].z + v[j].w * v[j].w); }
    const float rstd = H8_SCALE / sqrtf(wave_sum(s) * (1.f / 1024.f) + RMS_EPS);
    GAS unsigned* o4 = (GAS unsigned*)orow + lane;
#pragma unroll
    for (int j = 0; j < 4; ++j) { const f32x4 gg = gr[64 * j]; o4[64 * j] = pk4_fp8f(v[j].x * rstd * gg.x, v[j].y * rstd * gg.y, v[j].z * rstd * gg.z, v[j].w * rstd * gg.w); }
}
constexpr int IT_WIN0 = (1024 / 64) * (3072 / 32);
constexpr int IT_WOUT0 = (1024 / 64) * (1024 / 32);
constexpr int IT_RIN = (1024 / 64) * (6144 / 32);
constexpr int IT_ROUT = (2048 / 64) * (1024 / 32);
constexpr int IT_SHARED = IT_WIN0 + IT_WOUT0 + IT_RIN + IT_ROUT;
constexpr int IT_EXP = 3 * 256;
constexpr int IT_MOE = NEXP * IT_EXP;
__device__ __forceinline__ void conv_shared_item(Frame& F, const Args& a, int it, LAS float* scr) {
    unsigned char* ws = F.ws;
    if (it < IT_WIN0) { const int nblk = 96, kb = it / nblk, nb = it % nblk;
        if (QKV_FP8) transpose_block8(a.in[5] + (size_t)(64 * kb) * 3072 + 32 * nb, 3072, ws + WS_WINT0 + (size_t)(32 * nb) * 1024 + 64 * kb, 1024, WIN_SCALE, scr, F.lane);
        else transpose_block(a.in[5] + (size_t)(64 * kb) * 3072 + 32 * nb, 3072, (bf16*)(ws + WS_WINT0) + (size_t)(32 * nb) * 1024 + 64 * kb, 1024, scr, F.lane, nullptr);
        return; }
    it -= IT_WIN0;
    if (it < IT_WOUT0) { const int nblk = 32, kb = it / nblk, nb = it % nblk;
        transpose_block(a.in[8] + (size_t)(64 * kb) * 1024 + 32 * nb, 1024, (bf16*)(ws + WS_WOUTT0) + (size_t)(32 * nb) * 1024 + 64 * kb, 1024, scr, F.lane, nullptr); return; }
    it -= IT_WOUT0;
    if (it < IT_RIN) { const int nblk = 192, kb = it / nblk, nb = it % nblk, n0 = 32 * nb;
        unsigned char* A = ws + WS_WRINA; unsigned char* B = ws + WS_WRINB; unsigned char *d1, *d2 = nullptr;
        if (n0 < 1024) d1 = A + (size_t)n0 * 1024;
        else if (n0 < 2048) { d1 = A + (size_t)n0 * 1024; d2 = B + (size_t)(n0 - 1024) * 1024; }
        else if (n0 < 4096) d1 = B + (size_t)(n0 - 1024) * 1024;
        else d1 = A + (size_t)(n0 - 2048) * 1024;
        transpose_block8(a.in[9] + (size_t)(64 * kb) * 6144 + n0, 6144, d1 + 64 * kb, 1024, WIN_SCALE, scr, F.lane, d2 ? d2 + 64 * kb : nullptr); return; }
    it -= IT_RIN;
    { const int nblk = 32, kb = it / nblk, nb = it % nblk;
        transpose_block(a.in[10] + (size_t)(64 * kb) * 1024 + 32 * nb, 1024, (bf16*)(ws + WS_WROUTT) + (size_t)(32 * nb) * 2048 + 64 * kb, 2048, scr, F.lane, nullptr); }
}
__device__ __forceinline__ void conv_moe_item(Frame& F, const Args& a, int layer, int it, LAS float* scr) {
    unsigned char* ws = F.ws;
    const int e = it / IT_EXP; int r = it % IT_EXP; const size_t le = (size_t)layer * NEXP + e;
    if (r < 512) { const int up = r >> 8; r &= 255; const int kb = r / 16, nb = r % 16, n0 = 32 * nb;
        const float* src = a.in[up ? 16 : 15] + le * (1024 * 512) + (size_t)(64 * kb) * 512 + n0;
        const int drow = 256 * (n0 >> 7) + 128 * up + (n0 & 127);
        transpose_block8(src, 512, ws + WS_W1CAT + ((size_t)e * 1024 + drow) * 1024 + 64 * kb, 1024, W1_SCALE, scr, F.lane); return; }
    r -= 512; { const int kb = r / 32, nb = r % 32;
        const float* src = a.in[17] + le * (512 * 1024) + (size_t)(64 * kb) * 1024 + 32 * nb;
        transpose_block8(src, 1024, ws + WS_W2T + ((size_t)e * 1024 + 32 * nb) * 512 + 64 * kb, 512, W2_SCALE, scr, F.lane); }
}
__device__ __forceinline__ void build_router_frags(Frame& F, const Args& a, int gtid, int gthreads) {
    bf16* wrf = (bf16*)(F.ws + WS_WRF);
    for (int idx = gtid; idx < 2 * 32 * 3 * 64 * 8; idx += gthreads) {
        const int j = idx & 7, lane = (idx >> 3) & 63, nt = (idx >> 9) % 3, s = ((idx >> 9) / 3) & 31, L = (idx >> 9) / 96;
        const int k = 32 * s + 8 * (lane >> 4) + j, o = 16 * nt + (lane & 15);
        float w = 0.f;
        if (o < 4) w = a.in[11][((size_t)L * 1024 + k) * 4 + o]; else if (o < 36) w = a.in[13][((size_t)L * 1024 + k) * 32 + (o - 4)];
        w *= a.in[3][L * 1024 + k];
        const unsigned hi = f2bf(w); const float lo = w - __builtin_bit_cast(float, hi << 16);
        const size_t base = ((((size_t)L * 32 + s) * 3 + nt) * 2) * 512 + (size_t)lane * 8 + j;
        wrf[base] = (bf16)hi; wrf[base + 512] = (bf16)f2bf(lo);
    }
}
__device__ __forceinline__ void build_sincos(Frame& F, int gtid, int gthreads) {
    float* t1 = (float*)(F.ws + WS_SINCOS); float* t2 = (float*)(F.ws + WS_SINCOST);
    for (int idx = gtid; idx < SEQ * 128; idx += gthreads) {
        const int pos = idx >> 7, i = idx & 127;
        double ang = 1.0, bs = 0.9300449458481391;
        for (int bit = 0; bit < 7; ++bit) { if ((i >> bit) & 1) ang *= bs; bs *= bs; }
        const double ph = (double)pos * ang;
        const double kq = __builtin_rint(ph * 0.63661977236758134308);
        double r = __builtin_fma(-kq, 1.57079632679489655800, ph); r = __builtin_fma(-kq, 6.12323399573676603587e-17, r);
        const double r2 = r * r;
        double sn = r * (1.0 + r2 * (-1.0 / 6 + r2 * (1.0 / 120 + r2 * (-1.0 / 5040 + r2 * (1.0 / 362880 + r2 * (-1.0 / 39916800 + r2 * (1.0 / 6227020800.0)))))));
        double cs = 1.0 + r2 * (-0.5 + r2 * (1.0 / 24 + r2 * (-1.0 / 720 + r2 * (1.0 / 40320 + r2 * (-1.0 / 3628800 + r2 * (1.0 / 479001600.0 + r2 * (-1.0 / 87178291200.0)))))));
        const int q = ((int)kq) & 3;
        double s_ = (q == 0) ? sn : (q == 1) ? cs : (q == 2) ? -sn : -cs;
        double c_ = (q == 0) ? cs : (q == 1) ? -sn : (q == 2) ? -cs : sn;
        t1[(size_t)idx * 2] = (float)c_; t1[(size_t)idx * 2 + 1] = (float)s_;
        const size_t j = ((size_t)i * SEQ + pos) * 2; t2[j] = (float)c_; t2[j + 1] = (float)s_;
    }
}
__device__ __forceinline__ void p_prologue(Frame& F, const Args& a) {
    LAS float* scr = (LAS float*)(F.lds + RING_OFF + F.wave * 16384);
    const int gw = F.vcu * NWAVES + F.wave, NGW = F.G * NWAVES;
    for (int it = gw; it < IT_SHARED + IT_MOE; it += NGW) { if (it < IT_SHARED) conv_shared_item(F, a, it, scr); else conv_moe_item(F, a, 0, it - IT_SHARED, scr); }
    build_router_frags(F, a, F.vcu * 512 + F.tid, F.G * 512);
    build_sincos(F, F.vcu * 512 + F.tid, F.G * 512);
    for (int m = gw; m < TOK; m += NGW) { if (QKV_FP8) rms_row_to_fp8(F.lane, a.in[0] + (size_t)m * DM, a.in[2], F.ws + WS_HB + (size_t)m * DM); else rms_row_to_bf16(F.lane, a.in[0] + (size_t)m * DM, a.in[2], (bf16*)(F.ws + WS_HB) + (size_t)m * DM); }
}
__device__ __forceinline__ void p_attention(Frame& F, const Args& a) {
    LAS float* lut = (LAS float*)(F.lds + LX_LUT);
    const attn_body::bf16* QKV = (const attn_body::bf16*)(F.ws + WS_QKV0);
    const float* lq = a.in[6];
    const float lam = __expf(wave_sum(lq[F.lane] * lq[64 + F.lane])) - __expf(wave_sum(lq[128 + F.lane] * lq[192 + F.lane])) + 0.2f;
    for (int v = F.vcu; v < 256; v += F.G) {
        const int bh = v >> 2, s = v & 3, b = bh >> 3, h = bh & 7;
        __syncthreads();
        for (int idx = F.tid; idx < 672; idx += 512) { const int n = idx - 288; float val = 0.f;
            if (n < 0) val = -INFINITY;
            else if (n < 113) { int bk = n; if (n >= 16) { bk = 16; const int thr[15] = {19, 21, 24, 27, 31, 35, 40, 46, 52, 59, 67, 77, 87, 99, 113};
#pragma unroll
                for (int q = 0; q < 15; ++q) bk += (n >= thr[q]) ? 1 : 0; }
                val = (a.in[1][bk * 8 + h] - a.in[1][31 * 8 + h]) * LOG2E; }
            lut[idx] = val; }
        __syncthreads();
#pragma nounroll
        for (int i = 0; i < 8; ++i) {
            const int qb = (i < 4) ? 7 - s : s, m = (i >> 1) & 1, vh = i & 1;
            attn_body::bf16* O = (attn_body::bf16*)(F.ws + WS_OP) + (size_t)m * TOK * 1024 + h * 128 + vh * 64;
            attn_body::attn_unit<8>(b, qb, QKV, h * 128 + m * 64, 1024 + h * 128 + m * 64, 2048 + h * 128 + vh * 64, O, lut, (char*)F.lds + RING_OFF);
            if ((i & 3) == 3) {
                VM_WAIT(); __syncthreads();
                int t_ = threadIdx.x; asm volatile("" : "+v"(t_));
                const int row = b * SEQ + qb * 256 + (t_ >> 1), c0 = h * 128 + (t_ & 1) * 64;
                const bf16* O0 = (const bf16*)(F.ws + WS_OP) + (size_t)row * 1024 + c0; const bf16* O1 = O0 + (size_t)TOK * 1024; bf16* AO = (bf16*)(F.ws + WS_AO) + (size_t)row * 1024 + c0;
                const float* sg = a.in[7] + (t_ & 1) * 64;
                float ss = 0.f; v4u wa[8], wb[8];
#pragma unroll
                for (int q = 0; q < 8; ++q) { wa[q] = ((const GAS v4u*)O0)[q]; wb[q] = ((const GAS v4u*)O1)[q]; }
#pragma unroll
                for (int q = 0; q < 8; ++q) { const unsigned xa[4] = {wa[q].x, wa[q].y, wa[q].z, wa[q].w}, xb[4] = {wb[q].x, wb[q].y, wb[q].z, wb[q].w};
#pragma unroll
                    for (int j = 0; j < 4; ++j) { const float o0 = bflo(xa[j]) - lam * bflo(xb[j]), o1 = bfhi(xa[j]) - lam * bfhi(xb[j]); ss += o0 * o0 + o1 * o1; } }
                ss += __shfl_xor(ss, 1);
                const float rstd = 0.8f / sqrtf(ss * (1.f / 128.f) + SUBLN_EPS);
#pragma unroll
                for (int q = 0; q < 8; ++q) { const unsigned xa[4] = {wa[q].x, wa[q].y, wa[q].z, wa[q].w}, xb[4] = {wb[q].x, wb[q].y, wb[q].z, wb[q].w}; unsigned r[4];
                    const f32x4 g0 = *(const GAS f32x4*)(sg + q * 8), g1 = *(const GAS f32x4*)(sg + q * 8 + 4); const float gg[8] = {g0.x, g0.y, g0.z, g0.w, g1.x, g1.y, g1.z, g1.w};
#pragma unroll
                    for (int j = 0; j < 4; ++j) r[j] = pk2((bflo(xa[j]) - lam * bflo(xb[j])) * rstd * gg[2 * j], (bfhi(xa[j]) - lam * bfhi(xb[j])) * rstd * gg[2 * j + 1]);
                    v4u o; o.x = r[0]; o.y = r[1]; o.z = r[2]; o.w = r[3]; ((GAS v4u*)AO)[q] = o; }
            }
        }
    }
}
__device__ __forceinline__ void p_diffcombine(Frame& F, const Args& a) {
    const int gw = F.vcu * NWAVES + F.wave, NGW = F.G * NWAVES, lane = F.lane;
    const float* lq = a.in[6];
    const float lam = __expf(wave_sum(lq[lane] * lq[64 + lane])) - __expf(wave_sum(lq[128 + lane] * lq[192 + lane])) + 0.2f;
    const int d0 = (lane & 7) * 16; float g[16];
#pragma unroll
    for (int j = 0; j < 16; ++j) g[j] = a.in[7][d0 + j] * 0.8f;
    const bf16* O0 = (const bf16*)(F.ws + WS_OP); const bf16* O1 = O0 + (size_t)TOK * 1024; bf16* AO = (bf16*)(F.ws + WS_AO);
    for (int m = gw; m < TOK; m += NGW) {
        const GAS v4u* p0 = (const GAS v4u*)(O0 + (size_t)m * 1024 + lane * 16); const GAS v4u* p1 = (const GAS v4u*)(O1 + (size_t)m * 1024 + lane * 16);
        const v4u a0 = p0[0], a1 = p0[1], b0 = p1[0], b1 = p1[1];
        const unsigned wa[8] = {a0.x, a0.y, a0.z, a0.w, a1.x, a1.y, a1.z, a1.w}, wb[8] = {b0.x, b0.y, b0.z, b0.w, b1.x, b1.y, b1.z, b1.w};
        float o[16]; float ss = 0.f;
#pragma unroll
        for (int j = 0; j < 8; ++j) { o[2 * j] = bflo(wa[j]) - lam * bflo(wb[j]); o[2 * j + 1] = bfhi(wa[j]) - lam * bfhi(wb[j]); ss += o[2 * j] * o[2 * j] + o[2 * j + 1] * o[2 * j + 1]; }
        ss += __shfl_xor(ss, 1); ss += __shfl_xor(ss, 2); ss += __shfl_xor(ss, 4);
        const float rstd = 1.0f / sqrtf(ss * (1.f / 128.f) + SUBLN_EPS);
        v4u w0, w1;
        w0.x = pk2(o[0] * rstd * g[0], o[1] * rstd * g[1]); w0.y = pk2(o[2] * rstd * g[2], o[3] * rstd * g[3]); w0.z = pk2(o[4] * rstd * g[4], o[5] * rstd * g[5]); w0.w = pk2(o[6] * rstd * g[6], o[7] * rstd * g[7]);
        w1.x = pk2(o[8] * rstd * g[8], o[9] * rstd * g[9]); w1.y = pk2(o[10] * rstd * g[10], o[11] * rstd * g[11]); w1.z = pk2(o[12] * rstd * g[12], o[13] * rstd * g[13]); w1.w = pk2(o[14] * rstd * g[14], o[15] * rstd * g[15]);
        GAS v4u* po = (GAS v4u*)(AO + (size_t)m * 1024 + lane * 16); po[0] = w0; po[1] = w1;
    }
}
template <int LAYER> __device__ __forceinline__ void p_router(Frame& F, const Args& a, const float* xres, int bank = LAYER) {
    typedef float f32x4v __attribute__((ext_vector_type(4)));
    LAS float* part = (LAS float*)(F.lds + RING_OFF);
    LAS float* ssqp = (LAS float*)(F.lds + RING_OFF + 98304);
    LAS float* logit = (LAS float*)(F.lds + RING_OFF + 100352);
    LAS float* rstd_s = (LAS float*)(F.lds + RING_OFF + 109568);
    LAS int* lcnt = (LAS int*)(F.lds + RING_OFF + 109824);
    LAS int* lbase = (LAS int*)(F.lds + RING_OFF + 109952);
    const int lane = F.lane, w = F.wave, row = lane & 15, kg = lane >> 4;
    const bf16x8* wrf = (const bf16x8*)(F.ws + WS_WRF) + (size_t)LAYER * (32 * 3 * 2 * 64);
    bf16x8 Bh[4][3], Bl[4][3];
#pragma unroll
    for (int s = 0; s < 4; ++s)
#pragma unroll
        for (int nt = 0; nt < 3; ++nt) { Bh[s][nt] = wrf[(((4 * w + s) * 3 + nt) * 2 + 0) * 64 + lane]; Bl[s][nt] = wrf[(((4 * w + s) * 3 + nt) * 2 + 1) * 64 + lane]; }
    const float* gffn = a.in[3] + LAYER * 1024; const float* bg = a.in[12] + LAYER * 4; const float* be = a.in[14] + LAYER * 32;
    int* list = (int*)(F.ws + WS_LIST); float* pairw = (float*)(F.ws + WS_PAIRW); bf16* HB = (bf16*)(F.ws + WS_HB);
    for (int tb = F.vcu; tb < TOK / 64; tb += F.G) {
        __syncthreads();
        if (F.tid < 32) lcnt[F.tid] = 0;
        f32x4v acc[4][3];
#pragma unroll
        for (int mt = 0; mt < 4; ++mt)
#pragma unroll
            for (int nt = 0; nt < 3; ++nt) acc[mt][nt] = (f32x4v){0.f, 0.f, 0.f, 0.f};
#pragma unroll
        for (int mt = 0; mt < 4; ++mt) { const float* xr = xres + (size_t)(tb * 64 + mt * 16 + row) * DM + 128 * w + 8 * kg; float ss = 0.f;
#pragma unroll
            for (int s = 0; s < 4; ++s) { const f32x4 x0 = *(const GAS f32x4*)(xr + 32 * s), x1 = *(const GAS f32x4*)(xr + 32 * s + 4);
                const float xv[8] = {x0.x, x0.y, x0.z, x0.w, x1.x, x1.y, x1.z, x1.w}; bf16x8 ah, al;
#pragma unroll
                for (int j = 0; j < 8; ++j) { ss += xv[j] * xv[j]; const unsigned hi = f2bf(xv[j]); ah[j] = (short)hi; al[j] = (short)f2bf(xv[j] - __builtin_bit_cast(float, hi << 16)); }
#pragma unroll
                for (int nt = 0; nt < 3; ++nt) { acc[mt][nt] = __builtin_amdgcn_mfma_f32_16x16x32_bf16(ah, Bh[s][nt], acc[mt][nt], 0, 0, 0);
                    acc[mt][nt] = __builtin_amdgcn_mfma_f32_16x16x32_bf16(ah, Bl[s][nt], acc[mt][nt], 0, 0, 0); acc[mt][nt] = __builtin_amdgcn_mfma_f32_16x16x32_bf16(al, Bh[s][nt], acc[mt][nt], 0, 0, 0); } }
            ss += __shfl_xor(ss, 16); ss += __shfl_xor(ss, 32);
            if (kg == 0) ssqp[w * 64 + mt * 16 + row] = ss;
#pragma unroll
            for (int nt = 0; nt < 3; ++nt)
#pragma unroll
                for (int r = 0; r < 4; ++r) part[(w * 64 + mt * 16 + 4 * kg + r) * 48 + nt * 16 + row] = acc[mt][nt][r]; }
        __syncthreads();
        if (F.tid < 64) { float s = 0.f;
#pragma unroll
            for (int q = 0; q < 8; ++q) s += ssqp[q * 64 + F.tid];
            rstd_s[F.tid] = 1.0f / sqrtf(s * (1.f / 1024.f) + RMS_EPS); }
        __syncthreads();
        for (int idx = F.tid; idx < 64 * 36; idx += 512) { const int tk = idx / 36, o = idx % 36; float s = 0.f;
#pragma unroll
            for (int q = 0; q < 8; ++q) s += part[(q * 64 + tk) * 48 + o];
            logit[tk * 36 + o] = s * rstd_s[tk] + (o < 4 ? bg[o] : be[o - 4]); }
        __syncthreads();
        if (w == 0) {
            const LAS float* lg = logit + lane * 36;
            int gi = 0; float gm = lg[0];
#pragma unroll
            for (int j = 1; j < 4; ++j) { const float v = lg[j]; if (v > gm) { gm = v; gi = j; } }
            float gs = 0.f;
#pragma unroll
            for (int j = 0; j < 4; ++j) gs += __expf(lg[j] - gm);
            const float gp = 1.0f / gs;
            const LAS float* le = lg + 4 + gi * 8;
            int i1 = 0; float v1 = le[0];
#pragma unroll
            for (int j = 1; j < 8; ++j) { const float v = le[j]; if (v > v1) { v1 = v; i1 = j; } }
            int i2 = -1; float v2 = -INFINITY;
#pragma unroll
            for (int j = 0; j < 8; ++j) { const float v = le[j]; if (j != i1 && v > v2) { v2 = v; i2 = j; } }
            const float e2 = __expf(v2 - v1), w1 = gp / (1.0f + e2), w2 = gp * e2 / (1.0f + e2);
            const int e_1 = gi * 8 + i1, e_2 = gi * 8 + i2;
            const int r1 = __hip_atomic_fetch_add(lcnt + e_1, 1, __ATOMIC_RELAXED, __HIP_MEMORY_SCOPE_WORKGROUP);
            const int r2 = __hip_atomic_fetch_add(lcnt + e_2, 1, __ATOMIC_RELAXED, __HIP_MEMORY_SCOPE_WORKGROUP);
            LDS_WAIT();
            if (lane < 32) { const int c = lcnt[lane]; int bs = 0; if (c > 0) bs = (int)__hip_atomic_fetch_add((unsigned*)(F.ctl + CW_CNT + (bank * 32 + lane) * 64), (unsigned)c, RLX_AGENT); lbase[lane] = bs; }
            LDS_WAIT();
            const int tg = tb * 64 + lane; const int p1 = lbase[e_1] + r1, p2 = lbase[e_2] + r2;
            list[e_1 * LISTCAP + p1] = 2 * tg; list[e_2 * LISTCAP + p2] = 2 * tg + 1; pairw[2 * tg] = w1; pairw[2 * tg + 1] = w2;
        }
        for (int i = 0; i < 8; ++i) { const int tk = w * 8 + i, tg = tb * 64 + tk; const float rs = rstd_s[tk];
            const GAS f32x4* xr = (const GAS f32x4*)(xres + (size_t)tg * DM) + lane; const GAS f32x4* gr = (const GAS f32x4*)gffn + lane; GAS unsigned* o4 = (GAS unsigned*)((unsigned char*)HB + (size_t)tg * DM) + lane;
#pragma unroll
            for (int j = 0; j < 4; ++j) { const f32x4 v = xr[64 * j], gg = gr[64 * j]; const float rs8 = rs * H8_SCALE; o4[64 * j] = pk4_fp8f(v.x * rs8 * gg.x, v.y * rs8 * gg.y, v.z * rs8 * gg.z, v.w * rs8 * gg.w); } }
    }
}
template <int LAYER> __device__ __forceinline__ void moe_setup(Frame& F) {
    LAS int* tstart = (LAS int*)(F.lds + LX_TSTART); LAS int* texp = (LAS int*)(F.lds + LX_TEXP); LAS int* lc = (LAS int*)(F.lds + LX_CNT);
    __syncthreads();
    if (F.tid < 32) { int c = (int)__hip_atomic_load((unsigned*)(F.ctl + CW_CNT + (LAYER * 32 + F.tid) * 64), RLX_AGENT); c = c < 0 ? 0 : (c > LISTCAP ? LISTCAP : c); lc[F.tid] = c; }
    __syncthreads();
    if (F.tid == 0) { int acc = 0; for (int e = 0; e < 32; ++e) { tstart[e] = acc; acc += (lc[e] + 255) >> 8; } if (acc > MAXRT) acc = MAXRT; tstart[32] = acc; tstart[33] = acc; }
    __syncthreads();
    if (F.tid < MAXRT) { int e = 0;
#pragma unroll 1
        for (int q = 1; q < 32; ++q) if (tstart[q] <= F.tid) e = q;
        texp[F.tid] = e; }
    __syncthreads();
}
template <int LAYER> __device__ __forceinline__ void p_moe1(Frame& F) {
    moe_setup<LAYER>(F);
    const LAS int* tstart = (const LAS int*)(F.lds + LX_TSTART); const LAS int* texp = (const LAS int*)(F.lds + LX_TEXP); const LAS int* lc = (const LAS int*)(F.lds + LX_CNT);
    LAS int* rowtab = (LAS int*)(F.lds + LX_ROWTAB);
    pg8::MoeOrder S{F.G, F.vcu, 512, 0, tstart, texp};
    const int* list = (const int*)(F.ws + WS_LIST);
    pg8::Unit u;
    for (int i = 0; i < 4 && S.next(i, u); ++i) { if (F.tid < 256) { const int e = u.pn >> 2, pos = u.aux * 256 + F.tid; rowtab[i * 256 + F.tid] = (pos < lc[e]) ? (list[e * LISTCAP + pos] >> 1) : 0; } }
    VM_WAIT(); __syncthreads();
    pg8::Gemm g{(const bf16*)(F.ws + WS_HB), (const bf16*)(F.ws + WS_W1CAT), 512, 512, 512};
    pg8::EpiMoe1 E{(unsigned char*)(F.ws + WS_MACT)};
    pg8::gemm_phase<pg8::EpiMoe1, pg8::MoeOrder, true, true, true>(F.lds + RING_OFF, g, S, E, rowtab);
}
template <int LAYER> __device__ __forceinline__ void p_moe2(Frame& F) {
    moe_setup<LAYER>(F);
    const LAS int* tstart = (const LAS int*)(F.lds + LX_TSTART); const LAS int* texp = (const LAS int*)(F.lds + LX_TEXP); const LAS int* lc = (const LAS int*)(F.lds + LX_CNT);
    pg8::MoeOrder S{F.G, F.vcu, 256, 256 * 256, tstart, texp};
    pg8::Gemm g{(const bf16*)(F.ws + WS_MACT), (const bf16*)(F.ws + WS_W2T), 256, 256, 256};
    pg8::EpiMoe2 E{(bf16*)(F.ws + WS_Y), (const int*)(F.ws + WS_LIST), (const float*)(F.ws + WS_PAIRW), lc};
    pg8::gemm_phase<pg8::EpiMoe2, pg8::MoeOrder, true, false, true>(F.lds + RING_OFF, g, S, E, nullptr);
}
template <bool FINAL> __device__ __forceinline__ void p_combine(Frame& F, float* xres, const float* g, float* dry = nullptr) {
    const int gw = F.vcu * NWAVES + F.wave, NGW = F.G * NWAVES, lane = F.lane;
    const bf16* Y = (const bf16*)(F.ws + WS_Y); bf16* HB = (bf16*)(F.ws + WS_HB);
    for (int m = gw; m < TOK; m += NGW) {
        GAS f32x4* xr = (GAS f32x4*)(xres + (size_t)m * DM) + lane; GAS f32x4* xw = dry ? (GAS f32x4*)(dry + (size_t)m * DM) + lane : xr; const GAS v2u* y0 = (const GAS v2u*)(Y + (size_t)(2 * m) * DM) + lane; const GAS v2u* y1 = (const GAS v2u*)(Y + (size_t)(2 * m + 1) * DM) + lane;
        const GAS f32x4* gr = (const GAS f32x4*)g + lane;
        f32x4 v[4]; float s = 0.f;
#pragma unroll
        for (int j = 0; j < 4; ++j) { const f32x4 x = xr[64 * j]; const v2u p = y0[64 * j], q = y1[64 * j];
            v[j].x = x.x + bflo(p.x) + bflo(q.x); v[j].y = x.y + bfhi(p.x) + bfhi(q.x); v[j].z = x.z + bflo(p.y) + bflo(q.y); v[j].w = x.w + bfhi(p.y) + bfhi(q.y);
            s += (v[j].x * v[j].x + v[j].y * v[j].y) + (v[j].z * v[j].z + v[j].w * v[j].w); }
        const float rstd = 1.0f / sqrtf(wave_sum(s) * (1.f / 1024.f) + RMS_EPS);
        if (FINAL) {
#pragma unroll
            for (int j = 0; j < 4; ++j) { const f32x4 gg = gr[64 * j]; f32x4 o; o.x = v[j].x * rstd * gg.x; o.y = v[j].y * rstd * gg.y; o.z = v[j].z * rstd * gg.z; o.w = v[j].w * rstd * gg.w; xw[64 * j] = o; }
        } else {
            GAS unsigned* o4 = (GAS unsigned*)((dry ? (unsigned char*)(dry + (size_t)TOK * DM) : (unsigned char*)HB) + (size_t)m * DM) + lane; const float r8 = rstd * H8_SCALE;
#pragma unroll
            for (int j = 0; j < 4; ++j) { xw[64 * j] = v[j]; const f32x4 gg = gr[64 * j]; o4[64 * j] = pk4_fp8f(v[j].x * r8 * gg.x, v[j].y * r8 * gg.y, v[j].z * r8 * gg.z, v[j].w * r8 * gg.w); }
        }
    }
}
__device__ __forceinline__ void p_scan(Frame& F) {
    const bf16* DS = (const bf16*)(F.ws + WS_DS); bf16* BT = (bf16*)(F.ws + WS_BTCAT);
    for (int gidx = F.vcu * 512 + F.tid; gidx < NB * RH * 16384; gidx += F.G * 512) {
        const int bh = gidx >> 14, e8 = gidx & 16383, dv = e8 >> 5, dk0 = (e8 & 31) * 8, h = bh & 3;
        const float cd = __builtin_amdgcn_exp2f(256.0f * pg8::log2_gamma(h));
        v4u d[7];
#pragma unroll
        for (int n = 0; n < 7; ++n) d[n] = *(const GAS v4u*)(DS + ((size_t)(bh * RNC + n) * RDV + dv) * RDK + dk0);
        float s[8];
#pragma unroll
        for (int j = 0; j < 8; ++j) s[j] = 0.f;
#pragma unroll
        for (int n = 0; n < 8; ++n) {
            v4u o; o.x = pk2(s[0], s[1]); o.y = pk2(s[2], s[3]); o.z = pk2(s[4], s[5]); o.w = pk2(s[6], s[7]);
            *(GAS v4u*)(BT + ((size_t)(bh * RNC + n) * RDV + dv) * 512 + 256 + dk0) = o;
            if (n < 7) { const unsigned wv[4] = {d[n].x, d[n].y, d[n].z, d[n].w};
#pragma unroll
                for (int j = 0; j < 4; ++j) { s[2 * j] = cd * (s[2 * j] + bflo(wv[j])); s[2 * j + 1] = cd * (s[2 * j + 1] + bfhi(wv[j])); } }
        }
    }
}
__device__ __forceinline__ void p_normgate(Frame& F, bf16* dry = nullptr) {
    const int gw = F.vcu * NWAVES + F.wave, NGW = F.G * NWAVES, lane = F.lane;
    const bf16* OR = (const bf16*)(F.ws + WS_ORET); bf16* SG = (bf16*)(F.ws + WS_SG);
    for (int m = gw; m < TOK; m += NGW) {
        const GAS v4u* po = (const GAS v4u*)(OR + (size_t)m * 2048 + lane * 32); GAS v4u* pg = (GAS v4u*)(SG + (size_t)m * 2048 + lane * 32); GAS v4u* pw = dry ? (GAS v4u*)(dry + (size_t)m * 2048 + lane * 32) : pg;
        v4u ov[4], gv[4]; float ss = 0.f;
#pragma unroll
        for (int q = 0; q < 4; ++q) { ov[q] = po[q]; gv[q] = pg[q]; }
#pragma unroll
        for (int q = 0; q < 4; ++q) { const unsigned wv[4] = {ov[q].x, ov[q].y, ov[q].z, ov[q].w};
#pragma unroll
            for (int j = 0; j < 4; ++j) { const float x0 = bflo(wv[j]), x1 = bfhi(wv[j]); ss += x0 * x0 + x1 * x1; } }
        ss += __shfl_xor(ss, 1); ss += __shfl_xor(ss, 2); ss += __shfl_xor(ss, 4); ss += __shfl_xor(ss, 8);
        const float rstd = 1.0f / sqrtf(ss * (1.f / 512.f) + RMS_EPS);
#pragma unroll
        for (int q = 0; q < 4; ++q) { const unsigned wv[4] = {ov[q].x, ov[q].y, ov[q].z, ov[q].w}, wg[4] = {gv[q].x, gv[q].y, gv[q].z, gv[q].w}; unsigned r[4];
#pragma unroll
            for (int j = 0; j < 4; ++j) r[j] = pk2(bflo(wv[j]) * rstd * bflo(wg[j]), bfhi(wv[j]) * rstd * bfhi(wg[j]));
            v4u o; o.x = r[0]; o.y = r[1]; o.z = r[2]; o.w = r[3]; pw[q] = o; }
    }
}
__device__ __forceinline__ void p_conv_moe1(Frame& F, const Args& a) {
    LAS float* scr = (LAS float*)(F.lds + RING_OFF + F.wave * 16384);
    const int gw = F.vcu * NWAVES + F.wave, NGW = F.G * NWAVES;
    for (int it = gw; it < IT_MOE; it += NGW) conv_moe_item(F, a, 1, it, scr);
}

constexpr int N_PHASES = 19;
#ifndef MK_PER_PHASE
#define MK_PER_PHASE 0
#endif
__global__ void __launch_bounds__(NWAVES * 64, 2) hybrid_fwd(Args args) {
    extern __shared__ __attribute__((aligned(16))) unsigned char lds[];
    Frame F;
    F.lds = (LAS unsigned char*)lds;
    F.tid = threadIdx.x; F.lane = F.tid & 63; F.wave = __builtin_amdgcn_readfirstlane(F.tid >> 6);
    F.G = gridDim.x; { const int bx = blockIdx.x; F.vcu = (F.G % 8 == 0) ? (bx % 8) * (F.G / 8) + bx / 8 : bx; }
    F.ws = args.ws; F.ctl = (gu32*)(args.ws + WS_CTL);
    for (int u = F.tid; u < (LDS_BYTES - LX_OFF) / 4; u += NWAVES * 64) ((LAS unsigned*)(F.lds + LX_OFF))[u] = 0u;
    __syncthreads();
    XcdBarrier bar; bar.bar = (unsigned*)(F.ctl + CW_BAR); bar.x = 0; bar.st = nullptr;
    if (!MK_PER_PHASE) bar = xcd_barrier_post((unsigned*)(F.ctl + CW_BAR), (volatile LAS unsigned*)(F.lds + LX_MISC) + 8);
    const int lo = args.ph_lo, hi = args.ph_hi;
#ifndef PH_MASK
#define PH_MASK 0x7ffff
#endif
#define IN(k) (((PH_MASK >> (k)) & 1) && lo <= (k) && (k) < hi)
#define SEAM(k) do { if (IN(k) && IN((k) + 1)) xcd_barrier(bar); } while (0)
#define REFRESH() do { int t_ = threadIdx.x; asm volatile("" : "+v"(t_)); F.tid = t_; F.lane = t_ & 63; } while (0)
#ifndef DUP_MASK
#define DUP_MASK 0
#endif
#ifndef XBAR_N
#define XBAR_N 0
#endif
#define DUP(k) (((DUP_MASK >> (k)) & 1) != 0)
    float* xres = args.out;
    unsigned char* ws = args.ws;
    const int bx = (int)blockIdx.x;

    if (IN(0)) { REFRESH(); p_prologue(F, args); if (DUP(0)) { xcd_barrier(bar); p_prologue(F, args); } for (int q = 0; q < XBAR_N; ++q) xcd_barrier(bar); } SEAM(0);
    if (IN(1)) { REFRESH(); for (int rep_ = 0; rep_ < (DUP(1) ? 2 : 1); ++rep_) { if (rep_) xcd_barrier(bar);
        constexpr int KQ = QKV_FP8 ? 512 : 1024; pg8::Gemm g{(const bf16*)(ws + WS_HB), (const bf16*)(ws + WS_WINT0), KQ, KQ, KQ}; pg8::StaticOrder S; S.init(TOK, 3072, F.G, bx, KQ, KQ);
        pg8::EpiQKV E{(bf16*)(ws + WS_QKV0), ATT_C2};
        pg8::gemm_phase<pg8::EpiQKV, pg8::StaticOrder, true, false, (QKV_FP8 != 0)>(F.lds + RING_OFF, g, S, E, nullptr);
    }
    } SEAM(1);
    if (IN(2)) { REFRESH(); p_attention(F, args); if (DUP(2)) { xcd_barrier(bar); p_attention(F, args); } } if (IN(2) && IN(4)) xcd_barrier(bar);
    if (IN(4)) { REFRESH(); for (int rep_ = 0; rep_ < (DUP(4) ? 2 : 1); ++rep_) { if (rep_) xcd_barrier(bar);
        pg8::Gemm g{(const bf16*)(ws + WS_AO), (const bf16*)(ws + WS_WOUTT0), 1024, 1024, 1024}; pg8::StaticOrder S; S.init(TOK, 1024, F.G, bx, 1024, 1024);
        pg8::EpiRes E{args.in[0], xres};
        pg8::gemm_phase<pg8::EpiRes, pg8::StaticOrder, true, false>(F.lds + RING_OFF, g, S, E, nullptr);
    }
    } SEAM(4);
    if (IN(5)) { REFRESH(); p_router<0>(F, args, xres); if (DUP(5)) { xcd_barrier(bar); p_router<0>(F, args, xres, 2); } } SEAM(5);
    if (IN(6)) { REFRESH(); p_moe1<0>(F); if (DUP(6)) { xcd_barrier(bar); p_moe1<0>(F); } } SEAM(6);
    if (IN(7)) { REFRESH(); p_moe2<0>(F); if (DUP(7)) { xcd_barrier(bar); p_moe2<0>(F); } } SEAM(7);
    if (IN(8)) { REFRESH(); if (DUP(8)) { p_combine<false>(F, xres, args.in[2] + 1024, (float*)(ws + WS_KI)); xcd_barrier(bar); } p_combine<false>(F, xres, args.in[2] + 1024); } SEAM(8);
    if (IN(9)) { REFRESH(); for (int rep_ = 0; rep_ < (DUP(9) ? 2 : 1); ++rep_) { if (rep_) xcd_barrier(bar);
        { pg8::Gemm g{(const bf16*)(ws + WS_HB), (const bf16*)(ws + WS_WRINA), 512, 512, 512}; pg8::StaticOrder S; S.init(TOK, 4096, F.G, bx, 512, 512);
          pg8::EpiRetA E{(bf16*)(ws + WS_ACAT), (bf16*)(ws + WS_KI), (bf16*)(ws + WS_SG), (const float*)(ws + WS_SINCOS)};
          pg8::gemm_phase<pg8::EpiRetA, pg8::StaticOrder, true, false, true>(F.lds + RING_OFF, g, S, E, nullptr); }
        { pg8::Gemm g{(const bf16*)(ws + WS_WRINB), (const bf16*)(ws + WS_HB), 512, 512, 512}; pg8::StaticOrder S; S.init(3072, TOK, F.G, bx, 512, 512);
          pg8::EpiRetB E{(bf16*)(ws + WS_KIT), (bf16*)(ws + WS_BTCAT), (const float*)(ws + WS_SINCOST)};
          pg8::gemm_phase<pg8::EpiRetB, pg8::StaticOrder, true, false, true>(F.lds + RING_OFF, g, S, E, nullptr); }
    }
    } SEAM(9);
    if (IN(10)) { REFRESH(); for (int rep_ = 0; rep_ < (DUP(10) ? 2 : 1); ++rep_) { if (rep_) xcd_barrier(bar);
        { pg8::Gemm g{(const bf16*)(ws + WS_ACAT), (const bf16*)(ws + WS_KI), 512, 1024, 256}; pg8::ScoresOrder S{F.G, F.vcu};
          pg8::EpiScores E{(bf16*)(ws + WS_ACAT)};
          pg8::gemm_phase<pg8::EpiScores, pg8::ScoresOrder, true, false>(F.lds + RING_OFF, g, S, E, nullptr); }
        { pg8::Gemm g{(const bf16*)(ws + WS_BTCAT), (const bf16*)(ws + WS_KIT), 512, 2048, 256}; pg8::DsOrder S{F.G, F.vcu};
          pg8::EpiDS E{(bf16*)(ws + WS_DS)};
          pg8::gemm_phase<pg8::EpiDS, pg8::DsOrder, true, false>(F.lds + RING_OFF, g, S, E, nullptr); }
    }
    } SEAM(10);
    if (IN(11)) { REFRESH(); p_scan(F); if (DUP(11)) { xcd_barrier(bar); p_scan(F); } } SEAM(11);
    if (IN(12)) { REFRESH(); for (int rep_ = 0; rep_ < (DUP(12) ? 2 : 1); ++rep_) { if (rep_) xcd_barrier(bar);
        pg8::Gemm g{(const bf16*)(ws + WS_ACAT), (const bf16*)(ws + WS_BTCAT), 512, 512, 512}; pg8::RetOOrder S{F.G, F.vcu};
        pg8::EpiRetO E{(bf16*)(ws + WS_ORET), (bf16*)(ws + WS_SG), (LAS float*)(F.lds + LX_SSQ)};
        pg8::gemm_phase<pg8::EpiRetO, pg8::RetOOrder, true, false>(F.lds + RING_OFF, g, S, E, nullptr);
    }
    } if (IN(12) && IN(14)) xcd_barrier(bar);
    if (IN(14)) { REFRESH(); for (int rep_ = (DUP(14) ? 0 : 1); rep_ < 2; ++rep_) { if (rep_ && DUP(14)) xcd_barrier(bar);
        pg8::Gemm g{(const bf16*)(ws + WS_SG), (const bf16*)(ws + WS_WROUTT), 2048, 2048, 2048}; pg8::StaticOrder S; S.init(TOK, 1024, F.G, bx, 2048, 2048);
        pg8::EpiRes E{xres, rep_ ? xres : (float*)(ws + WS_ACAT)};
        pg8::gemm_phase<pg8::EpiRes, pg8::StaticOrder, true, false>(F.lds + RING_OFF, g, S, E, nullptr);
    }
    } SEAM(14);
    if (IN(15)) { REFRESH(); p_router<1>(F, args, xres); __syncthreads(); p_conv_moe1(F, args); if (DUP(15)) { xcd_barrier(bar); p_router<1>(F, args, xres, 3); __syncthreads(); p_conv_moe1(F, args); } } SEAM(15);
    if (IN(16)) { REFRESH(); p_moe1<1>(F); } SEAM(16);
    if (IN(17)) { REFRESH(); p_moe2<1>(F); } SEAM(17);
    if (IN(18)) { REFRESH(); if (DUP(18)) { p_combine<true>(F, xres, args.in[4], (float*)(ws + WS_KI)); xcd_barrier(bar); } p_combine<true>(F, xres, args.in[4]); }
#undef IN
#undef SEAM
}

extern "C" void kernel_launch(void* const* d_in, const int* in_sizes, int n_in, void* d_out, int out_size, void* d_ws, size_t ws_size, hipStream_t stream) {
    static int grid = 0;
    if (grid == 0) {
        if (n_in != 18 || in_sizes[0] != TOK * DM || out_size != TOK * DM || ws_size < WS_END) { fprintf(stderr, "kernel_launch: unexpected shapes / workspace (n_in %d, in0 %d, out %d, ws %zu < %zu); nothing launched\n", n_in, n_in > 0 ? in_sizes[0] : -1, out_size, ws_size, (size_t)WS_END); grid = -1; return; }
        int dev = 0, cus = 0, per_cu = 0;
        if (hipGetDevice(&dev) != hipSuccess || hipDeviceGetAttribute(&cus, hipDeviceAttributeMultiprocessorCount, dev) != hipSuccess) { grid = -1; return; }
        if (hipFuncSetAttribute((const void*)hybrid_fwd, hipFuncAttributeMaxDynamicSharedMemorySize, LDS_BYTES) != hipSuccess) { fprintf(stderr, "kernel_launch: hipFuncSetAttribute failed\n"); grid = -1; return; }
        if (hipOccupancyMaxActiveBlocksPerMultiprocessor(&per_cu, (const void*)hybrid_fwd, NWAVES * 64, LDS_BYTES) != hipSuccess || per_cu < 1) { fprintf(stderr, "kernel_launch: occupancy query says %d\n", per_cu); }
        (void)hipGetLastError();
        grid = cus > 256 ? 256 : cus;
    }
    if (grid < 0) return;
    if (hipMemsetAsync((char*)d_ws + WS_CTL, 0, CTL_ZERO_BYTES, stream) != hipSuccess) return;
    Args a{};
    for (int i = 0; i < 18; ++i) a.in[i] = (const float*)d_in[i];
    a.out = (float*)d_out; a.ws = (unsigned char*)d_ws; a.pad = 0;
#if MK_PER_PHASE
    for (int p = 0; p < N_PHASES; ++p) { a.ph_lo = p; a.ph_hi = p + 1; a.li = p; hipLaunchKernelGGL(hybrid_fwd, dim3(grid), dim3(NWAVES * 64), LDS_BYTES, stream, a); }
#else
    a.ph_lo = 0; a.ph_hi = N_PHASES; a.li = 0;
    hipLaunchKernelGGL(hybrid_fwd, dim3(grid), dim3(NWAVES * 64), LDS_BYTES, stream, a);
#endif
}
```

```cpp
#include <hip/hip_runtime.h>
#include <hip/hip_bf16.h>
#include <cstdio>
#include <cstdint>

#define LAS __attribute__((address_space(3)))
#define GAS __attribute__((address_space(1)))

namespace pg8 {
typedef unsigned short bf16_t;
typedef short bf16x8 __attribute__((ext_vector_type(8)));
typedef float f32x4 __attribute__((ext_vector_type(4)));
typedef float f32x2 __attribute__((ext_vector_type(2)));
typedef unsigned u32x4 __attribute__((ext_vector_type(4)));
typedef unsigned u32x2 __attribute__((ext_vector_type(2)));
constexpr int BM = 256, BK = 64, HALF = 128, HTB = HALF * BK * 2, STAGE_BYTES = 8 * HTB, NXCD = 8, WGM = 8;

__host__ __device__ __forceinline__ int lds_byte(int r, int c) { const int st = (r >> 4) * 2 + (c >> 5), rr = r & 15, cc = c & 31, ob = rr * 64 + cc * 2; return st * 1024 + (ob ^ (((ob >> 9) & 1) << 5)); }
__host__ __device__ __forceinline__ void stage_rc(int b, int& R, int& C) { const int st = b / 1024, sb = b % 1024, swz = sb ^ (((sb >> 9) & 1) << 5); R = (st >> 1) * 16 + swz / 64; C = (st & 1) * 32 + (swz % 64) / 2; }
__host__ __device__ __forceinline__ int perm32(int rho) { const int n = rho >> 4, i = rho & 15; return 8 * (i >> 2) + 4 * n + (i & 3); }

struct Unit { int pm, pn, aux; long aoff, boff; };
struct Gemm { const bf16_t* A; const bf16_t* Bt; int lda, ldb, K; };

struct StaticOrder {
    int nM, nN, nwg, G, c, lda, ldb;
    __device__ void init(int M, int N, int G_, int c_, int lda_, int ldb_) { nM = M / BM; nN = N / BM; nwg = nM * nN; G = G_; c = c_; lda = lda_; ldb = ldb_; }
    __device__ bool next(int i, Unit& u) const {
        const long L = (long)i * G + c; if (L >= nwg) return false;
        int wgid = (int)L; { const int q = nwg / NXCD, r = nwg % NXCD, xcd = wgid % NXCD, off = wgid / NXCD; wgid = (xcd < r ? xcd * (q + 1) : r * (q + 1) + (xcd - r) * q) + off; }
        const int nig = WGM * nN, gid = wgid / nig, fm = gid * WGM, gsz = (nM - fm) < WGM ? (nM - fm) : WGM;
        u.pm = fm + ((wgid % nig) % gsz); u.pn = (wgid % nig) / gsz; u.aux = 0;
        u.aoff = (long)u.pm * BM * lda; u.boff = (long)u.pn * BM * ldb; return true;
    }
};

__device__ __forceinline__ unsigned cvt_pk_bf16(float lo, float hi) { unsigned r; asm volatile("v_cvt_pk_bf16_f32 %0, %1, %2" : "=v"(r) : "v"(lo), "v"(hi)); return r; }
__device__ __forceinline__ u32x4 pack8(const f32x4 v0, const f32x4 v1) { u32x4 w; w.x = cvt_pk_bf16(v0[0], v0[1]); w.y = cvt_pk_bf16(v0[2], v0[3]); w.z = cvt_pk_bf16(v1[0], v1[1]); w.w = cvt_pk_bf16(v1[2], v1[3]); return w; }

typedef int v4i_t __attribute__((ext_vector_type(4)));
typedef int v8i_t __attribute__((ext_vector_type(8)));
__device__ __forceinline__ v8i_t cat8(const bf16x8 a, const bf16x8 b) { const v4i_t x = __builtin_bit_cast(v4i_t, a), y = __builtin_bit_cast(v4i_t, b); return __builtin_shufflevector(x, y, 0, 1, 2, 3, 4, 5, 6, 7); }
template <class Epi, class Sched, bool ALIGN_EPI, bool GATHER, bool FP8 = false>
__device__ __forceinline__ void gemm_phase(LAS unsigned char* lds, const Gemm g, const Sched& S, const Epi& E, const LAS int* rowtab) {
    int tid_ = threadIdx.x; asm volatile("" : "+v"(tid_));
    const int tid = tid_, wid = __builtin_amdgcn_readfirstlane(tid >> 6), lane = tid & 63, wr = wid >> 2, wc = wid & 3, fr = lane & 15, fq = lane >> 4;
    const int K = g.K, nt = K / BK;
    int sR[2], sC[2]; unsigned voffB[2];
#pragma unroll
    for (int i = 0; i < 2; ++i) { int R, C; stage_rc(tid * 16 + i * 8192, R, C); sR[i] = R; sC[i] = C; const int Rb = Epi::PERM ? ((R & ~31) + perm32(R & 31)) : R; voffB[i] = (unsigned)(Rb * g.ldb + C) * 2u; }
    unsigned avo[2][2], navo[2][2];
#define PG8_SETOFF(o, ui_) do { _Pragma("unroll") for (int h_ = 0; h_ < 2; ++h_) _Pragma("unroll") for (int i_ = 0; i_ < 2; ++i_) { const int row_ = h_ * HALF + sR[i_]; \
        const int grow_ = GATHER ? rowtab[(ui_) * BM + row_] : row_; o[h_][i_] = (unsigned)(grow_ * g.lda + sC[i_]) * 2u; } } while (0)
    const size_t kstep = (size_t)(BK * 2);
    const size_t hstepB = (size_t)HALF * g.ldb * 2;
    const unsigned ldsw = (unsigned)wid * 1024u;
    const int aoff = lds_byte(wr * 64 + fr, fq * 8), boff = lds_byte(wc * 32 + fr, fq * 8);
#define PG8_SA(b, h) (((b) * 2 + (h)) * HTB)
#define PG8_SB(b, h) ((4 + (b) * 2 + (h)) * HTB)
#define PG8_STAGE(bufoff, gbase, voff) do { _Pragma("unroll") for (int _i = 0; _i < 2; ++_i) \
        __builtin_amdgcn_global_load_lds((const unsigned*)((const char*)(gbase) + (voff)[_i]), (LAS unsigned*)(lds + (bufoff) + ldsw + _i * 8192), 16, 0, 0); } while (0)
#define PG8_LD8(dst8, addr_) do { const v4i_t lo_ = *(const LAS v4i_t*)(addr_), hi_ = *(const LAS v4i_t*)((addr_) + 1024); dst8 = __builtin_shufflevector(lo_, hi_, 0, 1, 2, 3, 4, 5, 6, 7); } while (0)
#define PG8_LDA(dst, b, h) do { _Pragma("unroll") for (int m = 0; m < 4; ++m) { if constexpr (FP8) { PG8_LD8(dst##8[m], lds + PG8_SA(b, h) + aoff + m * 2048); } else { _Pragma("unroll") for (int k = 0; k < 2; ++k) dst[m][k] = *(const LAS bf16x8*)(lds + PG8_SA(b, h) + aoff + m * 2048 + k * 1024); } } } while (0)
#define PG8_LDB(dst, b, h) do { _Pragma("unroll") for (int n = 0; n < 2; ++n) { if constexpr (FP8) { PG8_LD8(dst##8[n], lds + PG8_SB(b, h) + boff + n * 2048); } else { _Pragma("unroll") for (int k = 0; k < 2; ++k) dst[n][k] = *(const LAS bf16x8*)(lds + PG8_SB(b, h) + boff + n * 2048 + k * 1024); } } } while (0)
#define PG8_MMA(ai, bj, At, Bt) do { __builtin_amdgcn_s_setprio(1); _Pragma("unroll") for (int m = 0; m < 4; ++m) _Pragma("unroll") for (int n = 0; n < 2; ++n) { \
        if constexpr (FP8) asm volatile("v_mfma_scale_f32_16x16x128_f8f6f4 %0, %1, %2, %0, %3, %3 op_sel_hi:[0,0,0]" : "+v"(acc[ai][bj][m][n]) : "v"(Bt##8[n]), "v"(At##8[m]), "v"(sc1)); \
        else { _Pragma("unroll") for (int k = 0; k < 2; ++k) acc[ai][bj][m][n] = __builtin_amdgcn_mfma_f32_16x16x32_bf16(Bt[n][k], At[m][k], acc[ai][bj][m][n], 0, 0, 0); } } \
        __builtin_amdgcn_s_setprio(0); } while (0)
#define PG8_WAIT_V(n) asm volatile("s_waitcnt vmcnt(" #n ")" ::: "memory")
#define PG8_WAIT_L(n) asm volatile("s_waitcnt lgkmcnt(" #n ")" ::: "memory")
#define PG8_BAR __builtin_amdgcn_s_barrier()
#define PG8_SCHED __builtin_amdgcn_sched_barrier(0)
    unsigned sc1 = 0; if constexpr (FP8) asm volatile("v_mov_b32 %0, 0x7f7f7f7f\n\ts_nop 4" : "=v"(sc1));
    Unit cur, nxt; int ui = 0;
    if (!S.next(0, cur)) return;
    f32x4 acc[2][2][4][2];
#pragma unroll
    for (int a = 0; a < 2; ++a)
#pragma unroll
        for (int b = 0; b < 2; ++b)
#pragma unroll
            for (int m = 0; m < 4; ++m)
#pragma unroll
                for (int n = 0; n < 2; ++n) acc[a][b][m][n] = (f32x4){0.f, 0.f, 0.f, 0.f};
    bf16x8 At[4][2], B0[2][2], B1[2][2]; v8i_t At8[4], B08[2], B18[2];
    const char* cA = (const char*)g.A + cur.aoff * 2; const char* cB = (const char*)g.Bt + cur.boff * 2;
    PG8_SETOFF(avo, 0);
    PG8_STAGE(PG8_SB(0, 0), cB, voffB); PG8_STAGE(PG8_SB(0, 1), cB + hstepB, voffB); PG8_STAGE(PG8_SA(0, 0), cA, avo[0]); PG8_STAGE(PG8_SA(0, 1), cA, avo[1]);
    if (wr == 1) PG8_BAR;
    PG8_WAIT_V(2); PG8_BAR;
    PG8_STAGE(PG8_SB(1, 0), cB + kstep, voffB); PG8_STAGE(PG8_SA(1, 0), cA + kstep, avo[0]); PG8_STAGE(PG8_SB(1, 1), cB + hstepB + kstep, voffB);
    PG8_WAIT_V(6); PG8_BAR;
    for (;;) {
        const bool has_next = S.next(ui + 1, nxt);
        const char* nA = has_next ? (const char*)g.A + nxt.aoff * 2 : cA; const char* nB = has_next ? (const char*)g.Bt + nxt.boff * 2 : cB;
        if (GATHER && has_next) { PG8_SETOFF(navo, ui + 1); }
        else {
#pragma unroll
            for (int h_ = 0; h_ < 2; ++h_)
#pragma unroll
                for (int i_ = 0; i_ < 2; ++i_) navo[h_][i_] = avo[h_][i_]; }
#pragma nounroll
        for (int t = 0; t < nt; t += 2) {
            const bool last = (t == nt - 2);
            const char* a1 = cA + (size_t)(t + 1) * kstep;
            const char* a2 = last ? nA : cA + (size_t)(t + 2) * kstep; const char* b2 = last ? nB : cB + (size_t)(t + 2) * kstep;
            const char* a3 = a2 + kstep; const char* b3 = b2 + kstep;
            unsigned o2[2][2];
#pragma unroll
            for (int h_ = 0; h_ < 2; ++h_)
#pragma unroll
                for (int i_ = 0; i_ < 2; ++i_) o2[h_][i_] = (GATHER && last) ? navo[h_][i_] : avo[h_][i_];
            PG8_LDB(B0, 0, 0); PG8_LDB(B1, 0, 1); PG8_SCHED; PG8_LDA(At, 0, 0); PG8_STAGE(PG8_SA(1, 1), a1, avo[1]);
            PG8_WAIT_V(8); PG8_WAIT_L(0); PG8_BAR; PG8_MMA(0, 0, At, B0); PG8_MMA(0, 1, At, B1); PG8_BAR; PG8_SCHED;
            PG8_LDA(At, 0, 1); PG8_STAGE(PG8_SB(0, 0), b2, voffB); PG8_STAGE(PG8_SB(0, 1), b2 + hstepB, voffB); PG8_STAGE(PG8_SA(0, 0), a2, o2[0]);
            PG8_WAIT_V(8); PG8_WAIT_L(0); PG8_BAR; PG8_MMA(1, 0, At, B0); PG8_MMA(1, 1, At, B1); PG8_BAR; PG8_SCHED;
            PG8_LDB(B0, 1, 0); PG8_LDB(B1, 1, 1); PG8_SCHED; PG8_LDA(At, 1, 0); PG8_STAGE(PG8_SA(0, 1), a2, o2[1]);
            PG8_WAIT_V(8); PG8_WAIT_L(0); PG8_BAR; PG8_MMA(0, 0, At, B0); PG8_MMA(0, 1, At, B1); PG8_BAR; PG8_SCHED;
            PG8_LDA(At, 1, 1); PG8_STAGE(PG8_SB(1, 0), b3, voffB); PG8_STAGE(PG8_SB(1, 1), b3 + hstepB, voffB); PG8_STAGE(PG8_SA(1, 0), a3, o2[0]);
            PG8_WAIT_V(8); PG8_WAIT_L(0); PG8_BAR; PG8_MMA(1, 0, At, B0); PG8_MMA(1, 1, At, B1); PG8_BAR; PG8_SCHED;
        }
        if constexpr (ALIGN_EPI) { if (wr == 0) PG8_BAR; }
        if constexpr (FP8) asm volatile("s_nop 15\n\ts_nop 3" ::: "memory");
        { int efr = fr, efq = fq; asm volatile("" : "+v"(efr), "+v"(efq)); E(acc, cur, wr, wc, efr, efq); }
        if (!has_next) break;
#pragma unroll
        for (int a = 0; a < 2; ++a)
#pragma unroll
            for (int b = 0; b < 2; ++b)
#pragma unroll
                for (int m = 0; m < 4; ++m)
#pragma unroll
                    for (int n = 0; n < 2; ++n) acc[a][b][m][n] = (f32x4){0.f, 0.f, 0.f, 0.f};
        cur = nxt; cA = nA; cB = nB; ++ui;
#pragma unroll
        for (int h_ = 0; h_ < 2; ++h_)
#pragma unroll
            for (int i_ = 0; i_ < 2; ++i_) avo[h_][i_] = navo[h_][i_];
        if constexpr (ALIGN_EPI) { if (wr == 1) PG8_BAR; }
    }
    PG8_WAIT_V(0);
    if constexpr (!ALIGN_EPI) { if (wr == 0) PG8_BAR; }
    PG8_BAR;
#undef PG8_SETOFF
#undef PG8_SA
#undef PG8_SB
#undef PG8_STAGE
#undef PG8_LDA
#undef PG8_LDB
#undef PG8_MMA
#undef PG8_WAIT_V
#undef PG8_WAIT_L
#undef PG8_BAR
#undef PG8_SCHED
}
}
constexpr int NB = 8, SEQ = 2048, DM = 1024, TOK = NB * SEQ;
constexpr int AH = 8;
constexpr int RH = 4, RDK = 256, RDV = 512, RC = 256, RNC = SEQ / RC;
constexpr int NEXP = 32, EFF = 512, NPAIR = 2 * TOK, LISTCAP = TOK;
constexpr int MAXRT = NPAIR / 256 + NEXP;
constexpr float RMS_EPS = 1e-6f, SUBLN_EPS = 1e-5f, LOG2E = 1.4426950408889634f;
#ifndef QKV_FP8
#define QKV_FP8 0
#endif
#ifndef RIN_FP8
#define RIN_FP8 1
#endif
constexpr float WIN_SCALE = 64.f, IN_DESCALE = 1.0f / (16.f * 64.f);
constexpr float H8_SCALE = 16.f, W1_SCALE = 64.f, ACT_SCALE = 8.f, W2_SCALE = 32.f;
constexpr float ATT_C2 = 0.125f * LOG2E;

constexpr size_t MiB = 1u << 20;
constexpr size_t WS_CTL = 0, CTL_ZERO_BYTES = 1 * MiB;
constexpr size_t WS_LIST = 1 * MiB;
constexpr size_t WS_PAIRW = 3 * MiB;
constexpr size_t WS_WRF = 3 * MiB + 512 * 1024;
constexpr size_t WS_SINCOS = 4 * MiB;
constexpr size_t WS_SINCOST = 6 * MiB;
constexpr size_t WS_WINT0 = 8 * MiB;
constexpr size_t WS_WOUTT0 = 14 * MiB;
constexpr size_t WS_WRINA = 16 * MiB;
constexpr size_t WS_WRINB = 24 * MiB;
constexpr size_t WS_WROUTT = 30 * MiB;
constexpr size_t WS_W1CAT = 34 * MiB;
constexpr size_t WS_W2T = 98 * MiB;
constexpr size_t WS_DS = 34 * MiB;
constexpr size_t WS_ORET = 34 * MiB;
constexpr size_t WS_HB = 130 * MiB;
constexpr size_t WS_ACTBASE = 162 * MiB;
constexpr size_t WS_QKV0 = WS_ACTBASE;
constexpr size_t WS_OP = WS_ACTBASE + 96 * MiB;
constexpr size_t WS_AO = WS_ACTBASE + 160 * MiB;
constexpr size_t WS_MACT = WS_ACTBASE;
constexpr size_t WS_Y = WS_ACTBASE + 40 * MiB;
constexpr size_t WS_ACAT = WS_ACTBASE;
constexpr size_t WS_BTCAT = WS_ACTBASE + 64 * MiB;
constexpr size_t WS_KI = WS_ACTBASE + 192 * MiB;
constexpr size_t WS_KIT = WS_ACTBASE + 224 * MiB;
constexpr size_t WS_SG = WS_ACTBASE + 256 * MiB;
constexpr size_t WS_END = WS_ACTBASE + 320 * MiB;
constexpr int CW_TMO = 0, CW_BAR = 4096, CW_CNT = 16384;

constexpr int RING_OFF = 0, RING_BYTES = 131072;
constexpr int LX_OFF = RING_BYTES;
constexpr int LX_MISC = LX_OFF + 320;
constexpr int LX_ROWTAB = LX_OFF + 1024;
constexpr int LX_TSTART = LX_OFF + 5120;
constexpr int LX_TEXP = LX_OFF + 5376;
constexpr int LX_LUT = LX_OFF + 10240;
constexpr int LX_CNT = LX_OFF + 7168;
constexpr int LX_SSQ = LX_OFF + 8192;
constexpr int LDS_BYTES = 147456;

namespace pg8 {
struct EpiQKV {
    static constexpr bool PERM = true;
    bf16_t* O; float qscale;
    __device__ __forceinline__ void operator()(const f32x4 (&acc)[2][2][4][2], const Unit& u, int wr, int wc, int fr, int fq) const {
        const int row0 = u.pm * BM + wr * 64 + fr, col0 = u.pn * BM + wc * 32 + 8 * fq; const float sc = ((u.pn < 4) ? qscale : 1.f) * (QKV_FP8 ? IN_DESCALE : 1.f);
#pragma unroll
        for (int ai = 0; ai < 2; ++ai)
#pragma unroll
            for (int m = 0; m < 4; ++m) { bf16_t* rowp = O + (size_t)(row0 + ai * HALF + m * 16) * 3072 + col0;
#pragma unroll
                for (int bj = 0; bj < 2; ++bj) *(u32x4*)(rowp + bj * HALF) = pack8(acc[ai][bj][m][0] * sc, acc[ai][bj][m][1] * sc); }
    }
};
struct EpiRes {
    static constexpr bool PERM = false;
    const float* res; float* out;
    __device__ __forceinline__ void operator()(const f32x4 (&acc)[2][2][4][2], const Unit& u, int wr, int wc, int fr, int fq) const {
        const int row0 = u.pm * BM + wr * 64 + fr, col0 = u.pn * BM + wc * 32 + 4 * fq;
#pragma unroll
        for (int ai = 0; ai < 2; ++ai)
#pragma unroll
            for (int m = 0; m < 4; ++m) { const size_t off = (size_t)(row0 + ai * HALF + m * 16) * 1024 + col0;
#pragma unroll
                for (int bj = 0; bj < 2; ++bj)
#pragma unroll
                    for (int n = 0; n < 2; ++n) { const f32x4 r = *(const f32x4*)(res + off + bj * HALF + n * 16); *(f32x4*)(out + off + bj * HALF + n * 16) = r + acc[ai][bj][m][n]; }
                asm volatile("" ::: "memory"); }
    }
};
__device__ __forceinline__ float silu_f(float x) { return x * __builtin_amdgcn_rcpf(1.0f + __builtin_amdgcn_exp2f(-x * LOG2E)); }
__device__ __forceinline__ unsigned pk4_fp8(float a, float b, float c, float d) { int w = 0; w = __builtin_amdgcn_cvt_pk_fp8_f32(a, b, w, false); w = __builtin_amdgcn_cvt_pk_fp8_f32(c, d, w, true); return (unsigned)w; }
struct EpiMoe1 {
    static constexpr bool PERM = true;
    unsigned char* ACT;
    __device__ __forceinline__ void operator()(const f32x4 (&acc)[2][2][4][2], const Unit& u, int wr, int wc, int fr, int fq) const {
        const int row0 = u.pm * BM + wr * 64 + fr, col0 = (u.pn & 3) * 128 + wc * 32 + 8 * fq; constexpr float si = 1.0f / (H8_SCALE * W1_SCALE);
#pragma unroll
        for (int ai = 0; ai < 2; ++ai)
#pragma unroll
            for (int m = 0; m < 4; ++m) { f32x4 a0, a1;
#pragma unroll
                for (int j = 0; j < 4; ++j) { a0[j] = silu_f(acc[ai][0][m][0][j] * si) * acc[ai][1][m][0][j] * (si * ACT_SCALE); a1[j] = silu_f(acc[ai][0][m][1][j] * si) * acc[ai][1][m][1][j] * (si * ACT_SCALE); }
                u32x2 w; w.x = pk4_fp8(a0[0], a0[1], a0[2], a0[3]); w.y = pk4_fp8(a1[0], a1[1], a1[2], a1[3]);
                *(u32x2*)(ACT + (size_t)(row0 + ai * HALF + m * 16) * 512 + col0) = w; }
    }
};
struct EpiMoe2 {
    static constexpr bool PERM = true;
    bf16_t* Y; const int* list; const float* pairw; const LAS int* lcnt;
    __device__ __forceinline__ void operator()(const f32x4 (&acc)[2][2][4][2], const Unit& u, int wr, int wc, int fr, int fq) const {
        const int e = u.pn >> 2, col0 = (u.pn & 3) * BM + wc * 32 + 8 * fq, pos0 = u.aux * BM + wr * 64 + fr, cn = lcnt[e];
#pragma unroll
        for (int ai = 0; ai < 2; ++ai)
#pragma unroll
            for (int m = 0; m < 4; ++m) { const int pos = pos0 + ai * HALF + m * 16;
                if (pos < cn) { const int pair = list[e * LISTCAP + pos]; const float w = pairw[pair] * (1.0f / (ACT_SCALE * W2_SCALE)); bf16_t* rowp = Y + (size_t)pair * 1024 + col0;
#pragma unroll
                    for (int bj = 0; bj < 2; ++bj) *(u32x4*)(rowp + bj * HALF) = pack8(acc[ai][bj][m][0] * w, acc[ai][bj][m][1] * w); } }
    }
};
__device__ __forceinline__ float log2_gamma(int h) { return __builtin_log2f(1.0f - __builtin_amdgcn_exp2f(-5.0f - (float)h)); }
struct EpiRetA {
    static constexpr bool PERM = true;
    bf16_t* ACAT; bf16_t* KI; bf16_t* SG; const float* sincos;
    __device__ __forceinline__ void operator()(const f32x4 (&acc)[2][2][4][2], const Unit& u, int wr, int wc, int fr, int fq) const {
        const int r0 = wr * 64 + fr, c0 = wc * 32 + 8 * fq;
        if (u.pn >= 8) {
#pragma unroll
            for (int ai = 0; ai < 2; ++ai)
#pragma unroll
                for (int m = 0; m < 4; ++m) { bf16_t* rowp = SG + (size_t)(u.pm * BM + r0 + ai * HALF + m * 16) * 2048 + (u.pn - 8) * BM + c0;
#pragma unroll
                    for (int bj = 0; bj < 2; ++bj) { f32x4 a0, a1;
#pragma unroll
                        for (int j = 0; j < 4; ++j) { a0[j] = silu_f(acc[ai][bj][m][0][j] * IN_DESCALE); a1[j] = silu_f(acc[ai][bj][m][1][j] * IN_DESCALE); }
                        *(u32x4*)(rowp + bj * HALF) = pack8(a0, a1); } }
            return;
        }
        const bool isq = u.pn < 4; const int h = u.pn & 3; const float l2g = log2_gamma(h);
        const int b = u.pm >> 3, n = u.pm & 7;
#pragma unroll
        for (int ai = 0; ai < 2; ++ai)
#pragma unroll
            for (int m = 0; m < 4; ++m) { const int r = r0 + ai * HALF + m * 16, pos = n * RC + r;
                const float fac = IN_DESCALE * (isq ? __builtin_amdgcn_exp2f((float)(r + 1) * l2g) : 0.0625f * __builtin_amdgcn_exp2f(-(float)(r + 1) * l2g));
                bf16_t* rowp = isq ? ACAT + ((size_t)((b * RH + h) * RNC + n) * RC + r) * 512 + 256 + c0 : KI + (size_t)(u.pm * BM + r) * 1024 + h * RDK + c0;
#pragma unroll
                for (int bj = 0; bj < 2; ++bj) { const f32x4* cs = (const f32x4*)(sincos + ((size_t)pos * 128 + (bj * HALF + c0) / 2) * 2);
                    const f32x4 t0 = cs[0], t1 = cs[1]; const f32x4 x0 = acc[ai][bj][m][0], x1 = acc[ai][bj][m][1]; f32x4 y0, y1;
                    y0[0] = (x0[0] * t0[0] - x0[1] * t0[1]) * fac; y0[1] = (x0[1] * t0[0] + x0[0] * t0[1]) * fac; y0[2] = (x0[2] * t0[2] - x0[3] * t0[3]) * fac; y0[3] = (x0[3] * t0[2] + x0[2] * t0[3]) * fac;
                    y1[0] = (x1[0] * t1[0] - x1[1] * t1[1]) * fac; y1[1] = (x1[1] * t1[0] + x1[0] * t1[1]) * fac; y1[2] = (x1[2] * t1[2] - x1[3] * t1[3]) * fac; y1[3] = (x1[3] * t1[2] + x1[2] * t1[3]) * fac;
                    *(u32x4*)(rowp + bj * HALF) = pack8(y0, y1); } }
    }
};
struct EpiRetB {
    static constexpr bool PERM = true;
    bf16_t* KIT; bf16_t* BTCAT; const float* sincosT;
    __device__ __forceinline__ void operator()(const f32x4 (&acc)[2][2][4][2], const Unit& u, int wr, int wc, int fr, int fq) const {
        const int r0 = wr * 64 + fr, c0 = wc * 32 + 8 * fq; const int b = u.pn >> 3, n = u.pn & 7;
        if (u.pm >= 4) { const int h = (u.pm - 4) >> 1, dv0 = ((u.pm - 4) & 1) * BM;
#pragma unroll
            for (int ai = 0; ai < 2; ++ai)
#pragma unroll
                for (int m = 0; m < 4; ++m) { bf16_t* rowp = BTCAT + ((size_t)((b * RH + h) * RNC + n) * RDV + dv0 + r0 + ai * HALF + m * 16) * 512 + c0;
#pragma unroll
                    for (int bj = 0; bj < 2; ++bj) *(u32x4*)(rowp + bj * HALF) = pack8(acc[ai][bj][m][0] * IN_DESCALE, acc[ai][bj][m][1] * IN_DESCALE); }
            return;
        }
        const int h = u.pm; const float l2g = log2_gamma(h);
        float fc[2][8];
#pragma unroll
        for (int bj = 0; bj < 2; ++bj)
#pragma unroll
            for (int j = 0; j < 8; ++j) fc[bj][j] = (0.0625f * IN_DESCALE) * __builtin_amdgcn_exp2f(-(float)(bj * HALF + c0 + j + 1) * l2g);
        const bool odd = (fr & 1) != 0;
#pragma unroll
        for (int ai = 0; ai < 2; ++ai)
#pragma unroll
            for (int m = 0; m < 4; ++m) { const int r = r0 + ai * HALF + m * 16;
                bf16_t* rowp = KIT + ((size_t)((b * RH + h) * RDK + r)) * SEQ + n * RC + c0;
#pragma unroll
                for (int bj = 0; bj < 2; ++bj) { const f32x4* cs = (const f32x4*)(sincosT + ((size_t)(r >> 1) * SEQ + n * RC + bj * HALF + c0) * 2);
                    f32x4 y[2];
#pragma unroll
                    for (int nn = 0; nn < 2; ++nn) { const f32x4 ta = cs[nn * 2], tb = cs[nn * 2 + 1]; const f32x4 x = acc[ai][bj][m][nn]; f32x4 xp;
#pragma unroll
                        for (int j = 0; j < 4; ++j) xp[j] = __shfl_xor(x[j], 1);
                        const float cc[4] = {ta[0], ta[2], tb[0], tb[2]}, ss[4] = {ta[1], ta[3], tb[1], tb[3]};
#pragma unroll
                        for (int j = 0; j < 4; ++j) y[nn][j] = (x[j] * cc[j] + (odd ? xp[j] : -xp[j]) * ss[j]) * fc[bj][nn * 4 + j]; }
                    *(u32x4*)(rowp + bj * HALF) = pack8(y[0], y[1]); } }
    }
};
struct EpiScores {
    static constexpr bool PERM = true;
    bf16_t* ACAT;
    __device__ __forceinline__ void operator()(const f32x4 (&acc)[2][2][4][2], const Unit& u, int wr, int wc, int fr, int fq) const {
        const int r0 = wr * 64 + fr, c0 = wc * 32 + 8 * fq;
#pragma unroll
        for (int ai = 0; ai < 2; ++ai)
#pragma unroll
            for (int m = 0; m < 4; ++m) { const int r = r0 + ai * HALF + m * 16; bf16_t* rowp = ACAT + ((size_t)u.pm * RC + r) * 512 + c0;
#pragma unroll
                for (int bj = 0; bj < 2; ++bj) { f32x4 y0 = acc[ai][bj][m][0], y1 = acc[ai][bj][m][1]; const int cb = bj * HALF + c0;
#pragma unroll
                    for (int j = 0; j < 4; ++j) { if (cb + j > r) y0[j] = 0.f; if (cb + 4 + j > r) y1[j] = 0.f; }
                    *(u32x4*)(rowp + bj * HALF) = pack8(y0, y1); } }
    }
};
struct EpiDS {
    static constexpr bool PERM = true;
    bf16_t* DS;
    __device__ __forceinline__ void operator()(const f32x4 (&acc)[2][2][4][2], const Unit& u, int wr, int wc, int fr, int fq) const {
        const int r0 = wr * 64 + fr, c0 = wc * 32 + 8 * fq;
#pragma unroll
        for (int ai = 0; ai < 2; ++ai)
#pragma unroll
            for (int m = 0; m < 4; ++m) { bf16_t* rowp = DS + ((size_t)u.pm * RDV + u.pn * BM + r0 + ai * HALF + m * 16) * RDK + c0;
#pragma unroll
                for (int bj = 0; bj < 2; ++bj) *(u32x4*)(rowp + bj * HALF) = pack8(acc[ai][bj][m][0], acc[ai][bj][m][1]); }
    }
};
struct EpiRetO {
    static constexpr bool PERM = true;
    bf16_t* ORET; bf16_t* SG; LAS float* ssq;
    __device__ __forceinline__ void operator()(const f32x4 (&acc)[2][2][4][2], const Unit& u, int wr, int wc, int fr, int fq) const {
        const int r0 = wr * 64 + fr, c0 = wc * 32 + 8 * fq; const int n = u.pm & 7, h = (u.pm >> 3) & 3, b = u.pm >> 5;
        LAS float* sq = ssq + (u.aux & 1) * 256;
        if (u.pn == 0) { const int t_ = threadIdx.x; if (t_ < 256) ssq[((u.aux & 1) ^ 1) * 256 + t_] = 0.f; }
#pragma unroll
        for (int ai = 0; ai < 2; ++ai)
#pragma unroll
            for (int m = 0; m < 4; ++m) { float s = 0.f;
#pragma unroll
                for (int bj = 0; bj < 2; ++bj)
#pragma unroll
                    for (int nn = 0; nn < 2; ++nn) { const f32x4 x = acc[ai][bj][m][nn]; s += (x[0] * x[0] + x[1] * x[1]) + (x[2] * x[2] + x[3] * x[3]); }
                s += __shfl_xor(s, 16); s += __shfl_xor(s, 32);
                if (fq == 0) (void)__hip_atomic_fetch_add(sq + r0 + ai * HALF + m * 16, s, __ATOMIC_RELAXED, __HIP_MEMORY_SCOPE_WORKGROUP); }
        const size_t rowbase = (size_t)(b * SEQ + n * RC) * 2048 + h * RDV;
        if (u.pn == 0) {
#pragma unroll
            for (int ai = 0; ai < 2; ++ai)
#pragma unroll
                for (int m = 0; m < 4; ++m) { bf16_t* rowp = ORET + rowbase + (size_t)(r0 + ai * HALF + m * 16) * 2048 + c0;
#pragma unroll
                    for (int bj = 0; bj < 2; ++bj) *(u32x4*)(rowp + bj * HALF) = pack8(acc[ai][bj][m][0], acc[ai][bj][m][1]); }
            return;
        }
        asm volatile("s_waitcnt lgkmcnt(0)" ::: "memory"); __builtin_amdgcn_s_barrier(); asm volatile("" ::: "memory");
#pragma unroll
        for (int ai = 0; ai < 2; ++ai)
#pragma unroll
            for (int m = 0; m < 4; ++m) { const int r = r0 + ai * HALF + m * 16; const float rstd = __builtin_amdgcn_rsqf(sq[r] * (1.0f / 512.0f) + RMS_EPS);
                const size_t ro = rowbase + (size_t)r * 2048 + c0;
#pragma unroll
                for (int bj = 0; bj < 2; ++bj) {
                    { bf16_t* gp = SG + ro + BM + bj * HALF; const u32x4 g = *(const u32x4*)gp; f32x4 y0 = acc[ai][bj][m][0] * rstd, y1 = acc[ai][bj][m][1] * rstd;
                      y0[0] *= __uint_as_float(g.x << 16); y0[1] *= __uint_as_float(g.x & 0xffff0000u); y0[2] *= __uint_as_float(g.y << 16); y0[3] *= __uint_as_float(g.y & 0xffff0000u);
                      y1[0] *= __uint_as_float(g.z << 16); y1[1] *= __uint_as_float(g.z & 0xffff0000u); y1[2] *= __uint_as_float(g.w << 16); y1[3] *= __uint_as_float(g.w & 0xffff0000u);
                      *(u32x4*)gp = pack8(y0, y1); }
                    { bf16_t* gp = SG + ro + bj * HALF; const u32x4 g = *(const u32x4*)gp; const u32x4 o = *(const u32x4*)(ORET + ro + bj * HALF); f32x4 y0, y1;
                      y0[0] = __uint_as_float(o.x << 16) * rstd * __uint_as_float(g.x << 16); y0[1] = __uint_as_float(o.x & 0xffff0000u) * rstd * __uint_as_float(g.x & 0xffff0000u);
                      y0[2] = __uint_as_float(o.y << 16) * rstd * __uint_as_float(g.y << 16); y0[3] = __uint_as_float(o.y & 0xffff0000u) * rstd * __uint_as_float(g.y & 0xffff0000u);
                      y1[0] = __uint_as_float(o.z << 16) * rstd * __uint_as_float(g.z << 16); y1[1] = __uint_as_float(o.z & 0xffff0000u) * rstd * __uint_as_float(g.z & 0xffff0000u);
                      y1[2] = __uint_as_float(o.w << 16) * rstd * __uint_as_float(g.w << 16); y1[3] = __uint_as_float(o.w & 0xffff0000u) * rstd * __uint_as_float(g.w & 0xffff0000u);
                      *(u32x4*)gp = pack8(y0, y1); } } }
    }
};
struct ScoresOrder {
    int G, c;
    __device__ bool next(int i, Unit& u) const { const int L = i * G + c; if (L >= NB * RH * RNC) return false; const int n = L & 7, h = (L >> 3) & 3, b = L >> 5;
        u.pm = L; u.pn = 0; u.aux = 0; u.aoff = (long)L * RC * 512 + 256; u.boff = (long)(b * SEQ + n * RC) * 1024 + h * RDK; return true; }
};
struct DsOrder {
    int G, c;
    __device__ bool next(int i, Unit& u) const { const int L = i * G + c; if (L >= NB * RH * 7 * 2) return false; const int dvt = L & 1, q = L >> 1, n = q % 7, bh = q / 7, p = bh * RNC + n;
        u.pm = p; u.pn = dvt; u.aux = 0; u.aoff = ((long)p * RDV + dvt * BM) * 512; u.boff = (long)bh * RDK * SEQ + n * RC; return true; }
};
struct RetOOrder {
    int G, c;
    __device__ bool next(int i, Unit& u) const { const int k = i >> 1, dvt = i & 1, p = k * G + c; if (p >= NB * RH * RNC) return false;
        u.pm = p; u.pn = dvt; u.aux = k; u.aoff = (long)p * RC * 512; u.boff = ((long)p * RDV + dvt * BM) * 512; return true; }
};
struct MoeOrder {
    int G, c, ldb; long a_tile; const LAS int* tstart; const LAS int* texp;
    __device__ bool next(int i, Unit& u) const { const int L = i * G + c; const int ntiles = tstart[33]; if (L >= ntiles * 4) return false; const int rt = L >> 2, pnl = L & 3, e = texp[rt];
        u.pm = rt; u.pn = e * 4 + pnl; u.aux = rt - tstart[e]; u.aoff = (long)rt * a_tile; u.boff = ((long)e * 1024 + pnl * BM) * ldb; return true; }
};
}
namespace attn_body {
using bf16=__hip_bfloat16;
using bf16x8=__attribute__((ext_vector_type(8)))short;
using s16x4=__attribute__((ext_vector_type(4)))short;
using f32x16=__attribute__((ext_vector_type(16)))float;
using u32x4=__attribute__((ext_vector_type(4)))unsigned;
constexpr int D=64,PQ=3072,PO=1024;
constexpr int NW=8,QBLK=32,QB=QBLK*NW,KVBLK=64,NQB=SEQ/QB;
__device__ __forceinline__ int crow(int r,int hi){return (r&3)+8*(r>>2)+4*hi;}
#define SBAR() __builtin_amdgcn_sched_barrier(0)
__device__ __forceinline__ void biasmask(f32x16&p0,f32x16&p1,int jb6,int qrel,int hi,const LAS float*lut2){
  const LAS float*pb=lut2+(128+qrel-64*jb6-4*hi+288-91);
  #pragma unroll
  for(int g=0;g<4;++g){
    #pragma unroll
    for(int q=0;q<4;++q){const int r=4*g+q, c=q+8*g; const int rel=128+qrel-64*jb6-4*hi-c; const float b0=pb[91-c], b1=pb[91-c-32]; p0[r]=(rel<0)?-INFINITY:p0[r]+b0; p1[r]=(rel<32)?-INFINITY:p1[r]+b1;}
    asm volatile("":"+v"(p0),"+v"(p1)); __builtin_amdgcn_sched_barrier(0);}
}
constexpr int NSLOT=3, SLOTB=8192;
constexpr int LDS_K=0, LDS_V=NSLOT*SLOTB, LDS_WS=2*NSLOT*SLOTB, LDS_OST=LDS_WS+NW*64*4, LDS_BYTES=LDS_OST+NW*4096;
__device__ __forceinline__ void glds16(const void*gsrc,unsigned lds_dst){unsigned keep;
  asm volatile("s_mov_b32 %0, m0\n\ts_mov_b32 m0, %2\n\ts_nop 0\n\tglobal_load_lds_dwordx4 %1, off\n\ts_mov_b32 m0, %0":"=&s"(keep):"v"(gsrc),"s"(lds_dst):"memory");}
__device__ __forceinline__ float max3f(float a,float b,float c){float r;asm("v_max3_f32 %0, %1, %2, %3":"=v"(r):"v"(a),"v"(b),"v"(c));return r;}
__device__ __forceinline__ float max2f(float a,float b){float r;asm("v_max_f32_e32 %0, %1, %2":"=v"(r):"v"(a),"v"(b));return r;}
__device__ __forceinline__ float fadd_s(float a,float b){float r;asm("v_add_f32_e32 %0, %1, %2":"=v"(r):"v"(a),"v"(b));return r;}
__device__ __forceinline__ float fsub_s(float a,float b){float r;asm("v_sub_f32_e32 %0, %1, %2":"=v"(r):"v"(a),"v"(b));return r;}
typedef float f32x2_t __attribute__((ext_vector_type(2))); typedef __bf16 bf16x2_t __attribute__((ext_vector_type(2)));
__device__ __forceinline__ unsigned cvtpk_s(float lo,float hi){f32x2_t v={lo,hi};bf16x2_t b=__builtin_convertvector(v,bf16x2_t);return __builtin_bit_cast(unsigned,b);}
#define WAIT_BAR(N) asm volatile("s_waitcnt vmcnt(" #N ") lgkmcnt(0)\n\ts_barrier":::"memory")

__device__ __forceinline__ void qkt(f32x16&p0,f32x16&p1,const char*Kslot,const bf16x8*qr,const f32x16&negm,int r32,int hi){
  const char*kb=Kslot+hi*1024+r32*16;
  #pragma unroll
  for(int d0=0;d0<4;++d0){
    const bf16x8 b0=*reinterpret_cast<const bf16x8*>(kb+d0*2048);
    const bf16x8 b1=*reinterpret_cast<const bf16x8*>(kb+d0*2048+512);
    if(d0==0){p0=__builtin_amdgcn_mfma_f32_32x32x16_bf16(b0,qr[0],negm,0,0,0);p1=__builtin_amdgcn_mfma_f32_32x32x16_bf16(b1,qr[0],negm,0,0,0);}
    else{p0=__builtin_amdgcn_mfma_f32_32x32x16_bf16(b0,qr[d0],p0,0,0,0);p1=__builtin_amdgcn_mfma_f32_32x32x16_bf16(b1,qr[d0],p1,0,0,0);}}
}
typedef LAS const char* lds_cptr;
typedef short v4i16_t __attribute__((ext_vector_type(4)));
__device__ __forceinline__ void kload8(bf16x8*kf,lds_cptr kp){
  kf[0]=*(const LAS bf16x8*)(kp);      kf[1]=*(const LAS bf16x8*)(kp+512);
  kf[2]=*(const LAS bf16x8*)(kp+2048); kf[3]=*(const LAS bf16x8*)(kp+2560);
  kf[4]=*(const LAS bf16x8*)(kp+4096); kf[5]=*(const LAS bf16x8*)(kp+4608);
  kf[6]=*(const LAS bf16x8*)(kp+6144); kf[7]=*(const LAS bf16x8*)(kp+6656);
}
__device__ __forceinline__ void kload2(bf16x8*kf,lds_cptr kp,int j){ kf[2*j]=*(const LAS bf16x8*)(kp+j*2048); kf[2*j+1]=*(const LAS bf16x8*)(kp+j*2048+512); }
__device__ __forceinline__ s16x4 vtr(lds_cptr p){ return __builtin_bit_cast(s16x4,__builtin_amdgcn_ds_read_tr16_b64_v4i16((LAS v4i16_t*)p)); }
__device__ __forceinline__ float rowmax(const f32x16&p0,const f32x16&p1){
  float a=max3f(p0[0],p0[1],p1[0]),b=max3f(p0[2],p0[3],p1[1]);a=max3f(a,p1[2],p1[3]);
  #pragma unroll
  for(int r=4;r<16;r+=4){a=max3f(a,p0[r],p0[r+1]);b=max3f(b,p0[r+2],p0[r+3]);a=max3f(a,p1[r],p1[r+1]);b=max3f(b,p1[r+2],p1[r+3]);}
  const float m=max2f(a,b);
  auto rr=__builtin_amdgcn_permlane32_swap(__float_as_uint(m),__float_as_uint(m),false,false);
  return max2f(__uint_as_float(rr[0]),__uint_as_float(rr[1]));
}
__device__ __forceinline__ void pv(f32x16*o,int vb,bf16x8 pa0,bf16x8 pa1,bf16x8 pa2,bf16x8 pa3){
  #pragma unroll
  for(int d0=0;d0<2;++d0){s16x4 lo[4],hi[4];
    #pragma unroll
    for(int ks=0;ks<4;++ks){
      asm volatile("ds_read_b64_tr_b16 %0,%1 offset:%c2":"=&v"(lo[ks]):"v"(vb),"i"(d0*4096+ks*1024):"memory");
      asm volatile("ds_read_b64_tr_b16 %0,%1 offset:%c2":"=&v"(hi[ks]):"v"(vb),"i"(d0*4096+ks*1024+512):"memory");}
    asm volatile("s_waitcnt lgkmcnt(0)":::"memory");SBAR();
    #define PK(k) (bf16x8){lo[k][0],lo[k][1],lo[k][2],lo[k][3],hi[k][0],hi[k][1],hi[k][2],hi[k][3]}
    o[d0]=__builtin_amdgcn_mfma_f32_32x32x16_bf16(pa0,PK(0),o[d0],0,0,0);
    o[d0]=__builtin_amdgcn_mfma_f32_32x32x16_bf16(pa1,PK(1),o[d0],0,0,0);
    o[d0]=__builtin_amdgcn_mfma_f32_32x32x16_bf16(pa2,PK(2),o[d0],0,0,0);
    o[d0]=__builtin_amdgcn_mfma_f32_32x32x16_bf16(pa3,PK(3),o[d0],0,0,0);
    #undef PK
  }
}
template<int THRL> __device__ __forceinline__ void attn_unit(int b,int qb,const bf16*QKV,int Qc,int Kc,int Vc,bf16*O,const LAS float*lut,char*shm){
  int tid_=threadIdx.x; asm volatile("":"+v"(tid_)); const int tid=tid_,lane=tid&63,r32=lane&31,hi=lane>>5; const int wid=__builtin_amdgcn_readfirstlane(tid>>6);
  const long rowbase=(long)b*SEQ; const int q0=qb*QB;
  const bf16*Qw=QKV+(rowbase+q0+wid*QBLK)*PQ+Qc;
  const bf16*Kh=QKV+rowbase*PQ+Kc,*Vh=QKV+rowbase*PQ+Vc;
  const unsigned lds0=(unsigned)(uintptr_t)shm;
  float*wsf=(float*)(shm+LDS_WS)+wid*64;
  const bf16*ksrc=Kh+(long)lane*PQ+wid*8;
  const bf16*vsrc=Vh+(long)(16*(wid&3)+(lane>>2))*PQ+(wid>>2)*32+(lane&3)*8;
  const unsigned kdst=lds0+LDS_K+wid*1024, vdst=lds0+LDS_V+wid*1024;
  #define DMA_K(t,slot) glds16(ksrc+(long)(t)*KVBLK*PQ,(unsigned)__builtin_amdgcn_readfirstlane(kdst+(slot)))
  #define DMA_V(t,slot) glds16(vsrc+(long)(t)*KVBLK*PQ,(unsigned)__builtin_amdgcn_readfirstlane(vdst+(slot)))
  const int vb0=(int)(lds0+LDS_V)+((lane>>4)&1)*32+(lane&3)*8+(4*hi+((lane&15)>>2))*64;
  const char*Kbase=shm+LDS_K; bf16x8 kf[8];
  const lds_cptr shm3=(lds_cptr)shm; const lds_cptr kp0=shm3+LDS_K+hi*1024+r32*16; const lds_cptr vp0=shm3+LDS_V+((lane>>4)&1)*32+(lane&3)*8+(4*hi+((lane&15)>>2))*64;
  const int NT=(q0+QB)/KVBLK;
  DMA_K(0,0);DMA_V(0,0);DMA_K(1,SLOTB);
  bf16x8 qr[4];
  #pragma unroll
  for(int d0=0;d0<4;++d0)qr[d0]=*reinterpret_cast<const bf16x8*>(&Qw[(long)r32*PQ+d0*16+hi*8]);
  float mhat=0.f,l_reg=0.f;f32x16 o[2];f32x16 negm; { float zz; asm volatile("v_mov_b32 %0, 0":"=v"(zz)); _Pragma("unroll") for(int r=0;r<16;++r){o[0][r]=zz;o[1][r]=zz;negm[r]=zz;} } asm volatile("":"+v"(negm));
  const int qrel=wid*QBLK+r32;
  #define CMASK(P0,P1,t) do{int jb_=(t)-(NT-6); if(jb_>=0)biasmask(P0,P1,jb_,qrel,hi,lut);}while(0)
  bool resc=false;
  #define START(P0,P1) do{ const float rm=rowmax(P0,P1); resc=false; \
    { const float dl=rm; mhat=fadd_s(mhat,dl); \
      _Pragma("unroll") for(int r=0;r<16;++r){P0[r]=fsub_s(P0[r],dl);P1[r]=fsub_s(P1[r],dl);} \
      _Pragma("unroll") for(int r=0;r<16;++r)negm[r]=-mhat; asm volatile("":"+v"(negm)); } \
    _Pragma("unroll") for(int r=0;r<16;++r)P0[r]=__builtin_amdgcn_exp2f(P0[r]); }while(0)
  #define RESC() do{ if(resc){ asm volatile("s_waitcnt lgkmcnt(0)":::"memory"); \
      _Pragma("unroll") for(int d_=0;d_<2;++d_) _Pragma("unroll") for(int r=0;r<16;++r)o[d_][r]*=wsf[crow(r,hi)]; } }while(0)
  f32x16 pA0,pA1,pB0,pB1;
  int sl_prev=0,sl_cur=0,sl_next=SLOTB;
  #define ROT() do{sl_prev=sl_cur;sl_cur=sl_next;sl_next=(sl_next==(NSLOT-1)*SLOTB)?0:sl_next+SLOTB;}while(0)
  DMA_K(2,2*SLOTB);
  WAIT_BAR(3);
  qkt(pA0,pA1,Kbase,qr,negm,r32,hi);asm volatile("s_nop 15\n\ts_nop 7":"+v"(pA0),"+v"(pA1));CMASK(pA0,pA1,0);
  START(pA0,pA1);
  _Pragma("unroll") for(int r=0;r<16;++r)pA1[r]=__builtin_amdgcn_exp2f(pA1[r]);
  WAIT_BAR(0);
  DMA_K(3,0);DMA_V(1,SLOTB);
  ROT();
  kload8(kf,kp0+sl_cur);
  WAIT_BAR(2);
  s16x4 vlo[8],vhi[8]; u32x4 pw0,pw1,pw2,pw3;
  #define PKW(P,B) cvtpk_s(P[B],P[B+1])
  #define PAF(k) __builtin_bit_cast(bf16x8,pw##k)
  #define VFR(i) (bf16x8){vlo[i][0],vlo[i][1],vlo[i][2],vlo[i][3],vhi[i][0],vhi[i][1],vhi[i][2],vhi[i][3]}
  #define PIN(x) asm volatile("":"+v"(x))
  #define MX3(a,b,c) __builtin_fmaxf(__builtin_fmaxf((a),(b)),(c))
  #define GAPA(MF,A0,A1,A2,A3,W0,W1,PW) do{ MF; sacc+=A0; sacc+=A1; sacc+=A2; sacc+=A3; PIN(sacc); W0; W1; PIN(PW); SBAR(); }while(0)
  #define EX(v) __builtin_amdgcn_exp2f(v)
  #define GAPB(MF,X,B) do{ MF; X[B]=EX(X[B]); X[B+1]=EX(X[B+1]); X[B+2]=EX(X[B+2]); X[B+3]=EX(X[B+3]); PIN(X); SBAR(); }while(0)
  #define VRD(i) do{ vlo[i]=vtr(vp_+(((i)>>2)*4096+((i)&3)*1024)); vhi[i]=vtr(vp_+(((i)>>2)*4096+((i)&3)*1024+512)); }while(0)
  #define KRD(G,j) do{ if(G){ kload2(kf,kp0+sl_next,j); SBAR(); } }while(0)
  #define STEP(C0,C1,P0,P1,t,GK,GV,GL) do{ SBAR(); \
    const lds_cptr vp_=vp0+sl_prev; \
    VRD(0); SBAR(); float sacc=(P0[0]+P0[1]); \
    GAPA(C0=__builtin_amdgcn_mfma_f32_32x32x16_bf16(kf[0],qr[0],negm,0,0,0), P0[2],P0[3],P0[4],P0[5],     pw0[0]=PKW(P0,0), pw0[1]=PKW(P0,2), pw0); \
    VRD(4); SBAR(); GAPA(C1=__builtin_amdgcn_mfma_f32_32x32x16_bf16(kf[1],qr[0],negm,0,0,0), P0[6],P0[7],P0[8],P0[9],     pw0[2]=PKW(P0,4), pw0[3]=PKW(P0,6), pw0); \
    VRD(1); SBAR(); GAPA(C0=__builtin_amdgcn_mfma_f32_32x32x16_bf16(kf[2],qr[1],C0,0,0,0),   P0[10],P0[11],P0[12],P0[13], pw1[0]=PKW(P0,8), pw1[1]=PKW(P0,10), pw1); \
    VRD(5); SBAR(); GAPA(C1=__builtin_amdgcn_mfma_f32_32x32x16_bf16(kf[3],qr[1],C1,0,0,0),   P0[14],P0[15],P1[0],P1[1],   pw1[2]=PKW(P0,12),pw1[3]=PKW(P0,14), pw1); \
    VRD(2); SBAR(); GAPA(C0=__builtin_amdgcn_mfma_f32_32x32x16_bf16(kf[4],qr[2],C0,0,0,0),   P1[2],P1[3],P1[4],P1[5],     pw2[0]=PKW(P1,0), pw2[1]=PKW(P1,2), pw2); \
    VRD(6); SBAR(); GAPA(C1=__builtin_amdgcn_mfma_f32_32x32x16_bf16(kf[5],qr[2],C1,0,0,0),   P1[6],P1[7],P1[8],P1[9],     pw2[2]=PKW(P1,4), pw2[3]=PKW(P1,6), pw2); \
    VRD(3); SBAR(); GAPA(C0=__builtin_amdgcn_mfma_f32_32x32x16_bf16(kf[6],qr[3],C0,0,0,0),   P1[10],P1[11],P1[12],P1[13], pw3[0]=PKW(P1,8), pw3[1]=PKW(P1,10), pw3); \
    VRD(7); SBAR(); GAPA(C1=__builtin_amdgcn_mfma_f32_32x32x16_bf16(kf[7],qr[3],C1,0,0,0),   P1[14],P1[15],0.f,0.f,       pw3[2]=PKW(P1,12),pw3[3]=PKW(P1,14), pw3); \
    l_reg+=sacc; \
    if(GK){DMA_K((t)+3,sl_cur);} if(GV){DMA_V((t)+1,sl_next);} \
    CMASK(C0,C1,t); \
    { float a=MX3(C0[0],C0[1],C1[0]),b=MX3(C0[2],C0[3],C1[1]); a=MX3(a,C1[2],C1[3]); \
      _Pragma("unroll") for(int r=4;r<16;r+=4){a=MX3(a,C0[r],C0[r+1]);b=MX3(b,C0[r+2],C0[r+3]);a=MX3(a,C1[r],C1[r+1]);b=MX3(b,C1[r+2],C1[r+3]);} \
      float rm=__builtin_fmaxf(a,b); { auto rr=__builtin_amdgcn_permlane32_swap(__float_as_uint(rm),__float_as_uint(rm),false,false); rm=__builtin_fmaxf(__uint_as_float(rr[0]),__uint_as_float(rr[1])); } \
      resc=false; \
      if(__builtin_expect(__any(rm>(float)THRL),0)){ const float dl=__builtin_fmaxf(rm,0.f); mhat+=dl; \
        _Pragma("unroll") for(int r=0;r<16;++r){C0[r]-=dl;C1[r]-=dl;} \
        _Pragma("unroll") for(int r=0;r<16;++r)negm[r]=-mhat; asm volatile("":"+v"(negm)); \
        const float f=__builtin_amdgcn_exp2f(-dl); l_reg*=f; if(hi==0)wsf[r32]=f; resc=true; } } \
    SBAR(); \
    GAPB(o[0]=__builtin_amdgcn_mfma_f32_32x32x16_bf16(PAF(0),VFR(0),o[0],0,0,0), C0,0); \
    GAPB(o[1]=__builtin_amdgcn_mfma_f32_32x32x16_bf16(PAF(0),VFR(4),o[1],0,0,0), C0,4); \
    KRD(GL,0); GAPB(o[0]=__builtin_amdgcn_mfma_f32_32x32x16_bf16(PAF(1),VFR(1),o[0],0,0,0), C0,8); \
    KRD(GL,1); GAPB(o[1]=__builtin_amdgcn_mfma_f32_32x32x16_bf16(PAF(1),VFR(5),o[1],0,0,0), C0,12); \
    KRD(GL,2); GAPB(o[0]=__builtin_amdgcn_mfma_f32_32x32x16_bf16(PAF(2),VFR(2),o[0],0,0,0), C1,0); \
    KRD(GL,3); GAPB(o[1]=__builtin_amdgcn_mfma_f32_32x32x16_bf16(PAF(2),VFR(6),o[1],0,0,0), C1,4); \
    GAPB(o[0]=__builtin_amdgcn_mfma_f32_32x32x16_bf16(PAF(3),VFR(3),o[0],0,0,0), C1,8); \
    GAPB(o[1]=__builtin_amdgcn_mfma_f32_32x32x16_bf16(PAF(3),VFR(7),o[1],0,0,0), C1,12); \
    }while(0)
  int t=1;
  #undef CMASK
  #define CMASK(P0,P1,t) do{}while(0)
  for(;t+7<NT;t+=2){
    STEP(pB0,pB1,pA0,pA1,t,true,true,true);     WAIT_BAR(2); RESC(); ROT();
    STEP(pA0,pA1,pB0,pB1,t+1,true,true,true);   WAIT_BAR(2); RESC(); ROT();
  }
  #undef CMASK
  #define CMASK(P0,P1,t) do{int jb_=(t)-(NT-6); if(jb_>=0)biasmask(P0,P1,jb_,qrel,hi,lut);}while(0)
  #define ENDW(tt) do{ if((tt)+3<NT){WAIT_BAR(2);} else if((tt)+2<NT){WAIT_BAR(1);} else {WAIT_BAR(0);} }while(0)
  for(;t+1<NT;t+=2){
    STEP(pB0,pB1,pA0,pA1,t,(t+3<NT),(t+1<NT),(t+1<NT));       ENDW(t);   RESC(); ROT();
    STEP(pA0,pA1,pB0,pB1,t+1,(t+4<NT),(t+2<NT),(t+2<NT));     ENDW(t+1); RESC(); ROT();
  }
  STEP(pB0,pB1,pA0,pA1,NT-1,false,false,false); RESC();
  { float sacc=pB0[0]+pB0[1]; _Pragma("unroll") for(int r=2;r<16;++r)sacc+=pB0[r]; _Pragma("unroll") for(int r=0;r<16;++r)sacc+=pB1[r]; l_reg+=sacc;
    pw0=(u32x4){PKW(pB0,0),PKW(pB0,2),PKW(pB0,4),PKW(pB0,6)};pw1=(u32x4){PKW(pB0,8),PKW(pB0,10),PKW(pB0,12),PKW(pB0,14)};pw2=(u32x4){PKW(pB1,0),PKW(pB1,2),PKW(pB1,4),PKW(pB1,6)};pw3=(u32x4){PKW(pB1,8),PKW(pB1,10),PKW(pB1,12),PKW(pB1,14)};
    SBAR(); pv(o,vb0+sl_cur,PAF(0),PAF(1),PAF(2),PAF(3)); }
  #undef PKW
  #undef PAF
  #undef VFR
  #undef PIN
  #undef MX3
  #undef GAPA
  #undef GAPB
  #undef EX
  #undef VRD
  #undef KRD
  #undef STEP
  #undef ENDW
  {auto rr=__builtin_amdgcn_permlane32_swap(__float_as_uint(l_reg),__float_as_uint(l_reg),false,false);l_reg=__uint_as_float(rr[0])+__uint_as_float(rr[1]);}
  if(hi==0)wsf[32+r32]=l_reg;asm volatile("s_waitcnt lgkmcnt(0)":::"memory");
  float rli[16];
  #pragma unroll
  for(int r=0;r<16;++r)rli[r]=__builtin_amdgcn_rcpf(wsf[32+crow(r,hi)]);
  bf16*Ow=O+(rowbase+q0+wid*QBLK)*PO;
  { bf16*stg=(bf16*)(shm+LDS_OST)+wid*2048;
    #pragma unroll
    for(int r=0;r<16;++r){const int orow=crow(r,hi);
      #pragma unroll
      for(int d0=0;d0<2;++d0)stg[orow*64+d0*32+r32]=__float2bfloat16(o[d0][r]*rli[r]);}
    asm volatile("s_waitcnt lgkmcnt(0)":::"memory");
    #pragma unroll
    for(int i=0;i<4;++i){const int row=i*8+(lane>>3),ch=lane&7; const u32x4 v=*(const u32x4*)(stg+row*64+ch*8); *(u32x4*)(Ow+(long)row*PO+ch*8)=v;} }
  asm volatile("s_waitcnt lgkmcnt(0)\n\ts_barrier":::"memory");
  #undef DMA_K
  #undef DMA_V
  #undef CMASK
  #undef START
  #undef RESC
  #undef ROT
}

constexpr int VSLOTB=16384, L2_K=0, L2_V=NSLOT*SLOTB, L2_WS=L2_V+NSLOT*VSLOTB, L2_QO=L2_WS+NW*64*4, L2_BYTES=L2_QO+NW*4096;
template<int THRL> __device__ __forceinline__ void attn_unit128(int b,int qb,const bf16*QKV,int Qc,int Kc,int Vc,bf16*O,const LAS float*lut,char*shm){
  int tid_=threadIdx.x; asm volatile("":"+v"(tid_)); const int tid=tid_,lane=tid&63,r32=lane&31,hi=lane>>5; const int wid=__builtin_amdgcn_readfirstlane(tid>>6);
  const long rowbase=(long)b*SEQ; const int q0=qb*QB;
  const bf16*Qw=QKV+(rowbase+q0+wid*QBLK)*PQ+Qc;
  const bf16*Kh=QKV+rowbase*PQ+Kc,*Vh=QKV+rowbase*PQ+Vc;
  const unsigned lds0=(unsigned)(uintptr_t)shm;
  float*wsf=(float*)(shm+L2_WS)+wid*64;
  const bf16*ksrc=Kh+(long)lane*PQ+wid*8;
  const bf16*vsrc=Vh+(long)(16*(wid&3)+(lane>>2))*PQ+(wid>>2)*32+(lane&3)*8;
  const unsigned kdst=lds0+L2_K+wid*1024, vdst=lds0+L2_V+wid*1024;
  #define DMA_K(t,slot) glds16(ksrc+(long)(t)*KVBLK*PQ,(unsigned)__builtin_amdgcn_readfirstlane(kdst+(slot)))
  #define DMA_V(t,slot) do{ glds16(vsrc+(long)(t)*KVBLK*PQ,(unsigned)__builtin_amdgcn_readfirstlane(vdst+2*(slot))); glds16(vsrc+(long)(t)*KVBLK*PQ+64,(unsigned)__builtin_amdgcn_readfirstlane(vdst+2*(slot)+8192)); }while(0)
  const int vb0=(int)(lds0+L2_V)+((lane>>4)&1)*32+(lane&3)*8+(4*hi+((lane&15)>>2))*64;
  const char*Kbase=shm+L2_K; bf16x8 kf[8];
  const lds_cptr shm3=(lds_cptr)shm; const lds_cptr kp0=shm3+L2_K+hi*1024+r32*16; const lds_cptr vp0=shm3+L2_V+((lane>>4)&1)*32+(lane&3)*8+(4*hi+((lane&15)>>2))*64;
  const lds_cptr qst=shm3+L2_QO+wid*4096+lane*16;
  const int NT=(q0+QB)/KVBLK;
  DMA_K(0,0);DMA_V(0,0);DMA_K(1,SLOTB);
  { bf16x8 qr[4];
    #pragma unroll
    for(int d0=0;d0<4;++d0)qr[d0]=*reinterpret_cast<const bf16x8*>(&Qw[(long)r32*PQ+d0*16+hi*8]);
    #pragma unroll
    for(int d0=0;d0<4;++d0)*(LAS bf16x8*)(qst+d0*1024)=qr[d0]; }
  float mhat=0.f,l_reg=0.f;f32x16 o[4]; { float zz; asm volatile("v_mov_b32 %0, 0":"=v"(zz)); _Pragma("unroll") for(int r=0;r<16;++r){o[0][r]=zz;o[1][r]=zz;o[2][r]=zz;o[3][r]=zz;} }
  const int qrel=wid*QBLK+r32;
  #define QF(d0) (*(const LAS bf16x8*)(qst+(d0)*1024))
  #define CMASK(P0,P1,t) do{int jb_=(t)-(NT-6); if(jb_>=0)biasmask(P0,P1,jb_,qrel,hi,lut);}while(0)
  bool resc=false;
  #define RESC() do{ if(resc){ asm volatile("s_waitcnt lgkmcnt(0)":::"memory"); \
      _Pragma("unroll") for(int d_=0;d_<4;++d_) _Pragma("unroll") for(int r=0;r<16;++r)o[d_][r]*=wsf[crow(r,hi)]; } }while(0)
  f32x16 pA0,pA1,pB0,pB1;
  int sl_prev=0,sl_cur=0,sl_next=SLOTB;
  #define ROT() do{sl_prev=sl_cur;sl_cur=sl_next;sl_next=(sl_next==(NSLOT-1)*SLOTB)?0:sl_next+SLOTB;}while(0)
  DMA_K(2,2*SLOTB);
  WAIT_BAR(3);
  {
    const char*kb=Kbase+hi*1024+r32*16; const f32x16 z16={};
    #pragma unroll
    for(int d0=0;d0<4;++d0){ const bf16x8 qf=QF(d0);
      const bf16x8 b0=*reinterpret_cast<const bf16x8*>(kb+d0*2048); const bf16x8 b1=*reinterpret_cast<const bf16x8*>(kb+d0*2048+512);
      if(d0==0){pA0=__builtin_amdgcn_mfma_f32_32x32x16_bf16(b0,qf,z16,0,0,0);pA1=__builtin_amdgcn_mfma_f32_32x32x16_bf16(b1,qf,z16,0,0,0);}
      else{pA0=__builtin_amdgcn_mfma_f32_32x32x16_bf16(b0,qf,pA0,0,0,0);pA1=__builtin_amdgcn_mfma_f32_32x32x16_bf16(b1,qf,pA1,0,0,0);} }
    asm volatile("s_nop 15\n\ts_nop 7":"+v"(pA0),"+v"(pA1));CMASK(pA0,pA1,0);
    mhat=rowmax(pA0,pA1);
    #pragma unroll
    for(int r=0;r<16;++r){pA0[r]=__builtin_amdgcn_exp2f(pA0[r]-mhat);pA1[r]=__builtin_amdgcn_exp2f(pA1[r]-mhat);} }
  WAIT_BAR(0);
  DMA_K(3,0);DMA_V(1,SLOTB);
  ROT();
  kload8(kf,kp0+sl_cur);
  WAIT_BAR(3);
  s16x4 vlo[8],vhi[8]; u32x4 pw0,pw1,pw2,pw3;
  #define PKW(P,B) cvtpk_s(P[B],P[B+1])
  #define PAF(k) __builtin_bit_cast(bf16x8,pw##k)
  #define VFR(i) (bf16x8){vlo[i][0],vlo[i][1],vlo[i][2],vlo[i][3],vhi[i][0],vhi[i][1],vhi[i][2],vhi[i][3]}
  #define PIN(x) asm volatile("":"+v"(x))
  #define MX3(a,b,c) __builtin_fmaxf(__builtin_fmaxf((a),(b)),(c))
  #define MFQ(C,kk,qv,Cin) C=__builtin_amdgcn_mfma_f32_32x32x16_bf16(kf[kk],qv,Cin,0,0,0)
  #define GAPA(MF,A0,A1,A2,A3,W0,W1,PW) do{ MF; sacc+=A0; sacc+=A1; sacc+=A2; sacc+=A3; PIN(sacc); W0; W1; PIN(PW); SBAR(); }while(0)
  #define EX(v) __builtin_amdgcn_exp2f((v)-mhat)
  #define GAPB(MF,X,B) do{ MF; X[B]=EX(X[B]); X[B+1]=EX(X[B+1]); PIN(X); SBAR(); }while(0)
  #define VRD(i) do{ vlo[(i)&7]=vtr(vp_+(((i)>>2)*4096+((i)&3)*1024)); vhi[(i)&7]=vtr(vp_+(((i)>>2)*4096+((i)&3)*1024+512)); }while(0)
  #define KRD(G,j) do{ if(G){ kload2(kf,kp0+sl_next,j); SBAR(); } }while(0)
  #define STEP(C0,C1,P0,P1,t,GK,GV,GL) do{ SBAR(); \
    const lds_cptr vp_=vp0+2*sl_prev; const f32x16 z16={}; bf16x8 qf; \
    VRD(0); qf=QF(0); SBAR(); float sacc=(P0[0]+P0[1]); \
    GAPA(MFQ(C0,0,qf,z16), P0[2],P0[3],P0[4],P0[5],     pw0[0]=PKW(P0,0), pw0[1]=PKW(P0,2), pw0); \
    VRD(4); SBAR(); GAPA(MFQ(C1,1,qf,z16), P0[6],P0[7],P0[8],P0[9],     pw0[2]=PKW(P0,4), pw0[3]=PKW(P0,6), pw0); \
    VRD(1); qf=QF(1); SBAR(); GAPA(MFQ(C0,2,qf,C0),   P0[10],P0[11],P0[12],P0[13], pw1[0]=PKW(P0,8), pw1[1]=PKW(P0,10), pw1); \
    VRD(5); SBAR(); GAPA(MFQ(C1,3,qf,C1),   P0[14],P0[15],P1[0],P1[1],   pw1[2]=PKW(P0,12),pw1[3]=PKW(P0,14), pw1); \
    VRD(2); qf=QF(2); SBAR(); GAPA(MFQ(C0,4,qf,C0),   P1[2],P1[3],P1[4],P1[5],     pw2[0]=PKW(P1,0), pw2[1]=PKW(P1,2), pw2); \
    VRD(6); SBAR(); GAPA(MFQ(C1,5,qf,C1),   P1[6],P1[7],P1[8],P1[9],     pw2[2]=PKW(P1,4), pw2[3]=PKW(P1,6), pw2); \
    VRD(3); qf=QF(3); SBAR(); GAPA(MFQ(C0,6,qf,C0),   P1[10],P1[11],P1[12],P1[13], pw3[0]=PKW(P1,8), pw3[1]=PKW(P1,10), pw3); \
    VRD(7); SBAR(); GAPA(MFQ(C1,7,qf,C1),   P1[14],P1[15],0.f,0.f,       pw3[2]=PKW(P1,12),pw3[3]=PKW(P1,14), pw3); \
    l_reg+=sacc; \
    if(GK){DMA_K((t)+3,sl_cur);} if(GV){DMA_V((t)+1,sl_next);} \
    CMASK(C0,C1,t); \
    { float a=MX3(C0[0],C0[1],C1[0]),b=MX3(C0[2],C0[3],C1[1]); a=MX3(a,C1[2],C1[3]); \
      _Pragma("unroll") for(int r=4;r<16;r+=4){a=MX3(a,C0[r],C0[r+1]);b=MX3(b,C0[r+2],C0[r+3]);a=MX3(a,C1[r],C1[r+1]);b=MX3(b,C1[r+2],C1[r+3]);} \
      float rm=__builtin_fmaxf(a,b); { auto rr=__builtin_amdgcn_permlane32_swap(__float_as_uint(rm),__float_as_uint(rm),false,false); rm=__builtin_fmaxf(__uint_as_float(rr[0]),__uint_as_float(rr[1])); } \
      rm-=mhat; resc=false; \
      if(__builtin_expect(__any(rm>(float)THRL),0)){ const float dl=__builtin_fmaxf(rm,0.f); mhat+=dl; \
        const float f=__builtin_amdgcn_exp2f(-dl); l_reg*=f; if(hi==0)wsf[r32]=f; resc=true; } } \
    SBAR(); \
    GAPB(o[0]=__builtin_amdgcn_mfma_f32_32x32x16_bf16(PAF(0),VFR(0),o[0],0,0,0), C0,0);  VRD(8);  SBAR(); \
    GAPB(o[1]=__builtin_amdgcn_mfma_f32_32x32x16_bf16(PAF(0),VFR(4),o[1],0,0,0), C0,2);  VRD(12); SBAR(); \
    GAPB(o[0]=__builtin_amdgcn_mfma_f32_32x32x16_bf16(PAF(1),VFR(1),o[0],0,0,0), C0,4);  VRD(9);  SBAR(); \
    GAPB(o[1]=__builtin_amdgcn_mfma_f32_32x32x16_bf16(PAF(1),VFR(5),o[1],0,0,0), C0,6);  VRD(13); SBAR(); \
    GAPB(o[0]=__builtin_amdgcn_mfma_f32_32x32x16_bf16(PAF(2),VFR(2),o[0],0,0,0), C0,8);  VRD(10); SBAR(); \
    GAPB(o[1]=__builtin_amdgcn_mfma_f32_32x32x16_bf16(PAF(2),VFR(6),o[1],0,0,0), C0,10); VRD(14); SBAR(); \
    GAPB(o[0]=__builtin_amdgcn_mfma_f32_32x32x16_bf16(PAF(3),VFR(3),o[0],0,0,0), C0,12); VRD(11); SBAR(); \
    GAPB(o[1]=__builtin_amdgcn_mfma_f32_32x32x16_bf16(PAF(3),VFR(7),o[1],0,0,0), C0,14); VRD(15); SBAR(); \
    GAPB(o[2]=__builtin_amdgcn_mfma_f32_32x32x16_bf16(PAF(0),VFR(0),o[2],0,0,0), C1,0); \
    GAPB(o[3]=__builtin_amdgcn_mfma_f32_32x32x16_bf16(PAF(0),VFR(4),o[3],0,0,0), C1,2); \
    KRD(GL,0); GAPB(o[2]=__builtin_amdgcn_mfma_f32_32x32x16_bf16(PAF(1),VFR(1),o[2],0,0,0), C1,4); \
    KRD(GL,1); GAPB(o[3]=__builtin_amdgcn_mfma_f32_32x32x16_bf16(PAF(1),VFR(5),o[3],0,0,0), C1,6); \
    KRD(GL,2); GAPB(o[2]=__builtin_amdgcn_mfma_f32_32x32x16_bf16(PAF(2),VFR(2),o[2],0,0,0), C1,8); \
    KRD(GL,3); GAPB(o[3]=__builtin_amdgcn_mfma_f32_32x32x16_bf16(PAF(2),VFR(6),o[3],0,0,0), C1,10); \
    GAPB(o[2]=__builtin_amdgcn_mfma_f32_32x32x16_bf16(PAF(3),VFR(3),o[2],0,0,0), C1,12); \
    GAPB(o[3]=__builtin_amdgcn_mfma_f32_32x32x16_bf16(PAF(3),VFR(7),o[3],0,0,0), C1,14); \
    }while(0)
  int t=1;
  #undef CMASK
  #define CMASK(P0,P1,t) do{}while(0)
  for(;t+7<NT;t+=2){
    STEP(pB0,pB1,pA0,pA1,t,true,true,true);     WAIT_BAR(3); RESC(); ROT();
    STEP(pA0,pA1,pB0,pB1,t+1,true,true,true);   WAIT_BAR(3); RESC(); ROT();
  }
  #undef CMASK
  #define CMASK(P0,P1,t) do{int jb_=(t)-(NT-6); if(jb_>=0)biasmask(P0,P1,jb_,qrel,hi,lut);}while(0)
  #define ENDW(tt) do{ if((tt)+3<NT){WAIT_BAR(3);} else if((tt)+2<NT){WAIT_BAR(2);} else {WAIT_BAR(0);} }while(0)
  for(;t+1<NT;t+=2){
    STEP(pB0,pB1,pA0,pA1,t,(t+3<NT),(t+1<NT),(t+1<NT));       ENDW(t);   RESC(); ROT();
    STEP(pA0,pA1,pB0,pB1,t+1,(t+4<NT),(t+2<NT),(t+2<NT));     ENDW(t+1); RESC(); ROT();
  }
  STEP(pB0,pB1,pA0,pA1,NT-1,false,false,false); RESC();
  { float sacc=pB0[0]+pB0[1]; _Pragma("unroll") for(int r=2;r<16;++r)sacc+=pB0[r]; _Pragma("unroll") for(int r=0;r<16;++r)sacc+=pB1[r]; l_reg+=sacc;
    pw0=(u32x4){PKW(pB0,0),PKW(pB0,2),PKW(pB0,4),PKW(pB0,6)};pw1=(u32x4){PKW(pB0,8),PKW(pB0,10),PKW(pB0,12),PKW(pB0,14)};pw2=(u32x4){PKW(pB1,0),PKW(pB1,2),PKW(pB1,4),PKW(pB1,6)};pw3=(u32x4){PKW(pB1,8),PKW(pB1,10),PKW(pB1,12),PKW(pB1,14)};
    SBAR();
    const int vb=vb0+2*sl_cur;
    #pragma unroll
    for(int d0=0;d0<4;++d0){s16x4 lo[4],hh[4];
      #pragma unroll
      for(int ks=0;ks<4;++ks){
        asm volatile("ds_read_b64_tr_b16 %0,%1 offset:%c2":"=&v"(lo[ks]):"v"(vb),"i"(d0*4096+ks*1024):"memory");
        asm volatile("ds_read_b64_tr_b16 %0,%1 offset:%c2":"=&v"(hh[ks]):"v"(vb),"i"(d0*4096+ks*1024+512):"memory");}
      asm volatile("s_waitcnt lgkmcnt(0)":::"memory");SBAR();
      #define PK(k) (bf16x8){lo[k][0],lo[k][1],lo[k][2],lo[k][3],hh[k][0],hh[k][1],hh[k][2],hh[k][3]}
      o[d0]=__builtin_amdgcn_mfma_f32_32x32x16_bf16(PAF(0),PK(0),o[d0],0,0,0);
      o[d0]=__builtin_amdgcn_mfma_f32_32x32x16_bf16(PAF(1),PK(1),o[d0],0,0,0);
      o[d0]=__builtin_amdgcn_mfma_f32_32x32x16_bf16(PAF(2),PK(2),o[d0],0,0,0);
      o[d0]=__builtin_amdgcn_mfma_f32_32x32x16_bf16(PAF(3),PK(3),o[d0],0,0,0);
      #undef PK
    } }
  #undef PKW
  #undef PAF
  #undef VFR
  #undef PIN
  #undef MX3
  #undef MFQ
  #undef GAPA
  #undef GAPB
  #undef EX
  #undef VRD
  #undef KRD
  #undef STEP
  #undef ENDW
  #undef QF
  {auto rr=__builtin_amdgcn_permlane32_swap(__float_as_uint(l_reg),__float_as_uint(l_reg),false,false);l_reg=__uint_as_float(rr[0])+__uint_as_float(rr[1]);}
  if(hi==0)wsf[32+r32]=l_reg;asm volatile("s_waitcnt lgkmcnt(0)":::"memory");
  float rli[16];
  #pragma unroll
  for(int r=0;r<16;++r)rli[r]=__builtin_amdgcn_rcpf(wsf[32+crow(r,hi)]);
  bf16*Ow=O+(rowbase+q0+wid*QBLK)*PO;
  { bf16*stg=(bf16*)(shm+L2_QO)+wid*2048;
    #pragma unroll
    for(int hh=0;hh<2;++hh){
      #pragma unroll
      for(int r=0;r<16;++r){const int orow=crow(r,hi);
        #pragma unroll
        for(int d0=0;d0<2;++d0)stg[orow*64+d0*32+r32]=__float2bfloat16(o[2*hh+d0][r]*rli[r]);}
      asm volatile("s_waitcnt lgkmcnt(0)":::"memory");
      #pragma unroll
      for(int i=0;i<4;++i){const int row=i*8+(lane>>3),ch=lane&7; const u32x4 v=*(const u32x4*)(stg+row*64+ch*8); *(u32x4*)(Ow+(long)row*PO+hh*64+ch*8)=v;}
      asm volatile("s_waitcnt lgkmcnt(0)":::"memory"); } }
  asm volatile("s_waitcnt lgkmcnt(0)\n\ts_barrier":::"memory");
  #undef DMA_K
  #undef DMA_V
  #undef CMASK
  #undef RESC
  #undef ROT
}

constexpr int ATTN_LDS_BYTES=LDS_BYTES;
#undef SBAR
#undef WAIT_BAR
}
constexpr int NWAVES = 8;
typedef unsigned short bf16;
typedef unsigned v4u __attribute__((ext_vector_type(4)));
typedef unsigned v2u __attribute__((ext_vector_type(2)));
typedef float f32x4 __attribute__((ext_vector_type(4)));
typedef float f32x2 __attribute__((ext_vector_type(2)));
typedef short bf16x8 __attribute__((ext_vector_type(8)));
typedef GAS unsigned gu32;
#define RLX_AGENT __ATOMIC_RELAXED, __HIP_MEMORY_SCOPE_AGENT
#define LDS_WAIT() asm volatile("s_waitcnt lgkmcnt(0)" ::: "memory")
#define VM_WAIT() asm volatile("s_waitcnt vmcnt(0)" ::: "memory")
__device__ __forceinline__ unsigned f2bf(float f) { unsigned u = __builtin_bit_cast(unsigned, f); return (u + 0x7fffu + ((u >> 16) & 1u)) >> 16; }
__device__ __forceinline__ unsigned pk2(float lo, float hi) { return f2bf(lo) | (f2bf(hi) << 16); }
__device__ __forceinline__ float bf2f(unsigned short b) { return __builtin_bit_cast(float, (unsigned)b << 16); }
__device__ __forceinline__ float bflo(unsigned w) { return __builtin_bit_cast(float, w << 16); }
__device__ __forceinline__ float bfhi(unsigned w) { return __builtin_bit_cast(float, w & 0xffff0000u); }

#define XB_TMO      128
#define XB_XCNT(j)  (256  + 64 * (j))
#define XB_XSUB(j)  (1280 + 64 * (j))
#define XB_XGEN(j)  (2304 + 64 * (j))
#define XB_TOP      3328
#define XB_TOPGEN   3392
#define XCD_BAR_WORDS 3456
#define XB_SPIN_CAP (1u << 18)
__device__ __forceinline__ unsigned xb_ld(unsigned* p)              { return __hip_atomic_load(p, __ATOMIC_RELAXED, __HIP_MEMORY_SCOPE_AGENT); }
__device__ __forceinline__ unsigned xb_add(unsigned* p, unsigned v) { return __hip_atomic_fetch_add(p, v, __ATOMIC_RELAXED, __HIP_MEMORY_SCOPE_AGENT); }
__device__ __forceinline__ unsigned xb_xcc_id() { return (unsigned)__builtin_amdgcn_s_getreg((3 << 11) | 20) & 0xFu; }
#define XB_SPIN(cond, bar) do { unsigned _sp = 0; while (cond) { __builtin_amdgcn_s_sleep(1); \
    if ((++_sp & 255u) == 0u) { if (xb_ld(&(bar)[XB_TMO])) break; if (_sp > XB_SPIN_CAP) { atomicAdd(&(bar)[XB_TMO], 1u); break; } } } } while (0)
struct XcdBarrier { unsigned* bar; unsigned x; volatile LAS unsigned* st; };
__device__ __forceinline__ XcdBarrier xcd_barrier_post(unsigned* bar, volatile LAS unsigned* st) {
    XcdBarrier b; b.bar = bar; b.x = xb_xcc_id(); b.st = st;
    if (threadIdx.x == 0) (void)xb_add(&bar[XB_XCNT(b.x)], 1u);
    return b;
}
__device__ __forceinline__ void xcd_barrier_complete(unsigned* bar, unsigned x, unsigned& nloc, unsigned& nx) {
    const unsigned G = gridDim.x * gridDim.y * gridDim.z;
    unsigned sum, cnt, mine, sp = 0u;
    for (;;) {
        sum = 0u; cnt = 0u; mine = 0u;
#pragma unroll
        for (unsigned j = 0; j < 16; ++j) { const unsigned c = xb_ld(&bar[XB_XCNT(j)]); sum += c; cnt += (c > 0u) ? 1u : 0u; mine = (j == x) ? c : mine; }
        if (sum == G) break;
        __builtin_amdgcn_s_sleep(1);
        if ((++sp & 255u) == 0u) { if (xb_ld(&bar[XB_TMO])) break; if (sp > XB_SPIN_CAP) { atomicAdd(&bar[XB_TMO], 1u); break; } }
    }
    nloc = mine > 0u ? mine : 1u; nx = cnt > 0u ? cnt : 1u;
}
__device__ __forceinline__ void xcd_barrier(const XcdBarrier& b) {
    asm volatile("s_waitcnt vmcnt(0)" ::: "memory");
    __syncthreads();
    if (threadIdx.x == 0) {
        unsigned* bar = b.bar;
        __builtin_amdgcn_s_waitcnt(0);
        unsigned nloc = b.st[0], nx = b.st[1];
        if (nloc == 0u) { xcd_barrier_complete(bar, b.x, nloc, nx); b.st[0] = nloc; b.st[1] = nx; }
        const unsigned old = xb_add(&bar[XB_XSUB(b.x)], 1u);
        const unsigned gen = old / nloc;
        if (old + 1u == (gen + 1u) * nloc) {
            __builtin_amdgcn_fence(__ATOMIC_RELEASE, "agent");
            asm volatile("s_waitcnt vmcnt(0)" ::: "memory");
            const unsigned og = xb_add(&bar[XB_TOP], 1u);
            const unsigned tg = og / nx;
            if (og + 1u == (tg + 1u) * nx) xb_add(&bar[XB_TOPGEN], 1u);
            else XB_SPIN(xb_ld(&bar[XB_TOPGEN]) == tg, bar);
            __builtin_amdgcn_fence(__ATOMIC_ACQUIRE, "agent");
            xb_add(&bar[XB_XGEN(b.x)], 1u);
            asm volatile("s_waitcnt vmcnt(0)" ::: "memory");
        } else {
            XB_SPIN(xb_ld(&bar[XB_XGEN(b.x)]) == gen, bar);
            __builtin_amdgcn_fence(__ATOMIC_ACQUIRE, "agent");
            asm volatile("s_waitcnt vmcnt(0)" ::: "memory");
        }
    }
    __syncthreads();
}

struct Args { const float* in[18]; float* out; unsigned char* ws; int ph_lo, ph_hi, li, pad; };
struct Frame {
    LAS unsigned char* lds;
    gu32* ctl;
    unsigned char* ws;
    int tid, lane, wave;
    int vcu, G;
};

__device__ __forceinline__ float wave_sum(float v) {
#pragma unroll
    for (int o = 1; o < 64; o <<= 1) v += __shfl_xor(v, o);
    return v;
}
__device__ __forceinline__ void transpose_block(const float* src, int ld_src, bf16* dst, int ld_dst, LAS float* scr, int lane, bf16* dst2) {
#pragma unroll 8
    for (int i = 0; i < 32; ++i) { const int kk = 2 * i + (lane >> 5); scr[kk * 33 + (lane & 31)] = src[(size_t)kk * ld_src + (lane & 31)]; }
    LDS_WAIT(); asm volatile("" ::: "memory");
    const int c = lane & 7;
#pragma unroll
    for (int j = 0; j < 4; ++j) { const int n = (lane >> 3) + 8 * j; const LAS float* s = scr + (8 * c) * 33 + n;
        v4u o; o.x = pk2(s[0 * 33], s[1 * 33]); o.y = pk2(s[2 * 33], s[3 * 33]); o.z = pk2(s[4 * 33], s[5 * 33]); o.w = pk2(s[6 * 33], s[7 * 33]);
        *(GAS v4u*)(dst + (size_t)n * ld_dst + 8 * c) = o;
        if (dst2) *(GAS v4u*)(dst2 + (size_t)n * ld_dst + 8 * c) = o; }
    LDS_WAIT(); asm volatile("" ::: "memory");
}
__device__ __forceinline__ unsigned pk4_fp8f(float a, float b, float c, float d) { int w = 0; w = __builtin_amdgcn_cvt_pk_fp8_f32(a, b, w, false); w = __builtin_amdgcn_cvt_pk_fp8_f32(c, d, w, true); return (unsigned)w; }
__device__ __forceinline__ void transpose_block8(const float* src, int ld_src, unsigned char* dst, int ld_dst, float sc, LAS float* scr, int lane, unsigned char* dst2 = nullptr) {
#pragma unroll 8
    for (int i = 0; i < 32; ++i) { const int kk = 2 * i + (lane >> 5); scr[kk * 33 + (lane & 31)] = src[(size_t)kk * ld_src + (lane & 31)]; }
    LDS_WAIT(); asm volatile("" ::: "memory");
    const int c = lane & 7;
#pragma unroll
    for (int j = 0; j < 4; ++j) { const int n = (lane >> 3) + 8 * j; const LAS float* s = scr + (8 * c) * 33 + n;
        v2u o; o.x = pk4_fp8f(s[0 * 33] * sc, s[1 * 33] * sc, s[2 * 33] * sc, s[3 * 33] * sc); o.y = pk4_fp8f(s[4 * 33] * sc, s[5 * 33] * sc, s[6 * 33] * sc, s[7 * 33] * sc);
        *(GAS v2u*)(dst + (size_t)n * ld_dst + 8 * c) = o;
        if (dst2) *(GAS v2u*)(dst2 + (size_t)n * ld_dst + 8 * c) = o; }
    LDS_WAIT(); asm volatile("" ::: "memory");
}
__device__ __forceinline__ void rms_row_to_bf16(int lane, const float* xrow, const float* g, bf16* orow) {
    const GAS f32x4* xr = (const GAS f32x4*)xrow + lane; const GAS f32x4* gr = (const GAS f32x4*)g + lane;
    f32x4 v[4]; float s = 0.f;
#pragma unroll
    for (int j = 0; j < 4; ++j) { v[j] = xr[64 * j]; s += (v[j].x * v[j].x + v[j].y * v[j].y) + (v[j].z * v[j].z + v[j].w * v[j].w); }
    const float rstd = 1.0f / sqrtf(wave_sum(s) * (1.f / 1024.f) + RMS_EPS);
    GAS v2u* o8 = (GAS v2u*)orow + lane;
#pragma unroll
    for (int j = 0; j < 4; ++j) { const f32x4 gg = gr[64 * j]; v2u o; o.x = pk2(v[j].x * rstd * gg.x, v[j].y * rstd * gg.y); o.y = pk2(v[j].z * rstd * gg.z, v[j].w * rstd * gg.w); o8[64 * j] = o; }
}

__device__ __forceinline__ void rms_row_to_fp8(int lane, const float* xrow, const float* g, unsigned char* orow) {
    const GAS f32x4* xr = (const GAS f32x4*)xrow + lane; const GAS f32x4* gr = (const GAS f32x4*)g + lane;
    f32x4 v[4]; float s = 0.f;
#pragma unroll
    for (int j = 0; j < 4; ++j) { v[j] = xr[64 * j]; s += (v[j].x * v[j].x + v[j].y * v[j].y) + (v[j].z * v[j].z + v[j].w * v[j].w); }
    const float rstd = H8_SCALE / sqrtf(wave_sum(s) * (1.f / 1024.f) + RMS_EPS);
    GAS unsigned* o4 = (GAS unsigned*)orow + lane;
#pragma unroll
    for (int j = 0; j < 4; ++j) { const f32x4 gg = gr[64 * j]; o4[64 * j] = pk4_fp8f(v[j].x * rstd * gg.x, v[j].y * rstd * gg.y, v[j].z * rstd * gg.z, v[j].w * rstd * gg.w); }
}
constexpr int IT_WIN0 = (1024 / 64) * (3072 / 32);
constexpr int IT_WOUT0 = (1024 / 64) * (1024 / 32);
constexpr int IT_RIN = (1024 / 64) * (6144 / 32);
constexpr int IT_ROUT = (2048 / 64) * (1024 / 32);
constexpr int IT_SHARED = IT_WIN0 + IT_WOUT0 + IT_RIN + IT_ROUT;
constexpr int IT_EXP = 3 * 256;
constexpr int IT_MOE = NEXP * IT_EXP;
__device__ __forceinline__ void conv_shared_item(Frame& F, const Args& a, int it, LAS float* scr) {
    unsigned char* ws = F.ws;
    if (it < IT_WIN0) { const int nblk = 96, kb = it / nblk, nb = it % nblk;
        if (QKV_FP8) transpose_block8(a.in[5] + (size_t)(64 * kb) * 3072 + 32 * nb, 3072, ws + WS_WINT0 + (size_t)(32 * nb) * 1024 + 64 * kb, 1024, WIN_SCALE, scr, F.lane);
        else transpose_block(a.in[5] + (size_t)(64 * kb) * 3072 + 32 * nb, 3072, (bf16*)(ws + WS_WINT0) + (size_t)(32 * nb) * 1024 + 64 * kb, 1024, scr, F.lane, nullptr);
        return; }
    it -= IT_WIN0;
    if (it < IT_WOUT0) { const int nblk = 32, kb = it / nblk, nb = it % nblk;
        transpose_block(a.in[8] + (size_t)(64 * kb) * 1024 + 32 * nb, 1024, (bf16*)(ws + WS_WOUTT0) + (size_t)(32 * nb) * 1024 + 64 * kb, 1024, scr, F.lane, nullptr); return; }
    it -= IT_WOUT0;
    if (it < IT_RIN) { const int nblk = 192, kb = it / nblk, nb = it % nblk, n0 = 32 * nb;
        unsigned char* A = ws + WS_WRINA; unsigned char* B = ws + WS_WRINB; unsigned char *d1, *d2 = nullptr;
        if (n0 < 1024) d1 = A + (size_t)n0 * 1024;
        else if (n0 < 2048) { d1 = A + (size_t)n0 * 1024; d2 = B + (size_t)(n0 - 1024) * 1024; }
        else if (n0 < 4096) d1 = B + (size_t)(n0 - 1024) * 1024;
        else d1 = A + (size_t)(n0 - 2048) * 1024;
        transpose_block8(a.in[9] + (size_t)(64 * kb) * 6144 + n0, 6144, d1 + 64 * kb, 1024, WIN_SCALE, scr, F.lane, d2 ? d2 + 64 * kb : nullptr); return; }
    it -= IT_RIN;
    { const int nblk = 32, kb = it / nblk, nb = it % nblk;
        transpose_block(a.in[10] + (size_t)(64 * kb) * 1024 + 32 * nb, 1024, (bf16*)(ws + WS_WROUTT) + (size_t)(32 * nb) * 2048 + 64 * kb, 2048, scr, F.lane, nullptr); }
}
__device__ __forceinline__ void conv_moe_item(Frame& F, const Args& a, int layer, int it, LAS float* scr) {
    unsigned char* ws = F.ws;
    const int e = it / IT_EXP; int r = it % IT_EXP; const size_t le = (size_t)layer * NEXP + e;
    if (r < 512) { const int up = r >> 8; r &= 255; const int kb = r / 16, nb = r % 16, n0 = 32 * nb;
        const float* src = a.in[up ? 16 : 15] + le * (1024 * 512) + (size_t)(64 * kb) * 512 + n0;
        const int drow = 256 * (n0 >> 7) + 128 * up + (n0 & 127);
        transpose_block8(src, 512, ws + WS_W1CAT + ((size_t)e * 1024 + drow) * 1024 + 64 * kb, 1024, W1_SCALE, scr, F.lane); return; }
    r -= 512; { const int kb = r / 32, nb = r % 32;
        const float* src = a.in[17] + le * (512 * 1024) + (size_t)(64 * kb) * 1024 + 32 * nb;
        transpose_block8(src, 1024, ws + WS_W2T + ((size_t)e * 1024 + 32 * nb) * 512 + 64 * kb, 512, W2_SCALE, scr, F.lane); }
}
__device__ __forceinline__ void build_router_frags(Frame& F, const Args& a, int gtid, int gthreads) {
    bf16* wrf = (bf16*)(F.ws + WS_WRF);
    for (int idx = gtid; idx < 2 * 32 * 3 * 64 * 8; idx += gthreads) {
        const int j = idx & 7, lane = (idx >> 3) & 63, nt = (idx >> 9) % 3, s = ((idx >> 9) / 3) & 31, L = (idx >> 9) / 96;
        const int k = 32 * s + 8 * (lane >> 4) + j, o = 16 * nt + (lane & 15);
        float w = 0.f;
        if (o < 4) w = a.in[11][((size_t)L * 1024 + k) * 4 + o]; else if (o < 36) w = a.in[13][((size_t)L * 1024 + k) * 32 + (o - 4)];
        w *= a.in[3][L * 1024 + k];
        const unsigned hi = f2bf(w); const float lo = w - __builtin_bit_cast(float, hi << 16);
        const size_t base = ((((size_t)L * 32 + s) * 3 + nt) * 2) * 512 + (size_t)lane * 8 + j;
        wrf[base] = (bf16)hi; wrf[base + 512] = (bf16)f2bf(lo);
    }
}
__device__ __forceinline__ void build_sincos(Frame& F, int gtid, int gthreads) {
    float* t1 = (float*)(F.ws + WS_SINCOS); float* t2 = (float*)(F.ws + WS_SINCOST);
    for (int idx = gtid; idx < SEQ * 128; idx += gthreads) {
        const int pos = idx >> 7, i = idx & 127;
        double ang = 1.0, bs = 0.9300449458481391;
        for (int bit = 0; bit < 7; ++bit) { if ((i >> bit) & 1) ang *= bs; bs *= bs; }
        const double ph = (double)pos * ang;
        const double kq = __builtin_rint(ph * 0.63661977236758134308);
        double r = __builtin_fma(-kq, 1.57079632679489655800, ph); r = __builtin_fma(-kq, 6.12323399573676603587e-17, r);
        const double r2 = r * r;
        double sn = r * (1.0 + r2 * (-1.0 / 6 + r2 * (1.0 / 120 + r2 * (-1.0 / 5040 + r2 * (1.0 / 362880 + r2 * (-1.0 / 39916800 + r2 * (1.0 / 6227020800.0)))))));
        double cs = 1.0 + r2 * (-0.5 + r2 * (1.0 / 24 + r2 * (-1.0 / 720 + r2 * (1.0 / 40320 + r2 * (-1.0 / 3628800 + r2 * (1.0 / 479001600.0 + r2 * (-1.0 / 87178291200.0)))))));
        const int q = ((int)kq) & 3;
        double s_ = (q == 0) ? sn : (q == 1) ? cs : (q == 2) ? -sn : -cs;
        double c_ = (q == 0) ? cs : (q == 1) ? -sn : (q == 2) ? -cs : sn;
        t1[(size_t)idx * 2] = (float)c_; t1[(size_t)idx * 2 + 1] = (float)s_;
        const size_t j = ((size_t)i * SEQ + pos) * 2; t2[j] = (float)c_; t2[j + 1] = (float)s_;
    }
}
__device__ __forceinline__ void p_prologue(Frame& F, const Args& a) {
    LAS float* scr = (LAS float*)(F.lds + RING_OFF + F.wave * 16384);
    const int gw = F.vcu * NWAVES + F.wave, NGW = F.G * NWAVES;
    for (int it = gw; it < IT_SHARED + IT_MOE; it += NGW) { if (it < IT_SHARED) conv_shared_item(F, a, it, scr); else conv_moe_item(F, a, 0, it - IT_SHARED, scr); }
    build_router_frags(F, a, F.vcu * 512 + F.tid, F.G * 512);
    build_sincos(F, F.vcu * 512 + F.tid, F.G * 512);
    for (int m = gw; m < TOK; m += NGW) { if (QKV_FP8) rms_row_to_fp8(F.lane, a.in[0] + (size_t)m * DM, a.in[2], F.ws + WS_HB + (size_t)m * DM); else rms_row_to_bf16(F.lane, a.in[0] + (size_t)m * DM, a.in[2], (bf16*)(F.ws + WS_HB) + (size_t)m * DM); }
}
__device__ __forceinline__ void p_attention(Frame& F, const Args& a) {
    LAS float* lut = (LAS float*)(F.lds + LX_LUT);
    const attn_body::bf16* QKV = (const attn_body::bf16*)(F.ws + WS_QKV0);
    const float* lq = a.in[6];
    const float lam = __expf(wave_sum(lq[F.lane] * lq[64 + F.lane])) - __expf(wave_sum(lq[128 + F.lane] * lq[192 + F.lane])) + 0.2f;
    for (int v = F.vcu; v < 256; v += F.G) {
        const int bh = v >> 2, s = v & 3, b = bh >> 3, h = bh & 7;
        __syncthreads();
        for (int idx = F.tid; idx < 672; idx += 512) { const int n = idx - 288; float val = 0.f;
            if (n < 0) val = -INFINITY;
            else if (n < 113) { int bk = n; if (n >= 16) { bk = 16; const int thr[15] = {19, 21, 24, 27, 31, 35, 40, 46, 52, 59, 67, 77, 87, 99, 113};
#pragma unroll
                for (int q = 0; q < 15; ++q) bk += (n >= thr[q]) ? 1 : 0; }
                val = (a.in[1][bk * 8 + h] - a.in[1][31 * 8 + h]) * LOG2E; }
            lut[idx] = val; }
        __syncthreads();
#pragma nounroll
        for (int i = 0; i < 4; ++i) {
            const int qb = (i < 2) ? 7 - s : s, m = i & 1;
            attn_body::bf16* O = (attn_body::bf16*)(F.ws + WS_OP) + (size_t)m * TOK * 1024 + h * 128;
            attn_body::attn_unit128<8>(b, qb, QKV, h * 128 + m * 64, 1024 + h * 128 + m * 64, 2048 + h * 128, O, lut, (char*)F.lds + RING_OFF);
            if ((i & 1) == 1) {
                VM_WAIT(); __syncthreads();
                int t_ = threadIdx.x; asm volatile("" : "+v"(t_));
                const int row = b * SEQ + qb * 256 + (t_ >> 1), c0 = h * 128 + (t_ & 1) * 64;
                const bf16* O0 = (const bf16*)(F.ws + WS_OP) + (size_t)row * 1024 + c0; const bf16* O1 = O0 + (size_t)TOK * 1024; bf16* AO = (bf16*)(F.ws + WS_AO) + (size_t)row * 1024 + c0;
                const float* sg = a.in[7] + (t_ & 1) * 64;
                float ss = 0.f; v4u wa[8], wb[8];
#pragma unroll
                for (int q = 0; q < 8; ++q) { wa[q] = ((const GAS v4u*)O0)[q]; wb[q] = ((const GAS v4u*)O1)[q]; }
#pragma unroll
                for (int q = 0; q < 8; ++q) { const unsigned xa[4] = {wa[q].x, wa[q].y, wa[q].z, wa[q].w}, xb[4] = {wb[q].x, wb[q].y, wb[q].z, wb[q].w};
#pragma unroll
                    for (int j = 0; j < 4; ++j) { const float o0 = bflo(xa[j]) - lam * bflo(xb[j]), o1 = bfhi(xa[j]) - lam * bfhi(xb[j]); ss += o0 * o0 + o1 * o1; } }
                ss += __shfl_xor(ss, 1);
                const float rstd = 0.8f / sqrtf(ss * (1.f / 128.f) + SUBLN_EPS);
#pragma unroll
                for (int q = 0; q < 8; ++q) { const unsigned xa[4] = {wa[q].x, wa[q].y, wa[q].z, wa[q].w}, xb[4] = {wb[q].x, wb[q].y, wb[q].z, wb[q].w}; unsigned r[4];
                    const f32x4 g0 = *(const GAS f32x4*)(sg + q * 8), g1 = *(const GAS f32x4*)(sg + q * 8 + 4); const float gg[8] = {g0.x, g0.y, g0.z, g0.w, g1.x, g1.y, g1.z, g1.w};
#pragma unroll
                    for (int j = 0; j < 4; ++j) r[j] = pk2((bflo(xa[j]) - lam * bflo(xb[j])) * rstd * gg[2 * j], (bfhi(xa[j]) - lam * bfhi(xb[j])) * rstd * gg[2 * j + 1]);
                    v4u o; o.x = r[0]; o.y = r[1]; o.z = r[2]; o.w = r[3]; ((GAS v4u*)AO)[q] = o; }
            }
        }
    }
}
__device__ __forceinline__ void p_diffcombine(Frame& F, const Args& a) {
    const int gw = F.vcu * NWAVES + F.wave, NGW = F.G * NWAVES, lane = F.lane;
    const float* lq = a.in[6];
    const float lam = __expf(wave_sum(lq[lane] * lq[64 + lane])) - __expf(wave_sum(lq[128 + lane] * lq[192 + lane])) + 0.2f;
    const int d0 = (lane & 7) * 16; float g[16];
#pragma unroll
    for (int j = 0; j < 16; ++j) g[j] = a.in[7][d0 + j] * 0.8f;
    const bf16* O0 = (const bf16*)(F.ws + WS_OP); const bf16* O1 = O0 + (size_t)TOK * 1024; bf16* AO = (bf16*)(F.ws + WS_AO);
    for (int m = gw; m < TOK; m += NGW) {
        const GAS v4u* p0 = (const GAS v4u*)(O0 + (size_t)m * 1024 + lane * 16); const GAS v4u* p1 = (const GAS v4u*)(O1 + (size_t)m * 1024 + lane * 16);
        const v4u a0 = p0[0], a1 = p0[1], b0 = p1[0], b1 = p1[1];
        const unsigned wa[8] = {a0.x, a0.y, a0.z, a0.w, a1.x, a1.y, a1.z, a1.w}, wb[8] = {b0.x, b0.y, b0.z, b0.w, b1.x, b1.y, b1.z, b1.w};
        float o[16]; float ss = 0.f;
#pragma unroll
        for (int j = 0; j < 8; ++j) { o[2 * j] = bflo(wa[j]) - lam * bflo(wb[j]); o[2 * j + 1] = bfhi(wa[j]) - lam * bfhi(wb[j]); ss += o[2 * j] * o[2 * j] + o[2 * j + 1] * o[2 * j + 1]; }
        ss += __shfl_xor(ss, 1); ss += __shfl_xor(ss, 2); ss += __shfl_xor(ss, 4);
        const float rstd = 1.0f / sqrtf(ss * (1.f / 128.f) + SUBLN_EPS);
        v4u w0, w1;
        w0.x = pk2(o[0] * rstd * g[0], o[1] * rstd * g[1]); w0.y = pk2(o[2] * rstd * g[2], o[3] * rstd * g[3]); w0.z = pk2(o[4] * rstd * g[4], o[5] * rstd * g[5]); w0.w = pk2(o[6] * rstd * g[6], o[7] * rstd * g[7]);
        w1.x = pk2(o[8] * rstd * g[8], o[9] * rstd * g[9]); w1.y = pk2(o[10] * rstd * g[10], o[11] * rstd * g[11]); w1.z = pk2(o[12] * rstd * g[12], o[13] * rstd * g[13]); w1.w = pk2(o[14] * rstd * g[14], o[15] * rstd * g[15]);
        GAS v4u* po = (GAS v4u*)(AO + (size_t)m * 1024 + lane * 16); po[0] = w0; po[1] = w1;
    }
}
template <int LAYER> __device__ __forceinline__ void p_router(Frame& F, const Args& a, const float* xres, int bank = LAYER) {
    typedef float f32x4v __attribute__((ext_vector_type(4)));
    LAS float* part = (LAS float*)(F.lds + RING_OFF);
    LAS float* ssqp = (LAS float*)(F.lds + RING_OFF + 98304);
    LAS float* logit = (LAS float*)(F.lds + RING_OFF + 100352);
    LAS float* rstd_s = (LAS float*)(F.lds + RING_OFF + 109568);
    LAS int* lcnt = (LAS int*)(F.lds + RING_OFF + 109824);
    LAS int* lbase = (LAS int*)(F.lds + RING_OFF + 109952);
    const int lane = F.lane, w = F.wave, row = lane & 15, kg = lane >> 4;
    const bf16x8* wrf = (const bf16x8*)(F.ws + WS_WRF) + (size_t)LAYER * (32 * 3 * 2 * 64);
    bf16x8 Bh[4][3], Bl[4][3];
#pragma unroll
    for (int s = 0; s < 4; ++s)
#pragma unroll
        for (int nt = 0; nt < 3; ++nt) { Bh[s][nt] = wrf[(((4 * w + s) * 3 + nt) * 2 + 0) * 64 + lane]; Bl[s][nt] = wrf[(((4 * w + s) * 3 + nt) * 2 + 1) * 64 + lane]; }
    const float* gffn = a.in[3] + LAYER * 1024; const float* bg = a.in[12] + LAYER * 4; const float* be = a.in[14] + LAYER * 32;
    int* list = (int*)(F.ws + WS_LIST); float* pairw = (float*)(F.ws + WS_PAIRW); bf16* HB = (bf16*)(F.ws + WS_HB);
    for (int tb = F.vcu; tb < TOK / 64; tb += F.G) {
        __syncthreads();
        if (F.tid < 32) lcnt[F.tid] = 0;
        f32x4v acc[4][3];
#pragma unroll
        for (int mt = 0; mt < 4; ++mt)
#pragma unroll
            for (int nt = 0; nt < 3; ++nt) acc[mt][nt] = (f32x4v){0.f, 0.f, 0.f, 0.f};
#pragma unroll
        for (int mt = 0; mt < 4; ++mt) { const float* xr = xres + (size_t)(tb * 64 + mt * 16 + row) * DM + 128 * w + 8 * kg; float ss = 0.f;
#pragma unroll
            for (int s = 0; s < 4; ++s) { const f32x4 x0 = *(const GAS f32x4*)(xr + 32 * s), x1 = *(const GAS f32x4*)(xr + 32 * s + 4);
                const float xv[8] = {x0.x, x0.y, x0.z, x0.w, x1.x, x1.y, x1.z, x1.w}; bf16x8 ah, al;
#pragma unroll
                for (int j = 0; j < 8; ++j) { ss += xv[j] * xv[j]; const unsigned hi = f2bf(xv[j]); ah[j] = (short)hi; al[j] = (short)f2bf(xv[j] - __builtin_bit_cast(float, hi << 16)); }
#pragma unroll
                for (int nt = 0; nt < 3; ++nt) { acc[mt][nt] = __builtin_amdgcn_mfma_f32_16x16x32_bf16(ah, Bh[s][nt], acc[mt][nt], 0, 0, 0);
                    acc[mt][nt] = __builtin_amdgcn_mfma_f32_16x16x32_bf16(ah, Bl[s][nt], acc[mt][nt], 0, 0, 0); acc[mt][nt] = __builtin_amdgcn_mfma_f32_16x16x32_bf16(al, Bh[s][nt], acc[mt][nt], 0, 0, 0); } }
            ss += __shfl_xor(ss, 16); ss += __shfl_xor(ss, 32);
            if (kg == 0) ssqp[w * 64 + mt * 16 + row] = ss;
#pragma unroll
            for (int nt = 0; nt < 3; ++nt)
#pragma unroll
                for (int r = 0; r < 4; ++r) part[(w * 64 + mt * 16 + 4 * kg + r) * 48 + nt * 16 + row] = acc[mt][nt][r]; }
        __syncthreads();
        if (F.tid < 64) { float s = 0.f;
#pragma unroll
            for (int q = 0; q < 8; ++q) s += ssqp[q * 64 + F.tid];
            rstd_s[F.tid] = 1.0f / sqrtf(s * (1.f / 1024.f) + RMS_EPS); }
        __syncthreads();
        for (int idx = F.tid; idx < 64 * 36; idx += 512) { const int tk = idx / 36, o = idx % 36; float s = 0.f;
#pragma unroll
            for (int q = 0; q < 8; ++q) s += part[(q * 64 + tk) * 48 + o];
            logit[tk * 36 + o] = s * rstd_s[tk] + (o < 4 ? bg[o] : be[o - 4]); }
        __syncthreads();
        if (w == 0) {
            const LAS float* lg = logit + lane * 36;
            int gi = 0; float gm = lg[0];
#pragma unroll
            for (int j = 1; j < 4; ++j) { const float v = lg[j]; if (v > gm) { gm = v; gi = j; } }
            float gs = 0.f;
#pragma unroll
            for (int j = 0; j < 4; ++j) gs += __expf(lg[j] - gm);
            const float gp = 1.0f / gs;
            const LAS float* le = lg + 4 + gi * 8;
            int i1 = 0; float v1 = le[0];
#pragma unroll
            for (int j = 1; j < 8; ++j) { const float v = le[j]; if (v > v1) { v1 = v; i1 = j; } }
            int i2 = -1; float v2 = -INFINITY;
#pragma unroll
            for (int j = 0; j < 8; ++j) { const float v = le[j]; if (j != i1 && v > v2) { v2 = v; i2 = j; } }
            const float e2 = __expf(v2 - v1), w1 = gp / (1.0f + e2), w2 = gp * e2 / (1.0f + e2);
            const int e_1 = gi * 8 + i1, e_2 = gi * 8 + i2;
            const int r1 = __hip_atomic_fetch_add(lcnt + e_1, 1, __ATOMIC_RELAXED, __HIP_MEMORY_SCOPE_WORKGROUP);
            const int r2 = __hip_atomic_fetch_add(lcnt + e_2, 1, __ATOMIC_RELAXED, __HIP_MEMORY_SCOPE_WORKGROUP);
            LDS_WAIT();
            if (lane < 32) { const int c = lcnt[lane]; int bs = 0; if (c > 0) bs = (int)__hip_atomic_fetch_add((unsigned*)(F.ctl + CW_CNT + (bank * 32 + lane) * 64), (unsigned)c, RLX_AGENT); lbase[lane] = bs; }
            LDS_WAIT();
            const int tg = tb * 64 + lane; const int p1 = lbase[e_1] + r1, p2 = lbase[e_2] + r2;
            list[e_1 * LISTCAP + p1] = 2 * tg; list[e_2 * LISTCAP + p2] = 2 * tg + 1; pairw[2 * tg] = w1; pairw[2 * tg + 1] = w2;
        }
        for (int i = 0; i < 8; ++i) { const int tk = w * 8 + i, tg = tb * 64 + tk; const float rs = rstd_s[tk];
            const GAS f32x4* xr = (const GAS f32x4*)(xres + (size_t)tg * DM) + lane; const GAS f32x4* gr = (const GAS f32x4*)gffn + lane; GAS unsigned* o4 = (GAS unsigned*)((unsigned char*)HB + (size_t)tg * DM) + lane;
#pragma unroll
            for (int j = 0; j < 4; ++j) { const f32x4 v = xr[64 * j], gg = gr[64 * j]; const float rs8 = rs * H8_SCALE; o4[64 * j] = pk4_fp8f(v.x * rs8 * gg.x, v.y * rs8 * gg.y, v.z * rs8 * gg.z, v.w * rs8 * gg.w); } }
    }
}
template <int LAYER> __device__ __forceinline__ void moe_setup(Frame& F) {
    LAS int* tstart = (LAS int*)(F.lds + LX_TSTART); LAS int* texp = (LAS int*)(F.lds + LX_TEXP); LAS int* lc = (LAS int*)(F.lds + LX_CNT);
    __syncthreads();
    if (F.tid < 32) { int c = (int)__hip_atomic_load((unsigned*)(F.ctl + CW_CNT + (LAYER * 32 + F.tid) * 64), RLX_AGENT); c = c < 0 ? 0 : (c > LISTCAP ? LISTCAP : c); lc[F.tid] = c; }
    __syncthreads();
    if (F.tid == 0) { int acc = 0; for (int e = 0; e < 32; ++e) { tstart[e] = acc; acc += (lc[e] + 255) >> 8; } if (acc > MAXRT) acc = MAXRT; tstart[32] = acc; tstart[33] = acc; }
    __syncthreads();
    if (F.tid < MAXRT) { int e = 0;
#pragma unroll 1
        for (int q = 1; q < 32; ++q) if (tstart[q] <= F.tid) e = q;
        texp[F.tid] = e; }
    __syncthreads();
}
template <int LAYER> __device__ __forceinline__ void p_moe1(Frame& F) {
    moe_setup<LAYER>(F);
    const LAS int* tstart = (const LAS int*)(F.lds + LX_TSTART); const LAS int* texp = (const LAS int*)(F.lds + LX_TEXP); const LAS int* lc = (const LAS int*)(F.lds + LX_CNT);
    LAS int* rowtab = (LAS int*)(F.lds + LX_ROWTAB);
    pg8::MoeOrder S{F.G, F.vcu, 512, 0, tstart, texp};
    const int* list = (const int*)(F.ws + WS_LIST);
    pg8::Unit u;
    for (int i = 0; i < 4 && S.next(i, u); ++i) { if (F.tid < 256) { const int e = u.pn >> 2, pos = u.aux * 256 + F.tid; rowtab[i * 256 + F.tid] = (pos < lc[e]) ? (list[e * LISTCAP + pos] >> 1) : 0; } }
    VM_WAIT(); __syncthreads();
    pg8::Gemm g{(const bf16*)(F.ws + WS_HB), (const bf16*)(F.ws + WS_W1CAT), 512, 512, 512};
    pg8::EpiMoe1 E{(unsigned char*)(F.ws + WS_MACT)};
    pg8::gemm_phase<pg8::EpiMoe1, pg8::MoeOrder, true, true, true>(F.lds + RING_OFF, g, S, E, rowtab);
}
template <int LAYER> __device__ __forceinline__ void p_moe2(Frame& F) {
    moe_setup<LAYER>(F);
    const LAS int* tstart = (const LAS int*)(F.lds + LX_TSTART); const LAS int* texp = (const LAS int*)(F.lds + LX_TEXP); const LAS int* lc = (const LAS int*)(F.lds + LX_CNT);
    pg8::MoeOrder S{F.G, F.vcu, 256, 256 * 256, tstart, texp};
    pg8::Gemm g{(const bf16*)(F.ws + WS_MACT), (const bf16*)(F.ws + WS_W2T), 256, 256, 256};
    pg8::EpiMoe2 E{(bf16*)(F.ws + WS_Y), (const int*)(F.ws + WS_LIST), (const float*)(F.ws + WS_PAIRW), lc};
    pg8::gemm_phase<pg8::EpiMoe2, pg8::MoeOrder, true, false, true>(F.lds + RING_OFF, g, S, E, nullptr);
}
template <bool FINAL> __device__ __forceinline__ void p_combine(Frame& F, float* xres, const float* g, float* dry = nullptr) {
    const int gw = F.vcu * NWAVES + F.wave, NGW = F.G * NWAVES, lane = F.lane;
    const bf16* Y = (const bf16*)(F.ws + WS_Y); bf16* HB = (bf16*)(F.ws + WS_HB);
    for (int m = gw; m < TOK; m += NGW) {
        GAS f32x4* xr = (GAS f32x4*)(xres + (size_t)m * DM) + lane; GAS f32x4* xw = dry ? (GAS f32x4*)(dry + (size_t)m * DM) + lane : xr; const GAS v2u* y0 = (const GAS v2u*)(Y + (size_t)(2 * m) * DM) + lane; const GAS v2u* y1 = (const GAS v2u*)(Y + (size_t)(2 * m + 1) * DM) + lane;
        const GAS f32x4* gr = (const GAS f32x4*)g + lane;
        f32x4 v[4]; float s = 0.f;
#pragma unroll
        for (int j = 0; j < 4; ++j) { const f32x4 x = xr[64 * j]; const v2u p = y0[64 * j], q = y1[64 * j];
            v[j].x = x.x + bflo(p.x) + bflo(q.x); v[j].y = x.y + bfhi(p.x) + bfhi(q.x); v[j].z = x.z + bflo(p.y) + bflo(q.y); v[j].w = x.w + bfhi(p.y) + bfhi(q.y);
            s += (v[j].x * v[j].x + v[j].y * v[j].y) + (v[j].z * v[j].z + v[j].w * v[j].w); }
        const float rstd = 1.0f / sqrtf(wave_sum(s) * (1.f / 1024.f) + RMS_EPS);
        if (FINAL) {
#pragma unroll
            for (int j = 0; j < 4; ++j) { const f32x4 gg = gr[64 * j]; f32x4 o; o.x = v[j].x * rstd * gg.x; o.y = v[j].y * rstd * gg.y; o.z = v[j].z * rstd * gg.z; o.w = v[j].w * rstd * gg.w; xw[64 * j] = o; }
        } else {
            GAS unsigned* o4 = (GAS unsigned*)((dry ? (unsigned char*)(dry + (size_t)TOK * DM) : (unsigned char*)HB) + (size_t)m * DM) + lane; const float r8 = rstd * H8_SCALE;
#pragma unroll
            for (int j = 0; j < 4; ++j) { xw[64 * j] = v[j]; const f32x4 gg = gr[64 * j]; o4[64 * j] = pk4_fp8f(v[j].x * r8 * gg.x, v[j].y * r8 * gg.y, v[j].z * r8 * gg.z, v[j].w * r8 * gg.w); }
        }
    }
}
__device__ __forceinline__ void p_scan(Frame& F) {
    const bf16* DS = (const bf16*)(F.ws + WS_DS); bf16* BT = (bf16*)(F.ws + WS_BTCAT);
    for (int gidx = F.vcu * 512 + F.tid; gidx < NB * RH * 16384; gidx += F.G * 512) {
        const int bh = gidx >> 14, e8 = gidx & 16383, dv = e8 >> 5, dk0 = (e8 & 31) * 8, h = bh & 3;
        const float cd = __builtin_amdgcn_exp2f(256.0f * pg8::log2_gamma(h));
        v4u d[7];
#pragma unroll
        for (int n = 0; n < 7; ++n) d[n] = *(const GAS v4u*)(DS + ((size_t)(bh * RNC + n) * RDV + dv) * RDK + dk0);
        float s[8];
#pragma unroll
        for (int j = 0; j < 8; ++j) s[j] = 0.f;
#pragma unroll
        for (int n = 0; n < 8; ++n) {
            v4u o; o.x = pk2(s[0], s[1]); o.y = pk2(s[2], s[3]); o.z = pk2(s[4], s[5]); o.w = pk2(s[6], s[7]);
            *(GAS v4u*)(BT + ((size_t)(bh * RNC + n) * RDV + dv) * 512 + 256 + dk0) = o;
            if (n < 7) { const unsigned wv[4] = {d[n].x, d[n].y, d[n].z, d[n].w};
#pragma unroll
                for (int j = 0; j < 4; ++j) { s[2 * j] = cd * (s[2 * j] + bflo(wv[j])); s[2 * j + 1] = cd * (s[2 * j + 1] + bfhi(wv[j])); } }
        }
    }
}
__device__ __forceinline__ void p_normgate(Frame& F, bf16* dry = nullptr) {
    const int gw = F.vcu * NWAVES + F.wave, NGW = F.G * NWAVES, lane = F.lane;
    const bf16* OR = (const bf16*)(F.ws + WS_ORET); bf16* SG = (bf16*)(F.ws + WS_SG);
    for (int m = gw; m < TOK; m += NGW) {
        const GAS v4u* po = (const GAS v4u*)(OR + (size_t)m * 2048 + lane * 32); GAS v4u* pg = (GAS v4u*)(SG + (size_t)m * 2048 + lane * 32); GAS v4u* pw = dry ? (GAS v4u*)(dry + (size_t)m * 2048 + lane * 32) : pg;
        v4u ov[4], gv[4]; float ss = 0.f;
#pragma unroll
        for (int q = 0; q < 4; ++q) { ov[q] = po[q]; gv[q] = pg[q]; }
#pragma unroll
        for (int q = 0; q < 4; ++q) { const unsigned wv[4] = {ov[q].x, ov[q].y, ov[q].z, ov[q].w};
#pragma unroll
            for (int j = 0; j < 4; ++j) { const float x0 = bflo(wv[j]), x1 = bfhi(wv[j]); ss += x0 * x0 + x1 * x1; } }
        ss += __shfl_xor(ss, 1); ss += __shfl_xor(ss, 2); ss += __shfl_xor(ss, 4); ss += __shfl_xor(ss, 8);
        const float rstd = 1.0f / sqrtf(ss * (1.f / 512.f) + RMS_EPS);
#pragma unroll
        for (int q = 0; q < 4; ++q) { const unsigned wv[4] = {ov[q].x, ov[q].y, ov[q].z, ov[q].w}, wg[4] = {gv[q].x, gv[q].y, gv[q].z, gv[q].w}; unsigned r[4];
#pragma unroll
            for (int j = 0; j < 4; ++j) r[j] = pk2(bflo(wv[j]) * rstd * bflo(wg[j]), bfhi(wv[j]) * rstd * bfhi(wg[j]));
            v4u o; o.x = r[0]; o.y = r[1]; o.z = r[2]; o.w = r[3]; pw[q] = o; }
    }
}
__device__ __forceinline__ void p_conv_moe1(Frame& F, const Args& a) {
    LAS float* scr = (LAS float*)(F.lds + RING_OFF + F.wave * 16384);
    const int gw = F.vcu * NWAVES + F.wave, NGW = F.G * NWAVES;
    for (int it = gw; it < IT_MOE; it += NGW) conv_moe_item(F, a, 1, it, scr);
}

constexpr int N_PHASES = 19;
#ifndef MK_PER_PHASE
#define MK_PER_PHASE 0
#endif
__global__ void __launch_bounds__(NWAVES * 64, 2) hybrid_fwd(Args args) {
    extern __shared__ __attribute__((aligned(16))) unsigned char lds[];
    Frame F;
    F.lds = (LAS unsigned char*)lds;
    F.tid = threadIdx.x; F.lane = F.tid & 63; F.wave = __builtin_amdgcn_readfirstlane(F.tid >> 6);
    F.G = gridDim.x; { const int bx = blockIdx.x; F.vcu = (F.G % 8 == 0) ? (bx % 8) * (F.G / 8) + bx / 8 : bx; }
    F.ws = args.ws; F.ctl = (gu32*)(args.ws + WS_CTL);
    for (int u = F.tid; u < (LDS_BYTES - LX_OFF) / 4; u += NWAVES * 64) ((LAS unsigned*)(F.lds + LX_OFF))[u] = 0u;
    __syncthreads();
    XcdBarrier bar; bar.bar = (unsigned*)(F.ctl + CW_BAR); bar.x = 0; bar.st = nullptr;
    if (!MK_PER_PHASE) bar = xcd_barrier_post((unsigned*)(F.ctl + CW_BAR), (volatile LAS unsigned*)(F.lds + LX_MISC) + 8);
    const int lo = args.ph_lo, hi = args.ph_hi;
#ifndef PH_MASK
#define PH_MASK 0x7ffff
#endif
#define IN(k) (((PH_MASK >> (k)) & 1) && lo <= (k) && (k) < hi)
#define SEAM(k) do { if (IN(k) && IN((k) + 1)) xcd_barrier(bar); } while (0)
#define REFRESH() do { int t_ = threadIdx.x; asm volatile("" : "+v"(t_)); F.tid = t_; F.lane = t_ & 63; } while (0)
#ifndef DUP_MASK
#define DUP_MASK 0
#endif
#ifndef XBAR_N
#define XBAR_N 0
#endif
#define DUP(k) (((DUP_MASK >> (k)) & 1) != 0)
    float* xres = args.out;
    unsigned char* ws = args.ws;
    const int bx = (int)blockIdx.x;

    if (IN(0)) { REFRESH(); p_prologue(F, args); if (DUP(0)) { xcd_barrier(bar); p_prologue(F, args); } for (int q = 0; q < XBAR_N; ++q) xcd_barrier(bar); } SEAM(0);
    if (IN(1)) { REFRESH(); for (int rep_ = 0; rep_ < (DUP(1) ? 2 : 1); ++rep_) { if (rep_) xcd_barrier(bar);
        constexpr int KQ = QKV_FP8 ? 512 : 1024; pg8::Gemm g{(const bf16*)(ws + WS_HB), (const bf16*)(ws + WS_WINT0), KQ, KQ, KQ}; pg8::StaticOrder S; S.init(TOK, 3072, F.G, bx, KQ, KQ);
        pg8::EpiQKV E{(bf16*)(ws + WS_QKV0), ATT_C2};
        pg8::gemm_phase<pg8::EpiQKV, pg8::StaticOrder, true, false, (QKV_FP8 != 0)>(F.lds + RING_OFF, g, S, E, nullptr);
    }
    } SEAM(1);
    if (IN(2)) { REFRESH(); p_attention(F, args); if (DUP(2)) { xcd_barrier(bar); p_attention(F, args); } } if (IN(2) && IN(4)) xcd_barrier(bar);
    if (IN(4)) { REFRESH(); for (int rep_ = 0; rep_ < (DUP(4) ? 2 : 1); ++rep_) { if (rep_) xcd_barrier(bar);
        pg8::Gemm g{(const bf16*)(ws + WS_AO), (const bf16*)(ws + WS_WOUTT0), 1024, 1024, 1024}; pg8::StaticOrder S; S.init(TOK, 1024, F.G, bx, 1024, 1024);
        pg8::EpiRes E{args.in[0], xres};
        pg8::gemm_phase<pg8::EpiRes, pg8::StaticOrder, true, false>(F.lds + RING_OFF, g, S, E, nullptr);
    }
    } SEAM(4);
    if (IN(5)) { REFRESH(); p_router<0>(F, args, xres); if (DUP(5)) { xcd_barrier(bar); p_router<0>(F, args, xres, 2); } } SEAM(5);
    if (IN(6)) { REFRESH(); p_moe1<0>(F); if (DUP(6)) { xcd_barrier(bar); p_moe1<0>(F); } } SEAM(6);
    if (IN(7)) { REFRESH(); p_moe2<0>(F); if (DUP(7)) { xcd_barrier(bar); p_moe2<0>(F); } } SEAM(7);
    if (IN(8)) { REFRESH(); if (DUP(8)) { p_combine<false>(F, xres, args.in[2] + 1024, (float*)(ws + WS_KI)); xcd_barrier(bar); } p_combine<false>(F, xres, args.in[2] + 1024); } SEAM(8);
    if (IN(9)) { REFRESH(); for (int rep_ = 0; rep_ < (DUP(9) ? 2 : 1); ++rep_) { if (rep_) xcd_barrier(bar);
        { pg8::Gemm g{(const bf16*)(ws + WS_HB), (const bf16*)(ws + WS_WRINA), 512, 512, 512}; pg8::StaticOrder S; S.init(TOK, 4096, F.G, bx, 512, 512);
          pg8::EpiRetA E{(bf16*)(ws + WS_ACAT), (bf16*)(ws + WS_KI), (bf16*)(ws + WS_SG), (const float*)(ws + WS_SINCOS)};
          pg8::gemm_phase<pg8::EpiRetA, pg8::StaticOrder, true, false, true>(F.lds + RING_OFF, g, S, E, nullptr); }
        { pg8::Gemm g{(const bf16*)(ws + WS_WRINB), (const bf16*)(ws + WS_HB), 512, 512, 512}; pg8::StaticOrder S; S.init(3072, TOK, F.G, bx, 512, 512);
          pg8::EpiRetB E{(bf16*)(ws + WS_KIT), (bf16*)(ws + WS_BTCAT), (const float*)(ws + WS_SINCOST)};
          pg8::gemm_phase<pg8::EpiRetB, pg8::StaticOrder, true, false, true>(F.lds + RING_OFF, g, S, E, nullptr); }
    }
    } SEAM(9);
    if (IN(10)) { REFRESH(); for (int rep_ = 0; rep_ < (DUP(10) ? 2 : 1); ++rep_) { if (rep_) xcd_barrier(bar);
        { pg8::Gemm g{(const bf16*)(ws + WS_ACAT), (const bf16*)(ws + WS_KI), 512, 1024, 256}; pg8::ScoresOrder S{F.G, F.vcu};
          pg8::EpiScores E{(bf16*)(ws + WS_ACAT)};
          pg8::gemm_phase<pg8::EpiScores, pg8::ScoresOrder, true, false>(F.lds + RING_OFF, g, S, E, nullptr); }
        { pg8::Gemm g{(const bf16*)(ws + WS_BTCAT), (const bf16*)(ws + WS_KIT), 512, 2048, 256}; pg8::DsOrder S{F.G, F.vcu};
          pg8::EpiDS E{(bf16*)(ws + WS_DS)};
          pg8::gemm_phase<pg8::EpiDS, pg8::DsOrder, true, false>(F.lds + RING_OFF, g, S, E, nullptr); }
    }
    } SEAM(10);
    if (IN(11)) { REFRESH(); p_scan(F); if (DUP(11)) { xcd_barrier(bar); p_scan(F); } } SEAM(11);
    if (IN(12)) { REFRESH(); for (int rep_ = 0; rep_ < (DUP(12) ? 2 : 1); ++rep_) { if (rep_) xcd_barrier(bar);
        pg8::Gemm g{(const bf16*)(ws + WS_ACAT), (const bf16*)(ws + WS_BTCAT), 512, 512, 512}; pg8::RetOOrder S{F.G, F.vcu};
        pg8::EpiRetO E{(bf16*)(ws + WS_ORET), (bf16*)(ws + WS_SG), (LAS float*)(F.lds + LX_SSQ)};
        pg8::gemm_phase<pg8::EpiRetO, pg8::RetOOrder, true, false>(F.lds + RING_OFF, g, S, E, nullptr);
    }
    } if (IN(12) && IN(14)) xcd_barrier(bar);
    if (IN(14)) { REFRESH(); for (int rep_ = (DUP(14) ? 0 : 1); rep_ < 2; ++rep_) { if (rep_ && DUP(14)) xcd_barrier(bar);
        pg8::Gemm g{(const bf16*)(ws + WS_SG), (const bf16*)(ws + WS_WROUTT), 2048, 2048, 2048}; pg8::StaticOrder S; S.init(TOK, 1024, F.G, bx, 2048, 2048);
        pg8::EpiRes E{xres, rep_ ? xres : (float*)(ws + WS_ACAT)};
        pg8::gemm_phase<pg8::EpiRes, pg8::StaticOrder, true, false>(F.lds + RING_OFF, g, S, E, nullptr);
    }
    } SEAM(14);
    if (IN(15)) { REFRESH(); p_router<1>(F, args, xres); __syncthreads(); p_conv_moe1(F, args); if (DUP(15)) { xcd_barrier(bar); p_router<1>(F, args, xres, 3); __syncthreads(); p_conv_moe1(F, args); } } SEAM(15);
    if (IN(16)) { REFRESH(); p_moe1<1>(F); } SEAM(16);
    if (IN(17)) { REFRESH(); p_moe2<1>(F); } SEAM(17);
    if (IN(18)) { REFRESH(); if (DUP(18)) { p_combine<true>(F, xres, args.in[4], (float*)(ws + WS_KI)); xcd_barrier(bar); } p_combine<true>(F, xres, args.in[4]); }
#undef IN
#undef SEAM
}

extern "C" void kernel_launch(void* const* d_in, const int* in_sizes, int n_in, void* d_out, int out_size, void* d_ws, size_t ws_size, hipStream_t stream) {
    static int grid = 0;
    if (grid == 0) {
        if (n_in != 18 || in_sizes[0] != TOK * DM || out_size != TOK * DM || ws_size < WS_END) { fprintf(stderr, "kernel_launch: unexpected shapes / workspace (n_in %d, in0 %d, out %d, ws %zu < %zu); nothing launched\n", n_in, n_in > 0 ? in_sizes[0] : -1, out_size, ws_size, (size_t)WS_END); grid = -1; return; }
        int dev = 0, cus = 0, per_cu = 0;
        if (hipGetDevice(&dev) != hipSuccess || hipDeviceGetAttribute(&cus, hipDeviceAttributeMultiprocessorCount, dev) != hipSuccess) { grid = -1; return; }
        if (hipFuncSetAttribute((const void*)hybrid_fwd, hipFuncAttributeMaxDynamicSharedMemorySize, LDS_BYTES) != hipSuccess) { fprintf(stderr, "kernel_launch: hipFuncSetAttribute failed\n"); grid = -1; return; }
        if (hipOccupancyMaxActiveBlocksPerMultiprocessor(&per_cu, (const void*)hybrid_fwd, NWAVES * 64, LDS_BYTES) != hipSuccess || per_cu < 1) { fprintf(stderr, "kernel_launch: occupancy query says %d\n", per_cu); }
        (void)hipGetLastError();
        grid = cus > 256 ? 256 : cus;
    }
    if (grid < 0) return;
    if (hipMemsetAsync((char*)d_ws + WS_CTL, 0, CTL_ZERO_BYTES, stream) != hipSuccess) return;
    Args a{};
    for (int i = 0; i < 18; ++i) a.in[i] = (const float*)d_in[i];
    a.out = (float*)d_out; a.ws = (unsigned char*)d_ws; a.pad = 0;
#if MK_PER_PHASE
    for (int p = 0; p < N_PHASES; ++p) { a.ph_lo = p; a.ph_hi = p + 1; a.li = p; hipLaunchKernelGGL(hybrid_fwd, dim3(grid), dim3(NWAVES * 64), LDS_BYTES, stream, a); }
#else
    a.ph_lo = 0; a.ph_hi = N_PHASES; a.li = 0;
    hipLaunchKernelGGL(hybrid_fwd, dim3(grid), dim3(NWAVES * 64), LDS_BYTES, stream, a);
#endif
}
```

```cpp
#include <hip/hip_runtime.h>
#include <hip/hip_bf16.h>
#include <cstdio>
#include <cstdint>

#define LAS __attribute__((address_space(3)))
#define GAS __attribute__((address_space(1)))

namespace pg8 {
typedef unsigned short bf16_t;
typedef short bf16x8 __attribute__((ext_vector_type(8)));
typedef float f32x4 __attribute__((ext_vector_type(4)));
typedef float f32x2 __attribute__((ext_vector_type(2)));
typedef unsigned u32x4 __attribute__((ext_vector_type(4)));
typedef unsigned u32x2 __attribute__((ext_vector_type(2)));
constexpr int BM = 256, BK = 64, HALF = 128, HTB = HALF * BK * 2, STAGE_BYTES = 8 * HTB, NXCD = 8, WGM = 8;

__host__ __device__ __forceinline__ int lds_byte(int r, int c) { const int st = (r >> 4) * 2 + (c >> 5), rr = r & 15, cc = c & 31, ob = rr * 64 + cc * 2; return st * 1024 + (ob ^ (((ob >> 9) & 1) << 5)); }
__host__ __device__ __forceinline__ void stage_rc(int b, int& R, int& C) { const int st = b / 1024, sb = b % 1024, swz = sb ^ (((sb >> 9) & 1) << 5); R = (st >> 1) * 16 + swz / 64; C = (st & 1) * 32 + (swz % 64) / 2; }
__host__ __device__ __forceinline__ int perm32(int rho) { const int n = rho >> 4, i = rho & 15; return 8 * (i >> 2) + 4 * n + (i & 3); }

struct Unit { int pm, pn, aux; long aoff, boff; };
struct Gemm { const bf16_t* A; const bf16_t* Bt; int lda, ldb, K; };

struct StaticOrder {
    int nM, nN, nwg, G, c, lda, ldb;
    __device__ void init(int M, int N, int G_, int c_, int lda_, int ldb_) { nM = M / BM; nN = N / BM; nwg = nM * nN; G = G_; c = c_; lda = lda_; ldb = ldb_; }
    __device__ bool next(int i, Unit& u) const {
        const long L = (long)i * G + c; if (L >= nwg) return false;
        int wgid = (int)L; { const int q = nwg / NXCD, r = nwg % NXCD, xcd = wgid % NXCD, off = wgid / NXCD; wgid = (xcd < r ? xcd * (q + 1) : r * (q + 1) + (xcd - r) * q) + off; }
        const int nig = WGM * nN, gid = wgid / nig, fm = gid * WGM, gsz = (nM - fm) < WGM ? (nM - fm) : WGM;
        u.pm = fm + ((wgid % nig) % gsz); u.pn = (wgid % nig) / gsz; u.aux = 0;
        u.aoff = (long)u.pm * BM * lda; u.boff = (long)u.pn * BM * ldb; return true;
    }
};

__device__ __forceinline__ unsigned cvt_pk_bf16(float lo, float hi) { unsigned r; asm volatile("v_cvt_pk_bf16_f32 %0, %1, %2" : "=v"(r) : "v"(lo), "v"(hi)); return r; }
__device__ __forceinline__ u32x4 pack8(const f32x4 v0, const f32x4 v1) { u32x4 w; w.x = cvt_pk_bf16(v0[0], v0[1]); w.y = cvt_pk_bf16(v0[2], v0[3]); w.z = cvt_pk_bf16(v1[0], v1[1]); w.w = cvt_pk_bf16(v1[2], v1[3]); return w; }

typedef int v4i_t __attribute__((ext_vector_type(4)));
typedef int v8i_t __attribute__((ext_vector_type(8)));
__device__ __forceinline__ v8i_t cat8(const bf16x8 a, const bf16x8 b) { const v4i_t x = __builtin_bit_cast(v4i_t, a), y = __builtin_bit_cast(v4i_t, b); return __builtin_shufflevector(x, y, 0, 1, 2, 3, 4, 5, 6, 7); }
template <class Epi, class Sched, bool ALIGN_EPI, bool GATHER, bool FP8 = false>
__device__ __forceinline__ void gemm_phase(LAS unsigned char* lds, const Gemm g, const Sched& S, const Epi& E, const LAS int* rowtab) {
    int tid_ = threadIdx.x; asm volatile("" : "+v"(tid_));
    const int tid = tid_, wid = __builtin_amdgcn_readfirstlane(tid >> 6), lane = tid & 63, wr = wid >> 2, wc = wid & 3, fr = lane & 15, fq = lane >> 4;
    const int K = g.K, nt = K / BK;
    int sR[2], sC[2]; unsigned voffB[2];
#pragma unroll
    for (int i = 0; i < 2; ++i) { int R, C; stage_rc(tid * 16 + i * 8192, R, C); sR[i] = R; sC[i] = C; const int Rb = Epi::PERM ? ((R & ~31) + perm32(R & 31)) : R; voffB[i] = (unsigned)(Rb * g.ldb + C) * 2u; }
    unsigned avo[2][2], navo[2][2];
#define PG8_SETOFF(o, ui_) do { _Pragma("unroll") for (int h_ = 0; h_ < 2; ++h_) _Pragma("unroll") for (int i_ = 0; i_ < 2; ++i_) { const int row_ = h_ * HALF + sR[i_]; \
        const int grow_ = GATHER ? rowtab[(ui_) * BM + row_] : row_; o[h_][i_] = (unsigned)(grow_ * g.lda + sC[i_]) * 2u; } } while (0)
    const size_t kstep = (size_t)(BK * 2);
    const size_t hstepB = (size_t)HALF * g.ldb * 2;
    const unsigned ldsw = (unsigned)wid * 1024u;
    const int aoff = lds_byte(wr * 64 + fr, fq * 8), boff = lds_byte(wc * 32 + fr, fq * 8);
#define PG8_SA(b, h) (((b) * 2 + (h)) * HTB)
#define PG8_SB(b, h) ((4 + (b) * 2 + (h)) * HTB)
#define PG8_STAGE(bufoff, gbase, voff) do { _Pragma("unroll") for (int _i = 0; _i < 2; ++_i) \
        __builtin_amdgcn_global_load_lds((const unsigned*)((const char*)(gbase) + (voff)[_i]), (LAS unsigned*)(lds + (bufoff) + ldsw + _i * 8192), 16, 0, 0); } while (0)
#define PG8_LD8(dst8, addr_) do { const v4i_t lo_ = *(const LAS v4i_t*)(addr_), hi_ = *(const LAS v4i_t*)((addr_) + 1024); dst8 = __builtin_shufflevector(lo_, hi_, 0, 1, 2, 3, 4, 5, 6, 7); } while (0)
#define PG8_LDA(dst, b, h) do { _Pragma("unroll") for (int m = 0; m < 4; ++m) { if constexpr (FP8) { PG8_LD8(dst##8[m], lds + PG8_SA(b, h) + aoff + m * 2048); } else { _Pragma("unroll") for (int k = 0; k < 2; ++k) dst[m][k] = *(const LAS bf16x8*)(lds + PG8_SA(b, h) + aoff + m * 2048 + k * 1024); } } } while (0)
#define PG8_LDB(dst, b, h) do { _Pragma("unroll") for (int n = 0; n < 2; ++n) { if constexpr (FP8) { PG8_LD8(dst##8[n], lds + PG8_SB(b, h) + boff + n * 2048); } else { _Pragma("unroll") for (int k = 0; k < 2; ++k) dst[n][k] = *(const LAS bf16x8*)(lds + PG8_SB(b, h) + boff + n * 2048 + k * 1024); } } } while (0)
#define PG8_MMA(ai, bj, At, Bt) do { __builtin_amdgcn_s_setprio(1); _Pragma("unroll") for (int m = 0; m < 4; ++m) _Pragma("unroll") for (int n = 0; n < 2; ++n) { \
        if constexpr (FP8) asm volatile("v_mfma_scale_f32_16x16x128_f8f6f4 %0, %1, %2, %0, %3, %3 op_sel_hi:[0,0,0]" : "+v"(acc[ai][bj][m][n]) : "v"(Bt##8[n]), "v"(At##8[m]), "v"(sc1)); \
        else { _Pragma("unroll") for (int k = 0; k < 2; ++k) acc[ai][bj][m][n] = __builtin_amdgcn_mfma_f32_16x16x32_bf16(Bt[n][k], At[m][k], acc[ai][bj][m][n], 0, 0, 0); } } \
        __builtin_amdgcn_s_setprio(0); } while (0)
#define PG8_WAIT_V(n) asm volatile("s_waitcnt vmcnt(" #n ")" ::: "memory")
#define PG8_WAIT_L(n) asm volatile("s_waitcnt lgkmcnt(" #n ")" ::: "memory")
#define PG8_BAR __builtin_amdgcn_s_barrier()
#define PG8_SCHED __builtin_amdgcn_sched_barrier(0)
    unsigned sc1 = 0; if constexpr (FP8) asm volatile("v_mov_b32 %0, 0x7f7f7f7f\n\ts_nop 4" : "=v"(sc1));
    Unit cur, nxt; int ui = 0;
    if (!S.next(0, cur)) return;
    f32x4 acc[2][2][4][2];
#pragma unroll
    for (int a = 0; a < 2; ++a)
#pragma unroll
        for (int b = 0; b < 2; ++b)
#pragma unroll
            for (int m = 0; m < 4; ++m)
#pragma unroll
                for (int n = 0; n < 2; ++n) acc[a][b][m][n] = (f32x4){0.f, 0.f, 0.f, 0.f};
    bf16x8 At[4][2], B0[2][2], B1[2][2]; v8i_t At8[4], B08[2], B18[2];
    const char* cA = (const char*)g.A + cur.aoff * 2; const char* cB = (const char*)g.Bt + cur.boff * 2;
    PG8_SETOFF(avo, 0);
    PG8_STAGE(PG8_SB(0, 0), cB, voffB); PG8_STAGE(PG8_SB(0, 1), cB + hstepB, voffB); PG8_STAGE(PG8_SA(0, 0), cA, avo[0]); PG8_STAGE(PG8_SA(0, 1), cA, avo[1]);
    if (wr == 1) PG8_BAR;
    PG8_WAIT_V(2); PG8_BAR;
    PG8_STAGE(PG8_SB(1, 0), cB + kstep, voffB); PG8_STAGE(PG8_SA(1, 0), cA + kstep, avo[0]); PG8_STAGE(PG8_SB(1, 1), cB + hstepB + kstep, voffB);
    PG8_WAIT_V(6); PG8_BAR;
    for (;;) {
        const bool has_next = S.next(ui + 1, nxt);
        const char* nA = has_next ? (const char*)g.A + nxt.aoff * 2 : cA; const char* nB = has_next ? (const char*)g.Bt + nxt.boff * 2 : cB;
        if (GATHER && has_next) { PG8_SETOFF(navo, ui + 1); }
        else {
#pragma unroll
            for (int h_ = 0; h_ < 2; ++h_)
#pragma unroll
                for (int i_ = 0; i_ < 2; ++i_) navo[h_][i_] = avo[h_][i_]; }
#pragma nounroll
        for (int t = 0; t < nt; t += 2) {
            const bool last = (t == nt - 2);
            const char* a1 = cA + (size_t)(t + 1) * kstep;
            const char* a2 = last ? nA : cA + (size_t)(t + 2) * kstep; const char* b2 = last ? nB : cB + (size_t)(t + 2) * kstep;
            const char* a3 = a2 + kstep; const char* b3 = b2 + kstep;
            unsigned o2[2][2];
#pragma unroll
            for (int h_ = 0; h_ < 2; ++h_)
#pragma unroll
                for (int i_ = 0; i_ < 2; ++i_) o2[h_][i_] = (GATHER && last) ? navo[h_][i_] : avo[h_][i_];
            PG8_LDB(B0, 0, 0); PG8_LDB(B1, 0, 1); PG8_SCHED; PG8_LDA(At, 0, 0); PG8_STAGE(PG8_SA(1, 1), a1, avo[1]);
            PG8_WAIT_V(8); PG8_WAIT_L(0); PG8_BAR; PG8_MMA(0, 0, At, B0); PG8_MMA(0, 1, At, B1); PG8_BAR; PG8_SCHED;
            PG8_LDA(At, 0, 1); PG8_STAGE(PG8_SB(0, 0), b2, voffB); PG8_STAGE(PG8_SB(0, 1), b2 + hstepB, voffB); PG8_STAGE(PG8_SA(0, 0), a2, o2[0]);
            PG8_WAIT_V(8); PG8_WAIT_L(0); PG8_BAR; PG8_MMA(1, 0, At, B0); PG8_MMA(1, 1, At, B1); PG8_BAR; PG8_SCHED;
            PG8_LDB(B0, 1, 0); PG8_LDB(B1, 1, 1); PG8_SCHED; PG8_LDA(At, 1, 0); PG8_STAGE(PG8_SA(0, 1), a2, o2[1]);
            PG8_WAIT_V(8); PG8_WAIT_L(0); PG8_BAR; PG8_MMA(0, 0, At, B0); PG8_MMA(0, 1, At, B1); PG8_BAR; PG8_SCHED;
            PG8_LDA(At, 1, 1); PG8_STAGE(PG8_SB(1, 0), b3, voffB); PG8_STAGE(PG8_SB(1, 1), b3 + hstepB, voffB); PG8_STAGE(PG8_SA(1, 0), a3, o2[0]);
            PG8_WAIT_V(8); PG8_WAIT_L(0); PG8_BAR; PG8_MMA(1, 0, At, B0); PG8_MMA(1, 1, At, B1); PG8_BAR; PG8_SCHED;
        }
        if constexpr (ALIGN_EPI) { if (wr == 0) PG8_BAR; }
        if constexpr (FP8) asm volatile("s_nop 15\n\ts_nop 3" ::: "memory");
        { int efr = fr, efq = fq; asm volatile("" : "+v"(efr), "+v"(efq)); E(acc, cur, wr, wc, efr, efq); }
        if (!has_next) break;
#pragma unroll
        for (int a = 0; a < 2; ++a)
#pragma unroll
            for (int b = 0; b < 2; ++b)
#pragma unroll
                for (int m = 0; m < 4; ++m)
#pragma unroll
                    for (int n = 0; n < 2; ++n) acc[a][b][m][n] = (f32x4){0.f, 0.f, 0.f, 0.f};
        cur = nxt; cA = nA; cB = nB; ++ui;
#pragma unroll
        for (int h_ = 0; h_ < 2; ++h_)
#pragma unroll
            for (int i_ = 0; i_ < 2; ++i_) avo[h_][i_] = navo[h_][i_];
        if constexpr (ALIGN_EPI) { if (wr == 1) PG8_BAR; }
    }
    PG8_WAIT_V(0);
    if constexpr (!ALIGN_EPI) { if (wr == 0) PG8_BAR; }
    PG8_BAR;
#undef PG8_SETOFF
#undef PG8_SA
#undef PG8_SB
#undef PG8_STAGE
#undef PG8_LDA
#undef PG8_LDB
#undef PG8_MMA
#undef PG8_WAIT_V
#undef PG8_WAIT_L
#undef PG8_BAR
#undef PG8_SCHED
}
}
constexpr int NB = 8, SEQ = 2048, DM = 1024, TOK = NB * SEQ;
constexpr int AH = 8;
constexpr int RH = 4, RDK = 256, RDV = 512, RC = 256, RNC = SEQ / RC;
constexpr int NEXP = 32, EFF = 512, NPAIR = 2 * TOK, LISTCAP = TOK;
constexpr int MAXRT = NPAIR / 256 + NEXP;
constexpr float RMS_EPS = 1e-6f, SUBLN_EPS = 1e-5f, LOG2E = 1.4426950408889634f;
#ifndef QKV_FP8
#define QKV_FP8 0
#endif
#ifndef RIN_FP8
#define RIN_FP8 1
#endif
constexpr float WIN_SCALE = 64.f, IN_DESCALE = 1.0f / (16.f * 64.f);
constexpr float H8_SCALE = 16.f, W1_SCALE = 64.f, ACT_SCALE = 8.f, W2_SCALE = 32.f;
constexpr float ATT_C2 = 0.125f * LOG2E;

constexpr size_t MiB = 1u << 20;
constexpr size_t WS_CTL = 0, CTL_ZERO_BYTES = 1 * MiB;
constexpr size_t WS_LIST = 1 * MiB;
constexpr size_t WS_PAIRW = 3 * MiB;
constexpr size_t WS_WRF = 3 * MiB + 512 * 1024;
constexpr size_t WS_SINCOS = 4 * MiB;
constexpr size_t WS_SINCOST = 6 * MiB;
constexpr size_t WS_WINT0 = 8 * MiB;
constexpr size_t WS_WOUTT0 = 14 * MiB;
constexpr size_t WS_WRINA = 16 * MiB;
constexpr size_t WS_WRINB = 24 * MiB;
constexpr size_t WS_WROUTT = 30 * MiB;
constexpr size_t WS_W1CAT = 34 * MiB;
constexpr size_t WS_W2T = 98 * MiB;
constexpr size_t WS_DS = 34 * MiB;
constexpr size_t WS_ORET = 34 * MiB;
constexpr size_t WS_HB = 130 * MiB;
constexpr size_t WS_ACTBASE = 162 * MiB;
constexpr size_t WS_QKV0 = WS_ACTBASE;
constexpr size_t WS_OP = WS_ACTBASE + 96 * MiB;
constexpr size_t WS_AO = WS_ACTBASE + 160 * MiB;
constexpr size_t WS_MACT = WS_ACTBASE;
constexpr size_t WS_Y = WS_ACTBASE + 40 * MiB;
constexpr size_t WS_ACAT = WS_ACTBASE;
constexpr size_t WS_BTCAT = WS_ACTBASE + 64 * MiB;
constexpr size_t WS_KI = WS_ACTBASE + 192 * MiB;
constexpr size_t WS_KIT = WS_ACTBASE + 224 * MiB;
constexpr size_t WS_SG = WS_ACTBASE + 256 * MiB;
constexpr size_t WS_END = WS_ACTBASE + 320 * MiB;
constexpr int CW_TMO = 0, CW_BAR = 4096, CW_CNT = 16384;

constexpr int RING_OFF = 0, RING_BYTES = 131072;
constexpr int LX_OFF = RING_BYTES;
constexpr int LX_MISC = LX_OFF + 320;
constexpr int LX_ROWTAB = LX_OFF + 1024;
constexpr int LX_TSTART = LX_OFF + 5120;
constexpr int LX_TEXP = LX_OFF + 5376;
constexpr int LX_LUT = LX_OFF + 10240;
constexpr int LX_CNT = LX_OFF + 7168;
constexpr int LX_SSQ = LX_OFF + 8192;
constexpr int LDS_BYTES = 147456;

namespace pg8 {
struct EpiQKV {
    static constexpr bool PERM = true;
    bf16_t* O; float qscale;
    __device__ __forceinline__ void operator()(const f32x4 (&acc)[2][2][4][2], const Unit& u, int wr, int wc, int fr, int fq) const {
        const int row0 = u.pm * BM + wr * 64 + fr, col0 = u.pn * BM + wc * 32 + 8 * fq; const float sc = ((u.pn < 4) ? qscale : 1.f) * (QKV_FP8 ? IN_DESCALE : 1.f);
#pragma unroll
        for (int ai = 0; ai < 2; ++ai)
#pragma unroll
            for (int m = 0; m < 4; ++m) { bf16_t* rowp = O + (size_t)(row0 + ai * HALF + m * 16) * 3072 + col0;
#pragma unroll
                for (int bj = 0; bj < 2; ++bj) *(u32x4*)(rowp + bj * HALF) = pack8(acc[ai][bj][m][0] * sc, acc[ai][bj][m][1] * sc); }
    }
};
struct EpiRes {
    static constexpr bool PERM = false;
    const float* res; float* out;
    __device__ __forceinline__ void operator()(const f32x4 (&acc)[2][2][4][2], const Unit& u, int wr, int wc, int fr, int fq) const {
        const int row0 = u.pm * BM + wr * 64 + fr, col0 = u.pn * BM + wc * 32 + 4 * fq;
#pragma unroll
        for (int ai = 0; ai < 2; ++ai)
#pragma unroll
            for (int m = 0; m < 4; ++m) { const size_t off = (size_t)(row0 + ai * HALF + m * 16) * 1024 + col0;
#pragma unroll
                for (int bj = 0; bj < 2; ++bj)
#pragma unroll
                    for (int n = 0; n < 2; ++n) { const f32x4 r = *(const f32x4*)(res + off + bj * HALF + n * 16); *(f32x4*)(out + off + bj * HALF + n * 16) = r + acc[ai][bj][m][n]; }
                asm volatile("" ::: "memory"); }
    }
};
__device__ __forceinline__ float silu_f(float x) { return x * __builtin_amdgcn_rcpf(1.0f + __builtin_amdgcn_exp2f(-x * LOG2E)); }
__device__ __forceinline__ unsigned pk4_fp8(float a, float b, float c, float d) { int w = 0; w = __builtin_amdgcn_cvt_pk_fp8_f32(a, b, w, false); w = __builtin_amdgcn_cvt_pk_fp8_f32(c, d, w, true); return (unsigned)w; }
struct EpiMoe1 {
    static constexpr bool PERM = true;
    unsigned char* ACT;
    __device__ __forceinline__ void operator()(const f32x4 (&acc)[2][2][4][2], const Unit& u, int wr, int wc, int fr, int fq) const {
        const int row0 = u.pm * BM + wr * 64 + fr, col0 = (u.pn & 3) * 128 + wc * 32 + 8 * fq; constexpr float si = 1.0f / (H8_SCALE * W1_SCALE);
#pragma unroll
        for (int ai = 0; ai < 2; ++ai)
#pragma unroll
            for (int m = 0; m < 4; ++m) { f32x4 a0, a1;
#pragma unroll
                for (int j = 0; j < 4; ++j) { a0[j] = silu_f(acc[ai][0][m][0][j] * si) * acc[ai][1][m][0][j] * (si * ACT_SCALE); a1[j] = silu_f(acc[ai][0][m][1][j] * si) * acc[ai][1][m][1][j] * (si * ACT_SCALE); }
                u32x2 w; w.x = pk4_fp8(a0[0], a0[1], a0[2], a0[3]); w.y = pk4_fp8(a1[0], a1[1], a1[2], a1[3]);
                *(u32x2*)(ACT + (size_t)(row0 + ai * HALF + m * 16) * 512 + col0) = w; }
    }
};
struct EpiMoe2 {
    static constexpr bool PERM = true;
    bf16_t* Y; const int* list; const float* pairw; const LAS int* lcnt;
    __device__ __forceinline__ void operator()(const f32x4 (&acc)[2][2][4][2], const Unit& u, int wr, int wc, int fr, int fq) const {
        const int e = u.pn >> 2, col0 = (u.pn & 3) * BM + wc * 32 + 8 * fq, pos0 = u.aux * BM + wr * 64 + fr, cn = lcnt[e];
#pragma unroll
        for (int ai = 0; ai < 2; ++ai)
#pragma unroll
            for (int m = 0; m < 4; ++m) { const int pos = pos0 + ai * HALF + m * 16;
                if (pos < cn) { const int pair = list[e * LISTCAP + pos]; const float w = pairw[pair] * (1.0f / (ACT_SCALE * W2_SCALE)); bf16_t* rowp = Y + (size_t)pair * 1024 + col0;
#pragma unroll
                    for (int bj = 0; bj < 2; ++bj) *(u32x4*)(rowp + bj * HALF) = pack8(acc[ai][bj][m][0] * w, acc[ai][bj][m][1] * w); } }
    }
};
__device__ __forceinline__ float log2_gamma(int h) { return __builtin_log2f(1.0f - __builtin_amdgcn_exp2f(-5.0f - (float)h)); }
struct EpiRetA {
    static constexpr bool PERM = true;
    bf16_t* ACAT; bf16_t* KI; bf16_t* SG; const float* sincos; bf16_t* KIT;
    __device__ __forceinline__ void operator()(const f32x4 (&acc)[2][2][4][2], const Unit& u, int wr, int wc, int fr, int fq) const {
        const int r0 = wr * 64 + fr, c0 = wc * 32 + 8 * fq;
        if (u.pn >= 8) {
#pragma unroll
            for (int ai = 0; ai < 2; ++ai)
#pragma unroll
                for (int m = 0; m < 4; ++m) { bf16_t* rowp = SG + (size_t)(u.pm * BM + r0 + ai * HALF + m * 16) * 2048 + (u.pn - 8) * BM + c0;
#pragma unroll
                    for (int bj = 0; bj < 2; ++bj) { f32x4 a0, a1;
#pragma unroll
                        for (int j = 0; j < 4; ++j) { a0[j] = silu_f(acc[ai][bj][m][0][j] * IN_DESCALE); a1[j] = silu_f(acc[ai][bj][m][1][j] * IN_DESCALE); }
                        *(u32x4*)(rowp + bj * HALF) = pack8(a0, a1); } }
            return;
        }
        const bool isq = u.pn < 4; const int h = u.pn & 3; const float l2g = log2_gamma(h);
        const int b = u.pm >> 3, n = u.pm & 7;
#pragma unroll
        for (int ai = 0; ai < 2; ++ai)
#pragma unroll
            for (int m = 0; m < 4; ++m) { const int r = r0 + ai * HALF + m * 16, pos = n * RC + r;
                const float fac = IN_DESCALE * (isq ? __builtin_amdgcn_exp2f((float)(r + 1) * l2g) : 0.0625f * __builtin_amdgcn_exp2f(-(float)(r + 1) * l2g));
                bf16_t* rowp = isq ? ACAT + ((size_t)((b * RH + h) * RNC + n) * RC + r) * 512 + 256 + c0 : KI + (size_t)(u.pm * BM + r) * 1024 + h * RDK + c0;
#pragma unroll
                for (int bj = 0; bj < 2; ++bj) { const f32x4* cs = (const f32x4*)(sincos + ((size_t)pos * 128 + (bj * HALF + c0) / 2) * 2);
                    const f32x4 t0 = cs[0], t1 = cs[1]; const f32x4 x0 = acc[ai][bj][m][0], x1 = acc[ai][bj][m][1]; f32x4 y0, y1;
                    y0[0] = (x0[0] * t0[0] - x0[1] * t0[1]) * fac; y0[1] = (x0[1] * t0[0] + x0[0] * t0[1]) * fac; y0[2] = (x0[2] * t0[2] - x0[3] * t0[3]) * fac; y0[3] = (x0[3] * t0[2] + x0[2] * t0[3]) * fac;
                    y1[0] = (x1[0] * t1[0] - x1[1] * t1[1]) * fac; y1[1] = (x1[1] * t1[0] + x1[0] * t1[1]) * fac; y1[2] = (x1[2] * t1[2] - x1[3] * t1[3]) * fac; y1[3] = (x1[3] * t1[2] + x1[2] * t1[3]) * fac;
                    *(u32x4*)(rowp + bj * HALF) = pack8(y0, y1);
                    if (!isq) {
                        const int s0 = fr & 1, s1 = (fr >> 1) & 1;
#pragma unroll
                        for (int nn = 0; nn < 2; ++nn) { const f32x4 a = nn ? y1 : y0; float t[4], c[4];
#pragma unroll
                            for (int j = 0; j < 4; ++j) { const float other = __shfl_xor(a[j ^ 1], 1); t[j] = (s0 == (j & 1)) ? a[j] : other; }
#pragma unroll
                            for (int j = 0; j < 4; ++j) { const float other = __shfl_xor(t[j ^ 2], 2); c[j] = (s1 == (j >> 1)) ? t[j] : other; }
                            u32x2 w; w.x = cvt_pk_bf16(c[0], c[1]); w.y = cvt_pk_bf16(c[2], c[3]);
                            const int col = bj * HALF + c0 + nn * 4 + (fr & 3), tok = n * RC + (r & ~3);
                            *(u32x2*)(KIT + ((size_t)((b * RH + h) * RDK + col)) * SEQ + tok) = w; } }
                } }
    }
};
struct EpiRetB {
    static constexpr bool PERM = true;
    bf16_t* BTCAT;
    __device__ __forceinline__ void operator()(const f32x4 (&acc)[2][2][4][2], const Unit& u, int wr, int wc, int fr, int fq) const {
        const int r0 = wr * 64 + fr, c0 = wc * 32 + 8 * fq; const int b = u.pn >> 3, n = u.pn & 7; const int h = u.pm >> 1, dv0 = (u.pm & 1) * BM;
#pragma unroll
        for (int ai = 0; ai < 2; ++ai)
#pragma unroll
            for (int m = 0; m < 4; ++m) { bf16_t* rowp = BTCAT + ((size_t)((b * RH + h) * RNC + n) * RDV + dv0 + r0 + ai * HALF + m * 16) * 512 + c0;
#pragma unroll
                for (int bj = 0; bj < 2; ++bj) *(u32x4*)(rowp + bj * HALF) = pack8(acc[ai][bj][m][0] * IN_DESCALE, acc[ai][bj][m][1] * IN_DESCALE); }
    }
};
struct EpiScores {
    static constexpr bool PERM = true;
    bf16_t* ACAT;
    __device__ __forceinline__ void operator()(const f32x4 (&acc)[2][2][4][2], const Unit& u, int wr, int wc, int fr, int fq) const {
        const int r0 = wr * 64 + fr, c0 = wc * 32 + 8 * fq;
#pragma unroll
        for (int ai = 0; ai < 2; ++ai)
#pragma unroll
            for (int m = 0; m < 4; ++m) { const int r = r0 + ai * HALF + m * 16; bf16_t* rowp = ACAT + ((size_t)u.pm * RC + r) * 512 + c0;
#pragma unroll
                for (int bj = 0; bj < 2; ++bj) { f32x4 y0 = acc[ai][bj][m][0], y1 = acc[ai][bj][m][1]; const int cb = bj * HALF + c0;
#pragma unroll
                    for (int j = 0; j < 4; ++j) { if (cb + j > r) y0[j] = 0.f; if (cb + 4 + j > r) y1[j] = 0.f; }
                    *(u32x4*)(rowp + bj * HALF) = pack8(y0, y1); } }
    }
};
struct EpiDS {
    static constexpr bool PERM = true;
    bf16_t* DS;
    __device__ __forceinline__ void operator()(const f32x4 (&acc)[2][2][4][2], const Unit& u, int wr, int wc, int fr, int fq) const {
        const int r0 = wr * 64 + fr, c0 = wc * 32 + 8 * fq;
#pragma unroll
        for (int ai = 0; ai < 2; ++ai)
#pragma unroll
            for (int m = 0; m < 4; ++m) { bf16_t* rowp = DS + ((size_t)u.pm * RDV + u.pn * BM + r0 + ai * HALF + m * 16) * RDK + c0;
#pragma unroll
                for (int bj = 0; bj < 2; ++bj) *(u32x4*)(rowp + bj * HALF) = pack8(acc[ai][bj][m][0], acc[ai][bj][m][1]); }
    }
};
struct EpiRetO {
    static constexpr bool PERM = true;
    bf16_t* ORET; bf16_t* SG; LAS float* ssq;
    __device__ __forceinline__ void operator()(const f32x4 (&acc)[2][2][4][2], const Unit& u, int wr, int wc, int fr, int fq) const {
        const int r0 = wr * 64 + fr, c0 = wc * 32 + 8 * fq; const int n = u.pm & 7, h = (u.pm >> 3) & 3, b = u.pm >> 5;
        LAS float* sq = ssq + (u.aux & 1) * 256;
        if (u.pn == 0) { const int t_ = threadIdx.x; if (t_ < 256) ssq[((u.aux & 1) ^ 1) * 256 + t_] = 0.f; }
#pragma unroll
        for (int ai = 0; ai < 2; ++ai)
#pragma unroll
            for (int m = 0; m < 4; ++m) { float s = 0.f;
#pragma unroll
                for (int bj = 0; bj < 2; ++bj)
#pragma unroll
                    for (int nn = 0; nn < 2; ++nn) { const f32x4 x = acc[ai][bj][m][nn]; s += (x[0] * x[0] + x[1] * x[1]) + (x[2] * x[2] + x[3] * x[3]); }
                s += __shfl_xor(s, 16); s += __shfl_xor(s, 32);
                if (fq == 0) (void)__hip_atomic_fetch_add(sq + r0 + ai * HALF + m * 16, s, __ATOMIC_RELAXED, __HIP_MEMORY_SCOPE_WORKGROUP); }
        const size_t rowbase = (size_t)(b * SEQ + n * RC) * 2048 + h * RDV;
        if (u.pn == 0) {
#pragma unroll
            for (int ai = 0; ai < 2; ++ai)
#pragma unroll
                for (int m = 0; m < 4; ++m) { bf16_t* rowp = ORET + rowbase + (size_t)(r0 + ai * HALF + m * 16) * 2048 + c0;
#pragma unroll
                    for (int bj = 0; bj < 2; ++bj) *(u32x4*)(rowp + bj * HALF) = pack8(acc[ai][bj][m][0], acc[ai][bj][m][1]); }
            return;
        }
        asm volatile("s_waitcnt lgkmcnt(0)" ::: "memory"); __builtin_amdgcn_s_barrier(); asm volatile("" ::: "memory");
#pragma unroll
        for (int ai = 0; ai < 2; ++ai)
#pragma unroll
            for (int m = 0; m < 4; ++m) { const int r = r0 + ai * HALF + m * 16; const float rstd = __builtin_amdgcn_rsqf(sq[r] * (1.0f / 512.0f) + RMS_EPS);
                const size_t ro = rowbase + (size_t)r * 2048 + c0;
#pragma unroll
                for (int bj = 0; bj < 2; ++bj) {
                    { bf16_t* gp = SG + ro + BM + bj * HALF; const u32x4 g = *(const u32x4*)gp; f32x4 y0 = acc[ai][bj][m][0] * rstd, y1 = acc[ai][bj][m][1] * rstd;
                      y0[0] *= __uint_as_float(g.x << 16); y0[1] *= __uint_as_float(g.x & 0xffff0000u); y0[2] *= __uint_as_float(g.y << 16); y0[3] *= __uint_as_float(g.y & 0xffff0000u);
                      y1[0] *= __uint_as_float(g.z << 16); y1[1] *= __uint_as_float(g.z & 0xffff0000u); y1[2] *= __uint_as_float(g.w << 16); y1[3] *= __uint_as_float(g.w & 0xffff0000u);
                      *(u32x4*)gp = pack8(y0, y1); }
                    { bf16_t* gp = SG + ro + bj * HALF; const u32x4 g = *(const u32x4*)gp; const u32x4 o = *(const u32x4*)(ORET + ro + bj * HALF); f32x4 y0, y1;
                      y0[0] = __uint_as_float(o.x << 16) * rstd * __uint_as_float(g.x << 16); y0[1] = __uint_as_float(o.x & 0xffff0000u) * rstd * __uint_as_float(g.x & 0xffff0000u);
                      y0[2] = __uint_as_float(o.y << 16) * rstd * __uint_as_float(g.y << 16); y0[3] = __uint_as_float(o.y & 0xffff0000u) * rstd * __uint_as_float(g.y & 0xffff0000u);
                      y1[0] = __uint_as_float(o.z << 16) * rstd * __uint_as_float(g.z << 16); y1[1] = __uint_as_float(o.z & 0xffff0000u) * rstd * __uint_as_float(g.z & 0xffff0000u);
                      y1[2] = __uint_as_float(o.w << 16) * rstd * __uint_as_float(g.w << 16); y1[3] = __uint_as_float(o.w & 0xffff0000u) * rstd * __uint_as_float(g.w & 0xffff0000u);
                      *(u32x4*)gp = pack8(y0, y1); } } }
    }
};
struct ScoresOrder {
    int G, c;
    __device__ bool next(int i, Unit& u) const { const int L = i * G + c; if (L >= NB * RH * RNC) return false; const int n = L & 7, h = (L >> 3) & 3, b = L >> 5;
        u.pm = L; u.pn = 0; u.aux = 0; u.aoff = (long)L * RC * 512 + 256; u.boff = (long)(b * SEQ + n * RC) * 1024 + h * RDK; return true; }
};
struct DsOrder {
    int G, c;
    __device__ bool next(int i, Unit& u) const { const int L = i * G + c; if (L >= NB * RH * 7 * 2) return false; const int dvt = L & 1, q = L >> 1, n = q % 7, bh = q / 7, p = bh * RNC + n;
        u.pm = p; u.pn = dvt; u.aux = 0; u.aoff = ((long)p * RDV + dvt * BM) * 512; u.boff = (long)bh * RDK * SEQ + n * RC; return true; }
};
struct RetOOrder {
    int G, c;
    __device__ bool next(int i, Unit& u) const { const int k = i >> 1, dvt = i & 1, p = k * G + c; if (p >= NB * RH * RNC) return false;
        u.pm = p; u.pn = dvt; u.aux = k; u.aoff = (long)p * RC * 512; u.boff = ((long)p * RDV + dvt * BM) * 512; return true; }
};
struct MoeOrder {
    int G, c, ldb; long a_tile; const LAS int* tstart; const LAS int* texp;
    __device__ bool next(int i, Unit& u) const { const int L = i * G + c; const int ntiles = tstart[33]; if (L >= ntiles * 4) return false; const int rt = L >> 2, pnl = L & 3, e = texp[rt];
        u.pm = rt; u.pn = e * 4 + pnl; u.aux = rt - tstart[e]; u.aoff = (long)rt * a_tile; u.boff = ((long)e * 1024 + pnl * BM) * ldb; return true; }
};
}
namespace attn_body {
using bf16=__hip_bfloat16;
using bf16x8=__attribute__((ext_vector_type(8)))short;
using s16x4=__attribute__((ext_vector_type(4)))short;
using f32x16=__attribute__((ext_vector_type(16)))float;
using u32x4=__attribute__((ext_vector_type(4)))unsigned;
constexpr int D=64,PQ=3072,PO=1024;
constexpr int NW=8,QBLK=32,QB=QBLK*NW,KVBLK=64,NQB=SEQ/QB;
__device__ __forceinline__ int crow(int r,int hi){return (r&3)+8*(r>>2)+4*hi;}
#define SBAR() __builtin_amdgcn_sched_barrier(0)
__device__ __forceinline__ void biasmask(f32x16&p0,f32x16&p1,int jb6,int qrel,int hi,const LAS float*lut2){
  const LAS float*pb=lut2+(128+qrel-64*jb6-4*hi+288-91);
  #pragma unroll
  for(int g=0;g<4;++g){
    #pragma unroll
    for(int q=0;q<4;++q){const int r=4*g+q, c=q+8*g; const int rel=128+qrel-64*jb6-4*hi-c; const float b0=pb[91-c], b1=pb[91-c-32]; p0[r]=(rel<0)?-INFINITY:p0[r]+b0; p1[r]=(rel<32)?-INFINITY:p1[r]+b1;}
    asm volatile("":"+v"(p0),"+v"(p1)); __builtin_amdgcn_sched_barrier(0);}
}
constexpr int NSLOT=3, SLOTB=8192;
constexpr int LDS_K=0, LDS_V=NSLOT*SLOTB, LDS_WS=2*NSLOT*SLOTB, LDS_OST=LDS_WS+NW*64*4, LDS_BYTES=LDS_OST+NW*4096;
__device__ __forceinline__ void glds16(const void*gsrc,unsigned lds_dst){unsigned keep;
  asm volatile("s_mov_b32 %0, m0\n\ts_mov_b32 m0, %2\n\ts_nop 0\n\tglobal_load_lds_dwordx4 %1, off\n\ts_mov_b32 m0, %0":"=&s"(keep):"v"(gsrc),"s"(lds_dst):"memory");}
__device__ __forceinline__ float max3f(float a,float b,float c){float r;asm("v_max3_f32 %0, %1, %2, %3":"=v"(r):"v"(a),"v"(b),"v"(c));return r;}
__device__ __forceinline__ float max2f(float a,float b){float r;asm("v_max_f32_e32 %0, %1, %2":"=v"(r):"v"(a),"v"(b));return r;}
__device__ __forceinline__ float fadd_s(float a,float b){float r;asm("v_add_f32_e32 %0, %1, %2":"=v"(r):"v"(a),"v"(b));return r;}
__device__ __forceinline__ float fsub_s(float a,float b){float r;asm("v_sub_f32_e32 %0, %1, %2":"=v"(r):"v"(a),"v"(b));return r;}
typedef float f32x2_t __attribute__((ext_vector_type(2))); typedef __bf16 bf16x2_t __attribute__((ext_vector_type(2)));
__device__ __forceinline__ unsigned cvtpk_s(float lo,float hi){f32x2_t v={lo,hi};bf16x2_t b=__builtin_convertvector(v,bf16x2_t);return __builtin_bit_cast(unsigned,b);}
#define WAIT_BAR(N) asm volatile("s_waitcnt vmcnt(" #N ") lgkmcnt(0)\n\ts_barrier":::"memory")

__device__ __forceinline__ void qkt(f32x16&p0,f32x16&p1,const char*Kslot,const bf16x8*qr,const f32x16&negm,int r32,int hi){
  const char*kb=Kslot+hi*1024+r32*16;
  #pragma unroll
  for(int d0=0;d0<4;++d0){
    const bf16x8 b0=*reinterpret_cast<const bf16x8*>(kb+d0*2048);
    const bf16x8 b1=*reinterpret_cast<const bf16x8*>(kb+d0*2048+512);
    if(d0==0){p0=__builtin_amdgcn_mfma_f32_32x32x16_bf16(b0,qr[0],negm,0,0,0);p1=__builtin_amdgcn_mfma_f32_32x32x16_bf16(b1,qr[0],negm,0,0,0);}
    else{p0=__builtin_amdgcn_mfma_f32_32x32x16_bf16(b0,qr[d0],p0,0,0,0);p1=__builtin_amdgcn_mfma_f32_32x32x16_bf16(b1,qr[d0],p1,0,0,0);}}
}
typedef LAS const char* lds_cptr;
typedef short v4i16_t __attribute__((ext_vector_type(4)));
__device__ __forceinline__ void kload8(bf16x8*kf,lds_cptr kp){
  kf[0]=*(const LAS bf16x8*)(kp);      kf[1]=*(const LAS bf16x8*)(kp+512);
  kf[2]=*(const LAS bf16x8*)(kp+2048); kf[3]=*(const LAS bf16x8*)(kp+2560);
  kf[4]=*(const LAS bf16x8*)(kp+4096); kf[5]=*(const LAS bf16x8*)(kp+4608);
  kf[6]=*(const LAS bf16x8*)(kp+6144); kf[7]=*(const LAS bf16x8*)(kp+6656);
}
__device__ __forceinline__ void kload2(bf16x8*kf,lds_cptr kp,int j){ kf[2*j]=*(const LAS bf16x8*)(kp+j*2048); kf[2*j+1]=*(const LAS bf16x8*)(kp+j*2048+512); }
__device__ __forceinline__ s16x4 vtr(lds_cptr p){ return __builtin_bit_cast(s16x4,__builtin_amdgcn_ds_read_tr16_b64_v4i16((LAS v4i16_t*)p)); }
__device__ __forceinline__ float rowmax(const f32x16&p0,const f32x16&p1){
  float a=max3f(p0[0],p0[1],p1[0]),b=max3f(p0[2],p0[3],p1[1]);a=max3f(a,p1[2],p1[3]);
  #pragma unroll
  for(int r=4;r<16;r+=4){a=max3f(a,p0[r],p0[r+1]);b=max3f(b,p0[r+2],p0[r+3]);a=max3f(a,p1[r],p1[r+1]);b=max3f(b,p1[r+2],p1[r+3]);}
  const float m=max2f(a,b);
  auto rr=__builtin_amdgcn_permlane32_swap(__float_as_uint(m),__float_as_uint(m),false,false);
  return max2f(__uint_as_float(rr[0]),__uint_as_float(rr[1]));
}
__device__ __forceinline__ void pv(f32x16*o,int vb,bf16x8 pa0,bf16x8 pa1,bf16x8 pa2,bf16x8 pa3){
  #pragma unroll
  for(int d0=0;d0<2;++d0){s16x4 lo[4],hi[4];
    #pragma unroll
    for(int ks=0;ks<4;++ks){
      asm volatile("ds_read_b64_tr_b16 %0,%1 offset:%c2":"=&v"(lo[ks]):"v"(vb),"i"(d0*4096+ks*1024):"memory");
      asm volatile("ds_read_b64_tr_b16 %0,%1 offset:%c2":"=&v"(hi[ks]):"v"(vb),"i"(d0*4096+ks*1024+512):"memory");}
    asm volatile("s_waitcnt lgkmcnt(0)":::"memory");SBAR();
    #define PK(k) (bf16x8){lo[k][0],lo[k][1],lo[k][2],lo[k][3],hi[k][0],hi[k][1],hi[k][2],hi[k][3]}
    o[d0]=__builtin_amdgcn_mfma_f32_32x32x16_bf16(pa0,PK(0),o[d0],0,0,0);
    o[d0]=__builtin_amdgcn_mfma_f32_32x32x16_bf16(pa1,PK(1),o[d0],0,0,0);
    o[d0]=__builtin_amdgcn_mfma_f32_32x32x16_bf16(pa2,PK(2),o[d0],0,0,0);
    o[d0]=__builtin_amdgcn_mfma_f32_32x32x16_bf16(pa3,PK(3),o[d0],0,0,0);
    #undef PK
  }
}
template<int THRL> __device__ __forceinline__ void attn_unit(int b,int qb,const bf16*QKV,int Qc,int Kc,int Vc,bf16*O,const LAS float*lut,char*shm){
  int tid_=threadIdx.x; asm volatile("":"+v"(tid_)); const int tid=tid_,lane=tid&63,r32=lane&31,hi=lane>>5; const int wid=__builtin_amdgcn_readfirstlane(tid>>6);
  const long rowbase=(long)b*SEQ; const int q0=qb*QB;
  const bf16*Qw=QKV+(rowbase+q0+wid*QBLK)*PQ+Qc;
  const bf16*Kh=QKV+rowbase*PQ+Kc,*Vh=QKV+rowbase*PQ+Vc;
  const unsigned lds0=(unsigned)(uintptr_t)shm;
  float*wsf=(float*)(shm+LDS_WS)+wid*64;
  const bf16*ksrc=Kh+(long)lane*PQ+wid*8;
  const bf16*vsrc=Vh+(long)(16*(wid&3)+(lane>>2))*PQ+(wid>>2)*32+(lane&3)*8;
  const unsigned kdst=lds0+LDS_K+wid*1024, vdst=lds0+LDS_V+wid*1024;
  #define DMA_K(t,slot) glds16(ksrc+(long)(t)*KVBLK*PQ,(unsigned)__builtin_amdgcn_readfirstlane(kdst+(slot)))
  #define DMA_V(t,slot) glds16(vsrc+(long)(t)*KVBLK*PQ,(unsigned)__builtin_amdgcn_readfirstlane(vdst+(slot)))
  const int vb0=(int)(lds0+LDS_V)+((lane>>4)&1)*32+(lane&3)*8+(4*hi+((lane&15)>>2))*64;
  const char*Kbase=shm+LDS_K; bf16x8 kf[8];
  const lds_cptr shm3=(lds_cptr)shm; const lds_cptr kp0=shm3+LDS_K+hi*1024+r32*16; const lds_cptr vp0=shm3+LDS_V+((lane>>4)&1)*32+(lane&3)*8+(4*hi+((lane&15)>>2))*64;
  const int NT=(q0+QB)/KVBLK;
  DMA_K(0,0);DMA_V(0,0);DMA_K(1,SLOTB);
  bf16x8 qr[4];
  #pragma unroll
  for(int d0=0;d0<4;++d0)qr[d0]=*reinterpret_cast<const bf16x8*>(&Qw[(long)r32*PQ+d0*16+hi*8]);
  float mhat=0.f,l_reg=0.f;f32x16 o[2];f32x16 negm; { float zz; asm volatile("v_mov_b32 %0, 0":"=v"(zz)); _Pragma("unroll") for(int r=0;r<16;++r){o[0][r]=zz;o[1][r]=zz;negm[r]=zz;} } asm volatile("":"+v"(negm));
  const int qrel=wid*QBLK+r32;
  #define CMASK(P0,P1,t) do{int jb_=(t)-(NT-6); if(jb_>=0)biasmask(P0,P1,jb_,qrel,hi,lut);}while(0)
  bool resc=false;
  #define START(P0,P1) do{ const float rm=rowmax(P0,P1); resc=false; \
    { const float dl=rm; mhat=fadd_s(mhat,dl); \
      _Pragma("unroll") for(int r=0;r<16;++r){P0[r]=fsub_s(P0[r],dl);P1[r]=fsub_s(P1[r],dl);} \
      _Pragma("unroll") for(int r=0;r<16;++r)negm[r]=-mhat; asm volatile("":"+v"(negm)); } \
    _Pragma("unroll") for(int r=0;r<16;++r)P0[r]=__builtin_amdgcn_exp2f(P0[r]); }while(0)
  #define RESC() do{ if(resc){ asm volatile("s_waitcnt lgkmcnt(0)":::"memory"); \
      _Pragma("unroll") for(int d_=0;d_<2;++d_) _Pragma("unroll") for(int r=0;r<16;++r)o[d_][r]*=wsf[crow(r,hi)]; } }while(0)
  f32x16 pA0,pA1,pB0,pB1;
  int sl_prev=0,sl_cur=0,sl_next=SLOTB;
  #define ROT() do{sl_prev=sl_cur;sl_cur=sl_next;sl_next=(sl_next==(NSLOT-1)*SLOTB)?0:sl_next+SLOTB;}while(0)
  DMA_K(2,2*SLOTB);
  WAIT_BAR(3);
  qkt(pA0,pA1,Kbase,qr,negm,r32,hi);asm volatile("s_nop 15\n\ts_nop 7":"+v"(pA0),"+v"(pA1));CMASK(pA0,pA1,0);
  START(pA0,pA1);
  _Pragma("unroll") for(int r=0;r<16;++r)pA1[r]=__builtin_amdgcn_exp2f(pA1[r]);
  WAIT_BAR(0);
  DMA_K(3,0);DMA_V(1,SLOTB);
  ROT();
  kload8(kf,kp0+sl_cur);
  WAIT_BAR(2);
  s16x4 vlo[8],vhi[8]; u32x4 pw0,pw1,pw2,pw3;
  #define PKW(P,B) cvtpk_s(P[B],P[B+1])
  #define PAF(k) __builtin_bit_cast(bf16x8,pw##k)
  #define VFR(i) (bf16x8){vlo[i][0],vlo[i][1],vlo[i][2],vlo[i][3],vhi[i][0],vhi[i][1],vhi[i][2],vhi[i][3]}
  #define PIN(x) asm volatile("":"+v"(x))
  #define MX3(a,b,c) __builtin_fmaxf(__builtin_fmaxf((a),(b)),(c))
  #define GAPA(MF,A0,A1,A2,A3,W0,W1,PW) do{ MF; sacc+=A0; sacc+=A1; sacc+=A2; sacc+=A3; PIN(sacc); W0; W1; PIN(PW); SBAR(); }while(0)
  #define EX(v) __builtin_amdgcn_exp2f(v)
  #define GAPB(MF,X,B) do{ MF; X[B]=EX(X[B]); X[B+1]=EX(X[B+1]); X[B+2]=EX(X[B+2]); X[B+3]=EX(X[B+3]); PIN(X); SBAR(); }while(0)
  #define VRD(i) do{ vlo[i]=vtr(vp_+(((i)>>2)*4096+((i)&3)*1024)); vhi[i]=vtr(vp_+(((i)>>2)*4096+((i)&3)*1024+512)); }while(0)
  #define KRD(G,j) do{ if(G){ kload2(kf,kp0+sl_next,j); SBAR(); } }while(0)
  #define STEP(C0,C1,P0,P1,t,GK,GV,GL) do{ SBAR(); \
    const lds_cptr vp_=vp0+sl_prev; \
    VRD(0); SBAR(); float sacc=(P0[0]+P0[1]); \
    GAPA(C0=__builtin_amdgcn_mfma_f32_32x32x16_bf16(kf[0],qr[0],negm,0,0,0), P0[2],P0[3],P0[4],P0[5],     pw0[0]=PKW(P0,0), pw0[1]=PKW(P0,2), pw0); \
    VRD(4); SBAR(); GAPA(C1=__builtin_amdgcn_mfma_f32_32x32x16_bf16(kf[1],qr[0],negm,0,0,0), P0[6],P0[7],P0[8],P0[9],     pw0[2]=PKW(P0,4), pw0[3]=PKW(P0,6), pw0); \
    VRD(1); SBAR(); GAPA(C0=__builtin_amdgcn_mfma_f32_32x32x16_bf16(kf[2],qr[1],C0,0,0,0),   P0[10],P0[11],P0[12],P0[13], pw1[0]=PKW(P0,8), pw1[1]=PKW(P0,10), pw1); \
    VRD(5); SBAR(); GAPA(C1=__builtin_amdgcn_mfma_f32_32x32x16_bf16(kf[3],qr[1],C1,0,0,0),   P0[14],P0[15],P1[0],P1[1],   pw1[2]=PKW(P0,12),pw1[3]=PKW(P0,14), pw1); \
    VRD(2); SBAR(); GAPA(C0=__builtin_amdgcn_mfma_f32_32x32x16_bf16(kf[4],qr[2],C0,0,0,0),   P1[2],P1[3],P1[4],P1[5],     pw2[0]=PKW(P1,0), pw2[1]=PKW(P1,2), pw2); \
    VRD(6); SBAR(); GAPA(C1=__builtin_amdgcn_mfma_f32_32x32x16_bf16(kf[5],qr[2],C1,0,0,0),   P1[6],P1[7],P1[8],P1[9],     pw2[2]=PKW(P1,4), pw2[3]=PKW(P1,6), pw2); \
    VRD(3); SBAR(); GAPA(C0=__builtin_amdgcn_mfma_f32_32x32x16_bf16(kf[6],qr[3],C0,0,0,0),   P1[10],P1[11],P1[12],P1[13], pw3[0]=PKW(P1,8), pw3[1]=PKW(P1,10), pw3); \
    VRD(7); SBAR(); GAPA(C1=__builtin_amdgcn_mfma_f32_32x32x16_bf16(kf[7],qr[3],C1,0,0,0),   P1[14],P1[15],0.f,0.f,       pw3[2]=PKW(P1,12),pw3[3]=PKW(P1,14), pw3); \
    l_reg+=sacc; \
    if(GK){DMA_K((t)+3,sl_cur);} if(GV){DMA_V((t)+1,sl_next);} \
    CMASK(C0,C1,t); \
    { float a=MX3(C0[0],C0[1],C1[0]),b=MX3(C0[2],C0[3],C1[1]); a=MX3(a,C1[2],C1[3]); \
      _Pragma("unroll") for(int r=4;r<16;r+=4){a=MX3(a,C0[r],C0[r+1]);b=MX3(b,C0[r+2],C0[r+3]);a=MX3(a,C1[r],C1[r+1]);b=MX3(b,C1[r+2],C1[r+3]);} \
      float rm=__builtin_fmaxf(a,b); { auto rr=__builtin_amdgcn_permlane32_swap(__float_as_uint(rm),__float_as_uint(rm),false,false); rm=__builtin_fmaxf(__uint_as_float(rr[0]),__uint_as_float(rr[1])); } \
      resc=false; \
      if(__builtin_expect(__any(rm>(float)THRL),0)){ const float dl=__builtin_fmaxf(rm,0.f); mhat+=dl; \
        _Pragma("unroll") for(int r=0;r<16;++r){C0[r]-=dl;C1[r]-=dl;} \
        _Pragma("unroll") for(int r=0;r<16;++r)negm[r]=-mhat; asm volatile("":"+v"(negm)); \
        const float f=__builtin_amdgcn_exp2f(-dl); l_reg*=f; if(hi==0)wsf[r32]=f; resc=true; } } \
    SBAR(); \
    GAPB(o[0]=__builtin_amdgcn_mfma_f32_32x32x16_bf16(PAF(0),VFR(0),o[0],0,0,0), C0,0); \
    GAPB(o[1]=__builtin_amdgcn_mfma_f32_32x32x16_bf16(PAF(0),VFR(4),o[1],0,0,0), C0,4); \
    KRD(GL,0); GAPB(o[0]=__builtin_amdgcn_mfma_f32_32x32x16_bf16(PAF(1),VFR(1),o[0],0,0,0), C0,8); \
    KRD(GL,1); GAPB(o[1]=__builtin_amdgcn_mfma_f32_32x32x16_bf16(PAF(1),VFR(5),o[1],0,0,0), C0,12); \
    KRD(GL,2); GAPB(o[0]=__builtin_amdgcn_mfma_f32_32x32x16_bf16(PAF(2),VFR(2),o[0],0,0,0), C1,0); \
    KRD(GL,3); GAPB(o[1]=__builtin_amdgcn_mfma_f32_32x32x16_bf16(PAF(2),VFR(6),o[1],0,0,0), C1,4); \
    GAPB(o[0]=__builtin_amdgcn_mfma_f32_32x32x16_bf16(PAF(3),VFR(3),o[0],0,0,0), C1,8); \
    GAPB(o[1]=__builtin_amdgcn_mfma_f32_32x32x16_bf16(PAF(3),VFR(7),o[1],0,0,0), C1,12); \
    }while(0)
  int t=1;
  #undef CMASK
  #define CMASK(P0,P1,t) do{}while(0)
  for(;t+7<NT;t+=2){
    STEP(pB0,pB1,pA0,pA1,t,true,true,true);     WAIT_BAR(2); RESC(); ROT();
    STEP(pA0,pA1,pB0,pB1,t+1,true,true,true);   WAIT_BAR(2); RESC(); ROT();
  }
  #undef CMASK
  #define CMASK(P0,P1,t) do{int jb_=(t)-(NT-6); if(jb_>=0)biasmask(P0,P1,jb_,qrel,hi,lut);}while(0)
  #define ENDW(tt) do{ if((tt)+3<NT){WAIT_BAR(2);} else if((tt)+2<NT){WAIT_BAR(1);} else {WAIT_BAR(0);} }while(0)
  for(;t+1<NT;t+=2){
    STEP(pB0,pB1,pA0,pA1,t,(t+3<NT),(t+1<NT),(t+1<NT));       ENDW(t);   RESC(); ROT();
    STEP(pA0,pA1,pB0,pB1,t+1,(t+4<NT),(t+2<NT),(t+2<NT));     ENDW(t+1); RESC(); ROT();
  }
  STEP(pB0,pB1,pA0,pA1,NT-1,false,false,false); RESC();
  { float sacc=pB0[0]+pB0[1]; _Pragma("unroll") for(int r=2;r<16;++r)sacc+=pB0[r]; _Pragma("unroll") for(int r=0;r<16;++r)sacc+=pB1[r]; l_reg+=sacc;
    pw0=(u32x4){PKW(pB0,0),PKW(pB0,2),PKW(pB0,4),PKW(pB0,6)};pw1=(u32x4){PKW(pB0,8),PKW(pB0,10),PKW(pB0,12),PKW(pB0,14)};pw2=(u32x4){PKW(pB1,0),PKW(pB1,2),PKW(pB1,4),PKW(pB1,6)};pw3=(u32x4){PKW(pB1,8),PKW(pB1,10),PKW(pB1,12),PKW(pB1,14)};
    SBAR(); pv(o,vb0+sl_cur,PAF(0),PAF(1),PAF(2),PAF(3)); }
  #undef PKW
  #undef PAF
  #undef VFR
  #undef PIN
  #undef MX3
  #undef GAPA
  #undef GAPB
  #undef EX
  #undef VRD
  #undef KRD
  #undef STEP
  #undef ENDW
  {auto rr=__builtin_amdgcn_permlane32_swap(__float_as_uint(l_reg),__float_as_uint(l_reg),false,false);l_reg=__uint_as_float(rr[0])+__uint_as_float(rr[1]);}
  if(hi==0)wsf[32+r32]=l_reg;asm volatile("s_waitcnt lgkmcnt(0)":::"memory");
  float rli[16];
  #pragma unroll
  for(int r=0;r<16;++r)rli[r]=__builtin_amdgcn_rcpf(wsf[32+crow(r,hi)]);
  bf16*Ow=O+(rowbase+q0+wid*QBLK)*PO;
  { bf16*stg=(bf16*)(shm+LDS_OST)+wid*2048;
    #pragma unroll
    for(int r=0;r<16;++r){const int orow=crow(r,hi);
      #pragma unroll
      for(int d0=0;d0<2;++d0)stg[orow*64+d0*32+r32]=__float2bfloat16(o[d0][r]*rli[r]);}
    asm volatile("s_waitcnt lgkmcnt(0)":::"memory");
    #pragma unroll
    for(int i=0;i<4;++i){const int row=i*8+(lane>>3),ch=lane&7; const u32x4 v=*(const u32x4*)(stg+row*64+ch*8); *(u32x4*)(Ow+(long)row*PO+ch*8)=v;} }
  asm volatile("s_waitcnt lgkmcnt(0)\n\ts_barrier":::"memory");
  #undef DMA_K
  #undef DMA_V
  #undef CMASK
  #undef START
  #undef RESC
  #undef ROT
}

constexpr int VSLOTB=16384, L2_K=0, L2_V=NSLOT*SLOTB, L2_WS=L2_V+NSLOT*VSLOTB, L2_QO=L2_WS+NW*64*4, L2_BYTES=L2_QO+NW*4096;
template<int THRL> __device__ __forceinline__ void attn_unit128(int b,int qb,const bf16*QKV,int Qc,int Kc,int Vc,bf16*O,const LAS float*lut,char*shm){
  int tid_=threadIdx.x; asm volatile("":"+v"(tid_)); const int tid=tid_,lane=tid&63,r32=lane&31,hi=lane>>5; const int wid=__builtin_amdgcn_readfirstlane(tid>>6);
  const long rowbase=(long)b*SEQ; const int q0=qb*QB;
  const bf16*Qw=QKV+(rowbase+q0+wid*QBLK)*PQ+Qc;
  const bf16*Kh=QKV+rowbase*PQ+Kc,*Vh=QKV+rowbase*PQ+Vc;
  const unsigned lds0=(unsigned)(uintptr_t)shm;
  float*wsf=(float*)(shm+L2_WS)+wid*64;
  const bf16*ksrc=Kh+(long)lane*PQ+wid*8;
  const bf16*vsrc=Vh+(long)(16*(wid&3)+(lane>>2))*PQ+(wid>>2)*32+(lane&3)*8;
  const unsigned kdst=lds0+L2_K+wid*1024, vdst=lds0+L2_V+wid*1024;
  #define DMA_K(t,slot) glds16(ksrc+(long)(t)*KVBLK*PQ,(unsigned)__builtin_amdgcn_readfirstlane(kdst+(slot)))
  #define DMA_V(t,slot) do{ glds16(vsrc+(long)(t)*KVBLK*PQ,(unsigned)__builtin_amdgcn_readfirstlane(vdst+2*(slot))); glds16(vsrc+(long)(t)*KVBLK*PQ+64,(unsigned)__builtin_amdgcn_readfirstlane(vdst+2*(slot)+8192)); }while(0)
  const int vb0=(int)(lds0+L2_V)+((lane>>4)&1)*32+(lane&3)*8+(4*hi+((lane&15)>>2))*64;
  const char*Kbase=shm+L2_K; bf16x8 kf[8];
  const lds_cptr shm3=(lds_cptr)shm; const lds_cptr kp0=shm3+L2_K+hi*1024+r32*16; const lds_cptr vp0=shm3+L2_V+((lane>>4)&1)*32+(lane&3)*8+(4*hi+((lane&15)>>2))*64;
  const lds_cptr qst=shm3+L2_QO+wid*4096+lane*16;
  const int NT=(q0+QB)/KVBLK;
  DMA_K(0,0);DMA_V(0,0);DMA_K(1,SLOTB);
  { bf16x8 qr[4];
    #pragma unroll
    for(int d0=0;d0<4;++d0)qr[d0]=*reinterpret_cast<const bf16x8*>(&Qw[(long)r32*PQ+d0*16+hi*8]);
    #pragma unroll
    for(int d0=0;d0<4;++d0)*(LAS bf16x8*)(qst+d0*1024)=qr[d0]; }
  float mhat=0.f,l_reg=0.f;f32x16 o[4]; { float zz; asm volatile("v_mov_b32 %0, 0":"=v"(zz)); _Pragma("unroll") for(int r=0;r<16;++r){o[0][r]=zz;o[1][r]=zz;o[2][r]=zz;o[3][r]=zz;} }
  const int qrel=wid*QBLK+r32;
  #define QF(d0) (*(const LAS bf16x8*)(qst+(d0)*1024))
  #define CMASK(P0,P1,t) do{int jb_=(t)-(NT-6); if(jb_>=0)biasmask(P0,P1,jb_,qrel,hi,lut);}while(0)
  bool resc=false;
  #define RESC() do{ if(resc){ asm volatile("s_waitcnt lgkmcnt(0)":::"memory"); \
      _Pragma("unroll") for(int d_=0;d_<4;++d_) _Pragma("unroll") for(int r=0;r<16;++r)o[d_][r]*=wsf[crow(r,hi)]; } }while(0)
  f32x16 pA0,pA1,pB0,pB1;
  int sl_prev=0,sl_cur=0,sl_next=SLOTB;
  #define ROT() do{sl_prev=sl_cur;sl_cur=sl_next;sl_next=(sl_next==(NSLOT-1)*SLOTB)?0:sl_next+SLOTB;}while(0)
  DMA_K(2,2*SLOTB);
  WAIT_BAR(3);
  {
    const char*kb=Kbase+hi*1024+r32*16; const f32x16 z16={};
    #pragma unroll
    for(int d0=0;d0<4;++d0){ const bf16x8 qf=QF(d0);
      const bf16x8 b0=*reinterpret_cast<const bf16x8*>(kb+d0*2048); const bf16x8 b1=*reinterpret_cast<const bf16x8*>(kb+d0*2048+512);
      if(d0==0){pA0=__builtin_amdgcn_mfma_f32_32x32x16_bf16(b0,qf,z16,0,0,0);pA1=__builtin_amdgcn_mfma_f32_32x32x16_bf16(b1,qf,z16,0,0,0);}
      else{pA0=__builtin_amdgcn_mfma_f32_32x32x16_bf16(b0,qf,pA0,0,0,0);pA1=__builtin_amdgcn_mfma_f32_32x32x16_bf16(b1,qf,pA1,0,0,0);} }
    asm volatile("s_nop 15\n\ts_nop 7":"+v"(pA0),"+v"(pA1));CMASK(pA0,pA1,0);
    mhat=rowmax(pA0,pA1);
    #pragma unroll
    for(int r=0;r<16;++r){pA0[r]=__builtin_amdgcn_exp2f(pA0[r]-mhat);pA1[r]=__builtin_amdgcn_exp2f(pA1[r]-mhat);} }
  WAIT_BAR(0);
  DMA_K(3,0);DMA_V(1,SLOTB);
  ROT();
  kload8(kf,kp0+sl_cur);
  WAIT_BAR(3);
  s16x4 vlo[8],vhi[8]; u32x4 pw0,pw1,pw2,pw3;
  #define PKW(P,B) cvtpk_s(P[B],P[B+1])
  #define PAF(k) __builtin_bit_cast(bf16x8,pw##k)
  #define VFR(i) (bf16x8){vlo[i][0],vlo[i][1],vlo[i][2],vlo[i][3],vhi[i][0],vhi[i][1],vhi[i][2],vhi[i][3]}
  #define PIN(x) asm volatile("":"+v"(x))
  #define MX3(a,b,c) __builtin_fmaxf(__builtin_fmaxf((a),(b)),(c))
  #define MFQ(C,kk,qv,Cin) C=__builtin_amdgcn_mfma_f32_32x32x16_bf16(kf[kk],qv,Cin,0,0,0)
  #define GAPA(MF,A0,A1,A2,A3,W0,W1,PW) do{ MF; sacc+=A0; sacc+=A1; sacc+=A2; sacc+=A3; PIN(sacc); W0; W1; PIN(PW); SBAR(); }while(0)
  #define EX(v) __builtin_amdgcn_exp2f((v)-mhat)
  #define GAPB(MF,X,B) do{ MF; X[B]=EX(X[B]); X[B+1]=EX(X[B+1]); PIN(X); SBAR(); }while(0)
  #define VRD(i) do{ vlo[(i)&7]=vtr(vp_+(((i)>>2)*4096+((i)&3)*1024)); vhi[(i)&7]=vtr(vp_+(((i)>>2)*4096+((i)&3)*1024+512)); }while(0)
  #define KRD(G,j) do{ if(G){ kload2(kf,kp0+sl_next,j); SBAR(); } }while(0)
  #define STEP(C0,C1,P0,P1,t,GK,GV,GL) do{ SBAR(); \
    const lds_cptr vp_=vp0+2*sl_prev; const f32x16 z16={}; bf16x8 qf; \
    VRD(0); qf=QF(0); SBAR(); float sacc=(P0[0]+P0[1]); \
    GAPA(MFQ(C0,0,qf,z16), P0[2],P0[3],P0[4],P0[5],     pw0[0]=PKW(P0,0), pw0[1]=PKW(P0,2), pw0); \
    VRD(4); SBAR(); GAPA(MFQ(C1,1,qf,z16), P0[6],P0[7],P0[8],P0[9],     pw0[2]=PKW(P0,4), pw0[3]=PKW(P0,6), pw0); \
    VRD(1); qf=QF(1); SBAR(); GAPA(MFQ(C0,2,qf,C0),   P0[10],P0[11],P0[12],P0[13], pw1[0]=PKW(P0,8), pw1[1]=PKW(P0,10), pw1); \
    VRD(5); SBAR(); GAPA(MFQ(C1,3,qf,C1),   P0[14],P0[15],P1[0],P1[1],   pw1[2]=PKW(P0,12),pw1[3]=PKW(P0,14), pw1); \
    VRD(2); qf=QF(2); SBAR(); GAPA(MFQ(C0,4,qf,C0),   P1[2],P1[3],P1[4],P1[5],     pw2[0]=PKW(P1,0), pw2[1]=PKW(P1,2), pw2); \
    VRD(6); SBAR(); GAPA(MFQ(C1,5,qf,C1),   P1[6],P1[7],P1[8],P1[9],     pw2[2]=PKW(P1,4), pw2[3]=PKW(P1,6), pw2); \
    VRD(3); qf=QF(3); SBAR(); GAPA(MFQ(C0,6,qf,C0),   P1[10],P1[11],P1[12],P1[13], pw3[0]=PKW(P1,8), pw3[1]=PKW(P1,10), pw3); \
    VRD(7); SBAR(); GAPA(MFQ(C1,7,qf,C1),   P1[14],P1[15],0.f,0.f,       pw3[2]=PKW(P1,12),pw3[3]=PKW(P1,14), pw3); \
    l_reg+=sacc; \
    if(GK){DMA_K((t)+3,sl_cur);} if(GV){DMA_V((t)+1,sl_next);} \
    CMASK(C0,C1,t); \
    { float a=MX3(C0[0],C0[1],C1[0]),b=MX3(C0[2],C0[3],C1[1]); a=MX3(a,C1[2],C1[3]); \
      _Pragma("unroll") for(int r=4;r<16;r+=4){a=MX3(a,C0[r],C0[r+1]);b=MX3(b,C0[r+2],C0[r+3]);a=MX3(a,C1[r],C1[r+1]);b=MX3(b,C1[r+2],C1[r+3]);} \
      float rm=__builtin_fmaxf(a,b); { auto rr=__builtin_amdgcn_permlane32_swap(__float_as_uint(rm),__float_as_uint(rm),false,false); rm=__builtin_fmaxf(__uint_as_float(rr[0]),__uint_as_float(rr[1])); } \
      rm-=mhat; resc=false; \
      if(__builtin_expect(__any(rm>(float)THRL),0)){ const float dl=__builtin_fmaxf(rm,0.f); mhat+=dl; \
        const float f=__builtin_amdgcn_exp2f(-dl); l_reg*=f; if(hi==0)wsf[r32]=f; resc=true; } } \
    SBAR(); \
    GAPB(o[0]=__builtin_amdgcn_mfma_f32_32x32x16_bf16(PAF(0),VFR(0),o[0],0,0,0), C0,0);  VRD(8);  SBAR(); \
    GAPB(o[1]=__builtin_amdgcn_mfma_f32_32x32x16_bf16(PAF(0),VFR(4),o[1],0,0,0), C0,2);  VRD(12); SBAR(); \
    GAPB(o[0]=__builtin_amdgcn_mfma_f32_32x32x16_bf16(PAF(1),VFR(1),o[0],0,0,0), C0,4);  VRD(9);  SBAR(); \
    GAPB(o[1]=__builtin_amdgcn_mfma_f32_32x32x16_bf16(PAF(1),VFR(5),o[1],0,0,0), C0,6);  VRD(13); SBAR(); \
    GAPB(o[0]=__builtin_amdgcn_mfma_f32_32x32x16_bf16(PAF(2),VFR(2),o[0],0,0,0), C0,8);  VRD(10); SBAR(); \
    GAPB(o[1]=__builtin_amdgcn_mfma_f32_32x32x16_bf16(PAF(2),VFR(6),o[1],0,0,0), C0,10); VRD(14); SBAR(); \
    GAPB(o[0]=__builtin_amdgcn_mfma_f32_32x32x16_bf16(PAF(3),VFR(3),o[0],0,0,0), C0,12); VRD(11); SBAR(); \
    GAPB(o[1]=__builtin_amdgcn_mfma_f32_32x32x16_bf16(PAF(3),VFR(7),o[1],0,0,0), C0,14); VRD(15); SBAR(); \
    GAPB(o[2]=__builtin_amdgcn_mfma_f32_32x32x16_bf16(PAF(0),VFR(0),o[2],0,0,0), C1,0); \
    GAPB(o[3]=__builtin_amdgcn_mfma_f32_32x32x16_bf16(PAF(0),VFR(4),o[3],0,0,0), C1,2); \
    KRD(GL,0); GAPB(o[2]=__builtin_amdgcn_mfma_f32_32x32x16_bf16(PAF(1),VFR(1),o[2],0,0,0), C1,4); \
    KRD(GL,1); GAPB(o[3]=__builtin_amdgcn_mfma_f32_32x32x16_bf16(PAF(1),VFR(5),o[3],0,0,0), C1,6); \
    KRD(GL,2); GAPB(o[2]=__builtin_amdgcn_mfma_f32_32x32x16_bf16(PAF(2),VFR(2),o[2],0,0,0), C1,8); \
    KRD(GL,3); GAPB(o[3]=__builtin_amdgcn_mfma_f32_32x32x16_bf16(PAF(2),VFR(6),o[3],0,0,0), C1,10); \
    GAPB(o[2]=__builtin_amdgcn_mfma_f32_32x32x16_bf16(PAF(3),VFR(3),o[2],0,0,0), C1,12); \
    GAPB(o[3]=__builtin_amdgcn_mfma_f32_32x32x16_bf16(PAF(3),VFR(7),o[3],0,0,0), C1,14); \
    }while(0)
  int t=1;
  #undef CMASK
  #define CMASK(P0,P1,t) do{}while(0)
  for(;t+7<NT;t+=2){
    STEP(pB0,pB1,pA0,pA1,t,true,true,true);     WAIT_BAR(3); RESC(); ROT();
    STEP(pA0,pA1,pB0,pB1,t+1,true,true,true);   WAIT_BAR(3); RESC(); ROT();
  }
  #undef CMASK
  #define CMASK(P0,P1,t) do{int jb_=(t)-(NT-6); if(jb_>=0)biasmask(P0,P1,jb_,qrel,hi,lut);}while(0)
  #define ENDW(tt) do{ if((tt)+3<NT){WAIT_BAR(3);} else if((tt)+2<NT){WAIT_BAR(2);} else {WAIT_BAR(0);} }while(0)
  for(;t+1<NT;t+=2){
    STEP(pB0,pB1,pA0,pA1,t,(t+3<NT),(t+1<NT),(t+1<NT));       ENDW(t);   RESC(); ROT();
    STEP(pA0,pA1,pB0,pB1,t+1,(t+4<NT),(t+2<NT),(t+2<NT));     ENDW(t+1); RESC(); ROT();
  }
  STEP(pB0,pB1,pA0,pA1,NT-1,false,false,false); RESC();
  { float sacc=pB0[0]+pB0[1]; _Pragma("unroll") for(int r=2;r<16;++r)sacc+=pB0[r]; _Pragma("unroll") for(int r=0;r<16;++r)sacc+=pB1[r]; l_reg+=sacc;
    pw0=(u32x4){PKW(pB0,0),PKW(pB0,2),PKW(pB0,4),PKW(pB0,6)};pw1=(u32x4){PKW(pB0,8),PKW(pB0,10),PKW(pB0,12),PKW(pB0,14)};pw2=(u32x4){PKW(pB1,0),PKW(pB1,2),PKW(pB1,4),PKW(pB1,6)};pw3=(u32x4){PKW(pB1,8),PKW(pB1,10),PKW(pB1,12),PKW(pB1,14)};
    SBAR();
    const int vb=vb0+2*sl_cur;
    #pragma unroll
    for(int d0=0;d0<4;++d0){s16x4 lo[4],hh[4];
      #pragma unroll
      for(int ks=0;ks<4;++ks){
        asm volatile("ds_read_b64_tr_b16 %0,%1 offset:%c2":"=&v"(lo[ks]):"v"(vb),"i"(d0*4096+ks*1024):"memory");
        asm volatile("ds_read_b64_tr_b16 %0,%1 offset:%c2":"=&v"(hh[ks]):"v"(vb),"i"(d0*4096+ks*1024+512):"memory");}
      asm volatile("s_waitcnt lgkmcnt(0)":::"memory");SBAR();
      #define PK(k) (bf16x8){lo[k][0],lo[k][1],lo[k][2],lo[k][3],hh[k][0],hh[k][1],hh[k][2],hh[k][3]}
      o[d0]=__builtin_amdgcn_mfma_f32_32x32x16_bf16(PAF(0),PK(0),o[d0],0,0,0);
      o[d0]=__builtin_amdgcn_mfma_f32_32x32x16_bf16(PAF(1),PK(1),o[d0],0,0,0);
      o[d0]=__builtin_amdgcn_mfma_f32_32x32x16_bf16(PAF(2),PK(2),o[d0],0,0,0);
      o[d0]=__builtin_amdgcn_mfma_f32_32x32x16_bf16(PAF(3),PK(3),o[d0],0,0,0);
      #undef PK
    } }
  #undef PKW
  #undef PAF
  #undef VFR
  #undef PIN
  #undef MX3
  #undef MFQ
  #undef GAPA
  #undef GAPB
  #undef EX
  #undef VRD
  #undef KRD
  #undef STEP
  #undef ENDW
  #undef QF
  {auto rr=__builtin_amdgcn_permlane32_swap(__float_as_uint(l_reg),__float_as_uint(l_reg),false,false);l_reg=__uint_as_float(rr[0])+__uint_as_float(rr[1]);}
  if(hi==0)wsf[32+r32]=l_reg;asm volatile("s_waitcnt lgkmcnt(0)":::"memory");
  float rli[16];
  #pragma unroll
  for(int r=0;r<16;++r)rli[r]=__builtin_amdgcn_rcpf(wsf[32+crow(r,hi)]);
  bf16*Ow=O+(rowbase+q0+wid*QBLK)*PO;
  { bf16*stg=(bf16*)(shm+L2_QO)+wid*2048;
    #pragma unroll
    for(int hh=0;hh<2;++hh){
      #pragma unroll
      for(int r=0;r<16;++r){const int orow=crow(r,hi);
        #pragma unroll
        for(int d0=0;d0<2;++d0)stg[orow*64+d0*32+r32]=__float2bfloat16(o[2*hh+d0][r]*rli[r]);}
      asm volatile("s_waitcnt lgkmcnt(0)":::"memory");
      #pragma unroll
      for(int i=0;i<4;++i){const int row=i*8+(lane>>3),ch=lane&7; const u32x4 v=*(const u32x4*)(stg+row*64+ch*8); *(u32x4*)(Ow+(long)row*PO+hh*64+ch*8)=v;}
      asm volatile("s_waitcnt lgkmcnt(0)":::"memory"); } }
  asm volatile("s_waitcnt lgkmcnt(0)\n\ts_barrier":::"memory");
  #undef DMA_K
  #undef DMA_V
  #undef CMASK
  #undef RESC
  #undef ROT
}

constexpr int ATTN_LDS_BYTES=LDS_BYTES;
#undef SBAR
#undef WAIT_BAR
}
constexpr int NWAVES = 8;
typedef unsigned short bf16;
typedef unsigned v4u __attribute__((ext_vector_type(4)));
typedef unsigned v2u __attribute__((ext_vector_type(2)));
typedef float f32x4 __attribute__((ext_vector_type(4)));
typedef float f32x2 __attribute__((ext_vector_type(2)));
typedef short bf16x8 __attribute__((ext_vector_type(8)));
typedef GAS unsigned gu32;
#define RLX_AGENT __ATOMIC_RELAXED, __HIP_MEMORY_SCOPE_AGENT
#define LDS_WAIT() asm volatile("s_waitcnt lgkmcnt(0)" ::: "memory")
#define VM_WAIT() asm volatile("s_waitcnt vmcnt(0)" ::: "memory")
__device__ __forceinline__ unsigned f2bf(float f) { unsigned u = __builtin_bit_cast(unsigned, f); return (u + 0x7fffu + ((u >> 16) & 1u)) >> 16; }
__device__ __forceinline__ unsigned pk2(float lo, float hi) { return f2bf(lo) | (f2bf(hi) << 16); }
__device__ __forceinline__ float bf2f(unsigned short b) { return __builtin_bit_cast(float, (unsigned)b << 16); }
__device__ __forceinline__ float bflo(unsigned w) { return __builtin_bit_cast(float, w << 16); }
__device__ __forceinline__ float bfhi(unsigned w) { return __builtin_bit_cast(float, w & 0xffff0000u); }

#define XB_TMO      128
#define XB_XCNT(j)  (256  + 64 * (j))
#define XB_XSUB(j)  (1280 + 64 * (j))
#define XB_XGEN(j)  (2304 + 64 * (j))
#define XB_TOP      3328
#define XB_TOPGEN   3392
#define XCD_BAR_WORDS 3456
#define XB_SPIN_CAP (1u << 18)
__device__ __forceinline__ unsigned xb_ld(unsigned* p)              { return __hip_atomic_load(p, __ATOMIC_RELAXED, __HIP_MEMORY_SCOPE_AGENT); }
__device__ __forceinline__ unsigned xb_add(unsigned* p, unsigned v) { return __hip_atomic_fetch_add(p, v, __ATOMIC_RELAXED, __HIP_MEMORY_SCOPE_AGENT); }
__device__ __forceinline__ unsigned xb_xcc_id() { return (unsigned)__builtin_amdgcn_s_getreg((3 << 11) | 20) & 0xFu; }
#define XB_SPIN(cond, bar) do { unsigned _sp = 0; while (cond) { __builtin_amdgcn_s_sleep(1); \
    if ((++_sp & 255u) == 0u) { if (xb_ld(&(bar)[XB_TMO])) break; if (_sp > XB_SPIN_CAP) { atomicAdd(&(bar)[XB_TMO], 1u); break; } } } } while (0)
struct XcdBarrier { unsigned* bar; unsigned x; volatile LAS unsigned* st; };
__device__ __forceinline__ XcdBarrier xcd_barrier_post(unsigned* bar, volatile LAS unsigned* st) {
    XcdBarrier b; b.bar = bar; b.x = xb_xcc_id(); b.st = st;
    if (threadIdx.x == 0) (void)xb_add(&bar[XB_XCNT(b.x)], 1u);
    return b;
}
__device__ __forceinline__ void xcd_barrier_complete(unsigned* bar, unsigned x, unsigned& nloc, unsigned& nx) {
    const unsigned G = gridDim.x * gridDim.y * gridDim.z;
    unsigned sum, cnt, mine, sp = 0u;
    for (;;) {
        sum = 0u; cnt = 0u; mine = 0u;
#pragma unroll
        for (unsigned j = 0; j < 16; ++j) { const unsigned c = xb_ld(&bar[XB_XCNT(j)]); sum += c; cnt += (c > 0u) ? 1u : 0u; mine = (j == x) ? c : mine; }
        if (sum == G) break;
        __builtin_amdgcn_s_sleep(1);
        if ((++sp & 255u) == 0u) { if (xb_ld(&bar[XB_TMO])) break; if (sp > XB_SPIN_CAP) { atomicAdd(&bar[XB_TMO], 1u); break; } }
    }
    nloc = mine > 0u ? mine : 1u; nx = cnt > 0u ? cnt : 1u;
}
__device__ __forceinline__ void xcd_barrier(const XcdBarrier& b) {
    asm volatile("s_waitcnt vmcnt(0)" ::: "memory");
    __syncthreads();
    if (threadIdx.x == 0) {
        unsigned* bar = b.bar;
        __builtin_amdgcn_s_waitcnt(0);
        unsigned nloc = b.st[0], nx = b.st[1];
        if (nloc == 0u) { xcd_barrier_complete(bar, b.x, nloc, nx); b.st[0] = nloc; b.st[1] = nx; }
        const unsigned old = xb_add(&bar[XB_XSUB(b.x)], 1u);
        const unsigned gen = old / nloc;
        if (old + 1u == (gen + 1u) * nloc) {
            __builtin_amdgcn_fence(__ATOMIC_RELEASE, "agent");
            asm volatile("s_waitcnt vmcnt(0)" ::: "memory");
            const unsigned og = xb_add(&bar[XB_TOP], 1u);
            const unsigned tg = og / nx;
            if (og + 1u == (tg + 1u) * nx) xb_add(&bar[XB_TOPGEN], 1u);
            else XB_SPIN(xb_ld(&bar[XB_TOPGEN]) == tg, bar);
            __builtin_amdgcn_fence(__ATOMIC_ACQUIRE, "agent");
            xb_add(&bar[XB_XGEN(b.x)], 1u);
            asm volatile("s_waitcnt vmcnt(0)" ::: "memory");
        } else {
            XB_SPIN(xb_ld(&bar[XB_XGEN(b.x)]) == gen, bar);
            __builtin_amdgcn_fence(__ATOMIC_ACQUIRE, "agent");
            asm volatile("s_waitcnt vmcnt(0)" ::: "memory");
        }
    }
    __syncthreads();
}

struct Args { const float* in[18]; float* out; unsigned char* ws; int ph_lo, ph_hi, li, pad; };
struct Frame {
    LAS unsigned char* lds;
    gu32* ctl;
    unsigned char* ws;
    int tid, lane, wave;
    int vcu, G;
};

__device__ __forceinline__ float wave_sum(float v) {
#pragma unroll
    for (int o = 1; o < 64; o <<= 1) v += __shfl_xor(v, o);
    return v;
}
__device__ __forceinline__ void transpose_block(const float* src, int ld_src, bf16* dst, int ld_dst, LAS float* scr, int lane, bf16* dst2) {
#pragma unroll 8
    for (int i = 0; i < 32; ++i) { const int kk = 2 * i + (lane >> 5); scr[kk * 33 + (lane & 31)] = src[(size_t)kk * ld_src + (lane & 31)]; }
    LDS_WAIT(); asm volatile("" ::: "memory");
    const int c = lane & 7;
#pragma unroll
    for (int j = 0; j < 4; ++j) { const int n = (lane >> 3) + 8 * j; const LAS float* s = scr + (8 * c) * 33 + n;
        v4u o; o.x = pk2(s[0 * 33], s[1 * 33]); o.y = pk2(s[2 * 33], s[3 * 33]); o.z = pk2(s[4 * 33], s[5 * 33]); o.w = pk2(s[6 * 33], s[7 * 33]);
        *(GAS v4u*)(dst + (size_t)n * ld_dst + 8 * c) = o;
        if (dst2) *(GAS v4u*)(dst2 + (size_t)n * ld_dst + 8 * c) = o; }
    LDS_WAIT(); asm volatile("" ::: "memory");
}
__device__ __forceinline__ unsigned pk4_fp8f(float a, float b, float c, float d) { int w = 0; w = __builtin_amdgcn_cvt_pk_fp8_f32(a, b, w, false); w = __builtin_amdgcn_cvt_pk_fp8_f32(c, d, w, true); return (unsigned)w; }
__device__ __forceinline__ void transpose_block8(const float* src, int ld_src, unsigned char* dst, int ld_dst, float sc, LAS float* scr, int lane, unsigned char* dst2 = nullptr) {
#pragma unroll 8
    for (int i = 0; i < 32; ++i) { const int kk = 2 * i + (lane >> 5); scr[kk * 33 + (lane & 31)] = src[(size_t)kk * ld_src + (lane & 31)]; }
    LDS_WAIT(); asm volatile("" ::: "memory");
    const int c = lane & 7;
#pragma unroll
    for (int j = 0; j < 4; ++j) { const int n = (lane >> 3) + 8 * j; const LAS float* s = scr + (8 * c) * 33 + n;
        v2u o; o.x = pk4_fp8f(s[0 * 33] * sc, s[1 * 33] * sc, s[2 * 33] * sc, s[3 * 33] * sc); o.y = pk4_fp8f(s[4 * 33] * sc, s[5 * 33] * sc, s[6 * 33] * sc, s[7 * 33] * sc);
        *(GAS v2u*)(dst + (size_t)n * ld_dst + 8 * c) = o;
        if (dst2) *(GAS v2u*)(dst2 + (size_t)n * ld_dst + 8 * c) = o; }
    LDS_WAIT(); asm volatile("" ::: "memory");
}
__device__ __forceinline__ void rms_row_to_bf16(int lane, const float* xrow, const float* g, bf16* orow) {
    const GAS f32x4* xr = (const GAS f32x4*)xrow + lane; const GAS f32x4* gr = (const GAS f32x4*)g + lane;
    f32x4 v[4]; float s = 0.f;
#pragma unroll
    for (int j = 0; j < 4; ++j) { v[j] = xr[64 * j]; s += (v[j].x * v[j].x + v[j].y * v[j].y) + (v[j].z * v[j].z + v[j].w * v[j].w); }
    const float rstd = 1.0f / sqrtf(wave_sum(s) * (1.f / 1024.f) + RMS_EPS);
    GAS v2u* o8 = (GAS v2u*)orow + lane;
#pragma unroll
    for (int j = 0; j < 4; ++j) { const f32x4 gg = gr[64 * j]; v2u o; o.x = pk2(v[j].x * rstd * gg.x, v[j].y * rstd * gg.y); o.y = pk2(v[j].z * rstd * gg.z, v[j].w * rstd * gg.w); o8[64 * j] = o; }
}

__device__ __forceinline__ void rms_row_to_fp8(int lane, const float* xrow, const float* g, unsigned char* orow) {
    const GAS f32x4* xr = (const GAS f32x4*)xrow + lane; const GAS f32x4* gr = (const GAS f32x4*)g + lane;
    f32x4 v[4]; float s = 0.f;
#pragma unroll
    for (int j = 0; j < 4; ++j) { v[j] = xr[64 * j]; s += (v[j].x * v[j].x + v[j].y * v[j].y) + (v[j].z * v[j].z + v[j].w * v[j].w); }
    const float rstd = H8_SCALE / sqrtf(wave_sum(s) * (1.f / 1024.f) + RMS_EPS);
    GAS unsigned* o4 = (GAS unsigned*)orow + lane;
#pragma unroll
    for (int j = 0; j < 4; ++j) { const f32x4 gg = gr[64 * j]; o4[64 * j] = pk4_fp8f(v[j].x * rstd * gg.x, v[j].y * rstd * gg.y, v[j].z * rstd * gg.z, v[j].w * rstd * gg.w); }
}
constexpr int IT_WIN0 = (1024 / 64) * (3072 / 32);
constexpr int IT_WOUT0 = (1024 / 64) * (1024 / 32);
constexpr int IT_RIN = (1024 / 64) * (6144 / 32);
constexpr int IT_ROUT = (2048 / 64) * (1024 / 32);
constexpr int IT_SHARED = IT_WIN0 + IT_WOUT0 + IT_RIN + IT_ROUT;
constexpr int IT_EXP = 3 * 256;
constexpr int IT_MOE = NEXP * IT_EXP;
__device__ __forceinline__ void conv_shared_item(Frame& F, const Args& a, int it, LAS float* scr) {
    unsigned char* ws = F.ws;
    if (it < IT_WIN0) { const int nblk = 96, kb = it / nblk, nb = it % nblk;
        if (QKV_FP8) transpose_block8(a.in[5] + (size_t)(64 * kb) * 3072 + 32 * nb, 3072, ws + WS_WINT0 + (size_t)(32 * nb) * 1024 + 64 * kb, 1024, WIN_SCALE, scr, F.lane);
        else transpose_block(a.in[5] + (size_t)(64 * kb) * 3072 + 32 * nb, 3072, (bf16*)(ws + WS_WINT0) + (size_t)(32 * nb) * 1024 + 64 * kb, 1024, scr, F.lane, nullptr);
        return; }
    it -= IT_WIN0;
    if (it < IT_WOUT0) { const int nblk = 32, kb = it / nblk, nb = it % nblk;
        transpose_block(a.in[8] + (size_t)(64 * kb) * 1024 + 32 * nb, 1024, (bf16*)(ws + WS_WOUTT0) + (size_t)(32 * nb) * 1024 + 64 * kb, 1024, scr, F.lane, nullptr); return; }
    it -= IT_WOUT0;
    if (it < IT_RIN) { const int nblk = 192, kb = it / nblk, nb = it % nblk, n0 = 32 * nb;
        unsigned char* A = ws + WS_WRINA; unsigned char* B = ws + WS_WRINB; unsigned char *d1, *d2 = nullptr;
        if (n0 < 2048) d1 = A + (size_t)n0 * 1024;
        else if (n0 < 4096) d1 = B + (size_t)(n0 - 2048) * 1024;
        else d1 = A + (size_t)(n0 - 2048) * 1024;
        transpose_block8(a.in[9] + (size_t)(64 * kb) * 6144 + n0, 6144, d1 + 64 * kb, 1024, WIN_SCALE, scr, F.lane, d2 ? d2 + 64 * kb : nullptr); return; }
    it -= IT_RIN;
    { const int nblk = 32, kb = it / nblk, nb = it % nblk;
        transpose_block(a.in[10] + (size_t)(64 * kb) * 1024 + 32 * nb, 1024, (bf16*)(ws + WS_WROUTT) + (size_t)(32 * nb) * 2048 + 64 * kb, 2048, scr, F.lane, nullptr); }
}
__device__ __forceinline__ void conv_moe_item(Frame& F, const Args& a, int layer, int it, LAS float* scr) {
    unsigned char* ws = F.ws;
    const int e = it / IT_EXP; int r = it % IT_EXP; const size_t le = (size_t)layer * NEXP + e;
    if (r < 512) { const int up = r >> 8; r &= 255; const int kb = r / 16, nb = r % 16, n0 = 32 * nb;
        const float* src = a.in[up ? 16 : 15] + le * (1024 * 512) + (size_t)(64 * kb) * 512 + n0;
        const int drow = 256 * (n0 >> 7) + 128 * up + (n0 & 127);
        transpose_block8(src, 512, ws + WS_W1CAT + ((size_t)e * 1024 + drow) * 1024 + 64 * kb, 1024, W1_SCALE, scr, F.lane); return; }
    r -= 512; { const int kb = r / 32, nb = r % 32;
        const float* src = a.in[17] + le * (512 * 1024) + (size_t)(64 * kb) * 1024 + 32 * nb;
        transpose_block8(src, 1024, ws + WS_W2T + ((size_t)e * 1024 + 32 * nb) * 512 + 64 * kb, 512, W2_SCALE, scr, F.lane); }
}
__device__ __forceinline__ void build_router_frags(Frame& F, const Args& a, int gtid, int gthreads) {
    bf16* wrf = (bf16*)(F.ws + WS_WRF);
    for (int idx = gtid; idx < 2 * 32 * 3 * 64 * 8; idx += gthreads) {
        const int j = idx & 7, lane = (idx >> 3) & 63, nt = (idx >> 9) % 3, s = ((idx >> 9) / 3) & 31, L = (idx >> 9) / 96;
        const int k = 32 * s + 8 * (lane >> 4) + j, o = 16 * nt + (lane & 15);
        float w = 0.f;
        if (o < 4) w = a.in[11][((size_t)L * 1024 + k) * 4 + o]; else if (o < 36) w = a.in[13][((size_t)L * 1024 + k) * 32 + (o - 4)];
        w *= a.in[3][L * 1024 + k];
        const unsigned hi = f2bf(w); const float lo = w - __builtin_bit_cast(float, hi << 16);
        const size_t base = ((((size_t)L * 32 + s) * 3 + nt) * 2) * 512 + (size_t)lane * 8 + j;
        wrf[base] = (bf16)hi; wrf[base + 512] = (bf16)f2bf(lo);
    }
}
__device__ __forceinline__ void build_sincos(Frame& F, int gtid, int gthreads) {
    float* t1 = (float*)(F.ws + WS_SINCOS);
    for (int idx = gtid; idx < SEQ * 128; idx += gthreads) {
        const int pos = idx >> 7, i = idx & 127;
        double ang = 1.0, bs = 0.9300449458481391;
        for (int bit = 0; bit < 7; ++bit) { if ((i >> bit) & 1) ang *= bs; bs *= bs; }
        const double ph = (double)pos * ang;
        const double kq = __builtin_rint(ph * 0.63661977236758134308);
        double r = __builtin_fma(-kq, 1.57079632679489655800, ph); r = __builtin_fma(-kq, 6.12323399573676603587e-17, r);
        const double r2 = r * r;
        double sn = r * (1.0 + r2 * (-1.0 / 6 + r2 * (1.0 / 120 + r2 * (-1.0 / 5040 + r2 * (1.0 / 362880 + r2 * (-1.0 / 39916800 + r2 * (1.0 / 6227020800.0)))))));
        double cs = 1.0 + r2 * (-0.5 + r2 * (1.0 / 24 + r2 * (-1.0 / 720 + r2 * (1.0 / 40320 + r2 * (-1.0 / 3628800 + r2 * (1.0 / 479001600.0 + r2 * (-1.0 / 87178291200.0)))))));
        const int q = ((int)kq) & 3;
        double s_ = (q == 0) ? sn : (q == 1) ? cs : (q == 2) ? -sn : -cs;
        double c_ = (q == 0) ? cs : (q == 1) ? -sn : (q == 2) ? -cs : sn;
        t1[(size_t)idx * 2] = (float)c_; t1[(size_t)idx * 2 + 1] = (float)s_;
    }
}
__device__ __forceinline__ void p_prologue(Frame& F, const Args& a) {
    LAS float* scr = (LAS float*)(F.lds + RING_OFF + F.wave * 16384);
    const int gw = F.vcu * NWAVES + F.wave, NGW = F.G * NWAVES;
    for (int it = gw; it < IT_SHARED + IT_MOE; it += NGW) { if (it < IT_SHARED) conv_shared_item(F, a, it, scr); else conv_moe_item(F, a, 0, it - IT_SHARED, scr); }
    build_router_frags(F, a, F.vcu * 512 + F.tid, F.G * 512);
    build_sincos(F, F.vcu * 512 + F.tid, F.G * 512);
    for (int m = gw; m < TOK; m += NGW) { if (QKV_FP8) rms_row_to_fp8(F.lane, a.in[0] + (size_t)m * DM, a.in[2], F.ws + WS_HB + (size_t)m * DM); else rms_row_to_bf16(F.lane, a.in[0] + (size_t)m * DM, a.in[2], (bf16*)(F.ws + WS_HB) + (size_t)m * DM); }
}
__device__ __forceinline__ void p_attention(Frame& F, const Args& a) {
    LAS float* lut = (LAS float*)(F.lds + LX_LUT);
    const attn_body::bf16* QKV = (const attn_body::bf16*)(F.ws + WS_QKV0);
    const float* lq = a.in[6];
    const float lam = __expf(wave_sum(lq[F.lane] * lq[64 + F.lane])) - __expf(wave_sum(lq[128 + F.lane] * lq[192 + F.lane])) + 0.2f;
    for (int v = F.vcu; v < 256; v += F.G) {
        const int bh = v >> 2, s = v & 3, b = bh >> 3, h = bh & 7;
        __syncthreads();
        for (int idx = F.tid; idx < 672; idx += 512) { const int n = idx - 288; float val = 0.f;
            if (n < 0) val = -INFINITY;
            else if (n < 113) { int bk = n; if (n >= 16) { bk = 16; const int thr[15] = {19, 21, 24, 27, 31, 35, 40, 46, 52, 59, 67, 77, 87, 99, 113};
#pragma unroll
                for (int q = 0; q < 15; ++q) bk += (n >= thr[q]) ? 1 : 0; }
                val = (a.in[1][bk * 8 + h] - a.in[1][31 * 8 + h]) * LOG2E; }
            lut[idx] = val; }
        __syncthreads();
#pragma nounroll
        for (int i = 0; i < 4; ++i) {
            const int qb = (i < 2) ? 7 - s : s, m = i & 1;
            attn_body::bf16* O = (attn_body::bf16*)(F.ws + WS_OP) + (size_t)m * TOK * 1024 + h * 128;
            attn_body::attn_unit128<8>(b, qb, QKV, h * 128 + m * 64, 1024 + h * 128 + m * 64, 2048 + h * 128, O, lut, (char*)F.lds + RING_OFF);
            if ((i & 1) == 1) {
                VM_WAIT(); __syncthreads();
                int t_ = threadIdx.x; asm volatile("" : "+v"(t_));
                const int row = b * SEQ + qb * 256 + (t_ >> 1), c0 = h * 128 + (t_ & 1) * 64;
                const bf16* O0 = (const bf16*)(F.ws + WS_OP) + (size_t)row * 1024 + c0; const bf16* O1 = O0 + (size_t)TOK * 1024; bf16* AO = (bf16*)(F.ws + WS_AO) + (size_t)row * 1024 + c0;
                const float* sg = a.in[7] + (t_ & 1) * 64;
                float ss = 0.f; v4u wa[8], wb[8];
#pragma unroll
                for (int q = 0; q < 8; ++q) { wa[q] = ((const GAS v4u*)O0)[q]; wb[q] = ((const GAS v4u*)O1)[q]; }
#pragma unroll
                for (int q = 0; q < 8; ++q) { const unsigned xa[4] = {wa[q].x, wa[q].y, wa[q].z, wa[q].w}, xb[4] = {wb[q].x, wb[q].y, wb[q].z, wb[q].w};
#pragma unroll
                    for (int j = 0; j < 4; ++j) { const float o0 = bflo(xa[j]) - lam * bflo(xb[j]), o1 = bfhi(xa[j]) - lam * bfhi(xb[j]); ss += o0 * o0 + o1 * o1; } }
                ss += __shfl_xor(ss, 1);
                const float rstd = 0.8f / sqrtf(ss * (1.f / 128.f) + SUBLN_EPS);
#pragma unroll
                for (int q = 0; q < 8; ++q) { const unsigned xa[4] = {wa[q].x, wa[q].y, wa[q].z, wa[q].w}, xb[4] = {wb[q].x, wb[q].y, wb[q].z, wb[q].w}; unsigned r[4];
                    const f32x4 g0 = *(const GAS f32x4*)(sg + q * 8), g1 = *(const GAS f32x4*)(sg + q * 8 + 4); const float gg[8] = {g0.x, g0.y, g0.z, g0.w, g1.x, g1.y, g1.z, g1.w};
#pragma unroll
                    for (int j = 0; j < 4; ++j) r[j] = pk2((bflo(xa[j]) - lam * bflo(xb[j])) * rstd * gg[2 * j], (bfhi(xa[j]) - lam * bfhi(xb[j])) * rstd * gg[2 * j + 1]);
                    v4u o; o.x = r[0]; o.y = r[1]; o.z = r[2]; o.w = r[3]; ((GAS v4u*)AO)[q] = o; }
            }
        }
    }
}
__device__ __forceinline__ void p_diffcombine(Frame& F, const Args& a) {
    const int gw = F.vcu * NWAVES + F.wave, NGW = F.G * NWAVES, lane = F.lane;
    const float* lq = a.in[6];
    const float lam = __expf(wave_sum(lq[lane] * lq[64 + lane])) - __expf(wave_sum(lq[128 + lane] * lq[192 + lane])) + 0.2f;
    const int d0 = (lane & 7) * 16; float g[16];
#pragma unroll
    for (int j = 0; j < 16; ++j) g[j] = a.in[7][d0 + j] * 0.8f;
    const bf16* O0 = (const bf16*)(F.ws + WS_OP); const bf16* O1 = O0 + (size_t)TOK * 1024; bf16* AO = (bf16*)(F.ws + WS_AO);
    for (int m = gw; m < TOK; m += NGW) {
        const GAS v4u* p0 = (const GAS v4u*)(O0 + (size_t)m * 1024 + lane * 16); const GAS v4u* p1 = (const GAS v4u*)(O1 + (size_t)m * 1024 + lane * 16);
        const v4u a0 = p0[0], a1 = p0[1], b0 = p1[0], b1 = p1[1];
        const unsigned wa[8] = {a0.x, a0.y, a0.z, a0.w, a1.x, a1.y, a1.z, a1.w}, wb[8] = {b0.x, b0.y, b0.z, b0.w, b1.x, b1.y, b1.z, b1.w};
        float o[16]; float ss = 0.f;
#pragma unroll
        for (int j = 0; j < 8; ++j) { o[2 * j] = bflo(wa[j]) - lam * bflo(wb[j]); o[2 * j + 1] = bfhi(wa[j]) - lam * bfhi(wb[j]); ss += o[2 * j] * o[2 * j] + o[2 * j + 1] * o[2 * j + 1]; }
        ss += __shfl_xor(ss, 1); ss += __shfl_xor(ss, 2); ss += __shfl_xor(ss, 4);
        const float rstd = 1.0f / sqrtf(ss * (1.f / 128.f) + SUBLN_EPS);
        v4u w0, w1;
        w0.x = pk2(o[0] * rstd * g[0], o[1] * rstd * g[1]); w0.y = pk2(o[2] * rstd * g[2], o[3] * rstd * g[3]); w0.z = pk2(o[4] * rstd * g[4], o[5] * rstd * g[5]); w0.w = pk2(o[6] * rstd * g[6], o[7] * rstd * g[7]);
        w1.x = pk2(o[8] * rstd * g[8], o[9] * rstd * g[9]); w1.y = pk2(o[10] * rstd * g[10], o[11] * rstd * g[11]); w1.z = pk2(o[12] * rstd * g[12], o[13] * rstd * g[13]); w1.w = pk2(o[14] * rstd * g[14], o[15] * rstd * g[15]);
        GAS v4u* po = (GAS v4u*)(AO + (size_t)m * 1024 + lane * 16); po[0] = w0; po[1] = w1;
    }
}
template <int LAYER> __device__ __forceinline__ void p_router(Frame& F, const Args& a, const float* xres, int bank = LAYER) {
    typedef float f32x4v __attribute__((ext_vector_type(4)));
    LAS float* part = (LAS float*)(F.lds + RING_OFF);
    LAS float* ssqp = (LAS float*)(F.lds + RING_OFF + 98304);
    LAS float* logit = (LAS float*)(F.lds + RING_OFF + 100352);
    LAS float* rstd_s = (LAS float*)(F.lds + RING_OFF + 109568);
    LAS int* lcnt = (LAS int*)(F.lds + RING_OFF + 109824);
    LAS int* lbase = (LAS int*)(F.lds + RING_OFF + 109952);
    const int lane = F.lane, w = F.wave, row = lane & 15, kg = lane >> 4;
    const bf16x8* wrf = (const bf16x8*)(F.ws + WS_WRF) + (size_t)LAYER * (32 * 3 * 2 * 64);
    bf16x8 Bh[4][3], Bl[4][3];
#pragma unroll
    for (int s = 0; s < 4; ++s)
#pragma unroll
        for (int nt = 0; nt < 3; ++nt) { Bh[s][nt] = wrf[(((4 * w + s) * 3 + nt) * 2 + 0) * 64 + lane]; Bl[s][nt] = wrf[(((4 * w + s) * 3 + nt) * 2 + 1) * 64 + lane]; }
    const float* gffn = a.in[3] + LAYER * 1024; const float* bg = a.in[12] + LAYER * 4; const float* be = a.in[14] + LAYER * 32;
    int* list = (int*)(F.ws + WS_LIST); float* pairw = (float*)(F.ws + WS_PAIRW); bf16* HB = (bf16*)(F.ws + WS_HB);
    for (int tb = F.vcu; tb < TOK / 64; tb += F.G) {
        __syncthreads();
        if (F.tid < 32) lcnt[F.tid] = 0;
        f32x4v acc[4][3];
#pragma unroll
        for (int mt = 0; mt < 4; ++mt)
#pragma unroll
            for (int nt = 0; nt < 3; ++nt) acc[mt][nt] = (f32x4v){0.f, 0.f, 0.f, 0.f};
#pragma unroll
        for (int mt = 0; mt < 4; ++mt) { const float* xr = xres + (size_t)(tb * 64 + mt * 16 + row) * DM + 128 * w + 8 * kg; float ss = 0.f;
#pragma unroll
            for (int s = 0; s < 4; ++s) { const f32x4 x0 = *(const GAS f32x4*)(xr + 32 * s), x1 = *(const GAS f32x4*)(xr + 32 * s + 4);
                const float xv[8] = {x0.x, x0.y, x0.z, x0.w, x1.x, x1.y, x1.z, x1.w}; bf16x8 ah, al;
#pragma unroll
                for (int j = 0; j < 8; ++j) { ss += xv[j] * xv[j]; const unsigned hi = f2bf(xv[j]); ah[j] = (short)hi; al[j] = (short)f2bf(xv[j] - __builtin_bit_cast(float, hi << 16)); }
#pragma unroll
                for (int nt = 0; nt < 3; ++nt) { acc[mt][nt] = __builtin_amdgcn_mfma_f32_16x16x32_bf16(ah, Bh[s][nt], acc[mt][nt], 0, 0, 0);
                    acc[mt][nt] = __builtin_amdgcn_mfma_f32_16x16x32_bf16(ah, Bl[s][nt], acc[mt][nt], 0, 0, 0); acc[mt][nt] = __builtin_amdgcn_mfma_f32_16x16x32_bf16(al, Bh[s][nt], acc[mt][nt], 0, 0, 0); } }
            ss += __shfl_xor(ss, 16); ss += __shfl_xor(ss, 32);
            if (kg == 0) ssqp[w * 64 + mt * 16 + row] = ss;
#pragma unroll
            for (int nt = 0; nt < 3; ++nt)
#pragma unroll
                for (int r = 0; r < 4; ++r) part[(w * 64 + mt * 16 + 4 * kg + r) * 48 + nt * 16 + row] = acc[mt][nt][r]; }
        __syncthreads();
        if (F.tid < 64) { float s = 0.f;
#pragma unroll
            for (int q = 0; q < 8; ++q) s += ssqp[q * 64 + F.tid];
            rstd_s[F.tid] = 1.0f / sqrtf(s * (1.f / 1024.f) + RMS_EPS); }
        __syncthreads();
        for (int idx = F.tid; idx < 64 * 36; idx += 512) { const int tk = idx / 36, o = idx % 36; float s = 0.f;
#pragma unroll
            for (int q = 0; q < 8; ++q) s += part[(q * 64 + tk) * 48 + o];
            logit[tk * 36 + o] = s * rstd_s[tk] + (o < 4 ? bg[o] : be[o - 4]); }
        __syncthreads();
        if (w == 0) {
            const LAS float* lg = logit + lane * 36;
            int gi = 0; float gm = lg[0];
#pragma unroll
            for (int j = 1; j < 4; ++j) { const float v = lg[j]; if (v > gm) { gm = v; gi = j; } }
            float gs = 0.f;
#pragma unroll
            for (int j = 0; j < 4; ++j) gs += __expf(lg[j] - gm);
            const float gp = 1.0f / gs;
            const LAS float* le = lg + 4 + gi * 8;
            int i1 = 0; float v1 = le[0];
#pragma unroll
            for (int j = 1; j < 8; ++j) { const float v = le[j]; if (v > v1) { v1 = v; i1 = j; } }
            int i2 = -1; float v2 = -INFINITY;
#pragma unroll
            for (int j = 0; j < 8; ++j) { const float v = le[j]; if (j != i1 && v > v2) { v2 = v; i2 = j; } }
            const float e2 = __expf(v2 - v1), w1 = gp / (1.0f + e2), w2 = gp * e2 / (1.0f + e2);
            const int e_1 = gi * 8 + i1, e_2 = gi * 8 + i2;
            const int r1 = __hip_atomic_fetch_add(lcnt + e_1, 1, __ATOMIC_RELAXED, __HIP_MEMORY_SCOPE_WORKGROUP);
            const int r2 = __hip_atomic_fetch_add(lcnt + e_2, 1, __ATOMIC_RELAXED, __HIP_MEMORY_SCOPE_WORKGROUP);
            LDS_WAIT();
            if (lane < 32) { const int c = lcnt[lane]; int bs = 0; if (c > 0) bs = (int)__hip_atomic_fetch_add((unsigned*)(F.ctl + CW_CNT + (bank * 32 + lane) * 64), (unsigned)c, RLX_AGENT); lbase[lane] = bs; }
            LDS_WAIT();
            const int tg = tb * 64 + lane; const int p1 = lbase[e_1] + r1, p2 = lbase[e_2] + r2;
            list[e_1 * LISTCAP + p1] = 2 * tg; list[e_2 * LISTCAP + p2] = 2 * tg + 1; pairw[2 * tg] = w1; pairw[2 * tg + 1] = w2;
        }
        for (int i = 0; i < 8; ++i) { const int tk = w * 8 + i, tg = tb * 64 + tk; const float rs = rstd_s[tk];
            const GAS f32x4* xr = (const GAS f32x4*)(xres + (size_t)tg * DM) + lane; const GAS f32x4* gr = (const GAS f32x4*)gffn + lane; GAS unsigned* o4 = (GAS unsigned*)((unsigned char*)HB + (size_t)tg * DM) + lane;
#pragma unroll
            for (int j = 0; j < 4; ++j) { const f32x4 v = xr[64 * j], gg = gr[64 * j]; const float rs8 = rs * H8_SCALE; o4[64 * j] = pk4_fp8f(v.x * rs8 * gg.x, v.y * rs8 * gg.y, v.z * rs8 * gg.z, v.w * rs8 * gg.w); } }
    }
}
template <int LAYER> __device__ __forceinline__ void moe_setup(Frame& F) {
    LAS int* tstart = (LAS int*)(F.lds + LX_TSTART); LAS int* texp = (LAS int*)(F.lds + LX_TEXP); LAS int* lc = (LAS int*)(F.lds + LX_CNT);
    __syncthreads();
    if (F.tid < 32) { int c = (int)__hip_atomic_load((unsigned*)(F.ctl + CW_CNT + (LAYER * 32 + F.tid) * 64), RLX_AGENT); c = c < 0 ? 0 : (c > LISTCAP ? LISTCAP : c); lc[F.tid] = c; }
    __syncthreads();
    if (F.tid == 0) { int acc = 0; for (int e = 0; e < 32; ++e) { tstart[e] = acc; acc += (lc[e] + 255) >> 8; } if (acc > MAXRT) acc = MAXRT; tstart[32] = acc; tstart[33] = acc; }
    __syncthreads();
    if (F.tid < MAXRT) { int e = 0;
#pragma unroll 1
        for (int q = 1; q < 32; ++q) if (tstart[q] <= F.tid) e = q;
        texp[F.tid] = e; }
    __syncthreads();
}
template <int LAYER> __device__ __forceinline__ void p_moe1(Frame& F) {
    moe_setup<LAYER>(F);
    const LAS int* tstart = (const LAS int*)(F.lds + LX_TSTART); const LAS int* texp = (const LAS int*)(F.lds + LX_TEXP); const LAS int* lc = (const LAS int*)(F.lds + LX_CNT);
    LAS int* rowtab = (LAS int*)(F.lds + LX_ROWTAB);
    pg8::MoeOrder S{F.G, F.vcu, 512, 0, tstart, texp};
    const int* list = (const int*)(F.ws + WS_LIST);
    pg8::Unit u;
    for (int i = 0; i < 4 && S.next(i, u); ++i) { if (F.tid < 256) { const int e = u.pn >> 2, pos = u.aux * 256 + F.tid; rowtab[i * 256 + F.tid] = (pos < lc[e]) ? (list[e * LISTCAP + pos] >> 1) : 0; } }
    VM_WAIT(); __syncthreads();
    pg8::Gemm g{(const bf16*)(F.ws + WS_HB), (const bf16*)(F.ws + WS_W1CAT), 512, 512, 512};
    pg8::EpiMoe1 E{(unsigned char*)(F.ws + WS_MACT)};
    pg8::gemm_phase<pg8::EpiMoe1, pg8::MoeOrder, true, true, true>(F.lds + RING_OFF, g, S, E, rowtab);
}
template <int LAYER> __device__ __forceinline__ void p_moe2(Frame& F) {
    moe_setup<LAYER>(F);
    const LAS int* tstart = (const LAS int*)(F.lds + LX_TSTART); const LAS int* texp = (const LAS int*)(F.lds + LX_TEXP); const LAS int* lc = (const LAS int*)(F.lds + LX_CNT);
    pg8::MoeOrder S{F.G, F.vcu, 256, 256 * 256, tstart, texp};
    pg8::Gemm g{(const bf16*)(F.ws + WS_MACT), (const bf16*)(F.ws + WS_W2T), 256, 256, 256};
    pg8::EpiMoe2 E{(bf16*)(F.ws + WS_Y), (const int*)(F.ws + WS_LIST), (const float*)(F.ws + WS_PAIRW), lc};
    pg8::gemm_phase<pg8::EpiMoe2, pg8::MoeOrder, true, false, true>(F.lds + RING_OFF, g, S, E, nullptr);
}
template <bool FINAL> __device__ __forceinline__ void p_combine(Frame& F, float* xres, const float* g, float* dry = nullptr) {
    const int gw = F.vcu * NWAVES + F.wave, NGW = F.G * NWAVES, lane = F.lane;
    const bf16* Y = (const bf16*)(F.ws + WS_Y); bf16* HB = (bf16*)(F.ws + WS_HB);
    f32x4 gg[4];
#pragma unroll
    for (int j = 0; j < 4; ++j) gg[j] = ((const GAS f32x4*)g + lane)[64 * j];
    f32x4 cx[4], nx[4]; v2u cp[4], cq[4], np[4], nq[4];
#define CMB_LOAD(X, P, Q, m_) do { const GAS f32x4* xr_ = (const GAS f32x4*)(xres + (size_t)(m_) * DM) + lane; const GAS v2u* y0_ = (const GAS v2u*)(Y + (size_t)(2 * (m_)) * DM) + lane; const GAS v2u* y1_ = (const GAS v2u*)(Y + (size_t)(2 * (m_) + 1) * DM) + lane; \
        _Pragma("unroll") for (int j = 0; j < 4; ++j) { X[j] = xr_[64 * j]; P[j] = y0_[64 * j]; Q[j] = y1_[64 * j]; } } while (0)
    int m = gw;
    if (m < TOK) CMB_LOAD(cx, cp, cq, m);
    for (; m < TOK; m += NGW) {
        const int mn = m + NGW;
        if (mn < TOK) CMB_LOAD(nx, np, nq, mn);
        GAS f32x4* xw = (GAS f32x4*)((dry ? dry : xres) + (size_t)m * DM) + lane;
        f32x4 v[4]; float s = 0.f;
#pragma unroll
        for (int j = 0; j < 4; ++j) { const f32x4 x = cx[j]; const v2u p = cp[j], q = cq[j];
            v[j].x = x.x + bflo(p.x) + bflo(q.x); v[j].y = x.y + bfhi(p.x) + bfhi(q.x); v[j].z = x.z + bflo(p.y) + bflo(q.y); v[j].w = x.w + bfhi(p.y) + bfhi(q.y);
            s += (v[j].x * v[j].x + v[j].y * v[j].y) + (v[j].z * v[j].z + v[j].w * v[j].w); }
        const float rstd = 1.0f / sqrtf(wave_sum(s) * (1.f / 1024.f) + RMS_EPS);
        if (FINAL) {
#pragma unroll
            for (int j = 0; j < 4; ++j) { f32x4 o; o.x = v[j].x * rstd * gg[j].x; o.y = v[j].y * rstd * gg[j].y; o.z = v[j].z * rstd * gg[j].z; o.w = v[j].w * rstd * gg[j].w; xw[64 * j] = o; }
        } else {
            GAS unsigned* o4 = (GAS unsigned*)((dry ? (unsigned char*)(dry + (size_t)TOK * DM) : (unsigned char*)HB) + (size_t)m * DM) + lane; const float r8 = rstd * H8_SCALE;
#pragma unroll
            for (int j = 0; j < 4; ++j) { xw[64 * j] = v[j]; o4[64 * j] = pk4_fp8f(v[j].x * r8 * gg[j].x, v[j].y * r8 * gg[j].y, v[j].z * r8 * gg[j].z, v[j].w * r8 * gg[j].w); }
        }
#pragma unroll
        for (int j = 0; j < 4; ++j) { cx[j] = nx[j]; cp[j] = np[j]; cq[j] = nq[j]; }
    }
#undef CMB_LOAD
}
__device__ __forceinline__ void p_scan(Frame& F) {
    const bf16* DS = (const bf16*)(F.ws + WS_DS); bf16* BT = (bf16*)(F.ws + WS_BTCAT);
    for (int gidx = F.vcu * 512 + F.tid; gidx < NB * RH * 16384; gidx += F.G * 512) {
        const int bh = gidx >> 14, e8 = gidx & 16383, dv = e8 >> 5, dk0 = (e8 & 31) * 8, h = bh & 3;
        const float cd = __builtin_amdgcn_exp2f(256.0f * pg8::log2_gamma(h));
        v4u d[7];
#pragma unroll
        for (int n = 0; n < 7; ++n) d[n] = *(const GAS v4u*)(DS + ((size_t)(bh * RNC + n) * RDV + dv) * RDK + dk0);
        float s[8];
#pragma unroll
        for (int j = 0; j < 8; ++j) s[j] = 0.f;
#pragma unroll
        for (int n = 0; n < 8; ++n) {
            v4u o; o.x = pk2(s[0], s[1]); o.y = pk2(s[2], s[3]); o.z = pk2(s[4], s[5]); o.w = pk2(s[6], s[7]);
            *(GAS v4u*)(BT + ((size_t)(bh * RNC + n) * RDV + dv) * 512 + 256 + dk0) = o;
            if (n < 7) { const unsigned wv[4] = {d[n].x, d[n].y, d[n].z, d[n].w};
#pragma unroll
                for (int j = 0; j < 4; ++j) { s[2 * j] = cd * (s[2 * j] + bflo(wv[j])); s[2 * j + 1] = cd * (s[2 * j + 1] + bfhi(wv[j])); } }
        }
    }
}
__device__ __forceinline__ void p_normgate(Frame& F, bf16* dry = nullptr) {
    const int gw = F.vcu * NWAVES + F.wave, NGW = F.G * NWAVES, lane = F.lane;
    const bf16* OR = (const bf16*)(F.ws + WS_ORET); bf16* SG = (bf16*)(F.ws + WS_SG);
    for (int m = gw; m < TOK; m += NGW) {
        const GAS v4u* po = (const GAS v4u*)(OR + (size_t)m * 2048 + lane * 32); GAS v4u* pg = (GAS v4u*)(SG + (size_t)m * 2048 + lane * 32); GAS v4u* pw = dry ? (GAS v4u*)(dry + (size_t)m * 2048 + lane * 32) : pg;
        v4u ov[4], gv[4]; float ss = 0.f;
#pragma unroll
        for (int q = 0; q < 4; ++q) { ov[q] = po[q]; gv[q] = pg[q]; }
#pragma unroll
        for (int q = 0; q < 4; ++q) { const unsigned wv[4] = {ov[q].x, ov[q].y, ov[q].z, ov[q].w};
#pragma unroll
            for (int j = 0; j < 4; ++j) { const float x0 = bflo(wv[j]), x1 = bfhi(wv[j]); ss += x0 * x0 + x1 * x1; } }
        ss += __shfl_xor(ss, 1); ss += __shfl_xor(ss, 2); ss += __shfl_xor(ss, 4); ss += __shfl_xor(ss, 8);
        const float rstd = 1.0f / sqrtf(ss * (1.f / 512.f) + RMS_EPS);
#pragma unroll
        for (int q = 0; q < 4; ++q) { const unsigned wv[4] = {ov[q].x, ov[q].y, ov[q].z, ov[q].w}, wg[4] = {gv[q].x, gv[q].y, gv[q].z, gv[q].w}; unsigned r[4];
#pragma unroll
            for (int j = 0; j < 4; ++j) r[j] = pk2(bflo(wv[j]) * rstd * bflo(wg[j]), bfhi(wv[j]) * rstd * bfhi(wg[j]));
            v4u o; o.x = r[0]; o.y = r[1]; o.z = r[2]; o.w = r[3]; pw[q] = o; }
    }
}
__device__ __forceinline__ void p_conv_moe1(Frame& F, const Args& a) {
    LAS float* scr = (LAS float*)(F.lds + RING_OFF + F.wave * 16384);
    const int gw = F.vcu * NWAVES + F.wave, NGW = F.G * NWAVES;
    for (int it = gw; it < IT_MOE; it += NGW) conv_moe_item(F, a, 1, it, scr);
}

constexpr int N_PHASES = 19;
#ifndef MK_PER_PHASE
#define MK_PER_PHASE 0
#endif
__global__ void __launch_bounds__(NWAVES * 64, 2) hybrid_fwd(Args args) {
    extern __shared__ __attribute__((aligned(16))) unsigned char lds[];
    Frame F;
    F.lds = (LAS unsigned char*)lds;
    F.tid = threadIdx.x; F.lane = F.tid & 63; F.wave = __builtin_amdgcn_readfirstlane(F.tid >> 6);
    F.G = gridDim.x; { const int bx = blockIdx.x; F.vcu = (F.G % 8 == 0) ? (bx % 8) * (F.G / 8) + bx / 8 : bx; }
    F.ws = args.ws; F.ctl = (gu32*)(args.ws + WS_CTL);
    for (int u = F.tid; u < (LDS_BYTES - LX_OFF) / 4; u += NWAVES * 64) ((LAS unsigned*)(F.lds + LX_OFF))[u] = 0u;
    __syncthreads();
    XcdBarrier bar; bar.bar = (unsigned*)(F.ctl + CW_BAR); bar.x = 0; bar.st = nullptr;
    if (!MK_PER_PHASE) bar = xcd_barrier_post((unsigned*)(F.ctl + CW_BAR), (volatile LAS unsigned*)(F.lds + LX_MISC) + 8);
    const int lo = args.ph_lo, hi = args.ph_hi;
#ifndef PH_MASK
#define PH_MASK 0x7ffff
#endif
#define IN(k) (((PH_MASK >> (k)) & 1) && lo <= (k) && (k) < hi)
#define SEAM(k) do { if (IN(k) && IN((k) + 1)) xcd_barrier(bar); } while (0)
#define REFRESH() do { int t_ = threadIdx.x; asm volatile("" : "+v"(t_)); F.tid = t_; F.lane = t_ & 63; } while (0)
#ifndef DUP_MASK
#define DUP_MASK 0
#endif
#ifndef XBAR_N
#define XBAR_N 0
#endif
#define DUP(k) (((DUP_MASK >> (k)) & 1) != 0)
    float* xres = args.out;
    unsigned char* ws = args.ws;
    const int bx = (int)blockIdx.x;

    if (IN(0)) { REFRESH(); p_prologue(F, args); if (DUP(0)) { xcd_barrier(bar); p_prologue(F, args); } for (int q = 0; q < XBAR_N; ++q) xcd_barrier(bar); } SEAM(0);
    if (IN(1)) { REFRESH(); for (int rep_ = 0; rep_ < (DUP(1) ? 2 : 1); ++rep_) { if (rep_) xcd_barrier(bar);
        constexpr int KQ = QKV_FP8 ? 512 : 1024; pg8::Gemm g{(const bf16*)(ws + WS_HB), (const bf16*)(ws + WS_WINT0), KQ, KQ, KQ}; pg8::StaticOrder S; S.init(TOK, 3072, F.G, bx, KQ, KQ);
        pg8::EpiQKV E{(bf16*)(ws + WS_QKV0), ATT_C2};
        pg8::gemm_phase<pg8::EpiQKV, pg8::StaticOrder, true, false, (QKV_FP8 != 0)>(F.lds + RING_OFF, g, S, E, nullptr);
    }
    } SEAM(1);
    if (IN(2)) { REFRESH(); p_attention(F, args); if (DUP(2)) { xcd_barrier(bar); p_attention(F, args); } } if (IN(2) && IN(4)) xcd_barrier(bar);
    if (IN(4)) { REFRESH(); for (int rep_ = 0; rep_ < (DUP(4) ? 2 : 1); ++rep_) { if (rep_) xcd_barrier(bar);
        pg8::Gemm g{(const bf16*)(ws + WS_AO), (const bf16*)(ws + WS_WOUTT0), 1024, 1024, 1024}; pg8::StaticOrder S; S.init(TOK, 1024, F.G, bx, 1024, 1024);
        pg8::EpiRes E{args.in[0], xres};
        pg8::gemm_phase<pg8::EpiRes, pg8::StaticOrder, true, false>(F.lds + RING_OFF, g, S, E, nullptr);
    }
    } SEAM(4);
    if (IN(5)) { REFRESH(); p_router<0>(F, args, xres); if (DUP(5)) { xcd_barrier(bar); p_router<0>(F, args, xres, 2); } } SEAM(5);
    if (IN(6)) { REFRESH(); p_moe1<0>(F); if (DUP(6)) { xcd_barrier(bar); p_moe1<0>(F); } } SEAM(6);
    if (IN(7)) { REFRESH(); p_moe2<0>(F); if (DUP(7)) { xcd_barrier(bar); p_moe2<0>(F); } } SEAM(7);
    if (IN(8)) { REFRESH(); if (DUP(8)) { p_combine<false>(F, xres, args.in[2] + 1024, (float*)(ws + WS_KI)); xcd_barrier(bar); } p_combine<false>(F, xres, args.in[2] + 1024); } SEAM(8);
    if (IN(9)) { REFRESH(); for (int rep_ = 0; rep_ < (DUP(9) ? 2 : 1); ++rep_) { if (rep_) xcd_barrier(bar);
        { pg8::Gemm g{(const bf16*)(ws + WS_HB), (const bf16*)(ws + WS_WRINA), 512, 512, 512}; pg8::StaticOrder S; S.init(TOK, 4096, F.G, bx, 512, 512);
          pg8::EpiRetA E{(bf16*)(ws + WS_ACAT), (bf16*)(ws + WS_KI), (bf16*)(ws + WS_SG), (const float*)(ws + WS_SINCOS), (bf16*)(ws + WS_KIT)};
          pg8::gemm_phase<pg8::EpiRetA, pg8::StaticOrder, true, false, true>(F.lds + RING_OFF, g, S, E, nullptr); }
        { pg8::Gemm g{(const bf16*)(ws + WS_WRINB), (const bf16*)(ws + WS_HB), 512, 512, 512}; pg8::StaticOrder S; S.init(2048, TOK, F.G, bx, 512, 512);
          pg8::EpiRetB E{(bf16*)(ws + WS_BTCAT)};
          pg8::gemm_phase<pg8::EpiRetB, pg8::StaticOrder, true, false, true>(F.lds + RING_OFF, g, S, E, nullptr); }
    }
    } SEAM(9);
    if (IN(10)) { REFRESH(); for (int rep_ = 0; rep_ < (DUP(10) ? 2 : 1); ++rep_) { if (rep_) xcd_barrier(bar);
        { pg8::Gemm g{(const bf16*)(ws + WS_ACAT), (const bf16*)(ws + WS_KI), 512, 1024, 256}; pg8::ScoresOrder S{F.G, F.vcu};
          pg8::EpiScores E{(bf16*)(ws + WS_ACAT)};
          pg8::gemm_phase<pg8::EpiScores, pg8::ScoresOrder, true, false>(F.lds + RING_OFF, g, S, E, nullptr); }
        { pg8::Gemm g{(const bf16*)(ws + WS_BTCAT), (const bf16*)(ws + WS_KIT), 512, 2048, 256}; pg8::DsOrder S{F.G, F.vcu};
          pg8::EpiDS E{(bf16*)(ws + WS_DS)};
          pg8::gemm_phase<pg8::EpiDS, pg8::DsOrder, true, false>(F.lds + RING_OFF, g, S, E, nullptr); }
    }
    } SEAM(10);
    if (IN(11)) { REFRESH(); p_scan(F); if (DUP(11)) { xcd_barrier(bar); p_scan(F); } } SEAM(11);
    if (IN(12)) { REFRESH(); for (int rep_ = 0; rep_ < (DUP(12) ? 2 : 1); ++rep_) { if (rep_) xcd_barrier(bar);
        pg8::Gemm g{(const bf16*)(ws + WS_ACAT), (const bf16*)(ws + WS_BTCAT), 512, 512, 512}; pg8::RetOOrder S{F.G, F.vcu};
        pg8::EpiRetO E{(bf16*)(ws + WS_ORET), (bf16*)(ws + WS_SG), (LAS float*)(F.lds + LX_SSQ)};
        pg8::gemm_phase<pg8::EpiRetO, pg8::RetOOrder, true, false>(F.lds + RING_OFF, g, S, E, nullptr);
    }
    } if (IN(12) && IN(14)) xcd_barrier(bar);
    if (IN(14)) { REFRESH(); for (int rep_ = (DUP(14) ? 0 : 1); rep_ < 2; ++rep_) { if (rep_ && DUP(14)) xcd_barrier(bar);
        pg8::Gemm g{(const bf16*)(ws + WS_SG), (const bf16*)(ws + WS_WROUTT), 2048, 2048, 2048}; pg8::StaticOrder S; S.init(TOK, 1024, F.G, bx, 2048, 2048);
        pg8::EpiRes E{xres, rep_ ? xres : (float*)(ws + WS_ACAT)};
        pg8::gemm_phase<pg8::EpiRes, pg8::StaticOrder, true, false>(F.lds + RING_OFF, g, S, E, nullptr);
    }
    } SEAM(14);
    if (IN(15)) { REFRESH(); p_router<1>(F, args, xres); __syncthreads(); p_conv_moe1(F, args); if (DUP(15)) { xcd_barrier(bar); p_router<1>(F, args, xres, 3); __syncthreads(); p_conv_moe1(F, args); } } SEAM(15);
    if (IN(16)) { REFRESH(); p_moe1<1>(F); } SEAM(16);
    if (IN(17)) { REFRESH(); p_moe2<1>(F); } SEAM(17);
    if (IN(18)) { REFRESH(); if (DUP(18)) { p_combine<true>(F, xres, args.in[4], (float*)(ws + WS_KI)); xcd_barrier(bar); } p_combine<true>(F, xres, args.in[4]); }
#undef IN
#undef SEAM
}

extern "C" void kernel_launch(void* const* d_in, const int* in_sizes, int n_in, void* d_out, int out_size, void* d_ws, size_t ws_size, hipStream_t stream) {
    static int grid = 0;
    if (grid == 0) {
        if (n_in != 18 || in_sizes[0] != TOK * DM || out_size != TOK * DM || ws_size < WS_END) { fprintf(stderr, "kernel_launch: unexpected shapes / workspace (n_in %d, in0 %d, out %d, ws %zu < %zu); nothing launched\n", n_in, n_in > 0 ? in_sizes[0] : -1, out_size, ws_size, (size_t)WS_END); grid = -1; return; }
        int dev = 0, cus = 0, per_cu = 0;
        if (hipGetDevice(&dev) != hipSuccess || hipDeviceGetAttribute(&cus, hipDeviceAttributeMultiprocessorCount, dev) != hipSuccess) { grid = -1; return; }
        if (hipFuncSetAttribute((const void*)hybrid_fwd, hipFuncAttributeMaxDynamicSharedMemorySize, LDS_BYTES) != hipSuccess) { fprintf(stderr, "kernel_launch: hipFuncSetAttribute failed\n"); grid = -1; return; }
        if (hipOccupancyMaxActiveBlocksPerMultiprocessor(&per_cu, (const void*)hybrid_fwd, NWAVES * 64, LDS_BYTES) != hipSuccess || per_cu < 1) { fprintf(stderr, "kernel_launch: occupancy query says %d\n", per_cu); }
        (void)hipGetLastError();
        grid = cus > 256 ? 256 : cus;
    }
    if (grid < 0) return;
    if (hipMemsetAsync((char*)d_ws + WS_CTL, 0, CTL_ZERO_BYTES, stream) != hipSuccess) return;
    Args a{};
    for (int i = 0; i < 18; ++i) a.in[i] = (const float*)d_in[i];
    a.out = (float*)d_out; a.ws = (unsigned char*)d_ws; a.pad = 0;
#if MK_PER_PHASE
    for (int p = 0; p < N_PHASES; ++p) { a.ph_lo = p; a.ph_hi = p + 1; a.li = p; hipLaunchKernelGGL(hybrid_fwd, dim3(grid), dim3(NWAVES * 64), LDS_BYTES, stream, a); }
#else
    a.ph_lo = 0; a.ph_hi = N_PHASES; a.li = 0;
    hipLaunchKernelGGL(hybrid_fwd, dim3(grid), dim3(NWAVES * 64), LDS_BYTES, stream, a);
#endif
}
```

```cpp
#include <hip/hip_runtime.h>
#include <hip/hip_bf16.h>
#include <cstdio>
#include <cstdint>

#define LAS __attribute__((address_space(3)))
#define GAS __attribute__((address_space(1)))

namespace pg8 {
typedef unsigned short bf16_t;
typedef short bf16x8 __attribute__((ext_vector_type(8)));
typedef float f32x4 __attribute__((ext_vector_type(4)));
typedef float f32x2 __attribute__((ext_vector_type(2)));
typedef unsigned u32x4 __attribute__((ext_vector_type(4)));
typedef unsigned u32x2 __attribute__((ext_vector_type(2)));
constexpr int BM = 256, BK = 64, HALF = 128, HTB = HALF * BK * 2, STAGE_BYTES = 8 * HTB, NXCD = 8, WGM = 8;

__host__ __device__ __forceinline__ int lds_byte(int r, int c) { const int st = (r >> 4) * 2 + (c >> 5), rr = r & 15, cc = c & 31, ob = rr * 64 + cc * 2; return st * 1024 + (ob ^ (((ob >> 9) & 1) << 5)); }
__host__ __device__ __forceinline__ void stage_rc(int b, int& R, int& C) { const int st = b / 1024, sb = b % 1024, swz = sb ^ (((sb >> 9) & 1) << 5); R = (st >> 1) * 16 + swz / 64; C = (st & 1) * 32 + (swz % 64) / 2; }
__host__ __device__ __forceinline__ int perm32(int rho) { const int n = rho >> 4, i = rho & 15; return 8 * (i >> 2) + 4 * n + (i & 3); }

struct Unit { int pm, pn, aux; long aoff, boff; };
struct Gemm { const bf16_t* A; const bf16_t* Bt; int lda, ldb, K; };

struct StaticOrder {
    int nM, nN, nwg, G, c, lda, ldb;
    __device__ void init(int M, int N, int G_, int c_, int lda_, int ldb_) { nM = M / BM; nN = N / BM; nwg = nM * nN; G = G_; c = c_; lda = lda_; ldb = ldb_; }
    __device__ bool next(int i, Unit& u) const {
        const long L = (long)i * G + c; if (L >= nwg) return false;
        int wgid = (int)L; { const int q = nwg / NXCD, r = nwg % NXCD, xcd = wgid % NXCD, off = wgid / NXCD; wgid = (xcd < r ? xcd * (q + 1) : r * (q + 1) + (xcd - r) * q) + off; }
        const int nig = WGM * nN, gid = wgid / nig, fm = gid * WGM, gsz = (nM - fm) < WGM ? (nM - fm) : WGM;
        u.pm = fm + ((wgid % nig) % gsz); u.pn = (wgid % nig) / gsz; u.aux = 0;
        u.aoff = (long)u.pm * BM * lda; u.boff = (long)u.pn * BM * ldb; return true;
    }
};

__device__ __forceinline__ unsigned cvt_pk_bf16(float lo, float hi) { unsigned r; asm volatile("v_cvt_pk_bf16_f32 %0, %1, %2" : "=v"(r) : "v"(lo), "v"(hi)); return r; }
__device__ __forceinline__ u32x4 pack8(const f32x4 v0, const f32x4 v1) { u32x4 w; w.x = cvt_pk_bf16(v0[0], v0[1]); w.y = cvt_pk_bf16(v0[2], v0[3]); w.z = cvt_pk_bf16(v1[0], v1[1]); w.w = cvt_pk_bf16(v1[2], v1[3]); return w; }

typedef int v4i_t __attribute__((ext_vector_type(4)));
typedef int v8i_t __attribute__((ext_vector_type(8)));
__device__ __forceinline__ v8i_t cat8(const bf16x8 a, const bf16x8 b) { const v4i_t x = __builtin_bit_cast(v4i_t, a), y = __builtin_bit_cast(v4i_t, b); return __builtin_shufflevector(x, y, 0, 1, 2, 3, 4, 5, 6, 7); }
template <class Epi, class Sched, bool ALIGN_EPI, bool GATHER, bool FP8 = false>
__device__ __forceinline__ void gemm_phase(LAS unsigned char* lds, const Gemm g, const Sched& S, const Epi& E, const LAS int* rowtab) {
    int tid_ = threadIdx.x; asm volatile("" : "+v"(tid_));
    const int tid = tid_, wid = __builtin_amdgcn_readfirstlane(tid >> 6), lane = tid & 63, wr = wid >> 2, wc = wid & 3, fr = lane & 15, fq = lane >> 4;
    const int K = g.K, nt = K / BK;
    int sR[2], sC[2]; unsigned voffB[2];
#pragma unroll
    for (int i = 0; i < 2; ++i) { int R, C; stage_rc(tid * 16 + i * 8192, R, C); sR[i] = R; sC[i] = C; const int Rb = Epi::PERM ? ((R & ~31) + perm32(R & 31)) : R; voffB[i] = (unsigned)(Rb * g.ldb + C) * 2u; }
    unsigned avo[2][2], navo[2][2];
#define PG8_SETOFF(o, ui_) do { _Pragma("unroll") for (int h_ = 0; h_ < 2; ++h_) _Pragma("unroll") for (int i_ = 0; i_ < 2; ++i_) { const int row_ = h_ * HALF + sR[i_]; \
        const int grow_ = GATHER ? rowtab[(ui_) * BM + row_] : row_; o[h_][i_] = (unsigned)(grow_ * g.lda + sC[i_]) * 2u; } } while (0)
    const size_t kstep = (size_t)(BK * 2);
    const size_t hstepB = (size_t)HALF * g.ldb * 2;
    const unsigned ldsw = (unsigned)wid * 1024u;
    const int aoff = lds_byte(wr * 64 + fr, fq * 8), boff = lds_byte(wc * 32 + fr, fq * 8);
#define PG8_SA(b, h) (((b) * 2 + (h)) * HTB)
#define PG8_SB(b, h) ((4 + (b) * 2 + (h)) * HTB)
#define PG8_STAGE(bufoff, gbase, voff) do { _Pragma("unroll") for (int _i = 0; _i < 2; ++_i) \
        __builtin_amdgcn_global_load_lds((const unsigned*)((const char*)(gbase) + (voff)[_i]), (LAS unsigned*)(lds + (bufoff) + ldsw + _i * 8192), 16, 0, 0); } while (0)
#define PG8_LD8(dst8, addr_) do { const v4i_t lo_ = *(const LAS v4i_t*)(addr_), hi_ = *(const LAS v4i_t*)((addr_) + 1024); dst8 = __builtin_shufflevector(lo_, hi_, 0, 1, 2, 3, 4, 5, 6, 7); } while (0)
#define PG8_LDA(dst, b, h) do { _Pragma("unroll") for (int m = 0; m < 4; ++m) { if constexpr (FP8) { PG8_LD8(dst##8[m], lds + PG8_SA(b, h) + aoff + m * 2048); } else { _Pragma("unroll") for (int k = 0; k < 2; ++k) dst[m][k] = *(const LAS bf16x8*)(lds + PG8_SA(b, h) + aoff + m * 2048 + k * 1024); } } } while (0)
#define PG8_LDB(dst, b, h) do { _Pragma("unroll") for (int n = 0; n < 2; ++n) { if constexpr (FP8) { PG8_LD8(dst##8[n], lds + PG8_SB(b, h) + boff + n * 2048); } else { _Pragma("unroll") for (int k = 0; k < 2; ++k) dst[n][k] = *(const LAS bf16x8*)(lds + PG8_SB(b, h) + boff + n * 2048 + k * 1024); } } } while (0)
#define PG8_MMA(ai, bj, At, Bt) do { __builtin_amdgcn_s_setprio(1); _Pragma("unroll") for (int m = 0; m < 4; ++m) _Pragma("unroll") for (int n = 0; n < 2; ++n) { \
        if constexpr (FP8) asm volatile("v_mfma_scale_f32_16x16x128_f8f6f4 %0, %1, %2, %0, %3, %3 op_sel_hi:[0,0,0]" : "+v"(acc[ai][bj][m][n]) : "v"(Bt##8[n]), "v"(At##8[m]), "v"(sc1)); \
        else { _Pragma("unroll") for (int k = 0; k < 2; ++k) acc[ai][bj][m][n] = __builtin_amdgcn_mfma_f32_16x16x32_bf16(Bt[n][k], At[m][k], acc[ai][bj][m][n], 0, 0, 0); } } \
        __builtin_amdgcn_s_setprio(0); } while (0)
#define PG8_WAIT_V(n) asm volatile("s_waitcnt vmcnt(" #n ")" ::: "memory")
#define PG8_WAIT_L(n) asm volatile("s_waitcnt lgkmcnt(" #n ")" ::: "memory")
#define PG8_BAR __builtin_amdgcn_s_barrier()
#define PG8_SCHED __builtin_amdgcn_sched_barrier(0)
    unsigned sc1 = 0; if constexpr (FP8) asm volatile("v_mov_b32 %0, 0x7f7f7f7f\n\ts_nop 4" : "=v"(sc1));
    Unit cur, nxt; int ui = 0;
    if (!S.next(0, cur)) return;
    f32x4 acc[2][2][4][2];
#pragma unroll
    for (int a = 0; a < 2; ++a)
#pragma unroll
        for (int b = 0; b < 2; ++b)
#pragma unroll
            for (int m = 0; m < 4; ++m)
#pragma unroll
                for (int n = 0; n < 2; ++n) acc[a][b][m][n] = (f32x4){0.f, 0.f, 0.f, 0.f};
    bf16x8 At[4][2], B0[2][2], B1[2][2]; v8i_t At8[4], B08[2], B18[2];
    const char* cA = (const char*)g.A + cur.aoff * 2; const char* cB = (const char*)g.Bt + cur.boff * 2;
    PG8_SETOFF(avo, 0);
    PG8_STAGE(PG8_SB(0, 0), cB, voffB); PG8_STAGE(PG8_SB(0, 1), cB + hstepB, voffB); PG8_STAGE(PG8_SA(0, 0), cA, avo[0]); PG8_STAGE(PG8_SA(0, 1), cA, avo[1]);
    if (wr == 1) PG8_BAR;
    PG8_WAIT_V(2); PG8_BAR;
    PG8_STAGE(PG8_SB(1, 0), cB + kstep, voffB); PG8_STAGE(PG8_SA(1, 0), cA + kstep, avo[0]); PG8_STAGE(PG8_SB(1, 1), cB + hstepB + kstep, voffB);
    PG8_WAIT_V(6); PG8_BAR;
    for (;;) {
        const bool has_next = S.next(ui + 1, nxt);
        const char* nA = has_next ? (const char*)g.A + nxt.aoff * 2 : cA; const char* nB = has_next ? (const char*)g.Bt + nxt.boff * 2 : cB;
        if (GATHER && has_next) { PG8_SETOFF(navo, ui + 1); }
        else {
#pragma unroll
            for (int h_ = 0; h_ < 2; ++h_)
#pragma unroll
                for (int i_ = 0; i_ < 2; ++i_) navo[h_][i_] = avo[h_][i_]; }
#pragma nounroll
        for (int t = 0; t < nt; t += 2) {
            const bool last = (t == nt - 2);
            const char* a1 = cA + (size_t)(t + 1) * kstep;
            const char* a2 = last ? nA : cA + (size_t)(t + 2) * kstep; const char* b2 = last ? nB : cB + (size_t)(t + 2) * kstep;
            const char* a3 = a2 + kstep; const char* b3 = b2 + kstep;
            unsigned o2[2][2];
#pragma unroll
            for (int h_ = 0; h_ < 2; ++h_)
#pragma unroll
                for (int i_ = 0; i_ < 2; ++i_) o2[h_][i_] = (GATHER && last) ? navo[h_][i_] : avo[h_][i_];
            PG8_LDB(B0, 0, 0); PG8_LDB(B1, 0, 1); PG8_SCHED; PG8_LDA(At, 0, 0); PG8_STAGE(PG8_SA(1, 1), a1, avo[1]);
            PG8_WAIT_V(8); PG8_WAIT_L(0); PG8_BAR; PG8_MMA(0, 0, At, B0); PG8_MMA(0, 1, At, B1); PG8_BAR; PG8_SCHED;
            PG8_LDA(At, 0, 1); PG8_STAGE(PG8_SB(0, 0), b2, voffB); PG8_STAGE(PG8_SB(0, 1), b2 + hstepB, voffB); PG8_STAGE(PG8_SA(0, 0), a2, o2[0]);
            PG8_WAIT_V(8); PG8_WAIT_L(0); PG8_BAR; PG8_MMA(1, 0, At, B0); PG8_MMA(1, 1, At, B1); PG8_BAR; PG8_SCHED;
            PG8_LDB(B0, 1, 0); PG8_LDB(B1, 1, 1); PG8_SCHED; PG8_LDA(At, 1, 0); PG8_STAGE(PG8_SA(0, 1), a2, o2[1]);
            PG8_WAIT_V(8); PG8_WAIT_L(0); PG8_BAR; PG8_MMA(0, 0, At, B0); PG8_MMA(0, 1, At, B1); PG8_BAR; PG8_SCHED;
            PG8_LDA(At, 1, 1); PG8_STAGE(PG8_SB(1, 0), b3, voffB); PG8_STAGE(PG8_SB(1, 1), b3 + hstepB, voffB); PG8_STAGE(PG8_SA(1, 0), a3, o2[0]);
            PG8_WAIT_V(8); PG8_WAIT_L(0); PG8_BAR; PG8_MMA(1, 0, At, B0); PG8_MMA(1, 1, At, B1); PG8_BAR; PG8_SCHED;
        }
        if constexpr (ALIGN_EPI) { if (wr == 0) PG8_BAR; }
        if constexpr (FP8) asm volatile("s_nop 15\n\ts_nop 3" ::: "memory");
        { int efr = fr, efq = fq; asm volatile("" : "+v"(efr), "+v"(efq)); E(acc, cur, wr, wc, efr, efq); }
        if (!has_next) break;
#pragma unroll
        for (int a = 0; a < 2; ++a)
#pragma unroll
            for (int b = 0; b < 2; ++b)
#pragma unroll
                for (int m = 0; m < 4; ++m)
#pragma unroll
                    for (int n = 0; n < 2; ++n) acc[a][b][m][n] = (f32x4){0.f, 0.f, 0.f, 0.f};
        cur = nxt; cA = nA; cB = nB; ++ui;
#pragma unroll
        for (int h_ = 0; h_ < 2; ++h_)
#pragma unroll
            for (int i_ = 0; i_ < 2; ++i_) avo[h_][i_] = navo[h_][i_];
        if constexpr (ALIGN_EPI) { if (wr == 1) PG8_BAR; }
    }
    PG8_WAIT_V(0);
    if constexpr (!ALIGN_EPI) { if (wr == 0) PG8_BAR; }
    PG8_BAR;
#undef PG8_SETOFF
#undef PG8_SA
#undef PG8_SB
#undef PG8_STAGE
#undef PG8_LDA
#undef PG8_LDB
#undef PG8_MMA
#undef PG8_WAIT_V
#undef PG8_WAIT_L
#undef PG8_BAR
#undef PG8_SCHED
}
}
constexpr int NB = 8, SEQ = 2048, DM = 1024, TOK = NB * SEQ;
constexpr int AH = 8;
constexpr int RH = 4, RDK = 256, RDV = 512, RC = 256, RNC = SEQ / RC;
constexpr int NEXP = 32, EFF = 512, NPAIR = 2 * TOK, LISTCAP = TOK;
constexpr int MAXRT = NPAIR / 256 + NEXP;
constexpr float RMS_EPS = 1e-6f, SUBLN_EPS = 1e-5f, LOG2E = 1.4426950408889634f;
#ifndef QKV_FP8
#define QKV_FP8 0
#endif
#ifndef RIN_FP8
#define RIN_FP8 1
#endif
constexpr float WIN_SCALE = 64.f, IN_DESCALE = 1.0f / (16.f * 64.f);
constexpr float H8_SCALE = 16.f, W1_SCALE = 64.f, ACT_SCALE = 8.f, W2_SCALE = 32.f, Y_SCALE = 64.f;
constexpr float ATT_C2 = 0.125f * LOG2E;

constexpr size_t MiB = 1u << 20;
constexpr size_t WS_CTL = 0, CTL_ZERO_BYTES = 1 * MiB;
constexpr size_t WS_LIST = 1 * MiB;
constexpr size_t WS_PAIRW = 3 * MiB;
constexpr size_t WS_WRF = 3 * MiB + 512 * 1024;
constexpr size_t WS_SINCOS = 4 * MiB;
constexpr size_t WS_SINCOST = 6 * MiB;
constexpr size_t WS_WINT0 = 8 * MiB;
constexpr size_t WS_WOUTT0 = 14 * MiB;
constexpr size_t WS_WRINA = 16 * MiB;
constexpr size_t WS_WRINB = 24 * MiB;
constexpr size_t WS_WROUTT = 30 * MiB;
constexpr size_t WS_W1CAT = 34 * MiB;
constexpr size_t WS_W2T = 98 * MiB;
constexpr size_t WS_DS = 34 * MiB;
constexpr size_t WS_ORET = 34 * MiB;
constexpr size_t WS_HB = 130 * MiB;
constexpr size_t WS_ACTBASE = 162 * MiB;
constexpr size_t WS_QKV0 = WS_ACTBASE;
constexpr size_t WS_OP = WS_ACTBASE + 96 * MiB;
constexpr size_t WS_AO = WS_ACTBASE + 160 * MiB;
constexpr size_t WS_MACT = WS_ACTBASE;
constexpr size_t WS_Y = WS_ACTBASE + 40 * MiB;
constexpr size_t WS_X3 = WS_ACTBASE + 80 * MiB;
constexpr size_t WS_ACAT = WS_ACTBASE;
constexpr size_t WS_BTCAT = WS_ACTBASE + 64 * MiB;
constexpr size_t WS_KI = WS_ACTBASE + 192 * MiB;
constexpr size_t WS_KIT = WS_ACTBASE + 224 * MiB;
constexpr size_t WS_SG = WS_ACTBASE + 256 * MiB;
constexpr size_t WS_END = WS_ACTBASE + 320 * MiB;
constexpr int CW_TMO = 0, CW_BAR = 4096, CW_CNT = 16384;

constexpr int RING_OFF = 0, RING_BYTES = 131072;
constexpr int LX_OFF = RING_BYTES;
constexpr int LX_MISC = LX_OFF + 320;
constexpr int LX_ROWTAB = LX_OFF + 1024;
constexpr int LX_TSTART = LX_OFF + 5120;
constexpr int LX_TEXP = LX_OFF + 5376;
constexpr int LX_LUT = LX_OFF + 10240;
constexpr int LX_CNT = LX_OFF + 7168;
constexpr int LX_SSQ = LX_OFF + 8192;
constexpr int LDS_BYTES = 147456;

namespace pg8 {
struct EpiQKV {
    static constexpr bool PERM = true;
    bf16_t* O; float qscale;
    __device__ __forceinline__ void operator()(const f32x4 (&acc)[2][2][4][2], const Unit& u, int wr, int wc, int fr, int fq) const {
        const int row0 = u.pm * BM + wr * 64 + fr, col0 = u.pn * BM + wc * 32 + 8 * fq; const float sc = ((u.pn < 4) ? qscale : 1.f) * (QKV_FP8 ? IN_DESCALE : 1.f);
#pragma unroll
        for (int ai = 0; ai < 2; ++ai)
#pragma unroll
            for (int m = 0; m < 4; ++m) { bf16_t* rowp = O + (size_t)(row0 + ai * HALF + m * 16) * 3072 + col0;
#pragma unroll
                for (int bj = 0; bj < 2; ++bj) *(u32x4*)(rowp + bj * HALF) = pack8(acc[ai][bj][m][0] * sc, acc[ai][bj][m][1] * sc); }
    }
};
template <bool RESF32> struct EpiResB {
    static constexpr bool PERM = true;
    const void* res; bf16_t* out;
    __device__ __forceinline__ void operator()(const f32x4 (&acc)[2][2][4][2], const Unit& u, int wr, int wc, int fr, int fq) const {
        const int row0 = u.pm * BM + wr * 64 + fr, col0 = u.pn * BM + wc * 32 + 8 * fq;
#pragma unroll
        for (int ai = 0; ai < 2; ++ai)
#pragma unroll
            for (int m = 0; m < 4; ++m) { const size_t off = (size_t)(row0 + ai * HALF + m * 16) * 1024 + col0;
#pragma unroll
                for (int bj = 0; bj < 2; ++bj) { f32x4 r0, r1;
                    if (RESF32) { const float* rp = (const float*)res + off + bj * HALF; r0 = *(const f32x4*)rp; r1 = *(const f32x4*)(rp + 4); }
                    else { const u32x4 g = *(const u32x4*)((const bf16_t*)res + off + bj * HALF);
                        r0[0] = __uint_as_float(g.x << 16); r0[1] = __uint_as_float(g.x & 0xffff0000u); r0[2] = __uint_as_float(g.y << 16); r0[3] = __uint_as_float(g.y & 0xffff0000u);
                        r1[0] = __uint_as_float(g.z << 16); r1[1] = __uint_as_float(g.z & 0xffff0000u); r1[2] = __uint_as_float(g.w << 16); r1[3] = __uint_as_float(g.w & 0xffff0000u); }
                    *(u32x4*)(out + off + bj * HALF) = pack8(r0 + acc[ai][bj][m][0], r1 + acc[ai][bj][m][1]); }
                asm volatile("" ::: "memory"); }
    }
};
__device__ __forceinline__ float silu_f(float x) { return x * __builtin_amdgcn_rcpf(1.0f + __builtin_amdgcn_exp2f(-x * LOG2E)); }
__device__ __forceinline__ unsigned pk4_fp8(float a, float b, float c, float d) { int w = 0; w = __builtin_amdgcn_cvt_pk_fp8_f32(a, b, w, false); w = __builtin_amdgcn_cvt_pk_fp8_f32(c, d, w, true); return (unsigned)w; }
struct EpiMoe1 {
    static constexpr bool PERM = true;
    unsigned char* ACT;
    __device__ __forceinline__ void operator()(const f32x4 (&acc)[2][2][4][2], const Unit& u, int wr, int wc, int fr, int fq) const {
        const int row0 = u.pm * BM + wr * 64 + fr, col0 = (u.pn & 3) * 128 + wc * 32 + 8 * fq; constexpr float si = 1.0f / (H8_SCALE * W1_SCALE);
#pragma unroll
        for (int ai = 0; ai < 2; ++ai)
#pragma unroll
            for (int m = 0; m < 4; ++m) { f32x4 a0, a1;
#pragma unroll
                for (int j = 0; j < 4; ++j) { a0[j] = silu_f(acc[ai][0][m][0][j] * si) * acc[ai][1][m][0][j] * (si * ACT_SCALE); a1[j] = silu_f(acc[ai][0][m][1][j] * si) * acc[ai][1][m][1][j] * (si * ACT_SCALE); }
                u32x2 w; w.x = pk4_fp8(a0[0], a0[1], a0[2], a0[3]); w.y = pk4_fp8(a1[0], a1[1], a1[2], a1[3]);
                *(u32x2*)(ACT + (size_t)(row0 + ai * HALF + m * 16) * 512 + col0) = w; }
    }
};
struct EpiMoe2 {
    static constexpr bool PERM = true;
    unsigned char* Y; const int* list; const float* pairw; const LAS int* lcnt;
    __device__ __forceinline__ void operator()(const f32x4 (&acc)[2][2][4][2], const Unit& u, int wr, int wc, int fr, int fq) const {
        const int e = u.pn >> 2, col0 = (u.pn & 3) * BM + wc * 32 + 8 * fq, pos0 = u.aux * BM + wr * 64 + fr, cn = lcnt[e];
#pragma unroll
        for (int ai = 0; ai < 2; ++ai)
#pragma unroll
            for (int m = 0; m < 4; ++m) { const int pos = pos0 + ai * HALF + m * 16;
                if (pos < cn) { const int pair = list[e * LISTCAP + pos]; const float w = pairw[pair] * (Y_SCALE / (ACT_SCALE * W2_SCALE)); unsigned char* rowp = Y + (size_t)pair * 1024 + col0;
#pragma unroll
                    for (int bj = 0; bj < 2; ++bj) { const f32x4 a = acc[ai][bj][m][0] * w, c = acc[ai][bj][m][1] * w; u32x2 o; o.x = pk4_fp8(a[0], a[1], a[2], a[3]); o.y = pk4_fp8(c[0], c[1], c[2], c[3]);
                        *(u32x2*)(rowp + bj * HALF) = o; } } }
    }
};
__device__ __forceinline__ float log2_gamma(int h) { return __builtin_log2f(1.0f - __builtin_amdgcn_exp2f(-5.0f - (float)h)); }
struct EpiRetA {
    static constexpr bool PERM = true;
    bf16_t* ACAT; bf16_t* KI; bf16_t* SG; const float* sincos; bf16_t* KIT;
    __device__ __forceinline__ void operator()(const f32x4 (&acc)[2][2][4][2], const Unit& u, int wr, int wc, int fr, int fq) const {
        const int r0 = wr * 64 + fr, c0 = wc * 32 + 8 * fq;
        if (u.pn >= 8) {
#pragma unroll
            for (int ai = 0; ai < 2; ++ai)
#pragma unroll
                for (int m = 0; m < 4; ++m) { bf16_t* rowp = SG + (size_t)(u.pm * BM + r0 + ai * HALF + m * 16) * 2048 + (u.pn - 8) * BM + c0;
#pragma unroll
                    for (int bj = 0; bj < 2; ++bj) { f32x4 a0, a1;
#pragma unroll
                        for (int j = 0; j < 4; ++j) { a0[j] = silu_f(acc[ai][bj][m][0][j] * IN_DESCALE); a1[j] = silu_f(acc[ai][bj][m][1][j] * IN_DESCALE); }
                        *(u32x4*)(rowp + bj * HALF) = pack8(a0, a1); } }
            return;
        }
        const bool isq = u.pn < 4; const int h = u.pn & 3; const float l2g = log2_gamma(h);
        const int b = u.pm >> 3, n = u.pm & 7;
#pragma unroll
        for (int ai = 0; ai < 2; ++ai)
#pragma unroll
            for (int m = 0; m < 4; ++m) { const int r = r0 + ai * HALF + m * 16, pos = n * RC + r;
                const float fac = IN_DESCALE * (isq ? __builtin_amdgcn_exp2f((float)(r + 1) * l2g) : 0.0625f * __builtin_amdgcn_exp2f(-(float)(r + 1) * l2g));
                bf16_t* rowp = isq ? ACAT + ((size_t)((b * RH + h) * RNC + n) * RC + r) * 512 + 256 + c0 : KI + (size_t)(u.pm * BM + r) * 1024 + h * RDK + c0;
#pragma unroll
                for (int bj = 0; bj < 2; ++bj) { const f32x4* cs = (const f32x4*)(sincos + ((size_t)pos * 128 + (bj * HALF + c0) / 2) * 2);
                    const f32x4 t0 = cs[0], t1 = cs[1]; const f32x4 x0 = acc[ai][bj][m][0], x1 = acc[ai][bj][m][1]; f32x4 y0, y1;
                    y0[0] = (x0[0] * t0[0] - x0[1] * t0[1]) * fac; y0[1] = (x0[1] * t0[0] + x0[0] * t0[1]) * fac; y0[2] = (x0[2] * t0[2] - x0[3] * t0[3]) * fac; y0[3] = (x0[3] * t0[2] + x0[2] * t0[3]) * fac;
                    y1[0] = (x1[0] * t1[0] - x1[1] * t1[1]) * fac; y1[1] = (x1[1] * t1[0] + x1[0] * t1[1]) * fac; y1[2] = (x1[2] * t1[2] - x1[3] * t1[3]) * fac; y1[3] = (x1[3] * t1[2] + x1[2] * t1[3]) * fac;
                    *(u32x4*)(rowp + bj * HALF) = pack8(y0, y1);
                    if (!isq) {
                        const int s0 = fr & 1, s1 = (fr >> 1) & 1;
#pragma unroll
                        for (int nn = 0; nn < 2; ++nn) { const f32x4 a = nn ? y1 : y0; float t[4], c[4];
#pragma unroll
                            for (int j = 0; j < 4; ++j) { const float other = __shfl_xor(a[j ^ 1], 1); t[j] = (s0 == (j & 1)) ? a[j] : other; }
#pragma unroll
                            for (int j = 0; j < 4; ++j) { const float other = __shfl_xor(t[j ^ 2], 2); c[j] = (s1 == (j >> 1)) ? t[j] : other; }
                            u32x2 w; w.x = cvt_pk_bf16(c[0], c[1]); w.y = cvt_pk_bf16(c[2], c[3]);
                            const int col = bj * HALF + c0 + nn * 4 + (fr & 3), tok = n * RC + (r & ~3);
                            *(u32x2*)(KIT + ((size_t)((b * RH + h) * RDK + col)) * SEQ + tok) = w; } }
                } }
    }
};
struct EpiRetB {
    static constexpr bool PERM = true;
    bf16_t* BTCAT;
    __device__ __forceinline__ void operator()(const f32x4 (&acc)[2][2][4][2], const Unit& u, int wr, int wc, int fr, int fq) const {
        const int r0 = wr * 64 + fr, c0 = wc * 32 + 8 * fq; const int b = u.pn >> 3, n = u.pn & 7; const int h = u.pm >> 1, dv0 = (u.pm & 1) * BM;
#pragma unroll
        for (int ai = 0; ai < 2; ++ai)
#pragma unroll
            for (int m = 0; m < 4; ++m) { bf16_t* rowp = BTCAT + ((size_t)((b * RH + h) * RNC + n) * RDV + dv0 + r0 + ai * HALF + m * 16) * 512 + c0;
#pragma unroll
                for (int bj = 0; bj < 2; ++bj) *(u32x4*)(rowp + bj * HALF) = pack8(acc[ai][bj][m][0] * IN_DESCALE, acc[ai][bj][m][1] * IN_DESCALE); }
    }
};
struct EpiScores {
    static constexpr bool PERM = true;
    bf16_t* ACAT;
    __device__ __forceinline__ void operator()(const f32x4 (&acc)[2][2][4][2], const Unit& u, int wr, int wc, int fr, int fq) const {
        const int r0 = wr * 64 + fr, c0 = wc * 32 + 8 * fq;
#pragma unroll
        for (int ai = 0; ai < 2; ++ai)
#pragma unroll
            for (int m = 0; m < 4; ++m) { const int r = r0 + ai * HALF + m * 16; bf16_t* rowp = ACAT + ((size_t)u.pm * RC + r) * 512 + c0;
#pragma unroll
                for (int bj = 0; bj < 2; ++bj) { f32x4 y0 = acc[ai][bj][m][0], y1 = acc[ai][bj][m][1]; const int cb = bj * HALF + c0;
#pragma unroll
                    for (int j = 0; j < 4; ++j) { if (cb + j > r) y0[j] = 0.f; if (cb + 4 + j > r) y1[j] = 0.f; }
                    *(u32x4*)(rowp + bj * HALF) = pack8(y0, y1); } }
    }
};
struct EpiDS {
    static constexpr bool PERM = true;
    bf16_t* DS;
    __device__ __forceinline__ void operator()(const f32x4 (&acc)[2][2][4][2], const Unit& u, int wr, int wc, int fr, int fq) const {
        const int r0 = wr * 64 + fr, c0 = wc * 32 + 8 * fq;
#pragma unroll
        for (int ai = 0; ai < 2; ++ai)
#pragma unroll
            for (int m = 0; m < 4; ++m) { bf16_t* rowp = DS + ((size_t)u.pm * RDV + u.pn * BM + r0 + ai * HALF + m * 16) * RDK + c0;
#pragma unroll
                for (int bj = 0; bj < 2; ++bj) *(u32x4*)(rowp + bj * HALF) = pack8(acc[ai][bj][m][0], acc[ai][bj][m][1]); }
    }
};
struct EpiRetO {
    static constexpr bool PERM = true;
    bf16_t* ORET; bf16_t* SG; LAS float* ssq;
    __device__ __forceinline__ void operator()(const f32x4 (&acc)[2][2][4][2], const Unit& u, int wr, int wc, int fr, int fq) const {
        const int r0 = wr * 64 + fr, c0 = wc * 32 + 8 * fq; const int n = u.pm & 7, h = (u.pm >> 3) & 3, b = u.pm >> 5;
        LAS float* sq = ssq + (u.aux & 1) * 256;
        if (u.pn == 0) { const int t_ = threadIdx.x; if (t_ < 256) ssq[((u.aux & 1) ^ 1) * 256 + t_] = 0.f; }
#pragma unroll
        for (int ai = 0; ai < 2; ++ai)
#pragma unroll
            for (int m = 0; m < 4; ++m) { float s = 0.f;
#pragma unroll
                for (int bj = 0; bj < 2; ++bj)
#pragma unroll
                    for (int nn = 0; nn < 2; ++nn) { const f32x4 x = acc[ai][bj][m][nn]; s += (x[0] * x[0] + x[1] * x[1]) + (x[2] * x[2] + x[3] * x[3]); }
                s += __shfl_xor(s, 16); s += __shfl_xor(s, 32);
                if (fq == 0) (void)__hip_atomic_fetch_add(sq + r0 + ai * HALF + m * 16, s, __ATOMIC_RELAXED, __HIP_MEMORY_SCOPE_WORKGROUP); }
        const size_t rowbase = (size_t)(b * SEQ + n * RC) * 2048 + h * RDV;
        if (u.pn == 0) {
#pragma unroll
            for (int ai = 0; ai < 2; ++ai)
#pragma unroll
                for (int m = 0; m < 4; ++m) { bf16_t* rowp = ORET + rowbase + (size_t)(r0 + ai * HALF + m * 16) * 2048 + c0;
#pragma unroll
                    for (int bj = 0; bj < 2; ++bj) *(u32x4*)(rowp + bj * HALF) = pack8(acc[ai][bj][m][0], acc[ai][bj][m][1]); }
            return;
        }
        asm volatile("s_waitcnt lgkmcnt(0)" ::: "memory"); __builtin_amdgcn_s_barrier(); asm volatile("" ::: "memory");
#pragma unroll
        for (int ai = 0; ai < 2; ++ai)
#pragma unroll
            for (int m = 0; m < 4; ++m) { const int r = r0 + ai * HALF + m * 16; const float rstd = __builtin_amdgcn_rsqf(sq[r] * (1.0f / 512.0f) + RMS_EPS);
                const size_t ro = rowbase + (size_t)r * 2048 + c0;
#pragma unroll
                for (int bj = 0; bj < 2; ++bj) {
                    { bf16_t* gp = SG + ro + BM + bj * HALF; const u32x4 g = *(const u32x4*)gp; f32x4 y0 = acc[ai][bj][m][0] * rstd, y1 = acc[ai][bj][m][1] * rstd;
                      y0[0] *= __uint_as_float(g.x << 16); y0[1] *= __uint_as_float(g.x & 0xffff0000u); y0[2] *= __uint_as_float(g.y << 16); y0[3] *= __uint_as_float(g.y & 0xffff0000u);
                      y1[0] *= __uint_as_float(g.z << 16); y1[1] *= __uint_as_float(g.z & 0xffff0000u); y1[2] *= __uint_as_float(g.w << 16); y1[3] *= __uint_as_float(g.w & 0xffff0000u);
                      *(u32x4*)gp = pack8(y0, y1); }
                    { bf16_t* gp = SG + ro + bj * HALF; const u32x4 g = *(const u32x4*)gp; const u32x4 o = *(const u32x4*)(ORET + ro + bj * HALF); f32x4 y0, y1;
                      y0[0] = __uint_as_float(o.x << 16) * rstd * __uint_as_float(g.x << 16); y0[1] = __uint_as_float(o.x & 0xffff0000u) * rstd * __uint_as_float(g.x & 0xffff0000u);
                      y0[2] = __uint_as_float(o.y << 16) * rstd * __uint_as_float(g.y << 16); y0[3] = __uint_as_float(o.y & 0xffff0000u) * rstd * __uint_as_float(g.y & 0xffff0000u);
                      y1[0] = __uint_as_float(o.z << 16) * rstd * __uint_as_float(g.z << 16); y1[1] = __uint_as_float(o.z & 0xffff0000u) * rstd * __uint_as_float(g.z & 0xffff0000u);
                      y1[2] = __uint_as_float(o.w << 16) * rstd * __uint_as_float(g.w << 16); y1[3] = __uint_as_float(o.w & 0xffff0000u) * rstd * __uint_as_float(g.w & 0xffff0000u);
                      *(u32x4*)gp = pack8(y0, y1); } } }
    }
};
struct ScoresOrder {
    int G, c;
    __device__ bool next(int i, Unit& u) const { const int L = i * G + c; if (L >= NB * RH * RNC) return false; const int n = L & 7, h = (L >> 3) & 3, b = L >> 5;
        u.pm = L; u.pn = 0; u.aux = 0; u.aoff = (long)L * RC * 512 + 256; u.boff = (long)(b * SEQ + n * RC) * 1024 + h * RDK; return true; }
};
struct DsOrder {
    int G, c;
    __device__ bool next(int i, Unit& u) const { const int L = i * G + c; if (L >= NB * RH * 7 * 2) return false; const int dvt = L & 1, q = L >> 1, n = q % 7, bh = q / 7, p = bh * RNC + n;
        u.pm = p; u.pn = dvt; u.aux = 0; u.aoff = ((long)p * RDV + dvt * BM) * 512; u.boff = (long)bh * RDK * SEQ + n * RC; return true; }
};
struct RetOOrder {
    int G, c;
    __device__ bool next(int i, Unit& u) const { const int k = i >> 1, dvt = i & 1, p = k * G + c; if (p >= NB * RH * RNC) return false;
        u.pm = p; u.pn = dvt; u.aux = k; u.aoff = (long)p * RC * 512; u.boff = ((long)p * RDV + dvt * BM) * 512; return true; }
};
struct MoeOrder {
    int G, c, ldb; long a_tile; const LAS int* tstart; const LAS int* texp;
    __device__ bool next(int i, Unit& u) const { const int L = i * G + c; const int ntiles = tstart[33]; if (L >= ntiles * 4) return false; const int rt = L >> 2, pnl = L & 3, e = texp[rt];
        u.pm = rt; u.pn = e * 4 + pnl; u.aux = rt - tstart[e]; u.aoff = (long)rt * a_tile; u.boff = ((long)e * 1024 + pnl * BM) * ldb; return true; }
};
}
namespace attn_body {
using bf16=__hip_bfloat16;
using bf16x8=__attribute__((ext_vector_type(8)))short;
using s16x4=__attribute__((ext_vector_type(4)))short;
using f32x16=__attribute__((ext_vector_type(16)))float;
using u32x4=__attribute__((ext_vector_type(4)))unsigned;
constexpr int D=64,PQ=3072,PO=1024;
constexpr int NW=8,QBLK=32,QB=QBLK*NW,KVBLK=64,NQB=SEQ/QB;
__device__ __forceinline__ int crow(int r,int hi){return (r&3)+8*(r>>2)+4*hi;}
#define SBAR() __builtin_amdgcn_sched_barrier(0)
__device__ __forceinline__ void biasmask(f32x16&p0,f32x16&p1,int jb6,int qrel,int hi,const LAS float*lut2){
  const LAS float*pb=lut2+(128+qrel-64*jb6-4*hi+288-91);
  #pragma unroll
  for(int g=0;g<4;++g){
    #pragma unroll
    for(int q=0;q<4;++q){const int r=4*g+q, c=q+8*g; const int rel=128+qrel-64*jb6-4*hi-c; const float b0=pb[91-c], b1=pb[91-c-32]; p0[r]=(rel<0)?-INFINITY:p0[r]+b0; p1[r]=(rel<32)?-INFINITY:p1[r]+b1;}
    asm volatile("":"+v"(p0),"+v"(p1)); __builtin_amdgcn_sched_barrier(0);}
}
constexpr int NSLOT=3, SLOTB=8192;
constexpr int LDS_K=0, LDS_V=NSLOT*SLOTB, LDS_WS=2*NSLOT*SLOTB, LDS_OST=LDS_WS+NW*64*4, LDS_BYTES=LDS_OST+NW*4096;
__device__ __forceinline__ void glds16(const void*gsrc,unsigned lds_dst){unsigned keep;
  asm volatile("s_mov_b32 %0, m0\n\ts_mov_b32 m0, %2\n\ts_nop 0\n\tglobal_load_lds_dwordx4 %1, off\n\ts_mov_b32 m0, %0":"=&s"(keep):"v"(gsrc),"s"(lds_dst):"memory");}
__device__ __forceinline__ float max3f(float a,float b,float c){float r;asm("v_max3_f32 %0, %1, %2, %3":"=v"(r):"v"(a),"v"(b),"v"(c));return r;}
__device__ __forceinline__ float max2f(float a,float b){float r;asm("v_max_f32_e32 %0, %1, %2":"=v"(r):"v"(a),"v"(b));return r;}
__device__ __forceinline__ float fadd_s(float a,float b){float r;asm("v_add_f32_e32 %0, %1, %2":"=v"(r):"v"(a),"v"(b));return r;}
__device__ __forceinline__ float fsub_s(float a,float b){float r;asm("v_sub_f32_e32 %0, %1, %2":"=v"(r):"v"(a),"v"(b));return r;}
typedef float f32x2_t __attribute__((ext_vector_type(2))); typedef __bf16 bf16x2_t __attribute__((ext_vector_type(2)));
__device__ __forceinline__ unsigned cvtpk_s(float lo,float hi){f32x2_t v={lo,hi};bf16x2_t b=__builtin_convertvector(v,bf16x2_t);return __builtin_bit_cast(unsigned,b);}
#define WAIT_BAR(N) asm volatile("s_waitcnt vmcnt(" #N ") lgkmcnt(0)\n\ts_barrier":::"memory")

__device__ __forceinline__ void qkt(f32x16&p0,f32x16&p1,const char*Kslot,const bf16x8*qr,const f32x16&negm,int r32,int hi){
  const char*kb=Kslot+hi*1024+r32*16;
  #pragma unroll
  for(int d0=0;d0<4;++d0){
    const bf16x8 b0=*reinterpret_cast<const bf16x8*>(kb+d0*2048);
    const bf16x8 b1=*reinterpret_cast<const bf16x8*>(kb+d0*2048+512);
    if(d0==0){p0=__builtin_amdgcn_mfma_f32_32x32x16_bf16(b0,qr[0],negm,0,0,0);p1=__builtin_amdgcn_mfma_f32_32x32x16_bf16(b1,qr[0],negm,0,0,0);}
    else{p0=__builtin_amdgcn_mfma_f32_32x32x16_bf16(b0,qr[d0],p0,0,0,0);p1=__builtin_amdgcn_mfma_f32_32x32x16_bf16(b1,qr[d0],p1,0,0,0);}}
}
typedef LAS const char* lds_cptr;
typedef short v4i16_t __attribute__((ext_vector_type(4)));
__device__ __forceinline__ void kload8(bf16x8*kf,lds_cptr kp){
  kf[0]=*(const LAS bf16x8*)(kp);      kf[1]=*(const LAS bf16x8*)(kp+512);
  kf[2]=*(const LAS bf16x8*)(kp+2048); kf[3]=*(const LAS bf16x8*)(kp+2560);
  kf[4]=*(const LAS bf16x8*)(kp+4096); kf[5]=*(const LAS bf16x8*)(kp+4608);
  kf[6]=*(const LAS bf16x8*)(kp+6144); kf[7]=*(const LAS bf16x8*)(kp+6656);
}
__device__ __forceinline__ void kload2(bf16x8*kf,lds_cptr kp,int j){ kf[2*j]=*(const LAS bf16x8*)(kp+j*2048); kf[2*j+1]=*(const LAS bf16x8*)(kp+j*2048+512); }
__device__ __forceinline__ s16x4 vtr(lds_cptr p){ return __builtin_bit_cast(s16x4,__builtin_amdgcn_ds_read_tr16_b64_v4i16((LAS v4i16_t*)p)); }
__device__ __forceinline__ float rowmax(const f32x16&p0,const f32x16&p1){
  float a=max3f(p0[0],p0[1],p1[0]),b=max3f(p0[2],p0[3],p1[1]);a=max3f(a,p1[2],p1[3]);
  #pragma unroll
  for(int r=4;r<16;r+=4){a=max3f(a,p0[r],p0[r+1]);b=max3f(b,p0[r+2],p0[r+3]);a=max3f(a,p1[r],p1[r+1]);b=max3f(b,p1[r+2],p1[r+3]);}
  const float m=max2f(a,b);
  auto rr=__builtin_amdgcn_permlane32_swap(__float_as_uint(m),__float_as_uint(m),false,false);
  return max2f(__uint_as_float(rr[0]),__uint_as_float(rr[1]));
}
__device__ __forceinline__ void pv(f32x16*o,int vb,bf16x8 pa0,bf16x8 pa1,bf16x8 pa2,bf16x8 pa3){
  #pragma unroll
  for(int d0=0;d0<2;++d0){s16x4 lo[4],hi[4];
    #pragma unroll
    for(int ks=0;ks<4;++ks){
      asm volatile("ds_read_b64_tr_b16 %0,%1 offset:%c2":"=&v"(lo[ks]):"v"(vb),"i"(d0*4096+ks*1024):"memory");
      asm volatile("ds_read_b64_tr_b16 %0,%1 offset:%c2":"=&v"(hi[ks]):"v"(vb),"i"(d0*4096+ks*1024+512):"memory");}
    asm volatile("s_waitcnt lgkmcnt(0)":::"memory");SBAR();
    #define PK(k) (bf16x8){lo[k][0],lo[k][1],lo[k][2],lo[k][3],hi[k][0],hi[k][1],hi[k][2],hi[k][3]}
    o[d0]=__builtin_amdgcn_mfma_f32_32x32x16_bf16(pa0,PK(0),o[d0],0,0,0);
    o[d0]=__builtin_amdgcn_mfma_f32_32x32x16_bf16(pa1,PK(1),o[d0],0,0,0);
    o[d0]=__builtin_amdgcn_mfma_f32_32x32x16_bf16(pa2,PK(2),o[d0],0,0,0);
    o[d0]=__builtin_amdgcn_mfma_f32_32x32x16_bf16(pa3,PK(3),o[d0],0,0,0);
    #undef PK
  }
}
template<int THRL> __device__ __forceinline__ void attn_unit(int b,int qb,const bf16*QKV,int Qc,int Kc,int Vc,bf16*O,const LAS float*lut,char*shm){
  int tid_=threadIdx.x; asm volatile("":"+v"(tid_)); const int tid=tid_,lane=tid&63,r32=lane&31,hi=lane>>5; const int wid=__builtin_amdgcn_readfirstlane(tid>>6);
  const long rowbase=(long)b*SEQ; const int q0=qb*QB;
  const bf16*Qw=QKV+(rowbase+q0+wid*QBLK)*PQ+Qc;
  const bf16*Kh=QKV+rowbase*PQ+Kc,*Vh=QKV+rowbase*PQ+Vc;
  const unsigned lds0=(unsigned)(uintptr_t)shm;
  float*wsf=(float*)(shm+LDS_WS)+wid*64;
  const bf16*ksrc=Kh+(long)lane*PQ+wid*8;
  const bf16*vsrc=Vh+(long)(16*(wid&3)+(lane>>2))*PQ+(wid>>2)*32+(lane&3)*8;
  const unsigned kdst=lds0+LDS_K+wid*1024, vdst=lds0+LDS_V+wid*1024;
  #define DMA_K(t,slot) glds16(ksrc+(long)(t)*KVBLK*PQ,(unsigned)__builtin_amdgcn_readfirstlane(kdst+(slot)))
  #define DMA_V(t,slot) glds16(vsrc+(long)(t)*KVBLK*PQ,(unsigned)__builtin_amdgcn_readfirstlane(vdst+(slot)))
  const int vb0=(int)(lds0+LDS_V)+((lane>>4)&1)*32+(lane&3)*8+(4*hi+((lane&15)>>2))*64;
  const char*Kbase=shm+LDS_K; bf16x8 kf[8];
  const lds_cptr shm3=(lds_cptr)shm; const lds_cptr kp0=shm3+LDS_K+hi*1024+r32*16; const lds_cptr vp0=shm3+LDS_V+((lane>>4)&1)*32+(lane&3)*8+(4*hi+((lane&15)>>2))*64;
  const int NT=(q0+QB)/KVBLK;
  DMA_K(0,0);DMA_V(0,0);DMA_K(1,SLOTB);
  bf16x8 qr[4];
  #pragma unroll
  for(int d0=0;d0<4;++d0)qr[d0]=*reinterpret_cast<const bf16x8*>(&Qw[(long)r32*PQ+d0*16+hi*8]);
  float mhat=0.f,l_reg=0.f;f32x16 o[2];f32x16 negm; { float zz; asm volatile("v_mov_b32 %0, 0":"=v"(zz)); _Pragma("unroll") for(int r=0;r<16;++r){o[0][r]=zz;o[1][r]=zz;negm[r]=zz;} } asm volatile("":"+v"(negm));
  const int qrel=wid*QBLK+r32;
  #define CMASK(P0,P1,t) do{int jb_=(t)-(NT-6); if(jb_>=0)biasmask(P0,P1,jb_,qrel,hi,lut);}while(0)
  bool resc=false;
  #define START(P0,P1) do{ const float rm=rowmax(P0,P1); resc=false; \
    { const float dl=rm; mhat=fadd_s(mhat,dl); \
      _Pragma("unroll") for(int r=0;r<16;++r){P0[r]=fsub_s(P0[r],dl);P1[r]=fsub_s(P1[r],dl);} \
      _Pragma("unroll") for(int r=0;r<16;++r)negm[r]=-mhat; asm volatile("":"+v"(negm)); } \
    _Pragma("unroll") for(int r=0;r<16;++r)P0[r]=__builtin_amdgcn_exp2f(P0[r]); }while(0)
  #define RESC() do{ if(resc){ asm volatile("s_waitcnt lgkmcnt(0)":::"memory"); \
      _Pragma("unroll") for(int d_=0;d_<2;++d_) _Pragma("unroll") for(int r=0;r<16;++r)o[d_][r]*=wsf[crow(r,hi)]; } }while(0)
  f32x16 pA0,pA1,pB0,pB1;
  int sl_prev=0,sl_cur=0,sl_next=SLOTB;
  #define ROT() do{sl_prev=sl_cur;sl_cur=sl_next;sl_next=(sl_next==(NSLOT-1)*SLOTB)?0:sl_next+SLOTB;}while(0)
  DMA_K(2,2*SLOTB);
  WAIT_BAR(3);
  qkt(pA0,pA1,Kbase,qr,negm,r32,hi);asm volatile("s_nop 15\n\ts_nop 7":"+v"(pA0),"+v"(pA1));CMASK(pA0,pA1,0);
  START(pA0,pA1);
  _Pragma("unroll") for(int r=0;r<16;++r)pA1[r]=__builtin_amdgcn_exp2f(pA1[r]);
  WAIT_BAR(0);
  DMA_K(3,0);DMA_V(1,SLOTB);
  ROT();
  kload8(kf,kp0+sl_cur);
  WAIT_BAR(2);
  s16x4 vlo[8],vhi[8]; u32x4 pw0,pw1,pw2,pw3;
  #define PKW(P,B) cvtpk_s(P[B],P[B+1])
  #define PAF(k) __builtin_bit_cast(bf16x8,pw##k)
  #define VFR(i) (bf16x8){vlo[i][0],vlo[i][1],vlo[i][2],vlo[i][3],vhi[i][0],vhi[i][1],vhi[i][2],vhi[i][3]}
  #define PIN(x) asm volatile("":"+v"(x))
  #define MX3(a,b,c) __builtin_fmaxf(__builtin_fmaxf((a),(b)),(c))
  #define GAPA(MF,A0,A1,A2,A3,W0,W1,PW) do{ MF; sacc+=A0; sacc+=A1; sacc+=A2; sacc+=A3; PIN(sacc); W0; W1; PIN(PW); SBAR(); }while(0)
  #define EX(v) __builtin_amdgcn_exp2f(v)
  #define GAPB(MF,X,B) do{ MF; X[B]=EX(X[B]); X[B+1]=EX(X[B+1]); X[B+2]=EX(X[B+2]); X[B+3]=EX(X[B+3]); PIN(X); SBAR(); }while(0)
  #define VRD(i) do{ vlo[i]=vtr(vp_+(((i)>>2)*4096+((i)&3)*1024)); vhi[i]=vtr(vp_+(((i)>>2)*4096+((i)&3)*1024+512)); }while(0)
  #define KRD(G,j) do{ if(G){ kload2(kf,kp0+sl_next,j); SBAR(); } }while(0)
  #define STEP(C0,C1,P0,P1,t,GK,GV,GL) do{ SBAR(); \
    const lds_cptr vp_=vp0+sl_prev; \
    VRD(0); SBAR(); float sacc=(P0[0]+P0[1]); \
    GAPA(C0=__builtin_amdgcn_mfma_f32_32x32x16_bf16(kf[0],qr[0],negm,0,0,0), P0[2],P0[3],P0[4],P0[5],     pw0[0]=PKW(P0,0), pw0[1]=PKW(P0,2), pw0); \
    VRD(4); SBAR(); GAPA(C1=__builtin_amdgcn_mfma_f32_32x32x16_bf16(kf[1],qr[0],negm,0,0,0), P0[6],P0[7],P0[8],P0[9],     pw0[2]=PKW(P0,4), pw0[3]=PKW(P0,6), pw0); \
    VRD(1); SBAR(); GAPA(C0=__builtin_amdgcn_mfma_f32_32x32x16_bf16(kf[2],qr[1],C0,0,0,0),   P0[10],P0[11],P0[12],P0[13], pw1[0]=PKW(P0,8), pw1[1]=PKW(P0,10), pw1); \
    VRD(5); SBAR(); GAPA(C1=__builtin_amdgcn_mfma_f32_32x32x16_bf16(kf[3],qr[1],C1,0,0,0),   P0[14],P0[15],P1[0],P1[1],   pw1[2]=PKW(P0,12),pw1[3]=PKW(P0,14), pw1); \
    VRD(2); SBAR(); GAPA(C0=__builtin_amdgcn_mfma_f32_32x32x16_bf16(kf[4],qr[2],C0,0,0,0),   P1[2],P1[3],P1[4],P1[5],     pw2[0]=PKW(P1,0), pw2[1]=PKW(P1,2), pw2); \
    VRD(6); SBAR(); GAPA(C1=__builtin_amdgcn_mfma_f32_32x32x16_bf16(kf[5],qr[2],C1,0,0,0),   P1[6],P1[7],P1[8],P1[9],     pw2[2]=PKW(P1,4), pw2[3]=PKW(P1,6), pw2); \
    VRD(3); SBAR(); GAPA(C0=__builtin_amdgcn_mfma_f32_32x32x16_bf16(kf[6],qr[3],C0,0,0,0),   P1[10],P1[11],P1[12],P1[13], pw3[0]=PKW(P1,8), pw3[1]=PKW(P1,10), pw3); \
    VRD(7); SBAR(); GAPA(C1=__builtin_amdgcn_mfma_f32_32x32x16_bf16(kf[7],qr[3],C1,0,0,0),   P1[14],P1[15],0.f,0.f,       pw3[2]=PKW(P1,12),pw3[3]=PKW(P1,14), pw3); \
    l_reg+=sacc; \
    if(GK){DMA_K((t)+3,sl_cur);} if(GV){DMA_V((t)+1,sl_next);} \
    CMASK(C0,C1,t); \
    { float a=MX3(C0[0],C0[1],C1[0]),b=MX3(C0[2],C0[3],C1[1]); a=MX3(a,C1[2],C1[3]); \
      _Pragma("unroll") for(int r=4;r<16;r+=4){a=MX3(a,C0[r],C0[r+1]);b=MX3(b,C0[r+2],C0[r+3]);a=MX3(a,C1[r],C1[r+1]);b=MX3(b,C1[r+2],C1[r+3]);} \
      float rm=__builtin_fmaxf(a,b); { auto rr=__builtin_amdgcn_permlane32_swap(__float_as_uint(rm),__float_as_uint(rm),false,false); rm=__builtin_fmaxf(__uint_as_float(rr[0]),__uint_as_float(rr[1])); } \
      resc=false; \
      if(__builtin_expect(__any(rm>(float)THRL),0)){ const float dl=__builtin_fmaxf(rm,0.f); mhat+=dl; \
        _Pragma("unroll") for(int r=0;r<16;++r){C0[r]-=dl;C1[r]-=dl;} \
        _Pragma("unroll") for(int r=0;r<16;++r)negm[r]=-mhat; asm volatile("":"+v"(negm)); \
        const float f=__builtin_amdgcn_exp2f(-dl); l_reg*=f; if(hi==0)wsf[r32]=f; resc=true; } } \
    SBAR(); \
    GAPB(o[0]=__builtin_amdgcn_mfma_f32_32x32x16_bf16(PAF(0),VFR(0),o[0],0,0,0), C0,0); \
    GAPB(o[1]=__builtin_amdgcn_mfma_f32_32x32x16_bf16(PAF(0),VFR(4),o[1],0,0,0), C0,4); \
    KRD(GL,0); GAPB(o[0]=__builtin_amdgcn_mfma_f32_32x32x16_bf16(PAF(1),VFR(1),o[0],0,0,0), C0,8); \
    KRD(GL,1); GAPB(o[1]=__builtin_amdgcn_mfma_f32_32x32x16_bf16(PAF(1),VFR(5),o[1],0,0,0), C0,12); \
    KRD(GL,2); GAPB(o[0]=__builtin_amdgcn_mfma_f32_32x32x16_bf16(PAF(2),VFR(2),o[0],0,0,0), C1,0); \
    KRD(GL,3); GAPB(o[1]=__builtin_amdgcn_mfma_f32_32x32x16_bf16(PAF(2),VFR(6),o[1],0,0,0), C1,4); \
    GAPB(o[0]=__builtin_amdgcn_mfma_f32_32x32x16_bf16(PAF(3),VFR(3),o[0],0,0,0), C1,8); \
    GAPB(o[1]=__builtin_amdgcn_mfma_f32_32x32x16_bf16(PAF(3),VFR(7),o[1],0,0,0), C1,12); \
    }while(0)
  int t=1;
  #undef CMASK
  #define CMASK(P0,P1,t) do{}while(0)
  for(;t+7<NT;t+=2){
    STEP(pB0,pB1,pA0,pA1,t,true,true,true);     WAIT_BAR(2); RESC(); ROT();
    STEP(pA0,pA1,pB0,pB1,t+1,true,true,true);   WAIT_BAR(2); RESC(); ROT();
  }
  #undef CMASK
  #define CMASK(P0,P1,t) do{int jb_=(t)-(NT-6); if(jb_>=0)biasmask(P0,P1,jb_,qrel,hi,lut);}while(0)
  #define ENDW(tt) do{ if((tt)+3<NT){WAIT_BAR(2);} else if((tt)+2<NT){WAIT_BAR(1);} else {WAIT_BAR(0);} }while(0)
  for(;t+1<NT;t+=2){
    STEP(pB0,pB1,pA0,pA1,t,(t+3<NT),(t+1<NT),(t+1<NT));       ENDW(t);   RESC(); ROT();
    STEP(pA0,pA1,pB0,pB1,t+1,(t+4<NT),(t+2<NT),(t+2<NT));     ENDW(t+1); RESC(); ROT();
  }
  STEP(pB0,pB1,pA0,pA1,NT-1,false,false,false); RESC();
  { float sacc=pB0[0]+pB0[1]; _Pragma("unroll") for(int r=2;r<16;++r)sacc+=pB0[r]; _Pragma("unroll") for(int r=0;r<16;++r)sacc+=pB1[r]; l_reg+=sacc;
    pw0=(u32x4){PKW(pB0,0),PKW(pB0,2),PKW(pB0,4),PKW(pB0,6)};pw1=(u32x4){PKW(pB0,8),PKW(pB0,10),PKW(pB0,12),PKW(pB0,14)};pw2=(u32x4){PKW(pB1,0),PKW(pB1,2),PKW(pB1,4),PKW(pB1,6)};pw3=(u32x4){PKW(pB1,8),PKW(pB1,10),PKW(pB1,12),PKW(pB1,14)};
    SBAR(); pv(o,vb0+sl_cur,PAF(0),PAF(1),PAF(2),PAF(3)); }
  #undef PKW
  #undef PAF
  #undef VFR
  #undef PIN
  #undef MX3
  #undef GAPA
  #undef GAPB
  #undef EX
  #undef VRD
  #undef KRD
  #undef STEP
  #undef ENDW
  {auto rr=__builtin_amdgcn_permlane32_swap(__float_as_uint(l_reg),__float_as_uint(l_reg),false,false);l_reg=__uint_as_float(rr[0])+__uint_as_float(rr[1]);}
  if(hi==0)wsf[32+r32]=l_reg;asm volatile("s_waitcnt lgkmcnt(0)":::"memory");
  float rli[16];
  #pragma unroll
  for(int r=0;r<16;++r)rli[r]=__builtin_amdgcn_rcpf(wsf[32+crow(r,hi)]);
  bf16*Ow=O+(rowbase+q0+wid*QBLK)*PO;
  { bf16*stg=(bf16*)(shm+LDS_OST)+wid*2048;
    #pragma unroll
    for(int r=0;r<16;++r){const int orow=crow(r,hi);
      #pragma unroll
      for(int d0=0;d0<2;++d0)stg[orow*64+d0*32+r32]=__float2bfloat16(o[d0][r]*rli[r]);}
    asm volatile("s_waitcnt lgkmcnt(0)":::"memory");
    #pragma unroll
    for(int i=0;i<4;++i){const int row=i*8+(lane>>3),ch=lane&7; const u32x4 v=*(const u32x4*)(stg+row*64+ch*8); *(u32x4*)(Ow+(long)row*PO+ch*8)=v;} }
  asm volatile("s_waitcnt lgkmcnt(0)\n\ts_barrier":::"memory");
  #undef DMA_K
  #undef DMA_V
  #undef CMASK
  #undef START
  #undef RESC
  #undef ROT
}

constexpr int VSLOTB=16384, L2_K=0, L2_V=NSLOT*SLOTB, L2_WS=L2_V+NSLOT*VSLOTB, L2_QO=L2_WS+NW*64*4, L2_BYTES=L2_QO+NW*4096;
template<int THRL> __device__ __forceinline__ void attn_unit128(int b,int qb,const bf16*QKV,int Qc,int Kc,int Vc,bf16*O,const LAS float*lut,char*shm){
  int tid_=threadIdx.x; asm volatile("":"+v"(tid_)); const int tid=tid_,lane=tid&63,r32=lane&31,hi=lane>>5; const int wid=__builtin_amdgcn_readfirstlane(tid>>6);
  const long rowbase=(long)b*SEQ; const int q0=qb*QB;
  const bf16*Qw=QKV+(rowbase+q0+wid*QBLK)*PQ+Qc;
  const bf16*Kh=QKV+rowbase*PQ+Kc,*Vh=QKV+rowbase*PQ+Vc;
  const unsigned lds0=(unsigned)(uintptr_t)shm;
  float*wsf=(float*)(shm+L2_WS)+wid*64;
  const bf16*ksrc=Kh+(long)lane*PQ+wid*8;
  const bf16*vsrc=Vh+(long)(16*(wid&3)+(lane>>2))*PQ+(wid>>2)*32+(lane&3)*8;
  const unsigned kdst=lds0+L2_K+wid*1024, vdst=lds0+L2_V+wid*1024;
  #define DMA_K(t,slot) glds16(ksrc+(long)(t)*KVBLK*PQ,(unsigned)__builtin_amdgcn_readfirstlane(kdst+(slot)))
  #define DMA_V(t,slot) do{ glds16(vsrc+(long)(t)*KVBLK*PQ,(unsigned)__builtin_amdgcn_readfirstlane(vdst+2*(slot))); glds16(vsrc+(long)(t)*KVBLK*PQ+64,(unsigned)__builtin_amdgcn_readfirstlane(vdst+2*(slot)+8192)); }while(0)
  const int vb0=(int)(lds0+L2_V)+((lane>>4)&1)*32+(lane&3)*8+(4*hi+((lane&15)>>2))*64;
  const char*Kbase=shm+L2_K; bf16x8 kf[8];
  const lds_cptr shm3=(lds_cptr)shm; const lds_cptr kp0=shm3+L2_K+hi*1024+r32*16; const lds_cptr vp0=shm3+L2_V+((lane>>4)&1)*32+(lane&3)*8+(4*hi+((lane&15)>>2))*64;
  const lds_cptr qst=shm3+L2_QO+wid*4096+lane*16;
  const int NT=(q0+QB)/KVBLK;
  DMA_K(0,0);DMA_V(0,0);DMA_K(1,SLOTB);
  { bf16x8 qr[4];
    #pragma unroll
    for(int d0=0;d0<4;++d0)qr[d0]=*reinterpret_cast<const bf16x8*>(&Qw[(long)r32*PQ+d0*16+hi*8]);
    #pragma unroll
    for(int d0=0;d0<4;++d0)*(LAS bf16x8*)(qst+d0*1024)=qr[d0]; }
  float mhat=0.f,l_reg=0.f;f32x16 o[4]; { float zz; asm volatile("v_mov_b32 %0, 0":"=v"(zz)); _Pragma("unroll") for(int r=0;r<16;++r){o[0][r]=zz;o[1][r]=zz;o[2][r]=zz;o[3][r]=zz;} }
  const int qrel=wid*QBLK+r32;
  #define QF(d0) (*(const LAS bf16x8*)(qst+(d0)*1024))
  #define CMASK(P0,P1,t) do{int jb_=(t)-(NT-6); if(jb_>=0)biasmask(P0,P1,jb_,qrel,hi,lut);}while(0)
  bool resc=false;
  #define RESC() do{ if(resc){ asm volatile("s_waitcnt lgkmcnt(0)":::"memory"); \
      _Pragma("unroll") for(int d_=0;d_<4;++d_) _Pragma("unroll") for(int r=0;r<16;++r)o[d_][r]*=wsf[crow(r,hi)]; } }while(0)
  f32x16 pA0,pA1,pB0,pB1;
  int sl_prev=0,sl_cur=0,sl_next=SLOTB;
  #define ROT() do{sl_prev=sl_cur;sl_cur=sl_next;sl_next=(sl_next==(NSLOT-1)*SLOTB)?0:sl_next+SLOTB;}while(0)
  DMA_K(2,2*SLOTB);
  WAIT_BAR(3);
  {
    const char*kb=Kbase+hi*1024+r32*16; const f32x16 z16={};
    #pragma unroll
    for(int d0=0;d0<4;++d0){ const bf16x8 qf=QF(d0);
      const bf16x8 b0=*reinterpret_cast<const bf16x8*>(kb+d0*2048); const bf16x8 b1=*reinterpret_cast<const bf16x8*>(kb+d0*2048+512);
      if(d0==0){pA0=__builtin_amdgcn_mfma_f32_32x32x16_bf16(b0,qf,z16,0,0,0);pA1=__builtin_amdgcn_mfma_f32_32x32x16_bf16(b1,qf,z16,0,0,0);}
      else{pA0=__builtin_amdgcn_mfma_f32_32x32x16_bf16(b0,qf,pA0,0,0,0);pA1=__builtin_amdgcn_mfma_f32_32x32x16_bf16(b1,qf,pA1,0,0,0);} }
    asm volatile("s_nop 15\n\ts_nop 7":"+v"(pA0),"+v"(pA1));CMASK(pA0,pA1,0);
    mhat=rowmax(pA0,pA1);
    #pragma unroll
    for(int r=0;r<16;++r){pA0[r]=__builtin_amdgcn_exp2f(pA0[r]-mhat);pA1[r]=__builtin_amdgcn_exp2f(pA1[r]-mhat);} }
  WAIT_BAR(0);
  DMA_K(3,0);DMA_V(1,SLOTB);
  ROT();
  kload8(kf,kp0+sl_cur);
  WAIT_BAR(3);
  s16x4 vlo[8],vhi[8]; u32x4 pw0,pw1,pw2,pw3;
  #define PKW(P,B) cvtpk_s(P[B],P[B+1])
  #define PAF(k) __builtin_bit_cast(bf16x8,pw##k)
  #define VFR(i) (bf16x8){vlo[i][0],vlo[i][1],vlo[i][2],vlo[i][3],vhi[i][0],vhi[i][1],vhi[i][2],vhi[i][3]}
  #define PIN(x) asm volatile("":"+v"(x))
  #define MX3(a,b,c) __builtin_fmaxf(__builtin_fmaxf((a),(b)),(c))
  #define MFQ(C,kk,qv,Cin) C=__builtin_amdgcn_mfma_f32_32x32x16_bf16(kf[kk],qv,Cin,0,0,0)
  #define GAPA(MF,A0,A1,A2,A3,W0,W1,PW) do{ MF; sacc+=A0; sacc+=A1; sacc+=A2; sacc+=A3; PIN(sacc); W0; W1; PIN(PW); SBAR(); }while(0)
  #define EX(v) __builtin_amdgcn_exp2f((v)-mhat)
  #define GAPB(MF,X,B) do{ MF; X[B]=EX(X[B]); X[B+1]=EX(X[B+1]); PIN(X); SBAR(); }while(0)
  #define VRD(i) do{ vlo[(i)&7]=vtr(vp_+(((i)>>2)*4096+((i)&3)*1024)); vhi[(i)&7]=vtr(vp_+(((i)>>2)*4096+((i)&3)*1024+512)); }while(0)
  #define KRD(G,j) do{ if(G){ kload2(kf,kp0+sl_next,j); SBAR(); } }while(0)
  #define STEP(C0,C1,P0,P1,t,GK,GV,GL) do{ SBAR(); \
    const lds_cptr vp_=vp0+2*sl_prev; const f32x16 z16={}; bf16x8 qf; \
    VRD(0); qf=QF(0); SBAR(); float sacc=(P0[0]+P0[1]); \
    GAPA(MFQ(C0,0,qf,z16), P0[2],P0[3],P0[4],P0[5],     pw0[0]=PKW(P0,0), pw0[1]=PKW(P0,2), pw0); \
    VRD(4); SBAR(); GAPA(MFQ(C1,1,qf,z16), P0[6],P0[7],P0[8],P0[9],     pw0[2]=PKW(P0,4), pw0[3]=PKW(P0,6), pw0); \
    VRD(1); qf=QF(1); SBAR(); GAPA(MFQ(C0,2,qf,C0),   P0[10],P0[11],P0[12],P0[13], pw1[0]=PKW(P0,8), pw1[1]=PKW(P0,10), pw1); \
    VRD(5); SBAR(); GAPA(MFQ(C1,3,qf,C1),   P0[14],P0[15],P1[0],P1[1],   pw1[2]=PKW(P0,12),pw1[3]=PKW(P0,14), pw1); \
    VRD(2); qf=QF(2); SBAR(); GAPA(MFQ(C0,4,qf,C0),   P1[2],P1[3],P1[4],P1[5],     pw2[0]=PKW(P1,0), pw2[1]=PKW(P1,2), pw2); \
    VRD(6); SBAR(); GAPA(MFQ(C1,5,qf,C1),   P1[6],P1[7],P1[8],P1[9],     pw2[2]=PKW(P1,4), pw2[3]=PKW(P1,6), pw2); \
    VRD(3); qf=QF(3); SBAR(); GAPA(MFQ(C0,6,qf,C0),   P1[10],P1[11],P1[12],P1[13], pw3[0]=PKW(P1,8), pw3[1]=PKW(P1,10), pw3); \
    VRD(7); SBAR(); GAPA(MFQ(C1,7,qf,C1),   P1[14],P1[15],0.f,0.f,       pw3[2]=PKW(P1,12),pw3[3]=PKW(P1,14), pw3); \
    l_reg+=sacc; \
    if(GK){DMA_K((t)+3,sl_cur);} if(GV){DMA_V((t)+1,sl_next);} \
    CMASK(C0,C1,t); \
    { float a=MX3(C0[0],C0[1],C1[0]),b=MX3(C0[2],C0[3],C1[1]); a=MX3(a,C1[2],C1[3]); \
      _Pragma("unroll") for(int r=4;r<16;r+=4){a=MX3(a,C0[r],C0[r+1]);b=MX3(b,C0[r+2],C0[r+3]);a=MX3(a,C1[r],C1[r+1]);b=MX3(b,C1[r+2],C1[r+3]);} \
      float rm=__builtin_fmaxf(a,b); { auto rr=__builtin_amdgcn_permlane32_swap(__float_as_uint(rm),__float_as_uint(rm),false,false); rm=__builtin_fmaxf(__uint_as_float(rr[0]),__uint_as_float(rr[1])); } \
      rm-=mhat; resc=false; \
      if(__builtin_expect(__any(rm>(float)THRL),0)){ const float dl=__builtin_fmaxf(rm,0.f); mhat+=dl; \
        const float f=__builtin_amdgcn_exp2f(-dl); l_reg*=f; if(hi==0)wsf[r32]=f; resc=true; } } \
    SBAR(); \
    GAPB(o[0]=__builtin_amdgcn_mfma_f32_32x32x16_bf16(PAF(0),VFR(0),o[0],0,0,0), C0,0);  VRD(8);  SBAR(); \
    GAPB(o[1]=__builtin_amdgcn_mfma_f32_32x32x16_bf16(PAF(0),VFR(4),o[1],0,0,0), C0,2);  VRD(12); SBAR(); \
    GAPB(o[0]=__builtin_amdgcn_mfma_f32_32x32x16_bf16(PAF(1),VFR(1),o[0],0,0,0), C0,4);  VRD(9);  SBAR(); \
    GAPB(o[1]=__builtin_amdgcn_mfma_f32_32x32x16_bf16(PAF(1),VFR(5),o[1],0,0,0), C0,6);  VRD(13); SBAR(); \
    GAPB(o[0]=__builtin_amdgcn_mfma_f32_32x32x16_bf16(PAF(2),VFR(2),o[0],0,0,0), C0,8);  VRD(10); SBAR(); \
    GAPB(o[1]=__builtin_amdgcn_mfma_f32_32x32x16_bf16(PAF(2),VFR(6),o[1],0,0,0), C0,10); VRD(14); SBAR(); \
    GAPB(o[0]=__builtin_amdgcn_mfma_f32_32x32x16_bf16(PAF(3),VFR(3),o[0],0,0,0), C0,12); VRD(11); SBAR(); \
    GAPB(o[1]=__builtin_amdgcn_mfma_f32_32x32x16_bf16(PAF(3),VFR(7),o[1],0,0,0), C0,14); VRD(15); SBAR(); \
    GAPB(o[2]=__builtin_amdgcn_mfma_f32_32x32x16_bf16(PAF(0),VFR(0),o[2],0,0,0), C1,0); \
    GAPB(o[3]=__builtin_amdgcn_mfma_f32_32x32x16_bf16(PAF(0),VFR(4),o[3],0,0,0), C1,2); \
    KRD(GL,0); GAPB(o[2]=__builtin_amdgcn_mfma_f32_32x32x16_bf16(PAF(1),VFR(1),o[2],0,0,0), C1,4); \
    KRD(GL,1); GAPB(o[3]=__builtin_amdgcn_mfma_f32_32x32x16_bf16(PAF(1),VFR(5),o[3],0,0,0), C1,6); \
    KRD(GL,2); GAPB(o[2]=__builtin_amdgcn_mfma_f32_32x32x16_bf16(PAF(2),VFR(2),o[2],0,0,0), C1,8); \
    KRD(GL,3); GAPB(o[3]=__builtin_amdgcn_mfma_f32_32x32x16_bf16(PAF(2),VFR(6),o[3],0,0,0), C1,10); \
    GAPB(o[2]=__builtin_amdgcn_mfma_f32_32x32x16_bf16(PAF(3),VFR(3),o[2],0,0,0), C1,12); \
    GAPB(o[3]=__builtin_amdgcn_mfma_f32_32x32x16_bf16(PAF(3),VFR(7),o[3],0,0,0), C1,14); \
    }while(0)
  int t=1;
  #undef CMASK
  #define CMASK(P0,P1,t) do{}while(0)
  for(;t+7<NT;t+=2){
    STEP(pB0,pB1,pA0,pA1,t,true,true,true);     WAIT_BAR(3); RESC(); ROT();
    STEP(pA0,pA1,pB0,pB1,t+1,true,true,true);   WAIT_BAR(3); RESC(); ROT();
  }
  #undef CMASK
  #define CMASK(P0,P1,t) do{int jb_=(t)-(NT-6); if(jb_>=0)biasmask(P0,P1,jb_,qrel,hi,lut);}while(0)
  #define ENDW(tt) do{ if((tt)+3<NT){WAIT_BAR(3);} else if((tt)+2<NT){WAIT_BAR(2);} else {WAIT_BAR(0);} }while(0)
  for(;t+1<NT;t+=2){
    STEP(pB0,pB1,pA0,pA1,t,(t+3<NT),(t+1<NT),(t+1<NT));       ENDW(t);   RESC(); ROT();
    STEP(pA0,pA1,pB0,pB1,t+1,(t+4<NT),(t+2<NT),(t+2<NT));     ENDW(t+1); RESC(); ROT();
  }
  STEP(pB0,pB1,pA0,pA1,NT-1,false,false,false); RESC();
  { float sacc=pB0[0]+pB0[1]; _Pragma("unroll") for(int r=2;r<16;++r)sacc+=pB0[r]; _Pragma("unroll") for(int r=0;r<16;++r)sacc+=pB1[r]; l_reg+=sacc;
    pw0=(u32x4){PKW(pB0,0),PKW(pB0,2),PKW(pB0,4),PKW(pB0,6)};pw1=(u32x4){PKW(pB0,8),PKW(pB0,10),PKW(pB0,12),PKW(pB0,14)};pw2=(u32x4){PKW(pB1,0),PKW(pB1,2),PKW(pB1,4),PKW(pB1,6)};pw3=(u32x4){PKW(pB1,8),PKW(pB1,10),PKW(pB1,12),PKW(pB1,14)};
    SBAR();
    const int vb=vb0+2*sl_cur;
    #pragma unroll
    for(int d0=0;d0<4;++d0){s16x4 lo[4],hh[4];
      #pragma unroll
      for(int ks=0;ks<4;++ks){
        asm volatile("ds_read_b64_tr_b16 %0,%1 offset:%c2":"=&v"(lo[ks]):"v"(vb),"i"(d0*4096+ks*1024):"memory");
        asm volatile("ds_read_b64_tr_b16 %0,%1 offset:%c2":"=&v"(hh[ks]):"v"(vb),"i"(d0*4096+ks*1024+512):"memory");}
      asm volatile("s_waitcnt lgkmcnt(0)":::"memory");SBAR();
      #define PK(k) (bf16x8){lo[k][0],lo[k][1],lo[k][2],lo[k][3],hh[k][0],hh[k][1],hh[k][2],hh[k][3]}
      o[d0]=__builtin_amdgcn_mfma_f32_32x32x16_bf16(PAF(0),PK(0),o[d0],0,0,0);
      o[d0]=__builtin_amdgcn_mfma_f32_32x32x16_bf16(PAF(1),PK(1),o[d0],0,0,0);
      o[d0]=__builtin_amdgcn_mfma_f32_32x32x16_bf16(PAF(2),PK(2),o[d0],0,0,0);
      o[d0]=__builtin_amdgcn_mfma_f32_32x32x16_bf16(PAF(3),PK(3),o[d0],0,0,0);
      #undef PK
    } }
  #undef PKW
  #undef PAF
  #undef VFR
  #undef PIN
  #undef MX3
  #undef MFQ
  #undef GAPA
  #undef GAPB
  #undef EX
  #undef VRD
  #undef KRD
  #undef STEP
  #undef ENDW
  #undef QF
  {auto rr=__builtin_amdgcn_permlane32_swap(__float_as_uint(l_reg),__float_as_uint(l_reg),false,false);l_reg=__uint_as_float(rr[0])+__uint_as_float(rr[1]);}
  if(hi==0)wsf[32+r32]=l_reg;asm volatile("s_waitcnt lgkmcnt(0)":::"memory");
  float rli[16];
  #pragma unroll
  for(int r=0;r<16;++r)rli[r]=__builtin_amdgcn_rcpf(wsf[32+crow(r,hi)]);
  bf16*Ow=O+(rowbase+q0+wid*QBLK)*PO;
  { bf16*stg=(bf16*)(shm+L2_QO)+wid*2048;
    #pragma unroll
    for(int hh=0;hh<2;++hh){
      #pragma unroll
      for(int r=0;r<16;++r){const int orow=crow(r,hi);
        #pragma unroll
        for(int d0=0;d0<2;++d0)stg[orow*64+d0*32+r32]=__float2bfloat16(o[2*hh+d0][r]*rli[r]);}
      asm volatile("s_waitcnt lgkmcnt(0)":::"memory");
      #pragma unroll
      for(int i=0;i<4;++i){const int row=i*8+(lane>>3),ch=lane&7; const u32x4 v=*(const u32x4*)(stg+row*64+ch*8); *(u32x4*)(Ow+(long)row*PO+hh*64+ch*8)=v;}
      asm volatile("s_waitcnt lgkmcnt(0)":::"memory"); } }
  asm volatile("s_waitcnt lgkmcnt(0)\n\ts_barrier":::"memory");
  #undef DMA_K
  #undef DMA_V
  #undef CMASK
  #undef RESC
  #undef ROT
}

constexpr int ATTN_LDS_BYTES=LDS_BYTES;
#undef SBAR
#undef WAIT_BAR
}
constexpr int NWAVES = 8;
typedef unsigned short bf16;
typedef unsigned v4u __attribute__((ext_vector_type(4)));
typedef unsigned v2u __attribute__((ext_vector_type(2)));
typedef float f32x4 __attribute__((ext_vector_type(4)));
typedef float f32x2 __attribute__((ext_vector_type(2)));
typedef short bf16x8 __attribute__((ext_vector_type(8)));
typedef GAS unsigned gu32;
#define RLX_AGENT __ATOMIC_RELAXED, __HIP_MEMORY_SCOPE_AGENT
#define LDS_WAIT() asm volatile("s_waitcnt lgkmcnt(0)" ::: "memory")
#define VM_WAIT() asm volatile("s_waitcnt vmcnt(0)" ::: "memory")
__device__ __forceinline__ unsigned f2bf(float f) { unsigned u = __builtin_bit_cast(unsigned, f); return (u + 0x7fffu + ((u >> 16) & 1u)) >> 16; }
__device__ __forceinline__ unsigned pk2(float lo, float hi) { return f2bf(lo) | (f2bf(hi) << 16); }
__device__ __forceinline__ float bf2f(unsigned short b) { return __builtin_bit_cast(float, (unsigned)b << 16); }
__device__ __forceinline__ float bflo(unsigned w) { return __builtin_bit_cast(float, w << 16); }
__device__ __forceinline__ float bfhi(unsigned w) { return __builtin_bit_cast(float, w & 0xffff0000u); }

#define XB_TMO      128
#define XB_XCNT(j)  (256  + 64 * (j))
#define XB_XSUB(j)  (1280 + 64 * (j))
#define XB_XGEN(j)  (2304 + 64 * (j))
#define XB_TOP      3328
#define XB_TOPGEN   3392
#define XCD_BAR_WORDS 3456
#define XB_SPIN_CAP (1u << 18)
__device__ __forceinline__ unsigned xb_ld(unsigned* p)              { return __hip_atomic_load(p, __ATOMIC_RELAXED, __HIP_MEMORY_SCOPE_AGENT); }
__device__ __forceinline__ unsigned xb_add(unsigned* p, unsigned v) { return __hip_atomic_fetch_add(p, v, __ATOMIC_RELAXED, __HIP_MEMORY_SCOPE_AGENT); }
__device__ __forceinline__ unsigned xb_xcc_id() { return (unsigned)__builtin_amdgcn_s_getreg((3 << 11) | 20) & 0xFu; }
#define XB_SPIN(cond, bar) do { unsigned _sp = 0; while (cond) { __builtin_amdgcn_s_sleep(1); \
    if ((++_sp & 255u) == 0u) { if (xb_ld(&(bar)[XB_TMO])) break; if (_sp > XB_SPIN_CAP) { atomicAdd(&(bar)[XB_TMO], 1u); break; } } } } while (0)
struct XcdBarrier { unsigned* bar; unsigned x; volatile LAS unsigned* st; };
__device__ __forceinline__ XcdBarrier xcd_barrier_post(unsigned* bar, volatile LAS unsigned* st) {
    XcdBarrier b; b.bar = bar; b.x = xb_xcc_id(); b.st = st;
    if (threadIdx.x == 0) (void)xb_add(&bar[XB_XCNT(b.x)], 1u);
    return b;
}
__device__ __forceinline__ void xcd_barrier_complete(unsigned* bar, unsigned x, unsigned& nloc, unsigned& nx) {
    const unsigned G = gridDim.x * gridDim.y * gridDim.z;
    unsigned sum, cnt, mine, sp = 0u;
    for (;;) {
        sum = 0u; cnt = 0u; mine = 0u;
#pragma unroll
        for (unsigned j = 0; j < 16; ++j) { const unsigned c = xb_ld(&bar[XB_XCNT(j)]); sum += c; cnt += (c > 0u) ? 1u : 0u; mine = (j == x) ? c : mine; }
        if (sum == G) break;
        __builtin_amdgcn_s_sleep(1);
        if ((++sp & 255u) == 0u) { if (xb_ld(&bar[XB_TMO])) break; if (sp > XB_SPIN_CAP) { atomicAdd(&bar[XB_TMO], 1u); break; } }
    }
    nloc = mine > 0u ? mine : 1u; nx = cnt > 0u ? cnt : 1u;
}
__device__ __forceinline__ void xcd_barrier(const XcdBarrier& b) {
    asm volatile("s_waitcnt vmcnt(0)" ::: "memory");
    __syncthreads();
    if (threadIdx.x == 0) {
        unsigned* bar = b.bar;
        __builtin_amdgcn_s_waitcnt(0);
        unsigned nloc = b.st[0], nx = b.st[1];
        if (nloc == 0u) { xcd_barrier_complete(bar, b.x, nloc, nx); b.st[0] = nloc; b.st[1] = nx; }
        const unsigned old = xb_add(&bar[XB_XSUB(b.x)], 1u);
        const unsigned gen = old / nloc;
        if (old + 1u == (gen + 1u) * nloc) {
            __builtin_amdgcn_fence(__ATOMIC_RELEASE, "agent");
            asm volatile("s_waitcnt vmcnt(0)" ::: "memory");
            const unsigned og = xb_add(&bar[XB_TOP], 1u);
            const unsigned tg = og / nx;
            if (og + 1u == (tg + 1u) * nx) xb_add(&bar[XB_TOPGEN], 1u);
            else XB_SPIN(xb_ld(&bar[XB_TOPGEN]) == tg, bar);
            __builtin_amdgcn_fence(__ATOMIC_ACQUIRE, "agent");
            xb_add(&bar[XB_XGEN(b.x)], 1u);
            asm volatile("s_waitcnt vmcnt(0)" ::: "memory");
        } else {
            XB_SPIN(xb_ld(&bar[XB_XGEN(b.x)]) == gen, bar);
            __builtin_amdgcn_fence(__ATOMIC_ACQUIRE, "agent");
            asm volatile("s_waitcnt vmcnt(0)" ::: "memory");
        }
    }
    __syncthreads();
}

struct Args { const float* in[18]; float* out; unsigned char* ws; int ph_lo, ph_hi, li, pad; };
struct Frame {
    LAS unsigned char* lds;
    gu32* ctl;
    unsigned char* ws;
    int tid, lane, wave;
    int vcu, G;
};

__device__ __forceinline__ float wave_sum(float v) {
#pragma unroll
    for (int o = 1; o < 64; o <<= 1) v += __shfl_xor(v, o);
    return v;
}
__device__ __forceinline__ void transpose_block(const float* src, int ld_src, bf16* dst, int ld_dst, LAS float* scr, int lane, bf16* dst2) {
#pragma unroll 8
    for (int i = 0; i < 32; ++i) { const int kk = 2 * i + (lane >> 5); scr[kk * 33 + (lane & 31)] = src[(size_t)kk * ld_src + (lane & 31)]; }
    LDS_WAIT(); asm volatile("" ::: "memory");
    const int c = lane & 7;
#pragma unroll
    for (int j = 0; j < 4; ++j) { const int n = (lane >> 3) + 8 * j; const LAS float* s = scr + (8 * c) * 33 + n;
        v4u o; o.x = pk2(s[0 * 33], s[1 * 33]); o.y = pk2(s[2 * 33], s[3 * 33]); o.z = pk2(s[4 * 33], s[5 * 33]); o.w = pk2(s[6 * 33], s[7 * 33]);
        *(GAS v4u*)(dst + (size_t)n * ld_dst + 8 * c) = o;
        if (dst2) *(GAS v4u*)(dst2 + (size_t)n * ld_dst + 8 * c) = o; }
    LDS_WAIT(); asm volatile("" ::: "memory");
}
__device__ __forceinline__ unsigned pk4_fp8f(float a, float b, float c, float d) { int w = 0; w = __builtin_amdgcn_cvt_pk_fp8_f32(a, b, w, false); w = __builtin_amdgcn_cvt_pk_fp8_f32(c, d, w, true); return (unsigned)w; }
__device__ __forceinline__ void transpose_block8(const float* src, int ld_src, unsigned char* dst, int ld_dst, float sc, LAS float* scr, int lane, unsigned char* dst2 = nullptr) {
#pragma unroll 8
    for (int i = 0; i < 32; ++i) { const int kk = 2 * i + (lane >> 5); scr[kk * 33 + (lane & 31)] = src[(size_t)kk * ld_src + (lane & 31)]; }
    LDS_WAIT(); asm volatile("" ::: "memory");
    const int c = lane & 7;
#pragma unroll
    for (int j = 0; j < 4; ++j) { const int n = (lane >> 3) + 8 * j; const LAS float* s = scr + (8 * c) * 33 + n;
        v2u o; o.x = pk4_fp8f(s[0 * 33] * sc, s[1 * 33] * sc, s[2 * 33] * sc, s[3 * 33] * sc); o.y = pk4_fp8f(s[4 * 33] * sc, s[5 * 33] * sc, s[6 * 33] * sc, s[7 * 33] * sc);
        *(GAS v2u*)(dst + (size_t)n * ld_dst + 8 * c) = o;
        if (dst2) *(GAS v2u*)(dst2 + (size_t)n * ld_dst + 8 * c) = o; }
    LDS_WAIT(); asm volatile("" ::: "memory");
}
__device__ __forceinline__ void rms_row_to_bf16(int lane, const float* xrow, const float* g, bf16* orow) {
    const GAS f32x4* xr = (const GAS f32x4*)xrow + lane; const GAS f32x4* gr = (const GAS f32x4*)g + lane;
    f32x4 v[4]; float s = 0.f;
#pragma unroll
    for (int j = 0; j < 4; ++j) { v[j] = xr[64 * j]; s += (v[j].x * v[j].x + v[j].y * v[j].y) + (v[j].z * v[j].z + v[j].w * v[j].w); }
    const float rstd = 1.0f / sqrtf(wave_sum(s) * (1.f / 1024.f) + RMS_EPS);
    GAS v2u* o8 = (GAS v2u*)orow + lane;
#pragma unroll
    for (int j = 0; j < 4; ++j) { const f32x4 gg = gr[64 * j]; v2u o; o.x = pk2(v[j].x * rstd * gg.x, v[j].y * rstd * gg.y); o.y = pk2(v[j].z * rstd * gg.z, v[j].w * rstd * gg.w); o8[64 * j] = o; }
}

__device__ __forceinline__ void rms_row_to_fp8(int lane, const float* xrow, const float* g, unsigned char* orow) {
    const GAS f32x4* xr = (const GAS f32x4*)xrow + lane; const GAS f32x4* gr = (const GAS f32x4*)g + lane;
    f32x4 v[4]; float s = 0.f;
#pragma unroll
    for (int j = 0; j < 4; ++j) { v[j] = xr[64 * j]; s += (v[j].x * v[j].x + v[j].y * v[j].y) + (v[j].z * v[j].z + v[j].w * v[j].w); }
    const float rstd = H8_SCALE / sqrtf(wave_sum(s) * (1.f / 1024.f) + RMS_EPS);
    GAS unsigned* o4 = (GAS unsigned*)orow + lane;
#pragma unroll
    for (int j = 0; j < 4; ++j) { const f32x4 gg = gr[64 * j]; o4[64 * j] = pk4_fp8f(v[j].x * rstd * gg.x, v[j].y * rstd * gg.y, v[j].z * rstd * gg.z, v[j].w * rstd * gg.w); }
}
constexpr int IT_WIN0 = (1024 / 64) * (3072 / 32);
constexpr int IT_WOUT0 = (1024 / 64) * (1024 / 32);
constexpr int IT_RIN = (1024 / 64) * (6144 / 32);
constexpr int IT_ROUT = (2048 / 64) * (1024 / 32);
constexpr int IT_SHARED = IT_WIN0 + IT_WOUT0 + IT_RIN + IT_ROUT;
constexpr int IT_EXP = 3 * 256;
constexpr int IT_MOE = NEXP * IT_EXP;
__device__ __forceinline__ void conv_shared_item(Frame& F, const Args& a, int it, LAS float* scr) {
    unsigned char* ws = F.ws;
    if (it < IT_WIN0) { const int nblk = 96, kb = it / nblk, nb = it % nblk;
        if (QKV_FP8) transpose_block8(a.in[5] + (size_t)(64 * kb) * 3072 + 32 * nb, 3072, ws + WS_WINT0 + (size_t)(32 * nb) * 1024 + 64 * kb, 1024, WIN_SCALE, scr, F.lane);
        else transpose_block(a.in[5] + (size_t)(64 * kb) * 3072 + 32 * nb, 3072, (bf16*)(ws + WS_WINT0) + (size_t)(32 * nb) * 1024 + 64 * kb, 1024, scr, F.lane, nullptr);
        return; }
    it -= IT_WIN0;
    if (it < IT_WOUT0) { const int nblk = 32, kb = it / nblk, nb = it % nblk;
        transpose_block(a.in[8] + (size_t)(64 * kb) * 1024 + 32 * nb, 1024, (bf16*)(ws + WS_WOUTT0) + (size_t)(32 * nb) * 1024 + 64 * kb, 1024, scr, F.lane, nullptr); return; }
    it -= IT_WOUT0;
    if (it < IT_RIN) { const int nblk = 192, kb = it / nblk, nb = it % nblk, n0 = 32 * nb;
        unsigned char* A = ws + WS_WRINA; unsigned char* B = ws + WS_WRINB; unsigned char *d1, *d2 = nullptr;
        if (n0 < 2048) d1 = A + (size_t)n0 * 1024;
        else if (n0 < 4096) d1 = B + (size_t)(n0 - 2048) * 1024;
        else d1 = A + (size_t)(n0 - 2048) * 1024;
        transpose_block8(a.in[9] + (size_t)(64 * kb) * 6144 + n0, 6144, d1 + 64 * kb, 1024, WIN_SCALE, scr, F.lane, d2 ? d2 + 64 * kb : nullptr); return; }
    it -= IT_RIN;
    { const int nblk = 32, kb = it / nblk, nb = it % nblk;
        transpose_block(a.in[10] + (size_t)(64 * kb) * 1024 + 32 * nb, 1024, (bf16*)(ws + WS_WROUTT) + (size_t)(32 * nb) * 2048 + 64 * kb, 2048, scr, F.lane, nullptr); }
}
__device__ __forceinline__ void conv_moe_item(Frame& F, const Args& a, int layer, int it, LAS float* scr) {
    unsigned char* ws = F.ws;
    const int e = it / IT_EXP; int r = it % IT_EXP; const size_t le = (size_t)layer * NEXP + e;
    if (r < 512) { const int up = r >> 8; r &= 255; const int kb = r / 16, nb = r % 16, n0 = 32 * nb;
        const float* src = a.in[up ? 16 : 15] + le * (1024 * 512) + (size_t)(64 * kb) * 512 + n0;
        const int drow = 256 * (n0 >> 7) + 128 * up + (n0 & 127);
        transpose_block8(src, 512, ws + WS_W1CAT + ((size_t)e * 1024 + drow) * 1024 + 64 * kb, 1024, W1_SCALE, scr, F.lane); return; }
    r -= 512; { const int kb = r / 32, nb = r % 32;
        const float* src = a.in[17] + le * (512 * 1024) + (size_t)(64 * kb) * 1024 + 32 * nb;
        transpose_block8(src, 1024, ws + WS_W2T + ((size_t)e * 1024 + 32 * nb) * 512 + 64 * kb, 512, W2_SCALE, scr, F.lane); }
}
__device__ __forceinline__ void build_router_frags(Frame& F, const Args& a, int gtid, int gthreads) {
    bf16* wrf = (bf16*)(F.ws + WS_WRF);
    for (int idx = gtid; idx < 2 * 32 * 3 * 64 * 8; idx += gthreads) {
        const int j = idx & 7, lane = (idx >> 3) & 63, nt = (idx >> 9) % 3, s = ((idx >> 9) / 3) & 31, L = (idx >> 9) / 96;
        const int k = 32 * s + 8 * (lane >> 4) + j, o = 16 * nt + (lane & 15);
        float w = 0.f;
        if (o < 4) w = a.in[11][((size_t)L * 1024 + k) * 4 + o]; else if (o < 36) w = a.in[13][((size_t)L * 1024 + k) * 32 + (o - 4)];
        w *= a.in[3][L * 1024 + k];
        const unsigned hi = f2bf(w); const float lo = w - __builtin_bit_cast(float, hi << 16);
        const size_t base = ((((size_t)L * 32 + s) * 3 + nt) * 2) * 512 + (size_t)lane * 8 + j;
        wrf[base] = (bf16)hi; wrf[base + 512] = (bf16)f2bf(lo);
    }
}
__device__ __forceinline__ void build_sincos(Frame& F, int gtid, int gthreads) {
    float* t1 = (float*)(F.ws + WS_SINCOS);
    for (int idx = gtid; idx < SEQ * 128; idx += gthreads) {
        const int pos = idx >> 7, i = idx & 127;
        double ang = 1.0, bs = 0.9300449458481391;
        for (int bit = 0; bit < 7; ++bit) { if ((i >> bit) & 1) ang *= bs; bs *= bs; }
        const double ph = (double)pos * ang;
        const double kq = __builtin_rint(ph * 0.63661977236758134308);
        double r = __builtin_fma(-kq, 1.57079632679489655800, ph); r = __builtin_fma(-kq, 6.12323399573676603587e-17, r);
        const double r2 = r * r;
        double sn = r * (1.0 + r2 * (-1.0 / 6 + r2 * (1.0 / 120 + r2 * (-1.0 / 5040 + r2 * (1.0 / 362880 + r2 * (-1.0 / 39916800 + r2 * (1.0 / 6227020800.0)))))));
        double cs = 1.0 + r2 * (-0.5 + r2 * (1.0 / 24 + r2 * (-1.0 / 720 + r2 * (1.0 / 40320 + r2 * (-1.0 / 3628800 + r2 * (1.0 / 479001600.0 + r2 * (-1.0 / 87178291200.0)))))));
        const int q = ((int)kq) & 3;
        double s_ = (q == 0) ? sn : (q == 1) ? cs : (q == 2) ? -sn : -cs;
        double c_ = (q == 0) ? cs : (q == 1) ? -sn : (q == 2) ? -cs : sn;
        t1[(size_t)idx * 2] = (float)c_; t1[(size_t)idx * 2 + 1] = (float)s_;
    }
}
__device__ __forceinline__ void p_prologue(Frame& F, const Args& a) {
    LAS float* scr = (LAS float*)(F.lds + RING_OFF + F.wave * 16384);
    const int gw = F.vcu * NWAVES + F.wave, NGW = F.G * NWAVES;
    for (int it = gw; it < IT_SHARED + IT_MOE; it += NGW) { if (it < IT_SHARED) conv_shared_item(F, a, it, scr); else conv_moe_item(F, a, 0, it - IT_SHARED, scr); }
    build_router_frags(F, a, F.vcu * 512 + F.tid, F.G * 512);
    build_sincos(F, F.vcu * 512 + F.tid, F.G * 512);
    for (int m = gw; m < TOK; m += NGW) { if (QKV_FP8) rms_row_to_fp8(F.lane, a.in[0] + (size_t)m * DM, a.in[2], F.ws + WS_HB + (size_t)m * DM); else rms_row_to_bf16(F.lane, a.in[0] + (size_t)m * DM, a.in[2], (bf16*)(F.ws + WS_HB) + (size_t)m * DM); }
}
__device__ __forceinline__ void p_attention(Frame& F, const Args& a) {
    LAS float* lut = (LAS float*)(F.lds + LX_LUT);
    const attn_body::bf16* QKV = (const attn_body::bf16*)(F.ws + WS_QKV0);
    const float* lq = a.in[6];
    const float lam = __expf(wave_sum(lq[F.lane] * lq[64 + F.lane])) - __expf(wave_sum(lq[128 + F.lane] * lq[192 + F.lane])) + 0.2f;
    for (int v = F.vcu; v < 256; v += F.G) {
        const int bh = v >> 2, s = v & 3, b = bh >> 3, h = bh & 7;
        __syncthreads();
        for (int idx = F.tid; idx < 672; idx += 512) { const int n = idx - 288; float val = 0.f;
            if (n < 0) val = -INFINITY;
            else if (n < 113) { int bk = n; if (n >= 16) { bk = 16; const int thr[15] = {19, 21, 24, 27, 31, 35, 40, 46, 52, 59, 67, 77, 87, 99, 113};
#pragma unroll
                for (int q = 0; q < 15; ++q) bk += (n >= thr[q]) ? 1 : 0; }
                val = (a.in[1][bk * 8 + h] - a.in[1][31 * 8 + h]) * LOG2E; }
            lut[idx] = val; }
        __syncthreads();
#pragma nounroll
        for (int i = 0; i < 4; ++i) {
            const int qb = (i < 2) ? 7 - s : s, m = i & 1;
            attn_body::bf16* O = (attn_body::bf16*)(F.ws + WS_OP) + (size_t)m * TOK * 1024 + h * 128;
            attn_body::attn_unit128<8>(b, qb, QKV, h * 128 + m * 64, 1024 + h * 128 + m * 64, 2048 + h * 128, O, lut, (char*)F.lds + RING_OFF);
            if ((i & 1) == 1) {
                VM_WAIT(); __syncthreads();
                int t_ = threadIdx.x; asm volatile("" : "+v"(t_));
                const int row = b * SEQ + qb * 256 + (t_ >> 1), c0 = h * 128 + (t_ & 1) * 64;
                const bf16* O0 = (const bf16*)(F.ws + WS_OP) + (size_t)row * 1024 + c0; const bf16* O1 = O0 + (size_t)TOK * 1024; bf16* AO = (bf16*)(F.ws + WS_AO) + (size_t)row * 1024 + c0;
                const float* sg = a.in[7] + (t_ & 1) * 64;
                float ss = 0.f; v4u wa[8], wb[8];
#pragma unroll
                for (int q = 0; q < 8; ++q) { wa[q] = ((const GAS v4u*)O0)[q]; wb[q] = ((const GAS v4u*)O1)[q]; }
#pragma unroll
                for (int q = 0; q < 8; ++q) { const unsigned xa[4] = {wa[q].x, wa[q].y, wa[q].z, wa[q].w}, xb[4] = {wb[q].x, wb[q].y, wb[q].z, wb[q].w};
#pragma unroll
                    for (int j = 0; j < 4; ++j) { const float o0 = bflo(xa[j]) - lam * bflo(xb[j]), o1 = bfhi(xa[j]) - lam * bfhi(xb[j]); ss += o0 * o0 + o1 * o1; } }
                ss += __shfl_xor(ss, 1);
                const float rstd = 0.8f / sqrtf(ss * (1.f / 128.f) + SUBLN_EPS);
#pragma unroll
                for (int q = 0; q < 8; ++q) { const unsigned xa[4] = {wa[q].x, wa[q].y, wa[q].z, wa[q].w}, xb[4] = {wb[q].x, wb[q].y, wb[q].z, wb[q].w}; unsigned r[4];
                    const f32x4 g0 = *(const GAS f32x4*)(sg + q * 8), g1 = *(const GAS f32x4*)(sg + q * 8 + 4); const float gg[8] = {g0.x, g0.y, g0.z, g0.w, g1.x, g1.y, g1.z, g1.w};
#pragma unroll
                    for (int j = 0; j < 4; ++j) r[j] = pk2((bflo(xa[j]) - lam * bflo(xb[j])) * rstd * gg[2 * j], (bfhi(xa[j]) - lam * bfhi(xb[j])) * rstd * gg[2 * j + 1]);
                    v4u o; o.x = r[0]; o.y = r[1]; o.z = r[2]; o.w = r[3]; ((GAS v4u*)AO)[q] = o; }
            }
        }
    }
}
__device__ __forceinline__ void p_diffcombine(Frame& F, const Args& a) {
    const int gw = F.vcu * NWAVES + F.wave, NGW = F.G * NWAVES, lane = F.lane;
    const float* lq = a.in[6];
    const float lam = __expf(wave_sum(lq[lane] * lq[64 + lane])) - __expf(wave_sum(lq[128 + lane] * lq[192 + lane])) + 0.2f;
    const int d0 = (lane & 7) * 16; float g[16];
#pragma unroll
    for (int j = 0; j < 16; ++j) g[j] = a.in[7][d0 + j] * 0.8f;
    const bf16* O0 = (const bf16*)(F.ws + WS_OP); const bf16* O1 = O0 + (size_t)TOK * 1024; bf16* AO = (bf16*)(F.ws + WS_AO);
    for (int m = gw; m < TOK; m += NGW) {
        const GAS v4u* p0 = (const GAS v4u*)(O0 + (size_t)m * 1024 + lane * 16); const GAS v4u* p1 = (const GAS v4u*)(O1 + (size_t)m * 1024 + lane * 16);
        const v4u a0 = p0[0], a1 = p0[1], b0 = p1[0], b1 = p1[1];
        const unsigned wa[8] = {a0.x, a0.y, a0.z, a0.w, a1.x, a1.y, a1.z, a1.w}, wb[8] = {b0.x, b0.y, b0.z, b0.w, b1.x, b1.y, b1.z, b1.w};
        float o[16]; float ss = 0.f;
#pragma unroll
        for (int j = 0; j < 8; ++j) { o[2 * j] = bflo(wa[j]) - lam * bflo(wb[j]); o[2 * j + 1] = bfhi(wa[j]) - lam * bfhi(wb[j]); ss += o[2 * j] * o[2 * j] + o[2 * j + 1] * o[2 * j + 1]; }
        ss += __shfl_xor(ss, 1); ss += __shfl_xor(ss, 2); ss += __shfl_xor(ss, 4);
        const float rstd = 1.0f / sqrtf(ss * (1.f / 128.f) + SUBLN_EPS);
        v4u w0, w1;
        w0.x = pk2(o[0] * rstd * g[0], o[1] * rstd * g[1]); w0.y = pk2(o[2] * rstd * g[2], o[3] * rstd * g[3]); w0.z = pk2(o[4] * rstd * g[4], o[5] * rstd * g[5]); w0.w = pk2(o[6] * rstd * g[6], o[7] * rstd * g[7]);
        w1.x = pk2(o[8] * rstd * g[8], o[9] * rstd * g[9]); w1.y = pk2(o[10] * rstd * g[10], o[11] * rstd * g[11]); w1.z = pk2(o[12] * rstd * g[12], o[13] * rstd * g[13]); w1.w = pk2(o[14] * rstd * g[14], o[15] * rstd * g[15]);
        GAS v4u* po = (GAS v4u*)(AO + (size_t)m * 1024 + lane * 16); po[0] = w0; po[1] = w1;
    }
}
template <int LAYER> __device__ __forceinline__ void p_router(Frame& F, const Args& a, const bf16* xres, int bank = LAYER) {
    typedef float f32x4v __attribute__((ext_vector_type(4)));
    LAS float* part = (LAS float*)(F.lds + RING_OFF);
    LAS float* ssqp = (LAS float*)(F.lds + RING_OFF + 98304);
    LAS float* logit = (LAS float*)(F.lds + RING_OFF + 100352);
    LAS float* rstd_s = (LAS float*)(F.lds + RING_OFF + 109568);
    LAS int* lcnt = (LAS int*)(F.lds + RING_OFF + 109824);
    LAS int* lbase = (LAS int*)(F.lds + RING_OFF + 109952);
    const int lane = F.lane, w = F.wave, row = lane & 15, kg = lane >> 4;
    const bf16x8* wrf = (const bf16x8*)(F.ws + WS_WRF) + (size_t)LAYER * (32 * 3 * 2 * 64);
    bf16x8 Bh[4][3], Bl[4][3];
#pragma unroll
    for (int s = 0; s < 4; ++s)
#pragma unroll
        for (int nt = 0; nt < 3; ++nt) { Bh[s][nt] = wrf[(((4 * w + s) * 3 + nt) * 2 + 0) * 64 + lane]; Bl[s][nt] = wrf[(((4 * w + s) * 3 + nt) * 2 + 1) * 64 + lane]; }
    const float* gffn = a.in[3] + LAYER * 1024; const float* bg = a.in[12] + LAYER * 4; const float* be = a.in[14] + LAYER * 32;
    int* list = (int*)(F.ws + WS_LIST); float* pairw = (float*)(F.ws + WS_PAIRW); bf16* HB = (bf16*)(F.ws + WS_HB);
    for (int tb = F.vcu; tb < TOK / 64; tb += F.G) {
        __syncthreads();
        if (F.tid < 32) lcnt[F.tid] = 0;
        f32x4v acc[4][3];
#pragma unroll
        for (int mt = 0; mt < 4; ++mt)
#pragma unroll
            for (int nt = 0; nt < 3; ++nt) acc[mt][nt] = (f32x4v){0.f, 0.f, 0.f, 0.f};
#pragma unroll
        for (int mt = 0; mt < 4; ++mt) { const bf16* xr = xres + (size_t)(tb * 64 + mt * 16 + row) * DM + 128 * w + 8 * kg; float ss = 0.f;
#pragma unroll
            for (int s = 0; s < 4; ++s) { const v4u xw = *(const GAS v4u*)(xr + 32 * s); const bf16x8 ah = __builtin_bit_cast(bf16x8, xw);
                const unsigned xv[4] = {xw.x, xw.y, xw.z, xw.w};
#pragma unroll
                for (int j = 0; j < 4; ++j) { const float x0 = bflo(xv[j]), x1 = bfhi(xv[j]); ss += x0 * x0 + x1 * x1; }
#pragma unroll
                for (int nt = 0; nt < 3; ++nt) { acc[mt][nt] = __builtin_amdgcn_mfma_f32_16x16x32_bf16(ah, Bh[s][nt], acc[mt][nt], 0, 0, 0);
                    acc[mt][nt] = __builtin_amdgcn_mfma_f32_16x16x32_bf16(ah, Bl[s][nt], acc[mt][nt], 0, 0, 0); } }
            ss += __shfl_xor(ss, 16); ss += __shfl_xor(ss, 32);
            if (kg == 0) ssqp[w * 64 + mt * 16 + row] = ss;
#pragma unroll
            for (int nt = 0; nt < 3; ++nt)
#pragma unroll
                for (int r = 0; r < 4; ++r) part[(w * 64 + mt * 16 + 4 * kg + r) * 48 + nt * 16 + row] = acc[mt][nt][r]; }
        __syncthreads();
        if (F.tid < 64) { float s = 0.f;
#pragma unroll
            for (int q = 0; q < 8; ++q) s += ssqp[q * 64 + F.tid];
            rstd_s[F.tid] = 1.0f / sqrtf(s * (1.f / 1024.f) + RMS_EPS); }
        __syncthreads();
        for (int idx = F.tid; idx < 64 * 36; idx += 512) { const int tk = idx / 36, o = idx % 36; float s = 0.f;
#pragma unroll
            for (int q = 0; q < 8; ++q) s += part[(q * 64 + tk) * 48 + o];
            logit[tk * 36 + o] = s * rstd_s[tk] + (o < 4 ? bg[o] : be[o - 4]); }
        __syncthreads();
        if (w == 0) {
            const LAS float* lg = logit + lane * 36;
            int gi = 0; float gm = lg[0];
#pragma unroll
            for (int j = 1; j < 4; ++j) { const float v = lg[j]; if (v > gm) { gm = v; gi = j; } }
            float gs = 0.f;
#pragma unroll
            for (int j = 0; j < 4; ++j) gs += __expf(lg[j] - gm);
            const float gp = 1.0f / gs;
            const LAS float* le = lg + 4 + gi * 8;
            int i1 = 0; float v1 = le[0];
#pragma unroll
            for (int j = 1; j < 8; ++j) { const float v = le[j]; if (v > v1) { v1 = v; i1 = j; } }
            int i2 = -1; float v2 = -INFINITY;
#pragma unroll
            for (int j = 0; j < 8; ++j) { const float v = le[j]; if (j != i1 && v > v2) { v2 = v; i2 = j; } }
            const float e2 = __expf(v2 - v1), w1 = gp / (1.0f + e2), w2 = gp * e2 / (1.0f + e2);
            const int e_1 = gi * 8 + i1, e_2 = gi * 8 + i2;
            const int r1 = __hip_atomic_fetch_add(lcnt + e_1, 1, __ATOMIC_RELAXED, __HIP_MEMORY_SCOPE_WORKGROUP);
            const int r2 = __hip_atomic_fetch_add(lcnt + e_2, 1, __ATOMIC_RELAXED, __HIP_MEMORY_SCOPE_WORKGROUP);
            LDS_WAIT();
            if (lane < 32) { const int c = lcnt[lane]; int bs = 0; if (c > 0) bs = (int)__hip_atomic_fetch_add((unsigned*)(F.ctl + CW_CNT + (bank * 32 + lane) * 64), (unsigned)c, RLX_AGENT); lbase[lane] = bs; }
            LDS_WAIT();
            const int tg = tb * 64 + lane; const int p1 = lbase[e_1] + r1, p2 = lbase[e_2] + r2;
            list[e_1 * LISTCAP + p1] = 2 * tg; list[e_2 * LISTCAP + p2] = 2 * tg + 1; pairw[2 * tg] = w1; pairw[2 * tg + 1] = w2;
        }
        for (int i = 0; i < 8; ++i) { const int tk = w * 8 + i, tg = tb * 64 + tk; const float rs8 = rstd_s[tk] * H8_SCALE;
            const GAS v2u* xr = (const GAS v2u*)(xres + (size_t)tg * DM) + lane; const GAS f32x4* gr = (const GAS f32x4*)gffn + lane; GAS unsigned* o4 = (GAS unsigned*)((unsigned char*)HB + (size_t)tg * DM) + lane;
#pragma unroll
            for (int j = 0; j < 4; ++j) { const v2u v = xr[64 * j]; const f32x4 gg = gr[64 * j]; o4[64 * j] = pk4_fp8f(bflo(v.x) * rs8 * gg.x, bfhi(v.x) * rs8 * gg.y, bflo(v.y) * rs8 * gg.z, bfhi(v.y) * rs8 * gg.w); } }
    }
}
template <int LAYER> __device__ __forceinline__ void moe_setup(Frame& F) {
    LAS int* tstart = (LAS int*)(F.lds + LX_TSTART); LAS int* texp = (LAS int*)(F.lds + LX_TEXP); LAS int* lc = (LAS int*)(F.lds + LX_CNT);
    __syncthreads();
    if (F.tid < 32) { int c = (int)__hip_atomic_load((unsigned*)(F.ctl + CW_CNT + (LAYER * 32 + F.tid) * 64), RLX_AGENT); c = c < 0 ? 0 : (c > LISTCAP ? LISTCAP : c); lc[F.tid] = c; }
    __syncthreads();
    if (F.tid == 0) { int acc = 0; for (int e = 0; e < 32; ++e) { tstart[e] = acc; acc += (lc[e] + 255) >> 8; } if (acc > MAXRT) acc = MAXRT; tstart[32] = acc; tstart[33] = acc; }
    __syncthreads();
    if (F.tid < MAXRT) { int e = 0;
#pragma unroll 1
        for (int q = 1; q < 32; ++q) if (tstart[q] <= F.tid) e = q;
        texp[F.tid] = e; }
    __syncthreads();
}
template <int LAYER> __device__ __forceinline__ void p_moe1(Frame& F) {
    moe_setup<LAYER>(F);
    const LAS int* tstart = (const LAS int*)(F.lds + LX_TSTART); const LAS int* texp = (const LAS int*)(F.lds + LX_TEXP); const LAS int* lc = (const LAS int*)(F.lds + LX_CNT);
    LAS int* rowtab = (LAS int*)(F.lds + LX_ROWTAB);
    pg8::MoeOrder S{F.G, F.vcu, 512, 0, tstart, texp};
    const int* list = (const int*)(F.ws + WS_LIST);
    pg8::Unit u;
    for (int i = 0; i < 4 && S.next(i, u); ++i) { if (F.tid < 256) { const int e = u.pn >> 2, pos = u.aux * 256 + F.tid; rowtab[i * 256 + F.tid] = (pos < lc[e]) ? (list[e * LISTCAP + pos] >> 1) : 0; } }
    VM_WAIT(); __syncthreads();
    pg8::Gemm g{(const bf16*)(F.ws + WS_HB), (const bf16*)(F.ws + WS_W1CAT), 512, 512, 512};
    pg8::EpiMoe1 E{(unsigned char*)(F.ws + WS_MACT)};
    pg8::gemm_phase<pg8::EpiMoe1, pg8::MoeOrder, true, true, true>(F.lds + RING_OFF, g, S, E, rowtab);
}
template <int LAYER> __device__ __forceinline__ void p_moe2(Frame& F) {
    moe_setup<LAYER>(F);
    const LAS int* tstart = (const LAS int*)(F.lds + LX_TSTART); const LAS int* texp = (const LAS int*)(F.lds + LX_TEXP); const LAS int* lc = (const LAS int*)(F.lds + LX_CNT);
    pg8::MoeOrder S{F.G, F.vcu, 256, 256 * 256, tstart, texp};
    pg8::Gemm g{(const bf16*)(F.ws + WS_MACT), (const bf16*)(F.ws + WS_W2T), 256, 256, 256};
    pg8::EpiMoe2 E{(unsigned char*)(F.ws + WS_Y), (const int*)(F.ws + WS_LIST), (const float*)(F.ws + WS_PAIRW), lc};
    pg8::gemm_phase<pg8::EpiMoe2, pg8::MoeOrder, true, false, true>(F.lds + RING_OFF, g, S, E, nullptr);
}
template <bool FINAL> __device__ __forceinline__ void p_combine(Frame& F, const bf16* xin, bf16* xout, float* outf, const float* g) {
    typedef float f2v __attribute__((ext_vector_type(2)));
    const int gw = F.vcu * NWAVES + F.wave, NGW = F.G * NWAVES, lane = F.lane;
    const unsigned char* Y = F.ws + WS_Y; unsigned char* HB = F.ws + WS_HB;
    f32x4 gg[4];
#pragma unroll
    for (int j = 0; j < 4; ++j) gg[j] = ((const GAS f32x4*)g + lane)[64 * j];
    v2u cx[4], nx[4]; unsigned cp[4], cq[4], np[4], nq[4];
#define CMB_LOAD(X, P, Q, m_) do { const GAS v2u* xr_ = (const GAS v2u*)(xin + (size_t)(m_) * DM) + lane; const GAS unsigned* y0_ = (const GAS unsigned*)(Y + (size_t)(2 * (m_)) * DM) + lane; const GAS unsigned* y1_ = (const GAS unsigned*)(Y + (size_t)(2 * (m_) + 1) * DM) + lane; \
        _Pragma("unroll") for (int j = 0; j < 4; ++j) { X[j] = xr_[64 * j]; P[j] = y0_[64 * j]; Q[j] = y1_[64 * j]; } } while (0)
    int m = gw;
    if (m < TOK) CMB_LOAD(cx, cp, cq, m);
    for (; m < TOK; m += NGW) {
        const int mn = m + NGW;
        if (mn < TOK) CMB_LOAD(nx, np, nq, mn);
        f32x4 v[4]; float s = 0.f; constexpr float ys = 1.0f / Y_SCALE;
#pragma unroll
        for (int j = 0; j < 4; ++j) { const v2u x = cx[j]; const f2v p0 = __builtin_amdgcn_cvt_pk_f32_fp8((int)cp[j], false), p1 = __builtin_amdgcn_cvt_pk_f32_fp8((int)cp[j], true), q0 = __builtin_amdgcn_cvt_pk_f32_fp8((int)cq[j], false), q1 = __builtin_amdgcn_cvt_pk_f32_fp8((int)cq[j], true);
            v[j].x = bflo(x.x) + (p0.x + q0.x) * ys; v[j].y = bfhi(x.x) + (p0.y + q0.y) * ys; v[j].z = bflo(x.y) + (p1.x + q1.x) * ys; v[j].w = bfhi(x.y) + (p1.y + q1.y) * ys;
            s += (v[j].x * v[j].x + v[j].y * v[j].y) + (v[j].z * v[j].z + v[j].w * v[j].w); }
        const float rstd = 1.0f / sqrtf(wave_sum(s) * (1.f / 1024.f) + RMS_EPS);
        if (FINAL) { GAS f32x4* xw = (GAS f32x4*)(outf + (size_t)m * DM) + lane;
#pragma unroll
            for (int j = 0; j < 4; ++j) { f32x4 o; o.x = v[j].x * rstd * gg[j].x; o.y = v[j].y * rstd * gg[j].y; o.z = v[j].z * rstd * gg[j].z; o.w = v[j].w * rstd * gg[j].w; xw[64 * j] = o; }
        } else { GAS v2u* xw = (GAS v2u*)(xout + (size_t)m * DM) + lane;
            GAS unsigned* o4 = (GAS unsigned*)(HB + (size_t)m * DM) + lane; const float r8 = rstd * H8_SCALE;
#pragma unroll
            for (int j = 0; j < 4; ++j) { v2u xo; xo.x = pk2(v[j].x, v[j].y); xo.y = pk2(v[j].z, v[j].w); xw[64 * j] = xo; o4[64 * j] = pk4_fp8f(v[j].x * r8 * gg[j].x, v[j].y * r8 * gg[j].y, v[j].z * r8 * gg[j].z, v[j].w * r8 * gg[j].w); }
        }
#pragma unroll
        for (int j = 0; j < 4; ++j) { cx[j] = nx[j]; cp[j] = np[j]; cq[j] = nq[j]; }
    }
#undef CMB_LOAD
}
__device__ __forceinline__ void p_scan(Frame& F) {
    const bf16* DS = (const bf16*)(F.ws + WS_DS); bf16* BT = (bf16*)(F.ws + WS_BTCAT);
    for (int gidx = F.vcu * 512 + F.tid; gidx < NB * RH * 16384; gidx += F.G * 512) {
        const int bh = gidx >> 14, e8 = gidx & 16383, dv = e8 >> 5, dk0 = (e8 & 31) * 8, h = bh & 3;
        const float cd = __builtin_amdgcn_exp2f(256.0f * pg8::log2_gamma(h));
        v4u d[7];
#pragma unroll
        for (int n = 0; n < 7; ++n) d[n] = *(const GAS v4u*)(DS + ((size_t)(bh * RNC + n) * RDV + dv) * RDK + dk0);
        float s[8];
#pragma unroll
        for (int j = 0; j < 8; ++j) s[j] = 0.f;
#pragma unroll
        for (int n = 0; n < 8; ++n) {
            v4u o; o.x = pk2(s[0], s[1]); o.y = pk2(s[2], s[3]); o.z = pk2(s[4], s[5]); o.w = pk2(s[6], s[7]);
            *(GAS v4u*)(BT + ((size_t)(bh * RNC + n) * RDV + dv) * 512 + 256 + dk0) = o;
            if (n < 7) { const unsigned wv[4] = {d[n].x, d[n].y, d[n].z, d[n].w};
#pragma unroll
                for (int j = 0; j < 4; ++j) { s[2 * j] = cd * (s[2 * j] + bflo(wv[j])); s[2 * j + 1] = cd * (s[2 * j + 1] + bfhi(wv[j])); } }
        }
    }
}
__device__ __forceinline__ void p_normgate(Frame& F, bf16* dry = nullptr) {
    const int gw = F.vcu * NWAVES + F.wave, NGW = F.G * NWAVES, lane = F.lane;
    const bf16* OR = (const bf16*)(F.ws + WS_ORET); bf16* SG = (bf16*)(F.ws + WS_SG);
    for (int m = gw; m < TOK; m += NGW) {
        const GAS v4u* po = (const GAS v4u*)(OR + (size_t)m * 2048 + lane * 32); GAS v4u* pg = (GAS v4u*)(SG + (size_t)m * 2048 + lane * 32); GAS v4u* pw = dry ? (GAS v4u*)(dry + (size_t)m * 2048 + lane * 32) : pg;
        v4u ov[4], gv[4]; float ss = 0.f;
#pragma unroll
        for (int q = 0; q < 4; ++q) { ov[q] = po[q]; gv[q] = pg[q]; }
#pragma unroll
        for (int q = 0; q < 4; ++q) { const unsigned wv[4] = {ov[q].x, ov[q].y, ov[q].z, ov[q].w};
#pragma unroll
            for (int j = 0; j < 4; ++j) { const float x0 = bflo(wv[j]), x1 = bfhi(wv[j]); ss += x0 * x0 + x1 * x1; } }
        ss += __shfl_xor(ss, 1); ss += __shfl_xor(ss, 2); ss += __shfl_xor(ss, 4); ss += __shfl_xor(ss, 8);
        const float rstd = 1.0f / sqrtf(ss * (1.f / 512.f) + RMS_EPS);
#pragma unroll
        for (int q = 0; q < 4; ++q) { const unsigned wv[4] = {ov[q].x, ov[q].y, ov[q].z, ov[q].w}, wg[4] = {gv[q].x, gv[q].y, gv[q].z, gv[q].w}; unsigned r[4];
#pragma unroll
            for (int j = 0; j < 4; ++j) r[j] = pk2(bflo(wv[j]) * rstd * bflo(wg[j]), bfhi(wv[j]) * rstd * bfhi(wg[j]));
            v4u o; o.x = r[0]; o.y = r[1]; o.z = r[2]; o.w = r[3]; pw[q] = o; }
    }
}
__device__ __forceinline__ void p_conv_moe1(Frame& F, const Args& a) {
    LAS float* scr = (LAS float*)(F.lds + RING_OFF + F.wave * 16384);
    const int gw = F.vcu * NWAVES + F.wave, NGW = F.G * NWAVES;
    for (int it = gw; it < IT_MOE; it += NGW) conv_moe_item(F, a, 1, it, scr);
}

constexpr int N_PHASES = 19;
#ifndef MK_PER_PHASE
#define MK_PER_PHASE 0
#endif
__global__ void __launch_bounds__(NWAVES * 64, 2) hybrid_fwd(Args args) {
    extern __shared__ __attribute__((aligned(16))) unsigned char lds[];
    Frame F;
    F.lds = (LAS unsigned char*)lds;
    F.tid = threadIdx.x; F.lane = F.tid & 63; F.wave = __builtin_amdgcn_readfirstlane(F.tid >> 6);
    F.G = gridDim.x; { const int bx = blockIdx.x; F.vcu = (F.G % 8 == 0) ? (bx % 8) * (F.G / 8) + bx / 8 : bx; }
    F.ws = args.ws; F.ctl = (gu32*)(args.ws + WS_CTL);
    for (int u = F.tid; u < (LDS_BYTES - LX_OFF) / 4; u += NWAVES * 64) ((LAS unsigned*)(F.lds + LX_OFF))[u] = 0u;
    __syncthreads();
    XcdBarrier bar; bar.bar = (unsigned*)(F.ctl + CW_BAR); bar.x = 0; bar.st = nullptr;
    if (!MK_PER_PHASE) bar = xcd_barrier_post((unsigned*)(F.ctl + CW_BAR), (volatile LAS unsigned*)(F.lds + LX_MISC) + 8);
    const int lo = args.ph_lo, hi = args.ph_hi;
#ifndef PH_MASK
#define PH_MASK 0x7ffff
#endif
#define IN(k) (((PH_MASK >> (k)) & 1) && lo <= (k) && (k) < hi)
#define SEAM(k) do { if (IN(k) && IN((k) + 1)) xcd_barrier(bar); } while (0)
#define REFRESH() do { int t_ = threadIdx.x; asm volatile("" : "+v"(t_)); F.tid = t_; F.lane = t_ & 63; } while (0)
#ifndef DUP_MASK
#define DUP_MASK 0
#endif
#ifndef XBAR_N
#define XBAR_N 0
#endif
#define DUP(k) (((DUP_MASK >> (k)) & 1) != 0)
    bf16* xb = (bf16*)args.out;
    bf16* x3 = (bf16*)(args.ws + WS_X3);
    unsigned char* ws = args.ws;
    const int bx = (int)blockIdx.x;

    if (IN(0)) { REFRESH(); p_prologue(F, args); if (DUP(0)) { xcd_barrier(bar); p_prologue(F, args); } for (int q = 0; q < XBAR_N; ++q) xcd_barrier(bar); } SEAM(0);
    if (IN(1)) { REFRESH(); for (int rep_ = 0; rep_ < (DUP(1) ? 2 : 1); ++rep_) { if (rep_) xcd_barrier(bar);
        constexpr int KQ = QKV_FP8 ? 512 : 1024; pg8::Gemm g{(const bf16*)(ws + WS_HB), (const bf16*)(ws + WS_WINT0), KQ, KQ, KQ}; pg8::StaticOrder S; S.init(TOK, 3072, F.G, bx, KQ, KQ);
        pg8::EpiQKV E{(bf16*)(ws + WS_QKV0), ATT_C2};
        pg8::gemm_phase<pg8::EpiQKV, pg8::StaticOrder, true, false, (QKV_FP8 != 0)>(F.lds + RING_OFF, g, S, E, nullptr);
    }
    } SEAM(1);
    if (IN(2)) { REFRESH(); p_attention(F, args); if (DUP(2)) { xcd_barrier(bar); p_attention(F, args); } } if (IN(2) && IN(4)) xcd_barrier(bar);
    if (IN(4)) { REFRESH();
        pg8::Gemm g{(const bf16*)(ws + WS_AO), (const bf16*)(ws + WS_WOUTT0), 1024, 1024, 1024}; pg8::StaticOrder S; S.init(TOK, 1024, F.G, bx, 1024, 1024);
        pg8::EpiResB<true> E{args.in[0], xb};
        pg8::gemm_phase<pg8::EpiResB<true>, pg8::StaticOrder, true, false>(F.lds + RING_OFF, g, S, E, nullptr);
    } SEAM(4);
    if (IN(5)) { REFRESH(); p_router<0>(F, args, xb); } SEAM(5);
    if (IN(6)) { REFRESH(); p_moe1<0>(F); if (DUP(6)) { xcd_barrier(bar); p_moe1<0>(F); } } SEAM(6);
    if (IN(7)) { REFRESH(); p_moe2<0>(F); if (DUP(7)) { xcd_barrier(bar); p_moe2<0>(F); } } SEAM(7);
    if (IN(8)) { REFRESH(); p_combine<false>(F, xb, xb, nullptr, args.in[2] + 1024); } SEAM(8);
    if (IN(9)) { REFRESH(); for (int rep_ = 0; rep_ < (DUP(9) ? 2 : 1); ++rep_) { if (rep_) xcd_barrier(bar);
        { pg8::Gemm g{(const bf16*)(ws + WS_HB), (const bf16*)(ws + WS_WRINA), 512, 512, 512}; pg8::StaticOrder S; S.init(TOK, 4096, F.G, bx, 512, 512);
          pg8::EpiRetA E{(bf16*)(ws + WS_ACAT), (bf16*)(ws + WS_KI), (bf16*)(ws + WS_SG), (const float*)(ws + WS_SINCOS), (bf16*)(ws + WS_KIT)};
          pg8::gemm_phase<pg8::EpiRetA, pg8::StaticOrder, true, false, true>(F.lds + RING_OFF, g, S, E, nullptr); }
        { pg8::Gemm g{(const bf16*)(ws + WS_WRINB), (const bf16*)(ws + WS_HB), 512, 512, 512}; pg8::StaticOrder S; S.init(2048, TOK, F.G, bx, 512, 512);
          pg8::EpiRetB E{(bf16*)(ws + WS_BTCAT)};
          pg8::gemm_phase<pg8::EpiRetB, pg8::StaticOrder, true, false, true>(F.lds + RING_OFF, g, S, E, nullptr); }
    }
    } SEAM(9);
    if (IN(10)) { REFRESH(); for (int rep_ = 0; rep_ < (DUP(10) ? 2 : 1); ++rep_) { if (rep_) xcd_barrier(bar);
        { pg8::Gemm g{(const bf16*)(ws + WS_ACAT), (const bf16*)(ws + WS_KI), 512, 1024, 256}; pg8::ScoresOrder S{F.G, F.vcu};
          pg8::EpiScores E{(bf16*)(ws + WS_ACAT)};
          pg8::gemm_phase<pg8::EpiScores, pg8::ScoresOrder, true, false>(F.lds + RING_OFF, g, S, E, nullptr); }
        { pg8::Gemm g{(const bf16*)(ws + WS_BTCAT), (const bf16*)(ws + WS_KIT), 512, 2048, 256}; pg8::DsOrder S{F.G, F.vcu};
          pg8::EpiDS E{(bf16*)(ws + WS_DS)};
          pg8::gemm_phase<pg8::EpiDS, pg8::DsOrder, true, false>(F.lds + RING_OFF, g, S, E, nullptr); }
    }
    } SEAM(10);
    if (IN(11)) { REFRESH(); p_scan(F); if (DUP(11)) { xcd_barrier(bar); p_scan(F); } } SEAM(11);
    if (IN(12)) { REFRESH(); for (int rep_ = 0; rep_ < (DUP(12) ? 2 : 1); ++rep_) { if (rep_) xcd_barrier(bar);
        pg8::Gemm g{(const bf16*)(ws + WS_ACAT), (const bf16*)(ws + WS_BTCAT), 512, 512, 512}; pg8::RetOOrder S{F.G, F.vcu};
        pg8::EpiRetO E{(bf16*)(ws + WS_ORET), (bf16*)(ws + WS_SG), (LAS float*)(F.lds + LX_SSQ)};
        pg8::gemm_phase<pg8::EpiRetO, pg8::RetOOrder, true, false>(F.lds + RING_OFF, g, S, E, nullptr);
    }
    } if (IN(12) && IN(14)) xcd_barrier(bar);
    if (IN(14)) { REFRESH();
        pg8::Gemm g{(const bf16*)(ws + WS_SG), (const bf16*)(ws + WS_WROUTT), 2048, 2048, 2048}; pg8::StaticOrder S; S.init(TOK, 1024, F.G, bx, 2048, 2048);
        pg8::EpiResB<false> E{xb, x3};
        pg8::gemm_phase<pg8::EpiResB<false>, pg8::StaticOrder, true, false>(F.lds + RING_OFF, g, S, E, nullptr);
    } SEAM(14);
    if (IN(15)) { REFRESH(); p_router<1>(F, args, x3); __syncthreads(); p_conv_moe1(F, args); } SEAM(15);
    if (IN(16)) { REFRESH(); p_moe1<1>(F); } SEAM(16);
    if (IN(17)) { REFRESH(); p_moe2<1>(F); } SEAM(17);
    if (IN(18)) { REFRESH(); p_combine<true>(F, x3, nullptr, args.out, args.in[4]); }
#undef IN
#undef SEAM
}

extern "C" void kernel_launch(void* const* d_in, const int* in_sizes, int n_in, void* d_out, int out_size, void* d_ws, size_t ws_size, hipStream_t stream) {
    static int grid = 0;
    if (grid == 0) {
        if (n_in != 18 || in_sizes[0] != TOK * DM || out_size != TOK * DM || ws_size < WS_END) { fprintf(stderr, "kernel_launch: unexpected shapes / workspace (n_in %d, in0 %d, out %d, ws %zu < %zu); nothing launched\n", n_in, n_in > 0 ? in_sizes[0] : -1, out_size, ws_size, (size_t)WS_END); grid = -1; return; }
        int dev = 0, cus = 0, per_cu = 0;
        if (hipGetDevice(&dev) != hipSuccess || hipDeviceGetAttribute(&cus, hipDeviceAttributeMultiprocessorCount, dev) != hipSuccess) { grid = -1; return; }
        if (hipFuncSetAttribute((const void*)hybrid_fwd, hipFuncAttributeMaxDynamicSharedMemorySize, LDS_BYTES) != hipSuccess) { fprintf(stderr, "kernel_launch: hipFuncSetAttribute failed\n"); grid = -1; return; }
        if (hipOccupancyMaxActiveBlocksPerMultiprocessor(&per_cu, (const void*)hybrid_fwd, NWAVES * 64, LDS_BYTES) != hipSuccess || per_cu < 1) { fprintf(stderr, "kernel_launch: occupancy query says %d\n", per_cu); }
        (void)hipGetLastError();
        grid = cus > 256 ? 256 : cus;
    }
    if (grid < 0) return;
    if (hipMemsetAsync((char*)d_ws + WS_CTL, 0, CTL_ZERO_BYTES, stream) != hipSuccess) return;
    Args a{};
    for (int i = 0; i < 18; ++i) a.in[i] = (const float*)d_in[i];
    a.out = (float*)d_out; a.ws = (unsigned char*)d_ws; a.pad = 0;
#if MK_PER_PHASE
    for (int p = 0; p < N_PHASES; ++p) { a.ph_lo = p; a.ph_hi = p + 1; a.li = p; hipLaunchKernelGGL(hybrid_fwd, dim3(grid), dim3(NWAVES * 64), LDS_BYTES, stream, a); }
#else
    a.ph_lo = 0; a.ph_hi = N_PHASES; a.li = 0;
    hipLaunchKernelGGL(hybrid_fwd, dim3(grid), dim3(NWAVES * 64), LDS_BYTES, stream, a);
#endif
}
```

```cpp
#include <hip/hip_runtime.h>
#include <hip/hip_bf16.h>
#include <cstdio>
#include <cstdint>

#define LAS __attribute__((address_space(3)))
#define GAS __attribute__((address_space(1)))

namespace pg8 {
typedef unsigned short bf16_t;
typedef short bf16x8 __attribute__((ext_vector_type(8)));
typedef float f32x4 __attribute__((ext_vector_type(4)));
typedef float f32x2 __attribute__((ext_vector_type(2)));
typedef unsigned u32x4 __attribute__((ext_vector_type(4)));
typedef unsigned u32x2 __attribute__((ext_vector_type(2)));
constexpr int BM = 256, BK = 64, HALF = 128, HTB = HALF * BK * 2, STAGE_BYTES = 8 * HTB, NXCD = 8, WGM = 8;

__host__ __device__ __forceinline__ int lds_byte(int r, int c) { const int st = (r >> 4) * 2 + (c >> 5), rr = r & 15, cc = c & 31, ob = rr * 64 + cc * 2; return st * 1024 + (ob ^ (((ob >> 9) & 1) << 5)); }
__host__ __device__ __forceinline__ void stage_rc(int b, int& R, int& C) { const int st = b / 1024, sb = b % 1024, swz = sb ^ (((sb >> 9) & 1) << 5); R = (st >> 1) * 16 + swz / 64; C = (st & 1) * 32 + (swz % 64) / 2; }
__host__ __device__ __forceinline__ int perm32(int rho) { const int n = rho >> 4, i = rho & 15; return 8 * (i >> 2) + 4 * n + (i & 3); }

struct Unit { int pm, pn, aux; long aoff, boff; };
struct Gemm { const bf16_t* A; const bf16_t* Bt; int lda, ldb, K; };

struct StaticOrder {
    int nM, nN, nwg, G, c, lda, ldb;
    __device__ void init(int M, int N, int G_, int c_, int lda_, int ldb_) { nM = M / BM; nN = N / BM; nwg = nM * nN; G = G_; c = c_; lda = lda_; ldb = ldb_; }
    __device__ bool next(int i, Unit& u) const {
        const long L = (long)i * G + c; if (L >= nwg) return false;
        int wgid = (int)L; { const int q = nwg / NXCD, r = nwg % NXCD, xcd = wgid % NXCD, off = wgid / NXCD; wgid = (xcd < r ? xcd * (q + 1) : r * (q + 1) + (xcd - r) * q) + off; }
        const int nig = WGM * nN, gid = wgid / nig, fm = gid * WGM, gsz = (nM - fm) < WGM ? (nM - fm) : WGM;
        u.pm = fm + ((wgid % nig) % gsz); u.pn = (wgid % nig) / gsz; u.aux = 0;
        u.aoff = (long)u.pm * BM * lda; u.boff = (long)u.pn * BM * ldb; return true;
    }
};

__device__ __forceinline__ unsigned cvt_pk_bf16(float lo, float hi) { unsigned r; asm volatile("v_cvt_pk_bf16_f32 %0, %1, %2" : "=v"(r) : "v"(lo), "v"(hi)); return r; }
__device__ __forceinline__ u32x4 pack8(const f32x4 v0, const f32x4 v1) { u32x4 w; w.x = cvt_pk_bf16(v0[0], v0[1]); w.y = cvt_pk_bf16(v0[2], v0[3]); w.z = cvt_pk_bf16(v1[0], v1[1]); w.w = cvt_pk_bf16(v1[2], v1[3]); return w; }

typedef int v4i_t __attribute__((ext_vector_type(4)));
typedef int v8i_t __attribute__((ext_vector_type(8)));
__device__ __forceinline__ v8i_t cat8(const bf16x8 a, const bf16x8 b) { const v4i_t x = __builtin_bit_cast(v4i_t, a), y = __builtin_bit_cast(v4i_t, b); return __builtin_shufflevector(x, y, 0, 1, 2, 3, 4, 5, 6, 7); }
template <class Epi, class Sched, bool ALIGN_EPI, bool GATHER, bool FP8 = false>
__device__ __forceinline__ void gemm_phase(LAS unsigned char* lds, const Gemm g, const Sched& S, const Epi& E, const LAS int* rowtab) {
    int tid_ = threadIdx.x; asm volatile("" : "+v"(tid_));
    const int tid = tid_, wid = __builtin_amdgcn_readfirstlane(tid >> 6), lane = tid & 63, wr = wid >> 2, wc = wid & 3, fr = lane & 15, fq = lane >> 4;
    const int K = g.K, nt = K / BK;
    int sR[2], sC[2]; unsigned voffB[2];
#pragma unroll
    for (int i = 0; i < 2; ++i) { int R, C; stage_rc(tid * 16 + i * 8192, R, C); sR[i] = R; sC[i] = C; const int Rb = Epi::PERM ? ((R & ~31) + perm32(R & 31)) : R; voffB[i] = (unsigned)(Rb * g.ldb + C) * 2u; }
    unsigned avo[2][2], navo[2][2];
#define PG8_SETOFF(o, ui_) do { _Pragma("unroll") for (int h_ = 0; h_ < 2; ++h_) _Pragma("unroll") for (int i_ = 0; i_ < 2; ++i_) { const int row_ = h_ * HALF + sR[i_]; \
        const int grow_ = GATHER ? rowtab[(ui_) * BM + row_] : row_; o[h_][i_] = (unsigned)(grow_ * g.lda + sC[i_]) * 2u; } } while (0)
    const size_t kstep = (size_t)(BK * 2);
    const size_t hstepB = (size_t)HALF * g.ldb * 2;
    const unsigned ldsw = (unsigned)wid * 1024u;
    const int aoff = lds_byte(wr * 64 + fr, fq * 8), boff = lds_byte(wc * 32 + fr, fq * 8);
#define PG8_SA(b, h) (((b) * 2 + (h)) * HTB)
#define PG8_SB(b, h) ((4 + (b) * 2 + (h)) * HTB)
#define PG8_STAGE(bufoff, gbase, voff) do { _Pragma("unroll") for (int _i = 0; _i < 2; ++_i) \
        __builtin_amdgcn_global_load_lds((const unsigned*)((const char*)(gbase) + (voff)[_i]), (LAS unsigned*)(lds + (bufoff) + ldsw + _i * 8192), 16, 0, 0); } while (0)
#define PG8_LD8(dst8, addr_) do { const v4i_t lo_ = *(const LAS v4i_t*)(addr_), hi_ = *(const LAS v4i_t*)((addr_) + 1024); dst8 = __builtin_shufflevector(lo_, hi_, 0, 1, 2, 3, 4, 5, 6, 7); } while (0)
#define PG8_LDA(dst, b, h) do { _Pragma("unroll") for (int m = 0; m < 4; ++m) { if constexpr (FP8) { PG8_LD8(dst##8[m], lds + PG8_SA(b, h) + aoff + m * 2048); } else { _Pragma("unroll") for (int k = 0; k < 2; ++k) dst[m][k] = *(const LAS bf16x8*)(lds + PG8_SA(b, h) + aoff + m * 2048 + k * 1024); } } } while (0)
#define PG8_LDB(dst, b, h) do { _Pragma("unroll") for (int n = 0; n < 2; ++n) { if constexpr (FP8) { PG8_LD8(dst##8[n], lds + PG8_SB(b, h) + boff + n * 2048); } else { _Pragma("unroll") for (int k = 0; k < 2; ++k) dst[n][k] = *(const LAS bf16x8*)(lds + PG8_SB(b, h) + boff + n * 2048 + k * 1024); } } } while (0)
#define PG8_MMA(ai, bj, At, Bt) do { __builtin_amdgcn_s_setprio(1); _Pragma("unroll") for (int m = 0; m < 4; ++m) _Pragma("unroll") for (int n = 0; n < 2; ++n) { \
        if constexpr (FP8) asm volatile("v_mfma_scale_f32_16x16x128_f8f6f4 %0, %1, %2, %0, %3, %3 op_sel_hi:[0,0,0]" : "+v"(acc[ai][bj][m][n]) : "v"(Bt##8[n]), "v"(At##8[m]), "v"(sc1)); \
        else { _Pragma("unroll") for (int k = 0; k < 2; ++k) acc[ai][bj][m][n] = __builtin_amdgcn_mfma_f32_16x16x32_bf16(Bt[n][k], At[m][k], acc[ai][bj][m][n], 0, 0, 0); } } \
        __builtin_amdgcn_s_setprio(0); } while (0)
#define PG8_WAIT_V(n) asm volatile("s_waitcnt vmcnt(" #n ")" ::: "memory")
#define PG8_WAIT_L(n) asm volatile("s_waitcnt lgkmcnt(" #n ")" ::: "memory")
#define PG8_BAR __builtin_amdgcn_s_barrier()
#define PG8_SCHED __builtin_amdgcn_sched_barrier(0)
    unsigned sc1 = 0; if constexpr (FP8) asm volatile("v_mov_b32 %0, 0x7f7f7f7f\n\ts_nop 4" : "=v"(sc1));
    Unit cur, nxt; int ui = 0;
    if (!S.next(0, cur)) return;
    f32x4 acc[2][2][4][2];
#pragma unroll
    for (int a = 0; a < 2; ++a)
#pragma unroll
        for (int b = 0; b < 2; ++b)
#pragma unroll
            for (int m = 0; m < 4; ++m)
#pragma unroll
                for (int n = 0; n < 2; ++n) acc[a][b][m][n] = (f32x4){0.f, 0.f, 0.f, 0.f};
    bf16x8 At[4][2], B0[2][2], B1[2][2]; v8i_t At8[4], B08[2], B18[2];
    const char* cA = (const char*)g.A + cur.aoff * 2; const char* cB = (const char*)g.Bt + cur.boff * 2;
    PG8_SETOFF(avo, 0);
    PG8_STAGE(PG8_SB(0, 0), cB, voffB); PG8_STAGE(PG8_SB(0, 1), cB + hstepB, voffB); PG8_STAGE(PG8_SA(0, 0), cA, avo[0]); PG8_STAGE(PG8_SA(0, 1), cA, avo[1]);
    if (wr == 1) PG8_BAR;
    PG8_WAIT_V(2); PG8_BAR;
    PG8_STAGE(PG8_SB(1, 0), cB + kstep, voffB); PG8_STAGE(PG8_SA(1, 0), cA + kstep, avo[0]); PG8_STAGE(PG8_SB(1, 1), cB + hstepB + kstep, voffB);
    PG8_WAIT_V(6); PG8_BAR;
    for (;;) {
        const bool has_next = S.next(ui + 1, nxt);
        const char* nA = has_next ? (const char*)g.A + nxt.aoff * 2 : cA; const char* nB = has_next ? (const char*)g.Bt + nxt.boff * 2 : cB;
        if (GATHER && has_next) { PG8_SETOFF(navo, ui + 1); }
        else {
#pragma unroll
            for (int h_ = 0; h_ < 2; ++h_)
#pragma unroll
                for (int i_ = 0; i_ < 2; ++i_) navo[h_][i_] = avo[h_][i_]; }
#pragma nounroll
        for (int t = 0; t < nt; t += 2) {
            const bool last = (t == nt - 2);
            const char* a1 = cA + (size_t)(t + 1) * kstep;
            const char* a2 = last ? nA : cA + (size_t)(t + 2) * kstep; const char* b2 = last ? nB : cB + (size_t)(t + 2) * kstep;
            const char* a3 = a2 + kstep; const char* b3 = b2 + kstep;
            unsigned o2[2][2];
#pragma unroll
            for (int h_ = 0; h_ < 2; ++h_)
#pragma unroll
                for (int i_ = 0; i_ < 2; ++i_) o2[h_][i_] = (GATHER && last) ? navo[h_][i_] : avo[h_][i_];
            PG8_LDB(B0, 0, 0); PG8_LDB(B1, 0, 1); PG8_SCHED; PG8_LDA(At, 0, 0); PG8_STAGE(PG8_SA(1, 1), a1, avo[1]);
            PG8_WAIT_V(8); PG8_WAIT_L(0); PG8_BAR; PG8_MMA(0, 0, At, B0); PG8_MMA(0, 1, At, B1); PG8_BAR; PG8_SCHED;
            PG8_LDA(At, 0, 1); PG8_STAGE(PG8_SB(0, 0), b2, voffB); PG8_STAGE(PG8_SB(0, 1), b2 + hstepB, voffB); PG8_STAGE(PG8_SA(0, 0), a2, o2[0]);
            PG8_WAIT_V(8); PG8_WAIT_L(0); PG8_BAR; PG8_MMA(1, 0, At, B0); PG8_MMA(1, 1, At, B1); PG8_BAR; PG8_SCHED;
            PG8_LDB(B0, 1, 0); PG8_LDB(B1, 1, 1); PG8_SCHED; PG8_LDA(At, 1, 0); PG8_STAGE(PG8_SA(0, 1), a2, o2[1]);
            PG8_WAIT_V(8); PG8_WAIT_L(0); PG8_BAR; PG8_MMA(0, 0, At, B0); PG8_MMA(0, 1, At, B1); PG8_BAR; PG8_SCHED;
            PG8_LDA(At, 1, 1); PG8_STAGE(PG8_SB(1, 0), b3, voffB); PG8_STAGE(PG8_SB(1, 1), b3 + hstepB, voffB); PG8_STAGE(PG8_SA(1, 0), a3, o2[0]);
            PG8_WAIT_V(8); PG8_WAIT_L(0); PG8_BAR; PG8_MMA(1, 0, At, B0); PG8_MMA(1, 1, At, B1); PG8_BAR; PG8_SCHED;
        }
        if constexpr (ALIGN_EPI) { if (wr == 0) PG8_BAR; }
        if constexpr (FP8) asm volatile("s_nop 15\n\ts_nop 3" ::: "memory");
        { int efr = fr, efq = fq; asm volatile("" : "+v"(efr), "+v"(efq)); E(acc, cur, wr, wc, efr, efq); }
        if (!has_next) break;
#pragma unroll
        for (int a = 0; a < 2; ++a)
#pragma unroll
            for (int b = 0; b < 2; ++b)
#pragma unroll
                for (int m = 0; m < 4; ++m)
#pragma unroll
                    for (int n = 0; n < 2; ++n) acc[a][b][m][n] = (f32x4){0.f, 0.f, 0.f, 0.f};
        cur = nxt; cA = nA; cB = nB; ++ui;
#pragma unroll
        for (int h_ = 0; h_ < 2; ++h_)
#pragma unroll
            for (int i_ = 0; i_ < 2; ++i_) avo[h_][i_] = navo[h_][i_];
        if constexpr (ALIGN_EPI) { if (wr == 1) PG8_BAR; }
    }
    PG8_WAIT_V(0);
    if constexpr (!ALIGN_EPI) { if (wr == 0) PG8_BAR; }
    PG8_BAR;
#undef PG8_SETOFF
#undef PG8_SA
#undef PG8_SB
#undef PG8_STAGE
#undef PG8_LDA
#undef PG8_LDB
#undef PG8_MMA
#undef PG8_WAIT_V
#undef PG8_WAIT_L
#undef PG8_BAR
#undef PG8_SCHED
}
}
constexpr int NB = 8, SEQ = 2048, DM = 1024, TOK = NB * SEQ;
constexpr int AH = 8;
constexpr int RH = 4, RDK = 256, RDV = 512, RC = 256, RNC = SEQ / RC;
constexpr int NEXP = 32, EFF = 512, NPAIR = 2 * TOK, LISTCAP = TOK;
constexpr int MAXRT = NPAIR / 256 + NEXP;
constexpr float RMS_EPS = 1e-6f, SUBLN_EPS = 1e-5f, LOG2E = 1.4426950408889634f;
#ifndef QKV_FP8
#define QKV_FP8 0
#endif
#ifndef RIN_FP8
#define RIN_FP8 1
#endif
constexpr float WIN_SCALE = 64.f, IN_DESCALE = 1.0f / (16.f * 64.f);
constexpr float H8_SCALE = 16.f, W1_SCALE = 64.f, ACT_SCALE = 8.f, W2_SCALE = 32.f, Y_SCALE = 64.f;
constexpr float ATT_C2 = 0.125f * LOG2E;

constexpr size_t MiB = 1u << 20;
constexpr size_t WS_CTL = 0, CTL_ZERO_BYTES = 1 * MiB;
constexpr size_t WS_LIST = 1 * MiB;
constexpr size_t WS_PAIRW = 3 * MiB;
constexpr size_t WS_WRF = 3 * MiB + 512 * 1024;
constexpr size_t WS_SINCOS = 4 * MiB;
constexpr size_t WS_SINCOST = 6 * MiB;
constexpr size_t WS_WINT0 = 8 * MiB;
constexpr size_t WS_WOUTT0 = 14 * MiB;
constexpr size_t WS_WRINA = 16 * MiB;
constexpr size_t WS_WRINB = 24 * MiB;
constexpr size_t WS_WROUTT = 30 * MiB;
constexpr size_t WS_W1CAT = 34 * MiB;
constexpr size_t WS_W2T = 98 * MiB;
constexpr size_t WS_DS = 34 * MiB;
constexpr size_t WS_ORET = 34 * MiB;
constexpr size_t WS_HB = 130 * MiB;
constexpr size_t WS_ACTBASE = 162 * MiB;
constexpr size_t WS_QKV0 = WS_ACTBASE;
constexpr size_t WS_OP = WS_ACTBASE + 96 * MiB;
constexpr size_t WS_AO = WS_ACTBASE + 160 * MiB;
constexpr size_t WS_MACT = WS_ACTBASE;
constexpr size_t WS_Y = WS_ACTBASE + 40 * MiB;
constexpr size_t WS_X3 = WS_ACTBASE + 80 * MiB;
constexpr size_t WS_ACAT = WS_ACTBASE;
constexpr size_t WS_BTCAT = WS_ACTBASE + 64 * MiB;
constexpr size_t WS_KI = WS_ACTBASE + 192 * MiB;
constexpr size_t WS_KIT = WS_ACTBASE + 224 * MiB;
constexpr size_t WS_SG = WS_ACTBASE + 256 * MiB;
constexpr size_t WS_END = WS_ACTBASE + 320 * MiB;
constexpr int CW_TMO = 0, CW_BAR = 4096, CW_CNT = 16384;

constexpr int RING_OFF = 0, RING_BYTES = 131072;
constexpr int LX_OFF = RING_BYTES;
constexpr int LX_MISC = LX_OFF + 320;
constexpr int LX_ROWTAB = LX_OFF + 1024;
constexpr int LX_TSTART = LX_OFF + 5120;
constexpr int LX_TEXP = LX_OFF + 5376;
constexpr int LX_LUT = LX_OFF + 10240;
constexpr int LX_CNT = LX_OFF + 7168;
constexpr int LX_SSQ = LX_OFF + 8192;
constexpr int LDS_BYTES = 147456;

namespace pg8 {
struct EpiQKV {
    static constexpr bool PERM = true;
    bf16_t* O; float qscale;
    __device__ __forceinline__ void operator()(const f32x4 (&acc)[2][2][4][2], const Unit& u, int wr, int wc, int fr, int fq) const {
        const int row0 = u.pm * BM + wr * 64 + fr, col0 = u.pn * BM + wc * 32 + 8 * fq; const float sc = ((u.pn < 4) ? qscale : 1.f) * (QKV_FP8 ? IN_DESCALE : 1.f);
#pragma unroll
        for (int ai = 0; ai < 2; ++ai)
#pragma unroll
            for (int m = 0; m < 4; ++m) { bf16_t* rowp = O + (size_t)(row0 + ai * HALF + m * 16) * 3072 + col0;
#pragma unroll
                for (int bj = 0; bj < 2; ++bj) *(u32x4*)(rowp + bj * HALF) = pack8(acc[ai][bj][m][0] * sc, acc[ai][bj][m][1] * sc); }
    }
};
template <bool RESF32> struct EpiResB {
    static constexpr bool PERM = true;
    const void* res; bf16_t* out;
    __device__ __forceinline__ void operator()(const f32x4 (&acc)[2][2][4][2], const Unit& u, int wr, int wc, int fr, int fq) const {
        const int row0 = u.pm * BM + wr * 64 + fr, col0 = u.pn * BM + wc * 32 + 8 * fq;
#pragma unroll
        for (int ai = 0; ai < 2; ++ai)
#pragma unroll
            for (int m = 0; m < 4; ++m) { const size_t off = (size_t)(row0 + ai * HALF + m * 16) * 1024 + col0;
#pragma unroll
                for (int bj = 0; bj < 2; ++bj) { f32x4 r0, r1;
                    if (RESF32) { const float* rp = (const float*)res + off + bj * HALF; r0 = *(const f32x4*)rp; r1 = *(const f32x4*)(rp + 4); }
                    else { const u32x4 g = *(const u32x4*)((const bf16_t*)res + off + bj * HALF);
                        r0[0] = __uint_as_float(g.x << 16); r0[1] = __uint_as_float(g.x & 0xffff0000u); r0[2] = __uint_as_float(g.y << 16); r0[3] = __uint_as_float(g.y & 0xffff0000u);
                        r1[0] = __uint_as_float(g.z << 16); r1[1] = __uint_as_float(g.z & 0xffff0000u); r1[2] = __uint_as_float(g.w << 16); r1[3] = __uint_as_float(g.w & 0xffff0000u); }
                    *(u32x4*)(out + off + bj * HALF) = pack8(r0 + acc[ai][bj][m][0], r1 + acc[ai][bj][m][1]); }
                asm volatile("" ::: "memory"); }
    }
};
__device__ __forceinline__ float silu_f(float x) { return x * __builtin_amdgcn_rcpf(1.0f + __builtin_amdgcn_exp2f(-x * LOG2E)); }
__device__ __forceinline__ unsigned pk4_fp8(float a, float b, float c, float d) { int w = 0; w = __builtin_amdgcn_cvt_pk_fp8_f32(a, b, w, false); w = __builtin_amdgcn_cvt_pk_fp8_f32(c, d, w, true); return (unsigned)w; }
struct EpiMoe1 {
    static constexpr bool PERM = true;
    unsigned char* ACT;
    __device__ __forceinline__ void operator()(const f32x4 (&acc)[2][2][4][2], const Unit& u, int wr, int wc, int fr, int fq) const {
        const int row0 = u.pm * BM + wr * 64 + fr, col0 = (u.pn & 3) * 128 + wc * 32 + 8 * fq; constexpr float si = 1.0f / (H8_SCALE * W1_SCALE);
#pragma unroll
        for (int ai = 0; ai < 2; ++ai)
#pragma unroll
            for (int m = 0; m < 4; ++m) { f32x4 a0, a1;
#pragma unroll
                for (int j = 0; j < 4; ++j) { a0[j] = silu_f(acc[ai][0][m][0][j] * si) * acc[ai][1][m][0][j] * (si * ACT_SCALE); a1[j] = silu_f(acc[ai][0][m][1][j] * si) * acc[ai][1][m][1][j] * (si * ACT_SCALE); }
                u32x2 w; w.x = pk4_fp8(a0[0], a0[1], a0[2], a0[3]); w.y = pk4_fp8(a1[0], a1[1], a1[2], a1[3]);
                *(u32x2*)(ACT + (size_t)(row0 + ai * HALF + m * 16) * 512 + col0) = w; }
    }
};
struct EpiMoe2 {
    static constexpr bool PERM = true;
    unsigned char* Y; const int* list; const float* pairw; const LAS int* lcnt;
    __device__ __forceinline__ void operator()(const f32x4 (&acc)[2][2][4][2], const Unit& u, int wr, int wc, int fr, int fq) const {
        const int e = u.pn >> 2, col0 = (u.pn & 3) * BM + wc * 32 + 8 * fq, pos0 = u.aux * BM + wr * 64 + fr, cn = lcnt[e];
#pragma unroll
        for (int ai = 0; ai < 2; ++ai)
#pragma unroll
            for (int m = 0; m < 4; ++m) { const int pos = pos0 + ai * HALF + m * 16;
                if (pos < cn) { const int pair = list[e * LISTCAP + pos]; const float w = pairw[pair] * (Y_SCALE / (ACT_SCALE * W2_SCALE)); unsigned char* rowp = Y + (size_t)pair * 1024 + col0;
#pragma unroll
                    for (int bj = 0; bj < 2; ++bj) { const f32x4 a = acc[ai][bj][m][0] * w, c = acc[ai][bj][m][1] * w; u32x2 o; o.x = pk4_fp8(a[0], a[1], a[2], a[3]); o.y = pk4_fp8(c[0], c[1], c[2], c[3]);
                        *(u32x2*)(rowp + bj * HALF) = o; } } }
    }
};
__device__ __forceinline__ float log2_gamma(int h) { return __builtin_log2f(1.0f - __builtin_amdgcn_exp2f(-5.0f - (float)h)); }
struct EpiRetA {
    static constexpr bool PERM = true;
    bf16_t* ACAT; bf16_t* KI; bf16_t* SG; const float* sincos; bf16_t* KIT;
    __device__ __forceinline__ void operator()(const f32x4 (&acc)[2][2][4][2], const Unit& u, int wr, int wc, int fr, int fq) const {
        const int r0 = wr * 64 + fr, c0 = wc * 32 + 8 * fq;
        if (u.pn >= 8) {
#pragma unroll
            for (int ai = 0; ai < 2; ++ai)
#pragma unroll
                for (int m = 0; m < 4; ++m) { bf16_t* rowp = SG + (size_t)(u.pm * BM + r0 + ai * HALF + m * 16) * 2048 + (u.pn - 8) * BM + c0;
#pragma unroll
                    for (int bj = 0; bj < 2; ++bj) { f32x4 a0, a1;
#pragma unroll
                        for (int j = 0; j < 4; ++j) { a0[j] = silu_f(acc[ai][bj][m][0][j] * IN_DESCALE); a1[j] = silu_f(acc[ai][bj][m][1][j] * IN_DESCALE); }
                        *(u32x4*)(rowp + bj * HALF) = pack8(a0, a1); } }
            return;
        }
        const bool isq = u.pn < 4; const int h = u.pn & 3; const float l2g = log2_gamma(h);
        const int b = u.pm >> 3, n = u.pm & 7;
#pragma unroll
        for (int ai = 0; ai < 2; ++ai)
#pragma unroll
            for (int m = 0; m < 4; ++m) { const int r = r0 + ai * HALF + m * 16, pos = n * RC + r;
                const float fac = IN_DESCALE * (isq ? __builtin_amdgcn_exp2f((float)(r + 1) * l2g) : 0.0625f * __builtin_amdgcn_exp2f(-(float)(r + 1) * l2g));
                bf16_t* rowp = isq ? ACAT + ((size_t)((b * RH + h) * RNC + n) * RC + r) * 512 + 256 + c0 : KI + (size_t)(u.pm * BM + r) * 1024 + h * RDK + c0;
#pragma unroll
                for (int bj = 0; bj < 2; ++bj) { const f32x4* cs = (const f32x4*)(sincos + ((size_t)pos * 128 + (bj * HALF + c0) / 2) * 2);
                    const f32x4 t0 = cs[0], t1 = cs[1]; const f32x4 x0 = acc[ai][bj][m][0], x1 = acc[ai][bj][m][1]; f32x4 y0, y1;
                    y0[0] = (x0[0] * t0[0] - x0[1] * t0[1]) * fac; y0[1] = (x0[1] * t0[0] + x0[0] * t0[1]) * fac; y0[2] = (x0[2] * t0[2] - x0[3] * t0[3]) * fac; y0[3] = (x0[3] * t0[2] + x0[2] * t0[3]) * fac;
                    y1[0] = (x1[0] * t1[0] - x1[1] * t1[1]) * fac; y1[1] = (x1[1] * t1[0] + x1[0] * t1[1]) * fac; y1[2] = (x1[2] * t1[2] - x1[3] * t1[3]) * fac; y1[3] = (x1[3] * t1[2] + x1[2] * t1[3]) * fac;
                    *(u32x4*)(rowp + bj * HALF) = pack8(y0, y1);
                    if (!isq) {
                        const int s0 = fr & 1, s1 = (fr >> 1) & 1;
#pragma unroll
                        for (int nn = 0; nn < 2; ++nn) { const f32x4 a = nn ? y1 : y0; float t[4], c[4];
#pragma unroll
                            for (int j = 0; j < 4; ++j) { const float other = __shfl_xor(a[j ^ 1], 1); t[j] = (s0 == (j & 1)) ? a[j] : other; }
#pragma unroll
                            for (int j = 0; j < 4; ++j) { const float other = __shfl_xor(t[j ^ 2], 2); c[j] = (s1 == (j >> 1)) ? t[j] : other; }
                            u32x2 w; w.x = cvt_pk_bf16(c[0], c[1]); w.y = cvt_pk_bf16(c[2], c[3]);
                            const int col = bj * HALF + c0 + nn * 4 + (fr & 3), tok = n * RC + (r & ~3);
                            *(u32x2*)(KIT + ((size_t)((b * RH + h) * RDK + col)) * SEQ + tok) = w; } }
                } }
    }
};
struct EpiRetB {
    static constexpr bool PERM = true;
    bf16_t* BTCAT;
    __device__ __forceinline__ void operator()(const f32x4 (&acc)[2][2][4][2], const Unit& u, int wr, int wc, int fr, int fq) const {
        const int r0 = wr * 64 + fr, c0 = wc * 32 + 8 * fq; const int b = u.pn >> 3, n = u.pn & 7; const int h = u.pm >> 1, dv0 = (u.pm & 1) * BM;
#pragma unroll
        for (int ai = 0; ai < 2; ++ai)
#pragma unroll
            for (int m = 0; m < 4; ++m) { bf16_t* rowp = BTCAT + ((size_t)((b * RH + h) * RNC + n) * RDV + dv0 + r0 + ai * HALF + m * 16) * 512 + c0;
#pragma unroll
                for (int bj = 0; bj < 2; ++bj) *(u32x4*)(rowp + bj * HALF) = pack8(acc[ai][bj][m][0] * IN_DESCALE, acc[ai][bj][m][1] * IN_DESCALE); }
    }
};
struct EpiScores {
    static constexpr bool PERM = true;
    bf16_t* ACAT;
    __device__ __forceinline__ void operator()(const f32x4 (&acc)[2][2][4][2], const Unit& u, int wr, int wc, int fr, int fq) const {
        const int r0 = wr * 64 + fr, c0 = wc * 32 + 8 * fq;
#pragma unroll
        for (int ai = 0; ai < 2; ++ai)
#pragma unroll
            for (int m = 0; m < 4; ++m) { const int r = r0 + ai * HALF + m * 16; bf16_t* rowp = ACAT + ((size_t)u.pm * RC + r) * 512 + c0;
#pragma unroll
                for (int bj = 0; bj < 2; ++bj) { f32x4 y0 = acc[ai][bj][m][0], y1 = acc[ai][bj][m][1]; const int cb = bj * HALF + c0;
#pragma unroll
                    for (int j = 0; j < 4; ++j) { if (cb + j > r) y0[j] = 0.f; if (cb + 4 + j > r) y1[j] = 0.f; }
                    *(u32x4*)(rowp + bj * HALF) = pack8(y0, y1); } }
    }
};
struct EpiDS {
    static constexpr bool PERM = true;
    bf16_t* DS;
    __device__ __forceinline__ void operator()(const f32x4 (&acc)[2][2][4][2], const Unit& u, int wr, int wc, int fr, int fq) const {
        const int r0 = wr * 64 + fr, c0 = wc * 32 + 8 * fq;
#pragma unroll
        for (int ai = 0; ai < 2; ++ai)
#pragma unroll
            for (int m = 0; m < 4; ++m) { bf16_t* rowp = DS + ((size_t)u.pm * RDV + u.pn * BM + r0 + ai * HALF + m * 16) * RDK + c0;
#pragma unroll
                for (int bj = 0; bj < 2; ++bj) *(u32x4*)(rowp + bj * HALF) = pack8(acc[ai][bj][m][0], acc[ai][bj][m][1]); }
    }
};
struct EpiRetO {
    static constexpr bool PERM = true;
    bf16_t* ORET; bf16_t* SG; LAS float* ssq;
    __device__ __forceinline__ void operator()(const f32x4 (&acc)[2][2][4][2], const Unit& u, int wr, int wc, int fr, int fq) const {
        const int r0 = wr * 64 + fr, c0 = wc * 32 + 8 * fq; const int n = u.pm & 7, h = (u.pm >> 3) & 3, b = u.pm >> 5;
        LAS float* sq = ssq + (u.aux & 1) * 256;
        if (u.pn == 0) { const int t_ = threadIdx.x; if (t_ < 256) ssq[((u.aux & 1) ^ 1) * 256 + t_] = 0.f; }
#pragma unroll
        for (int ai = 0; ai < 2; ++ai)
#pragma unroll
            for (int m = 0; m < 4; ++m) { float s = 0.f;
#pragma unroll
                for (int bj = 0; bj < 2; ++bj)
#pragma unroll
                    for (int nn = 0; nn < 2; ++nn) { const f32x4 x = acc[ai][bj][m][nn]; s += (x[0] * x[0] + x[1] * x[1]) + (x[2] * x[2] + x[3] * x[3]); }
                s += __shfl_xor(s, 16); s += __shfl_xor(s, 32);
                if (fq == 0) (void)__hip_atomic_fetch_add(sq + r0 + ai * HALF + m * 16, s, __ATOMIC_RELAXED, __HIP_MEMORY_SCOPE_WORKGROUP); }
        const size_t rowbase = (size_t)(b * SEQ + n * RC) * 2048 + h * RDV;
        if (u.pn == 0) {
#pragma unroll
            for (int ai = 0; ai < 2; ++ai)
#pragma unroll
                for (int m = 0; m < 4; ++m) { bf16_t* rowp = ORET + rowbase + (size_t)(r0 + ai * HALF + m * 16) * 2048 + c0;
#pragma unroll
                    for (int bj = 0; bj < 2; ++bj) *(u32x4*)(rowp + bj * HALF) = pack8(acc[ai][bj][m][0], acc[ai][bj][m][1]); }
            return;
        }
        asm volatile("s_waitcnt lgkmcnt(0)" ::: "memory"); __builtin_amdgcn_s_barrier(); asm volatile("" ::: "memory");
#pragma unroll
        for (int ai = 0; ai < 2; ++ai)
#pragma unroll
            for (int m = 0; m < 4; ++m) { const int r = r0 + ai * HALF + m * 16; const float rstd = __builtin_amdgcn_rsqf(sq[r] * (1.0f / 512.0f) + RMS_EPS);
                const size_t ro = rowbase + (size_t)r * 2048 + c0;
#pragma unroll
                for (int bj = 0; bj < 2; ++bj) {
                    { bf16_t* gp = SG + ro + BM + bj * HALF; const u32x4 g = *(const u32x4*)gp; f32x4 y0 = acc[ai][bj][m][0] * rstd, y1 = acc[ai][bj][m][1] * rstd;
                      y0[0] *= __uint_as_float(g.x << 16); y0[1] *= __uint_as_float(g.x & 0xffff0000u); y0[2] *= __uint_as_float(g.y << 16); y0[3] *= __uint_as_float(g.y & 0xffff0000u);
                      y1[0] *= __uint_as_float(g.z << 16); y1[1] *= __uint_as_float(g.z & 0xffff0000u); y1[2] *= __uint_as_float(g.w << 16); y1[3] *= __uint_as_float(g.w & 0xffff0000u);
                      *(u32x4*)gp = pack8(y0, y1); }
                    { bf16_t* gp = SG + ro + bj * HALF; const u32x4 g = *(const u32x4*)gp; const u32x4 o = *(const u32x4*)(ORET + ro + bj * HALF); f32x4 y0, y1;
                      y0[0] = __uint_as_float(o.x << 16) * rstd * __uint_as_float(g.x << 16); y0[1] = __uint_as_float(o.x & 0xffff0000u) * rstd * __uint_as_float(g.x & 0xffff0000u);
                      y0[2] = __uint_as_float(o.y << 16) * rstd * __uint_as_float(g.y << 16); y0[3] = __uint_as_float(o.y & 0xffff0000u) * rstd * __uint_as_float(g.y & 0xffff0000u);
                      y1[0] = __uint_as_float(o.z << 16) * rstd * __uint_as_float(g.z << 16); y1[1] = __uint_as_float(o.z & 0xffff0000u) * rstd * __uint_as_float(g.z & 0xffff0000u);
                      y1[2] = __uint_as_float(o.w << 16) * rstd * __uint_as_float(g.w << 16); y1[3] = __uint_as_float(o.w & 0xffff0000u) * rstd * __uint_as_float(g.w & 0xffff0000u);
                      *(u32x4*)gp = pack8(y0, y1); } } }
    }
};
struct ScoresOrder {
    int G, c;
    __device__ bool next(int i, Unit& u) const { const int L = i * G + c; if (L >= NB * RH * RNC) return false; const int n = L & 7, h = (L >> 3) & 3, b = L >> 5;
        u.pm = L; u.pn = 0; u.aux = 0; u.aoff = (long)L * RC * 512 + 256; u.boff = (long)(b * SEQ + n * RC) * 1024 + h * RDK; return true; }
};
struct DsOrder {
    int G, c;
    __device__ bool next(int i, Unit& u) const { const int L = i * G + c; if (L >= NB * RH * 7 * 2) return false; const int dvt = L & 1, q = L >> 1, n = q % 7, bh = q / 7, p = bh * RNC + n;
        u.pm = p; u.pn = dvt; u.aux = 0; u.aoff = ((long)p * RDV + dvt * BM) * 512; u.boff = (long)bh * RDK * SEQ + n * RC; return true; }
};
struct RetOOrder {
    int G, c;
    __device__ bool next(int i, Unit& u) const { const int k = i >> 1, dvt = i & 1, p = k * G + c; if (p >= NB * RH * RNC) return false;
        u.pm = p; u.pn = dvt; u.aux = k; u.aoff = (long)p * RC * 512; u.boff = ((long)p * RDV + dvt * BM) * 512; return true; }
};
struct MoeOrder {
    int G, c, ldb; long a_tile; const LAS int* tstart; const LAS int* texp;
    __device__ bool next(int i, Unit& u) const { const int L = i * G + c; const int ntiles = tstart[33]; if (L >= ntiles * 4) return false; const int rt = L >> 2, pnl = L & 3, e = texp[rt];
        u.pm = rt; u.pn = e * 4 + pnl; u.aux = rt - tstart[e]; u.aoff = (long)rt * a_tile; u.boff = ((long)e * 1024 + pnl * BM) * ldb; return true; }
};
}
namespace attn_body {
using bf16=__hip_bfloat16;
using bf16x8=__attribute__((ext_vector_type(8)))short;
using s16x4=__attribute__((ext_vector_type(4)))short;
using f32x16=__attribute__((ext_vector_type(16)))float;
using u32x4=__attribute__((ext_vector_type(4)))unsigned;
constexpr int D=64,PQ=3072,PO=1024;
constexpr int NW=8,QBLK=32,QB=QBLK*NW,KVBLK=64,NQB=SEQ/QB;
__device__ __forceinline__ int crow(int r,int hi){return (r&3)+8*(r>>2)+4*hi;}
#define SBAR() __builtin_amdgcn_sched_barrier(0)
__device__ __forceinline__ void biasmask(f32x16&p0,f32x16&p1,int jb6,int qrel,int hi,const LAS float*lut2){
  const LAS float*pb=lut2+(128+qrel-64*jb6-4*hi+288-91);
  #pragma unroll
  for(int g=0;g<4;++g){
    #pragma unroll
    for(int q=0;q<4;++q){const int r=4*g+q, c=q+8*g; const int rel=128+qrel-64*jb6-4*hi-c; const float b0=pb[91-c], b1=pb[91-c-32]; p0[r]=(rel<0)?-INFINITY:p0[r]+b0; p1[r]=(rel<32)?-INFINITY:p1[r]+b1;}
    asm volatile("":"+v"(p0),"+v"(p1)); __builtin_amdgcn_sched_barrier(0);}
}
constexpr int NSLOT=3, SLOTB=8192;
constexpr int LDS_K=0, LDS_V=NSLOT*SLOTB, LDS_WS=2*NSLOT*SLOTB, LDS_OST=LDS_WS+NW*64*4, LDS_BYTES=LDS_OST+NW*4096;
__device__ __forceinline__ void glds16(const void*gsrc,unsigned lds_dst){unsigned keep;
  asm volatile("s_mov_b32 %0, m0\n\ts_mov_b32 m0, %2\n\ts_nop 0\n\tglobal_load_lds_dwordx4 %1, off\n\ts_mov_b32 m0, %0":"=&s"(keep):"v"(gsrc),"s"(lds_dst):"memory");}
__device__ __forceinline__ float max3f(float a,float b,float c){float r;asm("v_max3_f32 %0, %1, %2, %3":"=v"(r):"v"(a),"v"(b),"v"(c));return r;}
__device__ __forceinline__ float max2f(float a,float b){float r;asm("v_max_f32_e32 %0, %1, %2":"=v"(r):"v"(a),"v"(b));return r;}
__device__ __forceinline__ float fadd_s(float a,float b){float r;asm("v_add_f32_e32 %0, %1, %2":"=v"(r):"v"(a),"v"(b));return r;}
__device__ __forceinline__ float fsub_s(float a,float b){float r;asm("v_sub_f32_e32 %0, %1, %2":"=v"(r):"v"(a),"v"(b));return r;}
typedef float f32x2_t __attribute__((ext_vector_type(2))); typedef __bf16 bf16x2_t __attribute__((ext_vector_type(2)));
__device__ __forceinline__ unsigned cvtpk_s(float lo,float hi){f32x2_t v={lo,hi};bf16x2_t b=__builtin_convertvector(v,bf16x2_t);return __builtin_bit_cast(unsigned,b);}
#define WAIT_BAR(N) asm volatile("s_waitcnt vmcnt(" #N ") lgkmcnt(0)\n\ts_barrier":::"memory")

__device__ __forceinline__ void qkt(f32x16&p0,f32x16&p1,const char*Kslot,const bf16x8*qr,const f32x16&negm,int r32,int hi){
  const char*kb=Kslot+hi*1024+r32*16;
  #pragma unroll
  for(int d0=0;d0<4;++d0){
    const bf16x8 b0=*reinterpret_cast<const bf16x8*>(kb+d0*2048);
    const bf16x8 b1=*reinterpret_cast<const bf16x8*>(kb+d0*2048+512);
    if(d0==0){p0=__builtin_amdgcn_mfma_f32_32x32x16_bf16(b0,qr[0],negm,0,0,0);p1=__builtin_amdgcn_mfma_f32_32x32x16_bf16(b1,qr[0],negm,0,0,0);}
    else{p0=__builtin_amdgcn_mfma_f32_32x32x16_bf16(b0,qr[d0],p0,0,0,0);p1=__builtin_amdgcn_mfma_f32_32x32x16_bf16(b1,qr[d0],p1,0,0,0);}}
}
typedef LAS const char* lds_cptr;
typedef short v4i16_t __attribute__((ext_vector_type(4)));
__device__ __forceinline__ void kload8(bf16x8*kf,lds_cptr kp){
  kf[0]=*(const LAS bf16x8*)(kp);      kf[1]=*(const LAS bf16x8*)(kp+512);
  kf[2]=*(const LAS bf16x8*)(kp+2048); kf[3]=*(const LAS bf16x8*)(kp+2560);
  kf[4]=*(const LAS bf16x8*)(kp+4096); kf[5]=*(const LAS bf16x8*)(kp+4608);
  kf[6]=*(const LAS bf16x8*)(kp+6144); kf[7]=*(const LAS bf16x8*)(kp+6656);
}
__device__ __forceinline__ void kload2(bf16x8*kf,lds_cptr kp,int j){ kf[2*j]=*(const LAS bf16x8*)(kp+j*2048); kf[2*j+1]=*(const LAS bf16x8*)(kp+j*2048+512); }
__device__ __forceinline__ s16x4 vtr(lds_cptr p){ return __builtin_bit_cast(s16x4,__builtin_amdgcn_ds_read_tr16_b64_v4i16((LAS v4i16_t*)p)); }
__device__ __forceinline__ float rowmax(const f32x16&p0,const f32x16&p1){
  float a=max3f(p0[0],p0[1],p1[0]),b=max3f(p0[2],p0[3],p1[1]);a=max3f(a,p1[2],p1[3]);
  #pragma unroll
  for(int r=4;r<16;r+=4){a=max3f(a,p0[r],p0[r+1]);b=max3f(b,p0[r+2],p0[r+3]);a=max3f(a,p1[r],p1[r+1]);b=max3f(b,p1[r+2],p1[r+3]);}
  const float m=max2f(a,b);
  auto rr=__builtin_amdgcn_permlane32_swap(__float_as_uint(m),__float_as_uint(m),false,false);
  return max2f(__uint_as_float(rr[0]),__uint_as_float(rr[1]));
}
__device__ __forceinline__ void pv(f32x16*o,int vb,bf16x8 pa0,bf16x8 pa1,bf16x8 pa2,bf16x8 pa3){
  #pragma unroll
  for(int d0=0;d0<2;++d0){s16x4 lo[4],hi[4];
    #pragma unroll
    for(int ks=0;ks<4;++ks){
      asm volatile("ds_read_b64_tr_b16 %0,%1 offset:%c2":"=&v"(lo[ks]):"v"(vb),"i"(d0*4096+ks*1024):"memory");
      asm volatile("ds_read_b64_tr_b16 %0,%1 offset:%c2":"=&v"(hi[ks]):"v"(vb),"i"(d0*4096+ks*1024+512):"memory");}
    asm volatile("s_waitcnt lgkmcnt(0)":::"memory");SBAR();
    #define PK(k) (bf16x8){lo[k][0],lo[k][1],lo[k][2],lo[k][3],hi[k][0],hi[k][1],hi[k][2],hi[k][3]}
    o[d0]=__builtin_amdgcn_mfma_f32_32x32x16_bf16(pa0,PK(0),o[d0],0,0,0);
    o[d0]=__builtin_amdgcn_mfma_f32_32x32x16_bf16(pa1,PK(1),o[d0],0,0,0);
    o[d0]=__builtin_amdgcn_mfma_f32_32x32x16_bf16(pa2,PK(2),o[d0],0,0,0);
    o[d0]=__builtin_amdgcn_mfma_f32_32x32x16_bf16(pa3,PK(3),o[d0],0,0,0);
    #undef PK
  }
}
template<int THRL> __device__ __forceinline__ void attn_unit(int b,int qb,const bf16*QKV,int Qc,int Kc,int Vc,bf16*O,const LAS float*lut,char*shm){
  int tid_=threadIdx.x; asm volatile("":"+v"(tid_)); const int tid=tid_,lane=tid&63,r32=lane&31,hi=lane>>5; const int wid=__builtin_amdgcn_readfirstlane(tid>>6);
  const long rowbase=(long)b*SEQ; const int q0=qb*QB;
  const bf16*Qw=QKV+(rowbase+q0+wid*QBLK)*PQ+Qc;
  const bf16*Kh=QKV+rowbase*PQ+Kc,*Vh=QKV+rowbase*PQ+Vc;
  const unsigned lds0=(unsigned)(uintptr_t)shm;
  float*wsf=(float*)(shm+LDS_WS)+wid*64;
  const bf16*ksrc=Kh+(long)lane*PQ+wid*8;
  const bf16*vsrc=Vh+(long)(16*(wid&3)+(lane>>2))*PQ+(wid>>2)*32+(lane&3)*8;
  const unsigned kdst=lds0+LDS_K+wid*1024, vdst=lds0+LDS_V+wid*1024;
  #define DMA_K(t,slot) glds16(ksrc+(long)(t)*KVBLK*PQ,(unsigned)__builtin_amdgcn_readfirstlane(kdst+(slot)))
  #define DMA_V(t,slot) glds16(vsrc+(long)(t)*KVBLK*PQ,(unsigned)__builtin_amdgcn_readfirstlane(vdst+(slot)))
  const int vb0=(int)(lds0+LDS_V)+((lane>>4)&1)*32+(lane&3)*8+(4*hi+((lane&15)>>2))*64;
  const char*Kbase=shm+LDS_K; bf16x8 kf[8];
  const lds_cptr shm3=(lds_cptr)shm; const lds_cptr kp0=shm3+LDS_K+hi*1024+r32*16; const lds_cptr vp0=shm3+LDS_V+((lane>>4)&1)*32+(lane&3)*8+(4*hi+((lane&15)>>2))*64;
  const int NT=(q0+QB)/KVBLK;
  DMA_K(0,0);DMA_V(0,0);DMA_K(1,SLOTB);
  bf16x8 qr[4];
  #pragma unroll
  for(int d0=0;d0<4;++d0)qr[d0]=*reinterpret_cast<const bf16x8*>(&Qw[(long)r32*PQ+d0*16+hi*8]);
  float mhat=0.f,l_reg=0.f;f32x16 o[2];f32x16 negm; { float zz; asm volatile("v_mov_b32 %0, 0":"=v"(zz)); _Pragma("unroll") for(int r=0;r<16;++r){o[0][r]=zz;o[1][r]=zz;negm[r]=zz;} } asm volatile("":"+v"(negm));
  const int qrel=wid*QBLK+r32;
  #define CMASK(P0,P1,t) do{int jb_=(t)-(NT-6); if(jb_>=0)biasmask(P0,P1,jb_,qrel,hi,lut);}while(0)
  bool resc=false;
  #define START(P0,P1) do{ const float rm=rowmax(P0,P1); resc=false; \
    { const float dl=rm; mhat=fadd_s(mhat,dl); \
      _Pragma("unroll") for(int r=0;r<16;++r){P0[r]=fsub_s(P0[r],dl);P1[r]=fsub_s(P1[r],dl);} \
      _Pragma("unroll") for(int r=0;r<16;++r)negm[r]=-mhat; asm volatile("":"+v"(negm)); } \
    _Pragma("unroll") for(int r=0;r<16;++r)P0[r]=__builtin_amdgcn_exp2f(P0[r]); }while(0)
  #define RESC() do{ if(resc){ asm volatile("s_waitcnt lgkmcnt(0)":::"memory"); \
      _Pragma("unroll") for(int d_=0;d_<2;++d_) _Pragma("unroll") for(int r=0;r<16;++r)o[d_][r]*=wsf[crow(r,hi)]; } }while(0)
  f32x16 pA0,pA1,pB0,pB1;
  int sl_prev=0,sl_cur=0,sl_next=SLOTB;
  #define ROT() do{sl_prev=sl_cur;sl_cur=sl_next;sl_next=(sl_next==(NSLOT-1)*SLOTB)?0:sl_next+SLOTB;}while(0)
  DMA_K(2,2*SLOTB);
  WAIT_BAR(3);
  qkt(pA0,pA1,Kbase,qr,negm,r32,hi);asm volatile("s_nop 15\n\ts_nop 7":"+v"(pA0),"+v"(pA1));CMASK(pA0,pA1,0);
  START(pA0,pA1);
  _Pragma("unroll") for(int r=0;r<16;++r)pA1[r]=__builtin_amdgcn_exp2f(pA1[r]);
  WAIT_BAR(0);
  DMA_K(3,0);DMA_V(1,SLOTB);
  ROT();
  kload8(kf,kp0+sl_cur);
  WAIT_BAR(2);
  s16x4 vlo[8],vhi[8]; u32x4 pw0,pw1,pw2,pw3;
  #define PKW(P,B) cvtpk_s(P[B],P[B+1])
  #define PAF(k) __builtin_bit_cast(bf16x8,pw##k)
  #define VFR(i) (bf16x8){vlo[i][0],vlo[i][1],vlo[i][2],vlo[i][3],vhi[i][0],vhi[i][1],vhi[i][2],vhi[i][3]}
  #define PIN(x) asm volatile("":"+v"(x))
  #define MX3(a,b,c) __builtin_fmaxf(__builtin_fmaxf((a),(b)),(c))
  #define GAPA(MF,A0,A1,A2,A3,W0,W1,PW) do{ MF; sacc+=A0; sacc+=A1; sacc+=A2; sacc+=A3; PIN(sacc); W0; W1; PIN(PW); SBAR(); }while(0)
  #define EX(v) __builtin_amdgcn_exp2f(v)
  #define GAPB(MF,X,B) do{ MF; X[B]=EX(X[B]); X[B+1]=EX(X[B+1]); X[B+2]=EX(X[B+2]); X[B+3]=EX(X[B+3]); PIN(X); SBAR(); }while(0)
  #define VRD(i) do{ vlo[i]=vtr(vp_+(((i)>>2)*4096+((i)&3)*1024)); vhi[i]=vtr(vp_+(((i)>>2)*4096+((i)&3)*1024+512)); }while(0)
  #define KRD(G,j) do{ if(G){ kload2(kf,kp0+sl_next,j); SBAR(); } }while(0)
  #define STEP(C0,C1,P0,P1,t,GK,GV,GL) do{ SBAR(); \
    const lds_cptr vp_=vp0+sl_prev; \
    VRD(0); SBAR(); float sacc=(P0[0]+P0[1]); \
    GAPA(C0=__builtin_amdgcn_mfma_f32_32x32x16_bf16(kf[0],qr[0],negm,0,0,0), P0[2],P0[3],P0[4],P0[5],     pw0[0]=PKW(P0,0), pw0[1]=PKW(P0,2), pw0); \
    VRD(4); SBAR(); GAPA(C1=__builtin_amdgcn_mfma_f32_32x32x16_bf16(kf[1],qr[0],negm,0,0,0), P0[6],P0[7],P0[8],P0[9],     pw0[2]=PKW(P0,4), pw0[3]=PKW(P0,6), pw0); \
    VRD(1); SBAR(); GAPA(C0=__builtin_amdgcn_mfma_f32_32x32x16_bf16(kf[2],qr[1],C0,0,0,0),   P0[10],P0[11],P0[12],P0[13], pw1[0]=PKW(P0,8), pw1[1]=PKW(P0,10), pw1); \
    VRD(5); SBAR(); GAPA(C1=__builtin_amdgcn_mfma_f32_32x32x16_bf16(kf[3],qr[1],C1,0,0,0),   P0[14],P0[15],P1[0],P1[1],   pw1[2]=PKW(P0,12),pw1[3]=PKW(P0,14), pw1); \
    VRD(2); SBAR(); GAPA(C0=__builtin_amdgcn_mfma_f32_32x32x16_bf16(kf[4],qr[2],C0,0,0,0),   P1[2],P1[3],P1[4],P1[5],     pw2[0]=PKW(P1,0), pw2[1]=PKW(P1,2), pw2); \
    VRD(6); SBAR(); GAPA(C1=__builtin_amdgcn_mfma_f32_32x32x16_bf16(kf[5],qr[2],C1,0,0,0),   P1[6],P1[7],P1[8],P1[9],     pw2[2]=PKW(P1,4), pw2[3]=PKW(P1,6), pw2); \
    VRD(3); SBAR(); GAPA(C0=__builtin_amdgcn_mfma_f32_32x32x16_bf16(kf[6],qr[3],C0,0,0,0),   P1[10],P1[11],P1[12],P1[13], pw3[0]=PKW(P1,8), pw3[1]=PKW(P1,10), pw3); \
    VRD(7); SBAR(); GAPA(C1=__builtin_amdgcn_mfma_f32_32x32x16_bf16(kf[7],qr[3],C1,0,0,0),   P1[14],P1[15],0.f,0.f,       pw3[2]=PKW(P1,12),pw3[3]=PKW(P1,14), pw3); \
    l_reg+=sacc; \
    if(GK){DMA_K((t)+3,sl_cur);} if(GV){DMA_V((t)+1,sl_next);} \
    CMASK(C0,C1,t); \
    { float a=MX3(C0[0],C0[1],C1[0]),b=MX3(C0[2],C0[3],C1[1]); a=MX3(a,C1[2],C1[3]); \
      _Pragma("unroll") for(int r=4;r<16;r+=4){a=MX3(a,C0[r],C0[r+1]);b=MX3(b,C0[r+2],C0[r+3]);a=MX3(a,C1[r],C1[r+1]);b=MX3(b,C1[r+2],C1[r+3]);} \
      float rm=__builtin_fmaxf(a,b); { auto rr=__builtin_amdgcn_permlane32_swap(__float_as_uint(rm),__float_as_uint(rm),false,false); rm=__builtin_fmaxf(__uint_as_float(rr[0]),__uint_as_float(rr[1])); } \
      resc=false; \
      if(__builtin_expect(__any(rm>(float)THRL),0)){ const float dl=__builtin_fmaxf(rm,0.f); mhat+=dl; \
        _Pragma("unroll") for(int r=0;r<16;++r){C0[r]-=dl;C1[r]-=dl;} \
        _Pragma("unroll") for(int r=0;r<16;++r)negm[r]=-mhat; asm volatile("":"+v"(negm)); \
        const float f=__builtin_amdgcn_exp2f(-dl); l_reg*=f; if(hi==0)wsf[r32]=f; resc=true; } } \
    SBAR(); \
    GAPB(o[0]=__builtin_amdgcn_mfma_f32_32x32x16_bf16(PAF(0),VFR(0),o[0],0,0,0), C0,0); \
    GAPB(o[1]=__builtin_amdgcn_mfma_f32_32x32x16_bf16(PAF(0),VFR(4),o[1],0,0,0), C0,4); \
    KRD(GL,0); GAPB(o[0]=__builtin_amdgcn_mfma_f32_32x32x16_bf16(PAF(1),VFR(1),o[0],0,0,0), C0,8); \
    KRD(GL,1); GAPB(o[1]=__builtin_amdgcn_mfma_f32_32x32x16_bf16(PAF(1),VFR(5),o[1],0,0,0), C0,12); \
    KRD(GL,2); GAPB(o[0]=__builtin_amdgcn_mfma_f32_32x32x16_bf16(PAF(2),VFR(2),o[0],0,0,0), C1,0); \
    KRD(GL,3); GAPB(o[1]=__builtin_amdgcn_mfma_f32_32x32x16_bf16(PAF(2),VFR(6),o[1],0,0,0), C1,4); \
    GAPB(o[0]=__builtin_amdgcn_mfma_f32_32x32x16_bf16(PAF(3),VFR(3),o[0],0,0,0), C1,8); \
    GAPB(o[1]=__builtin_amdgcn_mfma_f32_32x32x16_bf16(PAF(3),VFR(7),o[1],0,0,0), C1,12); \
    }while(0)
  int t=1;
  #undef CMASK
  #define CMASK(P0,P1,t) do{}while(0)
  for(;t+7<NT;t+=2){
    STEP(pB0,pB1,pA0,pA1,t,true,true,true);     WAIT_BAR(2); RESC(); ROT();
    STEP(pA0,pA1,pB0,pB1,t+1,true,true,true);   WAIT_BAR(2); RESC(); ROT();
  }
  #undef CMASK
  #define CMASK(P0,P1,t) do{int jb_=(t)-(NT-6); if(jb_>=0)biasmask(P0,P1,jb_,qrel,hi,lut);}while(0)
  #define ENDW(tt) do{ if((tt)+3<NT){WAIT_BAR(2);} else if((tt)+2<NT){WAIT_BAR(1);} else {WAIT_BAR(0);} }while(0)
  for(;t+1<NT;t+=2){
    STEP(pB0,pB1,pA0,pA1,t,(t+3<NT),(t+1<NT),(t+1<NT));       ENDW(t);   RESC(); ROT();
    STEP(pA0,pA1,pB0,pB1,t+1,(t+4<NT),(t+2<NT),(t+2<NT));     ENDW(t+1); RESC(); ROT();
  }
  STEP(pB0,pB1,pA0,pA1,NT-1,false,false,false); RESC();
  { float sacc=pB0[0]+pB0[1]; _Pragma("unroll") for(int r=2;r<16;++r)sacc+=pB0[r]; _Pragma("unroll") for(int r=0;r<16;++r)sacc+=pB1[r]; l_reg+=sacc;
    pw0=(u32x4){PKW(pB0,0),PKW(pB0,2),PKW(pB0,4),PKW(pB0,6)};pw1=(u32x4){PKW(pB0,8),PKW(pB0,10),PKW(pB0,12),PKW(pB0,14)};pw2=(u32x4){PKW(pB1,0),PKW(pB1,2),PKW(pB1,4),PKW(pB1,6)};pw3=(u32x4){PKW(pB1,8),PKW(pB1,10),PKW(pB1,12),PKW(pB1,14)};
    SBAR(); pv(o,vb0+sl_cur,PAF(0),PAF(1),PAF(2),PAF(3)); }
  #undef PKW
  #undef PAF
  #undef VFR
  #undef PIN
  #undef MX3
  #undef GAPA
  #undef GAPB
  #undef EX
  #undef VRD
  #undef KRD
  #undef STEP
  #undef ENDW
  {auto rr=__builtin_amdgcn_permlane32_swap(__float_as_uint(l_reg),__float_as_uint(l_reg),false,false);l_reg=__uint_as_float(rr[0])+__uint_as_float(rr[1]);}
  if(hi==0)wsf[32+r32]=l_reg;asm volatile("s_waitcnt lgkmcnt(0)":::"memory");
  float rli[16];
  #pragma unroll
  for(int r=0;r<16;++r)rli[r]=__builtin_amdgcn_rcpf(wsf[32+crow(r,hi)]);
  bf16*Ow=O+(rowbase+q0+wid*QBLK)*PO;
  { bf16*stg=(bf16*)(shm+LDS_OST)+wid*2048;
    #pragma unroll
    for(int r=0;r<16;++r){const int orow=crow(r,hi);
      #pragma unroll
      for(int d0=0;d0<2;++d0)stg[orow*64+d0*32+r32]=__float2bfloat16(o[d0][r]*rli[r]);}
    asm volatile("s_waitcnt lgkmcnt(0)":::"memory");
    #pragma unroll
    for(int i=0;i<4;++i){const int row=i*8+(lane>>3),ch=lane&7; const u32x4 v=*(const u32x4*)(stg+row*64+ch*8); *(u32x4*)(Ow+(long)row*PO+ch*8)=v;} }
  asm volatile("s_waitcnt lgkmcnt(0)\n\ts_barrier":::"memory");
  #undef DMA_K
  #undef DMA_V
  #undef CMASK
  #undef START
  #undef RESC
  #undef ROT
}

constexpr int VSLOTB=16384, L2_K=0, L2_V=NSLOT*SLOTB, L2_WS=L2_V+NSLOT*VSLOTB, L2_QO=L2_WS+NW*64*4, L2_BYTES=L2_QO+NW*4096;
template<int THRL> __device__ __forceinline__ void attn_unit128(int b,int qb,const bf16*QKV,int Qc,int Kc,int Vc,bf16*O,const LAS float*lut,char*shm){
  int tid_=threadIdx.x; asm volatile("":"+v"(tid_)); const int tid=tid_,lane=tid&63,r32=lane&31,hi=lane>>5; const int wid=__builtin_amdgcn_readfirstlane(tid>>6);
  const long rowbase=(long)b*SEQ; const int q0=qb*QB;
  const bf16*Qw=QKV+(rowbase+q0+wid*QBLK)*PQ+Qc;
  const bf16*Kh=QKV+rowbase*PQ+Kc,*Vh=QKV+rowbase*PQ+Vc;
  const unsigned lds0=(unsigned)(uintptr_t)shm;
  float*wsf=(float*)(shm+L2_WS)+wid*64;
  const bf16*ksrc=Kh+(long)lane*PQ+wid*8;
  const bf16*vsrc=Vh+(long)(16*(wid&3)+(lane>>2))*PQ+(wid>>2)*32+(lane&3)*8;
  const unsigned kdst=lds0+L2_K+wid*1024, vdst=lds0+L2_V+wid*1024;
  #define DMA_K(t,slot) glds16(ksrc+(long)(t)*KVBLK*PQ,(unsigned)__builtin_amdgcn_readfirstlane(kdst+(slot)))
  #define DMA_V(t,slot) do{ glds16(vsrc+(long)(t)*KVBLK*PQ,(unsigned)__builtin_amdgcn_readfirstlane(vdst+2*(slot))); glds16(vsrc+(long)(t)*KVBLK*PQ+64,(unsigned)__builtin_amdgcn_readfirstlane(vdst+2*(slot)+8192)); }while(0)
  const int vb0=(int)(lds0+L2_V)+((lane>>4)&1)*32+(lane&3)*8+(4*hi+((lane&15)>>2))*64;
  const char*Kbase=shm+L2_K; bf16x8 kf[8];
  const lds_cptr shm3=(lds_cptr)shm; const lds_cptr kp0=shm3+L2_K+hi*1024+r32*16; const lds_cptr vp0=shm3+L2_V+((lane>>4)&1)*32+(lane&3)*8+(4*hi+((lane&15)>>2))*64;
  const lds_cptr qst=shm3+L2_QO+wid*4096+lane*16;
  const int NT=(q0+QB)/KVBLK;
  DMA_K(0,0);DMA_V(0,0);DMA_K(1,SLOTB);
  { bf16x8 qr[4];
    #pragma unroll
    for(int d0=0;d0<4;++d0)qr[d0]=*reinterpret_cast<const bf16x8*>(&Qw[(long)r32*PQ+d0*16+hi*8]);
    #pragma unroll
    for(int d0=0;d0<4;++d0)*(LAS bf16x8*)(qst+d0*1024)=qr[d0]; }
  float mhat=0.f,l_reg=0.f;f32x16 o[4]; { float zz; asm volatile("v_mov_b32 %0, 0":"=v"(zz)); _Pragma("unroll") for(int r=0;r<16;++r){o[0][r]=zz;o[1][r]=zz;o[2][r]=zz;o[3][r]=zz;} }
  const int qrel=wid*QBLK+r32;
  #define QF(d0) (*(const LAS bf16x8*)(qst+(d0)*1024))
  #define CMASK(P0,P1,t) do{int jb_=(t)-(NT-6); if(jb_>=0)biasmask(P0,P1,jb_,qrel,hi,lut);}while(0)
  bool resc=false;
  #define RESC() do{ if(resc){ asm volatile("s_waitcnt lgkmcnt(0)":::"memory"); \
      _Pragma("unroll") for(int d_=0;d_<4;++d_) _Pragma("unroll") for(int r=0;r<16;++r)o[d_][r]*=wsf[crow(r,hi)]; } }while(0)
  f32x16 pA0,pA1,pB0,pB1;
  int sl_prev=0,sl_cur=0,sl_next=SLOTB;
  #define ROT() do{sl_prev=sl_cur;sl_cur=sl_next;sl_next=(sl_next==(NSLOT-1)*SLOTB)?0:sl_next+SLOTB;}while(0)
  DMA_K(2,2*SLOTB);
  WAIT_BAR(3);
  {
    const char*kb=Kbase+hi*1024+r32*16; const f32x16 z16={};
    #pragma unroll
    for(int d0=0;d0<4;++d0){ const bf16x8 qf=QF(d0);
      const bf16x8 b0=*reinterpret_cast<const bf16x8*>(kb+d0*2048); const bf16x8 b1=*reinterpret_cast<const bf16x8*>(kb+d0*2048+512);
      if(d0==0){pA0=__builtin_amdgcn_mfma_f32_32x32x16_bf16(b0,qf,z16,0,0,0);pA1=__builtin_amdgcn_mfma_f32_32x32x16_bf16(b1,qf,z16,0,0,0);}
      else{pA0=__builtin_amdgcn_mfma_f32_32x32x16_bf16(b0,qf,pA0,0,0,0);pA1=__builtin_amdgcn_mfma_f32_32x32x16_bf16(b1,qf,pA1,0,0,0);} }
    asm volatile("s_nop 15\n\ts_nop 7":"+v"(pA0),"+v"(pA1));CMASK(pA0,pA1,0);
    mhat=rowmax(pA0,pA1);
    #pragma unroll
    for(int r=0;r<16;++r){pA0[r]=__builtin_amdgcn_exp2f(pA0[r]-mhat);pA1[r]=__builtin_amdgcn_exp2f(pA1[r]-mhat);} }
  WAIT_BAR(0);
  DMA_K(3,0);DMA_V(1,SLOTB);
  ROT();
  kload8(kf,kp0+sl_cur);
  WAIT_BAR(3);
  s16x4 vlo[8],vhi[8]; u32x4 pw0,pw1,pw2,pw3;
  #define PKW(P,B) cvtpk_s(P[B],P[B+1])
  #define PAF(k) __builtin_bit_cast(bf16x8,pw##k)
  #define VFR(i) (bf16x8){vlo[i][0],vlo[i][1],vlo[i][2],vlo[i][3],vhi[i][0],vhi[i][1],vhi[i][2],vhi[i][3]}
  #define PIN(x) asm volatile("":"+v"(x))
  #define MX3(a,b,c) __builtin_fmaxf(__builtin_fmaxf((a),(b)),(c))
  #define MFQ(C,kk,qv,Cin) C=__builtin_amdgcn_mfma_f32_32x32x16_bf16(kf[kk],qv,Cin,0,0,0)
  #define GAPA(MF,A0,A1,A2,A3,W0,W1,PW) do{ MF; sacc+=A0; sacc+=A1; sacc+=A2; sacc+=A3; PIN(sacc); W0; W1; PIN(PW); SBAR(); }while(0)
  #define EX(v) __builtin_amdgcn_exp2f((v)-mhat)
  #define GAPB(MF,X,B) do{ MF; X[B]=EX(X[B]); X[B+1]=EX(X[B+1]); PIN(X); SBAR(); }while(0)
  #define VRD(i) do{ vlo[(i)&7]=vtr(vp_+(((i)>>2)*4096+((i)&3)*1024)); vhi[(i)&7]=vtr(vp_+(((i)>>2)*4096+((i)&3)*1024+512)); }while(0)
  #define KRD(G,j) do{ if(G){ kload2(kf,kp0+sl_next,j); SBAR(); } }while(0)
  #define STEP(C0,C1,P0,P1,t,GK,GV,GL) do{ SBAR(); \
    const lds_cptr vp_=vp0+2*sl_prev; const f32x16 z16={}; bf16x8 qf; \
    VRD(0); qf=QF(0); SBAR(); float sacc=(P0[0]+P0[1]); \
    GAPA(MFQ(C0,0,qf,z16), P0[2],P0[3],P0[4],P0[5],     pw0[0]=PKW(P0,0), pw0[1]=PKW(P0,2), pw0); \
    VRD(4); SBAR(); GAPA(MFQ(C1,1,qf,z16), P0[6],P0[7],P0[8],P0[9],     pw0[2]=PKW(P0,4), pw0[3]=PKW(P0,6), pw0); \
    VRD(1); qf=QF(1); SBAR(); GAPA(MFQ(C0,2,qf,C0),   P0[10],P0[11],P0[12],P0[13], pw1[0]=PKW(P0,8), pw1[1]=PKW(P0,10), pw1); \
    VRD(5); SBAR(); GAPA(MFQ(C1,3,qf,C1),   P0[14],P0[15],P1[0],P1[1],   pw1[2]=PKW(P0,12),pw1[3]=PKW(P0,14), pw1); \
    VRD(2); qf=QF(2); SBAR(); GAPA(MFQ(C0,4,qf,C0),   P1[2],P1[3],P1[4],P1[5],     pw2[0]=PKW(P1,0), pw2[1]=PKW(P1,2), pw2); \
    VRD(6); SBAR(); GAPA(MFQ(C1,5,qf,C1),   P1[6],P1[7],P1[8],P1[9],     pw2[2]=PKW(P1,4), pw2[3]=PKW(P1,6), pw2); \
    VRD(3); qf=QF(3); SBAR(); GAPA(MFQ(C0,6,qf,C0),   P1[10],P1[11],P1[12],P1[13], pw3[0]=PKW(P1,8), pw3[1]=PKW(P1,10), pw3); \
    VRD(7); SBAR(); GAPA(MFQ(C1,7,qf,C1),   P1[14],P1[15],0.f,0.f,       pw3[2]=PKW(P1,12),pw3[3]=PKW(P1,14), pw3); \
    l_reg+=sacc; \
    if(GK){DMA_K((t)+3,sl_cur);} if(GV){DMA_V((t)+1,sl_next);} \
    CMASK(C0,C1,t); \
    { float a=MX3(C0[0],C0[1],C1[0]),b=MX3(C0[2],C0[3],C1[1]); a=MX3(a,C1[2],C1[3]); \
      _Pragma("unroll") for(int r=4;r<16;r+=4){a=MX3(a,C0[r],C0[r+1]);b=MX3(b,C0[r+2],C0[r+3]);a=MX3(a,C1[r],C1[r+1]);b=MX3(b,C1[r+2],C1[r+3]);} \
      float rm=__builtin_fmaxf(a,b); { auto rr=__builtin_amdgcn_permlane32_swap(__float_as_uint(rm),__float_as_uint(rm),false,false); rm=__builtin_fmaxf(__uint_as_float(rr[0]),__uint_as_float(rr[1])); } \
      rm-=mhat; resc=false; \
      if(__builtin_expect(__any(rm>(float)THRL),0)){ const float dl=__builtin_fmaxf(rm,0.f); mhat+=dl; \
        const float f=__builtin_amdgcn_exp2f(-dl); l_reg*=f; if(hi==0)wsf[r32]=f; resc=true; } } \
    SBAR(); \
    GAPB(o[0]=__builtin_amdgcn_mfma_f32_32x32x16_bf16(PAF(0),VFR(0),o[0],0,0,0), C0,0);  VRD(8);  SBAR(); \
    GAPB(o[1]=__builtin_amdgcn_mfma_f32_32x32x16_bf16(PAF(0),VFR(4),o[1],0,0,0), C0,2);  VRD(12); SBAR(); \
    GAPB(o[0]=__builtin_amdgcn_mfma_f32_32x32x16_bf16(PAF(1),VFR(1),o[0],0,0,0), C0,4);  VRD(9);  SBAR(); \
    GAPB(o[1]=__builtin_amdgcn_mfma_f32_32x32x16_bf16(PAF(1),VFR(5),o[1],0,0,0), C0,6);  VRD(13); SBAR(); \
    GAPB(o[0]=__builtin_amdgcn_mfma_f32_32x32x16_bf16(PAF(2),VFR(2),o[0],0,0,0), C0,8);  VRD(10); SBAR(); \
    GAPB(o[1]=__builtin_amdgcn_mfma_f32_32x32x16_bf16(PAF(2),VFR(6),o[1],0,0,0), C0,10); VRD(14); SBAR(); \
    GAPB(o[0]=__builtin_amdgcn_mfma_f32_32x32x16_bf16(PAF(3),VFR(3),o[0],0,0,0), C0,12); VRD(11); SBAR(); \
    GAPB(o[1]=__builtin_amdgcn_mfma_f32_32x32x16_bf16(PAF(3),VFR(7),o[1],0,0,0), C0,14); VRD(15); SBAR(); \
    GAPB(o[2]=__builtin_amdgcn_mfma_f32_32x32x16_bf16(PAF(0),VFR(0),o[2],0,0,0), C1,0); \
    GAPB(o[3]=__builtin_amdgcn_mfma_f32_32x32x16_bf16(PAF(0),VFR(4),o[3],0,0,0), C1,2); \
    KRD(GL,0); GAPB(o[2]=__builtin_amdgcn_mfma_f32_32x32x16_bf16(PAF(1),VFR(1),o[2],0,0,0), C1,4); \
    KRD(GL,1); GAPB(o[3]=__builtin_amdgcn_mfma_f32_32x32x16_bf16(PAF(1),VFR(5),o[3],0,0,0), C1,6); \
    KRD(GL,2); GAPB(o[2]=__builtin_amdgcn_mfma_f32_32x32x16_bf16(PAF(2),VFR(2),o[2],0,0,0), C1,8); \
    KRD(GL,3); GAPB(o[3]=__builtin_amdgcn_mfma_f32_32x32x16_bf16(PAF(2),VFR(6),o[3],0,0,0), C1,10); \
    GAPB(o[2]=__builtin_amdgcn_mfma_f32_32x32x16_bf16(PAF(3),VFR(3),o[2],0,0,0), C1,12); \
    GAPB(o[3]=__builtin_amdgcn_mfma_f32_32x32x16_bf16(PAF(3),VFR(7),o[3],0,0,0), C1,14); \
    }while(0)
  int t=1;
  #undef CMASK
  #define CMASK(P0,P1,t) do{}while(0)
  for(;t+7<NT;t+=2){
    STEP(pB0,pB1,pA0,pA1,t,true,true,true);     WAIT_BAR(3); RESC(); ROT();
    STEP(pA0,pA1,pB0,pB1,t+1,true,true,true);   WAIT_BAR(3); RESC(); ROT();
  }
  #undef CMASK
  #define CMASK(P0,P1,t) do{int jb_=(t)-(NT-6); if(jb_>=0)biasmask(P0,P1,jb_,qrel,hi,lut);}while(0)
  #define ENDW(tt) do{ if((tt)+3<NT){WAIT_BAR(3);} else if((tt)+2<NT){WAIT_BAR(2);} else {WAIT_BAR(0);} }while(0)
  for(;t+1<NT;t+=2){
    STEP(pB0,pB1,pA0,pA1,t,(t+3<NT),(t+1<NT),(t+1<NT));       ENDW(t);   RESC(); ROT();
    STEP(pA0,pA1,pB0,pB1,t+1,(t+4<NT),(t+2<NT),(t+2<NT));     ENDW(t+1); RESC(); ROT();
  }
  STEP(pB0,pB1,pA0,pA1,NT-1,false,false,false); RESC();
  { float sacc=pB0[0]+pB0[1]; _Pragma("unroll") for(int r=2;r<16;++r)sacc+=pB0[r]; _Pragma("unroll") for(int r=0;r<16;++r)sacc+=pB1[r]; l_reg+=sacc;
    pw0=(u32x4){PKW(pB0,0),PKW(pB0,2),PKW(pB0,4),PKW(pB0,6)};pw1=(u32x4){PKW(pB0,8),PKW(pB0,10),PKW(pB0,12),PKW(pB0,14)};pw2=(u32x4){PKW(pB1,0),PKW(pB1,2),PKW(pB1,4),PKW(pB1,6)};pw3=(u32x4){PKW(pB1,8),PKW(pB1,10),PKW(pB1,12),PKW(pB1,14)};
    SBAR();
    const int vb=vb0+2*sl_cur;
    #pragma unroll
    for(int d0=0;d0<4;++d0){s16x4 lo[4],hh[4];
      #pragma unroll
      for(int ks=0;ks<4;++ks){
        asm volatile("ds_read_b64_tr_b16 %0,%1 offset:%c2":"=&v"(lo[ks]):"v"(vb),"i"(d0*4096+ks*1024):"memory");
        asm volatile("ds_read_b64_tr_b16 %0,%1 offset:%c2":"=&v"(hh[ks]):"v"(vb),"i"(d0*4096+ks*1024+512):"memory");}
      asm volatile("s_waitcnt lgkmcnt(0)":::"memory");SBAR();
      #define PK(k) (bf16x8){lo[k][0],lo[k][1],lo[k][2],lo[k][3],hh[k][0],hh[k][1],hh[k][2],hh[k][3]}
      o[d0]=__builtin_amdgcn_mfma_f32_32x32x16_bf16(PAF(0),PK(0),o[d0],0,0,0);
      o[d0]=__builtin_amdgcn_mfma_f32_32x32x16_bf16(PAF(1),PK(1),o[d0],0,0,0);
      o[d0]=__builtin_amdgcn_mfma_f32_32x32x16_bf16(PAF(2),PK(2),o[d0],0,0,0);
      o[d0]=__builtin_amdgcn_mfma_f32_32x32x16_bf16(PAF(3),PK(3),o[d0],0,0,0);
      #undef PK
    } }
  #undef PKW
  #undef PAF
  #undef VFR
  #undef PIN
  #undef MX3
  #undef MFQ
  #undef GAPA
  #undef GAPB
  #undef EX
  #undef VRD
  #undef KRD
  #undef STEP
  #undef ENDW
  #undef QF
  {auto rr=__builtin_amdgcn_permlane32_swap(__float_as_uint(l_reg),__float_as_uint(l_reg),false,false);l_reg=__uint_as_float(rr[0])+__uint_as_float(rr[1]);}
  if(hi==0)wsf[32+r32]=l_reg;asm volatile("s_waitcnt lgkmcnt(0)":::"memory");
  float rli[16];
  #pragma unroll
  for(int r=0;r<16;++r)rli[r]=__builtin_amdgcn_rcpf(wsf[32+crow(r,hi)]);
  bf16*Ow=O+(rowbase+q0+wid*QBLK)*PO;
  { bf16*stg=(bf16*)(shm+L2_QO)+wid*2048;
    #pragma unroll
    for(int hh=0;hh<2;++hh){
      #pragma unroll
      for(int r=0;r<16;++r){const int orow=crow(r,hi);
        #pragma unroll
        for(int d0=0;d0<2;++d0)stg[orow*64+d0*32+r32]=__float2bfloat16(o[2*hh+d0][r]*rli[r]);}
      asm volatile("s_waitcnt lgkmcnt(0)":::"memory");
      #pragma unroll
      for(int i=0;i<4;++i){const int row=i*8+(lane>>3),ch=lane&7; const u32x4 v=*(const u32x4*)(stg+row*64+ch*8); *(u32x4*)(Ow+(long)row*PO+hh*64+ch*8)=v;}
      asm volatile("s_waitcnt lgkmcnt(0)":::"memory"); } }
  asm volatile("s_waitcnt lgkmcnt(0)\n\ts_barrier":::"memory");
  #undef DMA_K
  #undef DMA_V
  #undef CMASK
  #undef RESC
  #undef ROT
}

constexpr int ATTN_LDS_BYTES=LDS_BYTES;
#undef SBAR
#undef WAIT_BAR
}
constexpr int NWAVES = 8;
typedef unsigned short bf16;
typedef unsigned v4u __attribute__((ext_vector_type(4)));
typedef unsigned v2u __attribute__((ext_vector_type(2)));
typedef float f32x4 __attribute__((ext_vector_type(4)));
typedef float f32x2 __attribute__((ext_vector_type(2)));
typedef short bf16x8 __attribute__((ext_vector_type(8)));
typedef GAS unsigned gu32;
#define RLX_AGENT __ATOMIC_RELAXED, __HIP_MEMORY_SCOPE_AGENT
#define LDS_WAIT() asm volatile("s_waitcnt lgkmcnt(0)" ::: "memory")
#define VM_WAIT() asm volatile("s_waitcnt vmcnt(0)" ::: "memory")
__device__ __forceinline__ unsigned f2bf(float f) { unsigned u = __builtin_bit_cast(unsigned, f); return (u + 0x7fffu + ((u >> 16) & 1u)) >> 16; }
__device__ __forceinline__ unsigned pk2(float lo, float hi) { return f2bf(lo) | (f2bf(hi) << 16); }
__device__ __forceinline__ float bf2f(unsigned short b) { return __builtin_bit_cast(float, (unsigned)b << 16); }
__device__ __forceinline__ float bflo(unsigned w) { return __builtin_bit_cast(float, w << 16); }
__device__ __forceinline__ float bfhi(unsigned w) { return __builtin_bit_cast(float, w & 0xffff0000u); }

#define XB_TMO      128
#define XB_XCNT(j)  (256  + 64 * (j))
#define XB_XSUB(j)  (1280 + 64 * (j))
#define XB_XGEN(j)  (2304 + 64 * (j))
#define XB_TOP      3328
#define XB_TOPGEN   3392
#define XCD_BAR_WORDS 3456
#define XB_SPIN_CAP (1u << 18)
__device__ __forceinline__ unsigned xb_ld(unsigned* p)              { return __hip_atomic_load(p, __ATOMIC_RELAXED, __HIP_MEMORY_SCOPE_AGENT); }
__device__ __forceinline__ unsigned xb_add(unsigned* p, unsigned v) { return __hip_atomic_fetch_add(p, v, __ATOMIC_RELAXED, __HIP_MEMORY_SCOPE_AGENT); }
__device__ __forceinline__ unsigned xb_xcc_id() { return (unsigned)__builtin_amdgcn_s_getreg((3 << 11) | 20) & 0xFu; }
#define XB_SPIN(cond, bar) do { unsigned _sp = 0; while (cond) { __builtin_amdgcn_s_sleep(1); \
    if ((++_sp & 255u) == 0u) { if (xb_ld(&(bar)[XB_TMO])) break; if (_sp > XB_SPIN_CAP) { atomicAdd(&(bar)[XB_TMO], 1u); break; } } } } while (0)
struct XcdBarrier { unsigned* bar; unsigned x; volatile LAS unsigned* st; };
__device__ __forceinline__ XcdBarrier xcd_barrier_post(unsigned* bar, volatile LAS unsigned* st) {
    XcdBarrier b; b.bar = bar; b.x = xb_xcc_id(); b.st = st;
    if (threadIdx.x == 0) (void)xb_add(&bar[XB_XCNT(b.x)], 1u);
    return b;
}
__device__ __forceinline__ void xcd_barrier_complete(unsigned* bar, unsigned x, unsigned& nloc, unsigned& nx) {
    const unsigned G = gridDim.x * gridDim.y * gridDim.z;
    unsigned sum, cnt, mine, sp = 0u;
    for (;;) {
        sum = 0u; cnt = 0u; mine = 0u;
#pragma unroll
        for (unsigned j = 0; j < 16; ++j) { const unsigned c = xb_ld(&bar[XB_XCNT(j)]); sum += c; cnt += (c > 0u) ? 1u : 0u; mine = (j == x) ? c : mine; }
        if (sum == G) break;
        __builtin_amdgcn_s_sleep(1);
        if ((++sp & 255u) == 0u) { if (xb_ld(&bar[XB_TMO])) break; if (sp > XB_SPIN_CAP) { atomicAdd(&bar[XB_TMO], 1u); break; } }
    }
    nloc = mine > 0u ? mine : 1u; nx = cnt > 0u ? cnt : 1u;
}
__device__ __forceinline__ void xcd_barrier(const XcdBarrier& b) {
    asm volatile("s_waitcnt vmcnt(0)" ::: "memory");
    __syncthreads();
    if (threadIdx.x == 0) {
        unsigned* bar = b.bar;
        __builtin_amdgcn_s_waitcnt(0);
        unsigned nloc = b.st[0], nx = b.st[1];
        if (nloc == 0u) { xcd_barrier_complete(bar, b.x, nloc, nx); b.st[0] = nloc; b.st[1] = nx; }
        const unsigned old = xb_add(&bar[XB_XSUB(b.x)], 1u);
        const unsigned gen = old / nloc;
        if (old + 1u == (gen + 1u) * nloc) {
            __builtin_amdgcn_fence(__ATOMIC_RELEASE, "agent");
            asm volatile("s_waitcnt vmcnt(0)" ::: "memory");
            const unsigned og = xb_add(&bar[XB_TOP], 1u);
            const unsigned tg = og / nx;
            if (og + 1u == (tg + 1u) * nx) xb_add(&bar[XB_TOPGEN], 1u);
            else XB_SPIN(xb_ld(&bar[XB_TOPGEN]) == tg, bar);
            __builtin_amdgcn_fence(__ATOMIC_ACQUIRE, "agent");
            xb_add(&bar[XB_XGEN(b.x)], 1u);
            asm volatile("s_waitcnt vmcnt(0)" ::: "memory");
        } else {
            XB_SPIN(xb_ld(&bar[XB_XGEN(b.x)]) == gen, bar);
            __builtin_amdgcn_fence(__ATOMIC_ACQUIRE, "agent");
            asm volatile("s_waitcnt vmcnt(0)" ::: "memory");
        }
    }
    __syncthreads();
}

struct Args { const float* in[18]; float* out; unsigned char* ws; int ph_lo, ph_hi, li, pad; };
struct Frame {
    LAS unsigned char* lds;
    gu32* ctl;
    unsigned char* ws;
    int tid, lane, wave;
    int vcu, G;
};

__device__ __forceinline__ float wave_sum(float v) {
#pragma unroll
    for (int o = 1; o < 64; o <<= 1) v += __shfl_xor(v, o);
    return v;
}
__device__ __forceinline__ void transpose_block(const float* src, int ld_src, bf16* dst, int ld_dst, LAS float* scr, int lane, bf16* dst2) {
#pragma unroll 8
    for (int i = 0; i < 32; ++i) { const int kk = 2 * i + (lane >> 5); scr[kk * 33 + (lane & 31)] = __builtin_nontemporal_load(src + (size_t)kk * ld_src + (lane & 31)); }
    LDS_WAIT(); asm volatile("" ::: "memory");
    const int c = lane & 7;
#pragma unroll
    for (int j = 0; j < 4; ++j) { const int n = (lane >> 3) + 8 * j; const LAS float* s = scr + (8 * c) * 33 + n;
        v4u o; o.x = pk2(s[0 * 33], s[1 * 33]); o.y = pk2(s[2 * 33], s[3 * 33]); o.z = pk2(s[4 * 33], s[5 * 33]); o.w = pk2(s[6 * 33], s[7 * 33]);
        *(GAS v4u*)(dst + (size_t)n * ld_dst + 8 * c) = o;
        if (dst2) *(GAS v4u*)(dst2 + (size_t)n * ld_dst + 8 * c) = o; }
    LDS_WAIT(); asm volatile("" ::: "memory");
}
__device__ __forceinline__ unsigned pk4_fp8f(float a, float b, float c, float d) { int w = 0; w = __builtin_amdgcn_cvt_pk_fp8_f32(a, b, w, false); w = __builtin_amdgcn_cvt_pk_fp8_f32(c, d, w, true); return (unsigned)w; }
__device__ __forceinline__ void transpose_block8(const float* src, int ld_src, unsigned char* dst, int ld_dst, float sc, LAS float* scr, int lane, unsigned char* dst2 = nullptr) {
#pragma unroll 8
    for (int i = 0; i < 32; ++i) { const int kk = 2 * i + (lane >> 5); scr[kk * 33 + (lane & 31)] = __builtin_nontemporal_load(src + (size_t)kk * ld_src + (lane & 31)); }
    LDS_WAIT(); asm volatile("" ::: "memory");
    const int c = lane & 7;
#pragma unroll
    for (int j = 0; j < 4; ++j) { const int n = (lane >> 3) + 8 * j; const LAS float* s = scr + (8 * c) * 33 + n;
        v2u o; o.x = pk4_fp8f(s[0 * 33] * sc, s[1 * 33] * sc, s[2 * 33] * sc, s[3 * 33] * sc); o.y = pk4_fp8f(s[4 * 33] * sc, s[5 * 33] * sc, s[6 * 33] * sc, s[7 * 33] * sc);
        *(GAS v2u*)(dst + (size_t)n * ld_dst + 8 * c) = o;
        if (dst2) *(GAS v2u*)(dst2 + (size_t)n * ld_dst + 8 * c) = o; }
    LDS_WAIT(); asm volatile("" ::: "memory");
}
__device__ __forceinline__ void rms_row_to_bf16(int lane, const float* xrow, const float* g, bf16* orow) {
    const GAS f32x4* xr = (const GAS f32x4*)xrow + lane; const GAS f32x4* gr = (const GAS f32x4*)g + lane;
    f32x4 v[4]; float s = 0.f;
#pragma unroll
    for (int j = 0; j < 4; ++j) { v[j] = xr[64 * j]; s += (v[j].x * v[j].x + v[j].y * v[j].y) + (v[j].z * v[j].z + v[j].w * v[j].w); }
    const float rstd = 1.0f / sqrtf(wave_sum(s) * (1.f / 1024.f) + RMS_EPS);
    GAS v2u* o8 = (GAS v2u*)orow + lane;
#pragma unroll
    for (int j = 0; j < 4; ++j) { const f32x4 gg = gr[64 * j]; v2u o; o.x = pk2(v[j].x * rstd * gg.x, v[j].y * rstd * gg.y); o.y = pk2(v[j].z * rstd * gg.z, v[j].w * rstd * gg.w); o8[64 * j] = o; }
}

__device__ __forceinline__ void rms_row_to_fp8(int lane, const float* xrow, const float* g, unsigned char* orow) {
    const GAS f32x4* xr = (const GAS f32x4*)xrow + lane; const GAS f32x4* gr = (const GAS f32x4*)g + lane;
    f32x4 v[4]; float s = 0.f;
#pragma unroll
    for (int j = 0; j < 4; ++j) { v[j] = xr[64 * j]; s += (v[j].x * v[j].x + v[j].y * v[j].y) + (v[j].z * v[j].z + v[j].w * v[j].w); }
    const float rstd = H8_SCALE / sqrtf(wave_sum(s) * (1.f / 1024.f) + RMS_EPS);
    GAS unsigned* o4 = (GAS unsigned*)orow + lane;
#pragma unroll
    for (int j = 0; j < 4; ++j) { const f32x4 gg = gr[64 * j]; o4[64 * j] = pk4_fp8f(v[j].x * rstd * gg.x, v[j].y * rstd * gg.y, v[j].z * rstd * gg.z, v[j].w * rstd * gg.w); }
}
constexpr int IT_WIN0 = (1024 / 64) * (3072 / 32);
constexpr int IT_WOUT0 = (1024 / 64) * (1024 / 32);
constexpr int IT_RIN = (1024 / 64) * (6144 / 32);
constexpr int IT_ROUT = (2048 / 64) * (1024 / 32);
constexpr int IT_SHARED = IT_WIN0 + IT_WOUT0 + IT_RIN + IT_ROUT;
constexpr int IT_EXP = 3 * 256;
constexpr int IT_MOE = NEXP * IT_EXP;
__device__ __forceinline__ void conv_shared_item(Frame& F, const Args& a, int it, LAS float* scr) {
    unsigned char* ws = F.ws;
    if (it < IT_WIN0) { const int nblk = 96, kb = it / nblk, nb = it % nblk;
        if (QKV_FP8) transpose_block8(a.in[5] + (size_t)(64 * kb) * 3072 + 32 * nb, 3072, ws + WS_WINT0 + (size_t)(32 * nb) * 1024 + 64 * kb, 1024, WIN_SCALE, scr, F.lane);
        else transpose_block(a.in[5] + (size_t)(64 * kb) * 3072 + 32 * nb, 3072, (bf16*)(ws + WS_WINT0) + (size_t)(32 * nb) * 1024 + 64 * kb, 1024, scr, F.lane, nullptr);
        return; }
    it -= IT_WIN0;
    if (it < IT_WOUT0) { const int nblk = 32, kb = it / nblk, nb = it % nblk;
        transpose_block(a.in[8] + (size_t)(64 * kb) * 1024 + 32 * nb, 1024, (bf16*)(ws + WS_WOUTT0) + (size_t)(32 * nb) * 1024 + 64 * kb, 1024, scr, F.lane, nullptr); return; }
    it -= IT_WOUT0;
    if (it < IT_RIN) { const int nblk = 192, kb = it / nblk, nb = it % nblk, n0 = 32 * nb;
        unsigned char* A = ws + WS_WRINA; unsigned char* B = ws + WS_WRINB; unsigned char *d1, *d2 = nullptr;
        if (n0 < 2048) d1 = A + (size_t)n0 * 1024;
        else if (n0 < 4096) d1 = B + (size_t)(n0 - 2048) * 1024;
        else d1 = A + (size_t)(n0 - 2048) * 1024;
        transpose_block8(a.in[9] + (size_t)(64 * kb) * 6144 + n0, 6144, d1 + 64 * kb, 1024, WIN_SCALE, scr, F.lane, d2 ? d2 + 64 * kb : nullptr); return; }
    it -= IT_RIN;
    { const int nblk = 32, kb = it / nblk, nb = it % nblk;
        transpose_block(a.in[10] + (size_t)(64 * kb) * 1024 + 32 * nb, 1024, (bf16*)(ws + WS_WROUTT) + (size_t)(32 * nb) * 2048 + 64 * kb, 2048, scr, F.lane, nullptr); }
}
__device__ __forceinline__ void conv_moe_item(Frame& F, const Args& a, int layer, int it, LAS float* scr) {
    unsigned char* ws = F.ws;
    const int e = it / IT_EXP; int r = it % IT_EXP; const size_t le = (size_t)layer * NEXP + e;
    if (r < 512) { const int up = r >> 8; r &= 255; const int kb = r / 16, nb = r % 16, n0 = 32 * nb;
        const float* src = a.in[up ? 16 : 15] + le * (1024 * 512) + (size_t)(64 * kb) * 512 + n0;
        const int drow = 256 * (n0 >> 7) + 128 * up + (n0 & 127);
        transpose_block8(src, 512, ws + WS_W1CAT + ((size_t)e * 1024 + drow) * 1024 + 64 * kb, 1024, W1_SCALE, scr, F.lane); return; }
    r -= 512; { const int kb = r / 32, nb = r % 32;
        const float* src = a.in[17] + le * (512 * 1024) + (size_t)(64 * kb) * 1024 + 32 * nb;
        transpose_block8(src, 1024, ws + WS_W2T + ((size_t)e * 1024 + 32 * nb) * 512 + 64 * kb, 512, W2_SCALE, scr, F.lane); }
}
__device__ __forceinline__ void build_router_frags(Frame& F, const Args& a, int gtid, int gthreads) {
    bf16* wrf = (bf16*)(F.ws + WS_WRF);
    for (int idx = gtid; idx < 2 * 32 * 3 * 64 * 8; idx += gthreads) {
        const int j = idx & 7, lane = (idx >> 3) & 63, nt = (idx >> 9) % 3, s = ((idx >> 9) / 3) & 31, L = (idx >> 9) / 96;
        const int k = 32 * s + 8 * (lane >> 4) + j, o = 16 * nt + (lane & 15);
        float w = 0.f;
        if (o < 4) w = a.in[11][((size_t)L * 1024 + k) * 4 + o]; else if (o < 36) w = a.in[13][((size_t)L * 1024 + k) * 32 + (o - 4)];
        w *= a.in[3][L * 1024 + k];
        const unsigned hi = f2bf(w); const float lo = w - __builtin_bit_cast(float, hi << 16);
        const size_t base = ((((size_t)L * 32 + s) * 3 + nt) * 2) * 512 + (size_t)lane * 8 + j;
        wrf[base] = (bf16)hi; wrf[base + 512] = (bf16)f2bf(lo);
    }
}
__device__ __forceinline__ void build_sincos(Frame& F, int gtid, int gthreads) {
    float* t1 = (float*)(F.ws + WS_SINCOS);
    for (int idx = gtid; idx < SEQ * 128; idx += gthreads) {
        const int pos = idx >> 7, i = idx & 127;
        double ang = 1.0, bs = 0.9300449458481391;
        for (int bit = 0; bit < 7; ++bit) { if ((i >> bit) & 1) ang *= bs; bs *= bs; }
        const double ph = (double)pos * ang;
        const double kq = __builtin_rint(ph * 0.63661977236758134308);
        double r = __builtin_fma(-kq, 1.57079632679489655800, ph); r = __builtin_fma(-kq, 6.12323399573676603587e-17, r);
        const double r2 = r * r;
        double sn = r * (1.0 + r2 * (-1.0 / 6 + r2 * (1.0 / 120 + r2 * (-1.0 / 5040 + r2 * (1.0 / 362880 + r2 * (-1.0 / 39916800 + r2 * (1.0 / 6227020800.0)))))));
        double cs = 1.0 + r2 * (-0.5 + r2 * (1.0 / 24 + r2 * (-1.0 / 720 + r2 * (1.0 / 40320 + r2 * (-1.0 / 3628800 + r2 * (1.0 / 479001600.0 + r2 * (-1.0 / 87178291200.0)))))));
        const int q = ((int)kq) & 3;
        double s_ = (q == 0) ? sn : (q == 1) ? cs : (q == 2) ? -sn : -cs;
        double c_ = (q == 0) ? cs : (q == 1) ? -sn : (q == 2) ? -cs : sn;
        t1[(size_t)idx * 2] = (float)c_; t1[(size_t)idx * 2 + 1] = (float)s_;
    }
}
__device__ __forceinline__ void p_prologue(Frame& F, const Args& a) {
    LAS float* scr = (LAS float*)(F.lds + RING_OFF + F.wave * 16384);
    const int gw = F.vcu * NWAVES + F.wave, NGW = F.G * NWAVES;
    for (int it = gw; it < IT_SHARED + IT_MOE; it += NGW) { if (it < IT_SHARED) conv_shared_item(F, a, it, scr); else conv_moe_item(F, a, 0, it - IT_SHARED, scr); }
    build_router_frags(F, a, F.vcu * 512 + F.tid, F.G * 512);
    build_sincos(F, F.vcu * 512 + F.tid, F.G * 512);
    for (int m = gw; m < TOK; m += NGW) { if (QKV_FP8) rms_row_to_fp8(F.lane, a.in[0] + (size_t)m * DM, a.in[2], F.ws + WS_HB + (size_t)m * DM); else rms_row_to_bf16(F.lane, a.in[0] + (size_t)m * DM, a.in[2], (bf16*)(F.ws + WS_HB) + (size_t)m * DM); }
}
__device__ __forceinline__ void p_attention(Frame& F, const Args& a) {
    LAS float* lut = (LAS float*)(F.lds + LX_LUT);
    const attn_body::bf16* QKV = (const attn_body::bf16*)(F.ws + WS_QKV0);
    const float* lq = a.in[6];
    const float lam = __expf(wave_sum(lq[F.lane] * lq[64 + F.lane])) - __expf(wave_sum(lq[128 + F.lane] * lq[192 + F.lane])) + 0.2f;
    for (int v = F.vcu; v < 256; v += F.G) {
        const int bh = v >> 2, s = v & 3, b = bh >> 3, h = bh & 7;
        __syncthreads();
        for (int idx = F.tid; idx < 672; idx += 512) { const int n = idx - 288; float val = 0.f;
            if (n < 0) val = -INFINITY;
            else if (n < 113) { int bk = n; if (n >= 16) { bk = 16; const int thr[15] = {19, 21, 24, 27, 31, 35, 40, 46, 52, 59, 67, 77, 87, 99, 113};
#pragma unroll
                for (int q = 0; q < 15; ++q) bk += (n >= thr[q]) ? 1 : 0; }
                val = (a.in[1][bk * 8 + h] - a.in[1][31 * 8 + h]) * LOG2E; }
            lut[idx] = val; }
        __syncthreads();
#pragma nounroll
        for (int i = 0; i < 4; ++i) {
            const int qb = (i < 2) ? 7 - s : s, m = i & 1;
            attn_body::bf16* O = (attn_body::bf16*)(F.ws + WS_OP) + (size_t)m * TOK * 1024 + h * 128;
            attn_body::attn_unit128<8>(b, qb, QKV, h * 128 + m * 64, 1024 + h * 128 + m * 64, 2048 + h * 128, O, lut, (char*)F.lds + RING_OFF);
            if ((i & 1) == 1) {
                VM_WAIT(); __syncthreads();
                int t_ = threadIdx.x; asm volatile("" : "+v"(t_));
                const int row = b * SEQ + qb * 256 + (t_ >> 1), c0 = h * 128 + (t_ & 1) * 64;
                const bf16* O0 = (const bf16*)(F.ws + WS_OP) + (size_t)row * 1024 + c0; const bf16* O1 = O0 + (size_t)TOK * 1024; bf16* AO = (bf16*)(F.ws + WS_AO) + (size_t)row * 1024 + c0;
                const float* sg = a.in[7] + (t_ & 1) * 64;
                float ss = 0.f; v4u wa[8], wb[8];
#pragma unroll
                for (int q = 0; q < 8; ++q) { wa[q] = ((const GAS v4u*)O0)[q]; wb[q] = ((const GAS v4u*)O1)[q]; }
#pragma unroll
                for (int q = 0; q < 8; ++q) { const unsigned xa[4] = {wa[q].x, wa[q].y, wa[q].z, wa[q].w}, xb[4] = {wb[q].x, wb[q].y, wb[q].z, wb[q].w};
#pragma unroll
                    for (int j = 0; j < 4; ++j) { const float o0 = bflo(xa[j]) - lam * bflo(xb[j]), o1 = bfhi(xa[j]) - lam * bfhi(xb[j]); ss += o0 * o0 + o1 * o1; } }
                ss += __shfl_xor(ss, 1);
                const float rstd = 0.8f / sqrtf(ss * (1.f / 128.f) + SUBLN_EPS);
#pragma unroll
                for (int q = 0; q < 8; ++q) { const unsigned xa[4] = {wa[q].x, wa[q].y, wa[q].z, wa[q].w}, xb[4] = {wb[q].x, wb[q].y, wb[q].z, wb[q].w}; unsigned r[4];
                    const f32x4 g0 = *(const GAS f32x4*)(sg + q * 8), g1 = *(const GAS f32x4*)(sg + q * 8 + 4); const float gg[8] = {g0.x, g0.y, g0.z, g0.w, g1.x, g1.y, g1.z, g1.w};
#pragma unroll
                    for (int j = 0; j < 4; ++j) r[j] = pk2((bflo(xa[j]) - lam * bflo(xb[j])) * rstd * gg[2 * j], (bfhi(xa[j]) - lam * bfhi(xb[j])) * rstd * gg[2 * j + 1]);
                    v4u o; o.x = r[0]; o.y = r[1]; o.z = r[2]; o.w = r[3]; ((GAS v4u*)AO)[q] = o; }
            }
        }
    }
}
__device__ __forceinline__ void p_diffcombine(Frame& F, const Args& a) {
    const int gw = F.vcu * NWAVES + F.wave, NGW = F.G * NWAVES, lane = F.lane;
    const float* lq = a.in[6];
    const float lam = __expf(wave_sum(lq[lane] * lq[64 + lane])) - __expf(wave_sum(lq[128 + lane] * lq[192 + lane])) + 0.2f;
    const int d0 = (lane & 7) * 16; float g[16];
#pragma unroll
    for (int j = 0; j < 16; ++j) g[j] = a.in[7][d0 + j] * 0.8f;
    const bf16* O0 = (const bf16*)(F.ws + WS_OP); const bf16* O1 = O0 + (size_t)TOK * 1024; bf16* AO = (bf16*)(F.ws + WS_AO);
    for (int m = gw; m < TOK; m += NGW) {
        const GAS v4u* p0 = (const GAS v4u*)(O0 + (size_t)m * 1024 + lane * 16); const GAS v4u* p1 = (const GAS v4u*)(O1 + (size_t)m * 1024 + lane * 16);
        const v4u a0 = p0[0], a1 = p0[1], b0 = p1[0], b1 = p1[1];
        const unsigned wa[8] = {a0.x, a0.y, a0.z, a0.w, a1.x, a1.y, a1.z, a1.w}, wb[8] = {b0.x, b0.y, b0.z, b0.w, b1.x, b1.y, b1.z, b1.w};
        float o[16]; float ss = 0.f;
#pragma unroll
        for (int j = 0; j < 8; ++j) { o[2 * j] = bflo(wa[j]) - lam * bflo(wb[j]); o[2 * j + 1] = bfhi(wa[j]) - lam * bfhi(wb[j]); ss += o[2 * j] * o[2 * j] + o[2 * j + 1] * o[2 * j + 1]; }
        ss += __shfl_xor(ss, 1); ss += __shfl_xor(ss, 2); ss += __shfl_xor(ss, 4);
        const float rstd = 1.0f / sqrtf(ss * (1.f / 128.f) + SUBLN_EPS);
        v4u w0, w1;
        w0.x = pk2(o[0] * rstd * g[0], o[1] * rstd * g[1]); w0.y = pk2(o[2] * rstd * g[2], o[3] * rstd * g[3]); w0.z = pk2(o[4] * rstd * g[4], o[5] * rstd * g[5]); w0.w = pk2(o[6] * rstd * g[6], o[7] * rstd * g[7]);
        w1.x = pk2(o[8] * rstd * g[8], o[9] * rstd * g[9]); w1.y = pk2(o[10] * rstd * g[10], o[11] * rstd * g[11]); w1.z = pk2(o[12] * rstd * g[12], o[13] * rstd * g[13]); w1.w = pk2(o[14] * rstd * g[14], o[15] * rstd * g[15]);
        GAS v4u* po = (GAS v4u*)(AO + (size_t)m * 1024 + lane * 16); po[0] = w0; po[1] = w1;
    }
}
template <int LAYER> __device__ __forceinline__ void p_router(Frame& F, const Args& a, const bf16* xres, int bank = LAYER) {
    typedef float f32x4v __attribute__((ext_vector_type(4)));
    LAS float* part = (LAS float*)(F.lds + RING_OFF);
    LAS float* ssqp = (LAS float*)(F.lds + RING_OFF + 98304);
    LAS float* logit = (LAS float*)(F.lds + RING_OFF + 100352);
    LAS float* rstd_s = (LAS float*)(F.lds + RING_OFF + 109568);
    LAS int* lcnt = (LAS int*)(F.lds + RING_OFF + 109824);
    LAS int* lbase = (LAS int*)(F.lds + RING_OFF + 109952);
    const int lane = F.lane, w = F.wave, row = lane & 15, kg = lane >> 4;
    const bf16x8* wrf = (const bf16x8*)(F.ws + WS_WRF) + (size_t)LAYER * (32 * 3 * 2 * 64);
    bf16x8 Bh[4][3], Bl[4][3];
#pragma unroll
    for (int s = 0; s < 4; ++s)
#pragma unroll
        for (int nt = 0; nt < 3; ++nt) { Bh[s][nt] = wrf[(((4 * w + s) * 3 + nt) * 2 + 0) * 64 + lane]; Bl[s][nt] = wrf[(((4 * w + s) * 3 + nt) * 2 + 1) * 64 + lane]; }
    const float* gffn = a.in[3] + LAYER * 1024; const float* bg = a.in[12] + LAYER * 4; const float* be = a.in[14] + LAYER * 32;
    int* list = (int*)(F.ws + WS_LIST); float* pairw = (float*)(F.ws + WS_PAIRW); bf16* HB = (bf16*)(F.ws + WS_HB);
    for (int tb = F.vcu; tb < TOK / 64; tb += F.G) {
        __syncthreads();
        if (F.tid < 32) lcnt[F.tid] = 0;
        f32x4v acc[4][3];
#pragma unroll
        for (int mt = 0; mt < 4; ++mt)
#pragma unroll
            for (int nt = 0; nt < 3; ++nt) acc[mt][nt] = (f32x4v){0.f, 0.f, 0.f, 0.f};
#pragma unroll
        for (int mt = 0; mt < 4; ++mt) { const bf16* xr = xres + (size_t)(tb * 64 + mt * 16 + row) * DM + 128 * w + 8 * kg; float ss = 0.f;
#pragma unroll
            for (int s = 0; s < 4; ++s) { const v4u xw = *(const GAS v4u*)(xr + 32 * s); const bf16x8 ah = __builtin_bit_cast(bf16x8, xw);
                const unsigned xv[4] = {xw.x, xw.y, xw.z, xw.w};
#pragma unroll
                for (int j = 0; j < 4; ++j) { const float x0 = bflo(xv[j]), x1 = bfhi(xv[j]); ss += x0 * x0 + x1 * x1; }
#pragma unroll
                for (int nt = 0; nt < 3; ++nt) { acc[mt][nt] = __builtin_amdgcn_mfma_f32_16x16x32_bf16(ah, Bh[s][nt], acc[mt][nt], 0, 0, 0);
                    acc[mt][nt] = __builtin_amdgcn_mfma_f32_16x16x32_bf16(ah, Bl[s][nt], acc[mt][nt], 0, 0, 0); } }
            ss += __shfl_xor(ss, 16); ss += __shfl_xor(ss, 32);
            if (kg == 0) ssqp[w * 64 + mt * 16 + row] = ss;
#pragma unroll
            for (int nt = 0; nt < 3; ++nt)
#pragma unroll
                for (int r = 0; r < 4; ++r) part[(w * 64 + mt * 16 + 4 * kg + r) * 48 + nt * 16 + row] = acc[mt][nt][r]; }
        __syncthreads();
        if (F.tid < 64) { float s = 0.f;
#pragma unroll
            for (int q = 0; q < 8; ++q) s += ssqp[q * 64 + F.tid];
            rstd_s[F.tid] = 1.0f / sqrtf(s * (1.f / 1024.f) + RMS_EPS); }
        __syncthreads();
        for (int idx = F.tid; idx < 64 * 36; idx += 512) { const int tk = idx / 36, o = idx % 36; float s = 0.f;
#pragma unroll
            for (int q = 0; q < 8; ++q) s += part[(q * 64 + tk) * 48 + o];
            logit[tk * 36 + o] = s * rstd_s[tk] + (o < 4 ? bg[o] : be[o - 4]); }
        __syncthreads();
        if (w == 0) {
            const LAS float* lg = logit + lane * 36;
            int gi = 0; float gm = lg[0];
#pragma unroll
            for (int j = 1; j < 4; ++j) { const float v = lg[j]; if (v > gm) { gm = v; gi = j; } }
            float gs = 0.f;
#pragma unroll
            for (int j = 0; j < 4; ++j) gs += __expf(lg[j] - gm);
            const float gp = 1.0f / gs;
            const LAS float* le = lg + 4 + gi * 8;
            int i1 = 0; float v1 = le[0];
#pragma unroll
            for (int j = 1; j < 8; ++j) { const float v = le[j]; if (v > v1) { v1 = v; i1 = j; } }
            int i2 = -1; float v2 = -INFINITY;
#pragma unroll
            for (int j = 0; j < 8; ++j) { const float v = le[j]; if (j != i1 && v > v2) { v2 = v; i2 = j; } }
            const float e2 = __expf(v2 - v1), w1 = gp / (1.0f + e2), w2 = gp * e2 / (1.0f + e2);
            const int e_1 = gi * 8 + i1, e_2 = gi * 8 + i2;
            const int r1 = __hip_atomic_fetch_add(lcnt + e_1, 1, __ATOMIC_RELAXED, __HIP_MEMORY_SCOPE_WORKGROUP);
            const int r2 = __hip_atomic_fetch_add(lcnt + e_2, 1, __ATOMIC_RELAXED, __HIP_MEMORY_SCOPE_WORKGROUP);
            LDS_WAIT();
            if (lane < 32) { const int c = lcnt[lane]; int bs = 0; if (c > 0) bs = (int)__hip_atomic_fetch_add((unsigned*)(F.ctl + CW_CNT + (bank * 32 + lane) * 64), (unsigned)c, RLX_AGENT); lbase[lane] = bs; }
            LDS_WAIT();
            const int tg = tb * 64 + lane; const int p1 = lbase[e_1] + r1, p2 = lbase[e_2] + r2;
            list[e_1 * LISTCAP + p1] = 2 * tg; list[e_2 * LISTCAP + p2] = 2 * tg + 1; pairw[2 * tg] = w1; pairw[2 * tg + 1] = w2;
        }
        for (int i = 0; i < 8; ++i) { const int tk = w * 8 + i, tg = tb * 64 + tk; const float rs8 = rstd_s[tk] * H8_SCALE;
            const GAS v2u* xr = (const GAS v2u*)(xres + (size_t)tg * DM) + lane; const GAS f32x4* gr = (const GAS f32x4*)gffn + lane; GAS unsigned* o4 = (GAS unsigned*)((unsigned char*)HB + (size_t)tg * DM) + lane;
#pragma unroll
            for (int j = 0; j < 4; ++j) { const v2u v = xr[64 * j]; const f32x4 gg = gr[64 * j]; o4[64 * j] = pk4_fp8f(bflo(v.x) * rs8 * gg.x, bfhi(v.x) * rs8 * gg.y, bflo(v.y) * rs8 * gg.z, bfhi(v.y) * rs8 * gg.w); } }
    }
}
template <int LAYER> __device__ __forceinline__ void moe_setup(Frame& F) {
    LAS int* tstart = (LAS int*)(F.lds + LX_TSTART); LAS int* texp = (LAS int*)(F.lds + LX_TEXP); LAS int* lc = (LAS int*)(F.lds + LX_CNT);
    __syncthreads();
    if (F.tid < 32) { int c = (int)__hip_atomic_load((unsigned*)(F.ctl + CW_CNT + (LAYER * 32 + F.tid) * 64), RLX_AGENT); c = c < 0 ? 0 : (c > LISTCAP ? LISTCAP : c); lc[F.tid] = c; }
    __syncthreads();
    if (F.tid == 0) { int acc = 0; for (int e = 0; e < 32; ++e) { tstart[e] = acc; acc += (lc[e] + 255) >> 8; } if (acc > MAXRT) acc = MAXRT; tstart[32] = acc; tstart[33] = acc; }
    __syncthreads();
    if (F.tid < MAXRT) { int e = 0;
#pragma unroll 1
        for (int q = 1; q < 32; ++q) if (tstart[q] <= F.tid) e = q;
        texp[F.tid] = e; }
    __syncthreads();
}
template <int LAYER> __device__ __forceinline__ void p_moe1(Frame& F) {
    moe_setup<LAYER>(F);
    const LAS int* tstart = (const LAS int*)(F.lds + LX_TSTART); const LAS int* texp = (const LAS int*)(F.lds + LX_TEXP); const LAS int* lc = (const LAS int*)(F.lds + LX_CNT);
    LAS int* rowtab = (LAS int*)(F.lds + LX_ROWTAB);
    pg8::MoeOrder S{F.G, F.vcu, 512, 0, tstart, texp};
    const int* list = (const int*)(F.ws + WS_LIST);
    pg8::Unit u;
    for (int i = 0; i < 4 && S.next(i, u); ++i) { if (F.tid < 256) { const int e = u.pn >> 2, pos = u.aux * 256 + F.tid; rowtab[i * 256 + F.tid] = (pos < lc[e]) ? (list[e * LISTCAP + pos] >> 1) : 0; } }
    VM_WAIT(); __syncthreads();
    pg8::Gemm g{(const bf16*)(F.ws + WS_HB), (const bf16*)(F.ws + WS_W1CAT), 512, 512, 512};
    pg8::EpiMoe1 E{(unsigned char*)(F.ws + WS_MACT)};
    pg8::gemm_phase<pg8::EpiMoe1, pg8::MoeOrder, true, true, true>(F.lds + RING_OFF, g, S, E, rowtab);
}
template <int LAYER> __device__ __forceinline__ void p_moe2(Frame& F) {
    moe_setup<LAYER>(F);
    const LAS int* tstart = (const LAS int*)(F.lds + LX_TSTART); const LAS int* texp = (const LAS int*)(F.lds + LX_TEXP); const LAS int* lc = (const LAS int*)(F.lds + LX_CNT);
    pg8::MoeOrder S{F.G, F.vcu, 256, 256 * 256, tstart, texp};
    pg8::Gemm g{(const bf16*)(F.ws + WS_MACT), (const bf16*)(F.ws + WS_W2T), 256, 256, 256};
    pg8::EpiMoe2 E{(unsigned char*)(F.ws + WS_Y), (const int*)(F.ws + WS_LIST), (const float*)(F.ws + WS_PAIRW), lc};
    pg8::gemm_phase<pg8::EpiMoe2, pg8::MoeOrder, true, false, true>(F.lds + RING_OFF, g, S, E, nullptr);
}
template <bool FINAL> __device__ __forceinline__ void p_combine(Frame& F, const bf16* xin, bf16* xout, float* outf, const float* g) {
    typedef float f2v __attribute__((ext_vector_type(2)));
    const int gw = F.vcu * NWAVES + F.wave, NGW = F.G * NWAVES, lane = F.lane;
    const unsigned char* Y = F.ws + WS_Y; unsigned char* HB = F.ws + WS_HB;
    f32x4 gg[4];
#pragma unroll
    for (int j = 0; j < 4; ++j) gg[j] = ((const GAS f32x4*)g + lane)[64 * j];
    v2u cx[4], nx[4]; unsigned cp[4], cq[4], np[4], nq[4];
#define CMB_LOAD(X, P, Q, m_) do { const GAS v2u* xr_ = (const GAS v2u*)(xin + (size_t)(m_) * DM) + lane; const GAS unsigned* y0_ = (const GAS unsigned*)(Y + (size_t)(2 * (m_)) * DM) + lane; const GAS unsigned* y1_ = (const GAS unsigned*)(Y + (size_t)(2 * (m_) + 1) * DM) + lane; \
        _Pragma("unroll") for (int j = 0; j < 4; ++j) { X[j] = xr_[64 * j]; P[j] = y0_[64 * j]; Q[j] = y1_[64 * j]; } } while (0)
    int m = gw;
    if (m < TOK) CMB_LOAD(cx, cp, cq, m);
    for (; m < TOK; m += NGW) {
        const int mn = m + NGW;
        if (mn < TOK) CMB_LOAD(nx, np, nq, mn);
        f32x4 v[4]; float s = 0.f; constexpr float ys = 1.0f / Y_SCALE;
#pragma unroll
        for (int j = 0; j < 4; ++j) { const v2u x = cx[j]; const f2v p0 = __builtin_amdgcn_cvt_pk_f32_fp8((int)cp[j], false), p1 = __builtin_amdgcn_cvt_pk_f32_fp8((int)cp[j], true), q0 = __builtin_amdgcn_cvt_pk_f32_fp8((int)cq[j], false), q1 = __builtin_amdgcn_cvt_pk_f32_fp8((int)cq[j], true);
            v[j].x = bflo(x.x) + (p0.x + q0.x) * ys; v[j].y = bfhi(x.x) + (p0.y + q0.y) * ys; v[j].z = bflo(x.y) + (p1.x + q1.x) * ys; v[j].w = bfhi(x.y) + (p1.y + q1.y) * ys;
            s += (v[j].x * v[j].x + v[j].y * v[j].y) + (v[j].z * v[j].z + v[j].w * v[j].w); }
        const float rstd = 1.0f / sqrtf(wave_sum(s) * (1.f / 1024.f) + RMS_EPS);
        if (FINAL) { GAS f32x4* xw = (GAS f32x4*)(outf + (size_t)m * DM) + lane;
#pragma unroll
            for (int j = 0; j < 4; ++j) { f32x4 o; o.x = v[j].x * rstd * gg[j].x; o.y = v[j].y * rstd * gg[j].y; o.z = v[j].z * rstd * gg[j].z; o.w = v[j].w * rstd * gg[j].w; xw[64 * j] = o; }
        } else { GAS v2u* xw = (GAS v2u*)(xout + (size_t)m * DM) + lane;
            GAS unsigned* o4 = (GAS unsigned*)(HB + (size_t)m * DM) + lane; const float r8 = rstd * H8_SCALE;
#pragma unroll
            for (int j = 0; j < 4; ++j) { v2u xo; xo.x = pk2(v[j].x, v[j].y); xo.y = pk2(v[j].z, v[j].w); xw[64 * j] = xo; o4[64 * j] = pk4_fp8f(v[j].x * r8 * gg[j].x, v[j].y * r8 * gg[j].y, v[j].z * r8 * gg[j].z, v[j].w * r8 * gg[j].w); }
        }
#pragma unroll
        for (int j = 0; j < 4; ++j) { cx[j] = nx[j]; cp[j] = np[j]; cq[j] = nq[j]; }
    }
#undef CMB_LOAD
}
__device__ __forceinline__ void p_scan(Frame& F) {
    const bf16* DS = (const bf16*)(F.ws + WS_DS); bf16* BT = (bf16*)(F.ws + WS_BTCAT);
    for (int gidx = F.vcu * 512 + F.tid; gidx < NB * RH * 16384; gidx += F.G * 512) {
        const int bh = gidx >> 14, e8 = gidx & 16383, dv = e8 >> 5, dk0 = (e8 & 31) * 8, h = bh & 3;
        const float cd = __builtin_amdgcn_exp2f(256.0f * pg8::log2_gamma(h));
        v4u d[7];
#pragma unroll
        for (int n = 0; n < 7; ++n) d[n] = *(const GAS v4u*)(DS + ((size_t)(bh * RNC + n) * RDV + dv) * RDK + dk0);
        float s[8];
#pragma unroll
        for (int j = 0; j < 8; ++j) s[j] = 0.f;
#pragma unroll
        for (int n = 0; n < 8; ++n) {
            v4u o; o.x = pk2(s[0], s[1]); o.y = pk2(s[2], s[3]); o.z = pk2(s[4], s[5]); o.w = pk2(s[6], s[7]);
            *(GAS v4u*)(BT + ((size_t)(bh * RNC + n) * RDV + dv) * 512 + 256 + dk0) = o;
            if (n < 7) { const unsigned wv[4] = {d[n].x, d[n].y, d[n].z, d[n].w};
#pragma unroll
                for (int j = 0; j < 4; ++j) { s[2 * j] = cd * (s[2 * j] + bflo(wv[j])); s[2 * j + 1] = cd * (s[2 * j + 1] + bfhi(wv[j])); } }
        }
    }
}
__device__ __forceinline__ void p_normgate(Frame& F, bf16* dry = nullptr) {
    const int gw = F.vcu * NWAVES + F.wave, NGW = F.G * NWAVES, lane = F.lane;
    const bf16* OR = (const bf16*)(F.ws + WS_ORET); bf16* SG = (bf16*)(F.ws + WS_SG);
    for (int m = gw; m < TOK; m += NGW) {
        const GAS v4u* po = (const GAS v4u*)(OR + (size_t)m * 2048 + lane * 32); GAS v4u* pg = (GAS v4u*)(SG + (size_t)m * 2048 + lane * 32); GAS v4u* pw = dry ? (GAS v4u*)(dry + (size_t)m * 2048 + lane * 32) : pg;
        v4u ov[4], gv[4]; float ss = 0.f;
#pragma unroll
        for (int q = 0; q < 4; ++q) { ov[q] = po[q]; gv[q] = pg[q]; }
#pragma unroll
        for (int q = 0; q < 4; ++q) { const unsigned wv[4] = {ov[q].x, ov[q].y, ov[q].z, ov[q].w};
#pragma unroll
            for (int j = 0; j < 4; ++j) { const float x0 = bflo(wv[j]), x1 = bfhi(wv[j]); ss += x0 * x0 + x1 * x1; } }
        ss += __shfl_xor(ss, 1); ss += __shfl_xor(ss, 2); ss += __shfl_xor(ss, 4); ss += __shfl_xor(ss, 8);
        const float rstd = 1.0f / sqrtf(ss * (1.f / 512.f) + RMS_EPS);
#pragma unroll
        for (int q = 0; q < 4; ++q) { const unsigned wv[4] = {ov[q].x, ov[q].y, ov[q].z, ov[q].w}, wg[4] = {gv[q].x, gv[q].y, gv[q].z, gv[q].w}; unsigned r[4];
#pragma unroll
            for (int j = 0; j < 4; ++j) r[j] = pk2(bflo(wv[j]) * rstd * bflo(wg[j]), bfhi(wv[j]) * rstd * bfhi(wg[j]));
            v4u o; o.x = r[0]; o.y = r[1]; o.z = r[2]; o.w = r[3]; pw[q] = o; }
    }
}
__device__ __forceinline__ void p_conv_moe1(Frame& F, const Args& a) {
    LAS float* scr = (LAS float*)(F.lds + RING_OFF + F.wave * 16384);
    const int gw = F.vcu * NWAVES + F.wave, NGW = F.G * NWAVES;
    for (int it = gw; it < IT_MOE; it += NGW) conv_moe_item(F, a, 1, it, scr);
}

constexpr int N_PHASES = 19;
#ifndef MK_PER_PHASE
#define MK_PER_PHASE 0
#endif
__global__ void __launch_bounds__(NWAVES * 64, 2) hybrid_fwd(Args args) {
    extern __shared__ __attribute__((aligned(16))) unsigned char lds[];
    Frame F;
    F.lds = (LAS unsigned char*)lds;
    F.tid = threadIdx.x; F.lane = F.tid & 63; F.wave = __builtin_amdgcn_readfirstlane(F.tid >> 6);
    F.G = gridDim.x; { const int bx = blockIdx.x; F.vcu = (F.G % 8 == 0) ? (bx % 8) * (F.G / 8) + bx / 8 : bx; }
    F.ws = args.ws; F.ctl = (gu32*)(args.ws + WS_CTL);
    for (int u = F.tid; u < (LDS_BYTES - LX_OFF) / 4; u += NWAVES * 64) ((LAS unsigned*)(F.lds + LX_OFF))[u] = 0u;
    __syncthreads();
    XcdBarrier bar; bar.bar = (unsigned*)(F.ctl + CW_BAR); bar.x = 0; bar.st = nullptr;
    if (!MK_PER_PHASE) bar = xcd_barrier_post((unsigned*)(F.ctl + CW_BAR), (volatile LAS unsigned*)(F.lds + LX_MISC) + 8);
    const int lo = args.ph_lo, hi = args.ph_hi;
#ifndef PH_MASK
#define PH_MASK 0x7ffff
#endif
#define IN(k) (((PH_MASK >> (k)) & 1) && lo <= (k) && (k) < hi)
#define SEAM(k) do { if (IN(k) && IN((k) + 1)) xcd_barrier(bar); } while (0)
#define REFRESH() do { int t_ = threadIdx.x; asm volatile("" : "+v"(t_)); F.tid = t_; F.lane = t_ & 63; } while (0)
#ifndef DUP_MASK
#define DUP_MASK 0
#endif
#ifndef XBAR_N
#define XBAR_N 0
#endif
#define DUP(k) (((DUP_MASK >> (k)) & 1) != 0)
    bf16* xb = (bf16*)args.out;
    bf16* x3 = (bf16*)(args.ws + WS_X3);
    unsigned char* ws = args.ws;
    const int bx = (int)blockIdx.x;

    if (IN(0)) { REFRESH(); p_prologue(F, args); if (DUP(0)) { xcd_barrier(bar); p_prologue(F, args); } for (int q = 0; q < XBAR_N; ++q) xcd_barrier(bar); } SEAM(0);
    if (IN(1)) { REFRESH(); for (int rep_ = 0; rep_ < (DUP(1) ? 2 : 1); ++rep_) { if (rep_) xcd_barrier(bar);
        constexpr int KQ = QKV_FP8 ? 512 : 1024; pg8::Gemm g{(const bf16*)(ws + WS_HB), (const bf16*)(ws + WS_WINT0), KQ, KQ, KQ}; pg8::StaticOrder S; S.init(TOK, 3072, F.G, bx, KQ, KQ);
        pg8::EpiQKV E{(bf16*)(ws + WS_QKV0), ATT_C2};
        pg8::gemm_phase<pg8::EpiQKV, pg8::StaticOrder, true, false, (QKV_FP8 != 0)>(F.lds + RING_OFF, g, S, E, nullptr);
    }
    } SEAM(1);
    if (IN(2)) { REFRESH(); p_attention(F, args); if (DUP(2)) { xcd_barrier(bar); p_attention(F, args); } } if (IN(2) && IN(4)) xcd_barrier(bar);
    if (IN(4)) { REFRESH();
        pg8::Gemm g{(const bf16*)(ws + WS_AO), (const bf16*)(ws + WS_WOUTT0), 1024, 1024, 1024}; pg8::StaticOrder S; S.init(TOK, 1024, F.G, bx, 1024, 1024);
        pg8::EpiResB<true> E{args.in[0], xb};
        pg8::gemm_phase<pg8::EpiResB<true>, pg8::StaticOrder, true, false>(F.lds + RING_OFF, g, S, E, nullptr);
    } SEAM(4);
    if (IN(5)) { REFRESH(); p_router<0>(F, args, xb); } SEAM(5);
    if (IN(6)) { REFRESH(); p_moe1<0>(F); if (DUP(6)) { xcd_barrier(bar); p_moe1<0>(F); } } SEAM(6);
    if (IN(7)) { REFRESH(); p_moe2<0>(F); if (DUP(7)) { xcd_barrier(bar); p_moe2<0>(F); } } SEAM(7);
    if (IN(8)) { REFRESH(); p_combine<false>(F, xb, xb, nullptr, args.in[2] + 1024); } SEAM(8);
    if (IN(9)) { REFRESH(); for (int rep_ = 0; rep_ < (DUP(9) ? 2 : 1); ++rep_) { if (rep_) xcd_barrier(bar);
        { pg8::Gemm g{(const bf16*)(ws + WS_HB), (const bf16*)(ws + WS_WRINA), 512, 512, 512}; pg8::StaticOrder S; S.init(TOK, 4096, F.G, bx, 512, 512);
          pg8::EpiRetA E{(bf16*)(ws + WS_ACAT), (bf16*)(ws + WS_KI), (bf16*)(ws + WS_SG), (const float*)(ws + WS_SINCOS), (bf16*)(ws + WS_KIT)};
          pg8::gemm_phase<pg8::EpiRetA, pg8::StaticOrder, true, false, true>(F.lds + RING_OFF, g, S, E, nullptr); }
        { pg8::Gemm g{(const bf16*)(ws + WS_WRINB), (const bf16*)(ws + WS_HB), 512, 512, 512}; pg8::StaticOrder S; S.init(2048, TOK, F.G, bx, 512, 512);
          pg8::EpiRetB E{(bf16*)(ws + WS_BTCAT)};
          pg8::gemm_phase<pg8::EpiRetB, pg8::StaticOrder, true, false, true>(F.lds + RING_OFF, g, S, E, nullptr); }
    }
    } SEAM(9);
    if (IN(10)) { REFRESH(); for (int rep_ = 0; rep_ < (DUP(10) ? 2 : 1); ++rep_) { if (rep_) xcd_barrier(bar);
        { pg8::Gemm g{(const bf16*)(ws + WS_ACAT), (const bf16*)(ws + WS_KI), 512, 1024, 256}; pg8::ScoresOrder S{F.G, F.vcu};
          pg8::EpiScores E{(bf16*)(ws + WS_ACAT)};
          pg8::gemm_phase<pg8::EpiScores, pg8::ScoresOrder, true, false>(F.lds + RING_OFF, g, S, E, nullptr); }
        { pg8::Gemm g{(const bf16*)(ws + WS_BTCAT), (const bf16*)(ws + WS_KIT), 512, 2048, 256}; pg8::DsOrder S{F.G, F.vcu};
          pg8::EpiDS E{(bf16*)(ws + WS_DS)};
          pg8::gemm_phase<pg8::EpiDS, pg8::DsOrder, true, false>(F.lds + RING_OFF, g, S, E, nullptr); }
    }
    } SEAM(10);
    if (IN(11)) { REFRESH(); p_scan(F); if (DUP(11)) { xcd_barrier(bar); p_scan(F); } } SEAM(11);
    if (IN(12)) { REFRESH(); for (int rep_ = 0; rep_ < (DUP(12) ? 2 : 1); ++rep_) { if (rep_) xcd_barrier(bar);
        pg8::Gemm g{(const bf16*)(ws + WS_ACAT), (const bf16*)(ws + WS_BTCAT), 512, 512, 512}; pg8::RetOOrder S{F.G, F.vcu};
        pg8::EpiRetO E{(bf16*)(ws + WS_ORET), (bf16*)(ws + WS_SG), (LAS float*)(F.lds + LX_SSQ)};
        pg8::gemm_phase<pg8::EpiRetO, pg8::RetOOrder, true, false>(F.lds + RING_OFF, g, S, E, nullptr);
    }
    } if (IN(12) && IN(14)) xcd_barrier(bar);
    if (IN(14)) { REFRESH();
        pg8::Gemm g{(const bf16*)(ws + WS_SG), (const bf16*)(ws + WS_WROUTT), 2048, 2048, 2048}; pg8::StaticOrder S; S.init(TOK, 1024, F.G, bx, 2048, 2048);
        pg8::EpiResB<false> E{xb, x3};
        pg8::gemm_phase<pg8::EpiResB<false>, pg8::StaticOrder, true, false>(F.lds + RING_OFF, g, S, E, nullptr);
    } SEAM(14);
    if (IN(15)) { REFRESH(); p_router<1>(F, args, x3); __syncthreads(); p_conv_moe1(F, args); } SEAM(15);
    if (IN(16)) { REFRESH(); p_moe1<1>(F); } SEAM(16);
    if (IN(17)) { REFRESH(); p_moe2<1>(F); } SEAM(17);
    if (IN(18)) { REFRESH(); p_combine<true>(F, x3, nullptr, args.out, args.in[4]); }
#undef IN
#undef SEAM
}

extern "C" void kernel_launch(void* const* d_in, const int* in_sizes, int n_in, void* d_out, int out_size, void* d_ws, size_t ws_size, hipStream_t stream) {
    static int grid = 0;
    if (grid == 0) {
        if (n_in != 18 || in_sizes[0] != TOK * DM || out_size != TOK * DM || ws_size < WS_END) { fprintf(stderr, "kernel_launch: unexpected shapes / workspace (n_in %d, in0 %d, out %d, ws %zu < %zu); nothing launched\n", n_in, n_in > 0 ? in_sizes[0] : -1, out_size, ws_size, (size_t)WS_END); grid = -1; return; }
        int dev = 0, cus = 0, per_cu = 0;
        if (hipGetDevice(&dev) != hipSuccess || hipDeviceGetAttribute(&cus, hipDeviceAttributeMultiprocessorCount, dev) != hipSuccess) { grid = -1; return; }
        if (hipFuncSetAttribute((const void*)hybrid_fwd, hipFuncAttributeMaxDynamicSharedMemorySize, LDS_BYTES) != hipSuccess) { fprintf(stderr, "kernel_launch: hipFuncSetAttribute failed\n"); grid = -1; return; }
        if (hipOccupancyMaxActiveBlocksPerMultiprocessor(&per_cu, (const void*)hybrid_fwd, NWAVES * 64, LDS_BYTES) != hipSuccess || per_cu < 1) { fprintf(stderr, "kernel_launch: occupancy query says %d\n", per_cu); }
        (void)hipGetLastError();
        grid = cus > 256 ? 256 : cus;
    }
    if (grid < 0) return;
    if (hipMemsetAsync((char*)d_ws + WS_CTL, 0, CTL_ZERO_BYTES, stream) != hipSuccess) return;
    Args a{};
    for (int i = 0; i < 18; ++i) a.in[i] = (const float*)d_in[i];
    a.out = (float*)d_out; a.ws = (unsigned char*)d_ws; a.pad = 0;
#if MK_PER_PHASE
    for (int p = 0; p < N_PHASES; ++p) { a.ph_lo = p; a.ph_hi = p + 1; a.li = p; hipLaunchKernelGGL(hybrid_fwd, dim3(grid), dim3(NWAVES * 64), LDS_BYTES, stream, a); }
#else
    a.ph_lo = 0; a.ph_hi = N_PHASES; a.li = 0;
    hipLaunchKernelGGL(hybrid_fwd, dim3(grid), dim3(NWAVES * 64), LDS_BYTES, stream, a);
#endif
}
```

```cpp
#include <hip/hip_runtime.h>
#include <hip/hip_bf16.h>
#include <cstdio>
#include <cstdint>

#define LAS __attribute__((address_space(3)))
#define GAS __attribute__((address_space(1)))

namespace pg8 {
typedef unsigned short bf16_t;
typedef short bf16x8 __attribute__((ext_vector_type(8)));
typedef float f32x4 __attribute__((ext_vector_type(4)));
typedef float f32x2 __attribute__((ext_vector_type(2)));
typedef unsigned u32x4 __attribute__((ext_vector_type(4)));
typedef unsigned u32x2 __attribute__((ext_vector_type(2)));
constexpr int BM = 256, BK = 64, HALF = 128, HTB = HALF * BK * 2, STAGE_BYTES = 8 * HTB, NXCD = 8, WGM = 8;

__host__ __device__ __forceinline__ int lds_byte(int r, int c) { const int st = (r >> 4) * 2 + (c >> 5), rr = r & 15, cc = c & 31, ob = rr * 64 + cc * 2; return st * 1024 + (ob ^ (((ob >> 9) & 1) << 5)); }
__host__ __device__ __forceinline__ void stage_rc(int b, int& R, int& C) { const int st = b / 1024, sb = b % 1024, swz = sb ^ (((sb >> 9) & 1) << 5); R = (st >> 1) * 16 + swz / 64; C = (st & 1) * 32 + (swz % 64) / 2; }
__host__ __device__ __forceinline__ int perm32(int rho) { const int n = rho >> 4, i = rho & 15; return 8 * (i >> 2) + 4 * n + (i & 3); }

struct Unit { int pm, pn, aux; long aoff, boff; };
struct Gemm { const bf16_t* A; const bf16_t* Bt; int lda, ldb, K; };

struct StaticOrder {
    int nM, nN, nwg, G, c, lda, ldb;
    __device__ void init(int M, int N, int G_, int c_, int lda_, int ldb_) { nM = M / BM; nN = N / BM; nwg = nM * nN; G = G_; c = c_; lda = lda_; ldb = ldb_; }
    __device__ bool next(int i, Unit& u) const {
        const long L = (long)i * G + c; if (L >= nwg) return false;
        int wgid = (int)L; { const int q = nwg / NXCD, r = nwg % NXCD, xcd = wgid % NXCD, off = wgid / NXCD; wgid = (xcd < r ? xcd * (q + 1) : r * (q + 1) + (xcd - r) * q) + off; }
        const int nig = WGM * nN, gid = wgid / nig, fm = gid * WGM, gsz = (nM - fm) < WGM ? (nM - fm) : WGM;
        u.pm = fm + ((wgid % nig) % gsz); u.pn = (wgid % nig) / gsz; u.aux = 0;
        u.aoff = (long)u.pm * BM * lda; u.boff = (long)u.pn * BM * ldb; return true;
    }
};

__device__ __forceinline__ unsigned cvt_pk_bf16(float lo, float hi) { unsigned r; asm volatile("v_cvt_pk_bf16_f32 %0, %1, %2" : "=v"(r) : "v"(lo), "v"(hi)); return r; }
__device__ __forceinline__ u32x4 pack8(const f32x4 v0, const f32x4 v1) { u32x4 w; w.x = cvt_pk_bf16(v0[0], v0[1]); w.y = cvt_pk_bf16(v0[2], v0[3]); w.z = cvt_pk_bf16(v1[0], v1[1]); w.w = cvt_pk_bf16(v1[2], v1[3]); return w; }

typedef int v4i_t __attribute__((ext_vector_type(4)));
typedef int v8i_t __attribute__((ext_vector_type(8)));
__device__ __forceinline__ v8i_t cat8(const bf16x8 a, const bf16x8 b) { const v4i_t x = __builtin_bit_cast(v4i_t, a), y = __builtin_bit_cast(v4i_t, b); return __builtin_shufflevector(x, y, 0, 1, 2, 3, 4, 5, 6, 7); }
template <class Epi, class Sched, bool ALIGN_EPI, bool GATHER, bool FP8 = false>
__device__ __forceinline__ void gemm_phase(LAS unsigned char* lds, const Gemm g, const Sched& S, const Epi& E, const LAS int* rowtab) {
    int tid_ = threadIdx.x; asm volatile("" : "+v"(tid_));
    const int tid = tid_, wid = __builtin_amdgcn_readfirstlane(tid >> 6), lane = tid & 63, wr = wid >> 2, wc = wid & 3, fr = lane & 15, fq = lane >> 4;
    const int K = g.K, nt = K / BK;
    int sR[2], sC[2]; unsigned voffB[2];
#pragma unroll
    for (int i = 0; i < 2; ++i) { int R, C; stage_rc(tid * 16 + i * 8192, R, C); sR[i] = R; sC[i] = C; const int Rb = Epi::PERM ? ((R & ~31) + perm32(R & 31)) : R; voffB[i] = (unsigned)(Rb * g.ldb + C) * 2u; }
    unsigned avo[2][2], navo[2][2];
#define PG8_SETOFF(o, ui_) do { _Pragma("unroll") for (int h_ = 0; h_ < 2; ++h_) _Pragma("unroll") for (int i_ = 0; i_ < 2; ++i_) { const int row_ = h_ * HALF + sR[i_]; \
        const int grow_ = GATHER ? rowtab[(ui_) * BM + row_] : row_; o[h_][i_] = (unsigned)(grow_ * g.lda + sC[i_]) * 2u; } } while (0)
    const size_t kstep = (size_t)(BK * 2);
    const size_t hstepB = (size_t)HALF * g.ldb * 2;
    const unsigned ldsw = (unsigned)wid * 1024u;
    const int aoff = lds_byte(wr * 64 + fr, fq * 8), boff = lds_byte(wc * 32 + fr, fq * 8);
#define PG8_SA(b, h) (((b) * 2 + (h)) * HTB)
#define PG8_SB(b, h) ((4 + (b) * 2 + (h)) * HTB)
#define PG8_STAGE(bufoff, gbase, voff) do { _Pragma("unroll") for (int _i = 0; _i < 2; ++_i) \
        __builtin_amdgcn_global_load_lds((const unsigned*)((const char*)(gbase) + (voff)[_i]), (LAS unsigned*)(lds + (bufoff) + ldsw + _i * 8192), 16, 0, 0); } while (0)
#define PG8_LD8(dst8, addr_) do { const v4i_t lo_ = *(const LAS v4i_t*)(addr_), hi_ = *(const LAS v4i_t*)((addr_) + 1024); dst8 = __builtin_shufflevector(lo_, hi_, 0, 1, 2, 3, 4, 5, 6, 7); } while (0)
#define PG8_LDA(dst, b, h) do { _Pragma("unroll") for (int m = 0; m < 4; ++m) { if constexpr (FP8) { PG8_LD8(dst##8[m], lds + PG8_SA(b, h) + aoff + m * 2048); } else { _Pragma("unroll") for (int k = 0; k < 2; ++k) dst[m][k] = *(const LAS bf16x8*)(lds + PG8_SA(b, h) + aoff + m * 2048 + k * 1024); } } } while (0)
#define PG8_LDB(dst, b, h) do { _Pragma("unroll") for (int n = 0; n < 2; ++n) { if constexpr (FP8) { PG8_LD8(dst##8[n], lds + PG8_SB(b, h) + boff + n * 2048); } else { _Pragma("unroll") for (int k = 0; k < 2; ++k) dst[n][k] = *(const LAS bf16x8*)(lds + PG8_SB(b, h) + boff + n * 2048 + k * 1024); } } } while (0)
#define PG8_MMA(ai, bj, At, Bt) do { __builtin_amdgcn_s_setprio(1); _Pragma("unroll") for (int m = 0; m < 4; ++m) _Pragma("unroll") for (int n = 0; n < 2; ++n) { \
        if constexpr (FP8) asm volatile("v_mfma_f32_16x16x128_f8f6f4 %0, %1, %2, %0" : "+v"(acc[ai][bj][m][n]) : "v"(Bt##8[n]), "v"(At##8[m])); \
        else { _Pragma("unroll") for (int k = 0; k < 2; ++k) acc[ai][bj][m][n] = __builtin_amdgcn_mfma_f32_16x16x32_bf16(Bt[n][k], At[m][k], acc[ai][bj][m][n], 0, 0, 0); } } \
        __builtin_amdgcn_s_setprio(0); } while (0)
#define PG8_WAIT_V(n) asm volatile("s_waitcnt vmcnt(" #n ")" ::: "memory")
#define PG8_WAIT_L(n) asm volatile("s_waitcnt lgkmcnt(" #n ")" ::: "memory")
#define PG8_BAR __builtin_amdgcn_s_barrier()
#define PG8_SCHED __builtin_amdgcn_sched_barrier(0)
    unsigned sc1 = 0; if constexpr (FP8) asm volatile("v_mov_b32 %0, 0x7f7f7f7f\n\ts_nop 4" : "=v"(sc1));
    Unit cur, nxt; int ui = 0;
    if (!S.next(0, cur)) return;
    f32x4 acc[2][2][4][2];
#pragma unroll
    for (int a = 0; a < 2; ++a)
#pragma unroll
        for (int b = 0; b < 2; ++b)
#pragma unroll
            for (int m = 0; m < 4; ++m)
#pragma unroll
                for (int n = 0; n < 2; ++n) acc[a][b][m][n] = (f32x4){0.f, 0.f, 0.f, 0.f};
    bf16x8 At[4][2], B0[2][2], B1[2][2]; v8i_t At8[4], B08[2], B18[2];
    const char* cA = (const char*)g.A + cur.aoff * 2; const char* cB = (const char*)g.Bt + cur.boff * 2;
    PG8_SETOFF(avo, 0);
    PG8_STAGE(PG8_SB(0, 0), cB, voffB); PG8_STAGE(PG8_SB(0, 1), cB + hstepB, voffB); PG8_STAGE(PG8_SA(0, 0), cA, avo[0]); PG8_STAGE(PG8_SA(0, 1), cA, avo[1]);
    if (wr == 1) PG8_BAR;
    PG8_WAIT_V(2); PG8_BAR;
    PG8_STAGE(PG8_SB(1, 0), cB + kstep, voffB); PG8_STAGE(PG8_SA(1, 0), cA + kstep, avo[0]); PG8_STAGE(PG8_SB(1, 1), cB + hstepB + kstep, voffB);
    PG8_WAIT_V(6); PG8_BAR;
    for (;;) {
        const bool has_next = S.next(ui + 1, nxt);
        const char* nA = has_next ? (const char*)g.A + nxt.aoff * 2 : cA; const char* nB = has_next ? (const char*)g.Bt + nxt.boff * 2 : cB;
        if (GATHER && has_next) { PG8_SETOFF(navo, ui + 1); }
        else {
#pragma unroll
            for (int h_ = 0; h_ < 2; ++h_)
#pragma unroll
                for (int i_ = 0; i_ < 2; ++i_) navo[h_][i_] = avo[h_][i_]; }
#pragma nounroll
        for (int t = 0; t < nt; t += 2) {
            const bool last = (t == nt - 2);
            const char* a1 = cA + (size_t)(t + 1) * kstep;
            const char* a2 = last ? nA : cA + (size_t)(t + 2) * kstep; const char* b2 = last ? nB : cB + (size_t)(t + 2) * kstep;
            const char* a3 = a2 + kstep; const char* b3 = b2 + kstep;
            unsigned o2[2][2];
#pragma unroll
            for (int h_ = 0; h_ < 2; ++h_)
#pragma unroll
                for (int i_ = 0; i_ < 2; ++i_) o2[h_][i_] = (GATHER && last) ? navo[h_][i_] : avo[h_][i_];
            PG8_LDB(B0, 0, 0); PG8_LDB(B1, 0, 1); PG8_SCHED; PG8_LDA(At, 0, 0); PG8_STAGE(PG8_SA(1, 1), a1, avo[1]);
            PG8_WAIT_V(8); PG8_WAIT_L(0); PG8_BAR; PG8_MMA(0, 0, At, B0); PG8_MMA(0, 1, At, B1); PG8_BAR; PG8_SCHED;
            PG8_LDA(At, 0, 1); PG8_STAGE(PG8_SB(0, 0), b2, voffB); PG8_STAGE(PG8_SB(0, 1), b2 + hstepB, voffB); PG8_STAGE(PG8_SA(0, 0), a2, o2[0]);
            PG8_WAIT_V(8); PG8_WAIT_L(0); PG8_BAR; PG8_MMA(1, 0, At, B0); PG8_MMA(1, 1, At, B1); PG8_BAR; PG8_SCHED;
            PG8_LDB(B0, 1, 0); PG8_LDB(B1, 1, 1); PG8_SCHED; PG8_LDA(At, 1, 0); PG8_STAGE(PG8_SA(0, 1), a2, o2[1]);
            PG8_WAIT_V(8); PG8_WAIT_L(0); PG8_BAR; PG8_MMA(0, 0, At, B0); PG8_MMA(0, 1, At, B1); PG8_BAR; PG8_SCHED;
            PG8_LDA(At, 1, 1); PG8_STAGE(PG8_SB(1, 0), b3, voffB); PG8_STAGE(PG8_SB(1, 1), b3 + hstepB, voffB); PG8_STAGE(PG8_SA(1, 0), a3, o2[0]);
            PG8_WAIT_V(8); PG8_WAIT_L(0); PG8_BAR; PG8_MMA(1, 0, At, B0); PG8_MMA(1, 1, At, B1); PG8_BAR; PG8_SCHED;
        }
        if constexpr (ALIGN_EPI) { if (wr == 0) PG8_BAR; }
        if constexpr (FP8) asm volatile("s_nop 15\n\ts_nop 3" ::: "memory");
        { int efr = fr, efq = fq; asm volatile("" : "+v"(efr), "+v"(efq)); E(acc, cur, wr, wc, efr, efq); }
        if (!has_next) break;
#pragma unroll
        for (int a = 0; a < 2; ++a)
#pragma unroll
            for (int b = 0; b < 2; ++b)
#pragma unroll
                for (int m = 0; m < 4; ++m)
#pragma unroll
                    for (int n = 0; n < 2; ++n) acc[a][b][m][n] = (f32x4){0.f, 0.f, 0.f, 0.f};
        cur = nxt; cA = nA; cB = nB; ++ui;
#pragma unroll
        for (int h_ = 0; h_ < 2; ++h_)
#pragma unroll
            for (int i_ = 0; i_ < 2; ++i_) avo[h_][i_] = navo[h_][i_];
        if constexpr (ALIGN_EPI) { if (wr == 1) PG8_BAR; }
    }
    PG8_WAIT_V(0);
    if constexpr (!ALIGN_EPI) { if (wr == 0) PG8_BAR; }
    PG8_BAR;
#undef PG8_SETOFF
#undef PG8_SA
#undef PG8_SB
#undef PG8_STAGE
#undef PG8_LDA
#undef PG8_LDB
#undef PG8_MMA
#undef PG8_WAIT_V
#undef PG8_WAIT_L
#undef PG8_BAR
#undef PG8_SCHED
}
}
constexpr int NB = 8, SEQ = 2048, DM = 1024, TOK = NB * SEQ;
constexpr int AH = 8;
constexpr int RH = 4, RDK = 256, RDV = 512, RC = 256, RNC = SEQ / RC;
constexpr int NEXP = 32, EFF = 512, NPAIR = 2 * TOK, LISTCAP = TOK;
constexpr int MAXRT = NPAIR / 256 + NEXP;
constexpr float RMS_EPS = 1e-6f, SUBLN_EPS = 1e-5f, LOG2E = 1.4426950408889634f;
#ifndef QKV_FP8
#define QKV_FP8 0
#endif
#ifndef RIN_FP8
#define RIN_FP8 1
#endif
constexpr float WIN_SCALE = 64.f, IN_DESCALE = 1.0f / (16.f * 64.f);
constexpr float H8_SCALE = 16.f, W1_SCALE = 64.f, ACT_SCALE = 8.f, W2_SCALE = 32.f, Y_SCALE = 64.f;
#ifndef ROUT_FP8
#define ROUT_FP8 1
#endif
constexpr float AR_SCALE = 16.f, WRO_SCALE = 64.f;
constexpr float ATT_C2 = 0.125f * LOG2E;

constexpr size_t MiB = 1u << 20;
constexpr size_t WS_CTL = 0, CTL_ZERO_BYTES = 1 * MiB;
constexpr size_t WS_LIST = 1 * MiB;
constexpr size_t WS_PAIRW = 3 * MiB;
constexpr size_t WS_WRF = 3 * MiB + 512 * 1024;
constexpr size_t WS_SINCOS = 4 * MiB;
constexpr size_t WS_SINCOST = 6 * MiB;
constexpr size_t WS_WINT0 = 8 * MiB;
constexpr size_t WS_WOUTT0 = 14 * MiB;
constexpr size_t WS_WRINA = 16 * MiB;
constexpr size_t WS_WRINB = 24 * MiB;
constexpr size_t WS_WROUTT = 30 * MiB;
constexpr size_t WS_W1CAT = 34 * MiB;
constexpr size_t WS_W2T = 98 * MiB;
constexpr size_t WS_DS = 34 * MiB;
constexpr size_t WS_ORET = 34 * MiB;
constexpr size_t WS_HB = 130 * MiB;
constexpr size_t WS_ACTBASE = 162 * MiB;
constexpr size_t WS_QKV0 = WS_ACTBASE;
constexpr size_t WS_OP = WS_ACTBASE + 96 * MiB;
constexpr size_t WS_AO = WS_ACTBASE + 160 * MiB;
constexpr size_t WS_MACT = WS_ACTBASE;
constexpr size_t WS_Y = WS_ACTBASE + 40 * MiB;
constexpr size_t WS_X3 = WS_ACTBASE + 80 * MiB;
constexpr size_t WS_ACAT = WS_ACTBASE;
constexpr size_t WS_BTCAT = WS_ACTBASE + 64 * MiB;
constexpr size_t WS_KI = WS_ACTBASE + 192 * MiB;
constexpr size_t WS_KIT = WS_ACTBASE + 224 * MiB;
constexpr size_t WS_SG = WS_ACTBASE + 256 * MiB;
constexpr size_t WS_AR8 = WS_KI;
constexpr size_t WS_END = WS_ACTBASE + 320 * MiB;
constexpr int CW_TMO = 0, CW_BAR = 4096, CW_CNT = 16384;

constexpr int RING_OFF = 0, RING_BYTES = 131072;
constexpr int LX_OFF = RING_BYTES;
constexpr int LX_MISC = LX_OFF + 320;
constexpr int LX_ROWTAB = LX_OFF + 1024;
constexpr int LX_TSTART = LX_OFF + 5120;
constexpr int LX_TEXP = LX_OFF + 5376;
constexpr int LX_LUT = LX_OFF + 10240;
constexpr int LX_CNT = LX_OFF + 7168;
constexpr int LX_SSQ = LX_OFF + 8192;
constexpr int LDS_BYTES = 147456;

namespace pg8 {
struct EpiQKV {
    static constexpr bool PERM = true;
    bf16_t* O; float qscale;
    __device__ __forceinline__ void operator()(const f32x4 (&acc)[2][2][4][2], const Unit& u, int wr, int wc, int fr, int fq) const {
        const int row0 = u.pm * BM + wr * 64 + fr, col0 = u.pn * BM + wc * 32 + 8 * fq; const float sc = ((u.pn < 4) ? qscale : 1.f) * (QKV_FP8 ? IN_DESCALE : 1.f);
#pragma unroll
        for (int ai = 0; ai < 2; ++ai)
#pragma unroll
            for (int m = 0; m < 4; ++m) { bf16_t* rowp = O + (size_t)(row0 + ai * HALF + m * 16) * 3072 + col0;
#pragma unroll
                for (int bj = 0; bj < 2; ++bj) *(u32x4*)(rowp + bj * HALF) = pack8(acc[ai][bj][m][0] * sc, acc[ai][bj][m][1] * sc); }
    }
};
template <bool RESF32> struct EpiResB {
    static constexpr bool PERM = true;
    const void* res; bf16_t* out; float sc;
    __device__ __forceinline__ void operator()(const f32x4 (&acc)[2][2][4][2], const Unit& u, int wr, int wc, int fr, int fq) const {
        const int row0 = u.pm * BM + wr * 64 + fr, col0 = u.pn * BM + wc * 32 + 8 * fq;
#pragma unroll
        for (int ai = 0; ai < 2; ++ai)
#pragma unroll
            for (int m = 0; m < 4; ++m) { const size_t off = (size_t)(row0 + ai * HALF + m * 16) * 1024 + col0;
#pragma unroll
                for (int bj = 0; bj < 2; ++bj) { f32x4 r0, r1;
                    if (RESF32) { const float* rp = (const float*)res + off + bj * HALF; r0 = *(const f32x4*)rp; r1 = *(const f32x4*)(rp + 4); }
                    else { const u32x4 g = *(const u32x4*)((const bf16_t*)res + off + bj * HALF);
                        r0[0] = __uint_as_float(g.x << 16); r0[1] = __uint_as_float(g.x & 0xffff0000u); r0[2] = __uint_as_float(g.y << 16); r0[3] = __uint_as_float(g.y & 0xffff0000u);
                        r1[0] = __uint_as_float(g.z << 16); r1[1] = __uint_as_float(g.z & 0xffff0000u); r1[2] = __uint_as_float(g.w << 16); r1[3] = __uint_as_float(g.w & 0xffff0000u); }
                    *(u32x4*)(out + off + bj * HALF) = pack8(r0 + acc[ai][bj][m][0] * sc, r1 + acc[ai][bj][m][1] * sc); }
                asm volatile("" ::: "memory"); }
    }
};
__device__ __forceinline__ float silu_f(float x) { return x * __builtin_amdgcn_rcpf(1.0f + __builtin_amdgcn_exp2f(-x * LOG2E)); }
__device__ __forceinline__ unsigned pk4_fp8(float a, float b, float c, float d) { int w = 0; w = __builtin_amdgcn_cvt_pk_fp8_f32(a, b, w, false); w = __builtin_amdgcn_cvt_pk_fp8_f32(c, d, w, true); return (unsigned)w; }
struct EpiMoe1 {
    static constexpr bool PERM = true;
    unsigned char* ACT;
    __device__ __forceinline__ void operator()(const f32x4 (&acc)[2][2][4][2], const Unit& u, int wr, int wc, int fr, int fq) const {
        const int row0 = u.pm * BM + wr * 64 + fr, col0 = (u.pn & 3) * 128 + wc * 32 + 8 * fq; constexpr float si = 1.0f / (H8_SCALE * W1_SCALE);
#pragma unroll
        for (int ai = 0; ai < 2; ++ai)
#pragma unroll
            for (int m = 0; m < 4; ++m) { f32x4 a0, a1;
#pragma unroll
                for (int j = 0; j < 4; ++j) { a0[j] = silu_f(acc[ai][0][m][0][j] * si) * acc[ai][1][m][0][j] * (si * ACT_SCALE); a1[j] = silu_f(acc[ai][0][m][1][j] * si) * acc[ai][1][m][1][j] * (si * ACT_SCALE); }
                u32x2 w; w.x = pk4_fp8(a0[0], a0[1], a0[2], a0[3]); w.y = pk4_fp8(a1[0], a1[1], a1[2], a1[3]);
                *(u32x2*)(ACT + (size_t)(row0 + ai * HALF + m * 16) * 512 + col0) = w; }
    }
};
struct EpiMoe2 {
    static constexpr bool PERM = true;
    unsigned char* Y; const int* list; const float* pairw; const LAS int* lcnt;
    __device__ __forceinline__ void operator()(const f32x4 (&acc)[2][2][4][2], const Unit& u, int wr, int wc, int fr, int fq) const {
        const int e = u.pn >> 2, col0 = (u.pn & 3) * BM + wc * 32 + 8 * fq, pos0 = u.aux * BM + wr * 64 + fr, cn = lcnt[e];
#pragma unroll
        for (int ai = 0; ai < 2; ++ai)
#pragma unroll
            for (int m = 0; m < 4; ++m) { const int pos = pos0 + ai * HALF + m * 16;
                if (pos < cn) { const int pair = list[e * LISTCAP + pos]; const float w = pairw[pair] * (Y_SCALE / (ACT_SCALE * W2_SCALE)); unsigned char* rowp = Y + (size_t)pair * 1024 + col0;
#pragma unroll
                    for (int bj = 0; bj < 2; ++bj) { const f32x4 a = acc[ai][bj][m][0] * w, c = acc[ai][bj][m][1] * w; u32x2 o; o.x = pk4_fp8(a[0], a[1], a[2], a[3]); o.y = pk4_fp8(c[0], c[1], c[2], c[3]);
                        *(u32x2*)(rowp + bj * HALF) = o; } } }
    }
};
__device__ __forceinline__ float log2_gamma(int h) { return __builtin_log2f(1.0f - __builtin_amdgcn_exp2f(-5.0f - (float)h)); }
struct EpiRetA {
    static constexpr bool PERM = true;
    bf16_t* ACAT; bf16_t* KI; bf16_t* SG; const float* sincos; bf16_t* KIT;
    __device__ __forceinline__ void operator()(const f32x4 (&acc)[2][2][4][2], const Unit& u, int wr, int wc, int fr, int fq) const {
        const int r0 = wr * 64 + fr, c0 = wc * 32 + 8 * fq;
        if (u.pn >= 8) {
#pragma unroll
            for (int ai = 0; ai < 2; ++ai)
#pragma unroll
                for (int m = 0; m < 4; ++m) { bf16_t* rowp = SG + (size_t)(u.pm * BM + r0 + ai * HALF + m * 16) * 2048 + (u.pn - 8) * BM + c0;
#pragma unroll
                    for (int bj = 0; bj < 2; ++bj) { f32x4 a0, a1;
#pragma unroll
                        for (int j = 0; j < 4; ++j) { a0[j] = silu_f(acc[ai][bj][m][0][j] * IN_DESCALE); a1[j] = silu_f(acc[ai][bj][m][1][j] * IN_DESCALE); }
                        *(u32x4*)(rowp + bj * HALF) = pack8(a0, a1); } }
            return;
        }
        const bool isq = u.pn < 4; const int h = u.pn & 3; const float l2g = log2_gamma(h);
        const int b = u.pm >> 3, n = u.pm & 7;
#pragma unroll
        for (int ai = 0; ai < 2; ++ai)
#pragma unroll
            for (int m = 0; m < 4; ++m) { const int r = r0 + ai * HALF + m * 16, pos = n * RC + r;
                const float fac = IN_DESCALE * (isq ? __builtin_amdgcn_exp2f((float)(r + 1) * l2g) : 0.0625f * __builtin_amdgcn_exp2f(-(float)(r + 1) * l2g));
                bf16_t* rowp = isq ? ACAT + ((size_t)((b * RH + h) * RNC + n) * RC + r) * 512 + 256 + c0 : KI + (size_t)(u.pm * BM + r) * 1024 + h * RDK + c0;
#pragma unroll
                for (int bj = 0; bj < 2; ++bj) { const f32x4* cs = (const f32x4*)(sincos + ((size_t)pos * 128 + (bj * HALF + c0) / 2) * 2);
                    const f32x4 t0 = cs[0], t1 = cs[1]; const f32x4 x0 = acc[ai][bj][m][0], x1 = acc[ai][bj][m][1]; f32x4 y0, y1;
                    y0[0] = (x0[0] * t0[0] - x0[1] * t0[1]) * fac; y0[1] = (x0[1] * t0[0] + x0[0] * t0[1]) * fac; y0[2] = (x0[2] * t0[2] - x0[3] * t0[3]) * fac; y0[3] = (x0[3] * t0[2] + x0[2] * t0[3]) * fac;
                    y1[0] = (x1[0] * t1[0] - x1[1] * t1[1]) * fac; y1[1] = (x1[1] * t1[0] + x1[0] * t1[1]) * fac; y1[2] = (x1[2] * t1[2] - x1[3] * t1[3]) * fac; y1[3] = (x1[3] * t1[2] + x1[2] * t1[3]) * fac;
                    *(u32x4*)(rowp + bj * HALF) = pack8(y0, y1);
                    if (!isq) {
                        const int s0 = fr & 1, s1 = (fr >> 1) & 1;
#pragma unroll
                        for (int nn = 0; nn < 2; ++nn) { const f32x4 a = nn ? y1 : y0; float t[4], c[4];
#pragma unroll
                            for (int j = 0; j < 4; ++j) { const float other = __shfl_xor(a[j ^ 1], 1); t[j] = (s0 == (j & 1)) ? a[j] : other; }
#pragma unroll
                            for (int j = 0; j < 4; ++j) { const float other = __shfl_xor(t[j ^ 2], 2); c[j] = (s1 == (j >> 1)) ? t[j] : other; }
                            u32x2 w; w.x = cvt_pk_bf16(c[0], c[1]); w.y = cvt_pk_bf16(c[2], c[3]);
                            const int col = bj * HALF + c0 + nn * 4 + (fr & 3), tok = n * RC + (r & ~3);
                            *(u32x2*)(KIT + ((size_t)((b * RH + h) * RDK + col)) * SEQ + tok) = w; } }
                } }
    }
};
struct EpiRetB {
    static constexpr bool PERM = true;
    bf16_t* BTCAT;
    __device__ __forceinline__ void operator()(const f32x4 (&acc)[2][2][4][2], const Unit& u, int wr, int wc, int fr, int fq) const {
        const int r0 = wr * 64 + fr, c0 = wc * 32 + 8 * fq; const int b = u.pn >> 3, n = u.pn & 7; const int h = u.pm >> 1, dv0 = (u.pm & 1) * BM;
#pragma unroll
        for (int ai = 0; ai < 2; ++ai)
#pragma unroll
            for (int m = 0; m < 4; ++m) { bf16_t* rowp = BTCAT + ((size_t)((b * RH + h) * RNC + n) * RDV + dv0 + r0 + ai * HALF + m * 16) * 512 + c0;
#pragma unroll
                for (int bj = 0; bj < 2; ++bj) *(u32x4*)(rowp + bj * HALF) = pack8(acc[ai][bj][m][0] * IN_DESCALE, acc[ai][bj][m][1] * IN_DESCALE); }
    }
};
struct EpiScores {
    static constexpr bool PERM = true;
    bf16_t* ACAT;
    __device__ __forceinline__ void operator()(const f32x4 (&acc)[2][2][4][2], const Unit& u, int wr, int wc, int fr, int fq) const {
        const int r0 = wr * 64 + fr, c0 = wc * 32 + 8 * fq;
#pragma unroll
        for (int ai = 0; ai < 2; ++ai)
#pragma unroll
            for (int m = 0; m < 4; ++m) { const int r = r0 + ai * HALF + m * 16; bf16_t* rowp = ACAT + ((size_t)u.pm * RC + r) * 512 + c0;
#pragma unroll
                for (int bj = 0; bj < 2; ++bj) { f32x4 y0 = acc[ai][bj][m][0], y1 = acc[ai][bj][m][1]; const int cb = bj * HALF + c0;
#pragma unroll
                    for (int j = 0; j < 4; ++j) { if (cb + j > r) y0[j] = 0.f; if (cb + 4 + j > r) y1[j] = 0.f; }
                    *(u32x4*)(rowp + bj * HALF) = pack8(y0, y1); } }
    }
};
struct EpiDS {
    static constexpr bool PERM = true;
    bf16_t* DS;
    __device__ __forceinline__ void operator()(const f32x4 (&acc)[2][2][4][2], const Unit& u, int wr, int wc, int fr, int fq) const {
        const int r0 = wr * 64 + fr, c0 = wc * 32 + 8 * fq;
#pragma unroll
        for (int ai = 0; ai < 2; ++ai)
#pragma unroll
            for (int m = 0; m < 4; ++m) { bf16_t* rowp = DS + ((size_t)u.pm * RDV + u.pn * BM + r0 + ai * HALF + m * 16) * RDK + c0;
#pragma unroll
                for (int bj = 0; bj < 2; ++bj) *(u32x4*)(rowp + bj * HALF) = pack8(acc[ai][bj][m][0], acc[ai][bj][m][1]); }
    }
};
struct EpiRetO {
    static constexpr bool PERM = true;
    bf16_t* ORET; bf16_t* SG; LAS float* ssq; unsigned char* AR8;
    __device__ __forceinline__ void operator()(const f32x4 (&acc)[2][2][4][2], const Unit& u, int wr, int wc, int fr, int fq) const {
        const int r0 = wr * 64 + fr, c0 = wc * 32 + 8 * fq; const int n = u.pm & 7, h = (u.pm >> 3) & 3, b = u.pm >> 5;
        LAS float* sq = ssq + (u.aux & 1) * 256;
        if (u.pn == 0) { const int t_ = threadIdx.x; if (t_ < 256) ssq[((u.aux & 1) ^ 1) * 256 + t_] = 0.f; }
#pragma unroll
        for (int ai = 0; ai < 2; ++ai)
#pragma unroll
            for (int m = 0; m < 4; ++m) { float s = 0.f;
#pragma unroll
                for (int bj = 0; bj < 2; ++bj)
#pragma unroll
                    for (int nn = 0; nn < 2; ++nn) { const f32x4 x = acc[ai][bj][m][nn]; s += (x[0] * x[0] + x[1] * x[1]) + (x[2] * x[2] + x[3] * x[3]); }
                s += __shfl_xor(s, 16); s += __shfl_xor(s, 32);
                if (fq == 0) (void)__hip_atomic_fetch_add(sq + r0 + ai * HALF + m * 16, s, __ATOMIC_RELAXED, __HIP_MEMORY_SCOPE_WORKGROUP); }
        const size_t rowbase = (size_t)(b * SEQ + n * RC) * 2048 + h * RDV;
        if (u.pn == 0) {
#pragma unroll
            for (int ai = 0; ai < 2; ++ai)
#pragma unroll
                for (int m = 0; m < 4; ++m) { bf16_t* rowp = ORET + rowbase + (size_t)(r0 + ai * HALF + m * 16) * 2048 + c0;
#pragma unroll
                    for (int bj = 0; bj < 2; ++bj) *(u32x4*)(rowp + bj * HALF) = pack8(acc[ai][bj][m][0], acc[ai][bj][m][1]); }
            return;
        }
        asm volatile("s_waitcnt lgkmcnt(0)" ::: "memory"); __builtin_amdgcn_s_barrier(); asm volatile("" ::: "memory");
#pragma unroll
        for (int ai = 0; ai < 2; ++ai)
#pragma unroll
            for (int m = 0; m < 4; ++m) { const int r = r0 + ai * HALF + m * 16; const float rstd = __builtin_amdgcn_rsqf(sq[r] * (1.0f / 512.0f) + RMS_EPS);
                const size_t ro = rowbase + (size_t)r * 2048 + c0;
#pragma unroll
                for (int bj = 0; bj < 2; ++bj) {
                    { bf16_t* gp = SG + ro + BM + bj * HALF; const u32x4 g = *(const u32x4*)gp; f32x4 y0 = acc[ai][bj][m][0] * rstd, y1 = acc[ai][bj][m][1] * rstd;
                      y0[0] *= __uint_as_float(g.x << 16); y0[1] *= __uint_as_float(g.x & 0xffff0000u); y0[2] *= __uint_as_float(g.y << 16); y0[3] *= __uint_as_float(g.y & 0xffff0000u);
                      y1[0] *= __uint_as_float(g.z << 16); y1[1] *= __uint_as_float(g.z & 0xffff0000u); y1[2] *= __uint_as_float(g.w << 16); y1[3] *= __uint_as_float(g.w & 0xffff0000u);
                      if (ROUT_FP8) { u32x2 w; w.x = pk4_fp8(y0[0] * AR_SCALE, y0[1] * AR_SCALE, y0[2] * AR_SCALE, y0[3] * AR_SCALE); w.y = pk4_fp8(y1[0] * AR_SCALE, y1[1] * AR_SCALE, y1[2] * AR_SCALE, y1[3] * AR_SCALE); *(u32x2*)(AR8 + ro + BM + bj * HALF) = w; }
                      else *(u32x4*)gp = pack8(y0, y1); }
                    { bf16_t* gp = SG + ro + bj * HALF; const u32x4 g = *(const u32x4*)gp; const u32x4 o = *(const u32x4*)(ORET + ro + bj * HALF); f32x4 y0, y1;
                      y0[0] = __uint_as_float(o.x << 16) * rstd * __uint_as_float(g.x << 16); y0[1] = __uint_as_float(o.x & 0xffff0000u) * rstd * __uint_as_float(g.x & 0xffff0000u);
                      y0[2] = __uint_as_float(o.y << 16) * rstd * __uint_as_float(g.y << 16); y0[3] = __uint_as_float(o.y & 0xffff0000u) * rstd * __uint_as_float(g.y & 0xffff0000u);
                      y1[0] = __uint_as_float(o.z << 16) * rstd * __uint_as_float(g.z << 16); y1[1] = __uint_as_float(o.z & 0xffff0000u) * rstd * __uint_as_float(g.z & 0xffff0000u);
                      y1[2] = __uint_as_float(o.w << 16) * rstd * __uint_as_float(g.w << 16); y1[3] = __uint_as_float(o.w & 0xffff0000u) * rstd * __uint_as_float(g.w & 0xffff0000u);
                      if (ROUT_FP8) { u32x2 w; w.x = pk4_fp8(y0[0] * AR_SCALE, y0[1] * AR_SCALE, y0[2] * AR_SCALE, y0[3] * AR_SCALE); w.y = pk4_fp8(y1[0] * AR_SCALE, y1[1] * AR_SCALE, y1[2] * AR_SCALE, y1[3] * AR_SCALE); *(u32x2*)(AR8 + ro + bj * HALF) = w; }
                      else *(u32x4*)gp = pack8(y0, y1); } } }
    }
};
struct ScoresOrder {
    int G, c;
    __device__ bool next(int i, Unit& u) const { const int L = i * G + c; if (L >= NB * RH * RNC) return false; const int n = L & 7, h = (L >> 3) & 3, b = L >> 5;
        u.pm = L; u.pn = 0; u.aux = 0; u.aoff = (long)L * RC * 512 + 256; u.boff = (long)(b * SEQ + n * RC) * 1024 + h * RDK; return true; }
};
struct DsOrder {
    int G, c;
    __device__ bool next(int i, Unit& u) const { const int L = i * G + c; if (L >= NB * RH * 7 * 2) return false; const int dvt = L & 1, q = L >> 1, n = q % 7, bh = q / 7, p = bh * RNC + n;
        u.pm = p; u.pn = dvt; u.aux = 0; u.aoff = ((long)p * RDV + dvt * BM) * 512; u.boff = (long)bh * RDK * SEQ + n * RC; return true; }
};
struct RetOOrder {
    int G, c;
    __device__ bool next(int i, Unit& u) const { const int k = i >> 1, dvt = i & 1, p = k * G + c; if (p >= NB * RH * RNC) return false;
        u.pm = p; u.pn = dvt; u.aux = k; u.aoff = (long)p * RC * 512; u.boff = ((long)p * RDV + dvt * BM) * 512; return true; }
};
struct MoeOrder {
    int G, c, ldb; long a_tile; const LAS int* tstart; const LAS int* texp;
    __device__ bool next(int i, Unit& u) const { const int L = i * G + c; const int ntiles = tstart[33]; if (L >= ntiles * 4) return false; const int rt = L >> 2, pnl = L & 3, e = texp[rt];
        u.pm = rt; u.pn = e * 4 + pnl; u.aux = rt - tstart[e]; u.aoff = (long)rt * a_tile; u.boff = ((long)e * 1024 + pnl * BM) * ldb; return true; }
};
}
namespace attn_body {
using bf16=__hip_bfloat16;
using bf16x8=__attribute__((ext_vector_type(8)))short;
using s16x4=__attribute__((ext_vector_type(4)))short;
using f32x16=__attribute__((ext_vector_type(16)))float;
using u32x4=__attribute__((ext_vector_type(4)))unsigned;
constexpr int D=64,PQ=3072,PO=1024;
constexpr int NW=8,QBLK=32,QB=QBLK*NW,KVBLK=64,NQB=SEQ/QB;
__device__ __forceinline__ int crow(int r,int hi){return (r&3)+8*(r>>2)+4*hi;}
#define SBAR() __builtin_amdgcn_sched_barrier(0)
__device__ __forceinline__ void biasmask(f32x16&p0,f32x16&p1,int jb6,int qrel,int hi,const LAS float*lut2){
  const LAS float*pb=lut2+(128+qrel-64*jb6-4*hi+288-91);
  #pragma unroll
  for(int g=0;g<4;++g){
    #pragma unroll
    for(int q=0;q<4;++q){const int r=4*g+q, c=q+8*g; const int rel=128+qrel-64*jb6-4*hi-c; const float b0=pb[91-c], b1=pb[91-c-32]; p0[r]=(rel<0)?-INFINITY:p0[r]+b0; p1[r]=(rel<32)?-INFINITY:p1[r]+b1;}
    asm volatile("":"+v"(p0),"+v"(p1)); __builtin_amdgcn_sched_barrier(0);}
}
constexpr int NSLOT=3, SLOTB=8192;
constexpr int LDS_K=0, LDS_V=NSLOT*SLOTB, LDS_WS=2*NSLOT*SLOTB, LDS_OST=LDS_WS+NW*64*4, LDS_BYTES=LDS_OST+NW*4096;
__device__ __forceinline__ void glds16(const void*gsrc,unsigned lds_dst){unsigned keep;
  asm volatile("s_mov_b32 %0, m0\n\ts_mov_b32 m0, %2\n\ts_nop 0\n\tglobal_load_lds_dwordx4 %1, off\n\ts_mov_b32 m0, %0":"=&s"(keep):"v"(gsrc),"s"(lds_dst):"memory");}
__device__ __forceinline__ float max3f(float a,float b,float c){float r;asm("v_max3_f32 %0, %1, %2, %3":"=v"(r):"v"(a),"v"(b),"v"(c));return r;}
__device__ __forceinline__ float max2f(float a,float b){float r;asm("v_max_f32_e32 %0, %1, %2":"=v"(r):"v"(a),"v"(b));return r;}
__device__ __forceinline__ float fadd_s(float a,float b){float r;asm("v_add_f32_e32 %0, %1, %2":"=v"(r):"v"(a),"v"(b));return r;}
__device__ __forceinline__ float fsub_s(float a,float b){float r;asm("v_sub_f32_e32 %0, %1, %2":"=v"(r):"v"(a),"v"(b));return r;}
typedef float f32x2_t __attribute__((ext_vector_type(2))); typedef __bf16 bf16x2_t __attribute__((ext_vector_type(2)));
__device__ __forceinline__ unsigned cvtpk_s(float lo,float hi){f32x2_t v={lo,hi};bf16x2_t b=__builtin_convertvector(v,bf16x2_t);return __builtin_bit_cast(unsigned,b);}
#define WAIT_BAR(N) asm volatile("s_waitcnt vmcnt(" #N ") lgkmcnt(0)\n\ts_barrier":::"memory")

__device__ __forceinline__ void qkt(f32x16&p0,f32x16&p1,const char*Kslot,const bf16x8*qr,const f32x16&negm,int r32,int hi){
  const char*kb=Kslot+hi*1024+r32*16;
  #pragma unroll
  for(int d0=0;d0<4;++d0){
    const bf16x8 b0=*reinterpret_cast<const bf16x8*>(kb+d0*2048);
    const bf16x8 b1=*reinterpret_cast<const bf16x8*>(kb+d0*2048+512);
    if(d0==0){p0=__builtin_amdgcn_mfma_f32_32x32x16_bf16(b0,qr[0],negm,0,0,0);p1=__builtin_amdgcn_mfma_f32_32x32x16_bf16(b1,qr[0],negm,0,0,0);}
    else{p0=__builtin_amdgcn_mfma_f32_32x32x16_bf16(b0,qr[d0],p0,0,0,0);p1=__builtin_amdgcn_mfma_f32_32x32x16_bf16(b1,qr[d0],p1,0,0,0);}}
}
typedef LAS const char* lds_cptr;
typedef short v4i16_t __attribute__((ext_vector_type(4)));
__device__ __forceinline__ void kload8(bf16x8*kf,lds_cptr kp){
  kf[0]=*(const LAS bf16x8*)(kp);      kf[1]=*(const LAS bf16x8*)(kp+512);
  kf[2]=*(const LAS bf16x8*)(kp+2048); kf[3]=*(const LAS bf16x8*)(kp+2560);
  kf[4]=*(const LAS bf16x8*)(kp+4096); kf[5]=*(const LAS bf16x8*)(kp+4608);
  kf[6]=*(const LAS bf16x8*)(kp+6144); kf[7]=*(const LAS bf16x8*)(kp+6656);
}
__device__ __forceinline__ void kload2(bf16x8*kf,lds_cptr kp,int j){ kf[2*j]=*(const LAS bf16x8*)(kp+j*2048); kf[2*j+1]=*(const LAS bf16x8*)(kp+j*2048+512); }
__device__ __forceinline__ s16x4 vtr(lds_cptr p){ return __builtin_bit_cast(s16x4,__builtin_amdgcn_ds_read_tr16_b64_v4i16((LAS v4i16_t*)p)); }
__device__ __forceinline__ float rowmax(const f32x16&p0,const f32x16&p1){
  float a=max3f(p0[0],p0[1],p1[0]),b=max3f(p0[2],p0[3],p1[1]);a=max3f(a,p1[2],p1[3]);
  #pragma unroll
  for(int r=4;r<16;r+=4){a=max3f(a,p0[r],p0[r+1]);b=max3f(b,p0[r+2],p0[r+3]);a=max3f(a,p1[r],p1[r+1]);b=max3f(b,p1[r+2],p1[r+3]);}
  const float m=max2f(a,b);
  auto rr=__builtin_amdgcn_permlane32_swap(__float_as_uint(m),__float_as_uint(m),false,false);
  return max2f(__uint_as_float(rr[0]),__uint_as_float(rr[1]));
}
__device__ __forceinline__ void pv(f32x16*o,int vb,bf16x8 pa0,bf16x8 pa1,bf16x8 pa2,bf16x8 pa3){
  #pragma unroll
  for(int d0=0;d0<2;++d0){s16x4 lo[4],hi[4];
    #pragma unroll
    for(int ks=0;ks<4;++ks){
      asm volatile("ds_read_b64_tr_b16 %0,%1 offset:%c2":"=&v"(lo[ks]):"v"(vb),"i"(d0*4096+ks*1024):"memory");
      asm volatile("ds_read_b64_tr_b16 %0,%1 offset:%c2":"=&v"(hi[ks]):"v"(vb),"i"(d0*4096+ks*1024+512):"memory");}
    asm volatile("s_waitcnt lgkmcnt(0)":::"memory");SBAR();
    #define PK(k) (bf16x8){lo[k][0],lo[k][1],lo[k][2],lo[k][3],hi[k][0],hi[k][1],hi[k][2],hi[k][3]}
    o[d0]=__builtin_amdgcn_mfma_f32_32x32x16_bf16(pa0,PK(0),o[d0],0,0,0);
    o[d0]=__builtin_amdgcn_mfma_f32_32x32x16_bf16(pa1,PK(1),o[d0],0,0,0);
    o[d0]=__builtin_amdgcn_mfma_f32_32x32x16_bf16(pa2,PK(2),o[d0],0,0,0);
    o[d0]=__builtin_amdgcn_mfma_f32_32x32x16_bf16(pa3,PK(3),o[d0],0,0,0);
    #undef PK
  }
}
template<int THRL> __device__ __forceinline__ void attn_unit(int b,int qb,const bf16*QKV,int Qc,int Kc,int Vc,bf16*O,const LAS float*lut,char*shm){
  int tid_=threadIdx.x; asm volatile("":"+v"(tid_)); const int tid=tid_,lane=tid&63,r32=lane&31,hi=lane>>5; const int wid=__builtin_amdgcn_readfirstlane(tid>>6);
  const long rowbase=(long)b*SEQ; const int q0=qb*QB;
  const bf16*Qw=QKV+(rowbase+q0+wid*QBLK)*PQ+Qc;
  const bf16*Kh=QKV+rowbase*PQ+Kc,*Vh=QKV+rowbase*PQ+Vc;
  const unsigned lds0=(unsigned)(uintptr_t)shm;
  float*wsf=(float*)(shm+LDS_WS)+wid*64;
  const bf16*ksrc=Kh+(long)lane*PQ+wid*8;
  const bf16*vsrc=Vh+(long)(16*(wid&3)+(lane>>2))*PQ+(wid>>2)*32+(lane&3)*8;
  const unsigned kdst=lds0+LDS_K+wid*1024, vdst=lds0+LDS_V+wid*1024;
  #define DMA_K(t,slot) glds16(ksrc+(long)(t)*KVBLK*PQ,(unsigned)__builtin_amdgcn_readfirstlane(kdst+(slot)))
  #define DMA_V(t,slot) glds16(vsrc+(long)(t)*KVBLK*PQ,(unsigned)__builtin_amdgcn_readfirstlane(vdst+(slot)))
  const int vb0=(int)(lds0+LDS_V)+((lane>>4)&1)*32+(lane&3)*8+(4*hi+((lane&15)>>2))*64;
  const char*Kbase=shm+LDS_K; bf16x8 kf[8];
  const lds_cptr shm3=(lds_cptr)shm; const lds_cptr kp0=shm3+LDS_K+hi*1024+r32*16; const lds_cptr vp0=shm3+LDS_V+((lane>>4)&1)*32+(lane&3)*8+(4*hi+((lane&15)>>2))*64;
  const int NT=(q0+QB)/KVBLK;
  DMA_K(0,0);DMA_V(0,0);DMA_K(1,SLOTB);
  bf16x8 qr[4];
  #pragma unroll
  for(int d0=0;d0<4;++d0)qr[d0]=*reinterpret_cast<const bf16x8*>(&Qw[(long)r32*PQ+d0*16+hi*8]);
  float mhat=0.f,l_reg=0.f;f32x16 o[2];f32x16 negm; { float zz; asm volatile("v_mov_b32 %0, 0":"=v"(zz)); _Pragma("unroll") for(int r=0;r<16;++r){o[0][r]=zz;o[1][r]=zz;negm[r]=zz;} } asm volatile("":"+v"(negm));
  const int qrel=wid*QBLK+r32;
  #define CMASK(P0,P1,t) do{int jb_=(t)-(NT-6); if(jb_>=0)biasmask(P0,P1,jb_,qrel,hi,lut);}while(0)
  bool resc=false;
  #define START(P0,P1) do{ const float rm=rowmax(P0,P1); resc=false; \
    { const float dl=rm; mhat=fadd_s(mhat,dl); \
      _Pragma("unroll") for(int r=0;r<16;++r){P0[r]=fsub_s(P0[r],dl);P1[r]=fsub_s(P1[r],dl);} \
      _Pragma("unroll") for(int r=0;r<16;++r)negm[r]=-mhat; asm volatile("":"+v"(negm)); } \
    _Pragma("unroll") for(int r=0;r<16;++r)P0[r]=__builtin_amdgcn_exp2f(P0[r]); }while(0)
  #define RESC() do{ if(resc){ asm volatile("s_waitcnt lgkmcnt(0)":::"memory"); \
      _Pragma("unroll") for(int d_=0;d_<2;++d_) _Pragma("unroll") for(int r=0;r<16;++r)o[d_][r]*=wsf[crow(r,hi)]; } }while(0)
  f32x16 pA0,pA1,pB0,pB1;
  int sl_prev=0,sl_cur=0,sl_next=SLOTB;
  #define ROT() do{sl_prev=sl_cur;sl_cur=sl_next;sl_next=(sl_next==(NSLOT-1)*SLOTB)?0:sl_next+SLOTB;}while(0)
  DMA_K(2,2*SLOTB);
  WAIT_BAR(3);
  qkt(pA0,pA1,Kbase,qr,negm,r32,hi);asm volatile("s_nop 15\n\ts_nop 7":"+v"(pA0),"+v"(pA1));CMASK(pA0,pA1,0);
  START(pA0,pA1);
  _Pragma("unroll") for(int r=0;r<16;++r)pA1[r]=__builtin_amdgcn_exp2f(pA1[r]);
  WAIT_BAR(0);
  DMA_K(3,0);DMA_V(1,SLOTB);
  ROT();
  kload8(kf,kp0+sl_cur);
  WAIT_BAR(2);
  s16x4 vlo[8],vhi[8]; u32x4 pw0,pw1,pw2,pw3;
  #define PKW(P,B) cvtpk_s(P[B],P[B+1])
  #define PAF(k) __builtin_bit_cast(bf16x8,pw##k)
  #define VFR(i) (bf16x8){vlo[i][0],vlo[i][1],vlo[i][2],vlo[i][3],vhi[i][0],vhi[i][1],vhi[i][2],vhi[i][3]}
  #define PIN(x) asm volatile("":"+v"(x))
  #define MX3(a,b,c) __builtin_fmaxf(__builtin_fmaxf((a),(b)),(c))
  #define GAPA(MF,A0,A1,A2,A3,W0,W1,PW) do{ MF; sacc+=A0; sacc+=A1; sacc+=A2; sacc+=A3; PIN(sacc); W0; W1; PIN(PW); SBAR(); }while(0)
  #define EX(v) __builtin_amdgcn_exp2f(v)
  #define GAPB(MF,X,B) do{ MF; X[B]=EX(X[B]); X[B+1]=EX(X[B+1]); X[B+2]=EX(X[B+2]); X[B+3]=EX(X[B+3]); PIN(X); SBAR(); }while(0)
  #define VRD(i) do{ vlo[i]=vtr(vp_+(((i)>>2)*4096+((i)&3)*1024)); vhi[i]=vtr(vp_+(((i)>>2)*4096+((i)&3)*1024+512)); }while(0)
  #define KRD(G,j) do{ if(G){ kload2(kf,kp0+sl_next,j); SBAR(); } }while(0)
  #define STEP(C0,C1,P0,P1,t,GK,GV,GL) do{ SBAR(); \
    const lds_cptr vp_=vp0+sl_prev; \
    VRD(0); SBAR(); float sacc=(P0[0]+P0[1]); \
    GAPA(C0=__builtin_amdgcn_mfma_f32_32x32x16_bf16(kf[0],qr[0],negm,0,0,0), P0[2],P0[3],P0[4],P0[5],     pw0[0]=PKW(P0,0), pw0[1]=PKW(P0,2), pw0); \
    VRD(4); SBAR(); GAPA(C1=__builtin_amdgcn_mfma_f32_32x32x16_bf16(kf[1],qr[0],negm,0,0,0), P0[6],P0[7],P0[8],P0[9],     pw0[2]=PKW(P0,4), pw0[3]=PKW(P0,6), pw0); \
    VRD(1); SBAR(); GAPA(C0=__builtin_amdgcn_mfma_f32_32x32x16_bf16(kf[2],qr[1],C0,0,0,0),   P0[10],P0[11],P0[12],P0[13], pw1[0]=PKW(P0,8), pw1[1]=PKW(P0,10), pw1); \
    VRD(5); SBAR(); GAPA(C1=__builtin_amdgcn_mfma_f32_32x32x16_bf16(kf[3],qr[1],C1,0,0,0),   P0[14],P0[15],P1[0],P1[1],   pw1[2]=PKW(P0,12),pw1[3]=PKW(P0,14), pw1); \
    VRD(2); SBAR(); GAPA(C0=__builtin_amdgcn_mfma_f32_32x32x16_bf16(kf[4],qr[2],C0,0,0,0),   P1[2],P1[3],P1[4],P1[5],     pw2[0]=PKW(P1,0), pw2[1]=PKW(P1,2), pw2); \
    VRD(6); SBAR(); GAPA(C1=__builtin_amdgcn_mfma_f32_32x32x16_bf16(kf[5],qr[2],C1,0,0,0),   P1[6],P1[7],P1[8],P1[9],     pw2[2]=PKW(P1,4), pw2[3]=PKW(P1,6), pw2); \
    VRD(3); SBAR(); GAPA(C0=__builtin_amdgcn_mfma_f32_32x32x16_bf16(kf[6],qr[3],C0,0,0,0),   P1[10],P1[11],P1[12],P1[13], pw3[0]=PKW(P1,8), pw3[1]=PKW(P1,10), pw3); \
    VRD(7); SBAR(); GAPA(C1=__builtin_amdgcn_mfma_f32_32x32x16_bf16(kf[7],qr[3],C1,0,0,0),   P1[14],P1[15],0.f,0.f,       pw3[2]=PKW(P1,12),pw3[3]=PKW(P1,14), pw3); \
    l_reg+=sacc; \
    if(GK){DMA_K((t)+3,sl_cur);} if(GV){DMA_V((t)+1,sl_next);} \
    CMASK(C0,C1,t); \
    { float a=MX3(C0[0],C0[1],C1[0]),b=MX3(C0[2],C0[3],C1[1]); a=MX3(a,C1[2],C1[3]); \
      _Pragma("unroll") for(int r=4;r<16;r+=4){a=MX3(a,C0[r],C0[r+1]);b=MX3(b,C0[r+2],C0[r+3]);a=MX3(a,C1[r],C1[r+1]);b=MX3(b,C1[r+2],C1[r+3]);} \
      float rm=__builtin_fmaxf(a,b); { auto rr=__builtin_amdgcn_permlane32_swap(__float_as_uint(rm),__float_as_uint(rm),false,false); rm=__builtin_fmaxf(__uint_as_float(rr[0]),__uint_as_float(rr[1])); } \
      resc=false; \
      if(__builtin_expect(__any(rm>(float)THRL),0)){ const float dl=__builtin_fmaxf(rm,0.f); mhat+=dl; \
        _Pragma("unroll") for(int r=0;r<16;++r){C0[r]-=dl;C1[r]-=dl;} \
        _Pragma("unroll") for(int r=0;r<16;++r)negm[r]=-mhat; asm volatile("":"+v"(negm)); \
        const float f=__builtin_amdgcn_exp2f(-dl); l_reg*=f; if(hi==0)wsf[r32]=f; resc=true; } } \
    SBAR(); \
    GAPB(o[0]=__builtin_amdgcn_mfma_f32_32x32x16_bf16(PAF(0),VFR(0),o[0],0,0,0), C0,0); \
    GAPB(o[1]=__builtin_amdgcn_mfma_f32_32x32x16_bf16(PAF(0),VFR(4),o[1],0,0,0), C0,4); \
    KRD(GL,0); GAPB(o[0]=__builtin_amdgcn_mfma_f32_32x32x16_bf16(PAF(1),VFR(1),o[0],0,0,0), C0,8); \
    KRD(GL,1); GAPB(o[1]=__builtin_amdgcn_mfma_f32_32x32x16_bf16(PAF(1),VFR(5),o[1],0,0,0), C0,12); \
    KRD(GL,2); GAPB(o[0]=__builtin_amdgcn_mfma_f32_32x32x16_bf16(PAF(2),VFR(2),o[0],0,0,0), C1,0); \
    KRD(GL,3); GAPB(o[1]=__builtin_amdgcn_mfma_f32_32x32x16_bf16(PAF(2),VFR(6),o[1],0,0,0), C1,4); \
    GAPB(o[0]=__builtin_amdgcn_mfma_f32_32x32x16_bf16(PAF(3),VFR(3),o[0],0,0,0), C1,8); \
    GAPB(o[1]=__builtin_amdgcn_mfma_f32_32x32x16_bf16(PAF(3),VFR(7),o[1],0,0,0), C1,12); \
    }while(0)
  int t=1;
  #undef CMASK
  #define CMASK(P0,P1,t) do{}while(0)
  for(;t+7<NT;t+=2){
    STEP(pB0,pB1,pA0,pA1,t,true,true,true);     WAIT_BAR(2); RESC(); ROT();
    STEP(pA0,pA1,pB0,pB1,t+1,true,true,true);   WAIT_BAR(2); RESC(); ROT();
  }
  #undef CMASK
  #define CMASK(P0,P1,t) do{int jb_=(t)-(NT-6); if(jb_>=0)biasmask(P0,P1,jb_,qrel,hi,lut);}while(0)
  #define ENDW(tt) do{ if((tt)+3<NT){WAIT_BAR(2);} else if((tt)+2<NT){WAIT_BAR(1);} else {WAIT_BAR(0);} }while(0)
  for(;t+1<NT;t+=2){
    STEP(pB0,pB1,pA0,pA1,t,(t+3<NT),(t+1<NT),(t+1<NT));       ENDW(t);   RESC(); ROT();
    STEP(pA0,pA1,pB0,pB1,t+1,(t+4<NT),(t+2<NT),(t+2<NT));     ENDW(t+1); RESC(); ROT();
  }
  STEP(pB0,pB1,pA0,pA1,NT-1,false,false,false); RESC();
  { float sacc=pB0[0]+pB0[1]; _Pragma("unroll") for(int r=2;r<16;++r)sacc+=pB0[r]; _Pragma("unroll") for(int r=0;r<16;++r)sacc+=pB1[r]; l_reg+=sacc;
    pw0=(u32x4){PKW(pB0,0),PKW(pB0,2),PKW(pB0,4),PKW(pB0,6)};pw1=(u32x4){PKW(pB0,8),PKW(pB0,10),PKW(pB0,12),PKW(pB0,14)};pw2=(u32x4){PKW(pB1,0),PKW(pB1,2),PKW(pB1,4),PKW(pB1,6)};pw3=(u32x4){PKW(pB1,8),PKW(pB1,10),PKW(pB1,12),PKW(pB1,14)};
    SBAR(); pv(o,vb0+sl_cur,PAF(0),PAF(1),PAF(2),PAF(3)); }
  #undef PKW
  #undef PAF
  #undef VFR
  #undef PIN
  #undef MX3
  #undef GAPA
  #undef GAPB
  #undef EX
  #undef VRD
  #undef KRD
  #undef STEP
  #undef ENDW
  {auto rr=__builtin_amdgcn_permlane32_swap(__float_as_uint(l_reg),__float_as_uint(l_reg),false,false);l_reg=__uint_as_float(rr[0])+__uint_as_float(rr[1]);}
  if(hi==0)wsf[32+r32]=l_reg;asm volatile("s_waitcnt lgkmcnt(0)":::"memory");
  float rli[16];
  #pragma unroll
  for(int r=0;r<16;++r)rli[r]=__builtin_amdgcn_rcpf(wsf[32+crow(r,hi)]);
  bf16*Ow=O+(rowbase+q0+wid*QBLK)*PO;
  { bf16*stg=(bf16*)(shm+LDS_OST)+wid*2048;
    #pragma unroll
    for(int r=0;r<16;++r){const int orow=crow(r,hi);
      #pragma unroll
      for(int d0=0;d0<2;++d0)stg[orow*64+d0*32+r32]=__float2bfloat16(o[d0][r]*rli[r]);}
    asm volatile("s_waitcnt lgkmcnt(0)":::"memory");
    #pragma unroll
    for(int i=0;i<4;++i){const int row=i*8+(lane>>3),ch=lane&7; const u32x4 v=*(const u32x4*)(stg+row*64+ch*8); *(u32x4*)(Ow+(long)row*PO+ch*8)=v;} }
  asm volatile("s_waitcnt lgkmcnt(0)\n\ts_barrier":::"memory");
  #undef DMA_K
  #undef DMA_V
  #undef CMASK
  #undef START
  #undef RESC
  #undef ROT
}

constexpr int VSLOTB=16384, L2_K=0, L2_V=NSLOT*SLOTB, L2_WS=L2_V+NSLOT*VSLOTB, L2_QO=L2_WS+NW*64*4, L2_BYTES=L2_QO+NW*4096;
template<int THRL> __device__ __forceinline__ void attn_unit128(int b,int qb,const bf16*QKV,int Qc,int Kc,int Vc,bf16*O,const LAS float*lut,char*shm){
  int tid_=threadIdx.x; asm volatile("":"+v"(tid_)); const int tid=tid_,lane=tid&63,r32=lane&31,hi=lane>>5; const int wid=__builtin_amdgcn_readfirstlane(tid>>6);
  const long rowbase=(long)b*SEQ; const int q0=qb*QB;
  const bf16*Qw=QKV+(rowbase+q0+wid*QBLK)*PQ+Qc;
  const bf16*Kh=QKV+rowbase*PQ+Kc,*Vh=QKV+rowbase*PQ+Vc;
  const unsigned lds0=(unsigned)(uintptr_t)shm;
  float*wsf=(float*)(shm+L2_WS)+wid*64;
  const bf16*ksrc=Kh+(long)lane*PQ+wid*8;
  const bf16*vsrc=Vh+(long)(16*(wid&3)+(lane>>2))*PQ+(wid>>2)*32+(lane&3)*8;
  const unsigned kdst=lds0+L2_K+wid*1024, vdst=lds0+L2_V+wid*1024;
  #define DMA_K(t,slot) glds16(ksrc+(long)(t)*KVBLK*PQ,(unsigned)__builtin_amdgcn_readfirstlane(kdst+(slot)))
  #define DMA_V(t,slot) do{ glds16(vsrc+(long)(t)*KVBLK*PQ,(unsigned)__builtin_amdgcn_readfirstlane(vdst+2*(slot))); glds16(vsrc+(long)(t)*KVBLK*PQ+64,(unsigned)__builtin_amdgcn_readfirstlane(vdst+2*(slot)+8192)); }while(0)
  const int vb0=(int)(lds0+L2_V)+((lane>>4)&1)*32+(lane&3)*8+(4*hi+((lane&15)>>2))*64;
  const char*Kbase=shm+L2_K; bf16x8 kf[8];
  const lds_cptr shm3=(lds_cptr)shm; const lds_cptr kp0=shm3+L2_K+hi*1024+r32*16; const lds_cptr vp0=shm3+L2_V+((lane>>4)&1)*32+(lane&3)*8+(4*hi+((lane&15)>>2))*64;
  const lds_cptr qst=shm3+L2_QO+wid*4096+lane*16;
  const int NT=(q0+QB)/KVBLK;
  DMA_K(0,0);DMA_V(0,0);DMA_K(1,SLOTB);
  { bf16x8 qr[4];
    #pragma unroll
    for(int d0=0;d0<4;++d0)qr[d0]=*reinterpret_cast<const bf16x8*>(&Qw[(long)r32*PQ+d0*16+hi*8]);
    #pragma unroll
    for(int d0=0;d0<4;++d0)*(LAS bf16x8*)(qst+d0*1024)=qr[d0]; }
  float mhat=0.f,l_reg=0.f;f32x16 o[4]; { float zz; asm volatile("v_mov_b32 %0, 0":"=v"(zz)); _Pragma("unroll") for(int r=0;r<16;++r){o[0][r]=zz;o[1][r]=zz;o[2][r]=zz;o[3][r]=zz;} }
  const int qrel=wid*QBLK+r32;
  #define QF(d0) (*(const LAS bf16x8*)(qst+(d0)*1024))
  #define CMASK(P0,P1,t) do{int jb_=(t)-(NT-6); if(jb_>=0)biasmask(P0,P1,jb_,qrel,hi,lut);}while(0)
  bool resc=false;
  #define RESC() do{ if(resc){ asm volatile("s_waitcnt lgkmcnt(0)":::"memory"); \
      _Pragma("unroll") for(int d_=0;d_<4;++d_) _Pragma("unroll") for(int r=0;r<16;++r)o[d_][r]*=wsf[crow(r,hi)]; } }while(0)
  f32x16 pA0,pA1,pB0,pB1;
  int sl_prev=0,sl_cur=0,sl_next=SLOTB;
  #define ROT() do{sl_prev=sl_cur;sl_cur=sl_next;sl_next=(sl_next==(NSLOT-1)*SLOTB)?0:sl_next+SLOTB;}while(0)
  DMA_K(2,2*SLOTB);
  WAIT_BAR(3);
  {
    const char*kb=Kbase+hi*1024+r32*16; const f32x16 z16={};
    #pragma unroll
    for(int d0=0;d0<4;++d0){ const bf16x8 qf=QF(d0);
      const bf16x8 b0=*reinterpret_cast<const bf16x8*>(kb+d0*2048); const bf16x8 b1=*reinterpret_cast<const bf16x8*>(kb+d0*2048+512);
      if(d0==0){pA0=__builtin_amdgcn_mfma_f32_32x32x16_bf16(b0,qf,z16,0,0,0);pA1=__builtin_amdgcn_mfma_f32_32x32x16_bf16(b1,qf,z16,0,0,0);}
      else{pA0=__builtin_amdgcn_mfma_f32_32x32x16_bf16(b0,qf,pA0,0,0,0);pA1=__builtin_amdgcn_mfma_f32_32x32x16_bf16(b1,qf,pA1,0,0,0);} }
    asm volatile("s_nop 15\n\ts_nop 7":"+v"(pA0),"+v"(pA1));CMASK(pA0,pA1,0);
    mhat=rowmax(pA0,pA1);
    #pragma unroll
    for(int r=0;r<16;++r){pA0[r]=__builtin_amdgcn_exp2f(pA0[r]-mhat);pA1[r]=__builtin_amdgcn_exp2f(pA1[r]-mhat);} }
  WAIT_BAR(0);
  DMA_K(3,0);DMA_V(1,SLOTB);
  ROT();
  kload8(kf,kp0+sl_cur);
  WAIT_BAR(3);
  s16x4 vlo[8],vhi[8]; u32x4 pw0,pw1,pw2,pw3;
  #define PKW(P,B) cvtpk_s(P[B],P[B+1])
  #define PAF(k) __builtin_bit_cast(bf16x8,pw##k)
  #define VFR(i) (bf16x8){vlo[i][0],vlo[i][1],vlo[i][2],vlo[i][3],vhi[i][0],vhi[i][1],vhi[i][2],vhi[i][3]}
  #define PIN(x) asm volatile("":"+v"(x))
  #define MX3(a,b,c) __builtin_fmaxf(__builtin_fmaxf((a),(b)),(c))
  #define MFQ(C,kk,qv,Cin) C=__builtin_amdgcn_mfma_f32_32x32x16_bf16(kf[kk],qv,Cin,0,0,0)
  #define GAPA(MF,A0,A1,A2,A3,W0,W1,PW) do{ MF; sacc+=A0; sacc+=A1; sacc+=A2; sacc+=A3; PIN(sacc); W0; W1; PIN(PW); SBAR(); }while(0)
  #define EX(v) __builtin_amdgcn_exp2f((v)-mhat)
  #define GAPB(MF,X,B) do{ MF; X[B]=EX(X[B]); X[B+1]=EX(X[B+1]); PIN(X); SBAR(); }while(0)
  #define VRD(i) do{ vlo[(i)&7]=vtr(vp_+(((i)>>2)*4096+((i)&3)*1024)); vhi[(i)&7]=vtr(vp_+(((i)>>2)*4096+((i)&3)*1024+512)); }while(0)
  #define KRD(G,j) do{ if(G){ kload2(kf,kp0+sl_next,j); SBAR(); } }while(0)
  #define STEP(C0,C1,P0,P1,t,GK,GV,GL) do{ SBAR(); \
    const lds_cptr vp_=vp0+2*sl_prev; const f32x16 z16={}; bf16x8 qf; \
    VRD(0); qf=QF(0); SBAR(); float sacc=(P0[0]+P0[1]); \
    GAPA(MFQ(C0,0,qf,z16), P0[2],P0[3],P0[4],P0[5],     pw0[0]=PKW(P0,0), pw0[1]=PKW(P0,2), pw0); \
    VRD(4); SBAR(); GAPA(MFQ(C1,1,qf,z16), P0[6],P0[7],P0[8],P0[9],     pw0[2]=PKW(P0,4), pw0[3]=PKW(P0,6), pw0); \
    VRD(1); qf=QF(1); SBAR(); GAPA(MFQ(C0,2,qf,C0),   P0[10],P0[11],P0[12],P0[13], pw1[0]=PKW(P0,8), pw1[1]=PKW(P0,10), pw1); \
    VRD(5); SBAR(); GAPA(MFQ(C1,3,qf,C1),   P0[14],P0[15],P1[0],P1[1],   pw1[2]=PKW(P0,12),pw1[3]=PKW(P0,14), pw1); \
    VRD(2); qf=QF(2); SBAR(); GAPA(MFQ(C0,4,qf,C0),   P1[2],P1[3],P1[4],P1[5],     pw2[0]=PKW(P1,0), pw2[1]=PKW(P1,2), pw2); \
    VRD(6); SBAR(); GAPA(MFQ(C1,5,qf,C1),   P1[6],P1[7],P1[8],P1[9],     pw2[2]=PKW(P1,4), pw2[3]=PKW(P1,6), pw2); \
    VRD(3); qf=QF(3); SBAR(); GAPA(MFQ(C0,6,qf,C0),   P1[10],P1[11],P1[12],P1[13], pw3[0]=PKW(P1,8), pw3[1]=PKW(P1,10), pw3); \
    VRD(7); SBAR(); GAPA(MFQ(C1,7,qf,C1),   P1[14],P1[15],0.f,0.f,       pw3[2]=PKW(P1,12),pw3[3]=PKW(P1,14), pw3); \
    l_reg+=sacc; \
    if(GK){DMA_K((t)+3,sl_cur);} if(GV){DMA_V((t)+1,sl_next);} \
    CMASK(C0,C1,t); \
    { float a=MX3(C0[0],C0[1],C1[0]),b=MX3(C0[2],C0[3],C1[1]); a=MX3(a,C1[2],C1[3]); \
      _Pragma("unroll") for(int r=4;r<16;r+=4){a=MX3(a,C0[r],C0[r+1]);b=MX3(b,C0[r+2],C0[r+3]);a=MX3(a,C1[r],C1[r+1]);b=MX3(b,C1[r+2],C1[r+3]);} \
      float rm=__builtin_fmaxf(a,b); { auto rr=__builtin_amdgcn_permlane32_swap(__float_as_uint(rm),__float_as_uint(rm),false,false); rm=__builtin_fmaxf(__uint_as_float(rr[0]),__uint_as_float(rr[1])); } \
      rm-=mhat; resc=false; \
      if(__builtin_expect(__any(rm>(float)THRL),0)){ const float dl=__builtin_fmaxf(rm,0.f); mhat+=dl; \
        const float f=__builtin_amdgcn_exp2f(-dl); l_reg*=f; if(hi==0)wsf[r32]=f; resc=true; } } \
    SBAR(); \
    GAPB(o[0]=__builtin_amdgcn_mfma_f32_32x32x16_bf16(PAF(0),VFR(0),o[0],0,0,0), C0,0);  VRD(8);  SBAR(); \
    GAPB(o[1]=__builtin_amdgcn_mfma_f32_32x32x16_bf16(PAF(0),VFR(4),o[1],0,0,0), C0,2);  VRD(12); SBAR(); \
    GAPB(o[0]=__builtin_amdgcn_mfma_f32_32x32x16_bf16(PAF(1),VFR(1),o[0],0,0,0), C0,4);  VRD(9);  SBAR(); \
    GAPB(o[1]=__builtin_amdgcn_mfma_f32_32x32x16_bf16(PAF(1),VFR(5),o[1],0,0,0), C0,6);  VRD(13); SBAR(); \
    GAPB(o[0]=__builtin_amdgcn_mfma_f32_32x32x16_bf16(PAF(2),VFR(2),o[0],0,0,0), C0,8);  VRD(10); SBAR(); \
    GAPB(o[1]=__builtin_amdgcn_mfma_f32_32x32x16_bf16(PAF(2),VFR(6),o[1],0,0,0), C0,10); VRD(14); SBAR(); \
    GAPB(o[0]=__builtin_amdgcn_mfma_f32_32x32x16_bf16(PAF(3),VFR(3),o[0],0,0,0), C0,12); VRD(11); SBAR(); \
    GAPB(o[1]=__builtin_amdgcn_mfma_f32_32x32x16_bf16(PAF(3),VFR(7),o[1],0,0,0), C0,14); VRD(15); SBAR(); \
    GAPB(o[2]=__builtin_amdgcn_mfma_f32_32x32x16_bf16(PAF(0),VFR(0),o[2],0,0,0), C1,0); \
    GAPB(o[3]=__builtin_amdgcn_mfma_f32_32x32x16_bf16(PAF(0),VFR(4),o[3],0,0,0), C1,2); \
    KRD(GL,0); GAPB(o[2]=__builtin_amdgcn_mfma_f32_32x32x16_bf16(PAF(1),VFR(1),o[2],0,0,0), C1,4); \
    KRD(GL,1); GAPB(o[3]=__builtin_amdgcn_mfma_f32_32x32x16_bf16(PAF(1),VFR(5),o[3],0,0,0), C1,6); \
    KRD(GL,2); GAPB(o[2]=__builtin_amdgcn_mfma_f32_32x32x16_bf16(PAF(2),VFR(2),o[2],0,0,0), C1,8); \
    KRD(GL,3); GAPB(o[3]=__builtin_amdgcn_mfma_f32_32x32x16_bf16(PAF(2),VFR(6),o[3],0,0,0), C1,10); \
    GAPB(o[2]=__builtin_amdgcn_mfma_f32_32x32x16_bf16(PAF(3),VFR(3),o[2],0,0,0), C1,12); \
    GAPB(o[3]=__builtin_amdgcn_mfma_f32_32x32x16_bf16(PAF(3),VFR(7),o[3],0,0,0), C1,14); \
    }while(0)
  int t=1;
  #undef CMASK
  #define CMASK(P0,P1,t) do{}while(0)
  for(;t+7<NT;t+=2){
    STEP(pB0,pB1,pA0,pA1,t,true,true,true);     WAIT_BAR(3); RESC(); ROT();
    STEP(pA0,pA1,pB0,pB1,t+1,true,true,true);   WAIT_BAR(3); RESC(); ROT();
  }
  #undef CMASK
  #define CMASK(P0,P1,t) do{int jb_=(t)-(NT-6); if(jb_>=0)biasmask(P0,P1,jb_,qrel,hi,lut);}while(0)
  #define ENDW(tt) do{ if((tt)+3<NT){WAIT_BAR(3);} else if((tt)+2<NT){WAIT_BAR(2);} else {WAIT_BAR(0);} }while(0)
  for(;t+1<NT;t+=2){
    STEP(pB0,pB1,pA0,pA1,t,(t+3<NT),(t+1<NT),(t+1<NT));       ENDW(t);   RESC(); ROT();
    STEP(pA0,pA1,pB0,pB1,t+1,(t+4<NT),(t+2<NT),(t+2<NT));     ENDW(t+1); RESC(); ROT();
  }
  STEP(pB0,pB1,pA0,pA1,NT-1,false,false,false); RESC();
  { float sacc=pB0[0]+pB0[1]; _Pragma("unroll") for(int r=2;r<16;++r)sacc+=pB0[r]; _Pragma("unroll") for(int r=0;r<16;++r)sacc+=pB1[r]; l_reg+=sacc;
    pw0=(u32x4){PKW(pB0,0),PKW(pB0,2),PKW(pB0,4),PKW(pB0,6)};pw1=(u32x4){PKW(pB0,8),PKW(pB0,10),PKW(pB0,12),PKW(pB0,14)};pw2=(u32x4){PKW(pB1,0),PKW(pB1,2),PKW(pB1,4),PKW(pB1,6)};pw3=(u32x4){PKW(pB1,8),PKW(pB1,10),PKW(pB1,12),PKW(pB1,14)};
    SBAR();
    const int vb=vb0+2*sl_cur;
    #pragma unroll
    for(int d0=0;d0<4;++d0){s16x4 lo[4],hh[4];
      #pragma unroll
      for(int ks=0;ks<4;++ks){
        asm volatile("ds_read_b64_tr_b16 %0,%1 offset:%c2":"=&v"(lo[ks]):"v"(vb),"i"(d0*4096+ks*1024):"memory");
        asm volatile("ds_read_b64_tr_b16 %0,%1 offset:%c2":"=&v"(hh[ks]):"v"(vb),"i"(d0*4096+ks*1024+512):"memory");}
      asm volatile("s_waitcnt lgkmcnt(0)":::"memory");SBAR();
      #define PK(k) (bf16x8){lo[k][0],lo[k][1],lo[k][2],lo[k][3],hh[k][0],hh[k][1],hh[k][2],hh[k][3]}
      o[d0]=__builtin_amdgcn_mfma_f32_32x32x16_bf16(PAF(0),PK(0),o[d0],0,0,0);
      o[d0]=__builtin_amdgcn_mfma_f32_32x32x16_bf16(PAF(1),PK(1),o[d0],0,0,0);
      o[d0]=__builtin_amdgcn_mfma_f32_32x32x16_bf16(PAF(2),PK(2),o[d0],0,0,0);
      o[d0]=__builtin_amdgcn_mfma_f32_32x32x16_bf16(PAF(3),PK(3),o[d0],0,0,0);
      #undef PK
    } }
  #undef PKW
  #undef PAF
  #undef VFR
  #undef PIN
  #undef MX3
  #undef MFQ
  #undef GAPA
  #undef GAPB
  #undef EX
  #undef VRD
  #undef KRD
  #undef STEP
  #undef ENDW
  #undef QF
  {auto rr=__builtin_amdgcn_permlane32_swap(__float_as_uint(l_reg),__float_as_uint(l_reg),false,false);l_reg=__uint_as_float(rr[0])+__uint_as_float(rr[1]);}
  if(hi==0)wsf[32+r32]=l_reg;asm volatile("s_waitcnt lgkmcnt(0)":::"memory");
  float rli[16];
  #pragma unroll
  for(int r=0;r<16;++r)rli[r]=__builtin_amdgcn_rcpf(wsf[32+crow(r,hi)]);
  bf16*Ow=O+(rowbase+q0+wid*QBLK)*PO;
  { bf16*stg=(bf16*)(shm+L2_QO)+wid*2048;
    #pragma unroll
    for(int hh=0;hh<2;++hh){
      #pragma unroll
      for(int r=0;r<16;++r){const int orow=crow(r,hi);
        #pragma unroll
        for(int d0=0;d0<2;++d0)stg[orow*64+d0*32+r32]=__float2bfloat16(o[2*hh+d0][r]*rli[r]);}
      asm volatile("s_waitcnt lgkmcnt(0)":::"memory");
      #pragma unroll
      for(int i=0;i<4;++i){const int row=i*8+(lane>>3),ch=lane&7; const u32x4 v=*(const u32x4*)(stg+row*64+ch*8); *(u32x4*)(Ow+(long)row*PO+hh*64+ch*8)=v;}
      asm volatile("s_waitcnt lgkmcnt(0)":::"memory"); } }
  asm volatile("s_waitcnt lgkmcnt(0)\n\ts_barrier":::"memory");
  #undef DMA_K
  #undef DMA_V
  #undef CMASK
  #undef RESC
  #undef ROT
}

constexpr int ATTN_LDS_BYTES=LDS_BYTES;
#undef SBAR
#undef WAIT_BAR
}
constexpr int NWAVES = 8;
typedef unsigned short bf16;
typedef unsigned v4u __attribute__((ext_vector_type(4)));
typedef unsigned v2u __attribute__((ext_vector_type(2)));
typedef float f32x4 __attribute__((ext_vector_type(4)));
typedef float f32x2 __attribute__((ext_vector_type(2)));
typedef short bf16x8 __attribute__((ext_vector_type(8)));
typedef GAS unsigned gu32;
#define RLX_AGENT __ATOMIC_RELAXED, __HIP_MEMORY_SCOPE_AGENT
#define LDS_WAIT() asm volatile("s_waitcnt lgkmcnt(0)" ::: "memory")
#define VM_WAIT() asm volatile("s_waitcnt vmcnt(0)" ::: "memory")
__device__ __forceinline__ unsigned f2bf(float f) { unsigned u = __builtin_bit_cast(unsigned, f); return (u + 0x7fffu + ((u >> 16) & 1u)) >> 16; }
__device__ __forceinline__ unsigned pk2(float lo, float hi) { return f2bf(lo) | (f2bf(hi) << 16); }
__device__ __forceinline__ float bf2f(unsigned short b) { return __builtin_bit_cast(float, (unsigned)b << 16); }
__device__ __forceinline__ float bflo(unsigned w) { return __builtin_bit_cast(float, w << 16); }
__device__ __forceinline__ float bfhi(unsigned w) { return __builtin_bit_cast(float, w & 0xffff0000u); }

#define XB_TMO      128
#define XB_XCNT(j)  (256  + 64 * (j))
#define XB_XSUB(j)  (1280 + 64 * (j))
#define XB_XGEN(j)  (2304 + 64 * (j))
#define XB_TOP      3328
#define XB_TOPGEN   3392
#define XCD_BAR_WORDS 3456
#define XB_SPIN_CAP (1u << 18)
__device__ __forceinline__ unsigned xb_ld(unsigned* p)              { return __hip_atomic_load(p, __ATOMIC_RELAXED, __HIP_MEMORY_SCOPE_AGENT); }
__device__ __forceinline__ unsigned xb_add(unsigned* p, unsigned v) { return __hip_atomic_fetch_add(p, v, __ATOMIC_RELAXED, __HIP_MEMORY_SCOPE_AGENT); }
__device__ __forceinline__ unsigned xb_xcc_id() { return (unsigned)__builtin_amdgcn_s_getreg((3 << 11) | 20) & 0xFu; }
#define XB_SPIN(cond, bar) do { unsigned _sp = 0; while (cond) { __builtin_amdgcn_s_sleep(1); \
    if ((++_sp & 255u) == 0u) { if (xb_ld(&(bar)[XB_TMO])) break; if (_sp > XB_SPIN_CAP) { atomicAdd(&(bar)[XB_TMO], 1u); break; } } } } while (0)
struct XcdBarrier { unsigned* bar; unsigned x; volatile LAS unsigned* st; };
__device__ __forceinline__ XcdBarrier xcd_barrier_post(unsigned* bar, volatile LAS unsigned* st) {
    XcdBarrier b; b.bar = bar; b.x = xb_xcc_id(); b.st = st;
    if (threadIdx.x == 0) (void)xb_add(&bar[XB_XCNT(b.x)], 1u);
    return b;
}
__device__ __forceinline__ void xcd_barrier_complete(unsigned* bar, unsigned x, unsigned& nloc, unsigned& nx) {
    const unsigned G = gridDim.x * gridDim.y * gridDim.z;
    unsigned sum, cnt, mine, sp = 0u;
    for (;;) {
        sum = 0u; cnt = 0u; mine = 0u;
#pragma unroll
        for (unsigned j = 0; j < 16; ++j) { const unsigned c = xb_ld(&bar[XB_XCNT(j)]); sum += c; cnt += (c > 0u) ? 1u : 0u; mine = (j == x) ? c : mine; }
        if (sum == G) break;
        __builtin_amdgcn_s_sleep(1);
        if ((++sp & 255u) == 0u) { if (xb_ld(&bar[XB_TMO])) break; if (sp > XB_SPIN_CAP) { atomicAdd(&bar[XB_TMO], 1u); break; } }
    }
    nloc = mine > 0u ? mine : 1u; nx = cnt > 0u ? cnt : 1u;
}
__device__ __forceinline__ void xcd_barrier(const XcdBarrier& b) {
    asm volatile("s_waitcnt vmcnt(0)" ::: "memory");
    __syncthreads();
    if (threadIdx.x == 0) {
        unsigned* bar = b.bar;
        __builtin_amdgcn_s_waitcnt(0);
        unsigned nloc = b.st[0], nx = b.st[1];
        if (nloc == 0u) { xcd_barrier_complete(bar, b.x, nloc, nx); b.st[0] = nloc; b.st[1] = nx; }
        const unsigned old = xb_add(&bar[XB_XSUB(b.x)], 1u);
        const unsigned gen = old / nloc;
        if (old + 1u == (gen + 1u) * nloc) {
            __builtin_amdgcn_fence(__ATOMIC_RELEASE, "agent");
            asm volatile("s_waitcnt vmcnt(0)" ::: "memory");
            const unsigned og = xb_add(&bar[XB_TOP], 1u);
            const unsigned tg = og / nx;
            if (og + 1u == (tg + 1u) * nx) xb_add(&bar[XB_TOPGEN], 1u);
            else XB_SPIN(xb_ld(&bar[XB_TOPGEN]) == tg, bar);
            __builtin_amdgcn_fence(__ATOMIC_ACQUIRE, "agent");
            xb_add(&bar[XB_XGEN(b.x)], 1u);
            asm volatile("s_waitcnt vmcnt(0)" ::: "memory");
        } else {
            XB_SPIN(xb_ld(&bar[XB_XGEN(b.x)]) == gen, bar);
            __builtin_amdgcn_fence(__ATOMIC_ACQUIRE, "agent");
            asm volatile("s_waitcnt vmcnt(0)" ::: "memory");
        }
    }
    __syncthreads();
}

struct Args { const float* in[18]; float* out; unsigned char* ws; int ph_lo, ph_hi, li, pad; };
struct Frame {
    LAS unsigned char* lds;
    gu32* ctl;
    unsigned char* ws;
    int tid, lane, wave;
    int vcu, G;
};

__device__ __forceinline__ float wave_sum(float v) {
#pragma unroll
    for (int o = 1; o < 64; o <<= 1) v += __shfl_xor(v, o);
    return v;
}
__device__ __forceinline__ void transpose_block(const float* src, int ld_src, bf16* dst, int ld_dst, LAS float* scr, int lane, bf16* dst2) {
#pragma unroll 8
    for (int i = 0; i < 32; ++i) { const int kk = 2 * i + (lane >> 5); scr[kk * 33 + (lane & 31)] = __builtin_nontemporal_load(src + (size_t)kk * ld_src + (lane & 31)); }
    LDS_WAIT(); asm volatile("" ::: "memory");
    const int c = lane & 7;
#pragma unroll
    for (int j = 0; j < 4; ++j) { const int n = (lane >> 3) + 8 * j; const LAS float* s = scr + (8 * c) * 33 + n;
        v4u o; o.x = pk2(s[0 * 33], s[1 * 33]); o.y = pk2(s[2 * 33], s[3 * 33]); o.z = pk2(s[4 * 33], s[5 * 33]); o.w = pk2(s[6 * 33], s[7 * 33]);
        __builtin_nontemporal_store(o, (GAS v4u*)(dst + (size_t)n * ld_dst + 8 * c));
        if (dst2) __builtin_nontemporal_store(o, (GAS v4u*)(dst2 + (size_t)n * ld_dst + 8 * c)); }
    LDS_WAIT(); asm volatile("" ::: "memory");
}
__device__ __forceinline__ unsigned pk4_fp8f(float a, float b, float c, float d) { int w = 0; w = __builtin_amdgcn_cvt_pk_fp8_f32(a, b, w, false); w = __builtin_amdgcn_cvt_pk_fp8_f32(c, d, w, true); return (unsigned)w; }
__device__ __forceinline__ void transpose_block8(const float* src, int ld_src, unsigned char* dst, int ld_dst, float sc, LAS float* scr, int lane, unsigned char* dst2 = nullptr) {
#pragma unroll 8
    for (int i = 0; i < 32; ++i) { const int kk = 2 * i + (lane >> 5); scr[kk * 33 + (lane & 31)] = __builtin_nontemporal_load(src + (size_t)kk * ld_src + (lane & 31)); }
    LDS_WAIT(); asm volatile("" ::: "memory");
    const int c = lane & 7;
#pragma unroll
    for (int j = 0; j < 4; ++j) { const int n = (lane >> 3) + 8 * j; const LAS float* s = scr + (8 * c) * 33 + n;
        v2u o; o.x = pk4_fp8f(s[0 * 33] * sc, s[1 * 33] * sc, s[2 * 33] * sc, s[3 * 33] * sc); o.y = pk4_fp8f(s[4 * 33] * sc, s[5 * 33] * sc, s[6 * 33] * sc, s[7 * 33] * sc);
        __builtin_nontemporal_store(o, (GAS v2u*)(dst + (size_t)n * ld_dst + 8 * c));
        if (dst2) __builtin_nontemporal_store(o, (GAS v2u*)(dst2 + (size_t)n * ld_dst + 8 * c)); }
    LDS_WAIT(); asm volatile("" ::: "memory");
}
__device__ __forceinline__ void rms_row_to_bf16(int lane, const float* xrow, const float* g, bf16* orow) {
    const GAS f32x4* xr = (const GAS f32x4*)xrow + lane; const GAS f32x4* gr = (const GAS f32x4*)g + lane;
    f32x4 v[4]; float s = 0.f;
#pragma unroll
    for (int j = 0; j < 4; ++j) { v[j] = __builtin_nontemporal_load(xr + 64 * j); s += (v[j].x * v[j].x + v[j].y * v[j].y) + (v[j].z * v[j].z + v[j].w * v[j].w); }
    const float rstd = 1.0f / sqrtf(wave_sum(s) * (1.f / 1024.f) + RMS_EPS);
    GAS v2u* o8 = (GAS v2u*)orow + lane;
#pragma unroll
    for (int j = 0; j < 4; ++j) { const f32x4 gg = gr[64 * j]; v2u o; o.x = pk2(v[j].x * rstd * gg.x, v[j].y * rstd * gg.y); o.y = pk2(v[j].z * rstd * gg.z, v[j].w * rstd * gg.w); o8[64 * j] = o; }
}

__device__ __forceinline__ void rms_row_to_fp8(int lane, const float* xrow, const float* g, unsigned char* orow) {
    const GAS f32x4* xr = (const GAS f32x4*)xrow + lane; const GAS f32x4* gr = (const GAS f32x4*)g + lane;
    f32x4 v[4]; float s = 0.f;
#pragma unroll
    for (int j = 0; j < 4; ++j) { v[j] = __builtin_nontemporal_load(xr + 64 * j); s += (v[j].x * v[j].x + v[j].y * v[j].y) + (v[j].z * v[j].z + v[j].w * v[j].w); }
    const float rstd = H8_SCALE / sqrtf(wave_sum(s) * (1.f / 1024.f) + RMS_EPS);
    GAS unsigned* o4 = (GAS unsigned*)orow + lane;
#pragma unroll
    for (int j = 0; j < 4; ++j) { const f32x4 gg = gr[64 * j]; o4[64 * j] = pk4_fp8f(v[j].x * rstd * gg.x, v[j].y * rstd * gg.y, v[j].z * rstd * gg.z, v[j].w * rstd * gg.w); }
}
constexpr int IT_WIN0 = (1024 / 64) * (3072 / 32);
constexpr int IT_WOUT0 = (1024 / 64) * (1024 / 32);
constexpr int IT_RIN = (1024 / 64) * (6144 / 32);
constexpr int IT_ROUT = (2048 / 64) * (1024 / 32);
constexpr int IT_SHARED = IT_WIN0 + IT_WOUT0 + IT_RIN + IT_ROUT;
constexpr int IT_EXP = 3 * 256;
constexpr int IT_MOE = NEXP * IT_EXP;
__device__ __forceinline__ void conv_shared_item(Frame& F, const Args& a, int it, LAS float* scr) {
    unsigned char* ws = F.ws;
    if (it < IT_WIN0) { const int nblk = 96, kb = it / nblk, nb = it % nblk;
        if (QKV_FP8) transpose_block8(a.in[5] + (size_t)(64 * kb) * 3072 + 32 * nb, 3072, ws + WS_WINT0 + (size_t)(32 * nb) * 1024 + 64 * kb, 1024, WIN_SCALE, scr, F.lane);
        else transpose_block(a.in[5] + (size_t)(64 * kb) * 3072 + 32 * nb, 3072, (bf16*)(ws + WS_WINT0) + (size_t)(32 * nb) * 1024 + 64 * kb, 1024, scr, F.lane, nullptr);
        return; }
    it -= IT_WIN0;
    if (it < IT_WOUT0) { const int nblk = 32, kb = it / nblk, nb = it % nblk;
        transpose_block(a.in[8] + (size_t)(64 * kb) * 1024 + 32 * nb, 1024, (bf16*)(ws + WS_WOUTT0) + (size_t)(32 * nb) * 1024 + 64 * kb, 1024, scr, F.lane, nullptr); return; }
    it -= IT_WOUT0;
    if (it < IT_RIN) { const int nblk = 192, kb = it / nblk, nb = it % nblk, n0 = 32 * nb;
        unsigned char* A = ws + WS_WRINA; unsigned char* B = ws + WS_WRINB; unsigned char *d1, *d2 = nullptr;
        if (n0 < 2048) d1 = A + (size_t)n0 * 1024;
        else if (n0 < 4096) d1 = B + (size_t)(n0 - 2048) * 1024;
        else d1 = A + (size_t)(n0 - 2048) * 1024;
        transpose_block8(a.in[9] + (size_t)(64 * kb) * 6144 + n0, 6144, d1 + 64 * kb, 1024, WIN_SCALE, scr, F.lane, d2 ? d2 + 64 * kb : nullptr); return; }
    it -= IT_RIN;
    { const int nblk = 32, kb = it / nblk, nb = it % nblk;
        if (ROUT_FP8) transpose_block8(a.in[10] + (size_t)(64 * kb) * 1024 + 32 * nb, 1024, ws + WS_WROUTT + (size_t)(32 * nb) * 2048 + 64 * kb, 2048, WRO_SCALE, scr, F.lane);
        else transpose_block(a.in[10] + (size_t)(64 * kb) * 1024 + 32 * nb, 1024, (bf16*)(ws + WS_WROUTT) + (size_t)(32 * nb) * 2048 + 64 * kb, 2048, scr, F.lane, nullptr); }
}
__device__ __forceinline__ void conv_moe_item(Frame& F, const Args& a, int layer, int it, LAS float* scr) {
    unsigned char* ws = F.ws;
    const int e = it / IT_EXP; int r = it % IT_EXP; const size_t le = (size_t)layer * NEXP + e;
    if (r < 512) { const int up = r >> 8; r &= 255; const int kb = r / 16, nb = r % 16, n0 = 32 * nb;
        const float* src = a.in[up ? 16 : 15] + le * (1024 * 512) + (size_t)(64 * kb) * 512 + n0;
        const int drow = 256 * (n0 >> 7) + 128 * up + (n0 & 127);
        transpose_block8(src, 512, ws + WS_W1CAT + ((size_t)e * 1024 + drow) * 1024 + 64 * kb, 1024, W1_SCALE, scr, F.lane); return; }
    r -= 512; { const int kb = r / 32, nb = r % 32;
        const float* src = a.in[17] + le * (512 * 1024) + (size_t)(64 * kb) * 1024 + 32 * nb;
        transpose_block8(src, 1024, ws + WS_W2T + ((size_t)e * 1024 + 32 * nb) * 512 + 64 * kb, 512, W2_SCALE, scr, F.lane); }
}
__device__ __forceinline__ void build_router_frags(Frame& F, const Args& a, int gtid, int gthreads) {
    bf16* wrf = (bf16*)(F.ws + WS_WRF);
    for (int idx = gtid; idx < 2 * 32 * 3 * 64 * 8; idx += gthreads) {
        const int j = idx & 7, lane = (idx >> 3) & 63, nt = (idx >> 9) % 3, s = ((idx >> 9) / 3) & 31, L = (idx >> 9) / 96;
        const int k = 32 * s + 8 * (lane >> 4) + j, o = 16 * nt + (lane & 15);
        float w = 0.f;
        if (o < 4) w = a.in[11][((size_t)L * 1024 + k) * 4 + o]; else if (o < 36) w = a.in[13][((size_t)L * 1024 + k) * 32 + (o - 4)];
        w *= a.in[3][L * 1024 + k];
        const unsigned hi = f2bf(w); const float lo = w - __builtin_bit_cast(float, hi << 16);
        const size_t base = ((((size_t)L * 32 + s) * 3 + nt) * 2) * 512 + (size_t)lane * 8 + j;
        wrf[base] = (bf16)hi; wrf[base + 512] = (bf16)f2bf(lo);
    }
}
__device__ __forceinline__ void build_sincos(Frame& F, int gtid, int gthreads) {
    float* t1 = (float*)(F.ws + WS_SINCOS);
    for (int idx = gtid; idx < SEQ * 128; idx += gthreads) {
        const int pos = idx >> 7, i = idx & 127;
        double ang = 1.0, bs = 0.9300449458481391;
        for (int bit = 0; bit < 7; ++bit) { if ((i >> bit) & 1) ang *= bs; bs *= bs; }
        const double ph = (double)pos * ang;
        const double kq = __builtin_rint(ph * 0.63661977236758134308);
        double r = __builtin_fma(-kq, 1.57079632679489655800, ph); r = __builtin_fma(-kq, 6.12323399573676603587e-17, r);
        const double r2 = r * r;
        double sn = r * (1.0 + r2 * (-1.0 / 6 + r2 * (1.0 / 120 + r2 * (-1.0 / 5040 + r2 * (1.0 / 362880 + r2 * (-1.0 / 39916800 + r2 * (1.0 / 6227020800.0)))))));
        double cs = 1.0 + r2 * (-0.5 + r2 * (1.0 / 24 + r2 * (-1.0 / 720 + r2 * (1.0 / 40320 + r2 * (-1.0 / 3628800 + r2 * (1.0 / 479001600.0 + r2 * (-1.0 / 87178291200.0)))))));
        const int q = ((int)kq) & 3;
        double s_ = (q == 0) ? sn : (q == 1) ? cs : (q == 2) ? -sn : -cs;
        double c_ = (q == 0) ? cs : (q == 1) ? -sn : (q == 2) ? -cs : sn;
        t1[(size_t)idx * 2] = (float)c_; t1[(size_t)idx * 2 + 1] = (float)s_;
    }
}
__device__ __forceinline__ void p_prologue(Frame& F, const Args& a) {
    LAS float* scr = (LAS float*)(F.lds + RING_OFF + F.wave * 16384);
    const int gw = F.vcu * NWAVES + F.wave, NGW = F.G * NWAVES;
    for (int it = gw; it < IT_SHARED + IT_MOE; it += NGW) { if (it < IT_SHARED) conv_shared_item(F, a, it, scr); else conv_moe_item(F, a, 0, it - IT_SHARED, scr); }
    build_router_frags(F, a, F.vcu * 512 + F.tid, F.G * 512);
    build_sincos(F, F.vcu * 512 + F.tid, F.G * 512);
    for (int m = gw; m < TOK; m += NGW) { if (QKV_FP8) rms_row_to_fp8(F.lane, a.in[0] + (size_t)m * DM, a.in[2], F.ws + WS_HB + (size_t)m * DM); else rms_row_to_bf16(F.lane, a.in[0] + (size_t)m * DM, a.in[2], (bf16*)(F.ws + WS_HB) + (size_t)m * DM); }
}
__device__ __forceinline__ void p_attention(Frame& F, const Args& a) {
    LAS float* lut = (LAS float*)(F.lds + LX_LUT);
    const attn_body::bf16* QKV = (const attn_body::bf16*)(F.ws + WS_QKV0);
    const float* lq = a.in[6];
    const float lam = __expf(wave_sum(lq[F.lane] * lq[64 + F.lane])) - __expf(wave_sum(lq[128 + F.lane] * lq[192 + F.lane])) + 0.2f;
    for (int v = F.vcu; v < 256; v += F.G) {
        const int bh = v >> 2, s = v & 3, b = bh >> 3, h = bh & 7;
        __syncthreads();
        for (int idx = F.tid; idx < 672; idx += 512) { const int n = idx - 288; float val = 0.f;
            if (n < 0) val = -INFINITY;
            else if (n < 113) { int bk = n; if (n >= 16) { bk = 16; const int thr[15] = {19, 21, 24, 27, 31, 35, 40, 46, 52, 59, 67, 77, 87, 99, 113};
#pragma unroll
                for (int q = 0; q < 15; ++q) bk += (n >= thr[q]) ? 1 : 0; }
                val = (a.in[1][bk * 8 + h] - a.in[1][31 * 8 + h]) * LOG2E; }
            lut[idx] = val; }
        __syncthreads();
#pragma nounroll
        for (int i = 0; i < 4; ++i) {
            const int qb = (i < 2) ? 7 - s : s, m = i & 1;
            attn_body::bf16* O = (attn_body::bf16*)(F.ws + WS_OP) + (size_t)m * TOK * 1024 + h * 128;
            attn_body::attn_unit128<8>(b, qb, QKV, h * 128 + m * 64, 1024 + h * 128 + m * 64, 2048 + h * 128, O, lut, (char*)F.lds + RING_OFF);
            if ((i & 1) == 1) {
                VM_WAIT(); __syncthreads();
                int t_ = threadIdx.x; asm volatile("" : "+v"(t_));
                const int row = b * SEQ + qb * 256 + (t_ >> 1), c0 = h * 128 + (t_ & 1) * 64;
                const bf16* O0 = (const bf16*)(F.ws + WS_OP) + (size_t)row * 1024 + c0; const bf16* O1 = O0 + (size_t)TOK * 1024; bf16* AO = (bf16*)(F.ws + WS_AO) + (size_t)row * 1024 + c0;
                const float* sg = a.in[7] + (t_ & 1) * 64;
                float ss = 0.f; v4u wa[8], wb[8];
#pragma unroll
                for (int q = 0; q < 8; ++q) { wa[q] = ((const GAS v4u*)O0)[q]; wb[q] = ((const GAS v4u*)O1)[q]; }
#pragma unroll
                for (int q = 0; q < 8; ++q) { const unsigned xa[4] = {wa[q].x, wa[q].y, wa[q].z, wa[q].w}, xb[4] = {wb[q].x, wb[q].y, wb[q].z, wb[q].w};
#pragma unroll
                    for (int j = 0; j < 4; ++j) { const float o0 = bflo(xa[j]) - lam * bflo(xb[j]), o1 = bfhi(xa[j]) - lam * bfhi(xb[j]); ss += o0 * o0 + o1 * o1; } }
                ss += __shfl_xor(ss, 1);
                const float rstd = 0.8f / sqrtf(ss * (1.f / 128.f) + SUBLN_EPS);
#pragma unroll
                for (int q = 0; q < 8; ++q) { const unsigned xa[4] = {wa[q].x, wa[q].y, wa[q].z, wa[q].w}, xb[4] = {wb[q].x, wb[q].y, wb[q].z, wb[q].w}; unsigned r[4];
                    const f32x4 g0 = *(const GAS f32x4*)(sg + q * 8), g1 = *(const GAS f32x4*)(sg + q * 8 + 4); const float gg[8] = {g0.x, g0.y, g0.z, g0.w, g1.x, g1.y, g1.z, g1.w};
#pragma unroll
                    for (int j = 0; j < 4; ++j) r[j] = pk2((bflo(xa[j]) - lam * bflo(xb[j])) * rstd * gg[2 * j], (bfhi(xa[j]) - lam * bfhi(xb[j])) * rstd * gg[2 * j + 1]);
                    v4u o; o.x = r[0]; o.y = r[1]; o.z = r[2]; o.w = r[3]; ((GAS v4u*)AO)[q] = o; }
            }
        }
    }
}
__device__ __forceinline__ void p_diffcombine(Frame& F, const Args& a) {
    const int gw = F.vcu * NWAVES + F.wave, NGW = F.G * NWAVES, lane = F.lane;
    const float* lq = a.in[6];
    const float lam = __expf(wave_sum(lq[lane] * lq[64 + lane])) - __expf(wave_sum(lq[128 + lane] * lq[192 + lane])) + 0.2f;
    const int d0 = (lane & 7) * 16; float g[16];
#pragma unroll
    for (int j = 0; j < 16; ++j) g[j] = a.in[7][d0 + j] * 0.8f;
    const bf16* O0 = (const bf16*)(F.ws + WS_OP); const bf16* O1 = O0 + (size_t)TOK * 1024; bf16* AO = (bf16*)(F.ws + WS_AO);
    for (int m = gw; m < TOK; m += NGW) {
        const GAS v4u* p0 = (const GAS v4u*)(O0 + (size_t)m * 1024 + lane * 16); const GAS v4u* p1 = (const GAS v4u*)(O1 + (size_t)m * 1024 + lane * 16);
        const v4u a0 = p0[0], a1 = p0[1], b0 = p1[0], b1 = p1[1];
        const unsigned wa[8] = {a0.x, a0.y, a0.z, a0.w, a1.x, a1.y, a1.z, a1.w}, wb[8] = {b0.x, b0.y, b0.z, b0.w, b1.x, b1.y, b1.z, b1.w};
        float o[16]; float ss = 0.f;
#pragma unroll
        for (int j = 0; j < 8; ++j) { o[2 * j] = bflo(wa[j]) - lam * bflo(wb[j]); o[2 * j + 1] = bfhi(wa[j]) - lam * bfhi(wb[j]); ss += o[2 * j] * o[2 * j] + o[2 * j + 1] * o[2 * j + 1]; }
        ss += __shfl_xor(ss, 1); ss += __shfl_xor(ss, 2); ss += __shfl_xor(ss, 4);
        const float rstd = 1.0f / sqrtf(ss * (1.f / 128.f) + SUBLN_EPS);
        v4u w0, w1;
        w0.x = pk2(o[0] * rstd * g[0], o[1] * rstd * g[1]); w0.y = pk2(o[2] * rstd * g[2], o[3] * rstd * g[3]); w0.z = pk2(o[4] * rstd * g[4], o[5] * rstd * g[5]); w0.w = pk2(o[6] * rstd * g[6], o[7] * rstd * g[7]);
        w1.x = pk2(o[8] * rstd * g[8], o[9] * rstd * g[9]); w1.y = pk2(o[10] * rstd * g[10], o[11] * rstd * g[11]); w1.z = pk2(o[12] * rstd * g[12], o[13] * rstd * g[13]); w1.w = pk2(o[14] * rstd * g[14], o[15] * rstd * g[15]);
        GAS v4u* po = (GAS v4u*)(AO + (size_t)m * 1024 + lane * 16); po[0] = w0; po[1] = w1;
    }
}
template <int LAYER> __device__ __forceinline__ void p_router(Frame& F, const Args& a, const bf16* xres, int bank = LAYER) {
    typedef float f32x4v __attribute__((ext_vector_type(4)));
    LAS float* part = (LAS float*)(F.lds + RING_OFF);
    LAS float* ssqp = (LAS float*)(F.lds + RING_OFF + 98304);
    LAS float* logit = (LAS float*)(F.lds + RING_OFF + 100352);
    LAS float* rstd_s = (LAS float*)(F.lds + RING_OFF + 109568);
    LAS int* lcnt = (LAS int*)(F.lds + RING_OFF + 109824);
    LAS int* lbase = (LAS int*)(F.lds + RING_OFF + 109952);
    const int lane = F.lane, w = F.wave, row = lane & 15, kg = lane >> 4;
    const bf16x8* wrf = (const bf16x8*)(F.ws + WS_WRF) + (size_t)LAYER * (32 * 3 * 2 * 64);
    bf16x8 Bh[4][3], Bl[4][3];
#pragma unroll
    for (int s = 0; s < 4; ++s)
#pragma unroll
        for (int nt = 0; nt < 3; ++nt) { Bh[s][nt] = wrf[(((4 * w + s) * 3 + nt) * 2 + 0) * 64 + lane]; Bl[s][nt] = wrf[(((4 * w + s) * 3 + nt) * 2 + 1) * 64 + lane]; }
    const float* gffn = a.in[3] + LAYER * 1024; const float* bg = a.in[12] + LAYER * 4; const float* be = a.in[14] + LAYER * 32;
    int* list = (int*)(F.ws + WS_LIST); float* pairw = (float*)(F.ws + WS_PAIRW); bf16* HB = (bf16*)(F.ws + WS_HB);
    for (int tb = F.vcu; tb < TOK / 64; tb += F.G) {
        __syncthreads();
        if (F.tid < 32) lcnt[F.tid] = 0;
        f32x4v acc[4][3];
#pragma unroll
        for (int mt = 0; mt < 4; ++mt)
#pragma unroll
            for (int nt = 0; nt < 3; ++nt) acc[mt][nt] = (f32x4v){0.f, 0.f, 0.f, 0.f};
#pragma unroll
        for (int mt = 0; mt < 4; ++mt) { const bf16* xr = xres + (size_t)(tb * 64 + mt * 16 + row) * DM + 128 * w + 8 * kg; float ss = 0.f;
#pragma unroll
            for (int s = 0; s < 4; ++s) { const v4u xw = *(const GAS v4u*)(xr + 32 * s); const bf16x8 ah = __builtin_bit_cast(bf16x8, xw);
                const unsigned xv[4] = {xw.x, xw.y, xw.z, xw.w};
#pragma unroll
                for (int j = 0; j < 4; ++j) { const float x0 = bflo(xv[j]), x1 = bfhi(xv[j]); ss += x0 * x0 + x1 * x1; }
#pragma unroll
                for (int nt = 0; nt < 3; ++nt) { acc[mt][nt] = __builtin_amdgcn_mfma_f32_16x16x32_bf16(ah, Bh[s][nt], acc[mt][nt], 0, 0, 0);
                    acc[mt][nt] = __builtin_amdgcn_mfma_f32_16x16x32_bf16(ah, Bl[s][nt], acc[mt][nt], 0, 0, 0); } }
            ss += __shfl_xor(ss, 16); ss += __shfl_xor(ss, 32);
            if (kg == 0) ssqp[w * 64 + mt * 16 + row] = ss;
#pragma unroll
            for (int nt = 0; nt < 3; ++nt)
#pragma unroll
                for (int r = 0; r < 4; ++r) part[(w * 64 + mt * 16 + 4 * kg + r) * 48 + nt * 16 + row] = acc[mt][nt][r]; }
        __syncthreads();
        if (F.tid < 64) { float s = 0.f;
#pragma unroll
            for (int q = 0; q < 8; ++q) s += ssqp[q * 64 + F.tid];
            rstd_s[F.tid] = 1.0f / sqrtf(s * (1.f / 1024.f) + RMS_EPS); }
        __syncthreads();
        for (int idx = F.tid; idx < 64 * 36; idx += 512) { const int tk = idx / 36, o = idx % 36; float s = 0.f;
#pragma unroll
            for (int q = 0; q < 8; ++q) s += part[(q * 64 + tk) * 48 + o];
            logit[tk * 36 + o] = s * rstd_s[tk] + (o < 4 ? bg[o] : be[o - 4]); }
        __syncthreads();
        if (w == 0) {
            const LAS float* lg = logit + lane * 36;
            int gi = 0; float gm = lg[0];
#pragma unroll
            for (int j = 1; j < 4; ++j) { const float v = lg[j]; if (v > gm) { gm = v; gi = j; } }
            float gs = 0.f;
#pragma unroll
            for (int j = 0; j < 4; ++j) gs += __expf(lg[j] - gm);
            const float gp = 1.0f / gs;
            const LAS float* le = lg + 4 + gi * 8;
            int i1 = 0; float v1 = le[0];
#pragma unroll
            for (int j = 1; j < 8; ++j) { const float v = le[j]; if (v > v1) { v1 = v; i1 = j; } }
            int i2 = -1; float v2 = -INFINITY;
#pragma unroll
            for (int j = 0; j < 8; ++j) { const float v = le[j]; if (j != i1 && v > v2) { v2 = v; i2 = j; } }
            const float e2 = __expf(v2 - v1), w1 = gp / (1.0f + e2), w2 = gp * e2 / (1.0f + e2);
            const int e_1 = gi * 8 + i1, e_2 = gi * 8 + i2;
            const int r1 = __hip_atomic_fetch_add(lcnt + e_1, 1, __ATOMIC_RELAXED, __HIP_MEMORY_SCOPE_WORKGROUP);
            const int r2 = __hip_atomic_fetch_add(lcnt + e_2, 1, __ATOMIC_RELAXED, __HIP_MEMORY_SCOPE_WORKGROUP);
            LDS_WAIT();
            if (lane < 32) { const int c = lcnt[lane]; int bs = 0; if (c > 0) bs = (int)__hip_atomic_fetch_add((unsigned*)(F.ctl + CW_CNT + (bank * 32 + lane) * 64), (unsigned)c, RLX_AGENT); lbase[lane] = bs; }
            LDS_WAIT();
            const int tg = tb * 64 + lane; const int p1 = lbase[e_1] + r1, p2 = lbase[e_2] + r2;
            list[e_1 * LISTCAP + p1] = 2 * tg; list[e_2 * LISTCAP + p2] = 2 * tg + 1; pairw[2 * tg] = w1; pairw[2 * tg + 1] = w2;
        }
        for (int i = 0; i < 8; ++i) { const int tk = w * 8 + i, tg = tb * 64 + tk; const float rs8 = rstd_s[tk] * H8_SCALE;
            const GAS v2u* xr = (const GAS v2u*)(xres + (size_t)tg * DM) + lane; const GAS f32x4* gr = (const GAS f32x4*)gffn + lane; GAS unsigned* o4 = (GAS unsigned*)((unsigned char*)HB + (size_t)tg * DM) + lane;
#pragma unroll
            for (int j = 0; j < 4; ++j) { const v2u v = xr[64 * j]; const f32x4 gg = gr[64 * j]; o4[64 * j] = pk4_fp8f(bflo(v.x) * rs8 * gg.x, bfhi(v.x) * rs8 * gg.y, bflo(v.y) * rs8 * gg.z, bfhi(v.y) * rs8 * gg.w); } }
    }
}
template <int LAYER> __device__ __forceinline__ void moe_setup(Frame& F) {
    LAS int* tstart = (LAS int*)(F.lds + LX_TSTART); LAS int* texp = (LAS int*)(F.lds + LX_TEXP); LAS int* lc = (LAS int*)(F.lds + LX_CNT);
    __syncthreads();
    if (F.tid < 32) { int c = (int)__hip_atomic_load((unsigned*)(F.ctl + CW_CNT + (LAYER * 32 + F.tid) * 64), RLX_AGENT); c = c < 0 ? 0 : (c > LISTCAP ? LISTCAP : c); lc[F.tid] = c; }
    __syncthreads();
    if (F.tid == 0) { int acc = 0; for (int e = 0; e < 32; ++e) { tstart[e] = acc; acc += (lc[e] + 255) >> 8; } if (acc > MAXRT) acc = MAXRT; tstart[32] = acc; tstart[33] = acc; }
    __syncthreads();
    if (F.tid < MAXRT) { int e = 0;
#pragma unroll 1
        for (int q = 1; q < 32; ++q) if (tstart[q] <= F.tid) e = q;
        texp[F.tid] = e; }
    __syncthreads();
}
template <int LAYER> __device__ __forceinline__ void p_moe1(Frame& F) {
    moe_setup<LAYER>(F);
    const LAS int* tstart = (const LAS int*)(F.lds + LX_TSTART); const LAS int* texp = (const LAS int*)(F.lds + LX_TEXP); const LAS int* lc = (const LAS int*)(F.lds + LX_CNT);
    LAS int* rowtab = (LAS int*)(F.lds + LX_ROWTAB);
    pg8::MoeOrder S{F.G, F.vcu, 512, 0, tstart, texp};
    const int* list = (const int*)(F.ws + WS_LIST);
    pg8::Unit u;
    for (int i = 0; i < 4 && S.next(i, u); ++i) { if (F.tid < 256) { const int e = u.pn >> 2, pos = u.aux * 256 + F.tid; rowtab[i * 256 + F.tid] = (pos < lc[e]) ? (list[e * LISTCAP + pos] >> 1) : 0; } }
    VM_WAIT(); __syncthreads();
    pg8::Gemm g{(const bf16*)(F.ws + WS_HB), (const bf16*)(F.ws + WS_W1CAT), 512, 512, 512};
    pg8::EpiMoe1 E{(unsigned char*)(F.ws + WS_MACT)};
    pg8::gemm_phase<pg8::EpiMoe1, pg8::MoeOrder, true, true, true>(F.lds + RING_OFF, g, S, E, rowtab);
}
template <int LAYER> __device__ __forceinline__ void p_moe2(Frame& F) {
    moe_setup<LAYER>(F);
    const LAS int* tstart = (const LAS int*)(F.lds + LX_TSTART); const LAS int* texp = (const LAS int*)(F.lds + LX_TEXP); const LAS int* lc = (const LAS int*)(F.lds + LX_CNT);
    pg8::MoeOrder S{F.G, F.vcu, 256, 256 * 256, tstart, texp};
    pg8::Gemm g{(const bf16*)(F.ws + WS_MACT), (const bf16*)(F.ws + WS_W2T), 256, 256, 256};
    pg8::EpiMoe2 E{(unsigned char*)(F.ws + WS_Y), (const int*)(F.ws + WS_LIST), (const float*)(F.ws + WS_PAIRW), lc};
    pg8::gemm_phase<pg8::EpiMoe2, pg8::MoeOrder, true, false, true>(F.lds + RING_OFF, g, S, E, nullptr);
}
template <bool FINAL> __device__ __forceinline__ void p_combine(Frame& F, const bf16* xin, bf16* xout, float* outf, const float* g) {
    typedef float f2v __attribute__((ext_vector_type(2)));
    const int gw = F.vcu * NWAVES + F.wave, NGW = F.G * NWAVES, lane = F.lane;
    const unsigned char* Y = F.ws + WS_Y; unsigned char* HB = F.ws + WS_HB;
    f32x4 gg[4];
#pragma unroll
    for (int j = 0; j < 4; ++j) gg[j] = ((const GAS f32x4*)g + lane)[64 * j];
    v2u cx[4], nx[4]; unsigned cp[4], cq[4], np[4], nq[4];
#define CMB_LOAD(X, P, Q, m_) do { const GAS v2u* xr_ = (const GAS v2u*)(xin + (size_t)(m_) * DM) + lane; const GAS unsigned* y0_ = (const GAS unsigned*)(Y + (size_t)(2 * (m_)) * DM) + lane; const GAS unsigned* y1_ = (const GAS unsigned*)(Y + (size_t)(2 * (m_) + 1) * DM) + lane; \
        _Pragma("unroll") for (int j = 0; j < 4; ++j) { X[j] = xr_[64 * j]; P[j] = __builtin_nontemporal_load(y0_ + 64 * j); Q[j] = __builtin_nontemporal_load(y1_ + 64 * j); } } while (0)
    int m = gw;
    if (m < TOK) CMB_LOAD(cx, cp, cq, m);
    for (; m < TOK; m += NGW) {
        const int mn = m + NGW;
        if (mn < TOK) CMB_LOAD(nx, np, nq, mn);
        f32x4 v[4]; float s = 0.f; constexpr float ys = 1.0f / Y_SCALE;
#pragma unroll
        for (int j = 0; j < 4; ++j) { const v2u x = cx[j]; const f2v p0 = __builtin_amdgcn_cvt_pk_f32_fp8((int)cp[j], false), p1 = __builtin_amdgcn_cvt_pk_f32_fp8((int)cp[j], true), q0 = __builtin_amdgcn_cvt_pk_f32_fp8((int)cq[j], false), q1 = __builtin_amdgcn_cvt_pk_f32_fp8((int)cq[j], true);
            v[j].x = bflo(x.x) + (p0.x + q0.x) * ys; v[j].y = bfhi(x.x) + (p0.y + q0.y) * ys; v[j].z = bflo(x.y) + (p1.x + q1.x) * ys; v[j].w = bfhi(x.y) + (p1.y + q1.y) * ys;
            s += (v[j].x * v[j].x + v[j].y * v[j].y) + (v[j].z * v[j].z + v[j].w * v[j].w); }
        const float rstd = 1.0f / sqrtf(wave_sum(s) * (1.f / 1024.f) + RMS_EPS);
        if (FINAL) { GAS f32x4* xw = (GAS f32x4*)(outf + (size_t)m * DM) + lane;
#pragma unroll
            for (int j = 0; j < 4; ++j) { f32x4 o; o.x = v[j].x * rstd * gg[j].x; o.y = v[j].y * rstd * gg[j].y; o.z = v[j].z * rstd * gg[j].z; o.w = v[j].w * rstd * gg[j].w; __builtin_nontemporal_store(o, xw + 64 * j); }
        } else { GAS v2u* xw = (GAS v2u*)(xout + (size_t)m * DM) + lane;
            GAS unsigned* o4 = (GAS unsigned*)(HB + (size_t)m * DM) + lane; const float r8 = rstd * H8_SCALE;
#pragma unroll
            for (int j = 0; j < 4; ++j) { v2u xo; xo.x = pk2(v[j].x, v[j].y); xo.y = pk2(v[j].z, v[j].w); xw[64 * j] = xo; o4[64 * j] = pk4_fp8f(v[j].x * r8 * gg[j].x, v[j].y * r8 * gg[j].y, v[j].z * r8 * gg[j].z, v[j].w * r8 * gg[j].w); }
        }
#pragma unroll
        for (int j = 0; j < 4; ++j) { cx[j] = nx[j]; cp[j] = np[j]; cq[j] = nq[j]; }
    }
#undef CMB_LOAD
}
__device__ __forceinline__ void p_scan(Frame& F) {
    const bf16* DS = (const bf16*)(F.ws + WS_DS); bf16* BT = (bf16*)(F.ws + WS_BTCAT);
    for (int gidx = F.vcu * 512 + F.tid; gidx < NB * RH * 16384; gidx += F.G * 512) {
        const int bh = gidx >> 14, e8 = gidx & 16383, dv = e8 >> 5, dk0 = (e8 & 31) * 8, h = bh & 3;
        const float cd = __builtin_amdgcn_exp2f(256.0f * pg8::log2_gamma(h));
        v4u d[7];
#pragma unroll
        for (int n = 0; n < 7; ++n) d[n] = *(const GAS v4u*)(DS + ((size_t)(bh * RNC + n) * RDV + dv) * RDK + dk0);
        float s[8];
#pragma unroll
        for (int j = 0; j < 8; ++j) s[j] = 0.f;
#pragma unroll
        for (int n = 0; n < 8; ++n) {
            v4u o; o.x = pk2(s[0], s[1]); o.y = pk2(s[2], s[3]); o.z = pk2(s[4], s[5]); o.w = pk2(s[6], s[7]);
            *(GAS v4u*)(BT + ((size_t)(bh * RNC + n) * RDV + dv) * 512 + 256 + dk0) = o;
            if (n < 7) { const unsigned wv[4] = {d[n].x, d[n].y, d[n].z, d[n].w};
#pragma unroll
                for (int j = 0; j < 4; ++j) { s[2 * j] = cd * (s[2 * j] + bflo(wv[j])); s[2 * j + 1] = cd * (s[2 * j + 1] + bfhi(wv[j])); } }
        }
    }
}
__device__ __forceinline__ void p_normgate(Frame& F, bf16* dry = nullptr) {
    const int gw = F.vcu * NWAVES + F.wave, NGW = F.G * NWAVES, lane = F.lane;
    const bf16* OR = (const bf16*)(F.ws + WS_ORET); bf16* SG = (bf16*)(F.ws + WS_SG);
    for (int m = gw; m < TOK; m += NGW) {
        const GAS v4u* po = (const GAS v4u*)(OR + (size_t)m * 2048 + lane * 32); GAS v4u* pg = (GAS v4u*)(SG + (size_t)m * 2048 + lane * 32); GAS v4u* pw = dry ? (GAS v4u*)(dry + (size_t)m * 2048 + lane * 32) : pg;
        v4u ov[4], gv[4]; float ss = 0.f;
#pragma unroll
        for (int q = 0; q < 4; ++q) { ov[q] = po[q]; gv[q] = pg[q]; }
#pragma unroll
        for (int q = 0; q < 4; ++q) { const unsigned wv[4] = {ov[q].x, ov[q].y, ov[q].z, ov[q].w};
#pragma unroll
            for (int j = 0; j < 4; ++j) { const float x0 = bflo(wv[j]), x1 = bfhi(wv[j]); ss += x0 * x0 + x1 * x1; } }
        ss += __shfl_xor(ss, 1); ss += __shfl_xor(ss, 2); ss += __shfl_xor(ss, 4); ss += __shfl_xor(ss, 8);
        const float rstd = 1.0f / sqrtf(ss * (1.f / 512.f) + RMS_EPS);
#pragma unroll
        for (int q = 0; q < 4; ++q) { const unsigned wv[4] = {ov[q].x, ov[q].y, ov[q].z, ov[q].w}, wg[4] = {gv[q].x, gv[q].y, gv[q].z, gv[q].w}; unsigned r[4];
#pragma unroll
            for (int j = 0; j < 4; ++j) r[j] = pk2(bflo(wv[j]) * rstd * bflo(wg[j]), bfhi(wv[j]) * rstd * bfhi(wg[j]));
            v4u o; o.x = r[0]; o.y = r[1]; o.z = r[2]; o.w = r[3]; pw[q] = o; }
    }
}
__device__ __forceinline__ void p_conv_moe1(Frame& F, const Args& a) {
    LAS float* scr = (LAS float*)(F.lds + RING_OFF + F.wave * 16384);
    const int gw = F.vcu * NWAVES + F.wave, NGW = F.G * NWAVES;
    for (int it = gw; it < IT_MOE; it += NGW) conv_moe_item(F, a, 1, it, scr);
}

constexpr int N_PHASES = 19;
#ifndef MK_PER_PHASE
#define MK_PER_PHASE 0
#endif
__global__ void __launch_bounds__(NWAVES * 64, 2) hybrid_fwd(Args args) {
    extern __shared__ __attribute__((aligned(16))) unsigned char lds[];
    Frame F;
    F.lds = (LAS unsigned char*)lds;
    F.tid = threadIdx.x; F.lane = F.tid & 63; F.wave = __builtin_amdgcn_readfirstlane(F.tid >> 6);
    F.G = gridDim.x; { const int bx = blockIdx.x; F.vcu = (F.G % 8 == 0) ? (bx % 8) * (F.G / 8) + bx / 8 : bx; }
    F.ws = args.ws; F.ctl = (gu32*)(args.ws + WS_CTL);
    for (int u = F.tid; u < (LDS_BYTES - LX_OFF) / 4; u += NWAVES * 64) ((LAS unsigned*)(F.lds + LX_OFF))[u] = 0u;
    __syncthreads();
    XcdBarrier bar; bar.bar = (unsigned*)(F.ctl + CW_BAR); bar.x = 0; bar.st = nullptr;
    if (!MK_PER_PHASE) bar = xcd_barrier_post((unsigned*)(F.ctl + CW_BAR), (volatile LAS unsigned*)(F.lds + LX_MISC) + 8);
    const int lo = args.ph_lo, hi = args.ph_hi;
#ifndef PH_MASK
#define PH_MASK 0x7ffff
#endif
#define IN(k) (((PH_MASK >> (k)) & 1) && lo <= (k) && (k) < hi)
#define SEAM(k) do { if (IN(k) && IN((k) + 1)) xcd_barrier(bar); } while (0)
#define REFRESH() do { int t_ = threadIdx.x; asm volatile("" : "+v"(t_)); F.tid = t_; F.lane = t_ & 63; } while (0)
#ifndef DUP_MASK
#define DUP_MASK 0
#endif
#ifndef XBAR_N
#define XBAR_N 0
#endif
#define DUP(k) (((DUP_MASK >> (k)) & 1) != 0)
    bf16* xb = (bf16*)args.out;
    bf16* x3 = (bf16*)(args.ws + WS_X3);
    unsigned char* ws = args.ws;
    const int bx = (int)blockIdx.x;

    if (IN(0)) { REFRESH(); p_prologue(F, args); if (DUP(0)) { xcd_barrier(bar); p_prologue(F, args); } for (int q = 0; q < XBAR_N; ++q) xcd_barrier(bar); } SEAM(0);
    if (IN(1)) { REFRESH(); for (int rep_ = 0; rep_ < (DUP(1) ? 2 : 1); ++rep_) { if (rep_) xcd_barrier(bar);
        constexpr int KQ = QKV_FP8 ? 512 : 1024; pg8::Gemm g{(const bf16*)(ws + WS_HB), (const bf16*)(ws + WS_WINT0), KQ, KQ, KQ}; pg8::StaticOrder S; S.init(TOK, 3072, F.G, bx, KQ, KQ);
        pg8::EpiQKV E{(bf16*)(ws + WS_QKV0), ATT_C2};
        pg8::gemm_phase<pg8::EpiQKV, pg8::StaticOrder, true, false, (QKV_FP8 != 0)>(F.lds + RING_OFF, g, S, E, nullptr);
    }
    } SEAM(1);
    if (IN(2)) { REFRESH(); p_attention(F, args); if (DUP(2)) { xcd_barrier(bar); p_attention(F, args); } } if (IN(2) && IN(4)) xcd_barrier(bar);
    if (IN(4)) { REFRESH();
        pg8::Gemm g{(const bf16*)(ws + WS_AO), (const bf16*)(ws + WS_WOUTT0), 1024, 1024, 1024}; pg8::StaticOrder S; S.init(TOK, 1024, F.G, bx, 1024, 1024);
        pg8::EpiResB<true> E{args.in[0], xb, 1.0f};
        pg8::gemm_phase<pg8::EpiResB<true>, pg8::StaticOrder, true, false>(F.lds + RING_OFF, g, S, E, nullptr);
    } SEAM(4);
    if (IN(5)) { REFRESH(); p_router<0>(F, args, xb); } SEAM(5);
    if (IN(6)) { REFRESH(); p_moe1<0>(F); if (DUP(6)) { xcd_barrier(bar); p_moe1<0>(F); } } SEAM(6);
    if (IN(7)) { REFRESH(); p_moe2<0>(F); if (DUP(7)) { xcd_barrier(bar); p_moe2<0>(F); } } SEAM(7);
    if (IN(8)) { REFRESH(); p_combine<false>(F, xb, xb, nullptr, args.in[2] + 1024); } SEAM(8);
    if (IN(9)) { REFRESH(); for (int rep_ = 0; rep_ < (DUP(9) ? 2 : 1); ++rep_) { if (rep_) xcd_barrier(bar);
        { pg8::Gemm g{(const bf16*)(ws + WS_HB), (const bf16*)(ws + WS_WRINA), 512, 512, 512}; pg8::StaticOrder S; S.init(TOK, 4096, F.G, bx, 512, 512);
          pg8::EpiRetA E{(bf16*)(ws + WS_ACAT), (bf16*)(ws + WS_KI), (bf16*)(ws + WS_SG), (const float*)(ws + WS_SINCOS), (bf16*)(ws + WS_KIT)};
          pg8::gemm_phase<pg8::EpiRetA, pg8::StaticOrder, true, false, true>(F.lds + RING_OFF, g, S, E, nullptr); }
        { pg8::Gemm g{(const bf16*)(ws + WS_WRINB), (const bf16*)(ws + WS_HB), 512, 512, 512}; pg8::StaticOrder S; S.init(2048, TOK, F.G, bx, 512, 512);
          pg8::EpiRetB E{(bf16*)(ws + WS_BTCAT)};
          pg8::gemm_phase<pg8::EpiRetB, pg8::StaticOrder, true, false, true>(F.lds + RING_OFF, g, S, E, nullptr); }
    }
    } SEAM(9);
    if (IN(10)) { REFRESH(); for (int rep_ = 0; rep_ < (DUP(10) ? 2 : 1); ++rep_) { if (rep_) xcd_barrier(bar);
        { pg8::Gemm g{(const bf16*)(ws + WS_ACAT), (const bf16*)(ws + WS_KI), 512, 1024, 256}; pg8::ScoresOrder S{F.G, F.vcu};
          pg8::EpiScores E{(bf16*)(ws + WS_ACAT)};
          pg8::gemm_phase<pg8::EpiScores, pg8::ScoresOrder, true, false>(F.lds + RING_OFF, g, S, E, nullptr); }
        { pg8::Gemm g{(const bf16*)(ws + WS_BTCAT), (const bf16*)(ws + WS_KIT), 512, 2048, 256}; pg8::DsOrder S{F.G, F.vcu};
          pg8::EpiDS E{(bf16*)(ws + WS_DS)};
          pg8::gemm_phase<pg8::EpiDS, pg8::DsOrder, true, false>(F.lds + RING_OFF, g, S, E, nullptr); }
    }
    } SEAM(10);
    if (IN(11)) { REFRESH(); p_scan(F); if (DUP(11)) { xcd_barrier(bar); p_scan(F); } } SEAM(11);
    if (IN(12)) { REFRESH(); for (int rep_ = 0; rep_ < (DUP(12) ? 2 : 1); ++rep_) { if (rep_) xcd_barrier(bar);
        pg8::Gemm g{(const bf16*)(ws + WS_ACAT), (const bf16*)(ws + WS_BTCAT), 512, 512, 512}; pg8::RetOOrder S{F.G, F.vcu};
        pg8::EpiRetO E{(bf16*)(ws + WS_ORET), (bf16*)(ws + WS_SG), (LAS float*)(F.lds + LX_SSQ), ws + WS_AR8};
        pg8::gemm_phase<pg8::EpiRetO, pg8::RetOOrder, true, false>(F.lds + RING_OFF, g, S, E, nullptr);
    }
    } if (IN(12) && IN(14)) xcd_barrier(bar);
    if (IN(14)) { REFRESH();
        constexpr int KR = ROUT_FP8 ? 1024 : 2048;
        pg8::Gemm g{(const bf16*)(ws + (ROUT_FP8 ? WS_AR8 : WS_SG)), (const bf16*)(ws + WS_WROUTT), KR, KR, KR}; pg8::StaticOrder S; S.init(TOK, 1024, F.G, bx, KR, KR);
        pg8::EpiResB<false> E{xb, x3, ROUT_FP8 ? 1.0f / (AR_SCALE * WRO_SCALE) : 1.0f};
        pg8::gemm_phase<pg8::EpiResB<false>, pg8::StaticOrder, true, false, (ROUT_FP8 != 0)>(F.lds + RING_OFF, g, S, E, nullptr);
    } SEAM(14);
    if (IN(15)) { REFRESH(); p_router<1>(F, args, x3); __syncthreads(); p_conv_moe1(F, args); } SEAM(15);
    if (IN(16)) { REFRESH(); p_moe1<1>(F); } SEAM(16);
    if (IN(17)) { REFRESH(); p_moe2<1>(F); } SEAM(17);
    if (IN(18)) { REFRESH(); p_combine<true>(F, x3, nullptr, args.out, args.in[4]); }
#undef IN
#undef SEAM
}

extern "C" void kernel_launch(void* const* d_in, const int* in_sizes, int n_in, void* d_out, int out_size, void* d_ws, size_t ws_size, hipStream_t stream) {
    static int grid = 0;
    if (grid == 0) {
        if (n_in != 18 || in_sizes[0] != TOK * DM || out_size != TOK * DM || ws_size < WS_END) { fprintf(stderr, "kernel_launch: unexpected shapes / workspace (n_in %d, in0 %d, out %d, ws %zu < %zu); nothing launched\n", n_in, n_in > 0 ? in_sizes[0] : -1, out_size, ws_size, (size_t)WS_END); grid = -1; return; }
        int dev = 0, cus = 0, per_cu = 0;
        if (hipGetDevice(&dev) != hipSuccess || hipDeviceGetAttribute(&cus, hipDeviceAttributeMultiprocessorCount, dev) != hipSuccess) { grid = -1; return; }
        if (hipFuncSetAttribute((const void*)hybrid_fwd, hipFuncAttributeMaxDynamicSharedMemorySize, LDS_BYTES) != hipSuccess) { fprintf(stderr, "kernel_launch: hipFuncSetAttribute failed\n"); grid = -1; return; }
        if (hipOccupancyMaxActiveBlocksPerMultiprocessor(&per_cu, (const void*)hybrid_fwd, NWAVES * 64, LDS_BYTES) != hipSuccess || per_cu < 1) { fprintf(stderr, "kernel_launch: occupancy query says %d\n", per_cu); }
        (void)hipGetLastError();
        grid = cus > 256 ? 256 : cus;
    }
    if (grid < 0) return;
    if (hipMemsetAsync((char*)d_ws + WS_CTL, 0, CTL_ZERO_BYTES, stream) != hipSuccess) return;
    Args a{};
    for (int i = 0; i < 18; ++i) a.in[i] = (const float*)d_in[i];
    a.out = (float*)d_out; a.ws = (unsigned char*)d_ws; a.pad = 0;
#if MK_PER_PHASE
    for (int p = 0; p < N_PHASES; ++p) { a.ph_lo = p; a.ph_hi = p + 1; a.li = p; hipLaunchKernelGGL(hybrid_fwd, dim3(grid), dim3(NWAVES * 64), LDS_BYTES, stream, a); }
#else
    a.ph_lo = 0; a.ph_hi = N_PHASES; a.li = 0;
    hipLaunchKernelGGL(hybrid_fwd, dim3(grid), dim3(NWAVES * 64), LDS_BYTES, stream, a);
#endif
}
```
